# Optimizing an MI355X kernel written in HIP

```python
import math
import jax, jax.numpy as jnp
from jax import lax
import numpy as np

D_MODEL = 1024
BATCH = 8
SEQ = 2048
DEPTH = 4

CHUNK = 64
N_META = 16
HEAD_DIM = 64
RW_HEADS = 8
RW_WIDTH = RW_HEADS * HEAD_DIM
FX_HEADS = 8
FX_WIDTH = FX_HEADS * HEAD_DIM
DECAY_LORA = 64
AAA_LORA = 64
GATE_LORA = 160
D_FF = 2816
CONV_W = 3
Q_BLOCK = 128
NORM_EPS = 1e-6
GN_EPS = HEAD_DIM * 1e-5

RW_SIZES = (RW_WIDTH, RW_WIDTH, RW_WIDTH, DECAY_LORA, AAA_LORA, GATE_LORA)
RW_COLS = 3 * RW_WIDTH + DECAY_LORA + AAA_LORA + GATE_LORA
FX_SIZES = (FX_WIDTH, FX_WIDTH, FX_WIDTH, FX_WIDTH, FX_HEADS)
FX_COLS = 4 * FX_WIDTH + FX_HEADS
N_IN = RW_COLS + FX_COLS
MIX_WIDTH = RW_WIDTH + FX_WIDTH

kernel_name = "hybrid_rwkv7_fox_convffn_trunk"


def _rmsnorm(x, g, eps=NORM_EPS):
    xf = x.astype(jnp.float32)
    y = xf * lax.rsqrt(jnp.mean(xf * xf, axis=-1, keepdims=True) + eps)
    return (y * g.astype(jnp.float32)).astype(x.dtype)


def _split(h, sizes):
    out = []
    o = 0
    for s in sizes:
        out.append(h[..., o:o + s])
        o += s
    return out


def _heads(t, n):
    return t.reshape(t.shape[:-1] + (n, HEAD_DIM))


def _rwkv7_scan(r, w, k, v, a, b):
    B, L, H, N = r.shape

    def step(S, inp):
        r_t, w_t, k_t, v_t, a_t, b_t = inp
        sa = jnp.einsum('bhvk,bhk->bhv', S, a_t)
        S = S * w_t[:, :, None, :] + sa[..., None] * b_t[:, :, None, :] + v_t[..., None] * k_t[:, :, None, :]
        y = jnp.einsum('bhvk,bhk->bhv', S, r_t)
        return S, y

    xs = tuple(jnp.swapaxes(t, 0, 1) for t in (r, w, k, v, a, b))
    S0 = jnp.zeros((B, H, N, N), jnp.float32)
    _, y = lax.scan(step, S0, xs)
    return jnp.swapaxes(y, 0, 1)


def _rwkv7_mixer(h, mu, w0, w_up, a0, a_up, g_up, k_k, k_a, r_k, gn_w, gn_b):
    f32 = jnp.float32
    B, L, _ = h.shape
    dtype = h.dtype
    prev = jnp.pad(h, ((0, 0), (1, 0), (0, 0)))[:, :-1]
    h = h + mu.astype(dtype) * (prev - h)
    r, k, v, wd, ad, gd = _split(h, RW_SIZES)
    w_log = -jax.nn.softplus(-(w0 + jnp.tanh(wd) @ w_up).astype(f32)) - 0.5
    decay = jnp.exp(-jnp.exp(w_log))
    a = jax.nn.sigmoid((a0 + ad @ a_up).astype(f32))
    g = jax.nn.sigmoid(gd) @ g_up
    r = _heads(r.astype(f32), RW_HEADS)
    k = _heads(k.astype(f32), RW_HEADS)
    v = _heads(v.astype(f32), RW_HEADS)
    a = _heads(a, RW_HEADS)
    decay = _heads(decay, RW_HEADS)
    kk = k * _heads(k_k.astype(f32), RW_HEADS)
    kk = kk / jnp.maximum(jnp.sqrt(jnp.sum(kk * kk, axis=-1, keepdims=True)), 1e-12)
    k = k * (1.0 + (a - 1.0) * _heads(k_a.astype(f32), RW_HEADS))
    y = _rwkv7_scan(r, decay, k, v, -kk, kk * a)
    mean = jnp.mean(y, axis=-1, keepdims=True)
    var = jnp.mean(jnp.square(y - mean), axis=-1, keepdims=True)
    y = ((y - mean) * lax.rsqrt(var + GN_EPS)).reshape(B, L, RW_WIDTH)
    y = y * gn_w.astype(f32) + gn_b.astype(f32)
    bonus = jnp.sum(r * k * r_k.astype(f32), axis=-1, keepdims=True) * v
    y = y + bonus.reshape(B, L, RW_WIDTH)
    return (y * g.astype(f32)).astype(dtype)


def _fox_mixer(h, b_f, q_g, k_g):
    f32 = jnp.float32
    B, L, _ = h.shape
    dtype = h.dtype
    q, k, v, og, fl = _split(h, FX_SIZES)
    q = _rmsnorm(_heads(q, FX_HEADS), q_g).astype(f32) * (HEAD_DIM ** -0.5)
    k = _rmsnorm(_heads(k, FX_HEADS), k_g).astype(f32)
    v = _heads(v, FX_HEADS).astype(f32)
    logf = jax.nn.log_sigmoid((fl + b_f).astype(f32))
    c = jnp.cumsum(logf, axis=1)
    q = q.transpose(0, 2, 1, 3)
    k = k.transpose(0, 2, 1, 3)
    v = v.transpose(0, 2, 1, 3)
    c = c.transpose(0, 2, 1)
    n_blk = -(-L // Q_BLOCK)
    pad = n_blk * Q_BLOCK - L
    qb = jnp.pad(q, ((0, 0), (0, 0), (0, pad), (0, 0))).reshape(B, FX_HEADS, n_blk, Q_BLOCK, HEAD_DIM).transpose(2, 0, 1, 3, 4)
    cb = jnp.pad(c, ((0, 0), (0, 0), (0, pad))).reshape(B, FX_HEADS, n_blk, Q_BLOCK).transpose(2, 0, 1, 3)
    qpos = jnp.arange(n_blk * Q_BLOCK).reshape(n_blk, Q_BLOCK)
    kpos = jnp.arange(L)

    def block(args):
        q_i, c_i, pos_i = args
        s = jnp.einsum('bhqd,bhkd->bhqk', q_i, k) + c_i[..., None] - c[:, :, None, :]
        s = jnp.where(kpos[None, :] <= pos_i[:, None], s, -jnp.inf)
        p = jax.nn.softmax(s, axis=-1)
        return jnp.einsum('bhqk,bhkd->bhqd', p, v)

    o = lax.map(block, (qb, cb, qpos))
    o = o.transpose(1, 0, 3, 2, 4).reshape(B, n_blk * Q_BLOCK, FX_WIDTH)[:, :L]
    o = o * jax.nn.sigmoid(og.astype(f32))
    return o.astype(dtype)


def _conv_ffn(x, w_in, conv_w, conv_b, w_out):
    h = x @ w_in
    L = h.shape[1]
    hp = jnp.pad(h, ((0, 0), (CONV_W - 1, 0), (0, 0)))
    y = conv_b
    for i in range(CONV_W):
        y = y + conv_w[i] * hp[:, i:i + L]
    u, gt = jnp.split(y, 2, axis=-1)
    return (jax.nn.silu(gt) * u) @ w_out


def setup_inputs(seed: int = 0) -> dict:
    key = jax.random.key(seed)
    ks = jax.random.split(key, 26)
    f32 = jnp.float32
    nrm = lambda k, s: jax.random.normal(k, s, f32)
    uni = lambda k, s: jax.random.uniform(k, s, f32)
    D = D_MODEL
    conv_center = jnp.zeros((CONV_W, 1), f32).at[CONV_W - 1].set(1.0)
    return {
        "x": nrm(ks[0], (BATCH, SEQ, D)),
        "meta": nrm(ks[1], (N_META, D)),
        "norm1_g": 1.0 + 0.02 * nrm(ks[2], (DEPTH, D)),
        "w_in": nrm(ks[3], (DEPTH, D, N_IN)) * D ** -0.5,
        "rw_mu": uni(ks[4], (DEPTH, RW_COLS)),
        "rw_w0": -6.0 + 5.0 * uni(ks[5], (DEPTH, RW_WIDTH)),
        "rw_w_up": 0.5 * nrm(ks[6], (DEPTH, DECAY_LORA, RW_WIDTH)) * DECAY_LORA ** -0.5,
        "rw_a0": 0.02 * nrm(ks[7], (DEPTH, RW_WIDTH)),
        "rw_a_up": nrm(ks[8], (DEPTH, AAA_LORA, RW_WIDTH)) * AAA_LORA ** -0.5,
        "rw_g_up": nrm(ks[9], (DEPTH, GATE_LORA, RW_WIDTH)) * GATE_LORA ** -0.5,
        "rw_k_k": 0.85 + 0.02 * nrm(ks[10], (DEPTH, RW_WIDTH)),
        "rw_k_a": 1.0 + 0.02 * nrm(ks[11], (DEPTH, RW_WIDTH)),
        "rw_r_k": 0.1 * nrm(ks[12], (DEPTH, RW_HEADS, HEAD_DIM)),
        "rw_gn_w": 1.0 + 0.02 * nrm(ks[13], (DEPTH, RW_WIDTH)),
        "rw_gn_b": 0.02 * nrm(ks[14], (DEPTH, RW_WIDTH)),
        "fx_b_f": 1.0 + 3.0 * uni(ks[15], (DEPTH, FX_HEADS)),
        "fx_q_g": 1.0 + 0.02 * nrm(ks[16], (DEPTH, HEAD_DIM)),
        "fx_k_g": 1.0 + 0.02 * nrm(ks[17], (DEPTH, HEAD_DIM)),
        "w_o": nrm(ks[18], (DEPTH, MIX_WIDTH, D)) * MIX_WIDTH ** -0.5,
        "norm2_g": 1.0 + 0.02 * nrm(ks[19], (DEPTH, D)),
        "ffn_w_in": nrm(ks[20], (DEPTH, D, 2 * D_FF)) * D ** -0.5,
        "ffn_conv_w": 0.2 * nrm(ks[21], (DEPTH, CONV_W, 2 * D_FF)) + conv_center[None],
        "ffn_conv_b": 0.02 * nrm(ks[22], (DEPTH, 2 * D_FF)),
        "ffn_w_out": nrm(ks[23], (DEPTH, D_FF, D)) * D_FF ** -0.5,
    }


def reference(x, meta, norm1_g, w_in, rw_mu, rw_w0, rw_w_up, rw_a0, rw_a_up, rw_g_up,
              rw_k_k, rw_k_a, rw_r_k, rw_gn_w, rw_gn_b, fx_b_f, fx_q_g, fx_k_g, w_o,
              norm2_g, ffn_w_in, ffn_conv_w, ffn_conv_b, ffn_w_out):
    B = x.shape[0]
    meta_b = jnp.broadcast_to(meta[None].astype(x.dtype), (B, N_META, D_MODEL))
    h = jnp.concatenate([meta_b, x], axis=1)
    for l in range(DEPTH):
        p = _rmsnorm(h, norm1_g[l]) @ w_in[l]
        y_rw = _rwkv7_mixer(p[..., :RW_COLS], rw_mu[l], rw_w0[l], rw_w_up[l], rw_a0[l], rw_a_up[l],
                            rw_g_up[l], rw_k_k[l], rw_k_a[l], rw_r_k[l], rw_gn_w[l], rw_gn_b[l])
        y_fx = _fox_mixer(p[..., RW_COLS:], fx_b_f[l], fx_q_g[l], fx_k_g[l])
        h = h + jnp.concatenate([y_rw, y_fx], axis=-1) @ w_o[l]
        h = h + _conv_ffn(_rmsnorm(h, norm2_g[l]), ffn_w_in[l], ffn_conv_w[l], ffn_conv_b[l], ffn_w_out[l])
    return h[:, N_META:]
```

```cpp
#include <hip/hip_runtime.h>
#include <stdint.h>

typedef unsigned short bf16_t;
typedef short bf16x8 __attribute__((ext_vector_type(8)));
typedef float f32x4 __attribute__((ext_vector_type(4)));
typedef unsigned u32x4 __attribute__((ext_vector_type(4)));

constexpr int NB = 8, SEQ = 2048, NMETA = 16, LTOT = 2064, DM = 1024, DEPTH = 4, NH = 8, HD = 64;
constexpr int N_IN = 3880, DFF = 2816, DFF2 = 5632;
constexpr int MROWS = NB * SEQ;
constexpr int RROWS = MROWS + NMETA;
constexpr int N1 = 4096;
constexpr int PBW = 3584;
constexpr int PNW = 320;
constexpr float LOG2E = 1.4426950408889634f;

constexpr size_t MiB = 1u << 20;
constexpr size_t WS_W1 = 1 * MiB;
constexpr size_t WS_W2 = WS_W1 + 32 * MiB;
constexpr size_t WS_W3 = WS_W2 + 8 * MiB;
constexpr size_t WS_W4 = WS_W3 + 44 * MiB;
constexpr size_t WS_SMALL = WS_W4 + 22 * MiB;
constexpr size_t WS_HM = WS_SMALL;
constexpr size_t WS_RSTD = WS_SMALL + 128 * 1024;
constexpr size_t WS_C2 = WS_SMALL + 1 * MiB;
constexpr size_t WS_LF2 = WS_SMALL + 2 * MiB;
constexpr size_t WS_HB = WS_SMALL + 4 * MiB;
constexpr size_t WS_P = WS_HB + 33 * MiB;
constexpr size_t WS_PN = WS_P + 113 * MiB;
constexpr size_t WS_Y = WS_PN + 21 * MiB;
constexpr size_t WS_FREE = WS_Y + 33 * MiB;
constexpr size_t WS_WE = WS_HB;
constexpr size_t WS_ALR = WS_FREE;
constexpr size_t WS_ACT = WS_P;
constexpr size_t WS_RAW = WS_PN;

__device__ __forceinline__ float bf2f(bf16_t v) { return __uint_as_float(((unsigned)v) << 16); }
__device__ __forceinline__ bf16_t f2bf(float f) { unsigned u = __float_as_uint(f); return (bf16_t)((u + 0x7fffu + ((u >> 16) & 1u)) >> 16); }
__device__ __forceinline__ float sigmoidf_(float x) { return 1.f / (1.f + __expf(-x)); }
__device__ __forceinline__ float wave_sum(float v) {
#pragma unroll
    for (int o = 1; o < 64; o <<= 1) v += __shfl_xor(v, o);
    return v;
}
__device__ __forceinline__ float wave_max(float v) {
#pragma unroll
    for (int o = 1; o < 64; o <<= 1) v = fmaxf(v, __shfl_xor(v, o));
    return v;
}
__device__ __forceinline__ int rowof(int b, int t) { return t < NMETA ? MROWS + t : b * SEQ + (t - NMETA); }
__device__ __forceinline__ int prevrow(int row) {
    if (row >= MROWS) return row == MROWS ? -1 : row - 1;
    return (row & (SEQ - 1)) ? row - 1 : MROWS + NMETA - 1;
}

__device__ __forceinline__ int src_col(int mode, int n) {
    if (mode == 1) {
        const int g = n >> 9, o = n & 511;
        switch (g) {
            case 0: return o;
            case 1: return 512 + o;
            case 2: return 1024 + o;
            case 3: return 1824 + o;
            case 4: return 2336 + o;
            case 5: return 2848 + o;
            case 6: return 3360 + o;
            default:
                if (o < 64) return 1536 + o;
                if (o < 128) return 1600 + (o - 64);
                if (o < 288) return 1664 + (o - 128);
                if (o < 296) return 3872 + (o - 288);
                return -1;
        }
    }
    if (mode == 3) { const int t = n >> 8, c = n & 255; return c < 128 ? 128 * t + c : DFF + 128 * t + (c - 128); }
    return n;
}
__device__ __forceinline__ void wprep_item(const float* W, const float* gk, bf16_t* WT, int K, int Nsrc, int Ndst, int mode, int item, float* scr, int lane) {
    const int nblk = Ndst / 32, kb = item / nblk, nb = item % nblk, k0 = 64 * kb, n0 = 32 * nb;
    const int sc = src_col(mode, n0 + (lane & 31));
#pragma unroll 8
    for (int i = 0; i < 32; ++i) {
        const int kk = 2 * i + (lane >> 5);
        float v = 0.f;
        if (sc >= 0) { v = W[(size_t)(k0 + kk) * Nsrc + sc]; if (gk) v *= gk[k0 + kk]; }
        scr[kk * 33 + (lane & 31)] = v;
    }
    __builtin_amdgcn_s_waitcnt(0xc07f); __builtin_amdgcn_wave_barrier();
    const int c = lane & 7;
#pragma unroll
    for (int j = 0; j < 4; ++j) {
        const int n = (lane >> 3) + 8 * j; const float* s = scr + (8 * c) * 33 + n;
        u32x4 o;
        o.x = (unsigned)f2bf(s[0 * 33]) | ((unsigned)f2bf(s[1 * 33]) << 16);
        o.y = (unsigned)f2bf(s[2 * 33]) | ((unsigned)f2bf(s[3 * 33]) << 16);
        o.z = (unsigned)f2bf(s[4 * 33]) | ((unsigned)f2bf(s[5 * 33]) << 16);
        o.w = (unsigned)f2bf(s[6 * 33]) | ((unsigned)f2bf(s[7 * 33]) << 16);
        *(u32x4*)(WT + (size_t)(n0 + n) * K + k0 + 8 * c) = o;
    }
    __builtin_amdgcn_s_waitcnt(0xc07f); __builtin_amdgcn_wave_barrier();
}
struct WPrepArgs { const float* w_in; const float* w_o; const float* ffn_w_in; const float* ffn_w_out; const float* norm1_g; const float* norm2_g; unsigned char* ws; };
__global__ void __launch_bounds__(256) k_wprep(WPrepArgs a) {
    __shared__ float scr_all[4 * 64 * 33];
    const int lane = threadIdx.x & 63, wave = threadIdx.x >> 6;
    float* scr = scr_all + wave * 64 * 33;
    constexpr int I1 = (DM / 64) * (N1 / 32), I2 = (DM / 64) * (DM / 32), I3 = (DM / 64) * (DFF2 / 32), I4 = (DFF / 64) * (DM / 32), IL = I1 + I2 + I3 + I4;
    const int gw = blockIdx.x * 4 + wave, ngw = gridDim.x * 4;
    for (int it = gw; it < DEPTH * IL; it += ngw) {
        const int l = it / IL; int r = it % IL;
        if (r < I1) { wprep_item(a.w_in + (size_t)l * DM * N_IN, a.norm1_g + l * DM, (bf16_t*)(a.ws + WS_W1) + (size_t)l * N1 * DM, DM, N_IN, N1, 1, r, scr, lane); continue; } r -= I1;
        if (r < I2) { wprep_item(a.w_o + (size_t)l * DM * DM, nullptr, (bf16_t*)(a.ws + WS_W2) + (size_t)l * DM * DM, DM, DM, DM, 2, r, scr, lane); continue; } r -= I2;
        if (r < I3) { wprep_item(a.ffn_w_in + (size_t)l * DM * DFF2, a.norm2_g + l * DM, (bf16_t*)(a.ws + WS_W3) + (size_t)l * DFF2 * DM, DM, DFF2, DFF2, 3, r, scr, lane); continue; } r -= I3;
        wprep_item(a.ffn_w_out + (size_t)l * DFF * DM, nullptr, (bf16_t*)(a.ws + WS_W4) + (size_t)l * DM * DFF, DFF, DM, DM, 4, r, scr, lane);
    }
}

__global__ void k_init(const float* x, const float* meta, float* out, float* hm) {
    const size_t n4 = (size_t)MROWS * DM / 4;
    for (size_t i = blockIdx.x * (size_t)blockDim.x + threadIdx.x; i < n4; i += (size_t)gridDim.x * blockDim.x) ((f32x4*)out)[i] = ((const f32x4*)x)[i];
    for (size_t i = blockIdx.x * (size_t)blockDim.x + threadIdx.x; i < NMETA * DM / 4; i += (size_t)gridDim.x * blockDim.x) ((f32x4*)hm)[i] = ((const f32x4*)meta)[i];
}
__device__ __forceinline__ float* hrow(float* out, float* hm, int row) { return row < MROWS ? out + (size_t)row * DM : hm + (size_t)(row - MROWS) * DM; }

__global__ void __launch_bounds__(256) k_norm(float* out, float* hm, bf16_t* hb, float* rstd) {
    const int lane = threadIdx.x & 63, gw = blockIdx.x * 4 + (threadIdx.x >> 6), ngw = gridDim.x * 4;
    for (int row = gw; row < RROWS; row += ngw) {
        const f32x4* xr = (const f32x4*)hrow(out, hm, row) + lane;
        f32x4 v[4]; float s = 0.f;
#pragma unroll
        for (int j = 0; j < 4; ++j) { v[j] = xr[64 * j]; s += (v[j].x * v[j].x + v[j].y * v[j].y) + (v[j].z * v[j].z + v[j].w * v[j].w); }
        s = wave_sum(s);
        if (lane == 0) rstd[row] = 1.0f / sqrtf(s * (1.f / DM) + 1e-6f);
        unsigned long long* o8 = (unsigned long long*)(hb + (size_t)row * DM) + lane;
#pragma unroll
        for (int j = 0; j < 4; ++j)
            o8[64 * j] = (unsigned long long)((unsigned)f2bf(v[j].x) | ((unsigned)f2bf(v[j].y) << 16)) | ((unsigned long long)((unsigned)f2bf(v[j].z) | ((unsigned)f2bf(v[j].w) << 16)) << 32);
    }
}

struct Epi1 { const float* rstd; bf16_t* p; float* pn;
    __device__ __forceinline__ void operator()(int row, int col, float v) const {
        v *= rstd[row]; const int g = col >> 9;
        if (g < 7) p[(size_t)row * PBW + col] = f2bf(v);
        else { const int o = col & 511; if (o < 296) pn[(size_t)row * PNW + o] = v; } } };
struct EpiRes { float* out; float* hm;
    __device__ __forceinline__ void operator()(int row, int col, float v) const { float* h = hrow(out, hm, row) + col; *h = *h + v; } };
struct Epi3 { const float* rstd; bf16_t* raw; int ldr;
    __device__ __forceinline__ void operator()(int row, int col, float v) const { raw[(size_t)row * ldr + col] = f2bf(v * rstd[row]); } };

template <class Epi>
__global__ void __launch_bounds__(256) k_gemm(const bf16_t* A, const bf16_t* Wt, int M, int N, int K, Epi E) {
    const int lane = threadIdx.x & 63, wave = threadIdx.x >> 6, wr = wave >> 1, wc = wave & 1;
    const int nbn = N / 128;
    const int bm = blockIdx.x / nbn, bn = blockIdx.x % nbn;
    const int m0 = bm * 128 + wr * 64, n0 = bn * 128 + wc * 64;
    const int fr = lane & 15, fq = lane >> 4;
    f32x4 acc[4][4];
#pragma unroll
    for (int i = 0; i < 4; ++i)
#pragma unroll
        for (int j = 0; j < 4; ++j) acc[i][j] = (f32x4){0.f, 0.f, 0.f, 0.f};
    const bf16_t* ap = A + (size_t)(m0 + fr) * K + 8 * fq;
    const bf16_t* bp = Wt + (size_t)(n0 + fr) * K + 8 * fq;
    for (int k = 0; k < K; k += 32) {
        bf16x8 a[4], b[4];
#pragma unroll
        for (int i = 0; i < 4; ++i) a[i] = *(const bf16x8*)(ap + (size_t)(16 * i) * K + k);
#pragma unroll
        for (int j = 0; j < 4; ++j) b[j] = *(const bf16x8*)(bp + (size_t)(16 * j) * K + k);
#pragma unroll
        for (int i = 0; i < 4; ++i)
#pragma unroll
            for (int j = 0; j < 4; ++j) acc[i][j] = __builtin_amdgcn_mfma_f32_16x16x32_bf16(a[i], b[j], acc[i][j], 0, 0, 0);
    }
#pragma unroll
    for (int i = 0; i < 4; ++i)
#pragma unroll
        for (int j = 0; j < 4; ++j)
#pragma unroll
            for (int r = 0; r < 4; ++r) { const int row = m0 + 16 * i + 4 * fq + r, col = n0 + 16 * j + fr; if (row < M) E(row, col, acc[i][j][r]); }
}

struct RwP { const float* mu; const float* w0; const float* w_up; const float* a0; const float* a_up; const float* g_up; };
__global__ void __launch_bounds__(256) k_rwkv_prep(const float* pn, RwP P, float* WE, float* ALR, bf16_t* y) {
    __shared__ float s_in[8][288];
    const int row0 = blockIdx.x * 8, tid = threadIdx.x;
    for (int e = tid; e < 8 * 288; e += 256) {
        const int rr = e / 288, j = e % 288, row = row0 + rr, pr = prevrow(row);
        const float cur = pn[(size_t)row * PNW + j], prv = pr >= 0 ? pn[(size_t)pr * PNW + j] : 0.f;
        const float s = cur + P.mu[1536 + j] * (prv - cur);
        s_in[rr][j] = j < 64 ? tanhf(s) : (j < 128 ? s : sigmoidf_(s));
    }
    __syncthreads();
#pragma unroll 1
    for (int cc = 0; cc < 2; ++cc) {
        const int c = tid + 256 * cc;
        float zw[8], za[8], zg[8];
#pragma unroll
        for (int rr = 0; rr < 8; ++rr) { zw[rr] = P.w0[c]; za[rr] = P.a0[c]; zg[rr] = 0.f; }
        for (int j = 0; j < 64; ++j) { const float wu = P.w_up[j * 512 + c], au = P.a_up[j * 512 + c];
#pragma unroll
            for (int rr = 0; rr < 8; ++rr) { zw[rr] += s_in[rr][j] * wu; za[rr] += s_in[rr][64 + j] * au; } }
        for (int j = 0; j < 160; ++j) { const float gu = P.g_up[j * 512 + c];
#pragma unroll
            for (int rr = 0; rr < 8; ++rr) zg[rr] += s_in[rr][128 + j] * gu; }
#pragma unroll
        for (int rr = 0; rr < 8; ++rr) { const size_t o = (size_t)(row0 + rr) * 512 + c;
            WE[o] = 0.6065306597126334f * sigmoidf_(zw[rr]);
            ALR[o] = sigmoidf_(za[rr]);
            y[(size_t)(row0 + rr) * DM + c] = f2bf(zg[rr]); }
    }
}

struct RwS { const float* mu; const float* k_k; const float* k_a; const float* r_k; const float* gn_w; const float* gn_b; };
constexpr int RCH = 8;
__global__ void __launch_bounds__(256) k_rwkv_scan(const bf16_t* p, const float* WE, const float* ALR, RwS P, bf16_t* y) {
    __shared__ __attribute__((aligned(16))) float s_vec[RCH][5][64];
    __shared__ float s_v[RCH][64], s_bonus[RCH], s_y[RCH][64];
    const int b = blockIdx.x >> 3, h = blockIdx.x & 7, tid = threadIdx.x, lane = tid & 63, wave = tid >> 6;
    const int vl = lane >> 2, kq = lane & 3, vrow = wave * 16 + vl;
    float S[16];
#pragma unroll
    for (int i = 0; i < 16; ++i) S[i] = 0.f;
    for (int t0 = 0; t0 < LTOT; t0 += RCH) {
        for (int tt = wave; tt < RCH; tt += 4) {
            const int t = t0 + tt; if (t >= LTOT) break;
            const int row = rowof(b, t), pr = prevrow(row), c = h * 64 + lane;
            const bf16_t* pc = p + (size_t)row * PBW; const bf16_t* pp = p + (size_t)(pr >= 0 ? pr : row) * PBW;
            const float hp = pr >= 0 ? 1.f : 0.f;
            float r = bf2f(pc[c]), k = bf2f(pc[512 + c]), v = bf2f(pc[1024 + c]);
            r += P.mu[c] * (hp * bf2f(pp[c]) - r); k += P.mu[512 + c] * (hp * bf2f(pp[512 + c]) - k); v += P.mu[1024 + c] * (hp * bf2f(pp[1024 + c]) - v);
            const float we = WE[(size_t)row * 512 + c], alr = ALR[(size_t)row * 512 + c];
            float kk = k * P.k_k[c]; const float nrm = sqrtf(wave_sum(kk * kk)); kk = kk / fmaxf(nrm, 1e-12f);
            const float kp = k * (1.f + (alr - 1.f) * P.k_a[c]);
            const float bon = wave_sum(r * kp * P.r_k[c]);
            s_vec[tt][0][lane] = r; s_vec[tt][1][lane] = __expf(-we); s_vec[tt][2][lane] = kp; s_vec[tt][3][lane] = -kk; s_vec[tt][4][lane] = kk * alr;
            s_v[tt][lane] = v; if (lane == 0) s_bonus[tt] = bon;
        }
        __syncthreads();
        const int nt = (LTOT - t0) < RCH ? (LTOT - t0) : RCH;
        for (int tt = 0; tt < nt; ++tt) {
            const f32x4* vr = (const f32x4*)&s_vec[tt][0][16 * kq]; const f32x4* vw = (const f32x4*)&s_vec[tt][1][16 * kq];
            const f32x4* vk = (const f32x4*)&s_vec[tt][2][16 * kq]; const f32x4* va = (const f32x4*)&s_vec[tt][3][16 * kq]; const f32x4* vb = (const f32x4*)&s_vec[tt][4][16 * kq];
            const float vv = s_v[tt][vrow];
            float sa = 0.f;
#pragma unroll
            for (int q = 0; q < 4; ++q) { const f32x4 a4 = va[q]; sa += S[4 * q] * a4.x + S[4 * q + 1] * a4.y + S[4 * q + 2] * a4.z + S[4 * q + 3] * a4.w; }
            sa += __shfl_xor(sa, 1); sa += __shfl_xor(sa, 2);
            float yy = 0.f;
#pragma unroll
            for (int q = 0; q < 4; ++q) { const f32x4 w4 = vw[q], b4 = vb[q], k4 = vk[q], r4 = vr[q];
                S[4 * q] = S[4 * q] * w4.x + sa * b4.x + vv * k4.x; S[4 * q + 1] = S[4 * q + 1] * w4.y + sa * b4.y + vv * k4.y;
                S[4 * q + 2] = S[4 * q + 2] * w4.z + sa * b4.z + vv * k4.z; S[4 * q + 3] = S[4 * q + 3] * w4.w + sa * b4.w + vv * k4.w;
                yy += S[4 * q] * r4.x + S[4 * q + 1] * r4.y + S[4 * q + 2] * r4.z + S[4 * q + 3] * r4.w; }
            yy += __shfl_xor(yy, 1); yy += __shfl_xor(yy, 2);
            if (kq == 0) s_y[tt][vrow] = yy;
        }
        __syncthreads();
        for (int tt = wave; tt < nt; tt += 4) {
            const int t = t0 + tt; const int row = rowof(b, t), c = h * 64 + lane;
            const float yv = s_y[tt][lane];
            const float mean = wave_sum(yv) * (1.f / 64.f); const float d = yv - mean; const float var = wave_sum(d * d) * (1.f / 64.f);
            float o = d * (1.0f / sqrtf(var + 64e-5f)) * P.gn_w[c] + P.gn_b[c];
            o += s_bonus[tt] * s_v[tt][lane];
            if (t >= NMETA || b == 0) { bf16_t* yp = y + (size_t)row * DM + c; *yp = f2bf(o * bf2f(*yp)); }
        }
        __syncthreads();
    }
}

__global__ void __launch_bounds__(256) k_fox_prep(bf16_t* p, const float* pn, const float* b_f, const float* q_g, const float* k_g, float* lf2) {
    const int lane = threadIdx.x & 63, gw = blockIdx.x * 4 + (threadIdx.x >> 6), ngw = gridDim.x * 4;
    for (int it = gw; it < RROWS * NH; it += ngw) {
        const int row = it >> 3, h = it & 7;
        bf16_t* qp = p + (size_t)row * PBW + 1536 + h * 64 + lane; bf16_t* kp = p + (size_t)row * PBW + 2048 + h * 64 + lane;
        const float q = bf2f(*qp), k = bf2f(*kp);
        const float mq = wave_sum(q * q) * (1.f / 64.f), mk = wave_sum(k * k) * (1.f / 64.f);
        *qp = f2bf(q * (1.0f / sqrtf(mq + 1e-6f)) * q_g[lane] * (0.125f * LOG2E));
        *kp = f2bf(k * (1.0f / sqrtf(mk + 1e-6f)) * k_g[lane]);
        if (lane == 0) { const float z = pn[(size_t)row * PNW + 288 + h] + b_f[h];
            lf2[row * 8 + h] = (fminf(z, 0.f) - log1pf(__expf(-fabsf(z)))) * LOG2E; }
    }
}
__global__ void __launch_bounds__(64) k_cumsum(const float* lf2, float* c2) {
    const int b = blockIdx.x >> 3, h = blockIdx.x & 7, lane = threadIdx.x;
    constexpr int PER = 33;
    float loc[PER]; float s = 0.f;
#pragma unroll
    for (int i = 0; i < PER; ++i) { const int t = lane * PER + i; float v = 0.f; if (t < LTOT) v = lf2[rowof(b, t) * 8 + h]; s += v; loc[i] = s; }
    float incl = s;
#pragma unroll
    for (int o = 1; o < 64; o <<= 1) { const float n = __shfl_up(incl, o); if (lane >= o) incl += n; }
    const float base = incl - s;
#pragma unroll
    for (int i = 0; i < PER; ++i) { const int t = lane * PER + i; if (t < LTOT) c2[(size_t)(b * 8 + h) * LTOT + t] = base + loc[i]; }
}
__global__ void __launch_bounds__(256) k_fox_attn(const bf16_t* p, const float* c2, bf16_t* y) {
    __shared__ float s_q[4][64];
    __shared__ float s_s[4][LTOT];
    const int lane = threadIdx.x & 63, wave = threadIdx.x >> 6;
    const int gid = blockIdx.x * 4 + wave;
    const int t = gid % LTOT, bh = gid / LTOT, b = bh >> 3, h = bh & 7;
    if (bh >= 64) return;
    if (t < NMETA && b != 0) return;
    const int row = rowof(b, t);
    s_q[wave][lane] = bf2f(p[(size_t)row * PBW + 1536 + h * 64 + lane]);
    __builtin_amdgcn_s_waitcnt(0xc07f); __builtin_amdgcn_wave_barrier();
    const float* cc = c2 + (size_t)bh * LTOT;
    float m = -INFINITY;
    for (int j0 = 0; j0 <= t; j0 += 64) {
        const int j = j0 + lane;
        if (j <= t) {
            const bf16_t* kr = p + (size_t)rowof(b, j) * PBW + 2048 + h * 64;
            float d = 0.f;
#pragma unroll
            for (int c8 = 0; c8 < 8; ++c8) { const bf16x8 kv = *(const bf16x8*)(kr + 8 * c8);
#pragma unroll
                for (int e = 0; e < 8; ++e) d += s_q[wave][8 * c8 + e] * bf2f((bf16_t)kv[e]); }
            const float s = d - cc[j];
            s_s[wave][j] = s; m = fmaxf(m, s);
        }
    }
    m = wave_max(m);
    float sum = 0.f;
    for (int j0 = 0; j0 <= t; j0 += 64) { const int j = j0 + lane; if (j <= t) { const float e = exp2f(s_s[wave][j] - m); s_s[wave][j] = e; sum += e; } }
    sum = wave_sum(sum);
    __builtin_amdgcn_s_waitcnt(0xc07f); __builtin_amdgcn_wave_barrier();
    float o = 0.f;
    for (int j = 0; j <= t; ++j) o += s_s[wave][j] * bf2f(p[(size_t)rowof(b, j) * PBW + 2560 + h * 64 + lane]);
    o /= sum;
    const float og = bf2f(p[(size_t)row * PBW + 3072 + h * 64 + lane]);
    y[(size_t)row * DM + 512 + h * 64 + lane] = f2bf(o * sigmoidf_(og));
}

__global__ void __launch_bounds__(256) k_conv(const bf16_t* raw, int ldr, int tile0, int ntile, const float* cw, const float* cb, bf16_t* act) {
    const int per_row = ntile * 128;
    const size_t total = (size_t)RROWS * per_row;
    for (size_t e = blockIdx.x * (size_t)blockDim.x + threadIdx.x; e < total; e += (size_t)gridDim.x * blockDim.x) {
        const int row = (int)(e / per_row), jj = (int)(e % per_row), tl = jj >> 7, c = jj & 127;
        const int ch = 128 * (tile0 + tl) + c;
        const int p1 = prevrow(row), p2 = p1 >= 0 ? prevrow(p1) : -1;
        const int cu = tl * 256 + c, cg = cu + 128;
        float u = cb[ch] + cw[2 * DFF2 + ch] * bf2f(raw[(size_t)row * ldr + cu]);
        float g = cb[DFF + ch] + cw[2 * DFF2 + DFF + ch] * bf2f(raw[(size_t)row * ldr + cg]);
        if (p1 >= 0) { u += cw[DFF2 + ch] * bf2f(raw[(size_t)p1 * ldr + cu]); g += cw[DFF2 + DFF + ch] * bf2f(raw[(size_t)p1 * ldr + cg]); }
        if (p2 >= 0) { u += cw[ch] * bf2f(raw[(size_t)p2 * ldr + cu]); g += cw[DFF + ch] * bf2f(raw[(size_t)p2 * ldr + cg]); }
        act[(size_t)row * DFF + ch] = f2bf(g * sigmoidf_(g) * u);
    }
}

extern "C" void kernel_launch(void* const* d_in, const int* in_sizes, int n_in, void* d_out, int out_size, void* d_ws, size_t ws_size, hipStream_t stream) {
    const float* x = (const float*)d_in[0]; const float* meta = (const float*)d_in[1];
    const float* norm1_g = (const float*)d_in[2]; const float* w_in = (const float*)d_in[3];
    const float* rw_mu = (const float*)d_in[4]; const float* rw_w0 = (const float*)d_in[5]; const float* rw_w_up = (const float*)d_in[6];
    const float* rw_a0 = (const float*)d_in[7]; const float* rw_a_up = (const float*)d_in[8]; const float* rw_g_up = (const float*)d_in[9];
    const float* rw_k_k = (const float*)d_in[10]; const float* rw_k_a = (const float*)d_in[11]; const float* rw_r_k = (const float*)d_in[12];
    const float* rw_gn_w = (const float*)d_in[13]; const float* rw_gn_b = (const float*)d_in[14];
    const float* fx_b_f = (const float*)d_in[15]; const float* fx_q_g = (const float*)d_in[16]; const float* fx_k_g = (const float*)d_in[17];
    const float* w_o = (const float*)d_in[18]; const float* norm2_g = (const float*)d_in[19]; const float* ffn_w_in = (const float*)d_in[20];
    const float* ffn_conv_w = (const float*)d_in[21]; const float* ffn_conv_b = (const float*)d_in[22]; const float* ffn_w_out = (const float*)d_in[23];
    unsigned char* ws = (unsigned char*)d_ws; float* out = (float*)d_out;
    float* hm = (float*)(ws + WS_HM); float* rstd = (float*)(ws + WS_RSTD); float* c2 = (float*)(ws + WS_C2); float* lf2 = (float*)(ws + WS_LF2);
    bf16_t* hb = (bf16_t*)(ws + WS_HB); bf16_t* p = (bf16_t*)(ws + WS_P); float* pn = (float*)(ws + WS_PN); bf16_t* y = (bf16_t*)(ws + WS_Y);
    float* WE = (float*)(ws + WS_WE); float* ALR = (float*)(ws + WS_ALR); bf16_t* act = (bf16_t*)(ws + WS_ACT); bf16_t* raw = (bf16_t*)(ws + WS_RAW);

    WPrepArgs wa{w_in, w_o, ffn_w_in, ffn_w_out, norm1_g, norm2_g, ws};
    hipLaunchKernelGGL(k_wprep, dim3(2048), dim3(256), 0, stream, wa);
    hipLaunchKernelGGL(k_init, dim3(2048), dim3(256), 0, stream, x, meta, out, hm);
    const int MT = (RROWS + 127) / 128;
    for (int l = 0; l < DEPTH; ++l) {
        const bf16_t* W1 = (const bf16_t*)(ws + WS_W1) + (size_t)l * N1 * DM; const bf16_t* W2 = (const bf16_t*)(ws + WS_W2) + (size_t)l * DM * DM;
        const bf16_t* W3 = (const bf16_t*)(ws + WS_W3) + (size_t)l * DFF2 * DM; const bf16_t* W4 = (const bf16_t*)(ws + WS_W4) + (size_t)l * DM * DFF;
        hipLaunchKernelGGL(k_norm, dim3(1024), dim3(256), 0, stream, out, hm, hb, rstd);
        hipLaunchKernelGGL((k_gemm<Epi1>), dim3(MT * (N1 / 128)), dim3(256), 0, stream, (const bf16_t*)hb, W1, RROWS, N1, DM, Epi1{rstd, p, pn});
        RwP rp{rw_mu + l * 1824, rw_w0 + l * 512, rw_w_up + (size_t)l * 64 * 512, rw_a0 + l * 512, rw_a_up + (size_t)l * 64 * 512, rw_g_up + (size_t)l * 160 * 512};
        hipLaunchKernelGGL(k_rwkv_prep, dim3(RROWS / 8), dim3(256), 0, stream, (const float*)pn, rp, WE, ALR, y);
        hipLaunchKernelGGL(k_fox_prep, dim3(2048), dim3(256), 0, stream, p, (const float*)pn, fx_b_f + l * 8, fx_q_g + l * 64, fx_k_g + l * 64, lf2);
        hipLaunchKernelGGL(k_cumsum, dim3(64), dim3(64), 0, stream, (const float*)lf2, c2);
        RwS rs{rw_mu + l * 1824, rw_k_k + l * 512, rw_k_a + l * 512, rw_r_k + l * 512, rw_gn_w + l * 512, rw_gn_b + l * 512};
        hipLaunchKernelGGL(k_rwkv_scan, dim3(64), dim3(256), 0, stream, (const bf16_t*)p, (const float*)WE, (const float*)ALR, rs, y);
        hipLaunchKernelGGL(k_fox_attn, dim3(64 * LTOT / 4), dim3(256), 0, stream, (const bf16_t*)p, (const float*)c2, y);
        hipLaunchKernelGGL((k_gemm<EpiRes>), dim3(MT * (DM / 128)), dim3(256), 0, stream, (const bf16_t*)y, W2, RROWS, DM, DM, EpiRes{out, hm});
        hipLaunchKernelGGL(k_norm, dim3(1024), dim3(256), 0, stream, out, hm, hb, rstd);
        for (int t0 = 0; t0 < 22; t0 += 6) {
            const int nt = (22 - t0) < 6 ? (22 - t0) : 6;
            hipLaunchKernelGGL((k_gemm<Epi3>), dim3(MT * (nt * 2)), dim3(256), 0, stream, (const bf16_t*)hb, W3 + (size_t)t0 * 256 * DM, RROWS, nt * 256, DM, Epi3{rstd, raw, nt * 256});
            hipLaunchKernelGGL(k_conv, dim3(2048), dim3(256), 0, stream, (const bf16_t*)raw, nt * 256, t0, nt, ffn_conv_w + (size_t)l * 3 * DFF2, ffn_conv_b + (size_t)l * DFF2, act);
        }
        hipLaunchKernelGGL((k_gemm<EpiRes>), dim3(MT * (DM / 128)), dim3(256), 0, stream, (const bf16_t*)act, W4, RROWS, DM, DFF, EpiRes{out, hm});
    }
}
```

```cpp
#include <hip/hip_runtime.h>
#include <hip/hip_cooperative_groups.h>
#include <stdint.h>
#include <cstdio>
namespace cg = cooperative_groups;

typedef unsigned short bf16_t;
typedef short bf16x8 __attribute__((ext_vector_type(8)));
typedef float f32x4 __attribute__((ext_vector_type(4)));
typedef unsigned u32x4 __attribute__((ext_vector_type(4)));
typedef unsigned u32x2 __attribute__((ext_vector_type(2)));

constexpr int NB = 8, SEQ = 2048, NMETA = 16, LTOT = 2064, DM = 1024, DEPTH = 4, NH = 8, HD = 64;
constexpr int N_IN = 3880, DFF = 2816, DFF2 = 5632;
constexpr int MROWS = NB * SEQ;
constexpr int RROWS = MROWS + NMETA;
constexpr int N1 = 4096;
constexpr int PBW = 3584;
constexpr int PNW = 320;
constexpr float LOG2E = 1.4426950408889634f;

constexpr size_t MiB = 1u << 20;
constexpr size_t WS_CTL = 0, CTL_ZERO_BYTES = 1 * MiB;
constexpr size_t WS_W1 = 1 * MiB;
constexpr size_t WS_W2 = WS_W1 + 32 * MiB;
constexpr size_t WS_W3 = WS_W2 + 8 * MiB;
constexpr size_t WS_W4 = WS_W3 + 44 * MiB;
constexpr size_t WS_SMALL = WS_W4 + 22 * MiB;
constexpr size_t WS_HM = WS_SMALL;
constexpr size_t WS_C2 = WS_SMALL + 1 * MiB;
constexpr size_t WS_SSQ = WS_SMALL + 3 * MiB;
constexpr size_t WS_HB = WS_SMALL + 6 * MiB;
constexpr size_t WS_P = WS_HB + 33 * MiB;
constexpr size_t WS_PN = WS_P + 113 * MiB;
constexpr size_t WS_Y = WS_PN + 21 * MiB;
constexpr size_t WS_FREE = WS_Y + 33 * MiB;
constexpr size_t WS_WE = WS_HB;
constexpr size_t WS_ALR = WS_FREE;
constexpr size_t WS_ACT = WS_P;
constexpr size_t WS_RAW = WS_PN;
constexpr size_t WS_END = WS_ALR + 33 * MiB;

__device__ __forceinline__ float bf2f(bf16_t v) { return __uint_as_float(((unsigned)v) << 16); }
__device__ __forceinline__ bf16_t f2bf(float f) { unsigned u = __float_as_uint(f); return (bf16_t)((u + 0x7fffu + ((u >> 16) & 1u)) >> 16); }
__device__ __forceinline__ unsigned pk2bf(float lo, float hi) { return (unsigned)f2bf(lo) | ((unsigned)f2bf(hi) << 16); }
__device__ __forceinline__ float sigmoidf_(float x) { return 1.f / (1.f + __expf(-x)); }
__device__ __forceinline__ float wave_sum(float v) {
#pragma unroll
    for (int o = 1; o < 64; o <<= 1) v += __shfl_xor(v, o);
    return v;
}
__device__ __forceinline__ float wave_max(float v) {
#pragma unroll
    for (int o = 1; o < 64; o <<= 1) v = fmaxf(v, __shfl_xor(v, o));
    return v;
}
#define WAVE_LDS_SYNC() do { __builtin_amdgcn_s_waitcnt(0xc07f); __builtin_amdgcn_wave_barrier(); } while (0)
__device__ __forceinline__ int rowof(int b, int t) { return t < NMETA ? MROWS + t : b * SEQ + (t - NMETA); }
__device__ __forceinline__ int prevrow(int row) {
    if (row >= MROWS) return row == MROWS ? -1 : row - 1;
    return (row & (SEQ - 1)) ? row - 1 : MROWS + NMETA - 1;
}

__device__ __forceinline__ int src_col(int mode, int n) {
    if (mode == 1) {
        const int g = n >> 9, o = n & 511;
        switch (g) {
            case 0: return o;
            case 1: return 512 + o;
            case 2: return 1024 + o;
            case 3: return 1824 + o;
            case 4: return 2336 + o;
            case 5: return 2848 + o;
            case 6: return 3360 + o;
            default:
                if (o < 64) return 1536 + o;
                if (o < 128) return 1600 + (o - 64);
                if (o < 288) return 1664 + (o - 128);
                if (o < 296) return 3872 + (o - 288);
                return -1;
        }
    }
    if (mode == 3) { const int t = n >> 8, c = n & 255; return c < 128 ? 128 * t + c : DFF + 128 * t + (c - 128); }
    return n;
}
__device__ __forceinline__ void wprep_item(const float* W, const float* gk, bf16_t* WT, int K, int Nsrc, int Ndst, int mode, int item, float* scr, int lane) {
    const int nblk = Ndst / 32, kb = item / nblk, nb = item % nblk, k0 = 64 * kb, n0 = 32 * nb;
    const int sc = src_col(mode, n0 + (lane & 31));
#pragma unroll 8
    for (int i = 0; i < 32; ++i) {
        const int kk = 2 * i + (lane >> 5);
        float v = 0.f;
        if (sc >= 0) { v = W[(size_t)(k0 + kk) * Nsrc + sc]; if (gk) v *= gk[k0 + kk]; }
        scr[kk * 33 + (lane & 31)] = v;
    }
    WAVE_LDS_SYNC();
    const int c = lane & 7;
#pragma unroll
    for (int j = 0; j < 4; ++j) {
        const int n = (lane >> 3) + 8 * j; const float* s = scr + (8 * c) * 33 + n;
        u32x4 o;
        o.x = pk2bf(s[0 * 33], s[1 * 33]); o.y = pk2bf(s[2 * 33], s[3 * 33]); o.z = pk2bf(s[4 * 33], s[5 * 33]); o.w = pk2bf(s[6 * 33], s[7 * 33]);
        *(u32x4*)(WT + (size_t)(n0 + n) * K + k0 + 8 * c) = o;
    }
    WAVE_LDS_SYNC();
}
namespace pg8 {
#define PG8_LAS __attribute__((address_space(3)))
typedef unsigned short bf16_t;
typedef short bf16x8 __attribute__((ext_vector_type(8)));
typedef float f32x4 __attribute__((ext_vector_type(4)));
typedef unsigned u32x4 __attribute__((ext_vector_type(4)));
constexpr int BM = 256, BK = 64, HALF = 128, HTB = HALF * BK * 2  , STAGE_BYTES = 8 * HTB, NXCD = 8, WGM = 8;

__host__ __device__ __forceinline__ int lds_byte(int r, int c) { const int st = (r >> 4) * 2 + (c >> 5), rr = r & 15, cc = c & 31, ob = rr * 64 + cc * 2; return st * 1024 + (ob ^ (((ob >> 9) & 1) << 5)); }
__host__ __device__ __forceinline__ void stage_rc(int b, int& R, int& C) { const int st = b / 1024, sb = b % 1024, swz = sb ^ (((sb >> 9) & 1) << 5); R = (st >> 1) * 16 + swz / 64; C = (st & 1) * 32 + (swz % 64) / 2; }
__host__ __device__ __forceinline__ int perm32(int rho) { const int n = rho >> 4, i = rho & 15; return 8 * (i >> 2) + 4 * n + (i & 3); }

struct Unit { int pm, pn; };
struct Gemm { const bf16_t* A; const bf16_t* Bt; int M, N, K; };

struct StaticOrder {
    int nM, nN, nwg, G, c;
    __host__ __device__ void init(int M, int N, int G_, int c_) { nM = M / BM; nN = N / BM; nwg = nM * nN; G = G_; c = c_; }
    __host__ __device__ bool next(int i, Unit& u) const {
        const long L = (long)i * G + c; if (L >= nwg) return false;
        int wgid = (int)L; { const int q = nwg / NXCD, r = nwg % NXCD, xcd = wgid % NXCD, off = wgid / NXCD; wgid = (xcd < r ? xcd * (q + 1) : r * (q + 1) + (xcd - r) * q) + off; }
        const int nig = WGM * nN, gid = wgid / nig, fm = gid * WGM, gsz = (nM - fm) < WGM ? (nM - fm) : WGM;
        u.pm = fm + ((wgid % nig) % gsz); u.pn = (wgid % nig) / gsz; return true;
    }
    __device__ __forceinline__ void a_ready(const Unit&) const {}
    __device__ __forceinline__ void done(const Unit&) const {}
};

__device__ __forceinline__ float row_rstd(const float* ssqp, int row) {
    const f32x4* sp = (const f32x4*)(ssqp + (size_t)row * 16);
    const f32x4 a = sp[0], b = sp[1], c = sp[2], d = sp[3];
    const float s = (((a.x + a.y) + (a.z + a.w)) + ((b.x + b.y) + (b.z + b.w))) + (((c.x + c.y) + (c.z + c.w)) + ((d.x + d.y) + (d.z + d.w)));
    return 1.0f / sqrtf(s * (1.f / 1024.f) + 1e-6f);
}
struct Epi1 {
    static constexpr bool PERM = false, AFTER_DRAIN = false;
    const float* ssqp; bf16_t* p; float* pn;
    __device__ __forceinline__ void operator()(const f32x4 (&acc)[2][2][4][2], const Unit& u, int wr, int wc, int fr, int fq) const {
        const int row0 = u.pm * BM + wr * 64 + fr, col0 = u.pn * BM + wc * 32 + 4 * fq;
#pragma unroll
        for (int ai = 0; ai < 2; ++ai)
#pragma unroll
            for (int m = 0; m < 4; ++m) {
                const int row = row0 + ai * HALF + m * 16; const float rs = row_rstd(ssqp, row);
#pragma unroll
                for (int bj = 0; bj < 2; ++bj)
#pragma unroll
                    for (int n = 0; n < 2; ++n) {
                        const f32x4 v = acc[ai][bj][m][n] * rs; const int col = col0 + bj * HALF + n * 16;
                        if (u.pn < 14) { u32x2 w; w.x = pk2bf(v[0], v[1]); w.y = pk2bf(v[2], v[3]); *(u32x2*)(p + (size_t)row * PBW + col) = w; }
                        else { const int o = col - PBW; if (o < 296) *(f32x4*)(pn + (size_t)row * PNW + o) = v; }
                    }
            }
    }
};
struct EpiRes {
    static constexpr bool PERM = false, AFTER_DRAIN = false;
    float* h; bf16_t* hb; float* ssqp;
    __device__ __forceinline__ void operator()(const f32x4 (&acc)[2][2][4][2], const Unit& u, int wr, int wc, int fr, int fq) const {
        const int row0 = u.pm * BM + wr * 64 + fr, col0 = u.pn * BM + wc * 32 + 4 * fq;
#pragma unroll
        for (int ai = 0; ai < 2; ++ai)
#pragma unroll
            for (int m = 0; m < 4; ++m) {
                const int row = row0 + ai * HALF + m * 16; float ss = 0.f;
#pragma unroll
                for (int bj = 0; bj < 2; ++bj)
#pragma unroll
                    for (int n = 0; n < 2; ++n) {
                        const int col = col0 + bj * HALF + n * 16; float* hp = h + (size_t)row * DM + col;
                        const f32x4 v = *(const f32x4*)hp + acc[ai][bj][m][n];
                        *(f32x4*)hp = v; u32x2 w; w.x = pk2bf(v[0], v[1]); w.y = pk2bf(v[2], v[3]); *(u32x2*)(hb + (size_t)row * DM + col) = w;
                        ss += (v[0] * v[0] + v[1] * v[1]) + (v[2] * v[2] + v[3] * v[3]);
                    }
                ss += __shfl_xor(ss, 16); ss += __shfl_xor(ss, 32);
                if (fq == 0) ssqp[(size_t)row * 16 + u.pn * 4 + wc] = ss;
            }
    }
};
struct Epi3Raw {
    static constexpr bool PERM = false, AFTER_DRAIN = false;
    const float* ssqp; bf16_t* raw; int ldr;
    __device__ __forceinline__ void operator()(const f32x4 (&acc)[2][2][4][2], const Unit& u, int wr, int wc, int fr, int fq) const {
        const int row0 = u.pm * BM + wr * 64 + fr, col0 = u.pn * BM + wc * 32 + 4 * fq;
#pragma unroll
        for (int ai = 0; ai < 2; ++ai)
#pragma unroll
            for (int m = 0; m < 4; ++m) {
                const int row = row0 + ai * HALF + m * 16; const float rs = row_rstd(ssqp, row);
#pragma unroll
                for (int bj = 0; bj < 2; ++bj)
#pragma unroll
                    for (int n = 0; n < 2; ++n) {
                        const f32x4 v = acc[ai][bj][m][n] * rs; const int col = col0 + bj * HALF + n * 16;
                        u32x2 w; w.x = pk2bf(v[0], v[1]); w.y = pk2bf(v[2], v[3]); *(u32x2*)(raw + (size_t)row * ldr + col) = w;
                    }
            }
    }
};

template <class Epi, class Sched, bool ALIGN_EPI = false, bool SP2 = false>
__device__ __forceinline__ void gemm_phase(PG8_LAS unsigned char* lds, const Gemm g, const Sched& S, const Epi& E) {
    int tid_ = threadIdx.x; asm volatile("" : "+v"(tid_));
    const int tid = tid_, wid = __builtin_amdgcn_readfirstlane(tid >> 6), lane = tid & 63, wr = wid >> 2, wc = wid & 3, fr = lane & 15, fq = lane >> 4;
    const int K = g.K, nt = K / BK;
    unsigned voffA[2], voffB[2];
#pragma unroll
    for (int i = 0; i < 2; ++i) { int R, C; stage_rc(tid * 16 + i * 8192, R, C); const int Rb = Epi::PERM ? ((R & ~31) + perm32(R & 31)) : R;
        voffA[i] = (unsigned)(R * K + C) * 2u; voffB[i] = (unsigned)(Rb * K + C) * 2u; }
    const size_t kstep = (size_t)(BK * 2);
    const size_t hstep = (size_t)HALF * K * 2;
    const size_t tstep = 2 * hstep;
    const unsigned ldsw = (unsigned)wid * 1024u;
    const int aoff = lds_byte(wr * 64 + fr, fq * 8), boff = lds_byte(wc * 32 + fr, fq * 8);
#define PG8_SA(b, h) (((b) * 2 + (h)) * HTB)
#define PG8_SB(b, h) ((4 + (b) * 2 + (h)) * HTB)
#define PG8_STAGE(bufoff, gbase, voff) do { _Pragma("unroll") for (int _i = 0; _i < 2; ++_i) \
        __builtin_amdgcn_global_load_lds((const unsigned*)((const char*)(gbase) + (voff)[_i]), (PG8_LAS unsigned*)(lds + (bufoff) + ldsw + _i * 8192), 16, 0, 0); } while (0)
#define PG8_LDA(dst, b, h) do { _Pragma("unroll") for (int m = 0; m < 4; ++m) _Pragma("unroll") for (int k = 0; k < 2; ++k) dst[m][k] = *(const PG8_LAS bf16x8*)(lds + PG8_SA(b, h) + aoff + m * 2048 + k * 1024); } while (0)
#define PG8_LDB(dst, b, h) do { _Pragma("unroll") for (int n = 0; n < 2; ++n) _Pragma("unroll") for (int k = 0; k < 2; ++k) dst[n][k] = *(const PG8_LAS bf16x8*)(lds + PG8_SB(b, h) + boff + n * 2048 + k * 1024); } while (0)
#define PG8_MMA(ai, bj, At, Bt) do { __builtin_amdgcn_s_setprio(1); _Pragma("unroll") for (int m = 0; m < 4; ++m) _Pragma("unroll") for (int n = 0; n < 2; ++n) _Pragma("unroll") for (int k = 0; k < 2; ++k) \
        acc[ai][bj][m][n] = __builtin_amdgcn_mfma_f32_16x16x32_bf16(Bt[n][k], At[m][k], acc[ai][bj][m][n], 0, 0, 0); __builtin_amdgcn_s_setprio(0); } while (0)
#define PG8_WAIT_V(n) asm volatile("s_waitcnt vmcnt(" #n ")" ::: "memory")
#define PG8_WAIT_L(n) asm volatile("s_waitcnt lgkmcnt(" #n ")" ::: "memory")
#define PG8_BAR __builtin_amdgcn_s_barrier()
#define PG8_SCHED __builtin_amdgcn_sched_barrier(0)
    Unit cur, nxt; int ui = 0;
    if (!S.next(0, cur)) return;
    f32x4 acc[2][2][4][2];
#pragma unroll
    for (int a = 0; a < 2; ++a)
#pragma unroll
        for (int b = 0; b < 2; ++b)
#pragma unroll
            for (int m = 0; m < 4; ++m)
#pragma unroll
                for (int n = 0; n < 2; ++n) acc[a][b][m][n] = (f32x4){0.f, 0.f, 0.f, 0.f};
    bf16x8 At[4][2], B0[2][2], B1[2][2];
    const char* cA = (const char*)g.A + (size_t)cur.pm * tstep; const char* cB = (const char*)g.Bt + (size_t)cur.pn * tstep;
    S.a_ready(cur);
    if constexpr (SP2) {
        PG8_STAGE(PG8_SB(0, 0), cB, voffB); PG8_STAGE(PG8_SB(0, 1), cB + hstep, voffB); PG8_STAGE(PG8_SA(0, 0), cA, voffA); PG8_STAGE(PG8_SA(0, 1), cA + hstep, voffA);
        if (wr == 1) PG8_BAR;
        PG8_WAIT_V(2); PG8_BAR;
        PG8_STAGE(PG8_SB(1, 0), cB + kstep, voffB); PG8_STAGE(PG8_SA(1, 0), cA + kstep, voffA); PG8_STAGE(PG8_SB(1, 1), cB + hstep + kstep, voffB);
        PG8_WAIT_V(6); PG8_BAR;
    } else {
        PG8_STAGE(PG8_SB(0, 0), cB, voffB); PG8_STAGE(PG8_SA(0, 0), cA, voffA); PG8_STAGE(PG8_SB(0, 1), cB + hstep, voffB); PG8_STAGE(PG8_SA(0, 1), cA + hstep, voffA);
        if (wr == 1) PG8_BAR;
        PG8_WAIT_V(4); PG8_BAR;
        PG8_STAGE(PG8_SB(1, 0), cB + kstep, voffB); PG8_STAGE(PG8_SA(1, 0), cA + kstep, voffA); PG8_STAGE(PG8_SB(1, 1), cB + hstep + kstep, voffB);
        PG8_WAIT_V(6); PG8_BAR;
    }
    for (;;) {
        const bool has_next = S.next(ui + 1, nxt);
        const char* nA = has_next ? (const char*)g.A + (size_t)nxt.pm * tstep : cA; const char* nB = has_next ? (const char*)g.Bt + (size_t)nxt.pn * tstep : cB;
        for (int t = 0; t < nt; t += 2) {
            const bool last = (t == nt - 2);
            const char* a1 = cA + (size_t)(t + 1) * kstep;
            const char* a2 = last ? nA : cA + (size_t)(t + 2) * kstep; const char* b2 = last ? nB : cB + (size_t)(t + 2) * kstep;
            const char* a3 = a2 + kstep; const char* b3 = b2 + kstep;
            if (last && has_next) S.a_ready(nxt);
            if constexpr (SP2) {
            PG8_LDB(B0, 0, 0); PG8_LDB(B1, 0, 1); PG8_SCHED; PG8_LDA(At, 0, 0); PG8_STAGE(PG8_SA(1, 1), a1 + hstep, voffA);
            PG8_WAIT_V(8); PG8_WAIT_L(0); PG8_BAR; PG8_MMA(0, 0, At, B0); PG8_MMA(0, 1, At, B1); PG8_BAR; PG8_SCHED;
            PG8_LDA(At, 0, 1); PG8_STAGE(PG8_SB(0, 0), b2, voffB); PG8_STAGE(PG8_SB(0, 1), b2 + hstep, voffB); PG8_STAGE(PG8_SA(0, 0), a2, voffA);
            PG8_WAIT_V(8); PG8_WAIT_L(0); PG8_BAR; PG8_MMA(1, 0, At, B0); PG8_MMA(1, 1, At, B1); PG8_BAR; PG8_SCHED;
            PG8_LDB(B0, 1, 0); PG8_LDB(B1, 1, 1); PG8_SCHED; PG8_LDA(At, 1, 0); PG8_STAGE(PG8_SA(0, 1), a2 + hstep, voffA);
            PG8_WAIT_V(8); PG8_WAIT_L(0); PG8_BAR; PG8_MMA(0, 0, At, B0); PG8_MMA(0, 1, At, B1); PG8_BAR; PG8_SCHED;
            PG8_LDA(At, 1, 1); PG8_STAGE(PG8_SB(1, 0), b3, voffB); PG8_STAGE(PG8_SB(1, 1), b3 + hstep, voffB); PG8_STAGE(PG8_SA(1, 0), a3, voffA);
            PG8_WAIT_V(8); PG8_WAIT_L(0); PG8_BAR; PG8_MMA(1, 0, At, B0); PG8_MMA(1, 1, At, B1); PG8_BAR; PG8_SCHED;
            } else {
            PG8_LDB(B0, 0, 0); PG8_SCHED; PG8_LDA(At, 0, 0); PG8_STAGE(PG8_SA(1, 1), a1 + hstep, voffA);
            PG8_WAIT_L(8); PG8_BAR; PG8_WAIT_L(0); PG8_MMA(0, 0, At, B0); PG8_BAR; PG8_SCHED;
            PG8_LDB(B1, 0, 1); PG8_STAGE(PG8_SB(0, 0), b2, voffB);
            PG8_BAR; PG8_WAIT_L(0); PG8_MMA(0, 1, At, B1); PG8_BAR;
            PG8_LDA(At, 0, 1); PG8_STAGE(PG8_SA(0, 0), a2, voffA);
            PG8_BAR; PG8_WAIT_L(0); PG8_MMA(1, 0, At, B0); PG8_BAR; PG8_SCHED;
            PG8_STAGE(PG8_SB(0, 1), b2 + hstep, voffB);
            PG8_WAIT_V(6); PG8_BAR; PG8_MMA(1, 1, At, B1); PG8_BAR;
            PG8_LDB(B0, 1, 0); PG8_SCHED; PG8_LDA(At, 1, 0); PG8_STAGE(PG8_SA(0, 1), a2 + hstep, voffA);
            PG8_WAIT_L(8); PG8_BAR; PG8_WAIT_L(0); PG8_MMA(0, 0, At, B0); PG8_BAR; PG8_SCHED;
            PG8_LDB(B1, 1, 1); PG8_STAGE(PG8_SB(1, 0), b3, voffB);
            PG8_BAR; PG8_WAIT_L(0); PG8_MMA(0, 1, At, B1); PG8_BAR;
            PG8_LDA(At, 1, 1); PG8_STAGE(PG8_SA(1, 0), a3, voffA);
            PG8_BAR; PG8_WAIT_L(0); PG8_MMA(1, 0, At, B0); PG8_BAR; PG8_SCHED;
            PG8_STAGE(PG8_SB(1, 1), b3 + hstep, voffB);
            PG8_WAIT_V(6); PG8_BAR; PG8_MMA(1, 1, At, B1); PG8_BAR;
            }
        }
        if constexpr (ALIGN_EPI) { if (wr == 0) PG8_BAR; }
        if constexpr (!Epi::AFTER_DRAIN) { E(acc, cur, wr, wc, fr, fq); S.done(cur); }
        if (!has_next) break;
#pragma unroll
        for (int a = 0; a < 2; ++a)
#pragma unroll
            for (int b = 0; b < 2; ++b)
#pragma unroll
                for (int m = 0; m < 4; ++m)
#pragma unroll
                    for (int n = 0; n < 2; ++n) acc[a][b][m][n] = (f32x4){0.f, 0.f, 0.f, 0.f};
        cur = nxt; cA = nA; cB = nB; ++ui;
        if constexpr (ALIGN_EPI) { if (wr == 1) PG8_BAR; }
    }
    PG8_WAIT_V(0);
    if constexpr (!ALIGN_EPI) { if (wr == 0) PG8_BAR; }
    PG8_BAR;
    if constexpr (Epi::AFTER_DRAIN) { E.fused(acc, cur, wr, wc, fr, fq, lds, wid, lane); S.done(cur); }
#undef PG8_SA
#undef PG8_SB
#undef PG8_STAGE
#undef PG8_LDA
#undef PG8_LDB
#undef PG8_MMA
#undef PG8_WAIT_V
#undef PG8_WAIT_L
#undef PG8_BAR
#undef PG8_SCHED
}
}
#define GAS __attribute__((address_space(1)))
#define LAS __attribute__((address_space(3)))
typedef unsigned short bf16;
typedef unsigned v4u __attribute__((ext_vector_type(4)));
typedef float f32x4 __attribute__((ext_vector_type(4)));
typedef short bf16x8 __attribute__((ext_vector_type(8)));
typedef GAS unsigned gu32;
typedef GAS unsigned long long gu64;
#define RLX_AGENT __ATOMIC_RELAXED, __HIP_MEMORY_SCOPE_AGENT
#define LDS_WAIT() asm volatile("s_waitcnt lgkmcnt(0)" ::: "memory")
#define VM_WAIT() asm volatile("s_waitcnt vmcnt(0)" ::: "memory")
#define XB_TMO      128
#define XB_XCNT(j)  (256  + 64 * (j))
#define XB_XSUB(j)  (1280 + 64 * (j))
#define XB_XGEN(j)  (2304 + 64 * (j))
#define XB_TOP      3328
#define XB_TOPGEN   3392
#define XCD_BAR_WORDS 3456
#define XB_SPIN_CAP (1u << 18)

__device__ __forceinline__ unsigned xb_ld(unsigned* p)              { return __hip_atomic_load(p, __ATOMIC_RELAXED, __HIP_MEMORY_SCOPE_AGENT); }
__device__ __forceinline__ unsigned xb_add(unsigned* p, unsigned v) { return __hip_atomic_fetch_add(p, v, __ATOMIC_RELAXED, __HIP_MEMORY_SCOPE_AGENT); }
__device__ __forceinline__ unsigned xb_xcc_id() { return (unsigned)__builtin_amdgcn_s_getreg((3 << 11) | 20) & 0xFu; }
#define XB_SPIN(cond, bar) do { unsigned _sp = 0; while (cond) { __builtin_amdgcn_s_sleep(1); \
    if ((++_sp & 255u) == 0u) { if (xb_ld(&(bar)[XB_TMO])) break; if (_sp > XB_SPIN_CAP) { atomicAdd(&(bar)[XB_TMO], 1u); break; } } } } while (0)

struct XcdBarrier {
    unsigned* bar; unsigned x;
    volatile LAS unsigned* st;
};

__device__ __forceinline__ XcdBarrier xcd_barrier_post(unsigned* bar, volatile LAS unsigned* st) {
    XcdBarrier b; b.bar = bar; b.x = xb_xcc_id(); b.st = st;
    if (threadIdx.x == 0) (void)xb_add(&bar[XB_XCNT(b.x)], 1u);
    return b;
}
__device__ __forceinline__ void xcd_barrier_complete(unsigned* bar, unsigned x, unsigned& nloc, unsigned& nx) {
    const unsigned G = gridDim.x * gridDim.y * gridDim.z;
    unsigned sum, cnt, mine, sp = 0u;
    for (;;) {
        sum = 0u; cnt = 0u; mine = 0u;
#pragma unroll
        for (unsigned j = 0; j < 16; ++j) { const unsigned c = xb_ld(&bar[XB_XCNT(j)]); sum += c; cnt += (c > 0u) ? 1u : 0u; mine = (j == x) ? c : mine; }
        if (sum == G) break;
        __builtin_amdgcn_s_sleep(1);
        if ((++sp & 255u) == 0u) { if (xb_ld(&bar[XB_TMO])) break; if (sp > XB_SPIN_CAP) { atomicAdd(&bar[XB_TMO], 1u); break; } }
    }
    nloc = mine > 0u ? mine : 1u; nx = cnt > 0u ? cnt : 1u;
}

__device__ __forceinline__ void xcd_barrier(const XcdBarrier& b) {
    asm volatile("s_waitcnt vmcnt(0)" ::: "memory");
    __syncthreads();
    if (threadIdx.x == 0) {
        unsigned* bar = b.bar;
        __builtin_amdgcn_s_waitcnt(0);
        unsigned nloc = b.st[0], nx = b.st[1];
        if (nloc == 0u) { xcd_barrier_complete(bar, b.x, nloc, nx); b.st[0] = nloc; b.st[1] = nx; }
        const unsigned old = xb_add(&bar[XB_XSUB(b.x)], 1u);
        const unsigned gen = old / nloc;
        if (old + 1u == (gen + 1u) * nloc) {
            __builtin_amdgcn_fence(__ATOMIC_RELEASE, "agent");
            asm volatile("s_waitcnt vmcnt(0)" ::: "memory");
            const unsigned og = xb_add(&bar[XB_TOP], 1u);
            const unsigned tg = og / nx;
            if (og + 1u == (tg + 1u) * nx) xb_add(&bar[XB_TOPGEN], 1u);
            else XB_SPIN(xb_ld(&bar[XB_TOPGEN]) == tg, bar);
            __builtin_amdgcn_fence(__ATOMIC_ACQUIRE, "agent");
            xb_add(&bar[XB_XGEN(b.x)], 1u);
            asm volatile("s_waitcnt vmcnt(0)" ::: "memory");
        } else {
            XB_SPIN(xb_ld(&bar[XB_XGEN(b.x)]) == gen, bar);
            __builtin_amdgcn_fence(__ATOMIC_ACQUIRE, "agent");
            asm volatile("s_waitcnt vmcnt(0)" ::: "memory");
        }
    }
    __syncthreads();
}

constexpr int NWAVES = 8;
constexpr int RING_BYTES = 131072;
constexpr int LDSCTL_OFF = RING_BYTES, MISC_OFF = LDSCTL_OFF + 320;
constexpr int LDS_BYTES = 147456;
constexpr int CW_BAR = 4096;

struct Args { const float* in[24]; float* out; unsigned char* ws; };

template <bool AF32, class F>
__device__ __forceinline__ void meta_gemm(const void* A, int lda, const bf16_t* Wt, int N, int K, int gw, int ngw, int lane, const F& f) {
    const int fr = lane & 15, fq = lane >> 4;
    for (int cb = gw; cb < N / 16; cb += ngw) {
        f32x4 acc = (f32x4){0.f, 0.f, 0.f, 0.f}; float ss = 0.f;
        const bf16_t* bp = Wt + (size_t)(cb * 16 + fr) * K + 8 * fq;
#pragma unroll 4
        for (int k = 0; k < K; k += 32) {
            bf16x8 a;
            if (AF32) {
                const float* ap = (const float*)A + (size_t)fr * lda + k + 8 * fq;
                const f32x4 a0 = *(const f32x4*)ap, a1 = *(const f32x4*)(ap + 4);
                ss += ((a0.x * a0.x + a0.y * a0.y) + (a0.z * a0.z + a0.w * a0.w)) + ((a1.x * a1.x + a1.y * a1.y) + (a1.z * a1.z + a1.w * a1.w));
                u32x4 w; w.x = pk2bf(a0.x, a0.y); w.y = pk2bf(a0.z, a0.w); w.z = pk2bf(a1.x, a1.y); w.w = pk2bf(a1.z, a1.w);
                a = __builtin_bit_cast(bf16x8, w);
            } else a = *(const bf16x8*)((const bf16_t*)A + (size_t)fr * lda + k + 8 * fq);
            const bf16x8 b = *(const bf16x8*)(bp + k);
            acc = __builtin_amdgcn_mfma_f32_16x16x32_bf16(a, b, acc, 0, 0, 0);
        }
        float rstd = 1.f;
        if (AF32) { ss += __shfl_xor(ss, 16); ss += __shfl_xor(ss, 32); rstd = 1.0f / sqrtf(ss * (1.f / DM) + 1e-6f); }
#pragma unroll
        for (int r = 0; r < 4; ++r) { const int row = 4 * fq + r; const float rs = AF32 ? __shfl(rstd, row) : 1.f; f(row, cb * 16 + fr, acc[r] * rs); }
    }
}
struct MEpi1 { bf16_t* p; float* pn;
    __device__ __forceinline__ void operator()(int r, int col, float v) const {
        const int row = MROWS + r; const int g = col >> 9;
        if (g < 7) p[(size_t)row * PBW + col] = f2bf(v);
        else { const int o = col & 511; if (o < 296) pn[(size_t)row * PNW + o] = v; } } };
struct MEpiRes { float* hm; __device__ __forceinline__ void operator()(int r, int col, float v) const { float* h = hm + r * DM + col; *h = *h + v; } };
struct MEpi3 { bf16_t* raw; int ldr; __device__ __forceinline__ void operator()(int r, int col, float v) const { raw[(size_t)(MROWS + r) * ldr + col] = f2bf(v); } };

struct RwP { const float* mu; const float* w0; const float* w_up; const float* a0; const float* a_up; const float* g_up; };
struct RwS { const float* mu; const float* k_k; const float* k_a; const float* r_k; const float* gn_w; const float* gn_b; };
constexpr int RCH = 8;

__global__ void __launch_bounds__(NWAVES * 64, 2) mk_fwd(Args a) {
    extern __shared__ __attribute__((aligned(16))) unsigned char lds[];
    const int tid0 = threadIdx.x;
    const int G = gridDim.x, bid = blockIdx.x, ngw = G * NWAVES;
    for (int u = tid0; u < (LDS_BYTES - LDSCTL_OFF) / 4; u += NWAVES * 64) ((LAS unsigned*)((LAS unsigned char*)lds + LDSCTL_OFF))[u] = 0u;
    __syncthreads();
    unsigned char* ws = a.ws; float* out = a.out;
    XcdBarrier bar = xcd_barrier_post((unsigned*)(ws + WS_CTL) + CW_BAR, (volatile LAS unsigned*)((LAS unsigned char*)lds + MISC_OFF) + 8);
#define GRID_BAR() xcd_barrier(bar)
#define PHASE_IDS() int tid = tid0; asm volatile("" : "+v"(tid)); const int lane = tid & 63, wave = __builtin_amdgcn_readfirstlane(tid >> 6), gw = bid * NWAVES + wave; (void)lane; (void)gw
    const float* x = a.in[0]; const float* meta = a.in[1];
    float* hm = (float*)(ws + WS_HM); float* c2 = (float*)(ws + WS_C2); float* ssqp = (float*)(ws + WS_SSQ);
    bf16_t* hb = (bf16_t*)(ws + WS_HB); bf16_t* p = (bf16_t*)(ws + WS_P); float* pn = (float*)(ws + WS_PN); bf16_t* y = (bf16_t*)(ws + WS_Y);
    float* WE = (float*)(ws + WS_WE); float* ALR = (float*)(ws + WS_ALR); bf16_t* act = (bf16_t*)(ws + WS_ACT); bf16_t* raw = (bf16_t*)(ws + WS_RAW);
    LAS unsigned char* ldsl = (LAS unsigned char*)lds;

    {
        PHASE_IDS();
        float* scr = (float*)(lds + wave * 16384);
        constexpr int I1 = (DM / 64) * (N1 / 32), I2 = (DM / 64) * (DM / 32), I3 = (DM / 64) * (DFF2 / 32), I4 = (DFF / 64) * (DM / 32), IL = I1 + I2 + I3 + I4;
        for (int it = gw; it < DEPTH * IL; it += ngw) {
            const int l = it / IL; int r = it % IL;
            if (r < I1) { wprep_item(a.in[3] + (size_t)l * DM * N_IN, a.in[2] + l * DM, (bf16_t*)(ws + WS_W1) + (size_t)l * N1 * DM, DM, N_IN, N1, 1, r, scr, lane); continue; } r -= I1;
            if (r < I2) { wprep_item(a.in[18] + (size_t)l * DM * DM, nullptr, (bf16_t*)(ws + WS_W2) + (size_t)l * DM * DM, DM, DM, DM, 2, r, scr, lane); continue; } r -= I2;
            if (r < I3) { wprep_item(a.in[20] + (size_t)l * DM * DFF2, a.in[19] + l * DM, (bf16_t*)(ws + WS_W3) + (size_t)l * DFF2 * DM, DM, DFF2, DFF2, 3, r, scr, lane); continue; } r -= I3;
            wprep_item(a.in[23] + (size_t)l * DFF * DM, nullptr, (bf16_t*)(ws + WS_W4) + (size_t)l * DM * DFF, DFF, DM, DM, 4, r, scr, lane);
        }
        for (int row = gw; row < RROWS; row += ngw) {
            const f32x4* xr = (const f32x4*)(row < MROWS ? x + (size_t)row * DM : meta + (size_t)(row - MROWS) * DM) + lane;
            f32x4* hr = (f32x4*)(row < MROWS ? out + (size_t)row * DM : hm + (size_t)(row - MROWS) * DM) + lane;
            f32x4 v[4]; float s = 0.f;
#pragma unroll
            for (int j = 0; j < 4; ++j) { v[j] = xr[64 * j]; hr[64 * j] = v[j]; s += (v[j].x * v[j].x + v[j].y * v[j].y) + (v[j].z * v[j].z + v[j].w * v[j].w); }
            s = wave_sum(s);
            if (lane < 16) ssqp[(size_t)row * 16 + lane] = lane == 0 ? s : 0.f;
            u32x2* o8 = (u32x2*)(hb + (size_t)row * DM) + lane;
#pragma unroll
            for (int j = 0; j < 4; ++j) { u32x2 w; w.x = pk2bf(v[j].x, v[j].y); w.y = pk2bf(v[j].z, v[j].w); o8[64 * j] = w; }
        }
    }
    cg::this_grid().sync();

#pragma unroll 1
    for (int l = 0; l < DEPTH; ++l) {
        const bf16_t* W1 = (const bf16_t*)(ws + WS_W1) + (size_t)l * N1 * DM; const bf16_t* W2 = (const bf16_t*)(ws + WS_W2) + (size_t)l * DM * DM;
        const bf16_t* W3 = (const bf16_t*)(ws + WS_W3) + (size_t)l * DFF2 * DM; const bf16_t* W4 = (const bf16_t*)(ws + WS_W4) + (size_t)l * DM * DFF;
        {
            PHASE_IDS();
            pg8::Gemm g{hb, W1, MROWS, N1, DM}; pg8::StaticOrder S; S.init(MROWS, N1, G, bid);
            pg8::Epi1 E{ssqp, p, pn};
            pg8::gemm_phase<pg8::Epi1, pg8::StaticOrder, true, true>(ldsl, g, S, E);
            meta_gemm<true>(hm, DM, W1, N1, DM, gw, ngw, lane, MEpi1{p, pn});
        }
        GRID_BAR();
        {
            PHASE_IDS();
            const RwP P{a.in[4] + l * 1824, a.in[5] + l * 512, a.in[6] + (size_t)l * 64 * 512, a.in[7] + l * 512, a.in[8] + (size_t)l * 64 * 512, a.in[9] + (size_t)l * 160 * 512};
            float (*s_in)[288] = (float (*)[288])lds;
            for (int grp = bid; grp < RROWS / 8; grp += G) {
                __syncthreads();
                const int row0 = grp * 8;
                for (int e = tid; e < 8 * 288; e += NWAVES * 64) {
                    const int rr = e / 288, j = e % 288, row = row0 + rr, pr = prevrow(row);
                    const float cur = pn[(size_t)row * PNW + j], prv = pr >= 0 ? pn[(size_t)pr * PNW + j] : 0.f;
                    const float s = cur + P.mu[1536 + j] * (prv - cur);
                    s_in[rr][j] = j < 64 ? tanhf(s) : (j < 128 ? s : sigmoidf_(s));
                }
                __syncthreads();
                const int c = tid;
                float zw[8], za[8], zg[8];
#pragma unroll
                for (int rr = 0; rr < 8; ++rr) { zw[rr] = P.w0[c]; za[rr] = P.a0[c]; zg[rr] = 0.f; }
                for (int j = 0; j < 64; ++j) { const float wu = P.w_up[j * 512 + c], au = P.a_up[j * 512 + c];
#pragma unroll
                    for (int rr = 0; rr < 8; ++rr) { zw[rr] += s_in[rr][j] * wu; za[rr] += s_in[rr][64 + j] * au; } }
                for (int j = 0; j < 160; ++j) { const float gu = P.g_up[j * 512 + c];
#pragma unroll
                    for (int rr = 0; rr < 8; ++rr) zg[rr] += s_in[rr][128 + j] * gu; }
#pragma unroll
                for (int rr = 0; rr < 8; ++rr) { const size_t o = (size_t)(row0 + rr) * 512 + c;
                    WE[o] = 0.6065306597126334f * sigmoidf_(zw[rr]);
                    ALR[o] = sigmoidf_(za[rr]);
                    y[(size_t)(row0 + rr) * DM + c] = f2bf(zg[rr]); }
            }
            const float* q_g = a.in[16] + l * 64; const float* k_g = a.in[17] + l * 64; const float* b_f = a.in[15] + l * 8;
            for (int it = gw; it < RROWS * NH; it += ngw) {
                const int row = it >> 3, h = it & 7;
                bf16_t* qp = p + (size_t)row * PBW + 1536 + h * 64 + lane; bf16_t* kp = p + (size_t)row * PBW + 2048 + h * 64 + lane;
                const float q = bf2f(*qp), k = bf2f(*kp);
                const float mq = wave_sum(q * q) * (1.f / 64.f), mk = wave_sum(k * k) * (1.f / 64.f);
                *qp = f2bf(q * (1.0f / sqrtf(mq + 1e-6f)) * q_g[lane] * (0.125f * LOG2E));
                *kp = f2bf(k * (1.0f / sqrtf(mk + 1e-6f)) * k_g[lane]);
            }
            if (gw < 64) {
                const int b = gw >> 3, h = gw & 7; constexpr int PER = 33;
                float loc[PER]; float s = 0.f;
#pragma unroll
                for (int i = 0; i < PER; ++i) { const int t = lane * PER + i; float v = 0.f;
                    if (t < LTOT) { const float z = pn[(size_t)rowof(b, t) * PNW + 288 + h] + b_f[h]; v = (fminf(z, 0.f) - log1pf(__expf(-fabsf(z)))) * LOG2E; }
                    s += v; loc[i] = s; }
                float incl = s;
#pragma unroll
                for (int o = 1; o < 64; o <<= 1) { const float n = __shfl_up(incl, o); if (lane >= o) incl += n; }
                const float base = incl - s;
#pragma unroll
                for (int i = 0; i < PER; ++i) { const int t = lane * PER + i; if (t < LTOT) c2[(size_t)gw * LTOT + t] = base + loc[i]; }
            }
        }
        GRID_BAR();
        if (bid < 32) {
            PHASE_IDS();
            const RwS P{a.in[4] + l * 1824, a.in[10] + l * 512, a.in[11] + l * 512, a.in[12] + l * 512, a.in[13] + l * 512, a.in[14] + l * 512};
            const int half = tid >> 8, unit = bid * 2 + half, b = unit >> 3, h = unit & 7, t256 = tid & 255, w4 = t256 >> 6;
            unsigned char* base = lds + half * 16384;
            float (*s_vec)[5][64] = (float (*)[5][64])base;
            float (*s_v)[64] = (float (*)[64])(base + 10240); float* s_bonus = (float*)(base + 12288); float (*s_y)[64] = (float (*)[64])(base + 12544);
            const int vl = lane >> 2, kq = lane & 3, vrow = w4 * 16 + vl;
            float S[16];
#pragma unroll
            for (int i = 0; i < 16; ++i) S[i] = 0.f;
            for (int t0 = 0; t0 < LTOT; t0 += RCH) {
                for (int tt = w4; tt < RCH; tt += 4) {
                    const int t = t0 + tt;
                    const int row = rowof(b, t), pr = prevrow(row), c = h * 64 + lane;
                    const bf16_t* pc = p + (size_t)row * PBW; const bf16_t* pp = p + (size_t)(pr >= 0 ? pr : row) * PBW;
                    const float hp = pr >= 0 ? 1.f : 0.f;
                    float r = bf2f(pc[c]), k = bf2f(pc[512 + c]), v = bf2f(pc[1024 + c]);
                    r += P.mu[c] * (hp * bf2f(pp[c]) - r); k += P.mu[512 + c] * (hp * bf2f(pp[512 + c]) - k); v += P.mu[1024 + c] * (hp * bf2f(pp[1024 + c]) - v);
                    const float we = WE[(size_t)row * 512 + c], alr = ALR[(size_t)row * 512 + c];
                    float kk = k * P.k_k[c]; const float nrm = sqrtf(wave_sum(kk * kk)); kk = kk / fmaxf(nrm, 1e-12f);
                    const float kp = k * (1.f + (alr - 1.f) * P.k_a[c]);
                    const float bon = wave_sum(r * kp * P.r_k[c]);
                    s_vec[tt][0][lane] = r; s_vec[tt][1][lane] = __expf(-we); s_vec[tt][2][lane] = kp; s_vec[tt][3][lane] = -kk; s_vec[tt][4][lane] = kk * alr;
                    s_v[tt][lane] = v; if (lane == 0) s_bonus[tt] = bon;
                }
                __syncthreads();
                for (int tt = 0; tt < RCH; ++tt) {
                    const f32x4* vr = (const f32x4*)&s_vec[tt][0][16 * kq]; const f32x4* vw = (const f32x4*)&s_vec[tt][1][16 * kq];
                    const f32x4* vk = (const f32x4*)&s_vec[tt][2][16 * kq]; const f32x4* va = (const f32x4*)&s_vec[tt][3][16 * kq]; const f32x4* vb = (const f32x4*)&s_vec[tt][4][16 * kq];
                    const float vv = s_v[tt][vrow];
                    float sa = 0.f;
#pragma unroll
                    for (int q = 0; q < 4; ++q) { const f32x4 a4 = va[q]; sa += S[4 * q] * a4.x + S[4 * q + 1] * a4.y + S[4 * q + 2] * a4.z + S[4 * q + 3] * a4.w; }
                    sa += __shfl_xor(sa, 1); sa += __shfl_xor(sa, 2);
                    float yy = 0.f;
#pragma unroll
                    for (int q = 0; q < 4; ++q) { const f32x4 w4v = vw[q], b4 = vb[q], k4 = vk[q], r4 = vr[q];
                        S[4 * q] = S[4 * q] * w4v.x + sa * b4.x + vv * k4.x; S[4 * q + 1] = S[4 * q + 1] * w4v.y + sa * b4.y + vv * k4.y;
                        S[4 * q + 2] = S[4 * q + 2] * w4v.z + sa * b4.z + vv * k4.z; S[4 * q + 3] = S[4 * q + 3] * w4v.w + sa * b4.w + vv * k4.w;
                        yy += S[4 * q] * r4.x + S[4 * q + 1] * r4.y + S[4 * q + 2] * r4.z + S[4 * q + 3] * r4.w; }
                    yy += __shfl_xor(yy, 1); yy += __shfl_xor(yy, 2);
                    if (kq == 0) s_y[tt][vrow] = yy;
                }
                __syncthreads();
                for (int tt = w4; tt < RCH; tt += 4) {
                    const int t = t0 + tt; const int row = rowof(b, t), c = h * 64 + lane;
                    const float yv = s_y[tt][lane];
                    const float mean = wave_sum(yv) * (1.f / 64.f); const float d = yv - mean; const float var = wave_sum(d * d) * (1.f / 64.f);
                    float o = d * (1.0f / sqrtf(var + 64e-5f)) * P.gn_w[c] + P.gn_b[c];
                    o += s_bonus[tt] * s_v[tt][lane];
                    if (t >= NMETA || b == 0) { bf16_t* yp = y + (size_t)row * DM + c; *yp = f2bf(o * bf2f(*yp)); }
                }
                __syncthreads();
            }
        } else {
            PHASE_IDS();
            float* s_q = (float*)(lds + wave * 8704); float* s_s = s_q + 64;
            const int nw = (G - 32) * NWAVES;
            for (int item = (bid - 32) * NWAVES + wave; item < 64 * LTOT; item += nw) {
                const int t = item % LTOT, bh = item / LTOT, b = bh >> 3, h = bh & 7;
                if (t < NMETA && b != 0) continue;
                const int row = rowof(b, t);
                WAVE_LDS_SYNC();
                s_q[lane] = bf2f(p[(size_t)row * PBW + 1536 + h * 64 + lane]);
                WAVE_LDS_SYNC();
                const float* cc = c2 + (size_t)bh * LTOT;
                float m = -INFINITY;
                for (int j0 = 0; j0 <= t; j0 += 64) {
                    const int j = j0 + lane;
                    if (j <= t) {
                        const bf16_t* kr = p + (size_t)rowof(b, j) * PBW + 2048 + h * 64;
                        float d = 0.f;
#pragma unroll
                        for (int c8 = 0; c8 < 8; ++c8) { const bf16x8 kv = *(const bf16x8*)(kr + 8 * c8);
#pragma unroll
                            for (int e = 0; e < 8; ++e) d += s_q[8 * c8 + e] * bf2f((bf16_t)kv[e]); }
                        const float s = d - cc[j];
                        s_s[j] = s; m = fmaxf(m, s);
                    }
                }
                m = wave_max(m);
                float sum = 0.f;
                for (int j0 = 0; j0 <= t; j0 += 64) { const int j = j0 + lane; if (j <= t) { const float e = exp2f(s_s[j] - m); s_s[j] = e; sum += e; } }
                sum = wave_sum(sum);
                WAVE_LDS_SYNC();
                float o = 0.f;
                for (int j = 0; j <= t; ++j) o += s_s[j] * bf2f(p[(size_t)rowof(b, j) * PBW + 2560 + h * 64 + lane]);
                o /= sum;
                const float og = bf2f(p[(size_t)row * PBW + 3072 + h * 64 + lane]);
                y[(size_t)row * DM + 512 + h * 64 + lane] = f2bf(o * sigmoidf_(og));
            }
        }
        GRID_BAR();
        {
            PHASE_IDS();
            pg8::Gemm g{y, W2, MROWS, DM, DM}; pg8::StaticOrder S; S.init(MROWS, DM, G, bid);
            pg8::EpiRes E{out, hb, ssqp};
            pg8::gemm_phase<pg8::EpiRes, pg8::StaticOrder, true, true>(ldsl, g, S, E);
            meta_gemm<false>(y + (size_t)MROWS * DM, DM, W2, DM, DM, gw, ngw, lane, MEpiRes{hm});
        }
        GRID_BAR();
        for (int t0 = 0; t0 < 22; t0 += 6) {
            const int nt = (22 - t0) < 6 ? (22 - t0) : 6, ldr = nt * 256;
            {
                PHASE_IDS();
                pg8::Gemm g{hb, W3 + (size_t)t0 * 256 * DM, MROWS, ldr, DM}; pg8::StaticOrder S; S.init(MROWS, ldr, G, bid);
                pg8::Epi3Raw E{ssqp, raw, ldr};
                pg8::gemm_phase<pg8::Epi3Raw, pg8::StaticOrder, true, true>(ldsl, g, S, E);
                meta_gemm<true>(hm, DM, W3 + (size_t)t0 * 256 * DM, ldr, DM, gw, ngw, lane, MEpi3{raw, ldr});
            }
            GRID_BAR();
            {
                PHASE_IDS();
                const float* cw = a.in[21] + (size_t)l * 3 * DFF2; const float* cb = a.in[22] + (size_t)l * DFF2;
                const int per_row = nt * 128; const size_t total = (size_t)RROWS * per_row;
                for (size_t e = (size_t)bid * (NWAVES * 64) + tid; e < total; e += (size_t)G * (NWAVES * 64)) {
                    const int row = (int)(e / per_row), jj = (int)(e % per_row), tl = jj >> 7, c = jj & 127;
                    const int ch = 128 * (t0 + tl) + c;
                    const int p1 = prevrow(row), p2 = p1 >= 0 ? prevrow(p1) : -1;
                    const int cu = tl * 256 + c, cgt = cu + 128;
                    float u = cb[ch] + cw[2 * DFF2 + ch] * bf2f(raw[(size_t)row * ldr + cu]);
                    float g = cb[DFF + ch] + cw[2 * DFF2 + DFF + ch] * bf2f(raw[(size_t)row * ldr + cgt]);
                    if (p1 >= 0) { u += cw[DFF2 + ch] * bf2f(raw[(size_t)p1 * ldr + cu]); g += cw[DFF2 + DFF + ch] * bf2f(raw[(size_t)p1 * ldr + cgt]); }
                    if (p2 >= 0) { u += cw[ch] * bf2f(raw[(size_t)p2 * ldr + cu]); g += cw[DFF + ch] * bf2f(raw[(size_t)p2 * ldr + cgt]); }
                    act[(size_t)row * DFF + ch] = f2bf(g * sigmoidf_(g) * u);
                }
            }
            GRID_BAR();
        }
        {
            PHASE_IDS();
            pg8::Gemm g{act, W4, MROWS, DM, DFF}; pg8::StaticOrder S; S.init(MROWS, DM, G, bid);
            pg8::EpiRes E{out, hb, ssqp};
            pg8::gemm_phase<pg8::EpiRes, pg8::StaticOrder, true, true>(ldsl, g, S, E);
            meta_gemm<false>(act + (size_t)MROWS * DFF, DFF, W4, DM, DFF, gw, ngw, lane, MEpiRes{hm});
        }
        if (l + 1 < DEPTH) GRID_BAR();
    }
}

extern "C" void kernel_launch(void* const* d_in, const int* in_sizes, int n_in, void* d_out, int out_size, void* d_ws, size_t ws_size, hipStream_t stream) {
    static int grid = 0;
    if (grid == 0) {
        if (n_in != 24 || out_size != MROWS * DM || ws_size < WS_END) { fprintf(stderr, "kernel_launch: unexpected shapes (n_in %d out %d ws %zu)\n", n_in, out_size, ws_size); grid = -1; return; }
        int dev = 0, cus = 0, per_cu = 0;
        hipGetDevice(&dev); hipDeviceGetAttribute(&cus, hipDeviceAttributeMultiprocessorCount, dev);
        if (hipFuncSetAttribute((const void*)mk_fwd, hipFuncAttributeMaxDynamicSharedMemorySize, LDS_BYTES) != hipSuccess) { fprintf(stderr, "kernel_launch: hipFuncSetAttribute failed\n"); grid = -1; return; }
        hipOccupancyMaxActiveBlocksPerMultiprocessor(&per_cu, (const void*)mk_fwd, NWAVES * 64, LDS_BYTES);
        (void)hipGetLastError();
        if (per_cu < 1) { fprintf(stderr, "kernel_launch: occupancy query says %d blocks per CU\n", per_cu); }
        grid = cus;
    }
    if (grid < 0) return;
    hipMemsetAsync((char*)d_ws + WS_CTL, 0, CTL_ZERO_BYTES, stream);
    Args a{};
    for (int i = 0; i < 24; ++i) a.in[i] = (const float*)d_in[i];
    a.out = (float*)d_out; a.ws = (unsigned char*)d_ws;
    void* args[] = {&a};
    hipError_t e = hipLaunchCooperativeKernel((const void*)mk_fwd, dim3(grid), dim3(NWAVES * 64), args, LDS_BYTES, stream);
    if (e != hipSuccess) fprintf(stderr, "cooperative launch failed: %s (grid %d)\n", hipGetErrorString(e), grid);
}
```

```cpp
#include <hip/hip_runtime.h>
#include <hip/hip_cooperative_groups.h>
#include <stdint.h>
#include <cstdio>
namespace cg = cooperative_groups;

typedef unsigned short bf16_t;
typedef short bf16x8 __attribute__((ext_vector_type(8)));
typedef float f32x4 __attribute__((ext_vector_type(4)));
typedef unsigned u32x4 __attribute__((ext_vector_type(4)));
typedef unsigned u32x2 __attribute__((ext_vector_type(2)));

constexpr int NB = 8, SEQ = 2048, NMETA = 16, LTOT = 2064, DM = 1024, DEPTH = 4, NH = 8, HD = 64;
constexpr int N_IN = 3880, DFF = 2816, DFF2 = 5632;
constexpr int MROWS = NB * SEQ;
constexpr int RROWS = MROWS + NMETA;
constexpr int N1 = 4096;
constexpr int PBW = 3584;
constexpr int PNW = 320;
constexpr float LOG2E = 1.4426950408889634f;

constexpr size_t MiB = 1u << 20;
constexpr size_t WS_CTL = 0, CTL_ZERO_BYTES = 1 * MiB;
constexpr size_t WS_W1 = 1 * MiB;
constexpr size_t WS_W2 = WS_W1 + 32 * MiB;
constexpr size_t WS_W3 = WS_W2 + 8 * MiB;
constexpr size_t WS_W4 = WS_W3 + 44 * MiB;
constexpr size_t WS_SMALL = WS_W4 + 22 * MiB;
constexpr size_t WS_HM = WS_SMALL;
constexpr size_t WS_C2 = WS_SMALL + 1 * MiB;
constexpr size_t WS_SSQ = WS_SMALL + 3 * MiB;
constexpr size_t WS_HB = WS_SMALL + 6 * MiB;
constexpr size_t WS_P = WS_HB + 33 * MiB;
constexpr size_t WS_PN = WS_P + 113 * MiB;
constexpr size_t WS_Y = WS_PN + 21 * MiB;
constexpr size_t WS_FREE = WS_Y + 33 * MiB;
constexpr size_t WS_WE = WS_HB;
constexpr size_t WS_ALR = WS_FREE;
constexpr size_t WS_ACT = WS_P;
constexpr size_t WS_RAW = WS_PN;
constexpr size_t WS_END = WS_ALR + 33 * MiB;

__device__ __forceinline__ float bf2f(bf16_t v) { return __uint_as_float(((unsigned)v) << 16); }
__device__ __forceinline__ bf16_t f2bf(float f) { unsigned u = __float_as_uint(f); return (bf16_t)((u + 0x7fffu + ((u >> 16) & 1u)) >> 16); }
__device__ __forceinline__ unsigned pk2bf(float lo, float hi) { return (unsigned)f2bf(lo) | ((unsigned)f2bf(hi) << 16); }
__device__ __forceinline__ float sigmoidf_(float x) { return 1.f / (1.f + __expf(-x)); }
__device__ __forceinline__ float wave_sum(float v) {
#pragma unroll
    for (int o = 1; o < 64; o <<= 1) v += __shfl_xor(v, o);
    return v;
}
__device__ __forceinline__ float wave_max(float v) {
#pragma unroll
    for (int o = 1; o < 64; o <<= 1) v = fmaxf(v, __shfl_xor(v, o));
    return v;
}
#define WAVE_LDS_SYNC() do { __builtin_amdgcn_s_waitcnt(0xc07f); __builtin_amdgcn_wave_barrier(); } while (0)
__device__ __forceinline__ int rowof(int b, int t) { return t < NMETA ? MROWS + t : b * SEQ + (t - NMETA); }
__device__ __forceinline__ int prevrow(int row) {
    if (row >= MROWS) return row == MROWS ? -1 : row - 1;
    return (row & (SEQ - 1)) ? row - 1 : MROWS + NMETA - 1;
}

__device__ __forceinline__ int src_col(int mode, int n) {
    if (mode == 1) {
        const int g = n >> 9, o = n & 511;
        switch (g) {
            case 0: return o;
            case 1: return 512 + o;
            case 2: return 1024 + o;
            case 3: return 1824 + o;
            case 4: return 2336 + o;
            case 5: return 2848 + o;
            case 6: return 3360 + o;
            default:
                if (o < 64) return 1536 + o;
                if (o < 128) return 1600 + (o - 64);
                if (o < 288) return 1664 + (o - 128);
                if (o < 296) return 3872 + (o - 288);
                return -1;
        }
    }
    if (mode == 3) { const int t = n >> 8, c = n & 255; return c < 128 ? 128 * t + c : DFF + 128 * t + (c - 128); }
    return n;
}
__device__ __forceinline__ void wprep_item(const float* W, const float* gk, bf16_t* WT, int K, int Nsrc, int Ndst, int mode, int item, float* scr, int lane) {
    const int nblk = Ndst / 32, kb = item / nblk, nb = item % nblk, k0 = 64 * kb, n0 = 32 * nb;
    const int sc = src_col(mode, n0 + (lane & 31));
#pragma unroll 8
    for (int i = 0; i < 32; ++i) {
        const int kk = 2 * i + (lane >> 5);
        float v = 0.f;
        if (sc >= 0) { v = W[(size_t)(k0 + kk) * Nsrc + sc]; if (gk) v *= gk[k0 + kk]; }
        scr[kk * 33 + (lane & 31)] = v;
    }
    WAVE_LDS_SYNC();
    const int c = lane & 7;
#pragma unroll
    for (int j = 0; j < 4; ++j) {
        const int n = (lane >> 3) + 8 * j; const float* s = scr + (8 * c) * 33 + n;
        u32x4 o;
        o.x = pk2bf(s[0 * 33], s[1 * 33]); o.y = pk2bf(s[2 * 33], s[3 * 33]); o.z = pk2bf(s[4 * 33], s[5 * 33]); o.w = pk2bf(s[6 * 33], s[7 * 33]);
        *(u32x4*)(WT + (size_t)(n0 + n) * K + k0 + 8 * c) = o;
    }
    WAVE_LDS_SYNC();
}
namespace pg8 {
#define PG8_LAS __attribute__((address_space(3)))
typedef unsigned short bf16_t;
typedef short bf16x8 __attribute__((ext_vector_type(8)));
typedef float f32x4 __attribute__((ext_vector_type(4)));
typedef unsigned u32x4 __attribute__((ext_vector_type(4)));
constexpr int BM = 256, BK = 64, HALF = 128, HTB = HALF * BK * 2  , STAGE_BYTES = 8 * HTB, NXCD = 8, WGM = 8;

__host__ __device__ __forceinline__ int lds_byte(int r, int c) { const int st = (r >> 4) * 2 + (c >> 5), rr = r & 15, cc = c & 31, ob = rr * 64 + cc * 2; return st * 1024 + (ob ^ (((ob >> 9) & 1) << 5)); }
__host__ __device__ __forceinline__ void stage_rc(int b, int& R, int& C) { const int st = b / 1024, sb = b % 1024, swz = sb ^ (((sb >> 9) & 1) << 5); R = (st >> 1) * 16 + swz / 64; C = (st & 1) * 32 + (swz % 64) / 2; }
__host__ __device__ __forceinline__ int perm32(int rho) { const int n = rho >> 4, i = rho & 15; return 8 * (i >> 2) + 4 * n + (i & 3); }

struct Unit { int pm, pn; };
struct Gemm { const bf16_t* A; const bf16_t* Bt; int M, N, K; };

struct StaticOrder {
    int nM, nN, nwg, G, c;
    __host__ __device__ void init(int M, int N, int G_, int c_) { nM = M / BM; nN = N / BM; nwg = nM * nN; G = G_; c = c_; }
    __host__ __device__ bool next(int i, Unit& u) const {
        const long L = (long)i * G + c; if (L >= nwg) return false;
        int wgid = (int)L; { const int q = nwg / NXCD, r = nwg % NXCD, xcd = wgid % NXCD, off = wgid / NXCD; wgid = (xcd < r ? xcd * (q + 1) : r * (q + 1) + (xcd - r) * q) + off; }
        const int nig = WGM * nN, gid = wgid / nig, fm = gid * WGM, gsz = (nM - fm) < WGM ? (nM - fm) : WGM;
        u.pm = fm + ((wgid % nig) % gsz); u.pn = (wgid % nig) / gsz; return true;
    }
    __device__ __forceinline__ void a_ready(const Unit&) const {}
    __device__ __forceinline__ void done(const Unit&) const {}
};

__device__ __forceinline__ float row_rstd(const float* ssqp, int row) {
    const f32x4* sp = (const f32x4*)(ssqp + (size_t)row * 16);
    const f32x4 a = sp[0], b = sp[1], c = sp[2], d = sp[3];
    const float s = (((a.x + a.y) + (a.z + a.w)) + ((b.x + b.y) + (b.z + b.w))) + (((c.x + c.y) + (c.z + c.w)) + ((d.x + d.y) + (d.z + d.w)));
    return 1.0f / sqrtf(s * (1.f / 1024.f) + 1e-6f);
}
struct Epi1 {
    static constexpr bool PERM = false, AFTER_DRAIN = false;
    const float* ssqp; bf16_t* p; float* pn;
    __device__ __forceinline__ void operator()(const f32x4 (&acc)[2][2][4][2], const Unit& u, int wr, int wc, int fr, int fq) const {
        const int row0 = u.pm * BM + wr * 64 + fr, col0 = u.pn * BM + wc * 32 + 4 * fq;
#pragma unroll
        for (int ai = 0; ai < 2; ++ai)
#pragma unroll
            for (int m = 0; m < 4; ++m) {
                const int row = row0 + ai * HALF + m * 16; const float rs = row_rstd(ssqp, row);
#pragma unroll
                for (int bj = 0; bj < 2; ++bj)
#pragma unroll
                    for (int n = 0; n < 2; ++n) {
                        const f32x4 v = acc[ai][bj][m][n] * rs; const int col = col0 + bj * HALF + n * 16;
                        if (u.pn < 14) { u32x2 w; w.x = pk2bf(v[0], v[1]); w.y = pk2bf(v[2], v[3]); *(u32x2*)(p + (size_t)row * PBW + col) = w; }
                        else { const int o = col - PBW; if (o < 296) *(f32x4*)(pn + (size_t)row * PNW + o) = v; }
                    }
            }
    }
};
struct EpiRes {
    static constexpr bool PERM = false, AFTER_DRAIN = false;
    float* h; bf16_t* hb; float* ssqp;
    __device__ __forceinline__ void operator()(const f32x4 (&acc)[2][2][4][2], const Unit& u, int wr, int wc, int fr, int fq) const {
        const int row0 = u.pm * BM + wr * 64 + fr, col0 = u.pn * BM + wc * 32 + 4 * fq;
#pragma unroll
        for (int ai = 0; ai < 2; ++ai)
#pragma unroll
            for (int m = 0; m < 4; ++m) {
                const int row = row0 + ai * HALF + m * 16; float ss = 0.f;
#pragma unroll
                for (int bj = 0; bj < 2; ++bj)
#pragma unroll
                    for (int n = 0; n < 2; ++n) {
                        const int col = col0 + bj * HALF + n * 16; float* hp = h + (size_t)row * DM + col;
                        const f32x4 v = *(const f32x4*)hp + acc[ai][bj][m][n];
                        *(f32x4*)hp = v; u32x2 w; w.x = pk2bf(v[0], v[1]); w.y = pk2bf(v[2], v[3]); *(u32x2*)(hb + (size_t)row * DM + col) = w;
                        ss += (v[0] * v[0] + v[1] * v[1]) + (v[2] * v[2] + v[3] * v[3]);
                    }
                ss += __shfl_xor(ss, 16); ss += __shfl_xor(ss, 32);
                if (fq == 0) ssqp[(size_t)row * 16 + u.pn * 4 + wc] = ss;
            }
    }
};
struct Epi3Raw {
    static constexpr bool PERM = false, AFTER_DRAIN = false;
    const float* ssqp; bf16_t* raw; int ldr;
    __device__ __forceinline__ void operator()(const f32x4 (&acc)[2][2][4][2], const Unit& u, int wr, int wc, int fr, int fq) const {
        const int row0 = u.pm * BM + wr * 64 + fr, col0 = u.pn * BM + wc * 32 + 4 * fq;
#pragma unroll
        for (int ai = 0; ai < 2; ++ai)
#pragma unroll
            for (int m = 0; m < 4; ++m) {
                const int row = row0 + ai * HALF + m * 16; const float rs = row_rstd(ssqp, row);
#pragma unroll
                for (int bj = 0; bj < 2; ++bj)
#pragma unroll
                    for (int n = 0; n < 2; ++n) {
                        const f32x4 v = acc[ai][bj][m][n] * rs; const int col = col0 + bj * HALF + n * 16;
                        u32x2 w; w.x = pk2bf(v[0], v[1]); w.y = pk2bf(v[2], v[3]); *(u32x2*)(raw + (size_t)row * ldr + col) = w;
                    }
            }
    }
};

template <class Epi, class Sched, bool ALIGN_EPI = false, bool SP2 = false>
__device__ __forceinline__ void gemm_phase(PG8_LAS unsigned char* lds, const Gemm g, const Sched& S, const Epi& E) {
    int tid_ = threadIdx.x; asm volatile("" : "+v"(tid_));
    const int tid = tid_, wid = __builtin_amdgcn_readfirstlane(tid >> 6), lane = tid & 63, wr = wid >> 2, wc = wid & 3, fr = lane & 15, fq = lane >> 4;
    const int K = g.K, nt = K / BK;
    unsigned voffA[2], voffB[2];
#pragma unroll
    for (int i = 0; i < 2; ++i) { int R, C; stage_rc(tid * 16 + i * 8192, R, C); const int Rb = Epi::PERM ? ((R & ~31) + perm32(R & 31)) : R;
        voffA[i] = (unsigned)(R * K + C) * 2u; voffB[i] = (unsigned)(Rb * K + C) * 2u; }
    const size_t kstep = (size_t)(BK * 2);
    const size_t hstep = (size_t)HALF * K * 2;
    const size_t tstep = 2 * hstep;
    const unsigned ldsw = (unsigned)wid * 1024u;
    const int aoff = lds_byte(wr * 64 + fr, fq * 8), boff = lds_byte(wc * 32 + fr, fq * 8);
#define PG8_SA(b, h) (((b) * 2 + (h)) * HTB)
#define PG8_SB(b, h) ((4 + (b) * 2 + (h)) * HTB)
#define PG8_STAGE(bufoff, gbase, voff) do { _Pragma("unroll") for (int _i = 0; _i < 2; ++_i) \
        __builtin_amdgcn_global_load_lds((const unsigned*)((const char*)(gbase) + (voff)[_i]), (PG8_LAS unsigned*)(lds + (bufoff) + ldsw + _i * 8192), 16, 0, 0); } while (0)
#define PG8_LDA(dst, b, h) do { _Pragma("unroll") for (int m = 0; m < 4; ++m) _Pragma("unroll") for (int k = 0; k < 2; ++k) dst[m][k] = *(const PG8_LAS bf16x8*)(lds + PG8_SA(b, h) + aoff + m * 2048 + k * 1024); } while (0)
#define PG8_LDB(dst, b, h) do { _Pragma("unroll") for (int n = 0; n < 2; ++n) _Pragma("unroll") for (int k = 0; k < 2; ++k) dst[n][k] = *(const PG8_LAS bf16x8*)(lds + PG8_SB(b, h) + boff + n * 2048 + k * 1024); } while (0)
#define PG8_MMA(ai, bj, At, Bt) do { __builtin_amdgcn_s_setprio(1); _Pragma("unroll") for (int m = 0; m < 4; ++m) _Pragma("unroll") for (int n = 0; n < 2; ++n) _Pragma("unroll") for (int k = 0; k < 2; ++k) \
        acc[ai][bj][m][n] = __builtin_amdgcn_mfma_f32_16x16x32_bf16(Bt[n][k], At[m][k], acc[ai][bj][m][n], 0, 0, 0); __builtin_amdgcn_s_setprio(0); } while (0)
#define PG8_WAIT_V(n) asm volatile("s_waitcnt vmcnt(" #n ")" ::: "memory")
#define PG8_WAIT_L(n) asm volatile("s_waitcnt lgkmcnt(" #n ")" ::: "memory")
#define PG8_BAR __builtin_amdgcn_s_barrier()
#define PG8_SCHED __builtin_amdgcn_sched_barrier(0)
    Unit cur, nxt; int ui = 0;
    if (!S.next(0, cur)) return;
    f32x4 acc[2][2][4][2];
#pragma unroll
    for (int a = 0; a < 2; ++a)
#pragma unroll
        for (int b = 0; b < 2; ++b)
#pragma unroll
            for (int m = 0; m < 4; ++m)
#pragma unroll
                for (int n = 0; n < 2; ++n) acc[a][b][m][n] = (f32x4){0.f, 0.f, 0.f, 0.f};
    bf16x8 At[4][2], B0[2][2], B1[2][2];
    const char* cA = (const char*)g.A + (size_t)cur.pm * tstep; const char* cB = (const char*)g.Bt + (size_t)cur.pn * tstep;
    S.a_ready(cur);
    if constexpr (SP2) {
        PG8_STAGE(PG8_SB(0, 0), cB, voffB); PG8_STAGE(PG8_SB(0, 1), cB + hstep, voffB); PG8_STAGE(PG8_SA(0, 0), cA, voffA); PG8_STAGE(PG8_SA(0, 1), cA + hstep, voffA);
        if (wr == 1) PG8_BAR;
        PG8_WAIT_V(2); PG8_BAR;
        PG8_STAGE(PG8_SB(1, 0), cB + kstep, voffB); PG8_STAGE(PG8_SA(1, 0), cA + kstep, voffA); PG8_STAGE(PG8_SB(1, 1), cB + hstep + kstep, voffB);
        PG8_WAIT_V(6); PG8_BAR;
    } else {
        PG8_STAGE(PG8_SB(0, 0), cB, voffB); PG8_STAGE(PG8_SA(0, 0), cA, voffA); PG8_STAGE(PG8_SB(0, 1), cB + hstep, voffB); PG8_STAGE(PG8_SA(0, 1), cA + hstep, voffA);
        if (wr == 1) PG8_BAR;
        PG8_WAIT_V(4); PG8_BAR;
        PG8_STAGE(PG8_SB(1, 0), cB + kstep, voffB); PG8_STAGE(PG8_SA(1, 0), cA + kstep, voffA); PG8_STAGE(PG8_SB(1, 1), cB + hstep + kstep, voffB);
        PG8_WAIT_V(6); PG8_BAR;
    }
    for (;;) {
        const bool has_next = S.next(ui + 1, nxt);
        const char* nA = has_next ? (const char*)g.A + (size_t)nxt.pm * tstep : cA; const char* nB = has_next ? (const char*)g.Bt + (size_t)nxt.pn * tstep : cB;
        for (int t = 0; t < nt; t += 2) {
            const bool last = (t == nt - 2);
            const char* a1 = cA + (size_t)(t + 1) * kstep;
            const char* a2 = last ? nA : cA + (size_t)(t + 2) * kstep; const char* b2 = last ? nB : cB + (size_t)(t + 2) * kstep;
            const char* a3 = a2 + kstep; const char* b3 = b2 + kstep;
            if (last && has_next) S.a_ready(nxt);
            if constexpr (SP2) {
            PG8_LDB(B0, 0, 0); PG8_LDB(B1, 0, 1); PG8_SCHED; PG8_LDA(At, 0, 0); PG8_STAGE(PG8_SA(1, 1), a1 + hstep, voffA);
            PG8_WAIT_V(8); PG8_WAIT_L(0); PG8_BAR; PG8_MMA(0, 0, At, B0); PG8_MMA(0, 1, At, B1); PG8_BAR; PG8_SCHED;
            PG8_LDA(At, 0, 1); PG8_STAGE(PG8_SB(0, 0), b2, voffB); PG8_STAGE(PG8_SB(0, 1), b2 + hstep, voffB); PG8_STAGE(PG8_SA(0, 0), a2, voffA);
            PG8_WAIT_V(8); PG8_WAIT_L(0); PG8_BAR; PG8_MMA(1, 0, At, B0); PG8_MMA(1, 1, At, B1); PG8_BAR; PG8_SCHED;
            PG8_LDB(B0, 1, 0); PG8_LDB(B1, 1, 1); PG8_SCHED; PG8_LDA(At, 1, 0); PG8_STAGE(PG8_SA(0, 1), a2 + hstep, voffA);
            PG8_WAIT_V(8); PG8_WAIT_L(0); PG8_BAR; PG8_MMA(0, 0, At, B0); PG8_MMA(0, 1, At, B1); PG8_BAR; PG8_SCHED;
            PG8_LDA(At, 1, 1); PG8_STAGE(PG8_SB(1, 0), b3, voffB); PG8_STAGE(PG8_SB(1, 1), b3 + hstep, voffB); PG8_STAGE(PG8_SA(1, 0), a3, voffA);
            PG8_WAIT_V(8); PG8_WAIT_L(0); PG8_BAR; PG8_MMA(1, 0, At, B0); PG8_MMA(1, 1, At, B1); PG8_BAR; PG8_SCHED;
            } else {
            PG8_LDB(B0, 0, 0); PG8_SCHED; PG8_LDA(At, 0, 0); PG8_STAGE(PG8_SA(1, 1), a1 + hstep, voffA);
            PG8_WAIT_L(8); PG8_BAR; PG8_WAIT_L(0); PG8_MMA(0, 0, At, B0); PG8_BAR; PG8_SCHED;
            PG8_LDB(B1, 0, 1); PG8_STAGE(PG8_SB(0, 0), b2, voffB);
            PG8_BAR; PG8_WAIT_L(0); PG8_MMA(0, 1, At, B1); PG8_BAR;
            PG8_LDA(At, 0, 1); PG8_STAGE(PG8_SA(0, 0), a2, voffA);
            PG8_BAR; PG8_WAIT_L(0); PG8_MMA(1, 0, At, B0); PG8_BAR; PG8_SCHED;
            PG8_STAGE(PG8_SB(0, 1), b2 + hstep, voffB);
            PG8_WAIT_V(6); PG8_BAR; PG8_MMA(1, 1, At, B1); PG8_BAR;
            PG8_LDB(B0, 1, 0); PG8_SCHED; PG8_LDA(At, 1, 0); PG8_STAGE(PG8_SA(0, 1), a2 + hstep, voffA);
            PG8_WAIT_L(8); PG8_BAR; PG8_WAIT_L(0); PG8_MMA(0, 0, At, B0); PG8_BAR; PG8_SCHED;
            PG8_LDB(B1, 1, 1); PG8_STAGE(PG8_SB(1, 0), b3, voffB);
            PG8_BAR; PG8_WAIT_L(0); PG8_MMA(0, 1, At, B1); PG8_BAR;
            PG8_LDA(At, 1, 1); PG8_STAGE(PG8_SA(1, 0), a3, voffA);
            PG8_BAR; PG8_WAIT_L(0); PG8_MMA(1, 0, At, B0); PG8_BAR; PG8_SCHED;
            PG8_STAGE(PG8_SB(1, 1), b3 + hstep, voffB);
            PG8_WAIT_V(6); PG8_BAR; PG8_MMA(1, 1, At, B1); PG8_BAR;
            }
        }
        if constexpr (ALIGN_EPI) { if (wr == 0) PG8_BAR; }
        if constexpr (!Epi::AFTER_DRAIN) { E(acc, cur, wr, wc, fr, fq); S.done(cur); }
        if (!has_next) break;
#pragma unroll
        for (int a = 0; a < 2; ++a)
#pragma unroll
            for (int b = 0; b < 2; ++b)
#pragma unroll
                for (int m = 0; m < 4; ++m)
#pragma unroll
                    for (int n = 0; n < 2; ++n) acc[a][b][m][n] = (f32x4){0.f, 0.f, 0.f, 0.f};
        cur = nxt; cA = nA; cB = nB; ++ui;
        if constexpr (ALIGN_EPI) { if (wr == 1) PG8_BAR; }
    }
    PG8_WAIT_V(0);
    if constexpr (!ALIGN_EPI) { if (wr == 0) PG8_BAR; }
    PG8_BAR;
    if constexpr (Epi::AFTER_DRAIN) { E.fused(acc, cur, wr, wc, fr, fq, lds, wid, lane); S.done(cur); }
#undef PG8_SA
#undef PG8_SB
#undef PG8_STAGE
#undef PG8_LDA
#undef PG8_LDB
#undef PG8_MMA
#undef PG8_WAIT_V
#undef PG8_WAIT_L
#undef PG8_BAR
#undef PG8_SCHED
}
}
#include <hip/hip_bf16.h>
#include <cmath>
namespace attn_body {
using bf16=__hip_bfloat16;
using bf16x8=__attribute__((ext_vector_type(8)))short;
using s16x4=__attribute__((ext_vector_type(4)))short;
using f32x16=__attribute__((ext_vector_type(16)))float;
using u32x4=__attribute__((ext_vector_type(4)))unsigned;
constexpr int BATCH=8,NHEAD=8,SEQ=2048,D=64,PITCH=3584,OPITCH=1024,LEADROW=16384,VK=2176;
constexpr int NW=8,QBLK=32,QB=QBLK*NW,KVBLK=64,NQB=SEQ/QB;
constexpr int ATTN_UNIT_ROWS=QB;
__device__ __forceinline__ int crow(int r,int hi){return (r&3)+8*(r>>2)+4*hi;}
#define SBAR() __builtin_amdgcn_sched_barrier(0)
__device__ __forceinline__ void cmask(f32x16&p0,f32x16&p1,int jb,int qrel,int hi){
  const float NEG=-INFINITY; int kb=64*jb+4*hi;
  #pragma unroll
  for(int r=0;r<16;++r){int kv=kb+(r&3)+8*(r>>2); if(kv>qrel)p0[r]=NEG; if(kv+32>qrel)p1[r]=NEG;}
}

constexpr int NSLOT=3, SLOTB=8192;
constexpr int LDS_K=0, LDS_V=NSLOT*SLOTB, LDS_WS=2*NSLOT*SLOTB, LDS_OST=LDS_WS+NW*64*4, LDS_C2=LDS_OST+NW*4096, LDS_BYTES=LDS_C2+VK*4;
constexpr float C2=0.125f*1.4426950408889634f;
__device__ __forceinline__ void glds16(const void*gsrc,unsigned lds_dst){unsigned keep;
  asm volatile("s_mov_b32 %0, m0\n\ts_mov_b32 m0, %2\n\ts_nop 0\n\tglobal_load_lds_dwordx4 %1, off\n\ts_mov_b32 m0, %0":"=&s"(keep):"v"(gsrc),"s"(lds_dst):"memory");}
__device__ __forceinline__ float max3f(float a,float b,float c){float r;asm("v_max3_f32 %0, %1, %2, %3":"=v"(r):"v"(a),"v"(b),"v"(c));return r;}
__device__ __forceinline__ float max2f(float a,float b){float r;asm("v_max_f32_e32 %0, %1, %2":"=v"(r):"v"(a),"v"(b));return r;}
__device__ __forceinline__ float fadd_s(float a,float b){float r;asm("v_add_f32_e32 %0, %1, %2":"=v"(r):"v"(a),"v"(b));return r;}
__device__ __forceinline__ float fsub_s(float a,float b){float r;asm("v_sub_f32_e32 %0, %1, %2":"=v"(r):"v"(a),"v"(b));return r;}
typedef float f32x2_t __attribute__((ext_vector_type(2))); typedef __bf16 bf16x2_t __attribute__((ext_vector_type(2)));
__device__ __forceinline__ unsigned cvtpk_s(float lo,float hi){f32x2_t v={lo,hi};bf16x2_t b=__builtin_convertvector(v,bf16x2_t);return __builtin_bit_cast(unsigned,b);}
#define WAIT_BAR(N) asm volatile("s_waitcnt vmcnt(" #N ") lgkmcnt(0)\n\ts_barrier":::"memory")

__device__ __forceinline__ void qkt(f32x16&p0,f32x16&p1,const char*Kslot,const bf16x8*qr,int r32,int hi){
  const char*kb=Kslot+hi*1024+r32*16;
  #pragma unroll
  for(int d0=0;d0<4;++d0){
    const bf16x8 b0=*reinterpret_cast<const bf16x8*>(kb+d0*2048);
    const bf16x8 b1=*reinterpret_cast<const bf16x8*>(kb+d0*2048+512);
    p0=__builtin_amdgcn_mfma_f32_32x32x16_bf16(b0,qr[d0],p0,0,0,0);p1=__builtin_amdgcn_mfma_f32_32x32x16_bf16(b1,qr[d0],p1,0,0,0);}
}
typedef __attribute__((address_space(3))) const char* lds_cptr;
typedef short v4i16_t __attribute__((ext_vector_type(4)));
__device__ __forceinline__ void kload8(bf16x8*kf,lds_cptr kp){
  kf[0]=*(const __attribute__((address_space(3))) bf16x8*)(kp);      kf[1]=*(const __attribute__((address_space(3))) bf16x8*)(kp+512);
  kf[2]=*(const __attribute__((address_space(3))) bf16x8*)(kp+2048); kf[3]=*(const __attribute__((address_space(3))) bf16x8*)(kp+2560);
  kf[4]=*(const __attribute__((address_space(3))) bf16x8*)(kp+4096); kf[5]=*(const __attribute__((address_space(3))) bf16x8*)(kp+4608);
  kf[6]=*(const __attribute__((address_space(3))) bf16x8*)(kp+6144); kf[7]=*(const __attribute__((address_space(3))) bf16x8*)(kp+6656);
}
__device__ __forceinline__ void kload2(bf16x8*kf,lds_cptr kp,int j){ kf[2*j]=*(const __attribute__((address_space(3))) bf16x8*)(kp+j*2048); kf[2*j+1]=*(const __attribute__((address_space(3))) bf16x8*)(kp+j*2048+512); }
__device__ __forceinline__ s16x4 vtr(lds_cptr p){ return __builtin_bit_cast(s16x4,__builtin_amdgcn_ds_read_tr16_b64_v4i16((__attribute__((address_space(3))) v4i16_t*)p)); }
__device__ __forceinline__ float rowmax(const f32x16&p0,const f32x16&p1){
  float a=max3f(p0[0],p0[1],p1[0]),b=max3f(p0[2],p0[3],p1[1]);a=max3f(a,p1[2],p1[3]);
  #pragma unroll
  for(int r=4;r<16;r+=4){a=max3f(a,p0[r],p0[r+1]);b=max3f(b,p0[r+2],p0[r+3]);a=max3f(a,p1[r],p1[r+1]);b=max3f(b,p1[r+2],p1[r+3]);}
  const float m=max2f(a,b);
  auto rr=__builtin_amdgcn_permlane32_swap(__float_as_uint(m),__float_as_uint(m),false,false);
  return max2f(__uint_as_float(rr[0]),__uint_as_float(rr[1]));
}
__device__ __forceinline__ void pv(f32x16*o,int vb,bf16x8 pa0,bf16x8 pa1,bf16x8 pa2,bf16x8 pa3){
  #pragma unroll
  for(int d0=0;d0<2;++d0){s16x4 lo[4],hi[4];
    #pragma unroll
    for(int ks=0;ks<4;++ks){
      asm volatile("ds_read_b64_tr_b16 %0,%1 offset:%c2":"=&v"(lo[ks]):"v"(vb),"i"(d0*4096+ks*1024):"memory");
      asm volatile("ds_read_b64_tr_b16 %0,%1 offset:%c2":"=&v"(hi[ks]):"v"(vb),"i"(d0*4096+ks*1024+512):"memory");}
    asm volatile("s_waitcnt lgkmcnt(0)":::"memory");SBAR();
    #define PK(k) (bf16x8){lo[k][0],lo[k][1],lo[k][2],lo[k][3],hi[k][0],hi[k][1],hi[k][2],hi[k][3]}
    o[d0]=__builtin_amdgcn_mfma_f32_32x32x16_bf16(pa0,PK(0),o[d0],0,0,0);
    o[d0]=__builtin_amdgcn_mfma_f32_32x32x16_bf16(pa1,PK(1),o[d0],0,0,0);
    o[d0]=__builtin_amdgcn_mfma_f32_32x32x16_bf16(pa2,PK(2),o[d0],0,0,0);
    o[d0]=__builtin_amdgcn_mfma_f32_32x32x16_bf16(pa3,PK(3),o[d0],0,0,0);
    #undef PK
  }
}

#ifndef ATTN_STORE16
#define ATTN_STORE16(p,v) (*(u32x4*)(p)=(v))
#endif
template<int THRL> __device__ __forceinline__ void attn_unit(int b,int h,int qb,const bf16*Q,const bf16*__restrict__ K,const bf16*__restrict__ V,const bf16*__restrict__ OG,const float*__restrict__ c2v,bf16*O,char*shm){
  int tid_=threadIdx.x; asm volatile("":"+v"(tid_));
  const int tid=tid_,lane=tid&63,r32=lane&31,hi=lane>>5; const int wid=__builtin_amdgcn_readfirstlane(tid>>6);
  const long rowbase=(long)b*SEQ; const int q0=qb*QB;
  const bf16*Qw=Q+(rowbase+q0+wid*QBLK)*PITCH+h*D;
  const bf16*Kh=K+(rowbase-2*KVBLK)*PITCH+h*D,*Vh=V+(rowbase-2*KVBLK)*PITCH+h*D;
  const bf16*KhL=K+(long)LEADROW*PITCH+h*D,*VhL=V+(long)LEADROW*PITCH+h*D;
  const unsigned lds0=(unsigned)(uintptr_t)shm;
  float*wsf=(float*)(shm+LDS_WS)+wid*64;
  const bf16*ksrc=Kh+(long)lane*PITCH+wid*8,*ksrcL=KhL+(long)lane*PITCH+wid*8;
  const bf16*vsrc=Vh+(long)(16*(wid&3)+(lane>>2))*PITCH+(wid>>2)*32+(lane&3)*8,*vsrcL=VhL+(long)(16*(wid&3)+(lane>>2))*PITCH+(wid>>2)*32+(lane&3)*8;
  const unsigned kdst=lds0+LDS_K+wid*1024, vdst=lds0+LDS_V+wid*1024;
  #define DMA_K(t,slot) glds16(((t)<2?ksrcL:ksrc)+(long)(t)*KVBLK*PITCH,(unsigned)__builtin_amdgcn_readfirstlane(kdst+(slot)))
  #define DMA_V(t,slot) glds16(((t)<2?vsrcL:vsrc)+(long)(t)*KVBLK*PITCH,(unsigned)__builtin_amdgcn_readfirstlane(vdst+(slot)))
  const int vb0=(int)(lds0+LDS_V)+((lane>>4)&1)*32+(lane&3)*8+(4*hi+((lane&15)>>2))*64;
  const char*Kbase=shm+LDS_K; bf16x8 kf[8];
  const lds_cptr shm3=(lds_cptr)shm; const lds_cptr kp0=shm3+LDS_K+hi*1024+r32*16; const lds_cptr vp0=shm3+LDS_V+((lane>>4)&1)*32+(lane&3)*8+(4*hi+((lane&15)>>2))*64;
  const int NT=(q0+QB)/KVBLK+2;
  { float*negc_w=(float*)(shm+LDS_C2); const float*cs=c2v+(long)(b*NHEAD+h)*VK; for(int i=tid;i<NT*KVBLK;i+=NW*64)negc_w[i]=-cs[i]; }
  const __attribute__((address_space(3))) float* negc3=(const __attribute__((address_space(3))) float*)((lds_cptr)shm+LDS_C2)+4*hi;
  typedef float f32x4_t __attribute__((ext_vector_type(4)));
  #define NEGC(t,i) (*(const __attribute__((address_space(3))) f32x4_t*)(negc3+64*(t)+(((i)>>2)*32)+8*((i)&3)))
  DMA_K(0,0);DMA_V(0,0);DMA_K(1,SLOTB);
  bf16x8 qr[4];
  #pragma unroll
  for(int d0=0;d0<4;++d0)qr[d0]=*reinterpret_cast<const bf16x8*>(&Qw[(long)r32*PITCH+d0*16+hi*8]);
  float mhat=0.f,l_reg=0.f;f32x16 o[2];o[0]=f32x16{};o[1]=f32x16{};
  const int qrel=wid*QBLK+r32;
  #define CMASK(P0,P1,t) do{int jb_=(t)-(NT-4); if(jb_>=0)cmask(P0,P1,jb_,qrel,hi);}while(0)
  bool resc=false;
  #define START(P0,P1) do{ const float rm=rowmax(P0,P1); resc=false; \
    { const float dl=rm; mhat=fadd_s(mhat,dl); \
      _Pragma("unroll") for(int r=0;r<16;++r){P0[r]=fsub_s(P0[r],dl);P1[r]=fsub_s(P1[r],dl);} } \
    _Pragma("unroll") for(int r=0;r<16;++r)P0[r]=__builtin_amdgcn_exp2f(P0[r]); }while(0)
  #define RESC() do{ if(resc){ asm volatile("s_waitcnt lgkmcnt(0)":::"memory"); \
      _Pragma("unroll") for(int d_=0;d_<2;++d_) _Pragma("unroll") for(int r=0;r<16;++r)o[d_][r]*=wsf[crow(r,hi)]; } }while(0)
  f32x16 pA0,pA1,pB0,pB1;
  int sl_prev=0,sl_cur=0,sl_next=SLOTB;
  #define ROT() do{sl_prev=sl_cur;sl_cur=sl_next;sl_next=(sl_next==(NSLOT-1)*SLOTB)?0:sl_next+SLOTB;}while(0)
  DMA_K(2,2*SLOTB);
  WAIT_BAR(3);
  #define FILLT(P0,P1,t) do{ _Pragma("unroll") for(int i_=0;i_<4;++i_){ const f32x4_t a_=NEGC(t,i_),b_=NEGC(t,4+i_); \
      P0[4*i_]=a_[0]-mhat;P0[4*i_+1]=a_[1]-mhat;P0[4*i_+2]=a_[2]-mhat;P0[4*i_+3]=a_[3]-mhat; P1[4*i_]=b_[0]-mhat;P1[4*i_+1]=b_[1]-mhat;P1[4*i_+2]=b_[2]-mhat;P1[4*i_+3]=b_[3]-mhat; } }while(0)
  FILLT(pA0,pA1,0);
  qkt(pA0,pA1,Kbase,qr,r32,hi);asm volatile("s_nop 15\n\ts_nop 7":"+v"(pA0),"+v"(pA1));CMASK(pA0,pA1,0);
  START(pA0,pA1);
  FILLT(pB0,pB1,1);
  _Pragma("unroll") for(int r=0;r<16;++r)pA1[r]=__builtin_amdgcn_exp2f(pA1[r]);
  WAIT_BAR(0);
  DMA_K(3,0);DMA_V(1,SLOTB);
  ROT();
  kload8(kf,kp0+sl_cur);
  WAIT_BAR(2);
  s16x4 vlo[8],vhi[8]; u32x4 pw0,pw1,pw2,pw3;
  #define PKW(P,B) cvtpk_s(P[B],P[B+1])
  #define PAF(k) __builtin_bit_cast(bf16x8,pw##k)
  #define VFR(i) (bf16x8){vlo[i][0],vlo[i][1],vlo[i][2],vlo[i][3],vhi[i][0],vhi[i][1],vhi[i][2],vhi[i][3]}
  #define PIN(x) asm volatile("":"+v"(x))
  #define MX3(a,b,c) __builtin_fmaxf(__builtin_fmaxf((a),(b)),(c))
  #define GAPA(MF,A0,A1,A2,A3,W0,W1,PW) do{ MF; sacc+=A0; sacc+=A1; sacc+=A2; sacc+=A3; PIN(sacc); W0; W1; PIN(PW); SBAR(); }while(0)
  #define EX(v) __builtin_amdgcn_exp2f(v)
  #define GAPB(MF,X,B,FP,FB,I,t,GF) do{ MF; X[B]=EX(X[B]); X[B+1]=EX(X[B+1]); X[B+2]=EX(X[B+2]); X[B+3]=EX(X[B+3]); \
      if(GF){ FP[FB]=fsub_s(cn_[0],mhat); FP[FB+1]=fsub_s(cn_[1],mhat); FP[FB+2]=fsub_s(cn_[2],mhat); FP[FB+3]=fsub_s(cn_[3],mhat); PIN(FP); if((I)<7){cn_=NEGC((t)+1,(I)+1);} } \
      PIN(X); SBAR(); }while(0)
  #define VRD(i) do{ vlo[i]=vtr(vp_+(((i)>>2)*4096+((i)&3)*1024)); vhi[i]=vtr(vp_+(((i)>>2)*4096+((i)&3)*1024+512)); }while(0)
  #define KRD(G,j) do{ if(G){ kload2(kf,kp0+sl_next,j); SBAR(); } }while(0)
  #define STEP(C0,C1,P0,P1,t,GK,GV,GL) do{ SBAR(); \
    const lds_cptr vp_=vp0+sl_prev; \
    VRD(0); SBAR(); float sacc=(P0[0]+P0[1]); \
    GAPA(C0=__builtin_amdgcn_mfma_f32_32x32x16_bf16(kf[0],qr[0],C0,0,0,0), P0[2],P0[3],P0[4],P0[5],     pw0[0]=PKW(P0,0), pw0[1]=PKW(P0,2), pw0); \
    VRD(4); SBAR(); GAPA(C1=__builtin_amdgcn_mfma_f32_32x32x16_bf16(kf[1],qr[0],C1,0,0,0), P0[6],P0[7],P0[8],P0[9],     pw0[2]=PKW(P0,4), pw0[3]=PKW(P0,6), pw0); \
    VRD(1); SBAR(); GAPA(C0=__builtin_amdgcn_mfma_f32_32x32x16_bf16(kf[2],qr[1],C0,0,0,0),   P0[10],P0[11],P0[12],P0[13], pw1[0]=PKW(P0,8), pw1[1]=PKW(P0,10), pw1); \
    VRD(5); SBAR(); GAPA(C1=__builtin_amdgcn_mfma_f32_32x32x16_bf16(kf[3],qr[1],C1,0,0,0),   P0[14],P0[15],P1[0],P1[1],   pw1[2]=PKW(P0,12),pw1[3]=PKW(P0,14), pw1); \
    VRD(2); SBAR(); GAPA(C0=__builtin_amdgcn_mfma_f32_32x32x16_bf16(kf[4],qr[2],C0,0,0,0),   P1[2],P1[3],P1[4],P1[5],     pw2[0]=PKW(P1,0), pw2[1]=PKW(P1,2), pw2); \
    VRD(6); SBAR(); GAPA(C1=__builtin_amdgcn_mfma_f32_32x32x16_bf16(kf[5],qr[2],C1,0,0,0),   P1[6],P1[7],P1[8],P1[9],     pw2[2]=PKW(P1,4), pw2[3]=PKW(P1,6), pw2); \
    VRD(3); SBAR(); GAPA(C0=__builtin_amdgcn_mfma_f32_32x32x16_bf16(kf[6],qr[3],C0,0,0,0),   P1[10],P1[11],P1[12],P1[13], pw3[0]=PKW(P1,8), pw3[1]=PKW(P1,10), pw3); \
    VRD(7); SBAR(); GAPA(C1=__builtin_amdgcn_mfma_f32_32x32x16_bf16(kf[7],qr[3],C1,0,0,0),   P1[14],P1[15],0.f,0.f,       pw3[2]=PKW(P1,12),pw3[3]=PKW(P1,14), pw3); \
    l_reg+=sacc; \
    if(GK){DMA_K((t)+3,sl_cur);} if(GV){DMA_V((t)+1,sl_next);} \
    CMASK(C0,C1,t); \
    { float a=MX3(C0[0],C0[1],C1[0]),b=MX3(C0[2],C0[3],C1[1]); a=MX3(a,C1[2],C1[3]); \
      _Pragma("unroll") for(int r=4;r<16;r+=4){a=MX3(a,C0[r],C0[r+1]);b=MX3(b,C0[r+2],C0[r+3]);a=MX3(a,C1[r],C1[r+1]);b=MX3(b,C1[r+2],C1[r+3]);} \
      float rm=__builtin_fmaxf(a,b); { auto rr=__builtin_amdgcn_permlane32_swap(__float_as_uint(rm),__float_as_uint(rm),false,false); rm=__builtin_fmaxf(__uint_as_float(rr[0]),__uint_as_float(rr[1])); } \
      resc=false; \
      if(__builtin_expect(__any(rm>(float)THRL),0)){ const float dl=__builtin_fmaxf(rm,0.f); mhat+=dl; \
        _Pragma("unroll") for(int r=0;r<16;++r){C0[r]-=dl;C1[r]-=dl;} \
        const float f=__builtin_amdgcn_exp2f(-dl); l_reg*=f; if(hi==0)wsf[r32]=f; resc=true; } } \
    f32x4_t cn_=(f32x4_t){0.f,0.f,0.f,0.f}; if(GL){cn_=NEGC((t)+1,0);} \
    SBAR(); \
    GAPB(o[0]=__builtin_amdgcn_mfma_f32_32x32x16_bf16(PAF(0),VFR(0),o[0],0,0,0), C0,0,P0,0,0,t,GL); \
    GAPB(o[1]=__builtin_amdgcn_mfma_f32_32x32x16_bf16(PAF(0),VFR(4),o[1],0,0,0), C0,4,P0,4,1,t,GL); \
    KRD(GL,0); GAPB(o[0]=__builtin_amdgcn_mfma_f32_32x32x16_bf16(PAF(1),VFR(1),o[0],0,0,0), C0,8,P0,8,2,t,GL); \
    KRD(GL,1); GAPB(o[1]=__builtin_amdgcn_mfma_f32_32x32x16_bf16(PAF(1),VFR(5),o[1],0,0,0), C0,12,P0,12,3,t,GL); \
    KRD(GL,2); GAPB(o[0]=__builtin_amdgcn_mfma_f32_32x32x16_bf16(PAF(2),VFR(2),o[0],0,0,0), C1,0,P1,0,4,t,GL); \
    KRD(GL,3); GAPB(o[1]=__builtin_amdgcn_mfma_f32_32x32x16_bf16(PAF(2),VFR(6),o[1],0,0,0), C1,4,P1,4,5,t,GL); \
    GAPB(o[0]=__builtin_amdgcn_mfma_f32_32x32x16_bf16(PAF(3),VFR(3),o[0],0,0,0), C1,8,P1,8,6,t,GL); \
    GAPB(o[1]=__builtin_amdgcn_mfma_f32_32x32x16_bf16(PAF(3),VFR(7),o[1],0,0,0), C1,12,P1,12,7,t,GL); \
    }while(0)
  int t=1;
  #undef CMASK
  #define CMASK(P0,P1,t) do{}while(0)
  for(;t+5<NT;t+=2){
    STEP(pB0,pB1,pA0,pA1,t,true,true,true);     WAIT_BAR(2); RESC(); ROT();
    STEP(pA0,pA1,pB0,pB1,t+1,true,true,true);   WAIT_BAR(2); RESC(); ROT();
  }
  #undef CMASK
  #define CMASK(P0,P1,t) do{int jb_=(t)-(NT-4); if(jb_>=0)cmask(P0,P1,jb_,qrel,hi);}while(0)
  #define ENDW(tt) do{ if((tt)+3<NT){WAIT_BAR(2);} else if((tt)+2<NT){WAIT_BAR(1);} else {WAIT_BAR(0);} }while(0)
  for(;t+1<NT;t+=2){
    STEP(pB0,pB1,pA0,pA1,t,(t+3<NT),(t+1<NT),(t+1<NT));       ENDW(t);   RESC(); ROT();
    STEP(pA0,pA1,pB0,pB1,t+1,(t+4<NT),(t+2<NT),(t+2<NT));     ENDW(t+1); RESC(); ROT();
  }
  STEP(pB0,pB1,pA0,pA1,NT-1,false,false,false); RESC();
  { float sacc=pB0[0]+pB0[1]; _Pragma("unroll") for(int r=2;r<16;++r)sacc+=pB0[r]; _Pragma("unroll") for(int r=0;r<16;++r)sacc+=pB1[r]; l_reg+=sacc;
    pw0=(u32x4){PKW(pB0,0),PKW(pB0,2),PKW(pB0,4),PKW(pB0,6)};pw1=(u32x4){PKW(pB0,8),PKW(pB0,10),PKW(pB0,12),PKW(pB0,14)};pw2=(u32x4){PKW(pB1,0),PKW(pB1,2),PKW(pB1,4),PKW(pB1,6)};pw3=(u32x4){PKW(pB1,8),PKW(pB1,10),PKW(pB1,12),PKW(pB1,14)};
    SBAR(); pv(o,vb0+sl_cur,PAF(0),PAF(1),PAF(2),PAF(3)); }
  #undef PKW
  #undef PAF
  #undef VFR
  #undef PIN
  #undef MX3
  #undef GAPA
  #undef GAPB
  #undef EX
  #undef VRD
  #undef KRD
  #undef STEP
  #undef ENDW
  {auto rr=__builtin_amdgcn_permlane32_swap(__float_as_uint(l_reg),__float_as_uint(l_reg),false,false);l_reg=__uint_as_float(rr[0])+__uint_as_float(rr[1]);}
  if(hi==0)wsf[32+r32]=l_reg;asm volatile("s_waitcnt lgkmcnt(0)":::"memory");
  float rli[16];
  #pragma unroll
  for(int r=0;r<16;++r)rli[r]=__builtin_amdgcn_rcpf(wsf[32+crow(r,hi)]);
  bf16*Ow=O+(rowbase+q0+wid*QBLK)*OPITCH+h*D; const bf16*Gw=OG+(rowbase+q0+wid*QBLK)*PITCH+h*D;
  u32x4 gg[4];
  #pragma unroll
  for(int i=0;i<4;++i){const int row=i*8+(lane>>3),ch=lane&7; gg[i]=*(const u32x4*)(Gw+(long)row*PITCH+ch*8);}
  { bf16*stg=(bf16*)(shm+LDS_OST)+wid*2048;
    #pragma unroll
    for(int r=0;r<16;++r){const int orow=crow(r,hi);
      #pragma unroll
      for(int d0=0;d0<2;++d0)stg[orow*64+d0*32+r32]=__float2bfloat16(o[d0][r]*rli[r]);}
    asm volatile("s_waitcnt lgkmcnt(0)":::"memory");
    #pragma unroll
    for(int i=0;i<4;++i){const int row=i*8+(lane>>3),ch=lane&7; u32x4 v=*(const u32x4*)(stg+row*64+ch*8);
      #pragma unroll
      for(int w=0;w<4;++w){ const float o0=__uint_as_float(v[w]<<16),o1=__uint_as_float(v[w]&0xffff0000u),g0=__uint_as_float(gg[i][w]<<16),g1=__uint_as_float(gg[i][w]&0xffff0000u);
        v[w]=cvtpk_s(o0*__builtin_amdgcn_rcpf(1.f+__builtin_amdgcn_exp2f(-1.4426950408889634f*g0)),o1*__builtin_amdgcn_rcpf(1.f+__builtin_amdgcn_exp2f(-1.4426950408889634f*g1))); }
      ATTN_STORE16(Ow+(long)row*OPITCH+ch*8,v);} }
  asm volatile("s_waitcnt lgkmcnt(0)\n\ts_barrier":::"memory");
  #undef DMA_K
  #undef NEGC
  #undef FILLT
  #undef DMA_V
  #undef CMASK
  #undef START
  #undef RESC
  #undef ROT
}
constexpr int ATTN_LDS_BYTES=LDS_BYTES;
struct AttnTensors { const bf16* Q; const bf16* K; const bf16* V; const bf16* OG; const float* c2v; bf16* O; };
struct AttnUnit { int bh; int qb; };
struct StaticOrder {
  int vcu, G;
  __device__ __forceinline__ explicit StaticOrder(int grid,int block):vcu((grid%8==0)?(block%8)*(grid/8)+block/8:block),G(grid){}
  __device__ __forceinline__ bool next(int i,AttnUnit&u)const{ const int pair=vcu+(i>>1)*G; if(pair>=BATCH*NHEAD*4)return false; const int s=pair&3; u.bh=pair>>2; u.qb=(i&1)?s:7-s; return true; }
  __device__ __forceinline__ void a_ready(const AttnUnit&)const{}
  __device__ __forceinline__ void done(const AttnUnit&)const{}
};
template<class Sched,int THRL=8> __device__ __forceinline__ void attn_phase(char*lds,const AttnTensors&T,const Sched&S){
  AttnUnit u;
  for(int i=0;S.next(i,u);++i){ S.a_ready(u); attn_unit<THRL>(u.bh/NHEAD,u.bh%NHEAD,u.qb,T.Q,T.K,T.V,T.OG,T.c2v,T.O,lds); S.done(u); }
}
#undef SBAR
#undef WAIT_BAR
}
#define GAS __attribute__((address_space(1)))
#define LAS __attribute__((address_space(3)))
typedef unsigned short bf16;
typedef unsigned v4u __attribute__((ext_vector_type(4)));
typedef float f32x4 __attribute__((ext_vector_type(4)));
typedef short bf16x8 __attribute__((ext_vector_type(8)));
typedef GAS unsigned gu32;
typedef GAS unsigned long long gu64;
#define RLX_AGENT __ATOMIC_RELAXED, __HIP_MEMORY_SCOPE_AGENT
#define LDS_WAIT() asm volatile("s_waitcnt lgkmcnt(0)" ::: "memory")
#define VM_WAIT() asm volatile("s_waitcnt vmcnt(0)" ::: "memory")
#define XB_TMO      128
#define XB_XCNT(j)  (256  + 64 * (j))
#define XB_XSUB(j)  (1280 + 64 * (j))
#define XB_XGEN(j)  (2304 + 64 * (j))
#define XB_TOP      3328
#define XB_TOPGEN   3392
#define XCD_BAR_WORDS 3456
#define XB_SPIN_CAP (1u << 18)

__device__ __forceinline__ unsigned xb_ld(unsigned* p)              { return __hip_atomic_load(p, __ATOMIC_RELAXED, __HIP_MEMORY_SCOPE_AGENT); }
__device__ __forceinline__ unsigned xb_add(unsigned* p, unsigned v) { return __hip_atomic_fetch_add(p, v, __ATOMIC_RELAXED, __HIP_MEMORY_SCOPE_AGENT); }
__device__ __forceinline__ unsigned xb_xcc_id() { return (unsigned)__builtin_amdgcn_s_getreg((3 << 11) | 20) & 0xFu; }
#define XB_SPIN(cond, bar) do { unsigned _sp = 0; while (cond) { __builtin_amdgcn_s_sleep(1); \
    if ((++_sp & 255u) == 0u) { if (xb_ld(&(bar)[XB_TMO])) break; if (_sp > XB_SPIN_CAP) { atomicAdd(&(bar)[XB_TMO], 1u); break; } } } } while (0)

struct XcdBarrier {
    unsigned* bar; unsigned x;
    volatile LAS unsigned* st;
};

__device__ __forceinline__ XcdBarrier xcd_barrier_post(unsigned* bar, volatile LAS unsigned* st) {
    XcdBarrier b; b.bar = bar; b.x = xb_xcc_id(); b.st = st;
    if (threadIdx.x == 0) (void)xb_add(&bar[XB_XCNT(b.x)], 1u);
    return b;
}
__device__ __forceinline__ void xcd_barrier_complete(unsigned* bar, unsigned x, unsigned& nloc, unsigned& nx) {
    const unsigned G = gridDim.x * gridDim.y * gridDim.z;
    unsigned sum, cnt, mine, sp = 0u;
    for (;;) {
        sum = 0u; cnt = 0u; mine = 0u;
#pragma unroll
        for (unsigned j = 0; j < 16; ++j) { const unsigned c = xb_ld(&bar[XB_XCNT(j)]); sum += c; cnt += (c > 0u) ? 1u : 0u; mine = (j == x) ? c : mine; }
        if (sum == G) break;
        __builtin_amdgcn_s_sleep(1);
        if ((++sp & 255u) == 0u) { if (xb_ld(&bar[XB_TMO])) break; if (sp > XB_SPIN_CAP) { atomicAdd(&bar[XB_TMO], 1u); break; } }
    }
    nloc = mine > 0u ? mine : 1u; nx = cnt > 0u ? cnt : 1u;
}

__device__ __forceinline__ void xcd_barrier(const XcdBarrier& b) {
    asm volatile("s_waitcnt vmcnt(0)" ::: "memory");
    __syncthreads();
    if (threadIdx.x == 0) {
        unsigned* bar = b.bar;
        __builtin_amdgcn_s_waitcnt(0);
        unsigned nloc = b.st[0], nx = b.st[1];
        if (nloc == 0u) { xcd_barrier_complete(bar, b.x, nloc, nx); b.st[0] = nloc; b.st[1] = nx; }
        const unsigned old = xb_add(&bar[XB_XSUB(b.x)], 1u);
        const unsigned gen = old / nloc;
        if (old + 1u == (gen + 1u) * nloc) {
            __builtin_amdgcn_fence(__ATOMIC_RELEASE, "agent");
            asm volatile("s_waitcnt vmcnt(0)" ::: "memory");
            const unsigned og = xb_add(&bar[XB_TOP], 1u);
            const unsigned tg = og / nx;
            if (og + 1u == (tg + 1u) * nx) xb_add(&bar[XB_TOPGEN], 1u);
            else XB_SPIN(xb_ld(&bar[XB_TOPGEN]) == tg, bar);
            __builtin_amdgcn_fence(__ATOMIC_ACQUIRE, "agent");
            xb_add(&bar[XB_XGEN(b.x)], 1u);
            asm volatile("s_waitcnt vmcnt(0)" ::: "memory");
        } else {
            XB_SPIN(xb_ld(&bar[XB_XGEN(b.x)]) == gen, bar);
            __builtin_amdgcn_fence(__ATOMIC_ACQUIRE, "agent");
            asm volatile("s_waitcnt vmcnt(0)" ::: "memory");
        }
    }
    __syncthreads();
}

constexpr int NWAVES = 8;
constexpr int RING_BYTES = 131072;
constexpr int LDSCTL_OFF = RING_BYTES, MISC_OFF = LDSCTL_OFF + 320;
constexpr int LDS_BYTES = 147456;
constexpr int CW_BAR = 4096;

struct Args { const float* in[24]; float* out; unsigned char* ws; };

template <bool AF32, class F>
__device__ __forceinline__ void meta_gemm(const void* A, int lda, const bf16_t* Wt, int N, int K, int gw, int ngw, int lane, const F& f) {
    const int fr = lane & 15, fq = lane >> 4;
    for (int cb = gw; cb < N / 16; cb += ngw) {
        f32x4 acc = (f32x4){0.f, 0.f, 0.f, 0.f}; float ss = 0.f;
        const bf16_t* bp = Wt + (size_t)(cb * 16 + fr) * K + 8 * fq;
#pragma unroll 4
        for (int k = 0; k < K; k += 32) {
            bf16x8 a;
            if (AF32) {
                const float* ap = (const float*)A + (size_t)fr * lda + k + 8 * fq;
                const f32x4 a0 = *(const f32x4*)ap, a1 = *(const f32x4*)(ap + 4);
                ss += ((a0.x * a0.x + a0.y * a0.y) + (a0.z * a0.z + a0.w * a0.w)) + ((a1.x * a1.x + a1.y * a1.y) + (a1.z * a1.z + a1.w * a1.w));
                u32x4 w; w.x = pk2bf(a0.x, a0.y); w.y = pk2bf(a0.z, a0.w); w.z = pk2bf(a1.x, a1.y); w.w = pk2bf(a1.z, a1.w);
                a = __builtin_bit_cast(bf16x8, w);
            } else a = *(const bf16x8*)((const bf16_t*)A + (size_t)fr * lda + k + 8 * fq);
            const bf16x8 b = *(const bf16x8*)(bp + k);
            acc = __builtin_amdgcn_mfma_f32_16x16x32_bf16(a, b, acc, 0, 0, 0);
        }
        float rstd = 1.f;
        if (AF32) { ss += __shfl_xor(ss, 16); ss += __shfl_xor(ss, 32); rstd = 1.0f / sqrtf(ss * (1.f / DM) + 1e-6f); }
#pragma unroll
        for (int r = 0; r < 4; ++r) { const int row = 4 * fq + r; const float rs = AF32 ? __shfl(rstd, row) : 1.f; f(row, cb * 16 + fr, acc[r] * rs); }
    }
}
struct MEpi1 { bf16_t* p; float* pn;
    __device__ __forceinline__ void operator()(int r, int col, float v) const {
        const int row = MROWS + r; const int g = col >> 9;
        if (g < 7) p[(size_t)row * PBW + col] = f2bf(v);
        else { const int o = col & 511; if (o < 296) pn[(size_t)row * PNW + o] = v; } } };
struct MEpiRes { float* hm; __device__ __forceinline__ void operator()(int r, int col, float v) const { float* h = hm + r * DM + col; *h = *h + v; } };
struct MEpi3 { bf16_t* raw; int ldr; __device__ __forceinline__ void operator()(int r, int col, float v) const { raw[(size_t)(MROWS + r) * ldr + col] = f2bf(v); } };

struct RwP { const float* mu; const float* w0; const float* w_up; const float* a0; const float* a_up; const float* g_up; };
struct RwS { const float* mu; const float* k_k; const float* k_a; const float* r_k; const float* gn_w; const float* gn_b; };
constexpr int RCH = 8;

__global__ void __launch_bounds__(NWAVES * 64, 2) mk_fwd(Args a) {
    extern __shared__ __attribute__((aligned(16))) unsigned char lds[];
    const int tid0 = threadIdx.x;
    const int G = gridDim.x, bid = blockIdx.x, ngw = G * NWAVES;
    for (int u = tid0; u < (LDS_BYTES - LDSCTL_OFF) / 4; u += NWAVES * 64) ((LAS unsigned*)((LAS unsigned char*)lds + LDSCTL_OFF))[u] = 0u;
    __syncthreads();
    unsigned char* ws = a.ws; float* out = a.out;
    XcdBarrier bar = xcd_barrier_post((unsigned*)(ws + WS_CTL) + CW_BAR, (volatile LAS unsigned*)((LAS unsigned char*)lds + MISC_OFF) + 8);
#define GRID_BAR() xcd_barrier(bar)
#define PHASE_IDS() int tid = tid0; asm volatile("" : "+v"(tid)); const int lane = tid & 63, wave = __builtin_amdgcn_readfirstlane(tid >> 6), gw = bid * NWAVES + wave; (void)lane; (void)gw
    const float* x = a.in[0]; const float* meta = a.in[1];
    float* hm = (float*)(ws + WS_HM); float* c2 = (float*)(ws + WS_C2); float* ssqp = (float*)(ws + WS_SSQ);
    bf16_t* hb = (bf16_t*)(ws + WS_HB); bf16_t* p = (bf16_t*)(ws + WS_P); float* pn = (float*)(ws + WS_PN); bf16_t* y = (bf16_t*)(ws + WS_Y);
    float* WE = (float*)(ws + WS_WE); float* ALR = (float*)(ws + WS_ALR); bf16_t* act = (bf16_t*)(ws + WS_ACT); bf16_t* raw = (bf16_t*)(ws + WS_RAW);
    LAS unsigned char* ldsl = (LAS unsigned char*)lds;

    {
        PHASE_IDS();
        float* scr = (float*)(lds + wave * 16384);
        constexpr int I1 = (DM / 64) * (N1 / 32), I2 = (DM / 64) * (DM / 32), I3 = (DM / 64) * (DFF2 / 32), I4 = (DFF / 64) * (DM / 32), IL = I1 + I2 + I3 + I4;
        for (int it = gw; it < DEPTH * IL; it += ngw) {
            const int l = it / IL; int r = it % IL;
            if (r < I1) { wprep_item(a.in[3] + (size_t)l * DM * N_IN, a.in[2] + l * DM, (bf16_t*)(ws + WS_W1) + (size_t)l * N1 * DM, DM, N_IN, N1, 1, r, scr, lane); continue; } r -= I1;
            if (r < I2) { wprep_item(a.in[18] + (size_t)l * DM * DM, nullptr, (bf16_t*)(ws + WS_W2) + (size_t)l * DM * DM, DM, DM, DM, 2, r, scr, lane); continue; } r -= I2;
            if (r < I3) { wprep_item(a.in[20] + (size_t)l * DM * DFF2, a.in[19] + l * DM, (bf16_t*)(ws + WS_W3) + (size_t)l * DFF2 * DM, DM, DFF2, DFF2, 3, r, scr, lane); continue; } r -= I3;
            wprep_item(a.in[23] + (size_t)l * DFF * DM, nullptr, (bf16_t*)(ws + WS_W4) + (size_t)l * DM * DFF, DFF, DM, DM, 4, r, scr, lane);
        }
        for (int row = gw; row < RROWS; row += ngw) {
            const f32x4* xr = (const f32x4*)(row < MROWS ? x + (size_t)row * DM : meta + (size_t)(row - MROWS) * DM) + lane;
            f32x4* hr = (f32x4*)(row < MROWS ? out + (size_t)row * DM : hm + (size_t)(row - MROWS) * DM) + lane;
            f32x4 v[4]; float s = 0.f;
#pragma unroll
            for (int j = 0; j < 4; ++j) { v[j] = xr[64 * j]; hr[64 * j] = v[j]; s += (v[j].x * v[j].x + v[j].y * v[j].y) + (v[j].z * v[j].z + v[j].w * v[j].w); }
            s = wave_sum(s);
            if (lane < 16) ssqp[(size_t)row * 16 + lane] = lane == 0 ? s : 0.f;
            u32x2* o8 = (u32x2*)(hb + (size_t)row * DM) + lane;
#pragma unroll
            for (int j = 0; j < 4; ++j) { u32x2 w; w.x = pk2bf(v[j].x, v[j].y); w.y = pk2bf(v[j].z, v[j].w); o8[64 * j] = w; }
        }
    }
    {
        u32x4* z = (u32x4*)(p + (size_t)RROWS * PBW); const size_t n16 = (size_t)(16512 - RROWS) * PBW * 2 / 16;
        for (size_t i = (size_t)bid * (NWAVES * 64) + tid0; i < n16; i += (size_t)G * (NWAVES * 64)) z[i] = (u32x4){0u, 0u, 0u, 0u};
    }
    cg::this_grid().sync();

#pragma unroll 1
    for (int l = 0; l < DEPTH; ++l) {
        const bf16_t* W1 = (const bf16_t*)(ws + WS_W1) + (size_t)l * N1 * DM; const bf16_t* W2 = (const bf16_t*)(ws + WS_W2) + (size_t)l * DM * DM;
        const bf16_t* W3 = (const bf16_t*)(ws + WS_W3) + (size_t)l * DFF2 * DM; const bf16_t* W4 = (const bf16_t*)(ws + WS_W4) + (size_t)l * DM * DFF;
        {
            PHASE_IDS();
            pg8::Gemm g{hb, W1, MROWS, N1, DM}; pg8::StaticOrder S; S.init(MROWS, N1, G, bid);
            pg8::Epi1 E{ssqp, p, pn};
            pg8::gemm_phase<pg8::Epi1, pg8::StaticOrder, true, true>(ldsl, g, S, E);
            meta_gemm<true>(hm, DM, W1, N1, DM, gw, ngw, lane, MEpi1{p, pn});
        }
        GRID_BAR();
        {
            PHASE_IDS();
            const RwP P{a.in[4] + l * 1824, a.in[5] + l * 512, a.in[6] + (size_t)l * 64 * 512, a.in[7] + l * 512, a.in[8] + (size_t)l * 64 * 512, a.in[9] + (size_t)l * 160 * 512};
            float (*s_in)[288] = (float (*)[288])lds;
            for (int grp = bid; grp < RROWS / 8; grp += G) {
                __syncthreads();
                const int row0 = grp * 8;
                for (int e = tid; e < 8 * 288; e += NWAVES * 64) {
                    const int rr = e / 288, j = e % 288, row = row0 + rr, pr = prevrow(row);
                    const float cur = pn[(size_t)row * PNW + j], prv = pr >= 0 ? pn[(size_t)pr * PNW + j] : 0.f;
                    const float s = cur + P.mu[1536 + j] * (prv - cur);
                    s_in[rr][j] = j < 64 ? tanhf(s) : (j < 128 ? s : sigmoidf_(s));
                }
                __syncthreads();
                const int c = tid;
                float zw[8], za[8], zg[8];
#pragma unroll
                for (int rr = 0; rr < 8; ++rr) { zw[rr] = P.w0[c]; za[rr] = P.a0[c]; zg[rr] = 0.f; }
                for (int j = 0; j < 64; ++j) { const float wu = P.w_up[j * 512 + c], au = P.a_up[j * 512 + c];
#pragma unroll
                    for (int rr = 0; rr < 8; ++rr) { zw[rr] += s_in[rr][j] * wu; za[rr] += s_in[rr][64 + j] * au; } }
                for (int j = 0; j < 160; ++j) { const float gu = P.g_up[j * 512 + c];
#pragma unroll
                    for (int rr = 0; rr < 8; ++rr) zg[rr] += s_in[rr][128 + j] * gu; }
#pragma unroll
                for (int rr = 0; rr < 8; ++rr) { const size_t o = (size_t)(row0 + rr) * 512 + c;
                    WE[o] = 0.6065306597126334f * sigmoidf_(zw[rr]);
                    ALR[o] = sigmoidf_(za[rr]);
                    y[(size_t)(row0 + rr) * DM + c] = f2bf(zg[rr]); }
            }
            const float* q_g = a.in[16] + l * 64; const float* k_g = a.in[17] + l * 64; const float* b_f = a.in[15] + l * 8;
            for (int it = gw; it < RROWS * NH; it += ngw) {
                const int row = it >> 3, h = it & 7;
                bf16_t* qp = p + (size_t)row * PBW + 1536 + h * 64 + lane; bf16_t* kp = p + (size_t)row * PBW + 2048 + h * 64 + lane;
                const float q = bf2f(*qp), k = bf2f(*kp);
                const float mq = wave_sum(q * q) * (1.f / 64.f), mk = wave_sum(k * k) * (1.f / 64.f);
                *qp = f2bf(q * (1.0f / sqrtf(mq + 1e-6f)) * q_g[lane] * (0.125f * LOG2E));
                *kp = f2bf(k * (1.0f / sqrtf(mk + 1e-6f)) * k_g[lane]);
            }
            if (gw < 64) {
                const int b = gw >> 3, h = gw & 7; constexpr int PER = 33;
                float loc[PER]; float s = 0.f;
#pragma unroll
                for (int i = 0; i < PER; ++i) { const int t = lane * PER + i; float v = 0.f;
                    if (t < LTOT) { const float z = pn[(size_t)rowof(b, t) * PNW + 288 + h] + b_f[h]; v = (fminf(z, 0.f) - log1pf(__expf(-fabsf(z)))) * LOG2E; }
                    s += v; loc[i] = s; }
                float incl = s;
#pragma unroll
                for (int o = 1; o < 64; o <<= 1) { const float n = __shfl_up(incl, o); if (lane >= o) incl += n; }
                const float base = incl - s;
                float* cv = c2 + (size_t)gw * 2176;
#pragma unroll
                for (int i = 0; i < PER; ++i) { const int t = lane * PER + i; if (t < LTOT) cv[t < NMETA ? t : t + 112] = base + loc[i]; }
                cv[16 + lane] = 1e5f; if (lane < 48) cv[80 + lane] = 1e5f;
            }
        }
        GRID_BAR();
        if (bid < 32) {
            PHASE_IDS();
            const RwS P{a.in[4] + l * 1824, a.in[10] + l * 512, a.in[11] + l * 512, a.in[12] + l * 512, a.in[13] + l * 512, a.in[14] + l * 512};
            const int half = tid >> 8, unit = bid * 2 + half, b = unit >> 3, h = unit & 7, t256 = tid & 255, w4 = t256 >> 6;
            unsigned char* base = lds + half * 16384;
            float (*s_vec)[5][64] = (float (*)[5][64])base;
            float (*s_v)[64] = (float (*)[64])(base + 10240); float* s_bonus = (float*)(base + 12288); float (*s_y)[64] = (float (*)[64])(base + 12544);
            const int vl = lane >> 2, kq = lane & 3, vrow = w4 * 16 + vl;
            float S[16];
#pragma unroll
            for (int i = 0; i < 16; ++i) S[i] = 0.f;
            for (int t0 = 0; t0 < LTOT; t0 += RCH) {
                for (int tt = w4; tt < RCH; tt += 4) {
                    const int t = t0 + tt;
                    const int row = rowof(b, t), pr = prevrow(row), c = h * 64 + lane;
                    const bf16_t* pc = p + (size_t)row * PBW; const bf16_t* pp = p + (size_t)(pr >= 0 ? pr : row) * PBW;
                    const float hp = pr >= 0 ? 1.f : 0.f;
                    float r = bf2f(pc[c]), k = bf2f(pc[512 + c]), v = bf2f(pc[1024 + c]);
                    r += P.mu[c] * (hp * bf2f(pp[c]) - r); k += P.mu[512 + c] * (hp * bf2f(pp[512 + c]) - k); v += P.mu[1024 + c] * (hp * bf2f(pp[1024 + c]) - v);
                    const float we = WE[(size_t)row * 512 + c], alr = ALR[(size_t)row * 512 + c];
                    float kk = k * P.k_k[c]; const float nrm = sqrtf(wave_sum(kk * kk)); kk = kk / fmaxf(nrm, 1e-12f);
                    const float kp = k * (1.f + (alr - 1.f) * P.k_a[c]);
                    const float bon = wave_sum(r * kp * P.r_k[c]);
                    s_vec[tt][0][lane] = r; s_vec[tt][1][lane] = __expf(-we); s_vec[tt][2][lane] = kp; s_vec[tt][3][lane] = -kk; s_vec[tt][4][lane] = kk * alr;
                    s_v[tt][lane] = v; if (lane == 0) s_bonus[tt] = bon;
                }
                __syncthreads();
                for (int tt = 0; tt < RCH; ++tt) {
                    const f32x4* vr = (const f32x4*)&s_vec[tt][0][16 * kq]; const f32x4* vw = (const f32x4*)&s_vec[tt][1][16 * kq];
                    const f32x4* vk = (const f32x4*)&s_vec[tt][2][16 * kq]; const f32x4* va = (const f32x4*)&s_vec[tt][3][16 * kq]; const f32x4* vb = (const f32x4*)&s_vec[tt][4][16 * kq];
                    const float vv = s_v[tt][vrow];
                    float sa = 0.f;
#pragma unroll
                    for (int q = 0; q < 4; ++q) { const f32x4 a4 = va[q]; sa += S[4 * q] * a4.x + S[4 * q + 1] * a4.y + S[4 * q + 2] * a4.z + S[4 * q + 3] * a4.w; }
                    sa += __shfl_xor(sa, 1); sa += __shfl_xor(sa, 2);
                    float yy = 0.f;
#pragma unroll
                    for (int q = 0; q < 4; ++q) { const f32x4 w4v = vw[q], b4 = vb[q], k4 = vk[q], r4 = vr[q];
                        S[4 * q] = S[4 * q] * w4v.x + sa * b4.x + vv * k4.x; S[4 * q + 1] = S[4 * q + 1] * w4v.y + sa * b4.y + vv * k4.y;
                        S[4 * q + 2] = S[4 * q + 2] * w4v.z + sa * b4.z + vv * k4.z; S[4 * q + 3] = S[4 * q + 3] * w4v.w + sa * b4.w + vv * k4.w;
                        yy += S[4 * q] * r4.x + S[4 * q + 1] * r4.y + S[4 * q + 2] * r4.z + S[4 * q + 3] * r4.w; }
                    yy += __shfl_xor(yy, 1); yy += __shfl_xor(yy, 2);
                    if (kq == 0) s_y[tt][vrow] = yy;
                }
                __syncthreads();
                for (int tt = w4; tt < RCH; tt += 4) {
                    const int t = t0 + tt; const int row = rowof(b, t), c = h * 64 + lane;
                    const float yv = s_y[tt][lane];
                    const float mean = wave_sum(yv) * (1.f / 64.f); const float d = yv - mean; const float var = wave_sum(d * d) * (1.f / 64.f);
                    float o = d * (1.0f / sqrtf(var + 64e-5f)) * P.gn_w[c] + P.gn_b[c];
                    o += s_bonus[tt] * s_v[tt][lane];
                    if (t >= NMETA || b == 0) { bf16_t* yp = y + (size_t)row * DM + c; *yp = f2bf(o * bf2f(*yp)); }
                }
                __syncthreads();
            }
        }
        {
            PHASE_IDS();
            if (gw < NH * NMETA) {
                const int h = gw >> 4, t = gw & 15;
                const bf16_t* qrow = p + (size_t)(MROWS + t) * PBW + 1536 + h * 64;
                float s = -INFINITY;
                if (lane <= t) { const bf16_t* kr = p + (size_t)(MROWS + lane) * PBW + 2048 + h * 64; float d = 0.f;
                    for (int e = 0; e < 64; ++e) d += bf2f(qrow[e]) * bf2f(kr[e]);
                    s = d - c2[(size_t)h * 2176 + lane]; }
                const float mx = wave_max(s); const float e = lane <= t ? exp2f(s - mx) : 0.f; const float sum = wave_sum(e);
                float o = 0.f;
                for (int j = 0; j <= t; ++j) o += __shfl(e, j) * bf2f(p[(size_t)(MROWS + j) * PBW + 2560 + h * 64 + lane]);
                o /= sum;
                const float og = bf2f(p[(size_t)(MROWS + t) * PBW + 3072 + h * 64 + lane]);
                y[(size_t)(MROWS + t) * DM + 512 + h * 64 + lane] = f2bf(o * sigmoidf_(og));
            }
        }
        __syncthreads();
        {
            typedef attn_body::bf16 abf;
            const attn_body::AttnTensors AT{(const abf*)(p + 1536), (const abf*)(p + 2048), (const abf*)(p + 2560), (const abf*)(p + 3072), c2, (abf*)(y + 512)};
            const attn_body::StaticOrder S(G, bid);
            attn_body::attn_phase<attn_body::StaticOrder>((char*)lds, AT, S);
        }
        GRID_BAR();
        {
            PHASE_IDS();
            pg8::Gemm g{y, W2, MROWS, DM, DM}; pg8::StaticOrder S; S.init(MROWS, DM, G, bid);
            pg8::EpiRes E{out, hb, ssqp};
            pg8::gemm_phase<pg8::EpiRes, pg8::StaticOrder, true, true>(ldsl, g, S, E);
            meta_gemm<false>(y + (size_t)MROWS * DM, DM, W2, DM, DM, gw, ngw, lane, MEpiRes{hm});
        }
        GRID_BAR();
        for (int t0 = 0; t0 < 22; t0 += 6) {
            const int nt = (22 - t0) < 6 ? (22 - t0) : 6, ldr = nt * 256;
            {
                PHASE_IDS();
                pg8::Gemm g{hb, W3 + (size_t)t0 * 256 * DM, MROWS, ldr, DM}; pg8::StaticOrder S; S.init(MROWS, ldr, G, bid);
                pg8::Epi3Raw E{ssqp, raw, ldr};
                pg8::gemm_phase<pg8::Epi3Raw, pg8::StaticOrder, true, true>(ldsl, g, S, E);
                meta_gemm<true>(hm, DM, W3 + (size_t)t0 * 256 * DM, ldr, DM, gw, ngw, lane, MEpi3{raw, ldr});
            }
            GRID_BAR();
            {
                PHASE_IDS();
                const float* cw = a.in[21] + (size_t)l * 3 * DFF2; const float* cb = a.in[22] + (size_t)l * DFF2;
                const int per_row = nt * 128; const size_t total = (size_t)RROWS * per_row;
                for (size_t e = (size_t)bid * (NWAVES * 64) + tid; e < total; e += (size_t)G * (NWAVES * 64)) {
                    const int row = (int)(e / per_row), jj = (int)(e % per_row), tl = jj >> 7, c = jj & 127;
                    const int ch = 128 * (t0 + tl) + c;
                    const int p1 = prevrow(row), p2 = p1 >= 0 ? prevrow(p1) : -1;
                    const int cu = tl * 256 + c, cgt = cu + 128;
                    float u = cb[ch] + cw[2 * DFF2 + ch] * bf2f(raw[(size_t)row * ldr + cu]);
                    float g = cb[DFF + ch] + cw[2 * DFF2 + DFF + ch] * bf2f(raw[(size_t)row * ldr + cgt]);
                    if (p1 >= 0) { u += cw[DFF2 + ch] * bf2f(raw[(size_t)p1 * ldr + cu]); g += cw[DFF2 + DFF + ch] * bf2f(raw[(size_t)p1 * ldr + cgt]); }
                    if (p2 >= 0) { u += cw[ch] * bf2f(raw[(size_t)p2 * ldr + cu]); g += cw[DFF + ch] * bf2f(raw[(size_t)p2 * ldr + cgt]); }
                    act[(size_t)row * DFF + ch] = f2bf(g * sigmoidf_(g) * u);
                }
            }
            GRID_BAR();
        }
        {
            PHASE_IDS();
            pg8::Gemm g{act, W4, MROWS, DM, DFF}; pg8::StaticOrder S; S.init(MROWS, DM, G, bid);
            pg8::EpiRes E{out, hb, ssqp};
            pg8::gemm_phase<pg8::EpiRes, pg8::StaticOrder, true, true>(ldsl, g, S, E);
            meta_gemm<false>(act + (size_t)MROWS * DFF, DFF, W4, DM, DFF, gw, ngw, lane, MEpiRes{hm});
        }
        if (l + 1 < DEPTH) GRID_BAR();
    }
}

extern "C" void kernel_launch(void* const* d_in, const int* in_sizes, int n_in, void* d_out, int out_size, void* d_ws, size_t ws_size, hipStream_t stream) {
    static int grid = 0;
    if (grid == 0) {
        if (n_in != 24 || out_size != MROWS * DM || ws_size < WS_END) { fprintf(stderr, "kernel_launch: unexpected shapes (n_in %d out %d ws %zu)\n", n_in, out_size, ws_size); grid = -1; return; }
        int dev = 0, cus = 0, per_cu = 0;
        hipGetDevice(&dev); hipDeviceGetAttribute(&cus, hipDeviceAttributeMultiprocessorCount, dev);
        if (hipFuncSetAttribute((const void*)mk_fwd, hipFuncAttributeMaxDynamicSharedMemorySize, LDS_BYTES) != hipSuccess) { fprintf(stderr, "kernel_launch: hipFuncSetAttribute failed\n"); grid = -1; return; }
        hipOccupancyMaxActiveBlocksPerMultiprocessor(&per_cu, (const void*)mk_fwd, NWAVES * 64, LDS_BYTES);
        (void)hipGetLastError();
        if (per_cu < 1) { fprintf(stderr, "kernel_launch: occupancy query says %d blocks per CU\n", per_cu); }
        grid = cus;
    }
    if (grid < 0) return;
    hipMemsetAsync((char*)d_ws + WS_CTL, 0, CTL_ZERO_BYTES, stream);
    Args a{};
    for (int i = 0; i < 24; ++i) a.in[i] = (const float*)d_in[i];
    a.out = (float*)d_out; a.ws = (unsigned char*)d_ws;
    void* args[] = {&a};
    hipError_t e = hipLaunchCooperativeKernel((const void*)mk_fwd, dim3(grid), dim3(NWAVES * 64), args, LDS_BYTES, stream);
    if (e != hipSuccess) fprintf(stderr, "cooperative launch failed: %s (grid %d)\n", hipGetErrorString(e), grid);
}
```

```cpp
#include <hip/hip_runtime.h>
#include <hip/hip_cooperative_groups.h>
#include <stdint.h>
#include <cstdio>
namespace cg = cooperative_groups;

typedef unsigned short bf16_t;
typedef short bf16x8 __attribute__((ext_vector_type(8)));
typedef float f32x4 __attribute__((ext_vector_type(4)));
typedef unsigned u32x4 __attribute__((ext_vector_type(4)));
typedef unsigned u32x2 __attribute__((ext_vector_type(2)));

constexpr int NB = 8, SEQ = 2048, NMETA = 16, LTOT = 2064, DM = 1024, DEPTH = 4, NH = 8, HD = 64;
constexpr int N_IN = 3880, DFF = 2816, DFF2 = 5632;
constexpr int MROWS = NB * SEQ;
constexpr int RROWS = MROWS + NMETA;
constexpr int N1 = 4096;
constexpr int PBW = 3584;
constexpr int PNW = 320;
constexpr float LOG2E = 1.4426950408889634f;

constexpr size_t MiB = 1u << 20;
constexpr size_t WS_CTL = 0, CTL_ZERO_BYTES = 1 * MiB;
constexpr size_t WS_W = 1 * MiB, WL_BYTES = 27 * MiB;
constexpr size_t WO_W1 = 0;
constexpr size_t WO_W2 = 8 * MiB;
constexpr size_t WO_W3 = 10 * MiB;
constexpr size_t WO_W4 = 21 * MiB;
constexpr size_t WO_LUP = 26 * MiB + 512 * 1024;
constexpr size_t WS_SMALL = WS_W + 2 * WL_BYTES;
constexpr size_t WS_HM = WS_SMALL;
constexpr size_t WS_C2 = WS_SMALL + 1 * MiB;
constexpr size_t WS_SSQ = WS_SMALL + 3 * MiB;
constexpr size_t WS_HB = WS_SMALL + 6 * MiB;
constexpr size_t WS_P = WS_HB + 33 * MiB;
constexpr size_t WS_PN = WS_P + 113 * MiB;
constexpr size_t WS_Y = WS_PN + 21 * MiB;
constexpr size_t WS_FREE = WS_Y + 33 * MiB;
constexpr int NCH = 129;
constexpr size_t RA_BYTES = 8192, RB_BYTES = 4096;
constexpr size_t WS_RA = WS_FREE;
constexpr size_t WS_RB = WS_HB;
constexpr size_t WS_ACT = WS_P;
constexpr size_t WS_RAW = WS_PN;
constexpr size_t WS_END = WS_RA + 65 * MiB;

__device__ __forceinline__ float bf2f(bf16_t v) { return __uint_as_float(((unsigned)v) << 16); }
__device__ __forceinline__ bf16_t f2bf(float f) { unsigned u = __float_as_uint(f); return (bf16_t)((u + 0x7fffu + ((u >> 16) & 1u)) >> 16); }
__device__ __forceinline__ unsigned pk2bf(float lo, float hi) { return (unsigned)f2bf(lo) | ((unsigned)f2bf(hi) << 16); }
__device__ __forceinline__ float sigmoidf_(float x) { return 1.f / (1.f + __expf(-x)); }
__device__ __forceinline__ float wave_sum(float v) {
#pragma unroll
    for (int o = 1; o < 64; o <<= 1) v += __shfl_xor(v, o);
    return v;
}
__device__ __forceinline__ float wave_max(float v) {
#pragma unroll
    for (int o = 1; o < 64; o <<= 1) v = fmaxf(v, __shfl_xor(v, o));
    return v;
}
#define WAVE_LDS_SYNC() do { __builtin_amdgcn_s_waitcnt(0xc07f); __builtin_amdgcn_wave_barrier(); } while (0)
__device__ __forceinline__ int rowof(int b, int t) { return t < NMETA ? MROWS + t : b * SEQ + (t - NMETA); }
__device__ __forceinline__ int prevrow(int row) {
    if (row >= MROWS) return row == MROWS ? -1 : row - 1;
    return (row & (SEQ - 1)) ? row - 1 : MROWS + NMETA - 1;
}

__device__ __forceinline__ int src_col(int mode, int n) {
    if (mode == 1) {
        const int g = n >> 9, o = n & 511;
        switch (g) {
            case 0: return o;
            case 1: return 512 + o;
            case 2: return 1024 + o;
            case 3: return 1824 + o;
            case 4: return 2336 + o;
            case 5: return 2848 + o;
            case 6: return 3360 + o;
            default:
                if (o < 64) return 1536 + o;
                if (o < 128) return 1600 + (o - 64);
                if (o < 288) return 1664 + (o - 128);
                if (o < 296) return 3872 + (o - 288);
                return -1;
        }
    }
    if (mode == 3) { const int t = n >> 8, c = n & 255; return c < 128 ? 128 * t + c : DFF + 128 * t + (c - 128); }
    return n;
}
__device__ __forceinline__ void wprep_item(const float* W, const float* gk, bf16_t* WT, int K, int Nsrc, int Ndst, int mode, int item, float* scr, int lane) {
    const int nblk = Ndst / 32, kb = item / nblk, nb = item % nblk, k0 = 64 * kb, n0 = 32 * nb;
    const int sc = src_col(mode, n0 + (lane & 31));
#pragma unroll 8
    for (int i = 0; i < 32; ++i) {
        const int kk = 2 * i + (lane >> 5);
        float v = 0.f;
        if (sc >= 0) { v = W[(size_t)(k0 + kk) * Nsrc + sc]; if (gk) v *= gk[k0 + kk]; }
        scr[kk * 33 + (lane & 31)] = v;
    }
    WAVE_LDS_SYNC();
    const int c = lane & 7;
#pragma unroll
    for (int j = 0; j < 4; ++j) {
        const int n = (lane >> 3) + 8 * j; const float* s = scr + (8 * c) * 33 + n;
        u32x4 o;
        o.x = pk2bf(s[0 * 33], s[1 * 33]); o.y = pk2bf(s[2 * 33], s[3 * 33]); o.z = pk2bf(s[4 * 33], s[5 * 33]); o.w = pk2bf(s[6 * 33], s[7 * 33]);
        *(u32x4*)(WT + (size_t)(n0 + n) * K + k0 + 8 * c) = o;
    }
    WAVE_LDS_SYNC();
}
namespace pg8 {
#define PG8_LAS __attribute__((address_space(3)))
typedef unsigned short bf16_t;
typedef short bf16x8 __attribute__((ext_vector_type(8)));
typedef float f32x4 __attribute__((ext_vector_type(4)));
typedef unsigned u32x4 __attribute__((ext_vector_type(4)));
constexpr int BM = 256, BK = 64, HALF = 128, HTB = HALF * BK * 2  , STAGE_BYTES = 8 * HTB, NXCD = 8, WGM = 8;

__host__ __device__ __forceinline__ int lds_byte(int r, int c) { const int st = (r >> 4) * 2 + (c >> 5), rr = r & 15, cc = c & 31, ob = rr * 64 + cc * 2; return st * 1024 + (ob ^ (((ob >> 9) & 1) << 5)); }
__host__ __device__ __forceinline__ void stage_rc(int b, int& R, int& C) { const int st = b / 1024, sb = b % 1024, swz = sb ^ (((sb >> 9) & 1) << 5); R = (st >> 1) * 16 + swz / 64; C = (st & 1) * 32 + (swz % 64) / 2; }
__host__ __device__ __forceinline__ int perm32(int rho) { const int n = rho >> 4, i = rho & 15; return 8 * (i >> 2) + 4 * n + (i & 3); }

struct Unit { int pm, pn; };
struct Gemm { const bf16_t* A; const bf16_t* Bt; int M, N, K; };

struct StaticOrder {
    int nM, nN, nwg, G, c;
    __host__ __device__ void init(int M, int N, int G_, int c_) { nM = M / BM; nN = N / BM; nwg = nM * nN; G = G_; c = c_; }
    __host__ __device__ bool next(int i, Unit& u) const {
        const long L = (long)i * G + c; if (L >= nwg) return false;
        int wgid = (int)L; { const int q = nwg / NXCD, r = nwg % NXCD, xcd = wgid % NXCD, off = wgid / NXCD; wgid = (xcd < r ? xcd * (q + 1) : r * (q + 1) + (xcd - r) * q) + off; }
        const int nig = WGM * nN, gid = wgid / nig, fm = gid * WGM, gsz = (nM - fm) < WGM ? (nM - fm) : WGM;
        u.pm = fm + ((wgid % nig) % gsz); u.pn = (wgid % nig) / gsz; return true;
    }
    __device__ __forceinline__ void a_ready(const Unit&) const {}
    __device__ __forceinline__ void done(const Unit&) const {}
};

__device__ __forceinline__ float row_rstd(const float* ssqp, int row) {
    const f32x4* sp = (const f32x4*)(ssqp + (size_t)row * 16);
    const f32x4 a = sp[0], b = sp[1], c = sp[2], d = sp[3];
    const float s = (((a.x + a.y) + (a.z + a.w)) + ((b.x + b.y) + (b.z + b.w))) + (((c.x + c.y) + (c.z + c.w)) + ((d.x + d.y) + (d.z + d.w)));
    return 1.0f / sqrtf(s * (1.f / 1024.f) + 1e-6f);
}
struct Epi1 {
    static constexpr bool PERM = false, AFTER_DRAIN = false;
    const float* ssqp; bf16_t* p; float* pn;
    __device__ __forceinline__ void operator()(const f32x4 (&acc)[2][2][4][2], const Unit& u, int wr, int wc, int fr, int fq) const {
        const int row0 = u.pm * BM + wr * 64 + fr, col0 = u.pn * BM + wc * 32 + 4 * fq;
#pragma unroll
        for (int ai = 0; ai < 2; ++ai)
#pragma unroll
            for (int m = 0; m < 4; ++m) {
                const int row = row0 + ai * HALF + m * 16; const float rs = row_rstd(ssqp, row);
#pragma unroll
                for (int bj = 0; bj < 2; ++bj)
#pragma unroll
                    for (int n = 0; n < 2; ++n) {
                        const f32x4 v = acc[ai][bj][m][n] * rs; const int col = col0 + bj * HALF + n * 16;
                        if (u.pn < 14) { u32x2 w; w.x = pk2bf(v[0], v[1]); w.y = pk2bf(v[2], v[3]); *(u32x2*)(p + (size_t)row * PBW + col) = w; }
                        else { const int o = col - PBW; if (o < 296) *(f32x4*)(pn + (size_t)row * PNW + o) = v; }
                    }
            }
    }
};
struct EpiRes {
    static constexpr bool PERM = false, AFTER_DRAIN = false;
    float* h; bf16_t* hb; float* ssqp;
    __device__ __forceinline__ void operator()(const f32x4 (&acc)[2][2][4][2], const Unit& u, int wr, int wc, int fr, int fq) const {
        const int row0 = u.pm * BM + wr * 64 + fr, col0 = u.pn * BM + wc * 32 + 4 * fq;
#pragma unroll
        for (int ai = 0; ai < 2; ++ai)
#pragma unroll
            for (int m = 0; m < 4; ++m) {
                const int row = row0 + ai * HALF + m * 16; float ss = 0.f;
#pragma unroll
                for (int bj = 0; bj < 2; ++bj)
#pragma unroll
                    for (int n = 0; n < 2; ++n) {
                        const int col = col0 + bj * HALF + n * 16; float* hp = h + (size_t)row * DM + col;
                        const f32x4 v = *(const f32x4*)hp + acc[ai][bj][m][n];
                        *(f32x4*)hp = v; u32x2 w; w.x = pk2bf(v[0], v[1]); w.y = pk2bf(v[2], v[3]); *(u32x2*)(hb + (size_t)row * DM + col) = w;
                        ss += (v[0] * v[0] + v[1] * v[1]) + (v[2] * v[2] + v[3] * v[3]);
                    }
                ss += __shfl_xor(ss, 16); ss += __shfl_xor(ss, 32);
                if (fq == 0) ssqp[(size_t)row * 16 + u.pn * 4 + wc] = ss;
            }
    }
};
struct Epi3Raw {
    static constexpr bool PERM = false, AFTER_DRAIN = false;
    const float* ssqp; bf16_t* raw; int ldr;
    __device__ __forceinline__ void operator()(const f32x4 (&acc)[2][2][4][2], const Unit& u, int wr, int wc, int fr, int fq) const {
        const int row0 = u.pm * BM + wr * 64 + fr, col0 = u.pn * BM + wc * 32 + 4 * fq;
#pragma unroll
        for (int ai = 0; ai < 2; ++ai)
#pragma unroll
            for (int m = 0; m < 4; ++m) {
                const int row = row0 + ai * HALF + m * 16; const float rs = row_rstd(ssqp, row);
#pragma unroll
                for (int bj = 0; bj < 2; ++bj)
#pragma unroll
                    for (int n = 0; n < 2; ++n) {
                        const f32x4 v = acc[ai][bj][m][n] * rs; const int col = col0 + bj * HALF + n * 16;
                        u32x2 w; w.x = pk2bf(v[0], v[1]); w.y = pk2bf(v[2], v[3]); *(u32x2*)(raw + (size_t)row * ldr + col) = w;
                    }
            }
    }
};

template <class Epi, class Sched, bool ALIGN_EPI = false, bool SP2 = false>
__device__ __forceinline__ void gemm_phase(PG8_LAS unsigned char* lds, const Gemm g, const Sched& S, const Epi& E) {
    int tid_ = threadIdx.x; asm volatile("" : "+v"(tid_));
    const int tid = tid_, wid = __builtin_amdgcn_readfirstlane(tid >> 6), lane = tid & 63, wr = wid >> 2, wc = wid & 3, fr = lane & 15, fq = lane >> 4;
    const int K = g.K, nt = K / BK;
    unsigned voffA[2], voffB[2];
#pragma unroll
    for (int i = 0; i < 2; ++i) { int R, C; stage_rc(tid * 16 + i * 8192, R, C); const int Rb = Epi::PERM ? ((R & ~31) + perm32(R & 31)) : R;
        voffA[i] = (unsigned)(R * K + C) * 2u; voffB[i] = (unsigned)(Rb * K + C) * 2u; }
    const size_t kstep = (size_t)(BK * 2);
    const size_t hstep = (size_t)HALF * K * 2;
    const size_t tstep = 2 * hstep;
    const unsigned ldsw = (unsigned)wid * 1024u;
    const int aoff = lds_byte(wr * 64 + fr, fq * 8), boff = lds_byte(wc * 32 + fr, fq * 8);
#define PG8_SA(b, h) (((b) * 2 + (h)) * HTB)
#define PG8_SB(b, h) ((4 + (b) * 2 + (h)) * HTB)
#define PG8_STAGE(bufoff, gbase, voff) do { _Pragma("unroll") for (int _i = 0; _i < 2; ++_i) \
        __builtin_amdgcn_global_load_lds((const unsigned*)((const char*)(gbase) + (voff)[_i]), (PG8_LAS unsigned*)(lds + (bufoff) + ldsw + _i * 8192), 16, 0, 0); } while (0)
#define PG8_LDA(dst, b, h) do { _Pragma("unroll") for (int m = 0; m < 4; ++m) _Pragma("unroll") for (int k = 0; k < 2; ++k) dst[m][k] = *(const PG8_LAS bf16x8*)(lds + PG8_SA(b, h) + aoff + m * 2048 + k * 1024); } while (0)
#define PG8_LDB(dst, b, h) do { _Pragma("unroll") for (int n = 0; n < 2; ++n) _Pragma("unroll") for (int k = 0; k < 2; ++k) dst[n][k] = *(const PG8_LAS bf16x8*)(lds + PG8_SB(b, h) + boff + n * 2048 + k * 1024); } while (0)
#define PG8_MMA(ai, bj, At, Bt) do { __builtin_amdgcn_s_setprio(1); _Pragma("unroll") for (int m = 0; m < 4; ++m) _Pragma("unroll") for (int n = 0; n < 2; ++n) _Pragma("unroll") for (int k = 0; k < 2; ++k) \
        acc[ai][bj][m][n] = __builtin_amdgcn_mfma_f32_16x16x32_bf16(Bt[n][k], At[m][k], acc[ai][bj][m][n], 0, 0, 0); __builtin_amdgcn_s_setprio(0); } while (0)
#define PG8_WAIT_V(n) asm volatile("s_waitcnt vmcnt(" #n ")" ::: "memory")
#define PG8_WAIT_L(n) asm volatile("s_waitcnt lgkmcnt(" #n ")" ::: "memory")
#define PG8_BAR __builtin_amdgcn_s_barrier()
#define PG8_SCHED __builtin_amdgcn_sched_barrier(0)
    Unit cur, nxt; int ui = 0;
    if (!S.next(0, cur)) return;
    f32x4 acc[2][2][4][2];
#pragma unroll
    for (int a = 0; a < 2; ++a)
#pragma unroll
        for (int b = 0; b < 2; ++b)
#pragma unroll
            for (int m = 0; m < 4; ++m)
#pragma unroll
                for (int n = 0; n < 2; ++n) acc[a][b][m][n] = (f32x4){0.f, 0.f, 0.f, 0.f};
    bf16x8 At[4][2], B0[2][2], B1[2][2];
    const char* cA = (const char*)g.A + (size_t)cur.pm * tstep; const char* cB = (const char*)g.Bt + (size_t)cur.pn * tstep;
    S.a_ready(cur);
    if constexpr (SP2) {
        PG8_STAGE(PG8_SB(0, 0), cB, voffB); PG8_STAGE(PG8_SB(0, 1), cB + hstep, voffB); PG8_STAGE(PG8_SA(0, 0), cA, voffA); PG8_STAGE(PG8_SA(0, 1), cA + hstep, voffA);
        if (wr == 1) PG8_BAR;
        PG8_WAIT_V(2); PG8_BAR;
        PG8_STAGE(PG8_SB(1, 0), cB + kstep, voffB); PG8_STAGE(PG8_SA(1, 0), cA + kstep, voffA); PG8_STAGE(PG8_SB(1, 1), cB + hstep + kstep, voffB);
        PG8_WAIT_V(6); PG8_BAR;
    } else {
        PG8_STAGE(PG8_SB(0, 0), cB, voffB); PG8_STAGE(PG8_SA(0, 0), cA, voffA); PG8_STAGE(PG8_SB(0, 1), cB + hstep, voffB); PG8_STAGE(PG8_SA(0, 1), cA + hstep, voffA);
        if (wr == 1) PG8_BAR;
        PG8_WAIT_V(4); PG8_BAR;
        PG8_STAGE(PG8_SB(1, 0), cB + kstep, voffB); PG8_STAGE(PG8_SA(1, 0), cA + kstep, voffA); PG8_STAGE(PG8_SB(1, 1), cB + hstep + kstep, voffB);
        PG8_WAIT_V(6); PG8_BAR;
    }
    for (;;) {
        const bool has_next = S.next(ui + 1, nxt);
        const char* nA = has_next ? (const char*)g.A + (size_t)nxt.pm * tstep : cA; const char* nB = has_next ? (const char*)g.Bt + (size_t)nxt.pn * tstep : cB;
        for (int t = 0; t < nt; t += 2) {
            const bool last = (t == nt - 2);
            const char* a1 = cA + (size_t)(t + 1) * kstep;
            const char* a2 = last ? nA : cA + (size_t)(t + 2) * kstep; const char* b2 = last ? nB : cB + (size_t)(t + 2) * kstep;
            const char* a3 = a2 + kstep; const char* b3 = b2 + kstep;
            if (last && has_next) S.a_ready(nxt);
            if constexpr (SP2) {
            PG8_LDB(B0, 0, 0); PG8_LDB(B1, 0, 1); PG8_SCHED; PG8_LDA(At, 0, 0); PG8_STAGE(PG8_SA(1, 1), a1 + hstep, voffA);
            PG8_WAIT_V(8); PG8_WAIT_L(0); PG8_BAR; PG8_MMA(0, 0, At, B0); PG8_MMA(0, 1, At, B1); PG8_BAR; PG8_SCHED;
            PG8_LDA(At, 0, 1); PG8_STAGE(PG8_SB(0, 0), b2, voffB); PG8_STAGE(PG8_SB(0, 1), b2 + hstep, voffB); PG8_STAGE(PG8_SA(0, 0), a2, voffA);
            PG8_WAIT_V(8); PG8_WAIT_L(0); PG8_BAR; PG8_MMA(1, 0, At, B0); PG8_MMA(1, 1, At, B1); PG8_BAR; PG8_SCHED;
            PG8_LDB(B0, 1, 0); PG8_LDB(B1, 1, 1); PG8_SCHED; PG8_LDA(At, 1, 0); PG8_STAGE(PG8_SA(0, 1), a2 + hstep, voffA);
            PG8_WAIT_V(8); PG8_WAIT_L(0); PG8_BAR; PG8_MMA(0, 0, At, B0); PG8_MMA(0, 1, At, B1); PG8_BAR; PG8_SCHED;
            PG8_LDA(At, 1, 1); PG8_STAGE(PG8_SB(1, 0), b3, voffB); PG8_STAGE(PG8_SB(1, 1), b3 + hstep, voffB); PG8_STAGE(PG8_SA(1, 0), a3, voffA);
            PG8_WAIT_V(8); PG8_WAIT_L(0); PG8_BAR; PG8_MMA(1, 0, At, B0); PG8_MMA(1, 1, At, B1); PG8_BAR; PG8_SCHED;
            } else {
            PG8_LDB(B0, 0, 0); PG8_SCHED; PG8_LDA(At, 0, 0); PG8_STAGE(PG8_SA(1, 1), a1 + hstep, voffA);
            PG8_WAIT_L(8); PG8_BAR; PG8_WAIT_L(0); PG8_MMA(0, 0, At, B0); PG8_BAR; PG8_SCHED;
            PG8_LDB(B1, 0, 1); PG8_STAGE(PG8_SB(0, 0), b2, voffB);
            PG8_BAR; PG8_WAIT_L(0); PG8_MMA(0, 1, At, B1); PG8_BAR;
            PG8_LDA(At, 0, 1); PG8_STAGE(PG8_SA(0, 0), a2, voffA);
            PG8_BAR; PG8_WAIT_L(0); PG8_MMA(1, 0, At, B0); PG8_BAR; PG8_SCHED;
            PG8_STAGE(PG8_SB(0, 1), b2 + hstep, voffB);
            PG8_WAIT_V(6); PG8_BAR; PG8_MMA(1, 1, At, B1); PG8_BAR;
            PG8_LDB(B0, 1, 0); PG8_SCHED; PG8_LDA(At, 1, 0); PG8_STAGE(PG8_SA(0, 1), a2 + hstep, voffA);
            PG8_WAIT_L(8); PG8_BAR; PG8_WAIT_L(0); PG8_MMA(0, 0, At, B0); PG8_BAR; PG8_SCHED;
            PG8_LDB(B1, 1, 1); PG8_STAGE(PG8_SB(1, 0), b3, voffB);
            PG8_BAR; PG8_WAIT_L(0); PG8_MMA(0, 1, At, B1); PG8_BAR;
            PG8_LDA(At, 1, 1); PG8_STAGE(PG8_SA(1, 0), a3, voffA);
            PG8_BAR; PG8_WAIT_L(0); PG8_MMA(1, 0, At, B0); PG8_BAR; PG8_SCHED;
            PG8_STAGE(PG8_SB(1, 1), b3 + hstep, voffB);
            PG8_WAIT_V(6); PG8_BAR; PG8_MMA(1, 1, At, B1); PG8_BAR;
            }
        }
        if constexpr (ALIGN_EPI) { if (wr == 0) PG8_BAR; }
        if constexpr (!Epi::AFTER_DRAIN) { E(acc, cur, wr, wc, fr, fq); S.done(cur); }
        if (!has_next) break;
#pragma unroll
        for (int a = 0; a < 2; ++a)
#pragma unroll
            for (int b = 0; b < 2; ++b)
#pragma unroll
                for (int m = 0; m < 4; ++m)
#pragma unroll
                    for (int n = 0; n < 2; ++n) acc[a][b][m][n] = (f32x4){0.f, 0.f, 0.f, 0.f};
        cur = nxt; cA = nA; cB = nB; ++ui;
        if constexpr (ALIGN_EPI) { if (wr == 1) PG8_BAR; }
    }
    PG8_WAIT_V(0);
    if constexpr (!ALIGN_EPI) { if (wr == 0) PG8_BAR; }
    PG8_BAR;
    if constexpr (Epi::AFTER_DRAIN) { E.fused(acc, cur, wr, wc, fr, fq, lds, wid, lane); S.done(cur); }
#undef PG8_SA
#undef PG8_SB
#undef PG8_STAGE
#undef PG8_LDA
#undef PG8_LDB
#undef PG8_MMA
#undef PG8_WAIT_V
#undef PG8_WAIT_L
#undef PG8_BAR
#undef PG8_SCHED
}
}
#include <hip/hip_bf16.h>
#include <cmath>
namespace attn_body {
using bf16=__hip_bfloat16;
using bf16x8=__attribute__((ext_vector_type(8)))short;
using s16x4=__attribute__((ext_vector_type(4)))short;
using f32x16=__attribute__((ext_vector_type(16)))float;
using u32x4=__attribute__((ext_vector_type(4)))unsigned;
constexpr int BATCH=8,NHEAD=8,SEQ=2048,D=64,PITCH=3584,OPITCH=1024,LEADROW=16384,VK=2176;
constexpr int NW=8,QBLK=32,QB=QBLK*NW,KVBLK=64,NQB=SEQ/QB;
constexpr int ATTN_UNIT_ROWS=QB;
__device__ __forceinline__ int crow(int r,int hi){return (r&3)+8*(r>>2)+4*hi;}
#define SBAR() __builtin_amdgcn_sched_barrier(0)
__device__ __forceinline__ void cmask(f32x16&p0,f32x16&p1,int jb,int qrel,int hi){
  const float NEG=-INFINITY; int kb=64*jb+4*hi;
  #pragma unroll
  for(int r=0;r<16;++r){int kv=kb+(r&3)+8*(r>>2); if(kv>qrel)p0[r]=NEG; if(kv+32>qrel)p1[r]=NEG;}
}

constexpr int NSLOT=3, SLOTB=8192;
constexpr int LDS_K=0, LDS_V=NSLOT*SLOTB, LDS_WS=2*NSLOT*SLOTB, LDS_OST=LDS_WS+NW*64*4, LDS_C2=LDS_OST+NW*4096, LDS_BYTES=LDS_C2+VK*4;
constexpr float C2=0.125f*1.4426950408889634f;
__device__ __forceinline__ void glds16(const void*gsrc,unsigned lds_dst){unsigned keep;
  asm volatile("s_mov_b32 %0, m0\n\ts_mov_b32 m0, %2\n\ts_nop 0\n\tglobal_load_lds_dwordx4 %1, off\n\ts_mov_b32 m0, %0":"=&s"(keep):"v"(gsrc),"s"(lds_dst):"memory");}
__device__ __forceinline__ float max3f(float a,float b,float c){float r;asm("v_max3_f32 %0, %1, %2, %3":"=v"(r):"v"(a),"v"(b),"v"(c));return r;}
__device__ __forceinline__ float max2f(float a,float b){float r;asm("v_max_f32_e32 %0, %1, %2":"=v"(r):"v"(a),"v"(b));return r;}
__device__ __forceinline__ float fadd_s(float a,float b){float r;asm("v_add_f32_e32 %0, %1, %2":"=v"(r):"v"(a),"v"(b));return r;}
__device__ __forceinline__ float fsub_s(float a,float b){float r;asm("v_sub_f32_e32 %0, %1, %2":"=v"(r):"v"(a),"v"(b));return r;}
typedef float f32x2_t __attribute__((ext_vector_type(2))); typedef __bf16 bf16x2_t __attribute__((ext_vector_type(2)));
__device__ __forceinline__ unsigned cvtpk_s(float lo,float hi){f32x2_t v={lo,hi};bf16x2_t b=__builtin_convertvector(v,bf16x2_t);return __builtin_bit_cast(unsigned,b);}
#define WAIT_BAR(N) asm volatile("s_waitcnt vmcnt(" #N ") lgkmcnt(0)\n\ts_barrier":::"memory")

__device__ __forceinline__ void qkt(f32x16&p0,f32x16&p1,const char*Kslot,const bf16x8*qr,int r32,int hi){
  const char*kb=Kslot+hi*1024+r32*16;
  #pragma unroll
  for(int d0=0;d0<4;++d0){
    const bf16x8 b0=*reinterpret_cast<const bf16x8*>(kb+d0*2048);
    const bf16x8 b1=*reinterpret_cast<const bf16x8*>(kb+d0*2048+512);
    p0=__builtin_amdgcn_mfma_f32_32x32x16_bf16(b0,qr[d0],p0,0,0,0);p1=__builtin_amdgcn_mfma_f32_32x32x16_bf16(b1,qr[d0],p1,0,0,0);}
}
typedef __attribute__((address_space(3))) const char* lds_cptr;
typedef short v4i16_t __attribute__((ext_vector_type(4)));
__device__ __forceinline__ void kload8(bf16x8*kf,lds_cptr kp){
  kf[0]=*(const __attribute__((address_space(3))) bf16x8*)(kp);      kf[1]=*(const __attribute__((address_space(3))) bf16x8*)(kp+512);
  kf[2]=*(const __attribute__((address_space(3))) bf16x8*)(kp+2048); kf[3]=*(const __attribute__((address_space(3))) bf16x8*)(kp+2560);
  kf[4]=*(const __attribute__((address_space(3))) bf16x8*)(kp+4096); kf[5]=*(const __attribute__((address_space(3))) bf16x8*)(kp+4608);
  kf[6]=*(const __attribute__((address_space(3))) bf16x8*)(kp+6144); kf[7]=*(const __attribute__((address_space(3))) bf16x8*)(kp+6656);
}
__device__ __forceinline__ void kload2(bf16x8*kf,lds_cptr kp,int j){ kf[2*j]=*(const __attribute__((address_space(3))) bf16x8*)(kp+j*2048); kf[2*j+1]=*(const __attribute__((address_space(3))) bf16x8*)(kp+j*2048+512); }
__device__ __forceinline__ s16x4 vtr(lds_cptr p){ return __builtin_bit_cast(s16x4,__builtin_amdgcn_ds_read_tr16_b64_v4i16((__attribute__((address_space(3))) v4i16_t*)p)); }
__device__ __forceinline__ float rowmax(const f32x16&p0,const f32x16&p1){
  float a=max3f(p0[0],p0[1],p1[0]),b=max3f(p0[2],p0[3],p1[1]);a=max3f(a,p1[2],p1[3]);
  #pragma unroll
  for(int r=4;r<16;r+=4){a=max3f(a,p0[r],p0[r+1]);b=max3f(b,p0[r+2],p0[r+3]);a=max3f(a,p1[r],p1[r+1]);b=max3f(b,p1[r+2],p1[r+3]);}
  const float m=max2f(a,b);
  auto rr=__builtin_amdgcn_permlane32_swap(__float_as_uint(m),__float_as_uint(m),false,false);
  return max2f(__uint_as_float(rr[0]),__uint_as_float(rr[1]));
}
__device__ __forceinline__ void pv(f32x16*o,int vb,bf16x8 pa0,bf16x8 pa1,bf16x8 pa2,bf16x8 pa3){
  #pragma unroll
  for(int d0=0;d0<2;++d0){s16x4 lo[4],hi[4];
    #pragma unroll
    for(int ks=0;ks<4;++ks){
      asm volatile("ds_read_b64_tr_b16 %0,%1 offset:%c2":"=&v"(lo[ks]):"v"(vb),"i"(d0*4096+ks*1024):"memory");
      asm volatile("ds_read_b64_tr_b16 %0,%1 offset:%c2":"=&v"(hi[ks]):"v"(vb),"i"(d0*4096+ks*1024+512):"memory");}
    asm volatile("s_waitcnt lgkmcnt(0)":::"memory");SBAR();
    #define PK(k) (bf16x8){lo[k][0],lo[k][1],lo[k][2],lo[k][3],hi[k][0],hi[k][1],hi[k][2],hi[k][3]}
    o[d0]=__builtin_amdgcn_mfma_f32_32x32x16_bf16(pa0,PK(0),o[d0],0,0,0);
    o[d0]=__builtin_amdgcn_mfma_f32_32x32x16_bf16(pa1,PK(1),o[d0],0,0,0);
    o[d0]=__builtin_amdgcn_mfma_f32_32x32x16_bf16(pa2,PK(2),o[d0],0,0,0);
    o[d0]=__builtin_amdgcn_mfma_f32_32x32x16_bf16(pa3,PK(3),o[d0],0,0,0);
    #undef PK
  }
}

#ifndef ATTN_STORE16
#define ATTN_STORE16(p,v) (*(u32x4*)(p)=(v))
#endif
template<int THRL> __device__ __forceinline__ void attn_unit(int b,int h,int qb,const bf16*Q,const bf16*__restrict__ K,const bf16*__restrict__ V,const bf16*__restrict__ OG,const float*__restrict__ c2v,bf16*O,char*shm){
  int tid_=threadIdx.x; asm volatile("":"+v"(tid_));
  const int tid=tid_,lane=tid&63,r32=lane&31,hi=lane>>5; const int wid=__builtin_amdgcn_readfirstlane(tid>>6);
  const long rowbase=(long)b*SEQ; const int q0=qb*QB;
  const bf16*Qw=Q+(rowbase+q0+wid*QBLK)*PITCH+h*D;
  const bf16*Kh=K+(rowbase-2*KVBLK)*PITCH+h*D,*Vh=V+(rowbase-2*KVBLK)*PITCH+h*D;
  const bf16*KhL=K+(long)LEADROW*PITCH+h*D,*VhL=V+(long)LEADROW*PITCH+h*D;
  const unsigned lds0=(unsigned)(uintptr_t)shm;
  float*wsf=(float*)(shm+LDS_WS)+wid*64;
  const bf16*ksrc=Kh+(long)lane*PITCH+wid*8,*ksrcL=KhL+(long)lane*PITCH+wid*8;
  const bf16*vsrc=Vh+(long)(16*(wid&3)+(lane>>2))*PITCH+(wid>>2)*32+(lane&3)*8,*vsrcL=VhL+(long)(16*(wid&3)+(lane>>2))*PITCH+(wid>>2)*32+(lane&3)*8;
  const unsigned kdst=lds0+LDS_K+wid*1024, vdst=lds0+LDS_V+wid*1024;
  #define DMA_K(t,slot) glds16(((t)<2?ksrcL:ksrc)+(long)(t)*KVBLK*PITCH,(unsigned)__builtin_amdgcn_readfirstlane(kdst+(slot)))
  #define DMA_V(t,slot) glds16(((t)<2?vsrcL:vsrc)+(long)(t)*KVBLK*PITCH,(unsigned)__builtin_amdgcn_readfirstlane(vdst+(slot)))
  const int vb0=(int)(lds0+LDS_V)+((lane>>4)&1)*32+(lane&3)*8+(4*hi+((lane&15)>>2))*64;
  const char*Kbase=shm+LDS_K; bf16x8 kf[8];
  const lds_cptr shm3=(lds_cptr)shm; const lds_cptr kp0=shm3+LDS_K+hi*1024+r32*16; const lds_cptr vp0=shm3+LDS_V+((lane>>4)&1)*32+(lane&3)*8+(4*hi+((lane&15)>>2))*64;
  const int NT=(q0+QB)/KVBLK+2;
  { float*negc_w=(float*)(shm+LDS_C2); const float*cs=c2v+(long)(b*NHEAD+h)*VK; for(int i=tid;i<NT*KVBLK;i+=NW*64)negc_w[i]=-cs[i]; }
  const __attribute__((address_space(3))) float* negc3=(const __attribute__((address_space(3))) float*)((lds_cptr)shm+LDS_C2)+4*hi;
  typedef float f32x4_t __attribute__((ext_vector_type(4)));
  #define NEGC(t,i) (*(const __attribute__((address_space(3))) f32x4_t*)(negc3+64*(t)+(((i)>>2)*32)+8*((i)&3)))
  DMA_K(0,0);DMA_V(0,0);DMA_K(1,SLOTB);
  bf16x8 qr[4];
  #pragma unroll
  for(int d0=0;d0<4;++d0)qr[d0]=*reinterpret_cast<const bf16x8*>(&Qw[(long)r32*PITCH+d0*16+hi*8]);
  float mhat=0.f,l_reg=0.f;f32x16 o[2];o[0]=f32x16{};o[1]=f32x16{};
  const int qrel=wid*QBLK+r32;
  #define CMASK(P0,P1,t) do{int jb_=(t)-(NT-4); if(jb_>=0)cmask(P0,P1,jb_,qrel,hi);}while(0)
  bool resc=false;
  #define START(P0,P1) do{ const float rm=rowmax(P0,P1); resc=false; \
    { const float dl=rm; mhat=fadd_s(mhat,dl); \
      _Pragma("unroll") for(int r=0;r<16;++r){P0[r]=fsub_s(P0[r],dl);P1[r]=fsub_s(P1[r],dl);} } \
    _Pragma("unroll") for(int r=0;r<16;++r)P0[r]=__builtin_amdgcn_exp2f(P0[r]); }while(0)
  #define RESC() do{ if(resc){ asm volatile("s_waitcnt lgkmcnt(0)":::"memory"); \
      _Pragma("unroll") for(int d_=0;d_<2;++d_) _Pragma("unroll") for(int r=0;r<16;++r)o[d_][r]*=wsf[crow(r,hi)]; } }while(0)
  f32x16 pA0,pA1,pB0,pB1;
  int sl_prev=0,sl_cur=0,sl_next=SLOTB;
  #define ROT() do{sl_prev=sl_cur;sl_cur=sl_next;sl_next=(sl_next==(NSLOT-1)*SLOTB)?0:sl_next+SLOTB;}while(0)
  DMA_K(2,2*SLOTB);
  WAIT_BAR(3);
  #define FILLT(P0,P1,t) do{ _Pragma("unroll") for(int i_=0;i_<4;++i_){ const f32x4_t a_=NEGC(t,i_),b_=NEGC(t,4+i_); \
      P0[4*i_]=a_[0]-mhat;P0[4*i_+1]=a_[1]-mhat;P0[4*i_+2]=a_[2]-mhat;P0[4*i_+3]=a_[3]-mhat; P1[4*i_]=b_[0]-mhat;P1[4*i_+1]=b_[1]-mhat;P1[4*i_+2]=b_[2]-mhat;P1[4*i_+3]=b_[3]-mhat; } }while(0)
  FILLT(pA0,pA1,0);
  qkt(pA0,pA1,Kbase,qr,r32,hi);asm volatile("s_nop 15\n\ts_nop 7":"+v"(pA0),"+v"(pA1));CMASK(pA0,pA1,0);
  START(pA0,pA1);
  FILLT(pB0,pB1,1);
  _Pragma("unroll") for(int r=0;r<16;++r)pA1[r]=__builtin_amdgcn_exp2f(pA1[r]);
  WAIT_BAR(0);
  DMA_K(3,0);DMA_V(1,SLOTB);
  ROT();
  kload8(kf,kp0+sl_cur);
  WAIT_BAR(2);
  s16x4 vlo[8],vhi[8]; u32x4 pw0,pw1,pw2,pw3;
  #define PKW(P,B) cvtpk_s(P[B],P[B+1])
  #define PAF(k) __builtin_bit_cast(bf16x8,pw##k)
  #define VFR(i) (bf16x8){vlo[i][0],vlo[i][1],vlo[i][2],vlo[i][3],vhi[i][0],vhi[i][1],vhi[i][2],vhi[i][3]}
  #define PIN(x) asm volatile("":"+v"(x))
  #define MX3(a,b,c) __builtin_fmaxf(__builtin_fmaxf((a),(b)),(c))
  #define GAPA(MF,A0,A1,A2,A3,W0,W1,PW) do{ MF; sacc+=A0; sacc+=A1; sacc+=A2; sacc+=A3; PIN(sacc); W0; W1; PIN(PW); SBAR(); }while(0)
  #define EX(v) __builtin_amdgcn_exp2f(v)
  #define GAPB(MF,X,B,FP,FB,I,t,GF) do{ MF; X[B]=EX(X[B]); X[B+1]=EX(X[B+1]); X[B+2]=EX(X[B+2]); X[B+3]=EX(X[B+3]); \
      if(GF){ FP[FB]=fsub_s(cn_[0],mhat); FP[FB+1]=fsub_s(cn_[1],mhat); FP[FB+2]=fsub_s(cn_[2],mhat); FP[FB+3]=fsub_s(cn_[3],mhat); PIN(FP); if((I)<7){cn_=NEGC((t)+1,(I)+1);} } \
      PIN(X); SBAR(); }while(0)
  #define VRD(i) do{ vlo[i]=vtr(vp_+(((i)>>2)*4096+((i)&3)*1024)); vhi[i]=vtr(vp_+(((i)>>2)*4096+((i)&3)*1024+512)); }while(0)
  #define KRD(G,j) do{ if(G){ kload2(kf,kp0+sl_next,j); SBAR(); } }while(0)
  #define STEP(C0,C1,P0,P1,t,GK,GV,GL) do{ SBAR(); \
    const lds_cptr vp_=vp0+sl_prev; \
    VRD(0); SBAR(); float sacc=(P0[0]+P0[1]); \
    GAPA(C0=__builtin_amdgcn_mfma_f32_32x32x16_bf16(kf[0],qr[0],C0,0,0,0), P0[2],P0[3],P0[4],P0[5],     pw0[0]=PKW(P0,0), pw0[1]=PKW(P0,2), pw0); \
    VRD(4); SBAR(); GAPA(C1=__builtin_amdgcn_mfma_f32_32x32x16_bf16(kf[1],qr[0],C1,0,0,0), P0[6],P0[7],P0[8],P0[9],     pw0[2]=PKW(P0,4), pw0[3]=PKW(P0,6), pw0); \
    VRD(1); SBAR(); GAPA(C0=__builtin_amdgcn_mfma_f32_32x32x16_bf16(kf[2],qr[1],C0,0,0,0),   P0[10],P0[11],P0[12],P0[13], pw1[0]=PKW(P0,8), pw1[1]=PKW(P0,10), pw1); \
    VRD(5); SBAR(); GAPA(C1=__builtin_amdgcn_mfma_f32_32x32x16_bf16(kf[3],qr[1],C1,0,0,0),   P0[14],P0[15],P1[0],P1[1],   pw1[2]=PKW(P0,12),pw1[3]=PKW(P0,14), pw1); \
    VRD(2); SBAR(); GAPA(C0=__builtin_amdgcn_mfma_f32_32x32x16_bf16(kf[4],qr[2],C0,0,0,0),   P1[2],P1[3],P1[4],P1[5],     pw2[0]=PKW(P1,0), pw2[1]=PKW(P1,2), pw2); \
    VRD(6); SBAR(); GAPA(C1=__builtin_amdgcn_mfma_f32_32x32x16_bf16(kf[5],qr[2],C1,0,0,0),   P1[6],P1[7],P1[8],P1[9],     pw2[2]=PKW(P1,4), pw2[3]=PKW(P1,6), pw2); \
    VRD(3); SBAR(); GAPA(C0=__builtin_amdgcn_mfma_f32_32x32x16_bf16(kf[6],qr[3],C0,0,0,0),   P1[10],P1[11],P1[12],P1[13], pw3[0]=PKW(P1,8), pw3[1]=PKW(P1,10), pw3); \
    VRD(7); SBAR(); GAPA(C1=__builtin_amdgcn_mfma_f32_32x32x16_bf16(kf[7],qr[3],C1,0,0,0),   P1[14],P1[15],0.f,0.f,       pw3[2]=PKW(P1,12),pw3[3]=PKW(P1,14), pw3); \
    l_reg+=sacc; \
    if(GK){DMA_K((t)+3,sl_cur);} if(GV){DMA_V((t)+1,sl_next);} \
    CMASK(C0,C1,t); \
    { float a=MX3(C0[0],C0[1],C1[0]),b=MX3(C0[2],C0[3],C1[1]); a=MX3(a,C1[2],C1[3]); \
      _Pragma("unroll") for(int r=4;r<16;r+=4){a=MX3(a,C0[r],C0[r+1]);b=MX3(b,C0[r+2],C0[r+3]);a=MX3(a,C1[r],C1[r+1]);b=MX3(b,C1[r+2],C1[r+3]);} \
      float rm=__builtin_fmaxf(a,b); { auto rr=__builtin_amdgcn_permlane32_swap(__float_as_uint(rm),__float_as_uint(rm),false,false); rm=__builtin_fmaxf(__uint_as_float(rr[0]),__uint_as_float(rr[1])); } \
      resc=false; \
      if(__builtin_expect(__any(rm>(float)THRL),0)){ const float dl=__builtin_fmaxf(rm,0.f); mhat+=dl; \
        _Pragma("unroll") for(int r=0;r<16;++r){C0[r]-=dl;C1[r]-=dl;} \
        const float f=__builtin_amdgcn_exp2f(-dl); l_reg*=f; if(hi==0)wsf[r32]=f; resc=true; } } \
    f32x4_t cn_=(f32x4_t){0.f,0.f,0.f,0.f}; if(GL){cn_=NEGC((t)+1,0);} \
    SBAR(); \
    GAPB(o[0]=__builtin_amdgcn_mfma_f32_32x32x16_bf16(PAF(0),VFR(0),o[0],0,0,0), C0,0,P0,0,0,t,GL); \
    GAPB(o[1]=__builtin_amdgcn_mfma_f32_32x32x16_bf16(PAF(0),VFR(4),o[1],0,0,0), C0,4,P0,4,1,t,GL); \
    KRD(GL,0); GAPB(o[0]=__builtin_amdgcn_mfma_f32_32x32x16_bf16(PAF(1),VFR(1),o[0],0,0,0), C0,8,P0,8,2,t,GL); \
    KRD(GL,1); GAPB(o[1]=__builtin_amdgcn_mfma_f32_32x32x16_bf16(PAF(1),VFR(5),o[1],0,0,0), C0,12,P0,12,3,t,GL); \
    KRD(GL,2); GAPB(o[0]=__builtin_amdgcn_mfma_f32_32x32x16_bf16(PAF(2),VFR(2),o[0],0,0,0), C1,0,P1,0,4,t,GL); \
    KRD(GL,3); GAPB(o[1]=__builtin_amdgcn_mfma_f32_32x32x16_bf16(PAF(2),VFR(6),o[1],0,0,0), C1,4,P1,4,5,t,GL); \
    GAPB(o[0]=__builtin_amdgcn_mfma_f32_32x32x16_bf16(PAF(3),VFR(3),o[0],0,0,0), C1,8,P1,8,6,t,GL); \
    GAPB(o[1]=__builtin_amdgcn_mfma_f32_32x32x16_bf16(PAF(3),VFR(7),o[1],0,0,0), C1,12,P1,12,7,t,GL); \
    }while(0)
  int t=1;
  #undef CMASK
  #define CMASK(P0,P1,t) do{}while(0)
  for(;t+5<NT;t+=2){
    STEP(pB0,pB1,pA0,pA1,t,true,true,true);     WAIT_BAR(2); RESC(); ROT();
    STEP(pA0,pA1,pB0,pB1,t+1,true,true,true);   WAIT_BAR(2); RESC(); ROT();
  }
  #undef CMASK
  #define CMASK(P0,P1,t) do{int jb_=(t)-(NT-4); if(jb_>=0)cmask(P0,P1,jb_,qrel,hi);}while(0)
  #define ENDW(tt) do{ if((tt)+3<NT){WAIT_BAR(2);} else if((tt)+2<NT){WAIT_BAR(1);} else {WAIT_BAR(0);} }while(0)
  for(;t+1<NT;t+=2){
    STEP(pB0,pB1,pA0,pA1,t,(t+3<NT),(t+1<NT),(t+1<NT));       ENDW(t);   RESC(); ROT();
    STEP(pA0,pA1,pB0,pB1,t+1,(t+4<NT),(t+2<NT),(t+2<NT));     ENDW(t+1); RESC(); ROT();
  }
  STEP(pB0,pB1,pA0,pA1,NT-1,false,false,false); RESC();
  { float sacc=pB0[0]+pB0[1]; _Pragma("unroll") for(int r=2;r<16;++r)sacc+=pB0[r]; _Pragma("unroll") for(int r=0;r<16;++r)sacc+=pB1[r]; l_reg+=sacc;
    pw0=(u32x4){PKW(pB0,0),PKW(pB0,2),PKW(pB0,4),PKW(pB0,6)};pw1=(u32x4){PKW(pB0,8),PKW(pB0,10),PKW(pB0,12),PKW(pB0,14)};pw2=(u32x4){PKW(pB1,0),PKW(pB1,2),PKW(pB1,4),PKW(pB1,6)};pw3=(u32x4){PKW(pB1,8),PKW(pB1,10),PKW(pB1,12),PKW(pB1,14)};
    SBAR(); pv(o,vb0+sl_cur,PAF(0),PAF(1),PAF(2),PAF(3)); }
  #undef PKW
  #undef PAF
  #undef VFR
  #undef PIN
  #undef MX3
  #undef GAPA
  #undef GAPB
  #undef EX
  #undef VRD
  #undef KRD
  #undef STEP
  #undef ENDW
  {auto rr=__builtin_amdgcn_permlane32_swap(__float_as_uint(l_reg),__float_as_uint(l_reg),false,false);l_reg=__uint_as_float(rr[0])+__uint_as_float(rr[1]);}
  if(hi==0)wsf[32+r32]=l_reg;asm volatile("s_waitcnt lgkmcnt(0)":::"memory");
  float rli[16];
  #pragma unroll
  for(int r=0;r<16;++r)rli[r]=__builtin_amdgcn_rcpf(wsf[32+crow(r,hi)]);
  bf16*Ow=O+(rowbase+q0+wid*QBLK)*OPITCH+h*D; const bf16*Gw=OG+(rowbase+q0+wid*QBLK)*PITCH+h*D;
  u32x4 gg[4];
  #pragma unroll
  for(int i=0;i<4;++i){const int row=i*8+(lane>>3),ch=lane&7; gg[i]=*(const u32x4*)(Gw+(long)row*PITCH+ch*8);}
  { bf16*stg=(bf16*)(shm+LDS_OST)+wid*2048;
    #pragma unroll
    for(int r=0;r<16;++r){const int orow=crow(r,hi);
      #pragma unroll
      for(int d0=0;d0<2;++d0)stg[orow*64+d0*32+r32]=__float2bfloat16(o[d0][r]*rli[r]);}
    asm volatile("s_waitcnt lgkmcnt(0)":::"memory");
    #pragma unroll
    for(int i=0;i<4;++i){const int row=i*8+(lane>>3),ch=lane&7; u32x4 v=*(const u32x4*)(stg+row*64+ch*8);
      #pragma unroll
      for(int w=0;w<4;++w){ const float o0=__uint_as_float(v[w]<<16),o1=__uint_as_float(v[w]&0xffff0000u),g0=__uint_as_float(gg[i][w]<<16),g1=__uint_as_float(gg[i][w]&0xffff0000u);
        v[w]=cvtpk_s(o0*__builtin_amdgcn_rcpf(1.f+__builtin_amdgcn_exp2f(-1.4426950408889634f*g0)),o1*__builtin_amdgcn_rcpf(1.f+__builtin_amdgcn_exp2f(-1.4426950408889634f*g1))); }
      ATTN_STORE16(Ow+(long)row*OPITCH+ch*8,v);} }
  asm volatile("s_waitcnt lgkmcnt(0)\n\ts_barrier":::"memory");
  #undef DMA_K
  #undef NEGC
  #undef FILLT
  #undef DMA_V
  #undef CMASK
  #undef START
  #undef RESC
  #undef ROT
}
constexpr int ATTN_LDS_BYTES=LDS_BYTES;
struct AttnTensors { const bf16* Q; const bf16* K; const bf16* V; const bf16* OG; const float* c2v; bf16* O; };
struct AttnUnit { int bh; int qb; };
struct StaticOrder {
  int vcu, G;
  __device__ __forceinline__ explicit StaticOrder(int grid,int block):vcu((grid%8==0)?(block%8)*(grid/8)+block/8:block),G(grid){}
  __device__ __forceinline__ bool next(int i,AttnUnit&u)const{ const int pair=vcu+(i>>1)*G; if(pair>=BATCH*NHEAD*4)return false; const int s=pair&3; u.bh=pair>>2; u.qb=(i&1)?s:7-s; return true; }
  __device__ __forceinline__ void a_ready(const AttnUnit&)const{}
  __device__ __forceinline__ void done(const AttnUnit&)const{}
};
template<class Sched,int THRL=8> __device__ __forceinline__ void attn_phase(char*lds,const AttnTensors&T,const Sched&S){
  AttnUnit u;
  for(int i=0;S.next(i,u);++i){ S.a_ready(u); attn_unit<THRL>(u.bh/NHEAD,u.bh%NHEAD,u.qb,T.Q,T.K,T.V,T.OG,T.c2v,T.O,lds); S.done(u); }
}
#undef SBAR
#undef WAIT_BAR
}
#define GAS __attribute__((address_space(1)))
#define LAS __attribute__((address_space(3)))
typedef unsigned short bf16;
typedef unsigned v4u __attribute__((ext_vector_type(4)));
typedef float f32x4 __attribute__((ext_vector_type(4)));
typedef short bf16x8 __attribute__((ext_vector_type(8)));
typedef GAS unsigned gu32;
typedef GAS unsigned long long gu64;
#define RLX_AGENT __ATOMIC_RELAXED, __HIP_MEMORY_SCOPE_AGENT
#define LDS_WAIT() asm volatile("s_waitcnt lgkmcnt(0)" ::: "memory")
#define VM_WAIT() asm volatile("s_waitcnt vmcnt(0)" ::: "memory")
#define XB_TMO      128
#define XB_XCNT(j)  (256  + 64 * (j))
#define XB_XSUB(j)  (1280 + 64 * (j))
#define XB_XGEN(j)  (2304 + 64 * (j))
#define XB_TOP      3328
#define XB_TOPGEN   3392
#define XCD_BAR_WORDS 3456
#define XB_SPIN_CAP (1u << 18)

__device__ __forceinline__ unsigned xb_ld(unsigned* p)              { return __hip_atomic_load(p, __ATOMIC_RELAXED, __HIP_MEMORY_SCOPE_AGENT); }
__device__ __forceinline__ unsigned xb_add(unsigned* p, unsigned v) { return __hip_atomic_fetch_add(p, v, __ATOMIC_RELAXED, __HIP_MEMORY_SCOPE_AGENT); }
__device__ __forceinline__ unsigned xb_xcc_id() { return (unsigned)__builtin_amdgcn_s_getreg((3 << 11) | 20) & 0xFu; }
#define XB_SPIN(cond, bar) do { unsigned _sp = 0; while (cond) { __builtin_amdgcn_s_sleep(1); \
    if ((++_sp & 255u) == 0u) { if (xb_ld(&(bar)[XB_TMO])) break; if (_sp > XB_SPIN_CAP) { atomicAdd(&(bar)[XB_TMO], 1u); break; } } } } while (0)

struct XcdBarrier {
    unsigned* bar; unsigned x;
    volatile LAS unsigned* st;
};

__device__ __forceinline__ XcdBarrier xcd_barrier_post(unsigned* bar, volatile LAS unsigned* st) {
    XcdBarrier b; b.bar = bar; b.x = xb_xcc_id(); b.st = st;
    if (threadIdx.x == 0) (void)xb_add(&bar[XB_XCNT(b.x)], 1u);
    return b;
}
__device__ __forceinline__ void xcd_barrier_complete(unsigned* bar, unsigned x, unsigned& nloc, unsigned& nx) {
    const unsigned G = gridDim.x * gridDim.y * gridDim.z;
    unsigned sum, cnt, mine, sp = 0u;
    for (;;) {
        sum = 0u; cnt = 0u; mine = 0u;
#pragma unroll
        for (unsigned j = 0; j < 16; ++j) { const unsigned c = xb_ld(&bar[XB_XCNT(j)]); sum += c; cnt += (c > 0u) ? 1u : 0u; mine = (j == x) ? c : mine; }
        if (sum == G) break;
        __builtin_amdgcn_s_sleep(1);
        if ((++sp & 255u) == 0u) { if (xb_ld(&bar[XB_TMO])) break; if (sp > XB_SPIN_CAP) { atomicAdd(&bar[XB_TMO], 1u); break; } }
    }
    nloc = mine > 0u ? mine : 1u; nx = cnt > 0u ? cnt : 1u;
}

__device__ __forceinline__ void xcd_barrier(const XcdBarrier& b) {
    asm volatile("s_waitcnt vmcnt(0)" ::: "memory");
    __syncthreads();
    if (threadIdx.x == 0) {
        unsigned* bar = b.bar;
        __builtin_amdgcn_s_waitcnt(0);
        unsigned nloc = b.st[0], nx = b.st[1];
        if (nloc == 0u) { xcd_barrier_complete(bar, b.x, nloc, nx); b.st[0] = nloc; b.st[1] = nx; }
        const unsigned old = xb_add(&bar[XB_XSUB(b.x)], 1u);
        const unsigned gen = old / nloc;
        if (old + 1u == (gen + 1u) * nloc) {
            __builtin_amdgcn_fence(__ATOMIC_RELEASE, "agent");
            asm volatile("s_waitcnt vmcnt(0)" ::: "memory");
            const unsigned og = xb_add(&bar[XB_TOP], 1u);
            const unsigned tg = og / nx;
            if (og + 1u == (tg + 1u) * nx) xb_add(&bar[XB_TOPGEN], 1u);
            else XB_SPIN(xb_ld(&bar[XB_TOPGEN]) == tg, bar);
            __builtin_amdgcn_fence(__ATOMIC_ACQUIRE, "agent");
            xb_add(&bar[XB_XGEN(b.x)], 1u);
            asm volatile("s_waitcnt vmcnt(0)" ::: "memory");
        } else {
            XB_SPIN(xb_ld(&bar[XB_XGEN(b.x)]) == gen, bar);
            __builtin_amdgcn_fence(__ATOMIC_ACQUIRE, "agent");
            asm volatile("s_waitcnt vmcnt(0)" ::: "memory");
        }
    }
    __syncthreads();
}

constexpr int NWAVES = 8;
constexpr int RING_BYTES = 131072;
constexpr int LDSCTL_OFF = RING_BYTES, MISC_OFF = LDSCTL_OFF + 320;
constexpr int LDS_BYTES = 147456;
constexpr int CW_BAR = 4096;

struct Args { const float* in[24]; float* out; unsigned char* ws; };

template <bool AF32, class F>
__device__ __forceinline__ void meta_gemm(const void* A, int lda, const bf16_t* Wt, int N, int K, int gw, int ngw, int lane, const F& f) {
    const int fr = lane & 15, fq = lane >> 4;
    for (int cb = gw; cb < N / 16; cb += ngw) {
        f32x4 acc = (f32x4){0.f, 0.f, 0.f, 0.f}; float ss = 0.f;
        const bf16_t* bp = Wt + (size_t)(cb * 16 + fr) * K + 8 * fq;
#pragma unroll 4
        for (int k = 0; k < K; k += 32) {
            bf16x8 a;
            if (AF32) {
                const float* ap = (const float*)A + (size_t)fr * lda + k + 8 * fq;
                const f32x4 a0 = *(const f32x4*)ap, a1 = *(const f32x4*)(ap + 4);
                ss += ((a0.x * a0.x + a0.y * a0.y) + (a0.z * a0.z + a0.w * a0.w)) + ((a1.x * a1.x + a1.y * a1.y) + (a1.z * a1.z + a1.w * a1.w));
                u32x4 w; w.x = pk2bf(a0.x, a0.y); w.y = pk2bf(a0.z, a0.w); w.z = pk2bf(a1.x, a1.y); w.w = pk2bf(a1.z, a1.w);
                a = __builtin_bit_cast(bf16x8, w);
            } else a = *(const bf16x8*)((const bf16_t*)A + (size_t)fr * lda + k + 8 * fq);
            const bf16x8 b = *(const bf16x8*)(bp + k);
            acc = __builtin_amdgcn_mfma_f32_16x16x32_bf16(a, b, acc, 0, 0, 0);
        }
        float rstd = 1.f;
        if (AF32) { ss += __shfl_xor(ss, 16); ss += __shfl_xor(ss, 32); rstd = 1.0f / sqrtf(ss * (1.f / DM) + 1e-6f); }
#pragma unroll
        for (int r = 0; r < 4; ++r) { const int row = 4 * fq + r; const float rs = AF32 ? __shfl(rstd, row) : 1.f; f(row, cb * 16 + fr, acc[r] * rs); }
    }
}
struct MEpi1 { bf16_t* p; float* pn;
    __device__ __forceinline__ void operator()(int r, int col, float v) const {
        const int row = MROWS + r; const int g = col >> 9;
        if (g < 7) p[(size_t)row * PBW + col] = f2bf(v);
        else { const int o = col & 511; if (o < 296) pn[(size_t)row * PNW + o] = v; } } };
struct MEpiRes { float* hm; __device__ __forceinline__ void operator()(int r, int col, float v) const { float* h = hm + r * DM + col; *h = *h + v; } };
struct MEpi3 { bf16_t* raw; int ldr; __device__ __forceinline__ void operator()(int r, int col, float v) const { raw[(size_t)(MROWS + r) * ldr + col] = f2bf(v); } };

__device__ __forceinline__ void wprep_layer(const Args& a, int l, unsigned char* ws, int gw, int ngw, int lane, float* scr) {
    unsigned char* wb = ws + WS_W + (size_t)(l & 1) * WL_BYTES;
    constexpr int I1 = (DM / 64) * (N1 / 32), I2 = (DM / 64) * (DM / 32), I3 = (DM / 64) * (DFF2 / 32), I4 = (DFF / 64) * (DM / 32), IL = I1 + I2 + I3 + I4;
    for (int it = gw; it < IL; it += ngw) {
        int r = it;
        if (r < I1) { wprep_item(a.in[3] + (size_t)l * DM * N_IN, a.in[2] + l * DM, (bf16_t*)(wb + WO_W1), DM, N_IN, N1, 1, r, scr, lane); continue; } r -= I1;
        if (r < I2) { wprep_item(a.in[18] + (size_t)l * DM * DM, nullptr, (bf16_t*)(wb + WO_W2), DM, DM, DM, 2, r, scr, lane); continue; } r -= I2;
        if (r < I3) { wprep_item(a.in[20] + (size_t)l * DM * DFF2, a.in[19] + l * DM, (bf16_t*)(wb + WO_W3), DM, DFF2, DFF2, 3, r, scr, lane); continue; } r -= I3;
        wprep_item(a.in[23] + (size_t)l * DFF * DM, nullptr, (bf16_t*)(wb + WO_W4), DFF, DM, DM, 4, r, scr, lane);
    }
    bf16_t* lup = (bf16_t*)(wb + WO_LUP);
    const float* wu = a.in[6] + (size_t)l * 64 * 512; const float* au = a.in[8] + (size_t)l * 64 * 512; const float* gu = a.in[9] + (size_t)l * 160 * 512;
    for (int e = gw * 64 + lane; e < 512 * 288; e += ngw * 64) {
        const int n = e / 288, k = e % 288;
        lup[e] = f2bf(k < 64 ? wu[k * 512 + n] : (k < 128 ? au[(k - 64) * 512 + n] : gu[(k - 128) * 512 + n]));
    }
}

struct RwP { const float* mu; const float* w0; const float* w_up; const float* a0; const float* a_up; const float* g_up; };
struct RwS { const float* mu; const float* k_k; const float* k_a; const float* r_k; const float* gn_w; const float* gn_b; };
constexpr int RCH = 8;

__global__ void __launch_bounds__(NWAVES * 64, 2) mk_fwd(Args a) {
    extern __shared__ __attribute__((aligned(16))) unsigned char lds[];
    const int tid0 = threadIdx.x;
    const int G = gridDim.x, bid = blockIdx.x, ngw = G * NWAVES;
    for (int u = tid0; u < (LDS_BYTES - LDSCTL_OFF) / 4; u += NWAVES * 64) ((LAS unsigned*)((LAS unsigned char*)lds + LDSCTL_OFF))[u] = 0u;
    __syncthreads();
    unsigned char* ws = a.ws; float* out = a.out;
    XcdBarrier bar = xcd_barrier_post((unsigned*)(ws + WS_CTL) + CW_BAR, (volatile LAS unsigned*)((LAS unsigned char*)lds + MISC_OFF) + 8);
#define GRID_BAR() xcd_barrier(bar)
#define PHASE_IDS() int tid = tid0; asm volatile("" : "+v"(tid)); const int lane = tid & 63, wave = __builtin_amdgcn_readfirstlane(tid >> 6), gw = bid * NWAVES + wave; (void)lane; (void)gw
    const float* x = a.in[0]; const float* meta = a.in[1];
    float* hm = (float*)(ws + WS_HM); float* c2 = (float*)(ws + WS_C2); float* ssqp = (float*)(ws + WS_SSQ);
    bf16_t* hb = (bf16_t*)(ws + WS_HB); bf16_t* p = (bf16_t*)(ws + WS_P); float* pn = (float*)(ws + WS_PN); bf16_t* y = (bf16_t*)(ws + WS_Y);
    bf16_t* act = (bf16_t*)(ws + WS_ACT); bf16_t* raw = (bf16_t*)(ws + WS_RAW);
    LAS unsigned char* ldsl = (LAS unsigned char*)lds;

    {
        PHASE_IDS();
        float* scr = (float*)(lds + wave * 16384);
        wprep_layer(a, 0, ws, gw, ngw, lane, scr);
        for (int row = gw; row < RROWS; row += ngw) {
            const f32x4* xr = (const f32x4*)(row < MROWS ? x + (size_t)row * DM : meta + (size_t)(row - MROWS) * DM) + lane;
            f32x4* hr = (f32x4*)(row < MROWS ? out + (size_t)row * DM : hm + (size_t)(row - MROWS) * DM) + lane;
            f32x4 v[4]; float s = 0.f;
#pragma unroll
            for (int j = 0; j < 4; ++j) { v[j] = xr[64 * j]; hr[64 * j] = v[j]; s += (v[j].x * v[j].x + v[j].y * v[j].y) + (v[j].z * v[j].z + v[j].w * v[j].w); }
            s = wave_sum(s);
            if (lane < 16) ssqp[(size_t)row * 16 + lane] = lane == 0 ? s : 0.f;
            u32x2* o8 = (u32x2*)(hb + (size_t)row * DM) + lane;
#pragma unroll
            for (int j = 0; j < 4; ++j) { u32x2 w; w.x = pk2bf(v[j].x, v[j].y); w.y = pk2bf(v[j].z, v[j].w); o8[64 * j] = w; }
        }
    }
    {
        u32x4* z = (u32x4*)(p + (size_t)RROWS * PBW); const size_t n16 = (size_t)(16512 - RROWS) * PBW * 2 / 16;
        for (size_t i = (size_t)bid * (NWAVES * 64) + tid0; i < n16; i += (size_t)G * (NWAVES * 64)) z[i] = (u32x4){0u, 0u, 0u, 0u};
    }
    cg::this_grid().sync();

#pragma unroll 1
    for (int l = 0; l < DEPTH; ++l) {
        const unsigned char* wbuf = ws + WS_W + (size_t)(l & 1) * WL_BYTES;
        const bf16_t* W1 = (const bf16_t*)(wbuf + WO_W1); const bf16_t* W2 = (const bf16_t*)(wbuf + WO_W2);
        const bf16_t* W3 = (const bf16_t*)(wbuf + WO_W3); const bf16_t* W4 = (const bf16_t*)(wbuf + WO_W4);
        {
            PHASE_IDS();
            pg8::Gemm g{hb, W1, MROWS, N1, DM}; pg8::StaticOrder S; S.init(MROWS, N1, G, bid);
            pg8::Epi1 E{ssqp, p, pn};
            pg8::gemm_phase<pg8::Epi1, pg8::StaticOrder, true, true>(ldsl, g, S, E);
            meta_gemm<true>(hm, DM, W1, N1, DM, gw, ngw, lane, MEpi1{p, pn});
        }
        GRID_BAR();
        {
            PHASE_IDS();
            if (l + 1 < DEPTH) wprep_layer(a, l + 1, ws, gw, ngw, lane, (float*)(lds + wave * 16384));
            __syncthreads();
            {
                const float* mu = a.in[4] + l * 1824;
                const bf16_t* lup = (const bf16_t*)(wbuf + WO_LUP);
                const int h = wave, cg = h * 64 + lane, fr = lane & 15, fq = lane >> 4;
                const float mu_r = mu[cg], mu_k = mu[512 + cg], mu_v = mu[1024 + cg];
                const float w0c = (a.in[5] + l * 512)[cg], a0c = (a.in[7] + l * 512)[cg];
                const float kkc = (a.in[10] + l * 512)[cg], kac = (a.in[11] + l * 512)[cg], rkc = (a.in[12] + l * 512)[cg];
                LAS unsigned char* LIN = ldsl;
                LAS unsigned char* LW = ldsl + 10240 + wave * 11776;
                LAS float* TR = (LAS float*)LW; LAS float* LT = (LAS float*)(LW + 9216); LAS float* LAK = (LAS float*)(LW + 9216 + 1280);
                for (int u = bid; u < NB * NCH; u += G) {
                    const int b = u / NCH, c = u % NCH, row0 = rowof(b, 16 * c), prow0 = prevrow(row0);
                    __syncthreads();
                    for (int e = tid; e < 16 * 288; e += NWAVES * 64) {
                        const int i = e / 288, j = e % 288, row = row0 + i, pr = i ? row - 1 : prow0;
                        const float cur = pn[(size_t)row * PNW + j], prv = pr >= 0 ? pn[(size_t)pr * PNW + j] : 0.f;
                        const float s = cur + mu[1536 + j] * (prv - cur);
                        ((LAS bf16_t*)LIN)[i * 296 + j] = f2bf(j < 64 ? tanhf(s) : (j < 128 ? s : sigmoidf_(s)));
                    }
                    __syncthreads();
                    float zw[16], za[16], zg[16];
#define LORA(ZA, KB0, NKS) do { f32x4 acc_[4]; _Pragma("unroll") for (int nb = 0; nb < 4; ++nb) acc_[nb] = (f32x4){0.f, 0.f, 0.f, 0.f}; \
                        _Pragma("unroll") for (int ks = 0; ks < (NKS); ++ks) { const bf16x8 af = *(const LAS bf16x8*)(LIN + fr * 592 + ((KB0) + 32 * ks + 8 * fq) * 2); \
                            _Pragma("unroll") for (int nb = 0; nb < 4; ++nb) { const bf16x8 bfr = *(const bf16x8*)(lup + (size_t)(h * 64 + 16 * nb + fr) * 288 + (KB0) + 32 * ks + 8 * fq); \
                                acc_[nb] = __builtin_amdgcn_mfma_f32_16x16x32_bf16(af, bfr, acc_[nb], 0, 0, 0); } } \
                        WAVE_LDS_SYNC(); \
                        _Pragma("unroll") for (int nb = 0; nb < 4; ++nb) _Pragma("unroll") for (int r = 0; r < 4; ++r) TR[(4 * fq + r) * 65 + 16 * nb + fr] = acc_[nb][r]; \
                        WAVE_LDS_SYNC(); \
                        _Pragma("unroll") for (int i = 0; i < 16; ++i) ZA[i] = TR[i * 65 + lane]; } while (0)
                    LORA(zw, 0, 2); LORA(za, 64, 2); LORA(zg, 128, 5);
#undef LORA
                    WAVE_LDS_SYNC();
                    const int ci = (b * 8 + h) * NCH + c;
                    unsigned char* ra = ws + WS_RA + (size_t)ci * RA_BYTES; unsigned char* rb = ws + WS_RB + (size_t)ci * RB_BYTES;
                    bf16_t* RH = (bf16_t*)(ra + 2048); float* BON = (float*)(rb + 3840);
                    LAS bf16_t* OA = (LAS bf16_t*)LW; LAS bf16_t* OB = OA + 16 * 72; LAS bf16_t* OK = OB + 16 * 72; LAS bf16_t* OR = OK + 16 * 72;
                    const int permk = (lane >> 5) * 32 + ((lane >> 2) & 3) * 8 + ((lane >> 4) & 1) * 4 + (lane & 3);
                    float atil[16], btil[16], ktil[16], vv[16];
                    float cum = 0.f, gprev = 1.f, rp = 0.f, kp_ = 0.f, vp = 0.f;
                    if (prow0 >= 0) { const bf16_t* pp = p + (size_t)prow0 * PBW; rp = bf2f(pp[cg]); kp_ = bf2f(pp[512 + cg]); vp = bf2f(pp[1024 + cg]); }
                    const float hp0 = prow0 >= 0 ? 1.f : 0.f;
#pragma unroll
                    for (int i = 0; i < 16; ++i) {
                        const bf16_t* pc = p + (size_t)(row0 + i) * PBW;
                        const float rc = bf2f(pc[cg]), kc = bf2f(pc[512 + cg]), vc = bf2f(pc[1024 + cg]);
                        const float hp = i ? 1.f : hp0;
                        const float rs = rc + mu_r * (hp * rp - rc), ks_ = kc + mu_k * (hp * kp_ - kc), vs = vc + mu_v * (hp * vp - vc);
                        rp = rc; kp_ = kc; vp = vc;
                        const float we = 0.6065306597126334f * sigmoidf_(zw[i] + w0c);
                        cum += we;
                        const float alr = sigmoidf_(za[i] + a0c);
                        const float kkr = ks_ * kkc; const float kk = kkr / fmaxf(sqrtf(wave_sum(kkr * kkr)), 1e-12f);
                        const float kpr = ks_ * (1.f + (alr - 1.f) * kac);
                        const float bon = wave_sum(rs * kpr * rkc);
                        const float eg = __expf(cum), gi = __expf(-cum);
                        atil[i] = -kk * gprev; btil[i] = kk * alr * eg; ktil[i] = kpr * eg; vv[i] = vs;
                        const float rtil = rs * gi; gprev = gi;
                        OA[i * 72 + lane] = f2bf(atil[i]); OB[i * 72 + lane] = f2bf(btil[i]); OK[i * 72 + lane] = f2bf(ktil[i]); OR[i * 72 + lane] = f2bf(rtil);
                        RH[i * 64 + permk] = f2bf(rtil);
                        y[(size_t)(row0 + i) * DM + cg] = f2bf(zg[i]);
                        if (lane == 0) BON[i] = bon;
                    }
                    {
                        const float gC = gprev;
                        ((float*)(rb + 3584))[lane] = gC;
#pragma unroll
                        for (int q = 0; q < 4; ++q) { u32x4 w;
                            w.x = pk2bf(btil[4 * q] * gC, btil[4 * q + 1] * gC); w.y = pk2bf(btil[4 * q + 2] * gC, btil[4 * q + 3] * gC);
                            w.z = pk2bf(ktil[4 * q] * gC, ktil[4 * q + 1] * gC); w.w = pk2bf(ktil[4 * q + 2] * gC, ktil[4 * q + 3] * gC);
                            *(u32x4*)(ra + 4096 + (lane * 32 + 8 * q) * 2) = w; }
                        u32x4 v0, v1;
                        v0.x = pk2bf(vv[0], vv[1]); v0.y = pk2bf(vv[2], vv[3]); v0.z = pk2bf(vv[4], vv[5]); v0.w = pk2bf(vv[6], vv[7]);
                        v1.x = pk2bf(vv[8], vv[9]); v1.y = pk2bf(vv[10], vv[11]); v1.z = pk2bf(vv[12], vv[13]); v1.w = pk2bf(vv[14], vv[15]);
                        *(u32x4*)(rb + lane * 32) = v0; *(u32x4*)(rb + lane * 32 + 16) = v1;
                    }
                    WAVE_LDS_SYNC();
                    {
                        f32x4 dab = (f32x4){0.f, 0.f, 0.f, 0.f}, dak = dab, drb = dab, drk = dab;
#pragma unroll
                        for (int ks = 0; ks < 2; ++ks) {
                            const int off = fr * 72 + 32 * ks + 8 * fq;
                            const bf16x8 fa = *(const LAS bf16x8*)(OA + off), fb = *(const LAS bf16x8*)(OB + off), fk = *(const LAS bf16x8*)(OK + off), frr = *(const LAS bf16x8*)(OR + off);
                            dab = __builtin_amdgcn_mfma_f32_16x16x32_bf16(fa, fb, dab, 0, 0, 0); dak = __builtin_amdgcn_mfma_f32_16x16x32_bf16(fa, fk, dak, 0, 0, 0);
                            drb = __builtin_amdgcn_mfma_f32_16x16x32_bf16(frr, fb, drb, 0, 0, 0); drk = __builtin_amdgcn_mfma_f32_16x16x32_bf16(frr, fk, drk, 0, 0, 0);
                        }
                        bf16_t* MRK = (bf16_t*)(rb + 2048);
#pragma unroll
                        for (int r = 0; r < 4; ++r) { const int i = 4 * fq + r, j = fr;
                            LT[i * 20 + j] = j < i ? dab[r] : 0.f; LAK[i * 16 + j] = j < i ? dak[r] : 0.f;
                            MRK[i * 32 + (j >> 2) * 8 + (j & 3)] = f2bf(j <= i ? drb[r] : 0.f); MRK[i * 32 + (j >> 2) * 8 + 4 + (j & 3)] = f2bf(j <= i ? drk[r] : 0.f); }
                    }
                    WAVE_LDS_SYNC();
                    float tt[16];
#pragma unroll
                    for (int mm = 0; mm < 16; ++mm) tt[mm] = mm == fr ? 1.f : 0.f;
#pragma unroll
                    for (int j = 14; j >= 0; --j) { float val = 0.f;
#pragma unroll
                        for (int mm = j + 1; mm < 16; ++mm) val += tt[mm] * LT[mm * 20 + j];
                        tt[j] += val; }
                    WAVE_LDS_SYNC();
                    if (fq == 0) {
#pragma unroll
                        for (int mm = 0; mm < 16; ++mm) LT[fr * 20 + mm] = tt[mm]; }
                    {
                        f32x4 g4 = (f32x4){0.f, 0.f, 0.f, 0.f};
#pragma unroll
                        for (int mm = 0; mm < 16; ++mm) g4 += *(const LAS f32x4*)(LAK + mm * 16 + 4 * fq) * tt[mm];
                        u32x2 w; w.x = pk2bf(g4[0], g4[1]); w.y = pk2bf(g4[2], g4[3]);
                        *(u32x2*)(rb + 3072 + (fr * 16 + 4 * fq) * 2) = w;
                    }
                    WAVE_LDS_SYNC();
                    {
                        bf16_t* AH = (bf16_t*)ra;
#pragma unroll
                        for (int i = 0; i < 16; ++i) { float acc = 0.f;
                            const f32x4 t0 = *(const LAS f32x4*)(LT + i * 20), t1 = *(const LAS f32x4*)(LT + i * 20 + 4), t2 = *(const LAS f32x4*)(LT + i * 20 + 8), t3 = *(const LAS f32x4*)(LT + i * 20 + 12);
                            const float trow[16] = {t0[0], t0[1], t0[2], t0[3], t1[0], t1[1], t1[2], t1[3], t2[0], t2[1], t2[2], t2[3], t3[0], t3[1], t3[2], t3[3]};
#pragma unroll
                            for (int mm = 0; mm <= i; ++mm) acc += trow[mm] * atil[mm];
                            AH[i * 64 + permk] = f2bf(acc); }
                    }
                }
            }
            __syncthreads();
            const float* q_g = a.in[16] + l * 64; const float* k_g = a.in[17] + l * 64; const float* b_f = a.in[15] + l * 8;
            for (int it = gw; it < RROWS * NH; it += ngw) {
                const int row = it >> 3, h = it & 7;
                bf16_t* qp = p + (size_t)row * PBW + 1536 + h * 64 + lane; bf16_t* kp = p + (size_t)row * PBW + 2048 + h * 64 + lane;
                const float q = bf2f(*qp), k = bf2f(*kp);
                const float mq = wave_sum(q * q) * (1.f / 64.f), mk = wave_sum(k * k) * (1.f / 64.f);
                *qp = f2bf(q * (1.0f / sqrtf(mq + 1e-6f)) * q_g[lane] * (0.125f * LOG2E));
                *kp = f2bf(k * (1.0f / sqrtf(mk + 1e-6f)) * k_g[lane]);
            }
            if (gw < 64) {
                const int b = gw >> 3, h = gw & 7; constexpr int PER = 33;
                float loc[PER]; float s = 0.f;
#pragma unroll
                for (int i = 0; i < PER; ++i) { const int t = lane * PER + i; float v = 0.f;
                    if (t < LTOT) { const float z = pn[(size_t)rowof(b, t) * PNW + 288 + h] + b_f[h]; v = (fminf(z, 0.f) - log1pf(__expf(-fabsf(z)))) * LOG2E; }
                    s += v; loc[i] = s; }
                float incl = s;
#pragma unroll
                for (int o = 1; o < 64; o <<= 1) { const float n = __shfl_up(incl, o); if (lane >= o) incl += n; }
                const float base = incl - s;
                float* cv = c2 + (size_t)gw * 2176;
#pragma unroll
                for (int i = 0; i < PER; ++i) { const int t = lane * PER + i; if (t < LTOT) cv[t < NMETA ? t : t + 112] = base + loc[i]; }
                cv[16 + lane] = 1e5f; if (lane < 48) cv[80 + lane] = 1e5f;
            }
        }
        GRID_BAR();
        {
            PHASE_IDS();
            typedef short s16x4 __attribute__((ext_vector_type(4)));
            for (int unit = bid; unit < 64; unit += G) {
                const int b = unit >> 3, h = unit & 7, cg = h * 64 + lane, fr = lane & 15, fq = lane >> 4, v = 16 * (wave & 3) + fr;
                const unsigned char* RA0 = ws + WS_RA + (size_t)unit * NCH * RA_BYTES; const unsigned char* RB0 = ws + WS_RB + (size_t)unit * NCH * RB_BYTES;
                const float gnw = (a.in[13] + l * 512)[cg], gnb = (a.in[14] + l * 512)[cg];
                float* YB = (float*)lds;
                f32x4 Z[4];
#pragma unroll
                for (int kb = 0; kb < 4; ++kb) Z[kb] = (f32x4){0.f, 0.f, 0.f, 0.f};
                for (int c0 = 0; c0 < NCH; c0 += 4) {
                    const int nc = (NCH - c0) < 4 ? (NCH - c0) : 4;
                    if (wave < 4) {
                        for (int cs = 0; cs < nc; ++cs) {
                            const unsigned char* ra = RA0 + (size_t)(c0 + cs) * RA_BYTES; const unsigned char* rb = RB0 + (size_t)(c0 + cs) * RB_BYTES;
                            const bf16x8 ah0 = *(const bf16x8*)(ra + (fr * 64 + fq * 8) * 2), ah1 = *(const bf16x8*)(ra + (fr * 64 + 32 + fq * 8) * 2);
                            const bf16x8 rh0 = *(const bf16x8*)(ra + 2048 + (fr * 64 + fq * 8) * 2), rh1 = *(const bf16x8*)(ra + 2048 + (fr * 64 + 32 + fq * 8) * 2);
                            bf16x8 bk[4]; f32x4 gam[4];
#pragma unroll
                            for (int kb = 0; kb < 4; ++kb) { bk[kb] = *(const bf16x8*)(ra + 4096 + ((16 * kb + fr) * 32 + 8 * fq) * 2); gam[kb] = *(const f32x4*)(rb + 3584 + (16 * kb + 4 * fq) * 4); }
                            const u32x2 vt = *(const u32x2*)(rb + (v * 16 + 4 * fq) * 2);
                            const bf16x8 mrk = *(const bf16x8*)(rb + 2048 + (fr * 32 + 8 * fq) * 2);
                            const u32x2 g4 = *(const u32x2*)(rb + 3072 + (fr * 16 + 4 * fq) * 2);
                            u32x4 zw01, zw23;
                            zw01.x = pk2bf(Z[0][0], Z[0][1]); zw01.y = pk2bf(Z[0][2], Z[0][3]); zw01.z = pk2bf(Z[1][0], Z[1][1]); zw01.w = pk2bf(Z[1][2], Z[1][3]);
                            zw23.x = pk2bf(Z[2][0], Z[2][1]); zw23.y = pk2bf(Z[2][2], Z[2][3]); zw23.z = pk2bf(Z[3][0], Z[3][1]); zw23.w = pk2bf(Z[3][2], Z[3][3]);
                            const bf16x8 zp01 = __builtin_bit_cast(bf16x8, zw01), zp23 = __builtin_bit_cast(bf16x8, zw23);
                            f32x4 U = (f32x4){0.f, 0.f, 0.f, 0.f}, Yv = U;
                            U = __builtin_amdgcn_mfma_f32_16x16x32_bf16(ah0, zp01, U, 0, 0, 0); U = __builtin_amdgcn_mfma_f32_16x16x32_bf16(ah1, zp23, U, 0, 0, 0);
                            U = __builtin_amdgcn_mfma_f32_16x16x16bf16_1k(__builtin_bit_cast(s16x4, g4), __builtin_bit_cast(s16x4, vt), U, 0, 0, 0);
                            Yv = __builtin_amdgcn_mfma_f32_16x16x32_bf16(rh0, zp01, Yv, 0, 0, 0); Yv = __builtin_amdgcn_mfma_f32_16x16x32_bf16(rh1, zp23, Yv, 0, 0, 0);
                            u32x4 uvw; uvw.x = pk2bf(U[0], U[1]); uvw.y = pk2bf(U[2], U[3]); uvw.z = vt.x; uvw.w = vt.y;
                            const bf16x8 uv = __builtin_bit_cast(bf16x8, uvw);
                            Yv = __builtin_amdgcn_mfma_f32_16x16x32_bf16(mrk, uv, Yv, 0, 0, 0);
#pragma unroll
                            for (int kb = 0; kb < 4; ++kb) { Z[kb] = Z[kb] * gam[kb]; Z[kb] = __builtin_amdgcn_mfma_f32_16x16x32_bf16(bk[kb], uv, Z[kb], 0, 0, 0); }
#pragma unroll
                            for (int r = 0; r < 4; ++r) YB[(cs * 16 + 4 * fq + r) * 68 + v] = Yv[r];
                        }
                    }
                    __syncthreads();
                    for (int tk = wave; tk < nc * 16; tk += NWAVES) {
                        const int cc = c0 + (tk >> 4), i = tk & 15, t = 16 * cc + i, row = rowof(b, t);
                        const float yv = YB[tk * 68 + lane];
                        const float mean = wave_sum(yv) * (1.f / 64.f); const float d = yv - mean; const float var = wave_sum(d * d) * (1.f / 64.f);
                        float o = d * (1.0f / sqrtf(var + 64e-5f)) * gnw + gnb;
                        const unsigned char* rbp = RB0 + (size_t)cc * RB_BYTES;
                        o += ((const float*)(rbp + 3840))[i] * bf2f(((const bf16_t*)rbp)[lane * 16 + i]);
                        if (t >= NMETA || b == 0) { bf16_t* yp = y + (size_t)row * DM + cg; *yp = f2bf(o * bf2f(*yp)); }
                    }
                    __syncthreads();
                }
            }
        }
        {
            PHASE_IDS();
            if (gw < NH * NMETA) {
                const int h = gw >> 4, t = gw & 15;
                const bf16_t* qrow = p + (size_t)(MROWS + t) * PBW + 1536 + h * 64;
                float s = -INFINITY;
                if (lane <= t) { const bf16_t* kr = p + (size_t)(MROWS + lane) * PBW + 2048 + h * 64; float d = 0.f;
                    for (int e = 0; e < 64; ++e) d += bf2f(qrow[e]) * bf2f(kr[e]);
                    s = d - c2[(size_t)h * 2176 + lane]; }
                const float mx = wave_max(s); const float e = lane <= t ? exp2f(s - mx) : 0.f; const float sum = wave_sum(e);
                float o = 0.f;
                for (int j = 0; j <= t; ++j) o += __shfl(e, j) * bf2f(p[(size_t)(MROWS + j) * PBW + 2560 + h * 64 + lane]);
                o /= sum;
                const float og = bf2f(p[(size_t)(MROWS + t) * PBW + 3072 + h * 64 + lane]);
                y[(size_t)(MROWS + t) * DM + 512 + h * 64 + lane] = f2bf(o * sigmoidf_(og));
            }
        }
        __syncthreads();
        {
            typedef attn_body::bf16 abf;
            const attn_body::AttnTensors AT{(const abf*)(p + 1536), (const abf*)(p + 2048), (const abf*)(p + 2560), (const abf*)(p + 3072), c2, (abf*)(y + 512)};
            const attn_body::StaticOrder S(G, bid);
            attn_body::attn_phase<attn_body::StaticOrder>((char*)lds, AT, S);
        }
        GRID_BAR();
        {
            PHASE_IDS();
            pg8::Gemm g{y, W2, MROWS, DM, DM}; pg8::StaticOrder S; S.init(MROWS, DM, G, bid);
            pg8::EpiRes E{out, hb, ssqp};
            pg8::gemm_phase<pg8::EpiRes, pg8::StaticOrder, true, true>(ldsl, g, S, E);
            meta_gemm<false>(y + (size_t)MROWS * DM, DM, W2, DM, DM, gw, ngw, lane, MEpiRes{hm});
        }
        GRID_BAR();
        for (int t0 = 0; t0 < 22; t0 += 6) {
            const int nt = (22 - t0) < 6 ? (22 - t0) : 6, ldr = nt * 256;
            {
                PHASE_IDS();
                pg8::Gemm g{hb, W3 + (size_t)t0 * 256 * DM, MROWS, ldr, DM}; pg8::StaticOrder S; S.init(MROWS, ldr, G, bid);
                pg8::Epi3Raw E{ssqp, raw, ldr};
                pg8::gemm_phase<pg8::Epi3Raw, pg8::StaticOrder, true, true>(ldsl, g, S, E);
                meta_gemm<true>(hm, DM, W3 + (size_t)t0 * 256 * DM, ldr, DM, gw, ngw, lane, MEpi3{raw, ldr});
            }
            GRID_BAR();
            {
                PHASE_IDS();
                const float* cw = a.in[21] + (size_t)l * 3 * DFF2; const float* cb = a.in[22] + (size_t)l * DFF2;
                const int per_row = nt * 128; const size_t total = (size_t)RROWS * per_row;
                for (size_t e = (size_t)bid * (NWAVES * 64) + tid; e < total; e += (size_t)G * (NWAVES * 64)) {
                    const int row = (int)(e / per_row), jj = (int)(e % per_row), tl = jj >> 7, c = jj & 127;
                    const int ch = 128 * (t0 + tl) + c;
                    const int p1 = prevrow(row), p2 = p1 >= 0 ? prevrow(p1) : -1;
                    const int cu = tl * 256 + c, cgt = cu + 128;
                    float u = cb[ch] + cw[2 * DFF2 + ch] * bf2f(raw[(size_t)row * ldr + cu]);
                    float g = cb[DFF + ch] + cw[2 * DFF2 + DFF + ch] * bf2f(raw[(size_t)row * ldr + cgt]);
                    if (p1 >= 0) { u += cw[DFF2 + ch] * bf2f(raw[(size_t)p1 * ldr + cu]); g += cw[DFF2 + DFF + ch] * bf2f(raw[(size_t)p1 * ldr + cgt]); }
                    if (p2 >= 0) { u += cw[ch] * bf2f(raw[(size_t)p2 * ldr + cu]); g += cw[DFF + ch] * bf2f(raw[(size_t)p2 * ldr + cgt]); }
                    act[(size_t)row * DFF + ch] = f2bf(g * sigmoidf_(g) * u);
                }
            }
            GRID_BAR();
        }
        {
            PHASE_IDS();
            pg8::Gemm g{act, W4, MROWS, DM, DFF}; pg8::StaticOrder S; S.init(MROWS, DM, G, bid);
            pg8::EpiRes E{out, hb, ssqp};
            pg8::gemm_phase<pg8::EpiRes, pg8::StaticOrder, true, true>(ldsl, g, S, E);
            meta_gemm<false>(act + (size_t)MROWS * DFF, DFF, W4, DM, DFF, gw, ngw, lane, MEpiRes{hm});
        }
        if (l + 1 < DEPTH) GRID_BAR();
    }
}

extern "C" void kernel_launch(void* const* d_in, const int* in_sizes, int n_in, void* d_out, int out_size, void* d_ws, size_t ws_size, hipStream_t stream) {
    static int grid = 0;
    if (grid == 0) {
        if (n_in != 24 || out_size != MROWS * DM || ws_size < WS_END) { fprintf(stderr, "kernel_launch: unexpected shapes (n_in %d out %d ws %zu)\n", n_in, out_size, ws_size); grid = -1; return; }
        int dev = 0, cus = 0, per_cu = 0;
        hipGetDevice(&dev); hipDeviceGetAttribute(&cus, hipDeviceAttributeMultiprocessorCount, dev);
        if (hipFuncSetAttribute((const void*)mk_fwd, hipFuncAttributeMaxDynamicSharedMemorySize, LDS_BYTES) != hipSuccess) { fprintf(stderr, "kernel_launch: hipFuncSetAttribute failed\n"); grid = -1; return; }
        hipOccupancyMaxActiveBlocksPerMultiprocessor(&per_cu, (const void*)mk_fwd, NWAVES * 64, LDS_BYTES);
        (void)hipGetLastError();
        if (per_cu < 1) { fprintf(stderr, "kernel_launch: occupancy query says %d blocks per CU\n", per_cu); }
        grid = cus;
    }
    if (grid < 0) return;
    hipMemsetAsync((char*)d_ws + WS_CTL, 0, CTL_ZERO_BYTES, stream);
    Args a{};
    for (int i = 0; i < 24; ++i) a.in[i] = (const float*)d_in[i];
    a.out = (float*)d_out; a.ws = (unsigned char*)d_ws;
    void* args[] = {&a};
    hipError_t e = hipLaunchCooperativeKernel((const void*)mk_fwd, dim3(grid), dim3(NWAVES * 64), args, LDS_BYTES, stream);
    if (e != hipSuccess) fprintf(stderr, "cooperative launch failed: %s (grid %d)\n", hipGetErrorString(e), grid);
}
```

```cpp
#include <hip/hip_runtime.h>
#include <hip/hip_cooperative_groups.h>
#include <stdint.h>
#include <cstdio>
namespace cg = cooperative_groups;

typedef unsigned short bf16_t;
typedef short bf16x8 __attribute__((ext_vector_type(8)));
typedef float f32x4 __attribute__((ext_vector_type(4)));
typedef unsigned u32x4 __attribute__((ext_vector_type(4)));
typedef unsigned u32x2 __attribute__((ext_vector_type(2)));

constexpr int NB = 8, SEQ = 2048, NMETA = 16, LTOT = 2064, DM = 1024, DEPTH = 4, NH = 8, HD = 64;
constexpr int N_IN = 3880, DFF = 2816, DFF2 = 5632;
constexpr int MROWS = NB * SEQ;
constexpr int RROWS = MROWS + NMETA;
constexpr int N1 = 4096;
constexpr int PBW = 3584;
constexpr int PNW = 320;
constexpr float LOG2E = 1.4426950408889634f;

constexpr size_t MiB = 1u << 20;
constexpr size_t WS_CTL = 0, CTL_ZERO_BYTES = 1 * MiB;
constexpr size_t WS_W = 1 * MiB, WL_BYTES = 27 * MiB;
constexpr size_t WO_W1 = 0;
constexpr size_t WO_W2 = 8 * MiB;
constexpr size_t WO_W3 = 10 * MiB;
constexpr size_t WO_W4 = 21 * MiB;
constexpr size_t WO_LUP = 26 * MiB + 512 * 1024;
constexpr size_t WS_SMALL = WS_W + 2 * WL_BYTES;
constexpr size_t WS_HM = WS_SMALL;
constexpr size_t WS_C2 = WS_SMALL + 1 * MiB;
constexpr size_t WS_SSQ = WS_SMALL + 3 * MiB;
constexpr size_t WS_HB = WS_SMALL + 6 * MiB;
constexpr size_t WS_P = WS_HB + 33 * MiB;
constexpr size_t WS_PN = WS_P + 113 * MiB;
constexpr size_t WS_Y = WS_PN + 21 * MiB;
constexpr size_t WS_FREE = WS_Y + 33 * MiB;
constexpr int NCH = 129;
constexpr size_t RA_BYTES = 8192, RB_BYTES = 4096;
constexpr size_t WS_RA = WS_FREE;
constexpr size_t WS_RB = WS_HB;
#define SWZ4(r) (3 * (((r) >> 3) & 1))
constexpr size_t WS_ACT = WS_P;
constexpr size_t WS_RAW = WS_PN;
constexpr size_t WS_BV = WS_RA + 65 * MiB;
constexpr size_t WS_END = WS_BV + 17 * MiB;

__device__ __forceinline__ float bf2f(bf16_t v) { return __uint_as_float(((unsigned)v) << 16); }
__device__ __forceinline__ bf16_t f2bf(float f) { unsigned u = __float_as_uint(f); return (bf16_t)((u + 0x7fffu + ((u >> 16) & 1u)) >> 16); }
__device__ __forceinline__ unsigned pk2bf(float lo, float hi) { return (unsigned)f2bf(lo) | ((unsigned)f2bf(hi) << 16); }
__device__ __forceinline__ float sigmoidf_(float x) { return 1.f / (1.f + __expf(-x)); }
__device__ __forceinline__ float wave_sum(float v) {
#pragma unroll
    for (int o = 1; o < 64; o <<= 1) v += __shfl_xor(v, o);
    return v;
}
__device__ __forceinline__ float wave_max(float v) {
#pragma unroll
    for (int o = 1; o < 64; o <<= 1) v = fmaxf(v, __shfl_xor(v, o));
    return v;
}
#define WAVE_LDS_SYNC() do { __builtin_amdgcn_s_waitcnt(0xc07f); __builtin_amdgcn_wave_barrier(); } while (0)
__device__ __forceinline__ int rowof(int b, int t) { return t < NMETA ? MROWS + t : b * SEQ + (t - NMETA); }
__device__ __forceinline__ int prevrow(int row) {
    if (row >= MROWS) return row == MROWS ? -1 : row - 1;
    return (row & (SEQ - 1)) ? row - 1 : MROWS + NMETA - 1;
}

__device__ __forceinline__ int src_col(int mode, int n) {
    if (mode == 1) {
        const int g = n >> 9, o = n & 511;
        switch (g) {
            case 0: return o;
            case 1: return 512 + o;
            case 2: return 1024 + o;
            case 3: return 1824 + o;
            case 4: return 2336 + o;
            case 5: return 2848 + o;
            case 6: return 3360 + o;
            default:
                if (o < 64) return 1536 + o;
                if (o < 128) return 1600 + (o - 64);
                if (o < 288) return 1664 + (o - 128);
                if (o < 296) return 3872 + (o - 288);
                return -1;
        }
    }
    if (mode == 3) { const int t = n >> 8, c = n & 255; return c < 128 ? 128 * t + c : DFF + 128 * t + (c - 128); }
    return n;
}
__device__ __forceinline__ void wprep_item(const float* W, const float* gk, bf16_t* WT, int K, int Nsrc, int Ndst, int mode, int item, float* scr, int lane) {
    const int nblk = Ndst / 32, kb = item / nblk, nb = item % nblk, k0 = 64 * kb, n0 = 32 * nb;
    const int sc = src_col(mode, n0 + (lane & 31));
#pragma unroll 8
    for (int i = 0; i < 32; ++i) {
        const int kk = 2 * i + (lane >> 5);
        float v = 0.f;
        if (sc >= 0) { v = W[(size_t)(k0 + kk) * Nsrc + sc]; if (gk) v *= gk[k0 + kk]; }
        scr[kk * 33 + (lane & 31)] = v;
    }
    WAVE_LDS_SYNC();
    const int c = lane & 7;
#pragma unroll
    for (int j = 0; j < 4; ++j) {
        const int n = (lane >> 3) + 8 * j; const float* s = scr + (8 * c) * 33 + n;
        u32x4 o;
        o.x = pk2bf(s[0 * 33], s[1 * 33]); o.y = pk2bf(s[2 * 33], s[3 * 33]); o.z = pk2bf(s[4 * 33], s[5 * 33]); o.w = pk2bf(s[6 * 33], s[7 * 33]);
        *(u32x4*)(WT + (size_t)(n0 + n) * K + k0 + 8 * c) = o;
    }
    WAVE_LDS_SYNC();
}
namespace pg8 {
#define PG8_LAS __attribute__((address_space(3)))
typedef unsigned short bf16_t;
typedef short bf16x8 __attribute__((ext_vector_type(8)));
typedef float f32x4 __attribute__((ext_vector_type(4)));
typedef unsigned u32x4 __attribute__((ext_vector_type(4)));
constexpr int BM = 256, BK = 64, HALF = 128, HTB = HALF * BK * 2  , STAGE_BYTES = 8 * HTB, NXCD = 8, WGM = 8;

__host__ __device__ __forceinline__ int lds_byte(int r, int c) { const int st = (r >> 4) * 2 + (c >> 5), rr = r & 15, cc = c & 31, ob = rr * 64 + cc * 2; return st * 1024 + (ob ^ (((ob >> 9) & 1) << 5)); }
__host__ __device__ __forceinline__ void stage_rc(int b, int& R, int& C) { const int st = b / 1024, sb = b % 1024, swz = sb ^ (((sb >> 9) & 1) << 5); R = (st >> 1) * 16 + swz / 64; C = (st & 1) * 32 + (swz % 64) / 2; }
__host__ __device__ __forceinline__ int perm32(int rho) { const int n = rho >> 4, i = rho & 15; return 8 * (i >> 2) + 4 * n + (i & 3); }

struct Unit { int pm, pn; };
struct Gemm { const bf16_t* A; const bf16_t* Bt; int M, N, K; };

struct StaticOrder {
    int nM, nN, nwg, G, c;
    __host__ __device__ void init(int M, int N, int G_, int c_) { nM = M / BM; nN = N / BM; nwg = nM * nN; G = G_; c = c_; }
    __host__ __device__ bool next(int i, Unit& u) const {
        const long L = (long)i * G + c; if (L >= nwg) return false;
        int wgid = (int)L; { const int q = nwg / NXCD, r = nwg % NXCD, xcd = wgid % NXCD, off = wgid / NXCD; wgid = (xcd < r ? xcd * (q + 1) : r * (q + 1) + (xcd - r) * q) + off; }
        const int nig = WGM * nN, gid = wgid / nig, fm = gid * WGM, gsz = (nM - fm) < WGM ? (nM - fm) : WGM;
        u.pm = fm + ((wgid % nig) % gsz); u.pn = (wgid % nig) / gsz; return true;
    }
    __device__ __forceinline__ void a_ready(const Unit&) const {}
    __device__ __forceinline__ void done(const Unit&) const {}
};

__device__ __forceinline__ float row_rstd(const float* ssqp, int row) {
    const f32x4* sp = (const f32x4*)(ssqp + (size_t)row * 16);
    const f32x4 a = sp[0], b = sp[1], c = sp[2], d = sp[3];
    const float s = (((a.x + a.y) + (a.z + a.w)) + ((b.x + b.y) + (b.z + b.w))) + (((c.x + c.y) + (c.z + c.w)) + ((d.x + d.y) + (d.z + d.w)));
    return 1.0f / sqrtf(s * (1.f / 1024.f) + 1e-6f);
}
struct Epi1 {
    static constexpr bool PERM = false, AFTER_DRAIN = false;
    const float* ssqp; bf16_t* p; float* pn;
    __device__ __forceinline__ void operator()(const f32x4 (&acc)[2][2][4][2], const Unit& u, int wr, int wc, int fr, int fq) const {
        const int row0 = u.pm * BM + wr * 64 + fr, col0 = u.pn * BM + wc * 32 + 4 * fq;
#pragma unroll
        for (int ai = 0; ai < 2; ++ai)
#pragma unroll
            for (int m = 0; m < 4; ++m) {
                const int row = row0 + ai * HALF + m * 16; const float rs = row_rstd(ssqp, row);
#pragma unroll
                for (int bj = 0; bj < 2; ++bj)
#pragma unroll
                    for (int n = 0; n < 2; ++n) {
                        const f32x4 v = acc[ai][bj][m][n] * rs; const int col = col0 + bj * HALF + n * 16;
                        if (u.pn < 14) { u32x2 w; w.x = pk2bf(v[0], v[1]); w.y = pk2bf(v[2], v[3]); *(u32x2*)(p + (size_t)row * PBW + col) = w; }
                        else { const int o = col - PBW; if (o < 296) *(f32x4*)(pn + (size_t)row * PNW + o) = v; }
                    }
            }
    }
};
struct EpiRes {
    static constexpr bool PERM = false, AFTER_DRAIN = false;
    float* h; bf16_t* hb; float* ssqp;
    __device__ __forceinline__ void operator()(const f32x4 (&acc)[2][2][4][2], const Unit& u, int wr, int wc, int fr, int fq) const {
        const int row0 = u.pm * BM + wr * 64 + fr, col0 = u.pn * BM + wc * 32 + 4 * fq;
#pragma unroll
        for (int ai = 0; ai < 2; ++ai)
#pragma unroll
            for (int m = 0; m < 4; ++m) {
                const int row = row0 + ai * HALF + m * 16; float ss = 0.f;
#pragma unroll
                for (int bj = 0; bj < 2; ++bj)
#pragma unroll
                    for (int n = 0; n < 2; ++n) {
                        const int col = col0 + bj * HALF + n * 16; float* hp = h + (size_t)row * DM + col;
                        const f32x4 v = *(const f32x4*)hp + acc[ai][bj][m][n];
                        *(f32x4*)hp = v; u32x2 w; w.x = pk2bf(v[0], v[1]); w.y = pk2bf(v[2], v[3]); *(u32x2*)(hb + (size_t)row * DM + col) = w;
                        ss += (v[0] * v[0] + v[1] * v[1]) + (v[2] * v[2] + v[3] * v[3]);
                    }
                ss += __shfl_xor(ss, 16); ss += __shfl_xor(ss, 32);
                if (fq == 0) ssqp[(size_t)row * 16 + u.pn * 4 + wc] = ss;
            }
    }
};
struct Epi3Raw {
    static constexpr bool PERM = false, AFTER_DRAIN = false;
    const float* ssqp; bf16_t* raw; int ldr;
    __device__ __forceinline__ void operator()(const f32x4 (&acc)[2][2][4][2], const Unit& u, int wr, int wc, int fr, int fq) const {
        const int row0 = u.pm * BM + wr * 64 + fr, col0 = u.pn * BM + wc * 32 + 4 * fq;
#pragma unroll
        for (int ai = 0; ai < 2; ++ai)
#pragma unroll
            for (int m = 0; m < 4; ++m) {
                const int row = row0 + ai * HALF + m * 16; const float rs = row_rstd(ssqp, row);
#pragma unroll
                for (int bj = 0; bj < 2; ++bj)
#pragma unroll
                    for (int n = 0; n < 2; ++n) {
                        const f32x4 v = acc[ai][bj][m][n] * rs; const int col = col0 + bj * HALF + n * 16;
                        u32x2 w; w.x = pk2bf(v[0], v[1]); w.y = pk2bf(v[2], v[3]); *(u32x2*)(raw + (size_t)row * ldr + col) = w;
                    }
            }
    }
};

template <class Epi, class Sched, bool ALIGN_EPI = false, bool SP2 = false>
__device__ __forceinline__ void gemm_phase(PG8_LAS unsigned char* lds, const Gemm g, const Sched& S, const Epi& E) {
    int tid_ = threadIdx.x; asm volatile("" : "+v"(tid_));
    const int tid = tid_, wid = __builtin_amdgcn_readfirstlane(tid >> 6), lane = tid & 63, wr = wid >> 2, wc = wid & 3, fr = lane & 15, fq = lane >> 4;
    const int K = g.K, nt = K / BK;
    unsigned voffA[2], voffB[2];
#pragma unroll
    for (int i = 0; i < 2; ++i) { int R, C; stage_rc(tid * 16 + i * 8192, R, C); const int Rb = Epi::PERM ? ((R & ~31) + perm32(R & 31)) : R;
        voffA[i] = (unsigned)(R * K + C) * 2u; voffB[i] = (unsigned)(Rb * K + C) * 2u; }
    const size_t kstep = (size_t)(BK * 2);
    const size_t hstep = (size_t)HALF * K * 2;
    const size_t tstep = 2 * hstep;
    const unsigned ldsw = (unsigned)wid * 1024u;
    const int aoff = lds_byte(wr * 64 + fr, fq * 8), boff = lds_byte(wc * 32 + fr, fq * 8);
#define PG8_SA(b, h) (((b) * 2 + (h)) * HTB)
#define PG8_SB(b, h) ((4 + (b) * 2 + (h)) * HTB)
#define PG8_STAGE(bufoff, gbase, voff) do { _Pragma("unroll") for (int _i = 0; _i < 2; ++_i) \
        __builtin_amdgcn_global_load_lds((const unsigned*)((const char*)(gbase) + (voff)[_i]), (PG8_LAS unsigned*)(lds + (bufoff) + ldsw + _i * 8192), 16, 0, 0); } while (0)
#define PG8_LDA(dst, b, h) do { _Pragma("unroll") for (int m = 0; m < 4; ++m) _Pragma("unroll") for (int k = 0; k < 2; ++k) dst[m][k] = *(const PG8_LAS bf16x8*)(lds + PG8_SA(b, h) + aoff + m * 2048 + k * 1024); } while (0)
#define PG8_LDB(dst, b, h) do { _Pragma("unroll") for (int n = 0; n < 2; ++n) _Pragma("unroll") for (int k = 0; k < 2; ++k) dst[n][k] = *(const PG8_LAS bf16x8*)(lds + PG8_SB(b, h) + boff + n * 2048 + k * 1024); } while (0)
#define PG8_MMA(ai, bj, At, Bt) do { __builtin_amdgcn_s_setprio(1); _Pragma("unroll") for (int m = 0; m < 4; ++m) _Pragma("unroll") for (int n = 0; n < 2; ++n) _Pragma("unroll") for (int k = 0; k < 2; ++k) \
        acc[ai][bj][m][n] = __builtin_amdgcn_mfma_f32_16x16x32_bf16(Bt[n][k], At[m][k], acc[ai][bj][m][n], 0, 0, 0); __builtin_amdgcn_s_setprio(0); } while (0)
#define PG8_WAIT_V(n) asm volatile("s_waitcnt vmcnt(" #n ")" ::: "memory")
#define PG8_WAIT_L(n) asm volatile("s_waitcnt lgkmcnt(" #n ")" ::: "memory")
#define PG8_BAR __builtin_amdgcn_s_barrier()
#define PG8_SCHED __builtin_amdgcn_sched_barrier(0)
    Unit cur, nxt; int ui = 0;
    if (!S.next(0, cur)) return;
    f32x4 acc[2][2][4][2];
#pragma unroll
    for (int a = 0; a < 2; ++a)
#pragma unroll
        for (int b = 0; b < 2; ++b)
#pragma unroll
            for (int m = 0; m < 4; ++m)
#pragma unroll
                for (int n = 0; n < 2; ++n) acc[a][b][m][n] = (f32x4){0.f, 0.f, 0.f, 0.f};
    bf16x8 At[4][2], B0[2][2], B1[2][2];
    const char* cA = (const char*)g.A + (size_t)cur.pm * tstep; const char* cB = (const char*)g.Bt + (size_t)cur.pn * tstep;
    S.a_ready(cur);
    if constexpr (SP2) {
        PG8_STAGE(PG8_SB(0, 0), cB, voffB); PG8_STAGE(PG8_SB(0, 1), cB + hstep, voffB); PG8_STAGE(PG8_SA(0, 0), cA, voffA); PG8_STAGE(PG8_SA(0, 1), cA + hstep, voffA);
        if (wr == 1) PG8_BAR;
        PG8_WAIT_V(2); PG8_BAR;
        PG8_STAGE(PG8_SB(1, 0), cB + kstep, voffB); PG8_STAGE(PG8_SA(1, 0), cA + kstep, voffA); PG8_STAGE(PG8_SB(1, 1), cB + hstep + kstep, voffB);
        PG8_WAIT_V(6); PG8_BAR;
    } else {
        PG8_STAGE(PG8_SB(0, 0), cB, voffB); PG8_STAGE(PG8_SA(0, 0), cA, voffA); PG8_STAGE(PG8_SB(0, 1), cB + hstep, voffB); PG8_STAGE(PG8_SA(0, 1), cA + hstep, voffA);
        if (wr == 1) PG8_BAR;
        PG8_WAIT_V(4); PG8_BAR;
        PG8_STAGE(PG8_SB(1, 0), cB + kstep, voffB); PG8_STAGE(PG8_SA(1, 0), cA + kstep, voffA); PG8_STAGE(PG8_SB(1, 1), cB + hstep + kstep, voffB);
        PG8_WAIT_V(6); PG8_BAR;
    }
    for (;;) {
        const bool has_next = S.next(ui + 1, nxt);
        const char* nA = has_next ? (const char*)g.A + (size_t)nxt.pm * tstep : cA; const char* nB = has_next ? (const char*)g.Bt + (size_t)nxt.pn * tstep : cB;
        for (int t = 0; t < nt; t += 2) {
            const bool last = (t == nt - 2);
            const char* a1 = cA + (size_t)(t + 1) * kstep;
            const char* a2 = last ? nA : cA + (size_t)(t + 2) * kstep; const char* b2 = last ? nB : cB + (size_t)(t + 2) * kstep;
            const char* a3 = a2 + kstep; const char* b3 = b2 + kstep;
            if (last && has_next) S.a_ready(nxt);
            if constexpr (SP2) {
            PG8_LDB(B0, 0, 0); PG8_LDB(B1, 0, 1); PG8_SCHED; PG8_LDA(At, 0, 0); PG8_STAGE(PG8_SA(1, 1), a1 + hstep, voffA);
            PG8_WAIT_V(8); PG8_WAIT_L(0); PG8_BAR; PG8_MMA(0, 0, At, B0); PG8_MMA(0, 1, At, B1); PG8_BAR; PG8_SCHED;
            PG8_LDA(At, 0, 1); PG8_STAGE(PG8_SB(0, 0), b2, voffB); PG8_STAGE(PG8_SB(0, 1), b2 + hstep, voffB); PG8_STAGE(PG8_SA(0, 0), a2, voffA);
            PG8_WAIT_V(8); PG8_WAIT_L(0); PG8_BAR; PG8_MMA(1, 0, At, B0); PG8_MMA(1, 1, At, B1); PG8_BAR; PG8_SCHED;
            PG8_LDB(B0, 1, 0); PG8_LDB(B1, 1, 1); PG8_SCHED; PG8_LDA(At, 1, 0); PG8_STAGE(PG8_SA(0, 1), a2 + hstep, voffA);
            PG8_WAIT_V(8); PG8_WAIT_L(0); PG8_BAR; PG8_MMA(0, 0, At, B0); PG8_MMA(0, 1, At, B1); PG8_BAR; PG8_SCHED;
            PG8_LDA(At, 1, 1); PG8_STAGE(PG8_SB(1, 0), b3, voffB); PG8_STAGE(PG8_SB(1, 1), b3 + hstep, voffB); PG8_STAGE(PG8_SA(1, 0), a3, voffA);
            PG8_WAIT_V(8); PG8_WAIT_L(0); PG8_BAR; PG8_MMA(1, 0, At, B0); PG8_MMA(1, 1, At, B1); PG8_BAR; PG8_SCHED;
            } else {
            PG8_LDB(B0, 0, 0); PG8_SCHED; PG8_LDA(At, 0, 0); PG8_STAGE(PG8_SA(1, 1), a1 + hstep, voffA);
            PG8_WAIT_L(8); PG8_BAR; PG8_WAIT_L(0); PG8_MMA(0, 0, At, B0); PG8_BAR; PG8_SCHED;
            PG8_LDB(B1, 0, 1); PG8_STAGE(PG8_SB(0, 0), b2, voffB);
            PG8_BAR; PG8_WAIT_L(0); PG8_MMA(0, 1, At, B1); PG8_BAR;
            PG8_LDA(At, 0, 1); PG8_STAGE(PG8_SA(0, 0), a2, voffA);
            PG8_BAR; PG8_WAIT_L(0); PG8_MMA(1, 0, At, B0); PG8_BAR; PG8_SCHED;
            PG8_STAGE(PG8_SB(0, 1), b2 + hstep, voffB);
            PG8_WAIT_V(6); PG8_BAR; PG8_MMA(1, 1, At, B1); PG8_BAR;
            PG8_LDB(B0, 1, 0); PG8_SCHED; PG8_LDA(At, 1, 0); PG8_STAGE(PG8_SA(0, 1), a2 + hstep, voffA);
            PG8_WAIT_L(8); PG8_BAR; PG8_WAIT_L(0); PG8_MMA(0, 0, At, B0); PG8_BAR; PG8_SCHED;
            PG8_LDB(B1, 1, 1); PG8_STAGE(PG8_SB(1, 0), b3, voffB);
            PG8_BAR; PG8_WAIT_L(0); PG8_MMA(0, 1, At, B1); PG8_BAR;
            PG8_LDA(At, 1, 1); PG8_STAGE(PG8_SA(1, 0), a3, voffA);
            PG8_BAR; PG8_WAIT_L(0); PG8_MMA(1, 0, At, B0); PG8_BAR; PG8_SCHED;
            PG8_STAGE(PG8_SB(1, 1), b3 + hstep, voffB);
            PG8_WAIT_V(6); PG8_BAR; PG8_MMA(1, 1, At, B1); PG8_BAR;
            }
        }
        if constexpr (ALIGN_EPI) { if (wr == 0) PG8_BAR; }
        if constexpr (!Epi::AFTER_DRAIN) { E(acc, cur, wr, wc, fr, fq); S.done(cur); }
        if (!has_next) break;
#pragma unroll
        for (int a = 0; a < 2; ++a)
#pragma unroll
            for (int b = 0; b < 2; ++b)
#pragma unroll
                for (int m = 0; m < 4; ++m)
#pragma unroll
                    for (int n = 0; n < 2; ++n) acc[a][b][m][n] = (f32x4){0.f, 0.f, 0.f, 0.f};
        cur = nxt; cA = nA; cB = nB; ++ui;
        if constexpr (ALIGN_EPI) { if (wr == 1) PG8_BAR; }
    }
    PG8_WAIT_V(0);
    if constexpr (!ALIGN_EPI) { if (wr == 0) PG8_BAR; }
    PG8_BAR;
    if constexpr (Epi::AFTER_DRAIN) { E.fused(acc, cur, wr, wc, fr, fq, lds, wid, lane); S.done(cur); }
#undef PG8_SA
#undef PG8_SB
#undef PG8_STAGE
#undef PG8_LDA
#undef PG8_LDB
#undef PG8_MMA
#undef PG8_WAIT_V
#undef PG8_WAIT_L
#undef PG8_BAR
#undef PG8_SCHED
}
}
#include <hip/hip_bf16.h>
#include <cmath>
namespace attn_body {
using bf16=__hip_bfloat16;
using bf16x8=__attribute__((ext_vector_type(8)))short;
using s16x4=__attribute__((ext_vector_type(4)))short;
using f32x16=__attribute__((ext_vector_type(16)))float;
using u32x4=__attribute__((ext_vector_type(4)))unsigned;
constexpr int BATCH=8,NHEAD=8,SEQ=2048,D=64,PITCH=3584,OPITCH=1024,LEADROW=16384,VK=2176;
constexpr int NW=8,QBLK=32,QB=QBLK*NW,KVBLK=64,NQB=SEQ/QB;
constexpr int ATTN_UNIT_ROWS=QB;
__device__ __forceinline__ int crow(int r,int hi){return (r&3)+8*(r>>2)+4*hi;}
#define SBAR() __builtin_amdgcn_sched_barrier(0)
__device__ __forceinline__ void cmask(f32x16&p0,f32x16&p1,int jb,int qrel,int hi){
  const float NEG=-INFINITY; int kb=64*jb+4*hi;
  #pragma unroll
  for(int r=0;r<16;++r){int kv=kb+(r&3)+8*(r>>2); if(kv>qrel)p0[r]=NEG; if(kv+32>qrel)p1[r]=NEG;}
}

constexpr int NSLOT=3, SLOTB=8192;
constexpr int LDS_K=0, LDS_V=NSLOT*SLOTB, LDS_WS=2*NSLOT*SLOTB, LDS_OST=LDS_WS+NW*64*4, LDS_C2=LDS_OST+NW*4096, LDS_BYTES=LDS_C2+VK*4;
constexpr float C2=0.125f*1.4426950408889634f;
__device__ __forceinline__ void glds16(const void*gsrc,unsigned lds_dst){unsigned keep;
  asm volatile("s_mov_b32 %0, m0\n\ts_mov_b32 m0, %2\n\ts_nop 0\n\tglobal_load_lds_dwordx4 %1, off\n\ts_mov_b32 m0, %0":"=&s"(keep):"v"(gsrc),"s"(lds_dst):"memory");}
__device__ __forceinline__ float max3f(float a,float b,float c){float r;asm("v_max3_f32 %0, %1, %2, %3":"=v"(r):"v"(a),"v"(b),"v"(c));return r;}
__device__ __forceinline__ float max2f(float a,float b){float r;asm("v_max_f32_e32 %0, %1, %2":"=v"(r):"v"(a),"v"(b));return r;}
__device__ __forceinline__ float fadd_s(float a,float b){float r;asm("v_add_f32_e32 %0, %1, %2":"=v"(r):"v"(a),"v"(b));return r;}
__device__ __forceinline__ float fsub_s(float a,float b){float r;asm("v_sub_f32_e32 %0, %1, %2":"=v"(r):"v"(a),"v"(b));return r;}
typedef float f32x2_t __attribute__((ext_vector_type(2))); typedef __bf16 bf16x2_t __attribute__((ext_vector_type(2)));
__device__ __forceinline__ unsigned cvtpk_s(float lo,float hi){f32x2_t v={lo,hi};bf16x2_t b=__builtin_convertvector(v,bf16x2_t);return __builtin_bit_cast(unsigned,b);}
#define WAIT_BAR(N) asm volatile("s_waitcnt vmcnt(" #N ") lgkmcnt(0)\n\ts_barrier":::"memory")

__device__ __forceinline__ void qkt(f32x16&p0,f32x16&p1,const char*Kslot,const bf16x8*qr,int r32,int hi){
  const char*kb=Kslot+hi*1024+r32*16;
  #pragma unroll
  for(int d0=0;d0<4;++d0){
    const bf16x8 b0=*reinterpret_cast<const bf16x8*>(kb+d0*2048);
    const bf16x8 b1=*reinterpret_cast<const bf16x8*>(kb+d0*2048+512);
    p0=__builtin_amdgcn_mfma_f32_32x32x16_bf16(b0,qr[d0],p0,0,0,0);p1=__builtin_amdgcn_mfma_f32_32x32x16_bf16(b1,qr[d0],p1,0,0,0);}
}
typedef __attribute__((address_space(3))) const char* lds_cptr;
typedef short v4i16_t __attribute__((ext_vector_type(4)));
__device__ __forceinline__ void kload8(bf16x8*kf,lds_cptr kp){
  kf[0]=*(const __attribute__((address_space(3))) bf16x8*)(kp);      kf[1]=*(const __attribute__((address_space(3))) bf16x8*)(kp+512);
  kf[2]=*(const __attribute__((address_space(3))) bf16x8*)(kp+2048); kf[3]=*(const __attribute__((address_space(3))) bf16x8*)(kp+2560);
  kf[4]=*(const __attribute__((address_space(3))) bf16x8*)(kp+4096); kf[5]=*(const __attribute__((address_space(3))) bf16x8*)(kp+4608);
  kf[6]=*(const __attribute__((address_space(3))) bf16x8*)(kp+6144); kf[7]=*(const __attribute__((address_space(3))) bf16x8*)(kp+6656);
}
__device__ __forceinline__ void kload2(bf16x8*kf,lds_cptr kp,int j){ kf[2*j]=*(const __attribute__((address_space(3))) bf16x8*)(kp+j*2048); kf[2*j+1]=*(const __attribute__((address_space(3))) bf16x8*)(kp+j*2048+512); }
__device__ __forceinline__ s16x4 vtr(lds_cptr p){ return __builtin_bit_cast(s16x4,__builtin_amdgcn_ds_read_tr16_b64_v4i16((__attribute__((address_space(3))) v4i16_t*)p)); }
__device__ __forceinline__ float rowmax(const f32x16&p0,const f32x16&p1){
  float a=max3f(p0[0],p0[1],p1[0]),b=max3f(p0[2],p0[3],p1[1]);a=max3f(a,p1[2],p1[3]);
  #pragma unroll
  for(int r=4;r<16;r+=4){a=max3f(a,p0[r],p0[r+1]);b=max3f(b,p0[r+2],p0[r+3]);a=max3f(a,p1[r],p1[r+1]);b=max3f(b,p1[r+2],p1[r+3]);}
  const float m=max2f(a,b);
  auto rr=__builtin_amdgcn_permlane32_swap(__float_as_uint(m),__float_as_uint(m),false,false);
  return max2f(__uint_as_float(rr[0]),__uint_as_float(rr[1]));
}
__device__ __forceinline__ void pv(f32x16*o,int vb,bf16x8 pa0,bf16x8 pa1,bf16x8 pa2,bf16x8 pa3){
  #pragma unroll
  for(int d0=0;d0<2;++d0){s16x4 lo[4],hi[4];
    #pragma unroll
    for(int ks=0;ks<4;++ks){
      asm volatile("ds_read_b64_tr_b16 %0,%1 offset:%c2":"=&v"(lo[ks]):"v"(vb),"i"(d0*4096+ks*1024):"memory");
      asm volatile("ds_read_b64_tr_b16 %0,%1 offset:%c2":"=&v"(hi[ks]):"v"(vb),"i"(d0*4096+ks*1024+512):"memory");}
    asm volatile("s_waitcnt lgkmcnt(0)":::"memory");SBAR();
    #define PK(k) (bf16x8){lo[k][0],lo[k][1],lo[k][2],lo[k][3],hi[k][0],hi[k][1],hi[k][2],hi[k][3]}
    o[d0]=__builtin_amdgcn_mfma_f32_32x32x16_bf16(pa0,PK(0),o[d0],0,0,0);
    o[d0]=__builtin_amdgcn_mfma_f32_32x32x16_bf16(pa1,PK(1),o[d0],0,0,0);
    o[d0]=__builtin_amdgcn_mfma_f32_32x32x16_bf16(pa2,PK(2),o[d0],0,0,0);
    o[d0]=__builtin_amdgcn_mfma_f32_32x32x16_bf16(pa3,PK(3),o[d0],0,0,0);
    #undef PK
  }
}

#ifndef ATTN_STORE16
#define ATTN_STORE16(p,v) (*(u32x4*)(p)=(v))
#endif
template<int THRL> __device__ __forceinline__ void attn_unit(int b,int h,int qb,const bf16*Q,const bf16*__restrict__ K,const bf16*__restrict__ V,const bf16*__restrict__ OG,const float*__restrict__ c2v,bf16*O,char*shm){
  int tid_=threadIdx.x; asm volatile("":"+v"(tid_));
  const int tid=tid_,lane=tid&63,r32=lane&31,hi=lane>>5; const int wid=__builtin_amdgcn_readfirstlane(tid>>6);
  const long rowbase=(long)b*SEQ; const int q0=qb*QB;
  const bf16*Qw=Q+(rowbase+q0+wid*QBLK)*PITCH+h*D;
  const bf16*Kh=K+(rowbase-2*KVBLK)*PITCH+h*D,*Vh=V+(rowbase-2*KVBLK)*PITCH+h*D;
  const bf16*KhL=K+(long)LEADROW*PITCH+h*D,*VhL=V+(long)LEADROW*PITCH+h*D;
  const unsigned lds0=(unsigned)(uintptr_t)shm;
  float*wsf=(float*)(shm+LDS_WS)+wid*64;
  const bf16*ksrc=Kh+(long)lane*PITCH+wid*8,*ksrcL=KhL+(long)lane*PITCH+wid*8;
  const bf16*vsrc=Vh+(long)(16*(wid&3)+(lane>>2))*PITCH+(wid>>2)*32+(lane&3)*8,*vsrcL=VhL+(long)(16*(wid&3)+(lane>>2))*PITCH+(wid>>2)*32+(lane&3)*8;
  const unsigned kdst=lds0+LDS_K+wid*1024, vdst=lds0+LDS_V+wid*1024;
  #define DMA_K(t,slot) glds16(((t)<2?ksrcL:ksrc)+(long)(t)*KVBLK*PITCH,(unsigned)__builtin_amdgcn_readfirstlane(kdst+(slot)))
  #define DMA_V(t,slot) glds16(((t)<2?vsrcL:vsrc)+(long)(t)*KVBLK*PITCH,(unsigned)__builtin_amdgcn_readfirstlane(vdst+(slot)))
  const int vb0=(int)(lds0+LDS_V)+((lane>>4)&1)*32+(lane&3)*8+(4*hi+((lane&15)>>2))*64;
  const char*Kbase=shm+LDS_K; bf16x8 kf[8];
  const lds_cptr shm3=(lds_cptr)shm; const lds_cptr kp0=shm3+LDS_K+hi*1024+r32*16; const lds_cptr vp0=shm3+LDS_V+((lane>>4)&1)*32+(lane&3)*8+(4*hi+((lane&15)>>2))*64;
  const int NT=(q0+QB)/KVBLK+2;
  { float*negc_w=(float*)(shm+LDS_C2); const float*cs=c2v+(long)(b*NHEAD+h)*VK; for(int i=tid;i<NT*KVBLK;i+=NW*64)negc_w[i]=-cs[i]; }
  const __attribute__((address_space(3))) float* negc3=(const __attribute__((address_space(3))) float*)((lds_cptr)shm+LDS_C2)+4*hi;
  typedef float f32x4_t __attribute__((ext_vector_type(4)));
  #define NEGC(t,i) (*(const __attribute__((address_space(3))) f32x4_t*)(negc3+64*(t)+(((i)>>2)*32)+8*((i)&3)))
  DMA_K(0,0);DMA_V(0,0);DMA_K(1,SLOTB);
  bf16x8 qr[4];
  #pragma unroll
  for(int d0=0;d0<4;++d0)qr[d0]=*reinterpret_cast<const bf16x8*>(&Qw[(long)r32*PITCH+d0*16+hi*8]);
  float mhat=0.f,l_reg=0.f;f32x16 o[2];o[0]=f32x16{};o[1]=f32x16{};
  const int qrel=wid*QBLK+r32;
  #define CMASK(P0,P1,t) do{int jb_=(t)-(NT-4); if(jb_>=0)cmask(P0,P1,jb_,qrel,hi);}while(0)
  bool resc=false;
  #define START(P0,P1) do{ const float rm=rowmax(P0,P1); resc=false; \
    { const float dl=rm; mhat=fadd_s(mhat,dl); \
      _Pragma("unroll") for(int r=0;r<16;++r){P0[r]=fsub_s(P0[r],dl);P1[r]=fsub_s(P1[r],dl);} } \
    _Pragma("unroll") for(int r=0;r<16;++r)P0[r]=__builtin_amdgcn_exp2f(P0[r]); }while(0)
  #define RESC() do{ if(resc){ asm volatile("s_waitcnt lgkmcnt(0)":::"memory"); \
      _Pragma("unroll") for(int d_=0;d_<2;++d_) _Pragma("unroll") for(int r=0;r<16;++r)o[d_][r]*=wsf[crow(r,hi)]; } }while(0)
  f32x16 pA0,pA1,pB0,pB1;
  int sl_prev=0,sl_cur=0,sl_next=SLOTB;
  #define ROT() do{sl_prev=sl_cur;sl_cur=sl_next;sl_next=(sl_next==(NSLOT-1)*SLOTB)?0:sl_next+SLOTB;}while(0)
  DMA_K(2,2*SLOTB);
  WAIT_BAR(3);
  #define FILLT(P0,P1,t) do{ _Pragma("unroll") for(int i_=0;i_<4;++i_){ const f32x4_t a_=NEGC(t,i_),b_=NEGC(t,4+i_); \
      P0[4*i_]=a_[0]-mhat;P0[4*i_+1]=a_[1]-mhat;P0[4*i_+2]=a_[2]-mhat;P0[4*i_+3]=a_[3]-mhat; P1[4*i_]=b_[0]-mhat;P1[4*i_+1]=b_[1]-mhat;P1[4*i_+2]=b_[2]-mhat;P1[4*i_+3]=b_[3]-mhat; } }while(0)
  FILLT(pA0,pA1,0);
  qkt(pA0,pA1,Kbase,qr,r32,hi);asm volatile("s_nop 15\n\ts_nop 7":"+v"(pA0),"+v"(pA1));CMASK(pA0,pA1,0);
  START(pA0,pA1);
  FILLT(pB0,pB1,1);
  _Pragma("unroll") for(int r=0;r<16;++r)pA1[r]=__builtin_amdgcn_exp2f(pA1[r]);
  WAIT_BAR(0);
  DMA_K(3,0);DMA_V(1,SLOTB);
  ROT();
  kload8(kf,kp0+sl_cur);
  WAIT_BAR(2);
  s16x4 vlo[8],vhi[8]; u32x4 pw0,pw1,pw2,pw3;
  #define PKW(P,B) cvtpk_s(P[B],P[B+1])
  #define PAF(k) __builtin_bit_cast(bf16x8,pw##k)
  #define VFR(i) (bf16x8){vlo[i][0],vlo[i][1],vlo[i][2],vlo[i][3],vhi[i][0],vhi[i][1],vhi[i][2],vhi[i][3]}
  #define PIN(x) asm volatile("":"+v"(x))
  #define MX3(a,b,c) __builtin_fmaxf(__builtin_fmaxf((a),(b)),(c))
  #define GAPA(MF,A0,A1,A2,A3,W0,W1,PW) do{ MF; sacc+=A0; sacc+=A1; sacc+=A2; sacc+=A3; PIN(sacc); W0; W1; PIN(PW); SBAR(); }while(0)
  #define EX(v) __builtin_amdgcn_exp2f(v)
  #define GAPB(MF,X,B,FP,FB,I,t,GF) do{ MF; X[B]=EX(X[B]); X[B+1]=EX(X[B+1]); X[B+2]=EX(X[B+2]); X[B+3]=EX(X[B+3]); \
      if(GF){ FP[FB]=fsub_s(cn_[0],mhat); FP[FB+1]=fsub_s(cn_[1],mhat); FP[FB+2]=fsub_s(cn_[2],mhat); FP[FB+3]=fsub_s(cn_[3],mhat); PIN(FP); if((I)<7){cn_=NEGC((t)+1,(I)+1);} } \
      PIN(X); SBAR(); }while(0)
  #define VRD(i) do{ vlo[i]=vtr(vp_+(((i)>>2)*4096+((i)&3)*1024)); vhi[i]=vtr(vp_+(((i)>>2)*4096+((i)&3)*1024+512)); }while(0)
  #define KRD(G,j) do{ if(G){ kload2(kf,kp0+sl_next,j); SBAR(); } }while(0)
  #define STEP(C0,C1,P0,P1,t,GK,GV,GL) do{ SBAR(); \
    const lds_cptr vp_=vp0+sl_prev; \
    VRD(0); SBAR(); float sacc=(P0[0]+P0[1]); \
    GAPA(C0=__builtin_amdgcn_mfma_f32_32x32x16_bf16(kf[0],qr[0],C0,0,0,0), P0[2],P0[3],P0[4],P0[5],     pw0[0]=PKW(P0,0), pw0[1]=PKW(P0,2), pw0); \
    VRD(4); SBAR(); GAPA(C1=__builtin_amdgcn_mfma_f32_32x32x16_bf16(kf[1],qr[0],C1,0,0,0), P0[6],P0[7],P0[8],P0[9],     pw0[2]=PKW(P0,4), pw0[3]=PKW(P0,6), pw0); \
    VRD(1); SBAR(); GAPA(C0=__builtin_amdgcn_mfma_f32_32x32x16_bf16(kf[2],qr[1],C0,0,0,0),   P0[10],P0[11],P0[12],P0[13], pw1[0]=PKW(P0,8), pw1[1]=PKW(P0,10), pw1); \
    VRD(5); SBAR(); GAPA(C1=__builtin_amdgcn_mfma_f32_32x32x16_bf16(kf[3],qr[1],C1,0,0,0),   P0[14],P0[15],P1[0],P1[1],   pw1[2]=PKW(P0,12),pw1[3]=PKW(P0,14), pw1); \
    VRD(2); SBAR(); GAPA(C0=__builtin_amdgcn_mfma_f32_32x32x16_bf16(kf[4],qr[2],C0,0,0,0),   P1[2],P1[3],P1[4],P1[5],     pw2[0]=PKW(P1,0), pw2[1]=PKW(P1,2), pw2); \
    VRD(6); SBAR(); GAPA(C1=__builtin_amdgcn_mfma_f32_32x32x16_bf16(kf[5],qr[2],C1,0,0,0),   P1[6],P1[7],P1[8],P1[9],     pw2[2]=PKW(P1,4), pw2[3]=PKW(P1,6), pw2); \
    VRD(3); SBAR(); GAPA(C0=__builtin_amdgcn_mfma_f32_32x32x16_bf16(kf[6],qr[3],C0,0,0,0),   P1[10],P1[11],P1[12],P1[13], pw3[0]=PKW(P1,8), pw3[1]=PKW(P1,10), pw3); \
    VRD(7); SBAR(); GAPA(C1=__builtin_amdgcn_mfma_f32_32x32x16_bf16(kf[7],qr[3],C1,0,0,0),   P1[14],P1[15],0.f,0.f,       pw3[2]=PKW(P1,12),pw3[3]=PKW(P1,14), pw3); \
    l_reg+=sacc; \
    if(GK){DMA_K((t)+3,sl_cur);} if(GV){DMA_V((t)+1,sl_next);} \
    CMASK(C0,C1,t); \
    { float a=MX3(C0[0],C0[1],C1[0]),b=MX3(C0[2],C0[3],C1[1]); a=MX3(a,C1[2],C1[3]); \
      _Pragma("unroll") for(int r=4;r<16;r+=4){a=MX3(a,C0[r],C0[r+1]);b=MX3(b,C0[r+2],C0[r+3]);a=MX3(a,C1[r],C1[r+1]);b=MX3(b,C1[r+2],C1[r+3]);} \
      float rm=__builtin_fmaxf(a,b); { auto rr=__builtin_amdgcn_permlane32_swap(__float_as_uint(rm),__float_as_uint(rm),false,false); rm=__builtin_fmaxf(__uint_as_float(rr[0]),__uint_as_float(rr[1])); } \
      resc=false; \
      if(__builtin_expect(__any(rm>(float)THRL),0)){ const float dl=__builtin_fmaxf(rm,0.f); mhat+=dl; \
        _Pragma("unroll") for(int r=0;r<16;++r){C0[r]-=dl;C1[r]-=dl;} \
        const float f=__builtin_amdgcn_exp2f(-dl); l_reg*=f; if(hi==0)wsf[r32]=f; resc=true; } } \
    f32x4_t cn_=(f32x4_t){0.f,0.f,0.f,0.f}; if(GL){cn_=NEGC((t)+1,0);} \
    SBAR(); \
    GAPB(o[0]=__builtin_amdgcn_mfma_f32_32x32x16_bf16(PAF(0),VFR(0),o[0],0,0,0), C0,0,P0,0,0,t,GL); \
    GAPB(o[1]=__builtin_amdgcn_mfma_f32_32x32x16_bf16(PAF(0),VFR(4),o[1],0,0,0), C0,4,P0,4,1,t,GL); \
    KRD(GL,0); GAPB(o[0]=__builtin_amdgcn_mfma_f32_32x32x16_bf16(PAF(1),VFR(1),o[0],0,0,0), C0,8,P0,8,2,t,GL); \
    KRD(GL,1); GAPB(o[1]=__builtin_amdgcn_mfma_f32_32x32x16_bf16(PAF(1),VFR(5),o[1],0,0,0), C0,12,P0,12,3,t,GL); \
    KRD(GL,2); GAPB(o[0]=__builtin_amdgcn_mfma_f32_32x32x16_bf16(PAF(2),VFR(2),o[0],0,0,0), C1,0,P1,0,4,t,GL); \
    KRD(GL,3); GAPB(o[1]=__builtin_amdgcn_mfma_f32_32x32x16_bf16(PAF(2),VFR(6),o[1],0,0,0), C1,4,P1,4,5,t,GL); \
    GAPB(o[0]=__builtin_amdgcn_mfma_f32_32x32x16_bf16(PAF(3),VFR(3),o[0],0,0,0), C1,8,P1,8,6,t,GL); \
    GAPB(o[1]=__builtin_amdgcn_mfma_f32_32x32x16_bf16(PAF(3),VFR(7),o[1],0,0,0), C1,12,P1,12,7,t,GL); \
    }while(0)
  int t=1;
  #undef CMASK
  #define CMASK(P0,P1,t) do{}while(0)
  for(;t+5<NT;t+=2){
    STEP(pB0,pB1,pA0,pA1,t,true,true,true);     WAIT_BAR(2); RESC(); ROT();
    STEP(pA0,pA1,pB0,pB1,t+1,true,true,true);   WAIT_BAR(2); RESC(); ROT();
  }
  #undef CMASK
  #define CMASK(P0,P1,t) do{int jb_=(t)-(NT-4); if(jb_>=0)cmask(P0,P1,jb_,qrel,hi);}while(0)
  #define ENDW(tt) do{ if((tt)+3<NT){WAIT_BAR(2);} else if((tt)+2<NT){WAIT_BAR(1);} else {WAIT_BAR(0);} }while(0)
  for(;t+1<NT;t+=2){
    STEP(pB0,pB1,pA0,pA1,t,(t+3<NT),(t+1<NT),(t+1<NT));       ENDW(t);   RESC(); ROT();
    STEP(pA0,pA1,pB0,pB1,t+1,(t+4<NT),(t+2<NT),(t+2<NT));     ENDW(t+1); RESC(); ROT();
  }
  STEP(pB0,pB1,pA0,pA1,NT-1,false,false,false); RESC();
  { float sacc=pB0[0]+pB0[1]; _Pragma("unroll") for(int r=2;r<16;++r)sacc+=pB0[r]; _Pragma("unroll") for(int r=0;r<16;++r)sacc+=pB1[r]; l_reg+=sacc;
    pw0=(u32x4){PKW(pB0,0),PKW(pB0,2),PKW(pB0,4),PKW(pB0,6)};pw1=(u32x4){PKW(pB0,8),PKW(pB0,10),PKW(pB0,12),PKW(pB0,14)};pw2=(u32x4){PKW(pB1,0),PKW(pB1,2),PKW(pB1,4),PKW(pB1,6)};pw3=(u32x4){PKW(pB1,8),PKW(pB1,10),PKW(pB1,12),PKW(pB1,14)};
    SBAR(); pv(o,vb0+sl_cur,PAF(0),PAF(1),PAF(2),PAF(3)); }
  #undef PKW
  #undef PAF
  #undef VFR
  #undef PIN
  #undef MX3
  #undef GAPA
  #undef GAPB
  #undef EX
  #undef VRD
  #undef KRD
  #undef STEP
  #undef ENDW
  {auto rr=__builtin_amdgcn_permlane32_swap(__float_as_uint(l_reg),__float_as_uint(l_reg),false,false);l_reg=__uint_as_float(rr[0])+__uint_as_float(rr[1]);}
  if(hi==0)wsf[32+r32]=l_reg;asm volatile("s_waitcnt lgkmcnt(0)":::"memory");
  float rli[16];
  #pragma unroll
  for(int r=0;r<16;++r)rli[r]=__builtin_amdgcn_rcpf(wsf[32+crow(r,hi)]);
  bf16*Ow=O+(rowbase+q0+wid*QBLK)*OPITCH+h*D; const bf16*Gw=OG+(rowbase+q0+wid*QBLK)*PITCH+h*D;
  u32x4 gg[4];
  #pragma unroll
  for(int i=0;i<4;++i){const int row=i*8+(lane>>3),ch=lane&7; gg[i]=*(const u32x4*)(Gw+(long)row*PITCH+ch*8);}
  { bf16*stg=(bf16*)(shm+LDS_OST)+wid*2048;
    #pragma unroll
    for(int r=0;r<16;++r){const int orow=crow(r,hi);
      #pragma unroll
      for(int d0=0;d0<2;++d0)stg[orow*64+d0*32+r32]=__float2bfloat16(o[d0][r]*rli[r]);}
    asm volatile("s_waitcnt lgkmcnt(0)":::"memory");
    #pragma unroll
    for(int i=0;i<4;++i){const int row=i*8+(lane>>3),ch=lane&7; u32x4 v=*(const u32x4*)(stg+row*64+ch*8);
      #pragma unroll
      for(int w=0;w<4;++w){ const float o0=__uint_as_float(v[w]<<16),o1=__uint_as_float(v[w]&0xffff0000u),g0=__uint_as_float(gg[i][w]<<16),g1=__uint_as_float(gg[i][w]&0xffff0000u);
        v[w]=cvtpk_s(o0*__builtin_amdgcn_rcpf(1.f+__builtin_amdgcn_exp2f(-1.4426950408889634f*g0)),o1*__builtin_amdgcn_rcpf(1.f+__builtin_amdgcn_exp2f(-1.4426950408889634f*g1))); }
      ATTN_STORE16(Ow+(long)row*OPITCH+ch*8,v);} }
  asm volatile("s_waitcnt lgkmcnt(0)\n\ts_barrier":::"memory");
  #undef DMA_K
  #undef NEGC
  #undef FILLT
  #undef DMA_V
  #undef CMASK
  #undef START
  #undef RESC
  #undef ROT
}
constexpr int ATTN_LDS_BYTES=LDS_BYTES;
struct AttnTensors { const bf16* Q; const bf16* K; const bf16* V; const bf16* OG; const float* c2v; bf16* O; };
struct AttnUnit { int bh; int qb; };
struct StaticOrder {
  int vcu, G;
  __device__ __forceinline__ explicit StaticOrder(int grid,int block):vcu((grid%8==0)?(block%8)*(grid/8)+block/8:block),G(grid){}
  __device__ __forceinline__ bool next(int i,AttnUnit&u)const{ const int pair=vcu+(i>>1)*G; if(pair>=BATCH*NHEAD*4)return false; const int s=pair&3; u.bh=pair>>2; u.qb=(i&1)?s:7-s; return true; }
  __device__ __forceinline__ void a_ready(const AttnUnit&)const{}
  __device__ __forceinline__ void done(const AttnUnit&)const{}
};
template<class Sched,int THRL=8> __device__ __forceinline__ void attn_phase(char*lds,const AttnTensors&T,const Sched&S){
  AttnUnit u;
  for(int i=0;S.next(i,u);++i){ S.a_ready(u); attn_unit<THRL>(u.bh/NHEAD,u.bh%NHEAD,u.qb,T.Q,T.K,T.V,T.OG,T.c2v,T.O,lds); S.done(u); }
}
#undef SBAR
#undef WAIT_BAR
}
#define GAS __attribute__((address_space(1)))
#define LAS __attribute__((address_space(3)))
typedef unsigned short bf16;
typedef unsigned v4u __attribute__((ext_vector_type(4)));
typedef float f32x4 __attribute__((ext_vector_type(4)));
typedef short bf16x8 __attribute__((ext_vector_type(8)));
typedef GAS unsigned gu32;
typedef GAS unsigned long long gu64;
#define RLX_AGENT __ATOMIC_RELAXED, __HIP_MEMORY_SCOPE_AGENT
#define LDS_WAIT() asm volatile("s_waitcnt lgkmcnt(0)" ::: "memory")
#define VM_WAIT() asm volatile("s_waitcnt vmcnt(0)" ::: "memory")
#define XB_TMO      128
#define XB_XCNT(j)  (256  + 64 * (j))
#define XB_XSUB(j)  (1280 + 64 * (j))
#define XB_XGEN(j)  (2304 + 64 * (j))
#define XB_TOP      3328
#define XB_TOPGEN   3392
#define XCD_BAR_WORDS 3456
#define XB_SPIN_CAP (1u << 18)

__device__ __forceinline__ unsigned xb_ld(unsigned* p)              { return __hip_atomic_load(p, __ATOMIC_RELAXED, __HIP_MEMORY_SCOPE_AGENT); }
__device__ __forceinline__ unsigned xb_add(unsigned* p, unsigned v) { return __hip_atomic_fetch_add(p, v, __ATOMIC_RELAXED, __HIP_MEMORY_SCOPE_AGENT); }
__device__ __forceinline__ unsigned xb_xcc_id() { return (unsigned)__builtin_amdgcn_s_getreg((3 << 11) | 20) & 0xFu; }
#define XB_SPIN(cond, bar) do { unsigned _sp = 0; while (cond) { __builtin_amdgcn_s_sleep(1); \
    if ((++_sp & 255u) == 0u) { if (xb_ld(&(bar)[XB_TMO])) break; if (_sp > XB_SPIN_CAP) { atomicAdd(&(bar)[XB_TMO], 1u); break; } } } } while (0)

struct XcdBarrier {
    unsigned* bar; unsigned x;
    volatile LAS unsigned* st;
};

__device__ __forceinline__ XcdBarrier xcd_barrier_post(unsigned* bar, volatile LAS unsigned* st) {
    XcdBarrier b; b.bar = bar; b.x = xb_xcc_id(); b.st = st;
    if (threadIdx.x == 0) (void)xb_add(&bar[XB_XCNT(b.x)], 1u);
    return b;
}
__device__ __forceinline__ void xcd_barrier_complete(unsigned* bar, unsigned x, unsigned& nloc, unsigned& nx) {
    const unsigned G = gridDim.x * gridDim.y * gridDim.z;
    unsigned sum, cnt, mine, sp = 0u;
    for (;;) {
        sum = 0u; cnt = 0u; mine = 0u;
#pragma unroll
        for (unsigned j = 0; j < 16; ++j) { const unsigned c = xb_ld(&bar[XB_XCNT(j)]); sum += c; cnt += (c > 0u) ? 1u : 0u; mine = (j == x) ? c : mine; }
        if (sum == G) break;
        __builtin_amdgcn_s_sleep(1);
        if ((++sp & 255u) == 0u) { if (xb_ld(&bar[XB_TMO])) break; if (sp > XB_SPIN_CAP) { atomicAdd(&bar[XB_TMO], 1u); break; } }
    }
    nloc = mine > 0u ? mine : 1u; nx = cnt > 0u ? cnt : 1u;
}

__device__ __forceinline__ void xcd_barrier(const XcdBarrier& b) {
    asm volatile("s_waitcnt vmcnt(0)" ::: "memory");
    __syncthreads();
    if (threadIdx.x == 0) {
        unsigned* bar = b.bar;
        __builtin_amdgcn_s_waitcnt(0);
        unsigned nloc = b.st[0], nx = b.st[1];
        if (nloc == 0u) { xcd_barrier_complete(bar, b.x, nloc, nx); b.st[0] = nloc; b.st[1] = nx; }
        const unsigned old = xb_add(&bar[XB_XSUB(b.x)], 1u);
        const unsigned gen = old / nloc;
        if (old + 1u == (gen + 1u) * nloc) {
            __builtin_amdgcn_fence(__ATOMIC_RELEASE, "agent");
            asm volatile("s_waitcnt vmcnt(0)" ::: "memory");
            const unsigned og = xb_add(&bar[XB_TOP], 1u);
            const unsigned tg = og / nx;
            if (og + 1u == (tg + 1u) * nx) xb_add(&bar[XB_TOPGEN], 1u);
            else XB_SPIN(xb_ld(&bar[XB_TOPGEN]) == tg, bar);
            __builtin_amdgcn_fence(__ATOMIC_ACQUIRE, "agent");
            xb_add(&bar[XB_XGEN(b.x)], 1u);
            asm volatile("s_waitcnt vmcnt(0)" ::: "memory");
        } else {
            XB_SPIN(xb_ld(&bar[XB_XGEN(b.x)]) == gen, bar);
            __builtin_amdgcn_fence(__ATOMIC_ACQUIRE, "agent");
            asm volatile("s_waitcnt vmcnt(0)" ::: "memory");
        }
    }
    __syncthreads();
}

constexpr int NWAVES = 8;
constexpr int RING_BYTES = 131072;
constexpr int LDSCTL_OFF = RING_BYTES, MISC_OFF = LDSCTL_OFF + 320;
constexpr int LDS_BYTES = 147456;
constexpr int CW_BAR = 4096;

struct Args { const float* in[24]; float* out; unsigned char* ws; };

template <bool AF32, class F>
__device__ __forceinline__ void meta_gemm(const void* A, int lda, const bf16_t* Wt, int N, int K, int gw, int ngw, int lane, const F& f) {
    const int fr = lane & 15, fq = lane >> 4;
    for (int cb = gw; cb < N / 16; cb += ngw) {
        f32x4 acc = (f32x4){0.f, 0.f, 0.f, 0.f}; float ss = 0.f;
        const bf16_t* bp = Wt + (size_t)(cb * 16 + fr) * K + 8 * fq;
#pragma unroll 4
        for (int k = 0; k < K; k += 32) {
            bf16x8 a;
            if (AF32) {
                const float* ap = (const float*)A + (size_t)fr * lda + k + 8 * fq;
                const f32x4 a0 = *(const f32x4*)ap, a1 = *(const f32x4*)(ap + 4);
                ss += ((a0.x * a0.x + a0.y * a0.y) + (a0.z * a0.z + a0.w * a0.w)) + ((a1.x * a1.x + a1.y * a1.y) + (a1.z * a1.z + a1.w * a1.w));
                u32x4 w; w.x = pk2bf(a0.x, a0.y); w.y = pk2bf(a0.z, a0.w); w.z = pk2bf(a1.x, a1.y); w.w = pk2bf(a1.z, a1.w);
                a = __builtin_bit_cast(bf16x8, w);
            } else a = *(const bf16x8*)((const bf16_t*)A + (size_t)fr * lda + k + 8 * fq);
            const bf16x8 b = *(const bf16x8*)(bp + k);
            acc = __builtin_amdgcn_mfma_f32_16x16x32_bf16(a, b, acc, 0, 0, 0);
        }
        float rstd = 1.f;
        if (AF32) { ss += __shfl_xor(ss, 16); ss += __shfl_xor(ss, 32); rstd = 1.0f / sqrtf(ss * (1.f / DM) + 1e-6f); }
#pragma unroll
        for (int r = 0; r < 4; ++r) { const int row = 4 * fq + r; const float rs = AF32 ? __shfl(rstd, row) : 1.f; f(row, cb * 16 + fr, acc[r] * rs); }
    }
}
struct MEpi1 { bf16_t* p; float* pn;
    __device__ __forceinline__ void operator()(int r, int col, float v) const {
        const int row = MROWS + r; const int g = col >> 9;
        if (g < 7) p[(size_t)row * PBW + col] = f2bf(v);
        else { const int o = col & 511; if (o < 296) pn[(size_t)row * PNW + o] = v; } } };
struct MEpiRes { float* hm; __device__ __forceinline__ void operator()(int r, int col, float v) const { float* h = hm + r * DM + col; *h = *h + v; } };
struct MEpi3 { bf16_t* raw; int ldr; __device__ __forceinline__ void operator()(int r, int col, float v) const { raw[(size_t)(MROWS + r) * ldr + col] = f2bf(v); } };

__device__ __forceinline__ void wprep_layer(const Args& a, int l, unsigned char* ws, int gw, int ngw, int lane, float* scr) {
    unsigned char* wb = ws + WS_W + (size_t)(l & 1) * WL_BYTES;
    constexpr int I1 = (DM / 64) * (N1 / 32), I2 = (DM / 64) * (DM / 32), I3 = (DM / 64) * (DFF2 / 32), I4 = (DFF / 64) * (DM / 32), IL = I1 + I2 + I3 + I4;
    for (int it = gw; it < IL; it += ngw) {
        int r = it;
        if (r < I1) { wprep_item(a.in[3] + (size_t)l * DM * N_IN, a.in[2] + l * DM, (bf16_t*)(wb + WO_W1), DM, N_IN, N1, 1, r, scr, lane); continue; } r -= I1;
        if (r < I2) { wprep_item(a.in[18] + (size_t)l * DM * DM, nullptr, (bf16_t*)(wb + WO_W2), DM, DM, DM, 2, r, scr, lane); continue; } r -= I2;
        if (r < I3) { wprep_item(a.in[20] + (size_t)l * DM * DFF2, a.in[19] + l * DM, (bf16_t*)(wb + WO_W3), DM, DFF2, DFF2, 3, r, scr, lane); continue; } r -= I3;
        wprep_item(a.in[23] + (size_t)l * DFF * DM, nullptr, (bf16_t*)(wb + WO_W4), DFF, DM, DM, 4, r, scr, lane);
    }
    bf16_t* lup = (bf16_t*)(wb + WO_LUP);
    const float* wu = a.in[6] + (size_t)l * 64 * 512; const float* au = a.in[8] + (size_t)l * 64 * 512; const float* gu = a.in[9] + (size_t)l * 160 * 512;
    for (int e = gw * 64 + lane; e < 512 * 288; e += ngw * 64) {
        const int n = e / 288, k = e % 288;
        lup[e] = f2bf(k < 64 ? wu[k * 512 + n] : (k < 128 ? au[(k - 64) * 512 + n] : gu[(k - 128) * 512 + n]));
    }
}

struct RwP { const float* mu; const float* w0; const float* w_up; const float* a0; const float* a_up; const float* g_up; };
struct RwS { const float* mu; const float* k_k; const float* k_a; const float* r_k; const float* gn_w; const float* gn_b; };
constexpr int RCH = 8;

__global__ void __launch_bounds__(NWAVES * 64, 2) mk_fwd(Args a) {
    extern __shared__ __attribute__((aligned(16))) unsigned char lds[];
    const int tid0 = threadIdx.x;
    const int G = gridDim.x, bid = blockIdx.x, ngw = G * NWAVES;
    for (int u = tid0; u < (LDS_BYTES - LDSCTL_OFF) / 4; u += NWAVES * 64) ((LAS unsigned*)((LAS unsigned char*)lds + LDSCTL_OFF))[u] = 0u;
    __syncthreads();
    unsigned char* ws = a.ws; float* out = a.out;
    XcdBarrier bar = xcd_barrier_post((unsigned*)(ws + WS_CTL) + CW_BAR, (volatile LAS unsigned*)((LAS unsigned char*)lds + MISC_OFF) + 8);
#define GRID_BAR() xcd_barrier(bar)
#define PHASE_IDS() int tid = tid0; asm volatile("" : "+v"(tid)); const int lane = tid & 63, wave = __builtin_amdgcn_readfirstlane(tid >> 6), gw = bid * NWAVES + wave; (void)lane; (void)gw
    const float* x = a.in[0]; const float* meta = a.in[1];
    float* hm = (float*)(ws + WS_HM); float* c2 = (float*)(ws + WS_C2); float* ssqp = (float*)(ws + WS_SSQ);
    bf16_t* hb = (bf16_t*)(ws + WS_HB); bf16_t* p = (bf16_t*)(ws + WS_P); float* pn = (float*)(ws + WS_PN); bf16_t* y = (bf16_t*)(ws + WS_Y);
    bf16_t* act = (bf16_t*)(ws + WS_ACT); bf16_t* raw = (bf16_t*)(ws + WS_RAW);
    LAS unsigned char* ldsl = (LAS unsigned char*)lds;

    {
        PHASE_IDS();
        float* scr = (float*)(lds + wave * 16384);
        wprep_layer(a, 0, ws, gw, ngw, lane, scr);
        for (int row = gw; row < RROWS; row += ngw) {
            const f32x4* xr = (const f32x4*)(row < MROWS ? x + (size_t)row * DM : meta + (size_t)(row - MROWS) * DM) + lane;
            f32x4* hr = (f32x4*)(row < MROWS ? out + (size_t)row * DM : hm + (size_t)(row - MROWS) * DM) + lane;
            f32x4 v[4]; float s = 0.f;
#pragma unroll
            for (int j = 0; j < 4; ++j) { v[j] = xr[64 * j]; hr[64 * j] = v[j]; s += (v[j].x * v[j].x + v[j].y * v[j].y) + (v[j].z * v[j].z + v[j].w * v[j].w); }
            s = wave_sum(s);
            if (lane < 16) ssqp[(size_t)row * 16 + lane] = lane == 0 ? s : 0.f;
            u32x2* o8 = (u32x2*)(hb + (size_t)row * DM) + lane;
#pragma unroll
            for (int j = 0; j < 4; ++j) { u32x2 w; w.x = pk2bf(v[j].x, v[j].y); w.y = pk2bf(v[j].z, v[j].w); o8[64 * j] = w; }
        }
    }
    {
        u32x4* z = (u32x4*)(p + (size_t)RROWS * PBW); const size_t n16 = (size_t)(16512 - RROWS) * PBW * 2 / 16;
        for (size_t i = (size_t)bid * (NWAVES * 64) + tid0; i < n16; i += (size_t)G * (NWAVES * 64)) z[i] = (u32x4){0u, 0u, 0u, 0u};
    }
    cg::this_grid().sync();

#pragma unroll 1
    for (int l = 0; l < DEPTH; ++l) {
        const unsigned char* wbuf = ws + WS_W + (size_t)(l & 1) * WL_BYTES;
        const bf16_t* W1 = (const bf16_t*)(wbuf + WO_W1); const bf16_t* W2 = (const bf16_t*)(wbuf + WO_W2);
        const bf16_t* W3 = (const bf16_t*)(wbuf + WO_W3); const bf16_t* W4 = (const bf16_t*)(wbuf + WO_W4);
        {
            PHASE_IDS();
            pg8::Gemm g{hb, W1, MROWS, N1, DM}; pg8::StaticOrder S; S.init(MROWS, N1, G, bid);
            pg8::Epi1 E{ssqp, p, pn};
            pg8::gemm_phase<pg8::Epi1, pg8::StaticOrder, true, true>(ldsl, g, S, E);
            meta_gemm<true>(hm, DM, W1, N1, DM, gw, ngw, lane, MEpi1{p, pn});
        }
        GRID_BAR();
        {
            PHASE_IDS();
            if (l + 1 < DEPTH) wprep_layer(a, l + 1, ws, gw, ngw, lane, (float*)(lds + wave * 16384));
            __syncthreads();
            {
                const float* mu = a.in[4] + l * 1824;
                const bf16_t* lup = (const bf16_t*)(wbuf + WO_LUP);
                const int h = wave, cg = h * 64 + lane, fr = lane & 15, fq = lane >> 4;
                const float mu_r = mu[cg], mu_k = mu[512 + cg], mu_v = mu[1024 + cg];
                const float w0c = (a.in[5] + l * 512)[cg], a0c = (a.in[7] + l * 512)[cg];
                const float kkc = (a.in[10] + l * 512)[cg], kac = (a.in[11] + l * 512)[cg], rkc = (a.in[12] + l * 512)[cg];
                LAS unsigned char* LIN = ldsl;
                LAS unsigned char* LW = ldsl + 10240 + wave * 11776;
                LAS float* TR = (LAS float*)LW; LAS float* LT = (LAS float*)(LW + 9216); LAS float* LAK = (LAS float*)(LW + 9216 + 1280);
                for (int u = bid; u < NB * NCH; u += G) {
                    const int b = u / NCH, c = u % NCH, row0 = rowof(b, 16 * c), prow0 = prevrow(row0);
                    __syncthreads();
                    for (int e = tid; e < 16 * 288; e += NWAVES * 64) {
                        const int i = e / 288, j = e % 288, row = row0 + i, pr = i ? row - 1 : prow0;
                        const float cur = pn[(size_t)row * PNW + j], prv = pr >= 0 ? pn[(size_t)pr * PNW + j] : 0.f;
                        const float s = cur + mu[1536 + j] * (prv - cur);
                        ((LAS bf16_t*)LIN)[i * 296 + j] = f2bf(j < 64 ? tanhf(s) : (j < 128 ? s : sigmoidf_(s)));
                    }
                    __syncthreads();
#define LORA(ZA, KB0, NKS) do { f32x4 acc_[4]; _Pragma("unroll") for (int nb = 0; nb < 4; ++nb) acc_[nb] = (f32x4){0.f, 0.f, 0.f, 0.f}; \
                        _Pragma("unroll") for (int ks = 0; ks < (NKS); ++ks) { const bf16x8 af = *(const LAS bf16x8*)(LIN + fr * 592 + ((KB0) + 32 * ks + 8 * fq) * 2); \
                            _Pragma("unroll") for (int nb = 0; nb < 4; ++nb) { const bf16x8 bfr = *(const bf16x8*)(lup + (size_t)(h * 64 + 16 * nb + fr) * 288 + (KB0) + 32 * ks + 8 * fq); \
                                acc_[nb] = __builtin_amdgcn_mfma_f32_16x16x32_bf16(af, bfr, acc_[nb], 0, 0, 0); } } \
                        WAVE_LDS_SYNC(); \
                        _Pragma("unroll") for (int nb = 0; nb < 4; ++nb) _Pragma("unroll") for (int r = 0; r < 4; ++r) TR[(4 * fq + r) * 65 + 16 * nb + fr] = acc_[nb][r]; \
                        WAVE_LDS_SYNC(); \
                        _Pragma("unroll") for (int i = 0; i < 16; ++i) ZA[i] = TR[i * 65 + lane]; } while (0)
                    {
                        float zg[16]; LORA(zg, 128, 5);
#pragma unroll
                        for (int i = 0; i < 16; ++i) y[(size_t)(row0 + i) * DM + cg] = f2bf(zg[i]); }
                    float zw[16], za[16];
                    LORA(zw, 0, 2); LORA(za, 64, 2);
#undef LORA
                    WAVE_LDS_SYNC();
                    const int ci = (b * 8 + h) * NCH + c;
                    unsigned char* ra = ws + WS_RA + (size_t)ci * RA_BYTES; unsigned char* rb = ws + WS_RB + (size_t)ci * RB_BYTES;
                    bf16_t* BV = (bf16_t*)(ws + WS_BV);
                    LAS bf16_t* OA = (LAS bf16_t*)LW; LAS bf16_t* OB = OA + 16 * 72; LAS bf16_t* OK = OB + 16 * 72; LAS bf16_t* OR = OK + 16 * 72;
                    const int cxk = (lane >> 5) * 4 + ((lane >> 2) & 3), jk2 = (((lane >> 4) & 1) * 4 + (lane & 3)) * 2;
                    float atil[16]; unsigned bkB[8], bkK[8], vtp[8];
                    float cumC = 0.f;
#pragma unroll
                    for (int i = 0; i < 16; ++i) { zw[i] = 0.6065306597126334f * sigmoidf_(zw[i] + w0c); cumC += zw[i]; }
                    float cum = 0.f, gprev = 1.f, rp = 0.f, kp_ = 0.f, vp = 0.f, be = 0.f, ke = 0.f, ve = 0.f;
                    if (prow0 >= 0) { const bf16_t* pp = p + (size_t)prow0 * PBW; rp = bf2f(pp[cg]); kp_ = bf2f(pp[512 + cg]); vp = bf2f(pp[1024 + cg]); }
                    const float hp0 = prow0 >= 0 ? 1.f : 0.f;
#pragma unroll
                    for (int i = 0; i < 16; ++i) {
                        const bf16_t* pc = p + (size_t)(row0 + i) * PBW;
                        const float rc = bf2f(pc[cg]), kc = bf2f(pc[512 + cg]), vc = bf2f(pc[1024 + cg]);
                        const float hp = i ? 1.f : hp0;
                        const float rs = rc + mu_r * (hp * rp - rc), ks_ = kc + mu_k * (hp * kp_ - kc), vs = vc + mu_v * (hp * vp - vc);
                        rp = rc; kp_ = kc; vp = vc;
                        cum += zw[i];
                        const float alr = sigmoidf_(za[i] + a0c);
                        const float kkr = ks_ * kkc; const float kk = kkr / fmaxf(sqrtf(wave_sum(kkr * kkr)), 1e-12f);
                        const float kpr = ks_ * (1.f + (alr - 1.f) * kac);
                        const float bon = wave_sum(rs * kpr * rkc);
                        const float eg = __expf(cum), gi = __expf(-cum), tail = __expf(cum - cumC);
                        atil[i] = -kk * gprev;
                        const float bb = kk * alr, rtil = rs * gi; gprev = gi;
                        OA[i * 72 + lane] = f2bf(atil[i]); OB[i * 72 + lane] = f2bf(bb * eg); OK[i * 72 + lane] = f2bf(kpr * eg); OR[i * 72 + lane] = f2bf(rtil);
                        if (i & 1) { bkB[i >> 1] = pk2bf(be, bb * tail); bkK[i >> 1] = pk2bf(ke, kpr * tail); vtp[i >> 1] = pk2bf(ve, vs); } else { be = bb * tail; ke = kpr * tail; ve = vs; }
                        *(bf16_t*)(ra + 2048 + i * 128 + ((cxk ^ ((i >> 1) & 7)) << 4) + jk2) = f2bf(rtil);
                        BV[(size_t)(row0 + i) * 512 + cg] = f2bf(bon * vs);
                    }
                    {
                        ((float*)(rb + 3584))[lane] = gprev;
#pragma unroll
                        for (int q = 0; q < 4; ++q) *(u32x4*)(ra + 4096 + lane * 64 + ((q ^ SWZ4(lane)) << 4)) = (u32x4){bkB[2 * q], bkB[2 * q + 1], bkK[2 * q], bkK[2 * q + 1]};
                        *(u32x4*)(rb + lane * 32) = (u32x4){vtp[0], vtp[1], vtp[2], vtp[3]}; *(u32x4*)(rb + lane * 32 + 16) = (u32x4){vtp[4], vtp[5], vtp[6], vtp[7]};
                    }
                    WAVE_LDS_SYNC();
                    {
                        f32x4 dab = (f32x4){0.f, 0.f, 0.f, 0.f}, dak = dab, drb = dab, drk = dab;
#pragma unroll
                        for (int ks = 0; ks < 2; ++ks) {
                            const int off = fr * 72 + 32 * ks + 8 * fq;
                            const bf16x8 fa = *(const LAS bf16x8*)(OA + off), fb = *(const LAS bf16x8*)(OB + off), fk = *(const LAS bf16x8*)(OK + off), frr = *(const LAS bf16x8*)(OR + off);
                            dab = __builtin_amdgcn_mfma_f32_16x16x32_bf16(fa, fb, dab, 0, 0, 0); dak = __builtin_amdgcn_mfma_f32_16x16x32_bf16(fa, fk, dak, 0, 0, 0);
                            drb = __builtin_amdgcn_mfma_f32_16x16x32_bf16(frr, fb, drb, 0, 0, 0); drk = __builtin_amdgcn_mfma_f32_16x16x32_bf16(frr, fk, drk, 0, 0, 0);
                        }
#pragma unroll
                        for (int r = 0; r < 4; ++r) { const int i = 4 * fq + r, j = fr;
                            LT[i * 20 + j] = j < i ? dab[r] : 0.f; LAK[i * 16 + j] = j < i ? dak[r] : 0.f;
                            bf16_t* mp = (bf16_t*)(rb + 2048 + i * 64 + (((j >> 2) ^ SWZ4(i)) << 4)) + (j & 3);
                            mp[0] = f2bf(j <= i ? drb[r] : 0.f); mp[4] = f2bf(j <= i ? drk[r] : 0.f); }
                    }
                    WAVE_LDS_SYNC();
                    float tt[16];
#pragma unroll
                    for (int mm = 0; mm < 16; ++mm) tt[mm] = mm == fr ? 1.f : 0.f;
#pragma unroll
                    for (int j = 14; j >= 0; --j) { float val = 0.f;
#pragma unroll
                        for (int mm = j + 1; mm < 16; ++mm) val += tt[mm] * LT[mm * 20 + j];
                        tt[j] += val; }
                    WAVE_LDS_SYNC();
                    if (fq == 0) {
#pragma unroll
                        for (int mm = 0; mm < 16; ++mm) LT[fr * 20 + mm] = tt[mm]; }
                    {
                        f32x4 g4 = (f32x4){0.f, 0.f, 0.f, 0.f};
#pragma unroll
                        for (int mm = 0; mm < 16; ++mm) g4 += *(const LAS f32x4*)(LAK + mm * 16 + 4 * fq) * tt[mm];
                        u32x2 w; w.x = pk2bf(g4[0], g4[1]); w.y = pk2bf(g4[2], g4[3]);
                        *(u32x2*)(rb + 3072 + (fr * 16 + 4 * fq) * 2) = w;
                    }
                    WAVE_LDS_SYNC();
                    {
#pragma unroll
                        for (int i = 0; i < 16; ++i) { float acc = 0.f;
                            const f32x4 t0 = *(const LAS f32x4*)(LT + i * 20), t1 = *(const LAS f32x4*)(LT + i * 20 + 4), t2 = *(const LAS f32x4*)(LT + i * 20 + 8), t3 = *(const LAS f32x4*)(LT + i * 20 + 12);
                            const float trow[16] = {t0[0], t0[1], t0[2], t0[3], t1[0], t1[1], t1[2], t1[3], t2[0], t2[1], t2[2], t2[3], t3[0], t3[1], t3[2], t3[3]};
#pragma unroll
                            for (int mm = 0; mm <= i; ++mm) acc += trow[mm] * atil[mm];
                            *(bf16_t*)(ra + i * 128 + ((cxk ^ ((i >> 1) & 7)) << 4) + jk2) = f2bf(acc); }
                    }
                }
            }
            __syncthreads();
            const float* q_g = a.in[16] + l * 64; const float* k_g = a.in[17] + l * 64; const float* b_f = a.in[15] + l * 8;
            for (int it = gw; it < RROWS * NH; it += ngw) {
                const int row = it >> 3, h = it & 7;
                bf16_t* qp = p + (size_t)row * PBW + 1536 + h * 64 + lane; bf16_t* kp = p + (size_t)row * PBW + 2048 + h * 64 + lane;
                const float q = bf2f(*qp), k = bf2f(*kp);
                const float mq = wave_sum(q * q) * (1.f / 64.f), mk = wave_sum(k * k) * (1.f / 64.f);
                *qp = f2bf(q * (1.0f / sqrtf(mq + 1e-6f)) * q_g[lane] * (0.125f * LOG2E));
                *kp = f2bf(k * (1.0f / sqrtf(mk + 1e-6f)) * k_g[lane]);
            }
            if (gw < 64) {
                const int b = gw >> 3, h = gw & 7; constexpr int PER = 33;
                float loc[PER]; float s = 0.f;
#pragma unroll
                for (int i = 0; i < PER; ++i) { const int t = lane * PER + i; float v = 0.f;
                    if (t < LTOT) { const float z = pn[(size_t)rowof(b, t) * PNW + 288 + h] + b_f[h]; v = (fminf(z, 0.f) - log1pf(__expf(-fabsf(z)))) * LOG2E; }
                    s += v; loc[i] = s; }
                float incl = s;
#pragma unroll
                for (int o = 1; o < 64; o <<= 1) { const float n = __shfl_up(incl, o); if (lane >= o) incl += n; }
                const float base = incl - s;
                float* cv = c2 + (size_t)gw * 2176;
#pragma unroll
                for (int i = 0; i < PER; ++i) { const int t = lane * PER + i; if (t < LTOT) cv[t < NMETA ? t : t + 112] = base + loc[i]; }
                cv[16 + lane] = 1e5f; if (lane < 48) cv[80 + lane] = 1e5f;
            }
        }
        GRID_BAR();
        {
            PHASE_IDS();
            typedef short s16x4 __attribute__((ext_vector_type(4)));
            constexpr int SLOTB = 12288, NSLOT = 8, YB_OFF = NSLOT * SLOTB, YB_BYTES = 32 * 68 * 4, NSC = (NCH + 1) / 2;
#define RAW_BAR() asm volatile("s_waitcnt lgkmcnt(0)\n\ts_barrier" ::: "memory")
            for (int unit = bid; unit < 64; unit += G) {
                const int b = unit >> 3, h = unit & 7, fr = lane & 15, fq = lane >> 4;
                const unsigned char* RA0 = ws + WS_RA + (size_t)unit * NCH * RA_BYTES; const unsigned char* RB0 = ws + WS_RB + (size_t)unit * NCH * RB_BYTES;
                if (wave < 4) {
                    const int v = 16 * wave + fr;
                    f32x4 Z[4];
#pragma unroll
                    for (int kb = 0; kb < 4; ++kb) Z[kb] = (f32x4){0.f, 0.f, 0.f, 0.f};
                    const int o_ah0 = fr * 128 + (((fq) ^ ((fr >> 1) & 7)) << 4), o_ah1 = fr * 128 + (((4 + fq) ^ ((fr >> 1) & 7)) << 4);
                    const int o_bk = 4096 + fr * 64 + ((fq ^ SWZ4(fr)) << 4), o_mrk = 10240 + fr * 64 + ((fq ^ SWZ4(fr)) << 4);
                    const int o_vt = 8192 + v * 32 + fq * 8, o_g = 11264 + fr * 32 + fq * 8, o_gam = 11776 + fq * 16;
                    RAW_BAR();
                    for (int s = 0; s < NSC; ++s) {
                        LAS float* YB = (LAS float*)(ldsl + YB_OFF + (s & 1) * YB_BYTES);
                        const int nc = (NCH - 2 * s) < 2 ? 1 : 2;
                        for (int cs = 0; cs < nc; ++cs) {
                            const LAS unsigned char* sl = ldsl + ((2 * s + cs) & (NSLOT - 1)) * SLOTB;
                            const bf16x8 ah0 = *(const LAS bf16x8*)(sl + o_ah0), ah1 = *(const LAS bf16x8*)(sl + o_ah1);
                            const bf16x8 rh0 = *(const LAS bf16x8*)(sl + 2048 + o_ah0), rh1 = *(const LAS bf16x8*)(sl + 2048 + o_ah1);
                            bf16x8 bk[4]; f32x4 gam[4];
#pragma unroll
                            for (int kb = 0; kb < 4; ++kb) { bk[kb] = *(const LAS bf16x8*)(sl + o_bk + kb * 1024); gam[kb] = *(const LAS f32x4*)(sl + o_gam + kb * 64); }
                            const u32x2 vt = *(const LAS u32x2*)(sl + o_vt);
                            const bf16x8 mrk = *(const LAS bf16x8*)(sl + o_mrk);
                            const u32x2 g4 = *(const LAS u32x2*)(sl + o_g);
                            u32x4 zw01, zw23;
                            zw01.x = pk2bf(Z[0][0], Z[0][1]); zw01.y = pk2bf(Z[0][2], Z[0][3]); zw01.z = pk2bf(Z[1][0], Z[1][1]); zw01.w = pk2bf(Z[1][2], Z[1][3]);
                            zw23.x = pk2bf(Z[2][0], Z[2][1]); zw23.y = pk2bf(Z[2][2], Z[2][3]); zw23.z = pk2bf(Z[3][0], Z[3][1]); zw23.w = pk2bf(Z[3][2], Z[3][3]);
                            const bf16x8 zp01 = __builtin_bit_cast(bf16x8, zw01), zp23 = __builtin_bit_cast(bf16x8, zw23);
                            f32x4 U = (f32x4){0.f, 0.f, 0.f, 0.f}, Yv = U;
                            U = __builtin_amdgcn_mfma_f32_16x16x32_bf16(ah0, zp01, U, 0, 0, 0); U = __builtin_amdgcn_mfma_f32_16x16x32_bf16(ah1, zp23, U, 0, 0, 0);
                            U = __builtin_amdgcn_mfma_f32_16x16x16bf16_1k(__builtin_bit_cast(s16x4, g4), __builtin_bit_cast(s16x4, vt), U, 0, 0, 0);
                            Yv = __builtin_amdgcn_mfma_f32_16x16x32_bf16(rh0, zp01, Yv, 0, 0, 0); Yv = __builtin_amdgcn_mfma_f32_16x16x32_bf16(rh1, zp23, Yv, 0, 0, 0);
                            u32x4 uvw; uvw.x = pk2bf(U[0], U[1]); uvw.y = pk2bf(U[2], U[3]); uvw.z = vt.x; uvw.w = vt.y;
                            const bf16x8 uv = __builtin_bit_cast(bf16x8, uvw);
                            Yv = __builtin_amdgcn_mfma_f32_16x16x32_bf16(mrk, uv, Yv, 0, 0, 0);
#pragma unroll
                            for (int kb = 0; kb < 4; ++kb) { Z[kb] = Z[kb] * gam[kb]; Z[kb] = __builtin_amdgcn_mfma_f32_16x16x32_bf16(bk[kb], uv, Z[kb], 0, 0, 0); }
#pragma unroll
                            for (int r = 0; r < 4; ++r) YB[(cs * 16 + 4 * fq + r) * 68 + v] = Yv[r];
                        }
                        RAW_BAR();
                    }
                } else if (wave < 6) {
                    const unsigned lds0 = (unsigned)(uintptr_t)lds; const int lw = wave - 4;
#define DMA_SC(sc) do { const int nc_ = (NCH - 2 * (sc)) < 2 ? 1 : 2; for (int cs_ = 0; cs_ < nc_; ++cs_) { const int ch_ = 2 * (sc) + cs_; \
                        _Pragma("unroll") for (int pc_ = 0; pc_ < 6; ++pc_) { const int pc = lw * 6 + pc_; \
                            const unsigned char* src_ = (pc < 8 ? RA0 + (size_t)ch_ * RA_BYTES + pc * 1024 : RB0 + (size_t)ch_ * RB_BYTES + (pc - 8) * 1024) + lane * 16; \
                            attn_body::glds16(src_, (unsigned)__builtin_amdgcn_readfirstlane(lds0 + (ch_ & (NSLOT - 1)) * SLOTB + pc * 1024)); } } } while (0)
                    DMA_SC(0); DMA_SC(1); DMA_SC(2);
                    asm volatile("s_waitcnt vmcnt(24)\n\ts_barrier" ::: "memory");
                    for (int s = 0; s < NSC; ++s) {
                        if (s + 3 < NSC) DMA_SC(s + 3);
                        const int fl = (s + 3 < NSC ? ((NCH - 2 * (s + 3)) < 2 ? 6 : 12) : 0) + (s + 2 < NSC ? ((NCH - 2 * (s + 2)) < 2 ? 6 : 12) : 0);
                        if (fl == 24) asm volatile("s_waitcnt vmcnt(24)\n\ts_barrier" ::: "memory");
                        else if (fl == 18) asm volatile("s_waitcnt vmcnt(18)\n\ts_barrier" ::: "memory");
                        else if (fl == 6) asm volatile("s_waitcnt vmcnt(6)\n\ts_barrier" ::: "memory");
                        else asm volatile("s_waitcnt vmcnt(0)\n\ts_barrier" ::: "memory");
                    }
#undef DMA_SC
                } else {
                    const int pw = wave - 6, tk = lane >> 2, part = lane & 3, cgv = h * 64 + part * 16;
                    const bf16_t* BV = (const bf16_t*)(ws + WS_BV);
                    float gnw[16], gnb[16];
#pragma unroll
                    for (int j = 0; j < 16; ++j) { gnw[j] = (a.in[13] + l * 512)[cgv + j]; gnb[j] = (a.in[14] + l * 512)[cgv + j]; }
                    u32x4 gq0 = (u32x4){0u, 0u, 0u, 0u}, gq1 = gq0, bq0 = gq0, bq1 = gq0;
                    RAW_BAR();
                    for (int s = 0; s <= NSC; ++s) {
                        const int cp = 2 * (s - 1) + pw;
                        const bool do_now = s >= 1 && cp < NCH && (cp > 0 || b == 0);
                        const u32x4 g0 = gq0, g1 = gq1, b0 = bq0, b1 = bq1;
                        const int cn = 2 * s + pw;
                        if (s < NSC && cn < NCH) { const size_t rown = (size_t)rowof(b, 16 * cn + tk);
                            gq0 = *(const u32x4*)(y + rown * DM + cgv); gq1 = *(const u32x4*)(y + rown * DM + cgv + 8);
                            bq0 = *(const u32x4*)(BV + rown * 512 + cgv); bq1 = *(const u32x4*)(BV + rown * 512 + cgv + 8); }
                        if (do_now) {
                            const LAS float* yb = (const LAS float*)(ldsl + YB_OFF + ((s - 1) & 1) * YB_BYTES) + (pw * 16 + tk) * 68 + part * 16;
                            float yv[16];
#pragma unroll
                            for (int q4 = 0; q4 < 4; ++q4) { const f32x4 t4 = *(const LAS f32x4*)(yb + 4 * q4); yv[4 * q4] = t4[0]; yv[4 * q4 + 1] = t4[1]; yv[4 * q4 + 2] = t4[2]; yv[4 * q4 + 3] = t4[3]; }
                            float s1 = 0.f;
#pragma unroll
                            for (int j = 0; j < 16; ++j) s1 += yv[j];
                            s1 += __shfl_xor(s1, 1); s1 += __shfl_xor(s1, 2);
                            const float mean = s1 * (1.f / 64.f); float s2 = 0.f;
#pragma unroll
                            for (int j = 0; j < 16; ++j) { yv[j] -= mean; s2 += yv[j] * yv[j]; }
                            s2 += __shfl_xor(s2, 1); s2 += __shfl_xor(s2, 2);
                            const float rstd = 1.0f / sqrtf(s2 * (1.f / 64.f) + 64e-5f);
                            const unsigned gws[8] = {g0.x, g0.y, g0.z, g0.w, g1.x, g1.y, g1.z, g1.w}, bws[8] = {b0.x, b0.y, b0.z, b0.w, b1.x, b1.y, b1.z, b1.w};
                            unsigned ow[8];
#pragma unroll
                            for (int j2 = 0; j2 < 8; ++j2) {
                                const float oa = (yv[2 * j2] * rstd * gnw[2 * j2] + gnb[2 * j2] + __uint_as_float(bws[j2] << 16)) * __uint_as_float(gws[j2] << 16);
                                const float ob = (yv[2 * j2 + 1] * rstd * gnw[2 * j2 + 1] + gnb[2 * j2 + 1] + __uint_as_float(bws[j2] & 0xffff0000u)) * __uint_as_float(gws[j2] & 0xffff0000u);
                                ow[j2] = pk2bf(oa, ob); }
                            bf16_t* yo = y + (size_t)rowof(b, 16 * cp + tk) * DM + cgv;
                            *(u32x4*)yo = (u32x4){ow[0], ow[1], ow[2], ow[3]}; *(u32x4*)(yo + 8) = (u32x4){ow[4], ow[5], ow[6], ow[7]};
                        }
                        if (s < NSC) RAW_BAR();
                    }
                }
                __syncthreads();
            }
#undef RAW_BAR
        }
        {
            PHASE_IDS();
            if (gw < NH * NMETA) {
                const int h = gw >> 4, t = gw & 15;
                const bf16_t* qrow = p + (size_t)(MROWS + t) * PBW + 1536 + h * 64;
                float s = -INFINITY;
                if (lane <= t) { const bf16_t* kr = p + (size_t)(MROWS + lane) * PBW + 2048 + h * 64; float d = 0.f;
                    for (int e = 0; e < 64; ++e) d += bf2f(qrow[e]) * bf2f(kr[e]);
                    s = d - c2[(size_t)h * 2176 + lane]; }
                const float mx = wave_max(s); const float e = lane <= t ? exp2f(s - mx) : 0.f; const float sum = wave_sum(e);
                float o = 0.f;
                for (int j = 0; j <= t; ++j) o += __shfl(e, j) * bf2f(p[(size_t)(MROWS + j) * PBW + 2560 + h * 64 + lane]);
                o /= sum;
                const float og = bf2f(p[(size_t)(MROWS + t) * PBW + 3072 + h * 64 + lane]);
                y[(size_t)(MROWS + t) * DM + 512 + h * 64 + lane] = f2bf(o * sigmoidf_(og));
            }
        }
        __syncthreads();
        {
            typedef attn_body::bf16 abf;
            const attn_body::AttnTensors AT{(const abf*)(p + 1536), (const abf*)(p + 2048), (const abf*)(p + 2560), (const abf*)(p + 3072), c2, (abf*)(y + 512)};
            const attn_body::StaticOrder S(G, bid);
            attn_body::attn_phase<attn_body::StaticOrder>((char*)lds, AT, S);
        }
        GRID_BAR();
        {
            PHASE_IDS();
            pg8::Gemm g{y, W2, MROWS, DM, DM}; pg8::StaticOrder S; S.init(MROWS, DM, G, bid);
            pg8::EpiRes E{out, hb, ssqp};
            pg8::gemm_phase<pg8::EpiRes, pg8::StaticOrder, true, true>(ldsl, g, S, E);
            meta_gemm<false>(y + (size_t)MROWS * DM, DM, W2, DM, DM, gw, ngw, lane, MEpiRes{hm});
        }
        GRID_BAR();
        for (int t0 = 0; t0 < 22; t0 += 6) {
            const int nt = (22 - t0) < 6 ? (22 - t0) : 6, ldr = nt * 256;
            {
                PHASE_IDS();
                pg8::Gemm g{hb, W3 + (size_t)t0 * 256 * DM, MROWS, ldr, DM}; pg8::StaticOrder S; S.init(MROWS, ldr, G, bid);
                pg8::Epi3Raw E{ssqp, raw, ldr};
                pg8::gemm_phase<pg8::Epi3Raw, pg8::StaticOrder, true, true>(ldsl, g, S, E);
                meta_gemm<true>(hm, DM, W3 + (size_t)t0 * 256 * DM, ldr, DM, gw, ngw, lane, MEpi3{raw, ldr});
            }
            GRID_BAR();
            {
                PHASE_IDS();
                const float* cw = a.in[21] + (size_t)l * 3 * DFF2; const float* cb = a.in[22] + (size_t)l * DFF2;
                const int per_row = nt * 128; const size_t total = (size_t)RROWS * per_row;
                for (size_t e = (size_t)bid * (NWAVES * 64) + tid; e < total; e += (size_t)G * (NWAVES * 64)) {
                    const int row = (int)(e / per_row), jj = (int)(e % per_row), tl = jj >> 7, c = jj & 127;
                    const int ch = 128 * (t0 + tl) + c;
                    const int p1 = prevrow(row), p2 = p1 >= 0 ? prevrow(p1) : -1;
                    const int cu = tl * 256 + c, cgt = cu + 128;
                    float u = cb[ch] + cw[2 * DFF2 + ch] * bf2f(raw[(size_t)row * ldr + cu]);
                    float g = cb[DFF + ch] + cw[2 * DFF2 + DFF + ch] * bf2f(raw[(size_t)row * ldr + cgt]);
                    if (p1 >= 0) { u += cw[DFF2 + ch] * bf2f(raw[(size_t)p1 * ldr + cu]); g += cw[DFF2 + DFF + ch] * bf2f(raw[(size_t)p1 * ldr + cgt]); }
                    if (p2 >= 0) { u += cw[ch] * bf2f(raw[(size_t)p2 * ldr + cu]); g += cw[DFF + ch] * bf2f(raw[(size_t)p2 * ldr + cgt]); }
                    act[(size_t)row * DFF + ch] = f2bf(g * sigmoidf_(g) * u);
                }
            }
            GRID_BAR();
        }
        {
            PHASE_IDS();
            pg8::Gemm g{act, W4, MROWS, DM, DFF}; pg8::StaticOrder S; S.init(MROWS, DM, G, bid);
            pg8::EpiRes E{out, hb, ssqp};
            pg8::gemm_phase<pg8::EpiRes, pg8::StaticOrder, true, true>(ldsl, g, S, E);
            meta_gemm<false>(act + (size_t)MROWS * DFF, DFF, W4, DM, DFF, gw, ngw, lane, MEpiRes{hm});
        }
        if (l + 1 < DEPTH) GRID_BAR();
    }
}

extern "C" void kernel_launch(void* const* d_in, const int* in_sizes, int n_in, void* d_out, int out_size, void* d_ws, size_t ws_size, hipStream_t stream) {
    static int grid = 0;
    if (grid == 0) {
        if (n_in != 24 || out_size != MROWS * DM || ws_size < WS_END) { fprintf(stderr, "kernel_launch: unexpected shapes (n_in %d out %d ws %zu)\n", n_in, out_size, ws_size); grid = -1; return; }
        int dev = 0, cus = 0, per_cu = 0;
        hipGetDevice(&dev); hipDeviceGetAttribute(&cus, hipDeviceAttributeMultiprocessorCount, dev);
        if (hipFuncSetAttribute((const void*)mk_fwd, hipFuncAttributeMaxDynamicSharedMemorySize, LDS_BYTES) != hipSuccess) { fprintf(stderr, "kernel_launch: hipFuncSetAttribute failed\n"); grid = -1; return; }
        hipOccupancyMaxActiveBlocksPerMultiprocessor(&per_cu, (const void*)mk_fwd, NWAVES * 64, LDS_BYTES);
        (void)hipGetLastError();
        if (per_cu < 1) { fprintf(stderr, "kernel_launch: occupancy query says %d blocks per CU\n", per_cu); }
        grid = cus;
    }
    if (grid < 0) return;
    hipMemsetAsync((char*)d_ws + WS_CTL, 0, CTL_ZERO_BYTES, stream);
    Args a{};
    for (int i = 0; i < 24; ++i) a.in[i] = (const float*)d_in[i];
    a.out = (float*)d_out; a.ws = (unsigned char*)d_ws;
    void* args[] = {&a};
    hipError_t e = hipLaunchCooperativeKernel((const void*)mk_fwd, dim3(grid), dim3(NWAVES * 64), args, LDS_BYTES, stream);
    if (e != hipSuccess) fprintf(stderr, "cooperative launch failed: %s (grid %d)\n", hipGetErrorString(e), grid);
}
```

```cpp
#define PLAIN_LAUNCH 1
#include <hip/hip_runtime.h>
#include <hip/hip_cooperative_groups.h>
#include <stdint.h>
#include <cstdio>
namespace cg = cooperative_groups;

typedef unsigned short bf16_t;
typedef short bf16x8 __attribute__((ext_vector_type(8)));
typedef float f32x4 __attribute__((ext_vector_type(4)));
typedef unsigned u32x4 __attribute__((ext_vector_type(4)));
typedef unsigned u32x2 __attribute__((ext_vector_type(2)));

constexpr int NB = 8, SEQ = 2048, NMETA = 16, LTOT = 2064, DM = 1024, DEPTH = 4, NH = 8, HD = 64;
constexpr int N_IN = 3880, DFF = 2816, DFF2 = 5632;
constexpr int MROWS = NB * SEQ;
constexpr int RROWS = MROWS + NMETA;
constexpr int N1 = 4096;
constexpr int PBW = 3584;
constexpr int PNW = 320;
constexpr float LOG2E = 1.4426950408889634f;

constexpr size_t MiB = 1u << 20;
constexpr size_t WS_CTL = 0, CTL_ZERO_BYTES = 1 * MiB;
constexpr size_t WS_W = 1 * MiB, WL_BYTES = 27 * MiB;
constexpr size_t WO_W1 = 0;
constexpr size_t WO_W2 = 8 * MiB;
constexpr size_t WO_W3 = 10 * MiB;
constexpr size_t WO_W4 = 21 * MiB;
constexpr size_t WO_LUP = 26 * MiB + 512 * 1024;
constexpr size_t WS_SMALL = WS_W + 2 * WL_BYTES;
constexpr size_t WS_HM = WS_SMALL;
constexpr size_t WS_C2 = WS_SMALL + 1 * MiB;
constexpr size_t WS_SSQ = WS_SMALL + 3 * MiB;
constexpr size_t WS_HB = WS_SMALL + 6 * MiB;
constexpr size_t WS_P = WS_HB + 33 * MiB;
constexpr size_t WS_PN = WS_P + 113 * MiB;
constexpr size_t WS_Y = WS_PN + 21 * MiB;
constexpr size_t WS_FREE = WS_Y + 33 * MiB;
constexpr int NCH = 129;
constexpr size_t RA_BYTES = 8192, RB_BYTES = 4096;
constexpr size_t WS_RA = WS_FREE;
#define SWZ4(r) (3 * (((r) >> 3) & 1))
constexpr size_t WS_ACT = WS_P;
constexpr size_t WS_FIX = WS_PN;
constexpr size_t WS_RAWM = WS_PN + 6 * MiB;
constexpr size_t WS_BV = WS_RA + 65 * MiB;
constexpr size_t WS_END = WS_BV + 17 * MiB;

__device__ __forceinline__ float bf2f(bf16_t v) { return __uint_as_float(((unsigned)v) << 16); }
typedef float f32x2_t_ __attribute__((ext_vector_type(2))); typedef __bf16 bf16x2_t_ __attribute__((ext_vector_type(2)));
__device__ __forceinline__ unsigned pk2bf(float lo, float hi) { const f32x2_t_ v = {lo, hi}; return __builtin_bit_cast(unsigned, __builtin_convertvector(v, bf16x2_t_)); }
__device__ __forceinline__ bf16_t f2bf(float f) { return __builtin_bit_cast(bf16_t, (__bf16)f); }
__device__ __forceinline__ float sigmoidf_(float x) { return 1.f / (1.f + __expf(-x)); }
__device__ __forceinline__ float wave_sum_dpp(float v) {
#define DPPF_(x, ctrl, rmask) __int_as_float(__builtin_amdgcn_update_dpp(0, __float_as_int(x), ctrl, rmask, 0xf, false))
    v += DPPF_(v, 0xB1, 0xf);
    v += DPPF_(v, 0x4E, 0xf);
    v += DPPF_(v, 0x141, 0xf);
    v += DPPF_(v, 0x140, 0xf);
    v += DPPF_(v, 0x142, 0xa);
    v += DPPF_(v, 0x143, 0xc);
#undef DPPF_
    return __int_as_float(__builtin_amdgcn_readlane(__float_as_int(v), 63));
}
__device__ __forceinline__ float wave_sum(float v) { return wave_sum_dpp(v); }
__device__ __forceinline__ float wave_max(float v) {
#define DPPF_(x, ctrl, rmask) __int_as_float(__builtin_amdgcn_update_dpp(__float_as_int(x), __float_as_int(x), ctrl, rmask, 0xf, false))
    v = fmaxf(v, DPPF_(v, 0xB1, 0xf)); v = fmaxf(v, DPPF_(v, 0x4E, 0xf)); v = fmaxf(v, DPPF_(v, 0x141, 0xf)); v = fmaxf(v, DPPF_(v, 0x140, 0xf));
    v = fmaxf(v, DPPF_(v, 0x142, 0xa)); v = fmaxf(v, DPPF_(v, 0x143, 0xc));
#undef DPPF_
    return __int_as_float(__builtin_amdgcn_readlane(__float_as_int(v), 63));
}
__device__ __forceinline__ float add_xor16(float x) { const auto r = __builtin_amdgcn_permlane16_swap(__float_as_uint(x), __float_as_uint(x), false, false); return __uint_as_float(r[0]) + __uint_as_float(r[1]); }
__device__ __forceinline__ float add_xor32(float x) { const auto r = __builtin_amdgcn_permlane32_swap(__float_as_uint(x), __float_as_uint(x), false, false); return __uint_as_float(r[0]) + __uint_as_float(r[1]); }
__device__ __forceinline__ int lane_id() { int l; asm volatile("v_mbcnt_lo_u32_b32 %0, -1, 0\n\tv_mbcnt_hi_u32_b32 %0, -1, %0" : "=v"(l)); return l; }
#define WAVE_LDS_SYNC() do { __builtin_amdgcn_s_waitcnt(0xc07f); __builtin_amdgcn_wave_barrier(); } while (0)
__device__ __forceinline__ int rowof(int b, int t) { return t < NMETA ? MROWS + t : b * SEQ + (t - NMETA); }
__device__ __forceinline__ int prevrow(int row) {
    if (row >= MROWS) return row == MROWS ? -1 : row - 1;
    return (row & (SEQ - 1)) ? row - 1 : MROWS + NMETA - 1;
}

#define PERM32(j) (8 * (((j) >> 2) & 3) + 4 * ((j) >> 4) + ((j) & 3))
__device__ __forceinline__ int src_col(int mode, int n) {
    if (mode == 1) {
        const int g = n >> 9, c_ = n & 255, o = (n & 256) + (g < 7 ? ((c_ >> 5) & 3) * 64 + (c_ >> 7) * 32 + PERM32(c_ & 31) : c_);
        switch (g) {
            case 0: return o;
            case 1: return 512 + o;
            case 2: return 1024 + o;
            case 3: return 1824 + o;
            case 4: return 2336 + o;
            case 5: return 2848 + o;
            case 6: return 3360 + o;
            default:
                if (o < 64) return 1536 + o;
                if (o < 128) return 1600 + (o - 64);
                if (o < 288) return 1664 + (o - 128);
                if (o < 296) return 3872 + (o - 288);
                return -1;
        }
    }
    if (mode == 3) { const int t = n >> 8, c = n & 255; return c < 128 ? 128 * t + c : DFF + 128 * t + (c - 128); }
    return (n & ~31) + PERM32(n & 31);
}
__device__ __forceinline__ void wprep_item(const float* W, const float* gk, bf16_t* WT, int K, int Nsrc, int Ndst, int mode, int item, float* scr, int lane) {
    const int nblk = Ndst / 32, kb = item / nblk, nb = item % nblk, k0 = 64 * kb, n0 = 32 * nb;
    const int sc = src_col(mode, n0 + (lane & 31));
    const float* wp = W + (size_t)(k0 + (lane >> 5)) * Nsrc + (sc >= 0 ? sc : 0);
    float v[32];
#pragma unroll
    for (int i = 0; i < 32; ++i) { v[i] = *wp; wp += 2 * (size_t)Nsrc; }
#pragma unroll
    for (int i = 0; i < 32; ++i) scr[(2 * i + (lane >> 5)) * 33 + (lane & 31)] = sc >= 0 ? v[i] : 0.f;
    WAVE_LDS_SYNC();
    const int c = lane & 7;
    f32x4 g0 = (f32x4){1.f, 1.f, 1.f, 1.f}, g1 = g0;
    if (gk) { g0 = *(const f32x4*)(gk + k0 + 8 * c); g1 = *(const f32x4*)(gk + k0 + 8 * c + 4); }
#pragma unroll
    for (int j = 0; j < 4; ++j) {
        const int n = (lane >> 3) + 8 * j; const float* s = scr + (8 * c) * 33 + n;
        u32x4 o;
        o.x = pk2bf(s[0 * 33] * g0[0], s[1 * 33] * g0[1]); o.y = pk2bf(s[2 * 33] * g0[2], s[3 * 33] * g0[3]); o.z = pk2bf(s[4 * 33] * g1[0], s[5 * 33] * g1[1]); o.w = pk2bf(s[6 * 33] * g1[2], s[7 * 33] * g1[3]);
        *(u32x4*)(WT + (size_t)(n0 + n) * K + k0 + 8 * c) = o;
    }
    WAVE_LDS_SYNC();
}
namespace pg8 {
#define PG8_LAS __attribute__((address_space(3)))
typedef unsigned short bf16_t;
typedef short bf16x8 __attribute__((ext_vector_type(8)));
typedef float f32x4 __attribute__((ext_vector_type(4)));
typedef unsigned u32x4 __attribute__((ext_vector_type(4)));
constexpr int BM = 256, BK = 64, HALF = 128, HTB = HALF * BK * 2  , STAGE_BYTES = 8 * HTB, NXCD = 8, WGM = 8;

__host__ __device__ __forceinline__ int lds_byte(int r, int c) { const int st = (r >> 4) * 2 + (c >> 5), rr = r & 15, cc = c & 31, ob = rr * 64 + cc * 2; return st * 1024 + (ob ^ (((ob >> 9) & 1) << 5)); }
__host__ __device__ __forceinline__ void stage_rc(int b, int& R, int& C) { const int st = b / 1024, sb = b % 1024, swz = sb ^ (((sb >> 9) & 1) << 5); R = (st >> 1) * 16 + swz / 64; C = (st & 1) * 32 + (swz % 64) / 2; }
__host__ __device__ __forceinline__ int perm32(int rho) { const int n = rho >> 4, i = rho & 15; return 8 * (i >> 2) + 4 * n + (i & 3); }

struct Unit { int pm, pn, idx; };
struct Gemm { const bf16_t* A; const bf16_t* Bt; int M, N, K; };

struct StaticOrder {
    int nM, nN, nwg, G, c;
    __host__ __device__ void init(int M, int N, int G_, int c_) { nM = M / BM; nN = N / BM; nwg = nM * nN; G = G_; c = c_; }
    __host__ __device__ bool next(int i, Unit& u) const {
        const long L = (long)i * G + c; if (L >= nwg) return false;
        int wgid = (int)L; { const int q = nwg / NXCD, r = nwg % NXCD, xcd = wgid % NXCD, off = wgid / NXCD; wgid = (xcd < r ? xcd * (q + 1) : r * (q + 1) + (xcd - r) * q) + off; }
        const int nig = WGM * nN, gid = wgid / nig, fm = gid * WGM, gsz = (nM - fm) < WGM ? (nM - fm) : WGM;
        u.pm = fm + ((wgid % nig) % gsz); u.pn = (wgid % nig) / gsz; u.idx = i; return true;
    }
    __device__ __forceinline__ void a_ready(const Unit&) const {}
    __device__ __forceinline__ void done(const Unit&) const {}
};

__device__ __forceinline__ float row_rstd(const float* ssqp, int row) {
    const f32x4* sp = (const f32x4*)(ssqp + (size_t)row * 16);
    const f32x4 a = sp[0], b = sp[1], c = sp[2], d = sp[3];
    const float s = (((a.x + a.y) + (a.z + a.w)) + ((b.x + b.y) + (b.z + b.w))) + (((c.x + c.y) + (c.z + c.w)) + ((d.x + d.y) + (d.z + d.w)));
    return 1.0f / sqrtf(s * (1.f / 1024.f) + 1e-6f);
}
struct Epi1 {
    static constexpr bool PERM = false, AFTER_DRAIN = false, INIT_ACC = false;
    const PG8_LAS float* rstdl; bf16_t* p; float* pn; const float* q_g; const float* k_g;
    __device__ __forceinline__ void operator()(const f32x4 (&acc)[2][2][4][2], const Unit& u, int wr, int wc, int fr, int fq) const {
        const int row0 = u.pm * BM + wr * 64 + fr;
        const bool isq = (u.pn >> 1) == 3, isk = (u.pn >> 1) == 4;
        f32x4 gsc[2][2];
        if (isq || isk) {
#pragma unroll
            for (int bj = 0; bj < 2; ++bj)
#pragma unroll
                for (int n = 0; n < 2; ++n) gsc[bj][n] = *(const f32x4*)((isq ? q_g : k_g) + 32 * bj + 8 * fq + 4 * n) * (isq ? 0.125f * 1.4426950408889634f : 1.f);
        }
#pragma unroll
        for (int ai = 0; ai < 2; ++ai)
#pragma unroll
            for (int m = 0; m < 4; ++m) {
                const int row = row0 + ai * HALF + m * 16; const float rs = rstdl[u.idx * 256 + wr * 64 + fr + ai * HALF + m * 16];
                f32x4 v[2][2];
#pragma unroll
                for (int bj = 0; bj < 2; ++bj)
#pragma unroll
                    for (int n = 0; n < 2; ++n) v[bj][n] = acc[ai][bj][m][n] * rs;
                if (u.pn < 14) {
                    if (isq || isk) {
                        float ss = 0.f;
#pragma unroll
                        for (int bj = 0; bj < 2; ++bj)
#pragma unroll
                            for (int n = 0; n < 2; ++n) ss += (v[bj][n][0] * v[bj][n][0] + v[bj][n][1] * v[bj][n][1]) + (v[bj][n][2] * v[bj][n][2] + v[bj][n][3] * v[bj][n][3]);
                        ss = add_xor16(ss); ss = add_xor32(ss);
                        const float rn = 1.0f / sqrtf(ss * (1.f / 64.f) + 1e-6f);
#pragma unroll
                        for (int bj = 0; bj < 2; ++bj)
#pragma unroll
                            for (int n = 0; n < 2; ++n) v[bj][n] = v[bj][n] * gsc[bj][n] * rn;
                    }
#pragma unroll
                    for (int bj = 0; bj < 2; ++bj) { u32x4 w; w.x = pk2bf(v[bj][0][0], v[bj][0][1]); w.y = pk2bf(v[bj][0][2], v[bj][0][3]); w.z = pk2bf(v[bj][1][0], v[bj][1][1]); w.w = pk2bf(v[bj][1][2], v[bj][1][3]);
                        *(u32x4*)(p + (size_t)row * PBW + u.pn * BM + wc * 64 + bj * 32 + 8 * fq) = w; }
                } else {
#pragma unroll
                    for (int bj = 0; bj < 2; ++bj)
#pragma unroll
                        for (int n = 0; n < 2; ++n) { const int o = u.pn * BM + wc * 32 + 4 * fq + bj * HALF + n * 16 - PBW; if (o < 296) *(f32x4*)(pn + (size_t)row * PNW + o) = v[bj][n]; }
                }
            }
    }
};
struct EpiRes {
    static constexpr bool PERM = false, AFTER_DRAIN = false, INIT_ACC = true;
    float* outp; bf16_t* hb; float* ssqp;
    __device__ __forceinline__ void init_issue(u32x4 (&tmp)[2][4][2], const Unit& u, int wr, int wc, int fr, int fq) const {
        const int row0 = u.pm * BM + wr * 64 + fr, col0 = u.pn * BM + wc * 32 + 8 * fq;
#pragma unroll
        for (int ai = 0; ai < 2; ++ai)
#pragma unroll
            for (int m = 0; m < 4; ++m)
#pragma unroll
                for (int bj = 0; bj < 2; ++bj) tmp[ai][m][bj] = *(const u32x4*)(hb + (size_t)(row0 + ai * HALF + m * 16) * DM + col0 + bj * HALF);
    }
    __device__ __forceinline__ void init_finish(f32x4 (&acc)[2][2][4][2], const u32x4 (&tmp)[2][4][2]) const {
#pragma unroll
        for (int ai = 0; ai < 2; ++ai)
#pragma unroll
            for (int m = 0; m < 4; ++m)
#pragma unroll
                for (int bj = 0; bj < 2; ++bj) { const u32x4 h4 = tmp[ai][m][bj];
                    acc[ai][bj][m][0] = (f32x4){__uint_as_float(h4.x << 16), __uint_as_float(h4.x & 0xffff0000u), __uint_as_float(h4.y << 16), __uint_as_float(h4.y & 0xffff0000u)};
                    acc[ai][bj][m][1] = (f32x4){__uint_as_float(h4.z << 16), __uint_as_float(h4.z & 0xffff0000u), __uint_as_float(h4.w << 16), __uint_as_float(h4.w & 0xffff0000u)}; }
    }
    __device__ __forceinline__ void operator()(const f32x4 (&acc)[2][2][4][2], const Unit& u, int wr, int wc, int fr, int fq) const {
        const int row0 = u.pm * BM + wr * 64 + fr, col0 = u.pn * BM + wc * 32 + 8 * fq;
        const bool has_res = u.idx == 0;
#pragma unroll
        for (int ai = 0; ai < 2; ++ai) {
            u32x4 hw[4][2];
            if (!has_res) {
#pragma unroll
                for (int m = 0; m < 4; ++m)
#pragma unroll
                    for (int bj = 0; bj < 2; ++bj) hw[m][bj] = *(const u32x4*)(hb + (size_t)(row0 + ai * HALF + m * 16) * DM + col0 + bj * HALF);
            } else {
#pragma unroll
                for (int m = 0; m < 4; ++m)
#pragma unroll
                    for (int bj = 0; bj < 2; ++bj) hw[m][bj] = (u32x4){0u, 0u, 0u, 0u};
            }
#pragma unroll
            for (int m = 0; m < 4; ++m) {
                const int row = row0 + ai * HALF + m * 16; float ss = 0.f;
#pragma unroll
                for (int bj = 0; bj < 2; ++bj) {
                    const int col = col0 + bj * HALF; bf16_t* hp = hb + (size_t)row * DM + col;
                    const u32x4 h4 = hw[m][bj];
                    const f32x4 v0 = (f32x4){__uint_as_float(h4.x << 16), __uint_as_float(h4.x & 0xffff0000u), __uint_as_float(h4.y << 16), __uint_as_float(h4.y & 0xffff0000u)} + acc[ai][bj][m][0];
                    const f32x4 v1 = (f32x4){__uint_as_float(h4.z << 16), __uint_as_float(h4.z & 0xffff0000u), __uint_as_float(h4.w << 16), __uint_as_float(h4.w & 0xffff0000u)} + acc[ai][bj][m][1];
                    u32x4 w; w.x = pk2bf(v0[0], v0[1]); w.y = pk2bf(v0[2], v0[3]); w.z = pk2bf(v1[0], v1[1]); w.w = pk2bf(v1[2], v1[3]);
                    *(u32x4*)hp = w;
                    if (outp) { *(f32x4*)(outp + (size_t)row * DM + col) = v0; *(f32x4*)(outp + (size_t)row * DM + col + 4) = v1; }
                    const f32x4 r0 = (f32x4){__uint_as_float(w.x << 16), __uint_as_float(w.x & 0xffff0000u), __uint_as_float(w.y << 16), __uint_as_float(w.y & 0xffff0000u)};
                    const f32x4 r1 = (f32x4){__uint_as_float(w.z << 16), __uint_as_float(w.z & 0xffff0000u), __uint_as_float(w.w << 16), __uint_as_float(w.w & 0xffff0000u)};
                    ss += ((r0[0] * r0[0] + r0[1] * r0[1]) + (r0[2] * r0[2] + r0[3] * r0[3])) + ((r1[0] * r1[0] + r1[1] * r1[1]) + (r1[2] * r1[2] + r1[3] * r1[3]));
                }
                ss = add_xor16(ss); ss = add_xor32(ss);
                if (fq == 0) ssqp[(size_t)row * 16 + u.pn * 4 + wc] = ss;
            }
        }
    }
};
__device__ __forceinline__ float dpp_ror1(float x) { return __int_as_float(__builtin_amdgcn_mov_dpp(__float_as_int(x), 0x121, 0xf, 0xf, true)); }
__device__ __forceinline__ float dpp_ror2(float x) { return __int_as_float(__builtin_amdgcn_mov_dpp(__float_as_int(x), 0x122, 0xf, 0xf, true)); }
__device__ __forceinline__ float vmul_s(float a, float b) { float r; asm volatile("v_mul_f32_e32 %0, %1, %2" : "=v"(r) : "v"(a), "v"(b)); return r; }
struct EpiConv {
    static constexpr bool PERM = false, AFTER_DRAIN = false, INIT_ACC = false;
    const PG8_LAS float* rstdl; const float* cw; const float* cb; bf16_t* act; float* fix; PG8_LAS unsigned char* halo; PG8_LAS float* ctab;
    __device__ __forceinline__ void operator()(const f32x4 (&acc)[2][2][4][2], const Unit& u, int wr, int wc, int fr_, int fq_) const {
        int fr = fr_, fq = fq_; asm volatile("" : "+v"(fr), "+v"(fq));
        const int row0 = u.pm * BM + wr * 64 + fr, cl = wc * 32 + 4 * fq;
        {
            const int q = 2 * ((wr * 4 + wc) * 64 + fq * 16 + fr), p = q >> 8, col = q & 255;
            const float* src = (p < 3 ? cw + (size_t)p * DFF2 : cb) + (col < 128 ? 128 * u.pn + col : DFF + 128 * u.pn + (col - 128));
            typedef float f32x2w __attribute__((ext_vector_type(2)));
            *(PG8_LAS f32x2w*)(ctab + q) = *(const f32x2w*)src;
        }
        float rs[2][4];
#pragma unroll
        for (int ai = 0; ai < 2; ++ai)
#pragma unroll
            for (int m = 0; m < 4; ++m) rs[ai][m] = rstdl[u.idx * 256 + wr * 64 + fr + ai * HALF + m * 16];
        if (fr >= 14) {
#pragma unroll
            for (int ai = 0; ai < 2; ++ai)
#pragma unroll
                for (int bj = 0; bj < 2; ++bj)
#pragma unroll
                    for (int n = 0; n < 2; ++n) { const f32x4 v = acc[ai][bj][3][n] * rs[ai][3];
                        *(PG8_LAS f32x4*)(halo + ((((ai * 2 + wr) * 2 + (fr - 14)) * 256) + bj * HALF + cl + n * 16) * 4) = v;
                        if (ai == 1 && wr == 1) *(f32x4*)(fix + (size_t)(u.pm * 4 + 2 + (fr - 14)) * DFF2 + bj * DFF + 128 * u.pn + cl + n * 16) = v; }
        }
        if (fr < 2 && wr == 0) {
#pragma unroll
            for (int bj = 0; bj < 2; ++bj)
#pragma unroll
                for (int n = 0; n < 2; ++n) *(f32x4*)(fix + (size_t)(u.pm * 4 + fr) * DFF2 + bj * DFF + 128 * u.pn + cl + n * 16) = acc[0][bj][0][n] * rs[0][0];
        }
        asm volatile("s_waitcnt lgkmcnt(0)\n\ts_barrier" ::: "memory");
        typedef float f32x2v __attribute__((ext_vector_type(2)));
#pragma unroll
        for (int n = 0; n < 2; ++n) {
            const unsigned la2 = (unsigned)(fr * DFF + cl) * 2u;
            unsigned wpk[2][2][4];
#pragma unroll
            for (int eh = 0; eh < 2; ++eh) {
                asm volatile("" ::: "memory"); __builtin_amdgcn_sched_barrier(0);
                const int e = 2 * eh;
#define CWL(p, g) (*(const PG8_LAS f32x2v*)(ctab + (p) * 256 + (g) * 128 + cl + n * 16 + e))
                const f32x2v wu0 = CWL(0, 0), wu1 = CWL(1, 0), wu2 = CWL(2, 0), bu = CWL(3, 0);
                const f32x2v wg0 = CWL(0, 1), wg1 = CWL(1, 1), wg2 = CWL(2, 1), bg = CWL(3, 1);
#undef CWL
#pragma unroll
                for (int ai = 0; ai < 2; ++ai) {
                    const int ps = (ai * 2 + wr) ? (ai * 2 + wr - 1) : 0;
                    const PG8_LAS float* hp = (const PG8_LAS float*)halo + (ps * 2) * 256 + cl + n * 16 + e;
                    const f32x2v hu62 = *(const PG8_LAS f32x2v*)hp, hu63 = *(const PG8_LAS f32x2v*)(hp + 256), hg62 = *(const PG8_LAS f32x2v*)(hp + 128), hg63 = *(const PG8_LAS f32x2v*)(hp + 256 + 128);
                    f32x2v p1u = hu63, p1g = hg63, p2u = fr == 0 ? hu62 : hu63, p2g = fr == 0 ? hg62 : hg63;
#pragma unroll
                    for (int m = 0; m < 4; ++m) {
                        __builtin_amdgcn_sched_barrier(0);
                        f32x2v xu, xg;
                        xu.x = vmul_s(acc[ai][0][m][n][e], rs[ai][m]); xu.y = vmul_s(acc[ai][0][m][n][e + 1], rs[ai][m]); xg.x = vmul_s(acc[ai][1][m][n][e], rs[ai][m]); xg.y = vmul_s(acc[ai][1][m][n][e + 1], rs[ai][m]);
                        f32x2v r1u, r2u, r1g, r2g;
                        r1u.x = dpp_ror1(xu.x); r1u.y = dpp_ror1(xu.y); r2u.x = dpp_ror2(xu.x); r2u.y = dpp_ror2(xu.y);
                        r1g.x = dpp_ror1(xg.x); r1g.y = dpp_ror1(xg.y); r2g.x = dpp_ror2(xg.x); r2g.y = dpp_ror2(xg.y);
                        const f32x2v x1u = fr >= 1 ? r1u : p1u, x2u = fr >= 2 ? r2u : p2u, x1g = fr >= 1 ? r1g : p1g, x2g = fr >= 2 ? r2g : p2g;
                        p1u = r1u; p2u = r2u; p1g = r1g; p2g = r2g;
                        const f32x2v cu = bu + wu0 * x2u + wu1 * x1u + wu2 * xu, cg = bg + wg0 * x2g + wg1 * x1g + wg2 * xg;
                        const float o0 = cg.x * __builtin_amdgcn_rcpf(1.f + __builtin_amdgcn_exp2f(-1.4426950408889634f * cg.x)) * cu.x;
                        const float o1 = cg.y * __builtin_amdgcn_rcpf(1.f + __builtin_amdgcn_exp2f(-1.4426950408889634f * cg.y)) * cu.y;
                        wpk[eh][ai][m] = pk2bf(o0, o1);
                    }
                }
            }
#pragma unroll
            for (int ai = 0; ai < 2; ++ai)
#pragma unroll
                for (int m = 0; m < 4; ++m)
                {
                    u32x2 w; w.x = wpk[0][ai][m]; w.y = wpk[1][ai][m];
                    *(u32x2*)((char*)(act + (size_t)(u.pm * BM + wr * 64 + ai * HALF + m * 16) * DFF + 128 * u.pn + n * 16) + la2) = w; }
        }
    }
};

#ifdef TPROBE
#ifndef TPROBE_PH
#define TPROBE_PH -1
#endif
#define PG8_TP(ph) do { if (TPROBE < 20) break; const unsigned t_ = (unsigned)__builtin_amdgcn_s_memrealtime(); if (wave_s == 0 && lane_id() == 0) { volatile PG8_LAS unsigned* q_ = (volatile PG8_LAS unsigned*)(lds + (163840 - 1024 + 512)); \
        if ((ph) == TPROBE && (TPROBE_PH < 0 || q_[2] == (unsigned)TPROBE_PH)) q_[1] += t_ - q_[0]; q_[0] = t_; } } while (0)
#else
#define PG8_TP(ph) do {} while (0)
#endif
template <class Epi, class Sched, bool ALIGN_EPI = false, bool SP2 = false>
__device__ __forceinline__ void gemm_phase(PG8_LAS unsigned char* lds, const Gemm g, const Sched& S, const Epi& E, const int wave_s) {
    int tid_ = wave_s * 64 + lane_id(); asm volatile("" : "+v"(tid_));
    const int tid = tid_, wid = wave_s, lane = tid & 63, wr = wid >> 2, wc = wid & 3, fr = lane & 15, fq = lane >> 4;
    const int K = g.K, nt = K / BK;
    unsigned voffA[2], voffB[2];
#pragma unroll
    for (int i = 0; i < 2; ++i) { int R, C; stage_rc(tid * 16 + i * 8192, R, C); const int Rb = Epi::PERM ? ((R & ~31) + perm32(R & 31)) : R;
        voffA[i] = (unsigned)(R * K + C) * 2u; voffB[i] = (unsigned)(Rb * K + C) * 2u; }
    const size_t kstep = (size_t)(BK * 2);
    const size_t hstep = (size_t)HALF * K * 2;
    const size_t tstep = 2 * hstep;
    const unsigned ldsw = (unsigned)wid * 1024u;
    const int aoff = lds_byte(wr * 64 + fr, fq * 8), boff = lds_byte(wc * 32 + fr, fq * 8);
#define PG8_SA(b, h) (((b) * 2 + (h)) * HTB)
#define PG8_SB(b, h) ((4 + (b) * 2 + (h)) * HTB)
#define PG8_STAGE(bufoff, gbase, voff) do { _Pragma("unroll") for (int _i = 0; _i < 2; ++_i) \
        __builtin_amdgcn_global_load_lds((const unsigned*)((const char*)(gbase) + (voff)[_i]), (PG8_LAS unsigned*)(lds + (bufoff) + ldsw + _i * 8192), 16, 0, 0); } while (0)
#define PG8_LDA(dst, b, h) do { _Pragma("unroll") for (int m = 0; m < 4; ++m) _Pragma("unroll") for (int k = 0; k < 2; ++k) dst[m][k] = *(const PG8_LAS bf16x8*)(lds + PG8_SA(b, h) + aoff + m * 2048 + k * 1024); } while (0)
#define PG8_LDB(dst, b, h) do { _Pragma("unroll") for (int n = 0; n < 2; ++n) _Pragma("unroll") for (int k = 0; k < 2; ++k) dst[n][k] = *(const PG8_LAS bf16x8*)(lds + PG8_SB(b, h) + boff + n * 2048 + k * 1024); } while (0)
#define PG8_MMA(ai, bj, At, Bt) do { __builtin_amdgcn_s_setprio(1); _Pragma("unroll") for (int m = 0; m < 4; ++m) _Pragma("unroll") for (int n = 0; n < 2; ++n) _Pragma("unroll") for (int k = 0; k < 2; ++k) \
        acc[ai][bj][m][n] = __builtin_amdgcn_mfma_f32_16x16x32_bf16(Bt[n][k], At[m][k], acc[ai][bj][m][n], 0, 0, 0); __builtin_amdgcn_s_setprio(0); } while (0)
#define PG8_WAIT_V(n) asm volatile("s_waitcnt vmcnt(" #n ")" ::: "memory")
#define PG8_WAIT_L(n) asm volatile("s_waitcnt lgkmcnt(" #n ")" ::: "memory")
#define PG8_BAR __builtin_amdgcn_s_barrier()
#define PG8_SCHED __builtin_amdgcn_sched_barrier(0)
    Unit cur, nxt; int ui = 0;
    if (!S.next(0, cur)) return;
    f32x4 acc[2][2][4][2];
#pragma unroll
    for (int a = 0; a < 2; ++a)
#pragma unroll
        for (int b = 0; b < 2; ++b)
#pragma unroll
            for (int m = 0; m < 4; ++m)
#pragma unroll
                for (int n = 0; n < 2; ++n) acc[a][b][m][n] = (f32x4){0.f, 0.f, 0.f, 0.f};
    bf16x8 At[4][2], B0[2][2], B1[2][2];
    const char* cA = (const char*)g.A + (size_t)cur.pm * tstep; const char* cB = (const char*)g.Bt + (size_t)cur.pn * tstep;
    S.a_ready(cur);
    u32x4 itmp_[2][4][2];
    if constexpr (Epi::INIT_ACC) E.init_issue(itmp_, cur, wr, wc, fr, fq);
    if constexpr (SP2) {
        PG8_STAGE(PG8_SB(0, 0), cB, voffB); PG8_STAGE(PG8_SB(0, 1), cB + hstep, voffB); PG8_STAGE(PG8_SA(0, 0), cA, voffA); PG8_STAGE(PG8_SA(0, 1), cA + hstep, voffA);
        if (wr == 1) PG8_BAR;
        PG8_WAIT_V(2); PG8_BAR;
        PG8_STAGE(PG8_SB(1, 0), cB + kstep, voffB); PG8_STAGE(PG8_SA(1, 0), cA + kstep, voffA); PG8_STAGE(PG8_SB(1, 1), cB + hstep + kstep, voffB);
        PG8_WAIT_V(6); PG8_BAR;
    } else {
        PG8_STAGE(PG8_SB(0, 0), cB, voffB); PG8_STAGE(PG8_SA(0, 0), cA, voffA); PG8_STAGE(PG8_SB(0, 1), cB + hstep, voffB); PG8_STAGE(PG8_SA(0, 1), cA + hstep, voffA);
        if (wr == 1) PG8_BAR;
        PG8_WAIT_V(4); PG8_BAR;
        PG8_STAGE(PG8_SB(1, 0), cB + kstep, voffB); PG8_STAGE(PG8_SA(1, 0), cA + kstep, voffA); PG8_STAGE(PG8_SB(1, 1), cB + hstep + kstep, voffB);
        PG8_WAIT_V(6); PG8_BAR;
    }
    if constexpr (Epi::INIT_ACC) E.init_finish(acc, itmp_);
    for (;;) {
        const bool has_next = S.next(ui + 1, nxt);
        const char* nA = has_next ? (const char*)g.A + (size_t)nxt.pm * tstep : cA; const char* nB = has_next ? (const char*)g.Bt + (size_t)nxt.pn * tstep : cB;
        for (int t = 0; t < nt; t += 2) {
            const bool last = (t == nt - 2);
            const char* a1 = cA + (size_t)(t + 1) * kstep;
            const char* a2 = last ? nA : cA + (size_t)(t + 2) * kstep; const char* b2 = last ? nB : cB + (size_t)(t + 2) * kstep;
            const char* a3 = a2 + kstep; const char* b3 = b2 + kstep;
            if (last && has_next) S.a_ready(nxt);
            if constexpr (SP2) {
            PG8_LDB(B0, 0, 0); PG8_LDB(B1, 0, 1); PG8_SCHED; PG8_LDA(At, 0, 0); PG8_STAGE(PG8_SA(1, 1), a1 + hstep, voffA);
            PG8_WAIT_V(8); PG8_WAIT_L(0); PG8_BAR; PG8_MMA(0, 0, At, B0); PG8_MMA(0, 1, At, B1); PG8_BAR; PG8_SCHED;
            PG8_LDA(At, 0, 1); PG8_STAGE(PG8_SB(0, 0), b2, voffB); PG8_STAGE(PG8_SB(0, 1), b2 + hstep, voffB); PG8_STAGE(PG8_SA(0, 0), a2, voffA);
            PG8_WAIT_V(8); PG8_WAIT_L(0); PG8_BAR; PG8_MMA(1, 0, At, B0); PG8_MMA(1, 1, At, B1); PG8_BAR; PG8_SCHED;
            PG8_LDB(B0, 1, 0); PG8_LDB(B1, 1, 1); PG8_SCHED; PG8_LDA(At, 1, 0); PG8_STAGE(PG8_SA(0, 1), a2 + hstep, voffA);
            PG8_WAIT_V(8); PG8_WAIT_L(0); PG8_BAR; PG8_MMA(0, 0, At, B0); PG8_MMA(0, 1, At, B1); PG8_BAR; PG8_SCHED;
            PG8_LDA(At, 1, 1); PG8_STAGE(PG8_SB(1, 0), b3, voffB); PG8_STAGE(PG8_SB(1, 1), b3 + hstep, voffB); PG8_STAGE(PG8_SA(1, 0), a3, voffA);
            PG8_WAIT_V(8); PG8_WAIT_L(0); PG8_BAR; PG8_MMA(1, 0, At, B0); PG8_MMA(1, 1, At, B1); PG8_BAR; PG8_SCHED;
            } else {
            PG8_LDB(B0, 0, 0); PG8_SCHED; PG8_LDA(At, 0, 0); PG8_STAGE(PG8_SA(1, 1), a1 + hstep, voffA);
            PG8_WAIT_L(8); PG8_BAR; PG8_WAIT_L(0); PG8_MMA(0, 0, At, B0); PG8_BAR; PG8_SCHED;
            PG8_LDB(B1, 0, 1); PG8_STAGE(PG8_SB(0, 0), b2, voffB);
            PG8_BAR; PG8_WAIT_L(0); PG8_MMA(0, 1, At, B1); PG8_BAR;
            PG8_LDA(At, 0, 1); PG8_STAGE(PG8_SA(0, 0), a2, voffA);
            PG8_BAR; PG8_WAIT_L(0); PG8_MMA(1, 0, At, B0); PG8_BAR; PG8_SCHED;
            PG8_STAGE(PG8_SB(0, 1), b2 + hstep, voffB);
            PG8_WAIT_V(6); PG8_BAR; PG8_MMA(1, 1, At, B1); PG8_BAR;
            PG8_LDB(B0, 1, 0); PG8_SCHED; PG8_LDA(At, 1, 0); PG8_STAGE(PG8_SA(0, 1), a2 + hstep, voffA);
            PG8_WAIT_L(8); PG8_BAR; PG8_WAIT_L(0); PG8_MMA(0, 0, At, B0); PG8_BAR; PG8_SCHED;
            PG8_LDB(B1, 1, 1); PG8_STAGE(PG8_SB(1, 0), b3, voffB);
            PG8_BAR; PG8_WAIT_L(0); PG8_MMA(0, 1, At, B1); PG8_BAR;
            PG8_LDA(At, 1, 1); PG8_STAGE(PG8_SA(1, 0), a3, voffA);
            PG8_BAR; PG8_WAIT_L(0); PG8_MMA(1, 0, At, B0); PG8_BAR; PG8_SCHED;
            PG8_STAGE(PG8_SB(1, 1), b3 + hstep, voffB);
            PG8_WAIT_V(6); PG8_BAR; PG8_MMA(1, 1, At, B1); PG8_BAR;
            }
        }
        PG8_TP(49);
        if constexpr (ALIGN_EPI) { if (wr == 0) PG8_BAR; }
        if constexpr (!Epi::AFTER_DRAIN) { E(acc, cur, wr, wc, fr, fq); S.done(cur); }
        PG8_TP(50);
        if (!has_next) break;
#pragma unroll
        for (int a = 0; a < 2; ++a)
#pragma unroll
            for (int b = 0; b < 2; ++b)
#pragma unroll
                for (int m = 0; m < 4; ++m)
#pragma unroll
                    for (int n = 0; n < 2; ++n) acc[a][b][m][n] = (f32x4){0.f, 0.f, 0.f, 0.f};
        cur = nxt; cA = nA; cB = nB; ++ui;
        if constexpr (ALIGN_EPI) { if (wr == 1) PG8_BAR; }
    }
    PG8_WAIT_V(0);
    if constexpr (!ALIGN_EPI) { if (wr == 0) PG8_BAR; }
    PG8_BAR;
    if constexpr (Epi::AFTER_DRAIN) { E.fused(acc, cur, wr, wc, fr, fq, lds, wid, lane); S.done(cur); }
#undef PG8_SA
#undef PG8_SB
#undef PG8_STAGE
#undef PG8_LDA
#undef PG8_LDB
#undef PG8_MMA
#undef PG8_WAIT_V
#undef PG8_WAIT_L
#undef PG8_BAR
#undef PG8_SCHED
}
}
#include <hip/hip_bf16.h>
#include <cmath>
namespace attn_body {
using bf16=__hip_bfloat16;
using bf16x8=__attribute__((ext_vector_type(8)))short;
using s16x4=__attribute__((ext_vector_type(4)))short;
using f32x16=__attribute__((ext_vector_type(16)))float;
using u32x4=__attribute__((ext_vector_type(4)))unsigned;
constexpr int BATCH=8,NHEAD=8,SEQ=2048,D=64,PITCH=3584,OPITCH=1024,LEADROW=16384,VK=2176;
constexpr int NW=8,QBLK=32,QB=QBLK*NW,KVBLK=64,NQB=SEQ/QB;
constexpr int ATTN_UNIT_ROWS=QB;
__device__ __forceinline__ int crow(int r,int hi){return (r&3)+8*(r>>2)+4*hi;}
#define SBAR() __builtin_amdgcn_sched_barrier(0)
__device__ __forceinline__ void cmask(f32x16&p0,f32x16&p1,int jb,int qrel,int hi){
  const float NEG=-INFINITY; int kb=64*jb+4*hi;
  #pragma unroll
  for(int r=0;r<16;++r){int kv=kb+(r&3)+8*(r>>2); if(kv>qrel)p0[r]=NEG; if(kv+32>qrel)p1[r]=NEG;}
}

constexpr int NSLOT=3, SLOTB=8192;
constexpr int LDS_K=0, LDS_V=NSLOT*SLOTB, LDS_WS=2*NSLOT*SLOTB, LDS_OST=LDS_WS+NW*64*4, LDS_C2=LDS_OST+NW*4096, LDS_BYTES=LDS_C2+VK*4;
constexpr float C2=0.125f*1.4426950408889634f;
__device__ __forceinline__ void glds16(const void*gsrc,unsigned lds_dst){unsigned keep;
  asm volatile("s_mov_b32 %0, m0\n\ts_mov_b32 m0, %2\n\ts_nop 0\n\tglobal_load_lds_dwordx4 %1, off\n\ts_mov_b32 m0, %0":"=&s"(keep):"v"(gsrc),"s"(lds_dst):"memory");}
__device__ __forceinline__ float max3f(float a,float b,float c){float r;asm("v_max3_f32 %0, %1, %2, %3":"=v"(r):"v"(a),"v"(b),"v"(c));return r;}
__device__ __forceinline__ float max2f(float a,float b){float r;asm("v_max_f32_e32 %0, %1, %2":"=v"(r):"v"(a),"v"(b));return r;}
__device__ __forceinline__ float fadd_s(float a,float b){float r;asm("v_add_f32_e32 %0, %1, %2":"=v"(r):"v"(a),"v"(b));return r;}
__device__ __forceinline__ float fsub_s(float a,float b){float r;asm("v_sub_f32_e32 %0, %1, %2":"=v"(r):"v"(a),"v"(b));return r;}
typedef float f32x2_t __attribute__((ext_vector_type(2))); typedef __bf16 bf16x2_t __attribute__((ext_vector_type(2)));
__device__ __forceinline__ unsigned cvtpk_s(float lo,float hi){f32x2_t v={lo,hi};bf16x2_t b=__builtin_convertvector(v,bf16x2_t);return __builtin_bit_cast(unsigned,b);}
#define WAIT_BAR(N) asm volatile("s_waitcnt vmcnt(" #N ") lgkmcnt(0)\n\ts_barrier":::"memory")

__device__ __forceinline__ void qkt(f32x16&p0,f32x16&p1,const char*Kslot,const bf16x8*qr,int r32,int hi){
  const char*kb=Kslot+hi*1024+r32*16;
  #pragma unroll
  for(int d0=0;d0<4;++d0){
    const bf16x8 b0=*reinterpret_cast<const bf16x8*>(kb+d0*2048);
    const bf16x8 b1=*reinterpret_cast<const bf16x8*>(kb+d0*2048+512);
    p0=__builtin_amdgcn_mfma_f32_32x32x16_bf16(b0,qr[d0],p0,0,0,0);p1=__builtin_amdgcn_mfma_f32_32x32x16_bf16(b1,qr[d0],p1,0,0,0);}
}
typedef __attribute__((address_space(3))) const char* lds_cptr;
typedef short v4i16_t __attribute__((ext_vector_type(4)));
__device__ __forceinline__ void kload8(bf16x8*kf,lds_cptr kp){
  kf[0]=*(const __attribute__((address_space(3))) bf16x8*)(kp);      kf[1]=*(const __attribute__((address_space(3))) bf16x8*)(kp+512);
  kf[2]=*(const __attribute__((address_space(3))) bf16x8*)(kp+2048); kf[3]=*(const __attribute__((address_space(3))) bf16x8*)(kp+2560);
  kf[4]=*(const __attribute__((address_space(3))) bf16x8*)(kp+4096); kf[5]=*(const __attribute__((address_space(3))) bf16x8*)(kp+4608);
  kf[6]=*(const __attribute__((address_space(3))) bf16x8*)(kp+6144); kf[7]=*(const __attribute__((address_space(3))) bf16x8*)(kp+6656);
}
__device__ __forceinline__ void kload2(bf16x8*kf,lds_cptr kp,int j){ kf[2*j]=*(const __attribute__((address_space(3))) bf16x8*)(kp+j*2048); kf[2*j+1]=*(const __attribute__((address_space(3))) bf16x8*)(kp+j*2048+512); }
__device__ __forceinline__ s16x4 vtr(lds_cptr p){ return __builtin_bit_cast(s16x4,__builtin_amdgcn_ds_read_tr16_b64_v4i16((__attribute__((address_space(3))) v4i16_t*)p)); }
__device__ __forceinline__ float rowmax(const f32x16&p0,const f32x16&p1){
  float a=max3f(p0[0],p0[1],p1[0]),b=max3f(p0[2],p0[3],p1[1]);a=max3f(a,p1[2],p1[3]);
  #pragma unroll
  for(int r=4;r<16;r+=4){a=max3f(a,p0[r],p0[r+1]);b=max3f(b,p0[r+2],p0[r+3]);a=max3f(a,p1[r],p1[r+1]);b=max3f(b,p1[r+2],p1[r+3]);}
  const float m=max2f(a,b);
  auto rr=__builtin_amdgcn_permlane32_swap(__float_as_uint(m),__float_as_uint(m),false,false);
  return max2f(__uint_as_float(rr[0]),__uint_as_float(rr[1]));
}
__device__ __forceinline__ void pv(f32x16*o,int vb,bf16x8 pa0,bf16x8 pa1,bf16x8 pa2,bf16x8 pa3){
  #pragma unroll
  for(int d0=0;d0<2;++d0){s16x4 lo[4],hi[4];
    #pragma unroll
    for(int ks=0;ks<4;++ks){
      asm volatile("ds_read_b64_tr_b16 %0,%1 offset:%c2":"=&v"(lo[ks]):"v"(vb),"i"(d0*4096+ks*1024):"memory");
      asm volatile("ds_read_b64_tr_b16 %0,%1 offset:%c2":"=&v"(hi[ks]):"v"(vb),"i"(d0*4096+ks*1024+512):"memory");}
    asm volatile("s_waitcnt lgkmcnt(0)":::"memory");SBAR();
    #define PK(k) (bf16x8){lo[k][0],lo[k][1],lo[k][2],lo[k][3],hi[k][0],hi[k][1],hi[k][2],hi[k][3]}
    o[d0]=__builtin_amdgcn_mfma_f32_32x32x16_bf16(pa0,PK(0),o[d0],0,0,0);
    o[d0]=__builtin_amdgcn_mfma_f32_32x32x16_bf16(pa1,PK(1),o[d0],0,0,0);
    o[d0]=__builtin_amdgcn_mfma_f32_32x32x16_bf16(pa2,PK(2),o[d0],0,0,0);
    o[d0]=__builtin_amdgcn_mfma_f32_32x32x16_bf16(pa3,PK(3),o[d0],0,0,0);
    #undef PK
  }
}

#ifndef ATTN_STORE16
#define ATTN_STORE16(p,v) (*(u32x4*)(p)=(v))
#endif
template<int THRL> __device__ __forceinline__ void attn_unit(int b,int h,int qb,const bf16*Q,const bf16*__restrict__ K,const bf16*__restrict__ V,const bf16*__restrict__ OG,const float*__restrict__ c2v,bf16*O,char*shm,const int wave_s,const bool stage_c2=true){
  int tid_=wave_s*64+lane_id(); asm volatile("":"+v"(tid_));
  const int tid=tid_,lane=tid&63,r32=lane&31,hi=lane>>5; const int wid=wave_s;
  const long rowbase=(long)b*SEQ; const int q0=qb*QB;
  const bf16*Qw=Q+(rowbase+q0+wid*QBLK)*PITCH+h*D;
  const bf16*Kh=K+(rowbase-2*KVBLK)*PITCH+h*D,*Vh=V+(rowbase-2*KVBLK)*PITCH+h*D;
  const bf16*KhL=K+(long)LEADROW*PITCH+h*D,*VhL=V+(long)LEADROW*PITCH+h*D;
  const unsigned lds0=(unsigned)(uintptr_t)shm;
  float*wsf=(float*)(shm+LDS_WS)+wid*64;
  const bf16*ksrc=Kh+(long)lane*PITCH+wid*8,*ksrcL=KhL+(long)lane*PITCH+wid*8;
  const bf16*vsrc=Vh+(long)(16*(wid&3)+(lane>>2))*PITCH+(wid>>2)*32+(lane&3)*8,*vsrcL=VhL+(long)(16*(wid&3)+(lane>>2))*PITCH+(wid>>2)*32+(lane&3)*8;
  const unsigned kdst=lds0+LDS_K+wid*1024, vdst=lds0+LDS_V+wid*1024;
  #define DMA_K(t,slot) glds16(((t)<2?ksrcL:ksrc)+(long)(t)*KVBLK*PITCH,(unsigned)__builtin_amdgcn_readfirstlane(kdst+(slot)))
  #define DMA_V(t,slot) glds16(((t)<2?vsrcL:vsrc)+(long)(t)*KVBLK*PITCH,(unsigned)__builtin_amdgcn_readfirstlane(vdst+(slot)))
  const int vb0=(int)(lds0+LDS_V)+((lane>>4)&1)*32+(lane&3)*8+(4*hi+((lane&15)>>2))*64;
  const char*Kbase=shm+LDS_K; bf16x8 kf[8];
  const lds_cptr shm3=(lds_cptr)shm; const lds_cptr kp0=shm3+LDS_K+hi*1024+r32*16; const lds_cptr vp0=shm3+LDS_V+((lane>>4)&1)*32+(lane&3)*8+(4*hi+((lane&15)>>2))*64;
  const int NT=(q0+QB)/KVBLK+2;
  if(stage_c2){ __attribute__((address_space(3))) float*negc_w=(__attribute__((address_space(3))) float*)((lds_cptr)shm+LDS_C2); const float*cs=c2v+(long)(b*NHEAD+h)*VK;
    float cv_[5];
    _Pragma("unroll") for(int i_=0;i_<5;++i_){const int i=tid+i_*NW*64; cv_[i_]=i<NT*KVBLK?cs[i]:0.f;}
    _Pragma("unroll") for(int i_=0;i_<5;++i_){const int i=tid+i_*NW*64; if(i<NT*KVBLK)negc_w[i]=-cv_[i_];} }
  const __attribute__((address_space(3))) float* negc3=(const __attribute__((address_space(3))) float*)((lds_cptr)shm+LDS_C2)+4*hi;
  typedef float f32x4_t __attribute__((ext_vector_type(4)));
  #define NEGC(t,i) (*(const __attribute__((address_space(3))) f32x4_t*)(negc3+64*(t)+(((i)>>2)*32)+8*((i)&3)))
  DMA_K(0,0);DMA_V(0,0);DMA_K(1,SLOTB);
  bf16x8 qr[4];
  #pragma unroll
  for(int d0=0;d0<4;++d0)qr[d0]=*reinterpret_cast<const bf16x8*>(&Qw[(long)r32*PITCH+d0*16+hi*8]);
  float mhat=0.f,l_reg=0.f;f32x16 o[2];o[0]=f32x16{};o[1]=f32x16{};
  const int qrel=wid*QBLK+r32;
  #define CMASK(P0,P1,t) do{int jb_=(t)-(NT-4); if(jb_>=0)cmask(P0,P1,jb_,qrel,hi);}while(0)
  bool resc=false;
  #define START(P0,P1) do{ const float rm=rowmax(P0,P1); resc=false; \
    { const float dl=rm; mhat=fadd_s(mhat,dl); \
      _Pragma("unroll") for(int r=0;r<16;++r){P0[r]=fsub_s(P0[r],dl);P1[r]=fsub_s(P1[r],dl);} } \
    _Pragma("unroll") for(int r=0;r<16;++r)P0[r]=__builtin_amdgcn_exp2f(P0[r]); }while(0)
  #define RESC() do{ if(resc){ asm volatile("s_waitcnt lgkmcnt(0)":::"memory"); \
      _Pragma("unroll") for(int d_=0;d_<2;++d_) _Pragma("unroll") for(int r=0;r<16;++r)o[d_][r]*=wsf[crow(r,hi)]; } }while(0)
  f32x16 pA0,pA1,pB0,pB1;
  int sl_prev=0,sl_cur=0,sl_next=SLOTB;
  #define ROT() do{sl_prev=sl_cur;sl_cur=sl_next;sl_next=(sl_next==(NSLOT-1)*SLOTB)?0:sl_next+SLOTB;}while(0)
  DMA_K(2,2*SLOTB);
  WAIT_BAR(3);
  #define FILLT(P0,P1,t) do{ _Pragma("unroll") for(int i_=0;i_<4;++i_){ const f32x4_t a_=NEGC(t,i_),b_=NEGC(t,4+i_); \
      P0[4*i_]=a_[0]-mhat;P0[4*i_+1]=a_[1]-mhat;P0[4*i_+2]=a_[2]-mhat;P0[4*i_+3]=a_[3]-mhat; P1[4*i_]=b_[0]-mhat;P1[4*i_+1]=b_[1]-mhat;P1[4*i_+2]=b_[2]-mhat;P1[4*i_+3]=b_[3]-mhat; } }while(0)
  FILLT(pA0,pA1,0);
  qkt(pA0,pA1,Kbase,qr,r32,hi);asm volatile("s_nop 15\n\ts_nop 7":"+v"(pA0),"+v"(pA1));CMASK(pA0,pA1,0);
  START(pA0,pA1);
  FILLT(pB0,pB1,1);
  _Pragma("unroll") for(int r=0;r<16;++r)pA1[r]=__builtin_amdgcn_exp2f(pA1[r]);
  WAIT_BAR(0);
  DMA_K(3,0);DMA_V(1,SLOTB);
  ROT();
  kload8(kf,kp0+sl_cur);
  WAIT_BAR(2);
  s16x4 vlo[8],vhi[8]; u32x4 pw0,pw1,pw2,pw3;
  #define PKW(P,B) cvtpk_s(P[B],P[B+1])
  #define PAF(k) __builtin_bit_cast(bf16x8,pw##k)
  #define VFR(i) (bf16x8){vlo[i][0],vlo[i][1],vlo[i][2],vlo[i][3],vhi[i][0],vhi[i][1],vhi[i][2],vhi[i][3]}
  #define PIN(x) asm volatile("":"+v"(x))
  #define MX3(a,b,c) __builtin_fmaxf(__builtin_fmaxf((a),(b)),(c))
  #define GAPA(MF,A0,A1,A2,A3,W0,W1,PW) do{ MF; sacc+=A0; sacc+=A1; sacc+=A2; sacc+=A3; PIN(sacc); W0; W1; PIN(PW); SBAR(); }while(0)
  #define EX(v) __builtin_amdgcn_exp2f(v)
  #define GAPB(MF,X,B,FP,FB,I,t,GF) do{ MF; X[B]=EX(X[B]); X[B+1]=EX(X[B+1]); X[B+2]=EX(X[B+2]); X[B+3]=EX(X[B+3]); \
      if(GF){ FP[FB]=fsub_s(cn_[0],mhat); FP[FB+1]=fsub_s(cn_[1],mhat); FP[FB+2]=fsub_s(cn_[2],mhat); FP[FB+3]=fsub_s(cn_[3],mhat); PIN(FP); if((I)<7){cn_=NEGC((t)+1,(I)+1);} } \
      PIN(X); SBAR(); }while(0)
  #define VRD(i) do{ vlo[i]=vtr(vp_+(((i)>>2)*4096+((i)&3)*1024)); vhi[i]=vtr(vp_+(((i)>>2)*4096+((i)&3)*1024+512)); }while(0)
  #define KRD(G,j) do{ if(G){ kload2(kf,kp0+sl_next,j); SBAR(); } }while(0)
  #define STEP(C0,C1,P0,P1,t,GK,GV,GL) do{ SBAR(); \
    const lds_cptr vp_=vp0+sl_prev; \
    VRD(0); SBAR(); float sacc=(P0[0]+P0[1]); \
    GAPA(C0=__builtin_amdgcn_mfma_f32_32x32x16_bf16(kf[0],qr[0],C0,0,0,0), P0[2],P0[3],P0[4],P0[5],     pw0[0]=PKW(P0,0), pw0[1]=PKW(P0,2), pw0); \
    VRD(4); SBAR(); GAPA(C1=__builtin_amdgcn_mfma_f32_32x32x16_bf16(kf[1],qr[0],C1,0,0,0), P0[6],P0[7],P0[8],P0[9],     pw0[2]=PKW(P0,4), pw0[3]=PKW(P0,6), pw0); \
    VRD(1); SBAR(); GAPA(C0=__builtin_amdgcn_mfma_f32_32x32x16_bf16(kf[2],qr[1],C0,0,0,0),   P0[10],P0[11],P0[12],P0[13], pw1[0]=PKW(P0,8), pw1[1]=PKW(P0,10), pw1); \
    VRD(5); SBAR(); GAPA(C1=__builtin_amdgcn_mfma_f32_32x32x16_bf16(kf[3],qr[1],C1,0,0,0),   P0[14],P0[15],P1[0],P1[1],   pw1[2]=PKW(P0,12),pw1[3]=PKW(P0,14), pw1); \
    VRD(2); SBAR(); GAPA(C0=__builtin_amdgcn_mfma_f32_32x32x16_bf16(kf[4],qr[2],C0,0,0,0),   P1[2],P1[3],P1[4],P1[5],     pw2[0]=PKW(P1,0), pw2[1]=PKW(P1,2), pw2); \
    VRD(6); SBAR(); GAPA(C1=__builtin_amdgcn_mfma_f32_32x32x16_bf16(kf[5],qr[2],C1,0,0,0),   P1[6],P1[7],P1[8],P1[9],     pw2[2]=PKW(P1,4), pw2[3]=PKW(P1,6), pw2); \
    VRD(3); SBAR(); GAPA(C0=__builtin_amdgcn_mfma_f32_32x32x16_bf16(kf[6],qr[3],C0,0,0,0),   P1[10],P1[11],P1[12],P1[13], pw3[0]=PKW(P1,8), pw3[1]=PKW(P1,10), pw3); \
    VRD(7); SBAR(); GAPA(C1=__builtin_amdgcn_mfma_f32_32x32x16_bf16(kf[7],qr[3],C1,0,0,0),   P1[14],P1[15],0.f,0.f,       pw3[2]=PKW(P1,12),pw3[3]=PKW(P1,14), pw3); \
    l_reg+=sacc; \
    if(GK){DMA_K((t)+3,sl_cur);} if(GV){DMA_V((t)+1,sl_next);} \
    CMASK(C0,C1,t); \
    { float a=MX3(C0[0],C0[1],C1[0]),b=MX3(C0[2],C0[3],C1[1]); a=MX3(a,C1[2],C1[3]); \
      _Pragma("unroll") for(int r=4;r<16;r+=4){a=MX3(a,C0[r],C0[r+1]);b=MX3(b,C0[r+2],C0[r+3]);a=MX3(a,C1[r],C1[r+1]);b=MX3(b,C1[r+2],C1[r+3]);} \
      float rm=__builtin_fmaxf(a,b); { auto rr=__builtin_amdgcn_permlane32_swap(__float_as_uint(rm),__float_as_uint(rm),false,false); rm=__builtin_fmaxf(__uint_as_float(rr[0]),__uint_as_float(rr[1])); } \
      resc=false; \
      if(__builtin_expect(__any(rm>(float)THRL),0)){ const float dl=__builtin_fmaxf(rm,0.f); mhat+=dl; \
        _Pragma("unroll") for(int r=0;r<16;++r){C0[r]-=dl;C1[r]-=dl;} \
        const float f=__builtin_amdgcn_exp2f(-dl); l_reg*=f; if(hi==0)wsf[r32]=f; resc=true; } } \
    f32x4_t cn_=(f32x4_t){0.f,0.f,0.f,0.f}; if(GL){cn_=NEGC((t)+1,0);} \
    SBAR(); \
    GAPB(o[0]=__builtin_amdgcn_mfma_f32_32x32x16_bf16(PAF(0),VFR(0),o[0],0,0,0), C0,0,P0,0,0,t,GL); \
    GAPB(o[1]=__builtin_amdgcn_mfma_f32_32x32x16_bf16(PAF(0),VFR(4),o[1],0,0,0), C0,4,P0,4,1,t,GL); \
    KRD(GL,0); GAPB(o[0]=__builtin_amdgcn_mfma_f32_32x32x16_bf16(PAF(1),VFR(1),o[0],0,0,0), C0,8,P0,8,2,t,GL); \
    KRD(GL,1); GAPB(o[1]=__builtin_amdgcn_mfma_f32_32x32x16_bf16(PAF(1),VFR(5),o[1],0,0,0), C0,12,P0,12,3,t,GL); \
    KRD(GL,2); GAPB(o[0]=__builtin_amdgcn_mfma_f32_32x32x16_bf16(PAF(2),VFR(2),o[0],0,0,0), C1,0,P1,0,4,t,GL); \
    KRD(GL,3); GAPB(o[1]=__builtin_amdgcn_mfma_f32_32x32x16_bf16(PAF(2),VFR(6),o[1],0,0,0), C1,4,P1,4,5,t,GL); \
    GAPB(o[0]=__builtin_amdgcn_mfma_f32_32x32x16_bf16(PAF(3),VFR(3),o[0],0,0,0), C1,8,P1,8,6,t,GL); \
    GAPB(o[1]=__builtin_amdgcn_mfma_f32_32x32x16_bf16(PAF(3),VFR(7),o[1],0,0,0), C1,12,P1,12,7,t,GL); \
    }while(0)
  int t=1;
  #undef CMASK
  #define CMASK(P0,P1,t) do{}while(0)
  for(;t+5<NT;t+=2){
    STEP(pB0,pB1,pA0,pA1,t,true,true,true);     WAIT_BAR(2); RESC(); ROT();
    STEP(pA0,pA1,pB0,pB1,t+1,true,true,true);   WAIT_BAR(2); RESC(); ROT();
  }
  #undef CMASK
  #define CMASK(P0,P1,t) do{int jb_=(t)-(NT-4); if(jb_>=0)cmask(P0,P1,jb_,qrel,hi);}while(0)
  #define ENDW(tt) do{ if((tt)+3<NT){WAIT_BAR(2);} else if((tt)+2<NT){WAIT_BAR(1);} else {WAIT_BAR(0);} }while(0)
  for(;t+1<NT;t+=2){
    STEP(pB0,pB1,pA0,pA1,t,(t+3<NT),(t+1<NT),(t+1<NT));       ENDW(t);   RESC(); ROT();
    STEP(pA0,pA1,pB0,pB1,t+1,(t+4<NT),(t+2<NT),(t+2<NT));     ENDW(t+1); RESC(); ROT();
  }
  STEP(pB0,pB1,pA0,pA1,NT-1,false,false,false); RESC();
  { float sacc=pB0[0]+pB0[1]; _Pragma("unroll") for(int r=2;r<16;++r)sacc+=pB0[r]; _Pragma("unroll") for(int r=0;r<16;++r)sacc+=pB1[r]; l_reg+=sacc;
    pw0=(u32x4){PKW(pB0,0),PKW(pB0,2),PKW(pB0,4),PKW(pB0,6)};pw1=(u32x4){PKW(pB0,8),PKW(pB0,10),PKW(pB0,12),PKW(pB0,14)};pw2=(u32x4){PKW(pB1,0),PKW(pB1,2),PKW(pB1,4),PKW(pB1,6)};pw3=(u32x4){PKW(pB1,8),PKW(pB1,10),PKW(pB1,12),PKW(pB1,14)};
    SBAR(); pv(o,vb0+sl_cur,PAF(0),PAF(1),PAF(2),PAF(3)); }
  #undef PKW
  #undef PAF
  #undef VFR
  #undef PIN
  #undef MX3
  #undef GAPA
  #undef GAPB
  #undef EX
  #undef VRD
  #undef KRD
  #undef STEP
  #undef ENDW
  {auto rr=__builtin_amdgcn_permlane32_swap(__float_as_uint(l_reg),__float_as_uint(l_reg),false,false);l_reg=__uint_as_float(rr[0])+__uint_as_float(rr[1]);}
  if(hi==0)wsf[32+r32]=l_reg;asm volatile("s_waitcnt lgkmcnt(0)":::"memory");
  float rli[16];
  #pragma unroll
  for(int r=0;r<16;++r)rli[r]=__builtin_amdgcn_rcpf(wsf[32+crow(r,hi)]);
  bf16*Ow=O+(rowbase+q0+wid*QBLK)*OPITCH+h*D; const bf16*Gw=OG+(rowbase+q0+wid*QBLK)*PITCH+h*D;
  u32x4 gg[4];
  #pragma unroll
  for(int i=0;i<4;++i){const int row=i*8+(lane>>3),ch=lane&7; gg[i]=*(const u32x4*)(Gw+(long)row*PITCH+ch*8);}
  { bf16*stg=(bf16*)(shm+LDS_OST)+wid*2048;
    #pragma unroll
    for(int r=0;r<16;++r){const int orow=crow(r,hi);
      #pragma unroll
      for(int d0=0;d0<2;++d0)stg[orow*64+d0*32+r32]=__float2bfloat16(o[d0][r]*rli[r]);}
    asm volatile("s_waitcnt lgkmcnt(0)":::"memory");
    #pragma unroll
    for(int i=0;i<4;++i){const int row=i*8+(lane>>3),ch=lane&7; u32x4 v=*(const u32x4*)(stg+row*64+ch*8);
      #pragma unroll
      for(int w=0;w<4;++w){ const float o0=__uint_as_float(v[w]<<16),o1=__uint_as_float(v[w]&0xffff0000u),g0=__uint_as_float(gg[i][w]<<16),g1=__uint_as_float(gg[i][w]&0xffff0000u);
        v[w]=cvtpk_s(o0*__builtin_amdgcn_rcpf(1.f+__builtin_amdgcn_exp2f(-1.4426950408889634f*g0)),o1*__builtin_amdgcn_rcpf(1.f+__builtin_amdgcn_exp2f(-1.4426950408889634f*g1))); }
      ATTN_STORE16(Ow+(long)row*OPITCH+ch*8,v);} }
  asm volatile("s_waitcnt lgkmcnt(0)\n\ts_barrier":::"memory");
  #undef DMA_K
  #undef NEGC
  #undef FILLT
  #undef DMA_V
  #undef CMASK
  #undef START
  #undef RESC
  #undef ROT
}
constexpr int ATTN_LDS_BYTES=LDS_BYTES;
struct AttnTensors { const bf16* Q; const bf16* K; const bf16* V; const bf16* OG; const float* c2v; bf16* O; };
struct AttnUnit { int bh; int qb; };
struct StaticOrder {
  int vcu, G, blk;
  __device__ __forceinline__ explicit StaticOrder(int grid,int block):vcu((grid%8==0)?(block%8)*(grid/8)+block/8:block),G(grid),blk(block){}
  __device__ __forceinline__ bool next(int i,AttnUnit&u)const{
    if(G==256){ if(blk<64){ if(i>=1)return false; u.bh=blk; u.qb=0; return true; } const int j=blk-64,g=j>>6; u.bh=j&63;
      if(g==0){ if(i>=2)return false; u.qb=i?3:7; } else if(g==1){ if(i>=2)return false; u.qb=i?4:6; } else { if(i>=3)return false; u.qb=i==0?5:3-i; }
      return true; }
    const int pair=vcu+(i>>1)*G; if(pair>=BATCH*NHEAD*4)return false; const int s=pair&3; u.bh=pair>>2; u.qb=(i&1)?s:7-s; return true; }
  __device__ __forceinline__ void a_ready(const AttnUnit&)const{}
  __device__ __forceinline__ void done(const AttnUnit&)const{}
};
template<class Sched,int THRL=8> __device__ __forceinline__ void attn_phase(char*lds,const AttnTensors&T,const Sched&S,const int wave_s){
  AttnUnit u;
  int pbh=-1,pqb=-1;
  for(int i=0;S.next(i,u);++i){ S.a_ready(u); attn_unit<THRL>(u.bh/NHEAD,u.bh%NHEAD,u.qb,T.Q,T.K,T.V,T.OG,T.c2v,T.O,lds,wave_s,!(u.bh==pbh&&u.qb<=pqb)); if(u.bh!=pbh||u.qb>pqb){pbh=u.bh;pqb=u.qb;} S.done(u); }
}
#undef SBAR
#undef WAIT_BAR
}
#define GAS __attribute__((address_space(1)))
#define LAS __attribute__((address_space(3)))
typedef unsigned short bf16;
typedef unsigned v4u __attribute__((ext_vector_type(4)));
typedef float f32x4 __attribute__((ext_vector_type(4)));
typedef short bf16x8 __attribute__((ext_vector_type(8)));
typedef GAS unsigned gu32;
typedef GAS unsigned long long gu64;
#define RLX_AGENT __ATOMIC_RELAXED, __HIP_MEMORY_SCOPE_AGENT
#define LDS_WAIT() asm volatile("s_waitcnt lgkmcnt(0)" ::: "memory")
#define VM_WAIT() asm volatile("s_waitcnt vmcnt(0)" ::: "memory")
#define XB_TMO      128
#define XB_XCNT(j)  (256  + 64 * (j))
#define XB_XSUB(j)  (1280 + 64 * (j))
#define XB_XGEN(j)  (2304 + 64 * (j))
#define XB_TOP      3328
#define XB_TOPGEN   3392
#define XCD_BAR_WORDS 3456
#define XB_SPIN_CAP (1u << 18)

__device__ __forceinline__ unsigned xb_ld(unsigned* p)              { return __hip_atomic_load(p, __ATOMIC_RELAXED, __HIP_MEMORY_SCOPE_AGENT); }
__device__ __forceinline__ unsigned xb_add(unsigned* p, unsigned v) { return __hip_atomic_fetch_add(p, v, __ATOMIC_RELAXED, __HIP_MEMORY_SCOPE_AGENT); }
__device__ __forceinline__ unsigned xb_xcc_id() { return (unsigned)__builtin_amdgcn_s_getreg((3 << 11) | 20) & 0xFu; }
#define XB_SPIN(cond, bar) do { unsigned _sp = 0; while (cond) { __builtin_amdgcn_s_sleep(1); \
    if ((++_sp & 255u) == 0u) { if (xb_ld(&(bar)[XB_TMO])) break; if (_sp > XB_SPIN_CAP) { atomicAdd(&(bar)[XB_TMO], 1u); break; } } } } while (0)

struct XcdBarrier {
    unsigned* bar; unsigned x;
    volatile LAS unsigned* st;
};

__device__ __forceinline__ XcdBarrier xcd_barrier_post(unsigned* bar, volatile LAS unsigned* st) {
    XcdBarrier b; b.bar = bar; b.x = xb_xcc_id(); b.st = st;
    if (threadIdx.x == 0) (void)xb_add(&bar[XB_XCNT(b.x)], 1u);
    return b;
}
__device__ __forceinline__ void xcd_barrier_complete(unsigned* bar, unsigned x, unsigned& nloc, unsigned& nx) {
    const unsigned G = gridDim.x * gridDim.y * gridDim.z;
    unsigned sum, cnt, mine, sp = 0u;
    for (;;) {
        sum = 0u; cnt = 0u; mine = 0u;
#pragma unroll
        for (unsigned j = 0; j < 16; ++j) { const unsigned c = xb_ld(&bar[XB_XCNT(j)]); sum += c; cnt += (c > 0u) ? 1u : 0u; mine = (j == x) ? c : mine; }
        if (sum == G) break;
        __builtin_amdgcn_s_sleep(1);
        if ((++sp & 255u) == 0u) { if (xb_ld(&bar[XB_TMO])) break; if (sp > XB_SPIN_CAP) { atomicAdd(&bar[XB_TMO], 1u); break; } }
    }
    nloc = mine > 0u ? mine : 1u; nx = cnt > 0u ? cnt : 1u;
}

__device__ __forceinline__ void xcd_barrier(const XcdBarrier& b, const int wave_s) {
    asm volatile("s_waitcnt vmcnt(0)" ::: "memory");
    __syncthreads();
    if (wave_s == 0 && lane_id() == 0) {
        int z0_ = 0; asm volatile("" : "+s"(z0_));
        unsigned* bar = b.bar + z0_;
        __builtin_amdgcn_s_waitcnt(0);
        unsigned nloc = b.st[0], nx = b.st[1];
        if (nloc == 0u) { xcd_barrier_complete(bar, b.x, nloc, nx); b.st[0] = nloc; b.st[1] = nx; }
        const unsigned old = xb_add(&bar[XB_XSUB(b.x)], 1u);
        const unsigned gen = old / nloc;
        if (old + 1u == (gen + 1u) * nloc) {
            __builtin_amdgcn_fence(__ATOMIC_RELEASE, "agent");
            asm volatile("s_waitcnt vmcnt(0)" ::: "memory");
            const unsigned og = xb_add(&bar[XB_TOP], 1u);
            const unsigned tg = og / nx;
            if (og + 1u == (tg + 1u) * nx) xb_add(&bar[XB_TOPGEN], 1u);
            else XB_SPIN(xb_ld(&bar[XB_TOPGEN]) == tg, bar);
            __builtin_amdgcn_fence(__ATOMIC_ACQUIRE, "agent");
            xb_add(&bar[XB_XGEN(b.x)], 1u);
            asm volatile("s_waitcnt vmcnt(0)" ::: "memory");
        } else {
            XB_SPIN(xb_ld(&bar[XB_XGEN(b.x)]) == gen, bar);
            __builtin_amdgcn_fence(__ATOMIC_ACQUIRE, "agent");
            asm volatile("s_waitcnt vmcnt(0)" ::: "memory");
        }
    }
    __syncthreads();
}

constexpr int NWAVES = 8;
constexpr int RING_BYTES = 131072;
constexpr int LDS_BYTES = 163840;
constexpr int LDSCTL_OFF = LDS_BYTES - 1024, MISC_OFF = LDSCTL_OFF + 320;
constexpr int HALO_OFF = RING_BYTES;
constexpr int RSTD_OFF = HALO_OFF + 8192;
static_assert(RSTD_OFF + 6 * 1024 + 4096 <= LDSCTL_OFF, "LDS map");
constexpr int CW_BAR = 4096;

struct Args { const float* in[24]; float* out; unsigned char* ws; };

template <bool AF32, class F>
__device__ __forceinline__ void meta_gemm(const void* A, int lda, const bf16_t* Wt, int N, int K, int bid, int G, int wave, int lane, float* red, const F& f) {
    const int fr = lane & 15, fq = lane >> 4, kw = K / NWAVES;
    for (int cb = bid; cb < N / 16; cb += G) {
        f32x4 acc = (f32x4){0.f, 0.f, 0.f, 0.f}; float ss = 0.f;
        const bf16_t* bp = Wt + (size_t)(cb * 16 + fr) * K + wave * kw + 8 * fq;
#pragma unroll
        for (int k = 0; k < kw; k += 32) {
            bf16x8 a;
            if (AF32) {
                const float* ap = (const float*)A + (size_t)fr * lda + wave * kw + k + 8 * fq;
                const f32x4 a0 = *(const f32x4*)ap, a1 = *(const f32x4*)(ap + 4);
                ss += ((a0.x * a0.x + a0.y * a0.y) + (a0.z * a0.z + a0.w * a0.w)) + ((a1.x * a1.x + a1.y * a1.y) + (a1.z * a1.z + a1.w * a1.w));
                u32x4 w; w.x = pk2bf(a0.x, a0.y); w.y = pk2bf(a0.z, a0.w); w.z = pk2bf(a1.x, a1.y); w.w = pk2bf(a1.z, a1.w);
                a = __builtin_bit_cast(bf16x8, w);
            } else a = *(const bf16x8*)((const bf16_t*)A + (size_t)fr * lda + wave * kw + k + 8 * fq);
            const bf16x8 b = *(const bf16x8*)(bp + k);
            acc = __builtin_amdgcn_mfma_f32_16x16x32_bf16(a, b, acc, 0, 0, 0);
        }
        float* rw = red + (wave * 64 + lane) * 5;
        rw[0] = acc[0]; rw[1] = acc[1]; rw[2] = acc[2]; rw[3] = acc[3]; rw[4] = ss;
        __syncthreads();
        if (wave == 0) {
            f32x4 t = (f32x4){0.f, 0.f, 0.f, 0.f}; float s2 = 0.f;
#pragma unroll
            for (int w = 0; w < NWAVES; ++w) { const float* r_ = red + (w * 64 + lane) * 5; t[0] += r_[0]; t[1] += r_[1]; t[2] += r_[2]; t[3] += r_[3]; s2 += r_[4]; }
            float rstd = 1.f;
            if (AF32) { s2 = add_xor16(s2); s2 = add_xor32(s2); rstd = 1.0f / sqrtf(s2 * (1.f / DM) + 1e-6f); }
#pragma unroll
            for (int r = 0; r < 4; ++r) { const int row = 4 * fq + r; const float rs = AF32 ? __int_as_float(__builtin_amdgcn_ds_bpermute(row << 2, __float_as_int(rstd))) : 1.f; f(row, cb * 16 + fr, t[r] * rs); }
        }
        __syncthreads();
    }
}
struct MEpi1 { bf16_t* p; float* pn;
    __device__ __forceinline__ void operator()(int r, int col, float v) const {
        const int row = MROWS + r; const int g = col >> 9, c_ = col & 255;
        if (g < 7) p[(size_t)row * PBW + (col & ~255) + ((c_ >> 5) & 3) * 64 + (c_ >> 7) * 32 + PERM32(c_ & 31)] = f2bf(v);
        else { const int o = col & 511; if (o < 296) pn[(size_t)row * PNW + o] = v; } } };
struct MEpiRes { float* hm; __device__ __forceinline__ void operator()(int r, int col, float v) const { float* h = hm + r * DM + (col & ~31) + PERM32(col & 31); *h = *h + v; } };
struct MEpi3 { float* rawm;
    __device__ __forceinline__ void operator()(int r, int col, float v) const { const int t = col >> 8, c = col & 255; rawm[(size_t)r * DFF2 + (c < 128 ? 128 * t + c : DFF + 128 * t + (c - 128))] = v; } };

__device__ __forceinline__ void meta_gemm3(const float* hm, const bf16_t* W3, int bid, int G, int wave, int lane, int tid, float* red, float* rug, const float* cw, const float* cb, float* rawm, bf16_t* am) {
    const int fr = lane & 15, fq = lane >> 4; constexpr int kw = DM / NWAVES;
    for (int pr = bid; pr < DFF / 16; pr += G) {
        const int t = pr >> 3, kk = pr & 7, cbu = 16 * t + kk;
        f32x4 au = (f32x4){0.f, 0.f, 0.f, 0.f}, ag = au; float ss = 0.f;
        const bf16_t* bpu = W3 + (size_t)(cbu * 16 + fr) * DM + wave * kw + 8 * fq; const bf16_t* bpg = bpu + (size_t)128 * DM;
#pragma unroll
        for (int k = 0; k < kw; k += 32) {
            const float* ap = hm + (size_t)fr * DM + wave * kw + k + 8 * fq;
            const f32x4 a0 = *(const f32x4*)ap, a1 = *(const f32x4*)(ap + 4);
            ss += ((a0.x * a0.x + a0.y * a0.y) + (a0.z * a0.z + a0.w * a0.w)) + ((a1.x * a1.x + a1.y * a1.y) + (a1.z * a1.z + a1.w * a1.w));
            u32x4 w; w.x = pk2bf(a0.x, a0.y); w.y = pk2bf(a0.z, a0.w); w.z = pk2bf(a1.x, a1.y); w.w = pk2bf(a1.z, a1.w);
            const bf16x8 a = __builtin_bit_cast(bf16x8, w);
            au = __builtin_amdgcn_mfma_f32_16x16x32_bf16(a, *(const bf16x8*)(bpu + k), au, 0, 0, 0);
            ag = __builtin_amdgcn_mfma_f32_16x16x32_bf16(a, *(const bf16x8*)(bpg + k), ag, 0, 0, 0);
        }
        float* rw = red + (wave * 64 + lane) * 9;
        rw[0] = au[0]; rw[1] = au[1]; rw[2] = au[2]; rw[3] = au[3]; rw[4] = ag[0]; rw[5] = ag[1]; rw[6] = ag[2]; rw[7] = ag[3]; rw[8] = ss;
        __syncthreads();
        if (wave == 0) {
            f32x4 tu = (f32x4){0.f, 0.f, 0.f, 0.f}, tg = tu; float s2 = 0.f;
#pragma unroll
            for (int w = 0; w < NWAVES; ++w) { const float* r_ = red + (w * 64 + lane) * 9; tu[0] += r_[0]; tu[1] += r_[1]; tu[2] += r_[2]; tu[3] += r_[3]; tg[0] += r_[4]; tg[1] += r_[5]; tg[2] += r_[6]; tg[3] += r_[7]; s2 += r_[8]; }
            s2 = add_xor16(s2); s2 = add_xor32(s2); const float rstd = 1.0f / sqrtf(s2 * (1.f / DM) + 1e-6f);
#pragma unroll
            for (int r = 0; r < 4; ++r) { const int row = 4 * fq + r; const float rs = __int_as_float(__builtin_amdgcn_ds_bpermute(row << 2, __float_as_int(rstd)));
                const float vu = tu[r] * rs, vg = tg[r] * rs; rug[row * 16 + fr] = vu; rug[256 + row * 16 + fr] = vg;
                if (row >= 14) { rawm[(size_t)row * DFF2 + 128 * t + 16 * kk + fr] = vu; rawm[(size_t)row * DFF2 + DFF + 128 * t + 16 * kk + fr] = vg; } }
        }
        __syncthreads();
        if (tid < 256) {
            const int row = tid >> 4, j = tid & 15, ch = 128 * t + 16 * kk + j;
            const float xu0 = rug[row * 16 + j], xu1 = row >= 1 ? rug[(row - 1) * 16 + j] : 0.f, xu2 = row >= 2 ? rug[(row - 2) * 16 + j] : 0.f;
            const float xg0 = rug[256 + row * 16 + j], xg1 = row >= 1 ? rug[256 + (row - 1) * 16 + j] : 0.f, xg2 = row >= 2 ? rug[256 + (row - 2) * 16 + j] : 0.f;
            const float cu = cb[ch] + cw[ch] * xu2 + cw[DFF2 + ch] * xu1 + cw[2 * DFF2 + ch] * xu0;
            const float cg = cb[DFF + ch] + cw[DFF + ch] * xg2 + cw[DFF2 + DFF + ch] * xg1 + cw[2 * DFF2 + DFF + ch] * xg0;
            am[(size_t)row * DFF + ch] = f2bf(cg * sigmoidf_(cg) * cu);
        }
        __syncthreads();
    }
}

__device__ __forceinline__ void wprep_layer(const float* const* in, int l, unsigned char* ws, int gw, int ngw, int lane, float* scr, int part) {
    unsigned char* wb = ws + WS_W + (size_t)(l & 1) * WL_BYTES;
    constexpr int I1 = (DM / 64) * (N1 / 32), I2 = (DM / 64) * (DM / 32), I3 = (DM / 64) * (DFF2 / 32), I4 = (DFF / 64) * (DM / 32);
    const int n1 = (part & 1) ? I1 : 0, n2 = (part & 2) ? I2 : 0, n3 = (part & 4) ? I3 : 0, n4 = (part & 8) ? I4 : 0;
    for (int it = gw; it < n1 + n2 + n3 + n4; it += ngw) {
        int r = it, mode = 1, K = DM, Nsrc = N_IN, Ndst = N1; const float* W = in[3] + (size_t)l * DM * N_IN; const float* gk = in[2] + l * DM; bf16_t* WT = (bf16_t*)(wb + WO_W1);
        if (r >= n1) { r -= n1; mode = 2; Nsrc = DM; Ndst = DM; W = in[18] + (size_t)l * DM * DM; gk = nullptr; WT = (bf16_t*)(wb + WO_W2);
            if (r >= n2) { r -= n2; mode = 3; Nsrc = DFF2; Ndst = DFF2; W = in[20] + (size_t)l * DM * DFF2; gk = in[19] + l * DM; WT = (bf16_t*)(wb + WO_W3);
                if (r >= n3) { r -= n3; mode = 4; K = DFF; Nsrc = DM; Ndst = DM; W = in[23] + (size_t)l * DFF * DM; gk = nullptr; WT = (bf16_t*)(wb + WO_W4); } } }
        wprep_item(W, gk, WT, K, Nsrc, Ndst, mode, r, scr, lane);
    }
    if (part & 1) {
        bf16_t* lup = (bf16_t*)(wb + WO_LUP);
        const float* wu = in[6] + (size_t)l * 64 * 512; const float* au = in[8] + (size_t)l * 64 * 512; const float* gu = in[9] + (size_t)l * 160 * 512;
        for (int n = gw; n < 512; n += ngw) {
#pragma unroll
            for (int kq = 0; kq < 5; ++kq) { const int k = lane + 64 * kq;
                if (k < 288) lup[n * 288 + k] = f2bf(k < 64 ? wu[k * 512 + n] : (k < 128 ? au[(k - 64) * 512 + n] : gu[(k - 128) * 512 + n])); }
        }
    }
}

struct RwP { const float* mu; const float* w0; const float* w_up; const float* a0; const float* a_up; const float* g_up; };
struct RwS { const float* mu; const float* k_k; const float* k_a; const float* r_k; const float* gn_w; const float* gn_b; };
constexpr int RCH = 8;

__global__ void __launch_bounds__(NWAVES * 64, 2) mk_fwd(Args a) {
    extern __shared__ __attribute__((aligned(16))) unsigned char lds[];
    const int tid0 = threadIdx.x, wave_s = __builtin_amdgcn_readfirstlane(tid0 >> 6);
    const int G0 = gridDim.x, bid0 = blockIdx.x;
    for (int u = tid0; u < (LDS_BYTES - LDSCTL_OFF) / 4; u += NWAVES * 64) ((LAS unsigned*)((LAS unsigned char*)lds + LDSCTL_OFF))[u] = 0u;
    __syncthreads();
    XcdBarrier bar = xcd_barrier_post((unsigned*)(a.ws + WS_CTL) + CW_BAR, (volatile LAS unsigned*)((LAS unsigned char*)lds + MISC_OFF) + 8);
#ifdef TPROBE
#define TP_MARK(ph) do { if ((ph) >= 20 && TPROBE < 20) break;     \
        const unsigned t_ = (unsigned)__builtin_amdgcn_s_memrealtime(); if (wave_s == 0 && lane_id() == 0) { volatile LAS unsigned* q_ = (volatile LAS unsigned*)((LAS unsigned char*)lds + LDSCTL_OFF + 512); \
        if ((ph) == TPROBE) q_[1] += t_ - q_[0]; q_[0] = t_; } } while (0)
#else
#define TP_MARK(ph) do {} while (0)
#endif
#define GRID_BAR() do { int wv_ = wave_s; asm volatile("" : "+s"(wv_)); xcd_barrier(bar, wv_); } while (0)
#define RSTD_TABLE(S) do { pg8::Unit u_; for (int i_ = 0; S.next(i_, u_); ++i_) for (int r_ = tid; r_ < 256; r_ += NWAVES * 64) \
        ((LAS float*)(ldsl + RSTD_OFF))[i_ * 256 + r_] = pg8::row_rstd(ssqp, u_.pm * 256 + r_); __syncthreads(); } while (0)
    TP_MARK(-1);
#define PHASE_IDS() int G_ = G0, bid_ = bid0, wv_ = wave_s; asm volatile("" : "+s"(G_), "+s"(bid_), "+s"(wv_)); int tid = wv_ * 64 + lane_id(); asm volatile("" : "+v"(tid)); \
    const int G = G_, bid = bid_, ngw = G * NWAVES, lane = tid & 63, wave = wv_, gw = bid * NWAVES + wave; (void)lane; (void)gw; (void)ngw
#define PHASE_PTRS(L) int z0_ = 0; asm volatile("" : "+s"(z0_)); const float* const* inq = a.in + z0_; unsigned char* ws = a.ws + z0_; float* out = a.out + z0_; const int lq = (L) + z0_; \
    float* hm = (float*)(ws + WS_HM); float* c2 = (float*)(ws + WS_C2); float* ssqp = (float*)(ws + WS_SSQ); \
    bf16_t* hb = (bf16_t*)(ws + WS_HB); bf16_t* p = (bf16_t*)(ws + WS_P); float* pn = (float*)(ws + WS_PN); bf16_t* y = (bf16_t*)(ws + WS_Y); \
    bf16_t* act = (bf16_t*)(ws + WS_ACT); float* fixb = (float*)(ws + WS_FIX); float* rawm = (float*)(ws + WS_RAWM); \
    const unsigned char* wbuf = ws + WS_W + (size_t)(lq & 1) * WL_BYTES; \
    const bf16_t* W1 = (const bf16_t*)(wbuf + WO_W1); const bf16_t* W2 = (const bf16_t*)(wbuf + WO_W2); const bf16_t* W3 = (const bf16_t*)(wbuf + WO_W3); const bf16_t* W4 = (const bf16_t*)(wbuf + WO_W4); \
    (void)hm; (void)c2; (void)ssqp; (void)hb; (void)p; (void)pn; (void)y; (void)act; (void)fixb; (void)rawm; (void)out; (void)W1; (void)W2; (void)W3; (void)W4
    LAS unsigned char* ldsl = (LAS unsigned char*)lds;

    {
        PHASE_IDS(); PHASE_PTRS(0);
        for (int row = gw; row < RROWS; row += ngw) {
            const f32x4* xr = (const f32x4*)(row < MROWS ? inq[0] + (size_t)row * DM : inq[1] + (size_t)(row - MROWS) * DM) + lane;
            f32x4* hr = (f32x4*)(hm + (size_t)(row < MROWS ? 0 : row - MROWS) * DM) + lane;
            f32x4 v[4]; float s = 0.f;
#pragma unroll
            for (int j = 0; j < 4; ++j) { v[j] = xr[64 * j]; if (row >= MROWS) hr[64 * j] = v[j]; s += (v[j].x * v[j].x + v[j].y * v[j].y) + (v[j].z * v[j].z + v[j].w * v[j].w); }
            s = wave_sum(s);
            if (lane < 16) ssqp[(size_t)row * 16 + lane] = lane == 0 ? s : 0.f;
            u32x2* o8 = (u32x2*)(hb + (size_t)row * DM) + lane;
#pragma unroll
            for (int j = 0; j < 4; ++j) { u32x2 w; w.x = pk2bf(v[j].x, v[j].y); w.y = pk2bf(v[j].z, v[j].w); o8[64 * j] = w; }
        }
    }
    {
        PHASE_IDS(); PHASE_PTRS(0);
        u32x4* z = (u32x4*)(p + (size_t)RROWS * PBW); const unsigned n16 = (unsigned)((16512 - RROWS) * PBW * 2 / 16);
        for (unsigned i = (unsigned)(bid * (NWAVES * 64) + tid); i < n16; i += (unsigned)(G * (NWAVES * 64))) z[i] = (u32x4){0u, 0u, 0u, 0u};
    }
#ifndef PLAIN_LAUNCH
    cg::this_grid().sync();
#endif
    TP_MARK(0);

#pragma unroll 1
    for (int l = -1; l < DEPTH; ++l) {
#pragma unroll 1
      for (int ph = l < 0 ? 1 : 0; ph < (l < 0 ? 2 : 6); ++ph) {
#ifdef TPROBE
        if (wave_s == 0 && lane_id() == 0) ((volatile LAS unsigned*)((LAS unsigned char*)lds + LDSCTL_OFF + 512))[2] = (unsigned)ph;
#endif
        if (ph == 1 || ph == 4)
        {
            PHASE_IDS(); PHASE_PTRS(l);
            if (lq + 1 < DEPTH) {
                const int first = (G == 256 && lq >= 0) ? (ph == 4 ? 128 : 8) : 0, part = lq < 0 ? 15 : (G == 256 ? (ph == 4 ? 6 : 9) : (ph == 4 ? 0 : 15));
                if (bid >= first && part) wprep_layer(inq, lq + 1, ws, gw - first * NWAVES, ngw - first * NWAVES, lane, (float*)(lds + wave * 16384), part);
            }
            __syncthreads();
        }
        if (ph == 0) {
        {
            PHASE_IDS(); PHASE_PTRS(l);
            pg8::Gemm g{hb, W1, MROWS, N1, DM}; pg8::StaticOrder S; S.init(MROWS, N1, G, bid);
            RSTD_TABLE(S);
            pg8::Epi1 E{(const LAS float*)(ldsl + RSTD_OFF), p, pn, inq[16] + lq * 64, inq[17] + lq * 64};
            pg8::gemm_phase<pg8::Epi1, pg8::StaticOrder, true, true>(ldsl, g, S, E, wave);
            meta_gemm<true>(hm, DM, W1, N1, DM, bid, G, wave, lane, (float*)lds, MEpi1{p, pn});
        }
        } else if (ph == 4) {
        {
            PHASE_IDS(); PHASE_PTRS(l);
            const float* cw = inq[21] + (size_t)lq * 3 * DFF2; const float* cb = inq[22] + (size_t)lq * DFF2;
            pg8::Gemm g{hb, W3, MROWS, DFF2, DM}; pg8::StaticOrder S; S.init(MROWS, DFF2, G, bid);
            RSTD_TABLE(S);
            pg8::EpiConv E{(const LAS float*)(ldsl + RSTD_OFF), cw, cb, act, fixb, ldsl + HALO_OFF, (LAS float*)(ldsl + RSTD_OFF + 6 * 1024)};
            pg8::gemm_phase<pg8::EpiConv, pg8::StaticOrder, true, true>(ldsl, g, S, E, wave);
            meta_gemm3(hm, W3, bid, G, wave, lane, tid, (float*)lds, (float*)(lds + 20480), cw, cb, rawm, act + (size_t)MROWS * DFF);
        }
        }
        if (ph == 1 && l >= 0) {
        {
            PHASE_IDS(); PHASE_PTRS(l);
            __syncthreads(); TP_MARK(20);
            {
                const float* mu = inq[4] + lq * 1824;
                const bf16_t* lup = (const bf16_t*)(wbuf + WO_LUP);
                const int h = wave, cg = h * 64 + lane, fr = lane & 15, fq = lane >> 4;
                const float mu_r = mu[cg], mu_k = mu[512 + cg], mu_v = mu[1024 + cg];
                const float w0c = (inq[5] + lq * 512)[cg], a0c = (inq[7] + lq * 512)[cg];
                const float kkc = (inq[10] + lq * 512)[cg], kac = (inq[11] + lq * 512)[cg], rkc = (inq[12] + lq * 512)[cg];
                LAS unsigned char* PNS = ldsl;
                LAS unsigned char* PSW = ldsl + 22528 + wave * 6528;
                LAS unsigned char* LW = ldsl + 74752 + wave * 9216;
                LAS unsigned char* LIN = ldsl + 148480;
                LAS float* MU = (LAS float*)(ldsl + 158720);
                LAS float* TR = (LAS float*)LW; LAS float* LT = (LAS float*)LW; LAS float* LAK = (LAS float*)(LW + 1280);
#define PN_DMA(uu) do { const int c_ = (uu) % NCH, r0_ = rowof((uu) / NCH, 16 * c_), p0_ = prevrow(r0_); \
                    for (int pc_ = wave; pc_ < (p0_ >= 0 ? 22 : 20); pc_ += NWAVES) { \
                        const char* src_ = (pc_ < 20 ? (const char*)(pn + (size_t)r0_ * PNW) + pc_ * 1024 : (const char*)(pn + (size_t)p0_ * PNW) + (pc_ - 20) * 1024) + lane * 16; \
                        __builtin_amdgcn_global_load_lds((const unsigned*)src_, (LAS unsigned*)(PNS + pc_ * 1024), 16, 0, 0); } } while (0)
#define PS_DMA(uu) do { const int c_ = (uu) % NCH, r0_ = rowof((uu) / NCH, 16 * c_), p0_ = prevrow(r0_); int ln_ = lane; asm volatile("" : "+v"(ln_));     \
                    _Pragma("unroll") for (int j_ = 0; j_ < 7; ++j_) { const int s_ = j_ * 8 + (ln_ >> 3); \
                        if (s_ < 51) { const int i_ = s_ / 3, sg_ = s_ - 3 * i_, rw_ = i_ ? r0_ + i_ - 1 : (p0_ >= 0 ? p0_ : r0_); \
                            const char* src_ = (const char*)(p + (size_t)rw_ * PBW) + sg_ * 1024 + wave * 128 + (ln_ & 7) * 16; \
                            __builtin_amdgcn_global_load_lds((const unsigned*)src_, (LAS unsigned*)(PSW + j_ * 1024), 16, 0, 0); } } } while (0)
#define PSV(i, sg) bf2f(((const LAS bf16_t*)PSW)[(3 * (i) + (sg)) * 64 + lane])
                if (tid < 288) MU[tid] = mu[1536 + tid];
                if (bid < NB * NCH) { PN_DMA(bid); PS_DMA(bid); }
                asm volatile("s_waitcnt vmcnt(0)" ::: "memory");
                bf16x8 bw_[2][4];
                {   const int fru = lane & 15, fqu = lane >> 4;
#pragma unroll
                    for (int nb = 0; nb < 4; ++nb) { const bf16_t* bp_ = lup + (size_t)(h * 64 + 16 * nb + fru) * 288 + 8 * fqu;
#pragma unroll
                        for (int ks = 0; ks < 2; ++ks) bw_[ks][nb] = *(const bf16x8*)(bp_ + 32 * ks);
                    } }
                for (int u = bid; u < NB * NCH; u += G) {
                    const int b = u / NCH, c = u % NCH, row0 = rowof(b, 16 * c), prow0 = prevrow(row0);
                    int tidu = tid; asm volatile("" : "+v"(tidu));
                    const int fr = tidu & 15, fq = (tidu >> 4) & 3;
                    bf16x8 ba_[2][4], bg_[5][4];
                    {   const int fru = fr, fqu = fq;
#pragma unroll
                        for (int nb = 0; nb < 4; ++nb) { const bf16_t* bp_ = lup + (size_t)(h * 64 + 16 * nb + fru) * 288 + 8 * fqu;
#pragma unroll
                            for (int ks = 0; ks < 2; ++ks) ba_[ks][nb] = *(const bf16x8*)(bp_ + 64 + 32 * ks);
                        } }
                    TP_MARK(27);
                    asm volatile("s_waitcnt lgkmcnt(0)\n\ts_barrier" ::: "memory");
                    {
                        float cur_[9], prv_[9], mu_[9];
#pragma unroll
                        for (int i = 0; i < 9; ++i) { const int e = tidu + 512 * i, ti = e / 288, j = e - 288 * ti;
                            cur_[i] = ((const LAS float*)PNS)[ti * 320 + j]; prv_[i] = ((const LAS float*)PNS)[(ti ? ti - 1 : 16) * 320 + j]; mu_[i] = MU[j]; }
#pragma unroll
                        for (int i = 0; i < 9; ++i) { const int e = tidu + 512 * i, ti = e / 288, j = e - 288 * ti;
                            const float prv = (ti || prow0 >= 0) ? prv_[i] : 0.f, s = cur_[i] + mu_[i] * (prv - cur_[i]);
                            const float ex = __builtin_amdgcn_exp2f((j < 64 ? 2.f * LOG2E : -LOG2E) * s), rc = __builtin_amdgcn_rcpf(1.f + ex);
                            ((LAS bf16_t*)LIN)[ti * 296 + j] = f2bf(j < 64 ? 1.f - 2.f * rc : (j < 128 ? s : rc)); }
                    }
                    {   const int fru = fr, fqu = fq;
#pragma unroll
                        for (int nb = 0; nb < 4; ++nb) { const bf16_t* bp_ = lup + (size_t)(h * 64 + 16 * nb + fru) * 288 + 8 * fqu;
#pragma unroll
                            for (int ks = 0; ks < 5; ++ks) bg_[ks][nb] = *(const bf16x8*)(bp_ + 128 + 32 * ks); } }
                    TP_MARK(28);
                    asm volatile("s_waitcnt lgkmcnt(0)\n\ts_barrier" ::: "memory");
                    if (u + G < NB * NCH) PN_DMA(u + G);
                    TP_MARK(22);
#define LORA_PRE(ZA, KB0, NKS, BF) do { f32x4 acc_[4]; _Pragma("unroll") for (int nb = 0; nb < 4; ++nb) acc_[nb] = (f32x4){0.f, 0.f, 0.f, 0.f}; \
                        _Pragma("unroll") for (int ks = 0; ks < (NKS); ++ks) { const bf16x8 af = *(const LAS bf16x8*)(LIN + fr * 592 + ((KB0) + 32 * ks + 8 * fq) * 2); \
                            _Pragma("unroll") for (int nb = 0; nb < 4; ++nb) acc_[nb] = __builtin_amdgcn_mfma_f32_16x16x32_bf16(af, BF[ks][nb], acc_[nb], 0, 0, 0); } \
                        WAVE_LDS_SYNC(); \
                        _Pragma("unroll") for (int nb = 0; nb < 4; ++nb) _Pragma("unroll") for (int r = 0; r < 4; ++r) TR[(4 * fq + r) * 65 + 16 * nb + fr] = acc_[nb][r]; \
                        WAVE_LDS_SYNC(); \
                        _Pragma("unroll") for (int i = 0; i < 16; ++i) ZA[i] = TR[i * 65 + lane]; } while (0)
                    float zw[16], za[16];
                    LORA_PRE(zw, 0, 2, bw_); LORA_PRE(za, 64, 2, ba_);
                    {
                        float zg[16]; LORA_PRE(zg, 128, 5, bg_); (void)zg;
                        asm volatile("s_waitcnt vmcnt(0)" ::: "memory");
                        {
                            const int ti_ = lane >> 2, pt_ = lane & 3; float gv_[16];
#pragma unroll
                            for (int k_ = 0; k_ < 16; ++k_) gv_[k_] = TR[ti_ * 65 + 16 * pt_ + k_];
                            u32x4 o0_, o1_;
                            o0_.x = pk2bf(gv_[0], gv_[1]); o0_.y = pk2bf(gv_[2], gv_[3]); o0_.z = pk2bf(gv_[4], gv_[5]); o0_.w = pk2bf(gv_[6], gv_[7]);
                            o1_.x = pk2bf(gv_[8], gv_[9]); o1_.y = pk2bf(gv_[10], gv_[11]); o1_.z = pk2bf(gv_[12], gv_[13]); o1_.w = pk2bf(gv_[14], gv_[15]);
                            bf16_t* yp_ = y + (size_t)(row0 + ti_) * DM + h * 64 + 16 * pt_;
                            *(u32x4*)yp_ = o0_; *(u32x4*)(yp_ + 8) = o1_; } }
#undef LORA_PRE
                    WAVE_LDS_SYNC();
                    const int ci = (b * 8 + h) * NCH + c;
                    unsigned char* ra = ws + WS_RA + (size_t)ci * RA_BYTES; unsigned char* rb = (unsigned char*)out + (size_t)ci * RB_BYTES;
                    bf16_t* BV = (bf16_t*)(ws + WS_BV);
                    LAS bf16_t* OA = (LAS bf16_t*)LW; LAS bf16_t* OB = OA + 16 * 72; LAS bf16_t* OK = OB + 16 * 72; LAS bf16_t* OR = OK + 16 * 72;
                    const int cxk = (lane >> 5) * 4 + ((lane >> 2) & 3), jk2 = (((lane >> 4) & 1) * 4 + (lane & 3)) * 2;
                    TP_MARK(23);
                    float atil[16]; unsigned bkB[8], bkK[8], vtp[8];
                    float cumC = 0.f;
#pragma unroll
                    for (int i = 0; i < 16; ++i) { zw[i] = 0.6065306597126334f * __builtin_amdgcn_rcpf(1.f + __builtin_amdgcn_exp2f(-LOG2E * (zw[i] + w0c))); cumC += zw[i]; }
                    float cum = 0.f, gprev = 1.f, rp = 0.f, kp_ = 0.f, vp = 0.f, be = 0.f, ke = 0.f, ve = 0.f, bve = 0.f; unsigned bvp[8];
                    unsigned short prr[17], pkk[17], pvv[17];
#pragma unroll
                    for (int i = 0; i < 17; ++i) { prr[i] = ((const LAS bf16_t*)PSW)[(3 * i) * 64 + lane]; pkk[i] = ((const LAS bf16_t*)PSW)[(3 * i + 1) * 64 + lane]; pvv[i] = ((const LAS bf16_t*)PSW)[(3 * i + 2) * 64 + lane]; }
                    WAVE_LDS_SYNC();
                    if (u + G < NB * NCH) PS_DMA(u + G);
                    rp = bf2f(prr[0]); kp_ = bf2f(pkk[0]); vp = bf2f(pvv[0]);
                    const float hp0 = prow0 >= 0 ? 1.f : 0.f;
#pragma unroll
                    for (int i = 0; i < 16; ++i) {
                        const float rc = bf2f(prr[i + 1]), kc = bf2f(pkk[i + 1]), vc = bf2f(pvv[i + 1]);
                        const float hp = i ? 1.f : hp0;
                        const float rs = rc + mu_r * (hp * rp - rc), ks_ = kc + mu_k * (hp * kp_ - kc), vs = vc + mu_v * (hp * vp - vc);
                        rp = rc; kp_ = kc; vp = vc;
                        cum += zw[i];
                        const float alr = __builtin_amdgcn_rcpf(1.f + __builtin_amdgcn_exp2f(-LOG2E * (za[i] + a0c)));
                        const float kkr = ks_ * kkc; const float kk = kkr * __builtin_amdgcn_rsqf(fmaxf(wave_sum_dpp(kkr * kkr), 1e-24f));
                        const float kpr = ks_ * (1.f + (alr - 1.f) * kac);
                        const float bon = wave_sum_dpp(rs * kpr * rkc);
                        const float eg = __builtin_amdgcn_exp2f(LOG2E * cum), gi = __builtin_amdgcn_exp2f(-LOG2E * cum), tail = __builtin_amdgcn_exp2f(LOG2E * (cum - cumC));
                        atil[i] = -kk * gprev;
                        const float bb = kk * alr, rtil = rs * gi; gprev = gi;
                        OA[i * 72 + lane] = f2bf(atil[i]); OB[i * 72 + lane] = f2bf(bb * eg); OK[i * 72 + lane] = f2bf(kpr * eg); OR[i * 72 + lane] = f2bf(rtil);
                        if (i & 1) { bkB[i >> 1] = pk2bf(be, bb * tail); bkK[i >> 1] = pk2bf(ke, kpr * tail); vtp[i >> 1] = pk2bf(ve, vs); } else { be = bb * tail; ke = kpr * tail; ve = vs; }
                        if (i & 1) bvp[i >> 1] = pk2bf(bve, bon * vs); else bve = bon * vs;
                    }
                    {
                        ((float*)(rb + 3584))[lane] = gprev;
#pragma unroll
                        for (int q = 0; q < 4; ++q) *(u32x4*)(ra + 4096 + lane * 64 + ((q ^ SWZ4(lane)) << 4)) = (u32x4){bkB[2 * q], bkB[2 * q + 1], bkK[2 * q], bkK[2 * q + 1]};
                        *(u32x4*)(rb + lane * 32) = (u32x4){vtp[0], vtp[1], vtp[2], vtp[3]}; *(u32x4*)(rb + lane * 32 + 16) = (u32x4){vtp[4], vtp[5], vtp[6], vtp[7]};
                    }
                    WAVE_LDS_SYNC();
                    TP_MARK(24);
#define REC_STORE(TILE, DST) do { _Pragma("unroll") for (int hh_ = 0; hh_ < 2; ++hh_) { const int i_ = (lane >> 3) + 8 * hh_, pc_ = lane & 7, c_ = pc_ ^ ((i_ >> 1) & 7), base_ = (c_ >> 2) * 32 + (c_ & 3) * 4; \
                        const u32x2 lo_ = *(const LAS u32x2*)((TILE) + i_ * 72 + base_), hi_ = *(const LAS u32x2*)((TILE) + i_ * 72 + base_ + 16); \
                        *(u32x4*)((DST) + i_ * 128 + pc_ * 16) = (u32x4){lo_.x, lo_.y, hi_.x, hi_.y}; } } while (0)
                    REC_STORE(OR, ra + 2048);
                    {
                        f32x4 dab = (f32x4){0.f, 0.f, 0.f, 0.f}, dak = dab, drb = dab, drk = dab;
#pragma unroll
                        for (int ks = 0; ks < 2; ++ks) {
                            const int off = fr * 72 + 32 * ks + 8 * fq;
                            const bf16x8 fa = *(const LAS bf16x8*)(OA + off), fb = *(const LAS bf16x8*)(OB + off), fk = *(const LAS bf16x8*)(OK + off), frr = *(const LAS bf16x8*)(OR + off);
                            dab = __builtin_amdgcn_mfma_f32_16x16x32_bf16(fa, fb, dab, 0, 0, 0); dak = __builtin_amdgcn_mfma_f32_16x16x32_bf16(fa, fk, dak, 0, 0, 0);
                            drb = __builtin_amdgcn_mfma_f32_16x16x32_bf16(frr, fb, drb, 0, 0, 0); drk = __builtin_amdgcn_mfma_f32_16x16x32_bf16(frr, fk, drk, 0, 0, 0);
                        }
#pragma unroll
                        for (int r = 0; r < 4; ++r) { const int i = 4 * fq + r, j = fr;
                            LT[i * 20 + j] = j < i ? dab[r] : 0.f; LAK[i * 16 + j] = j < i ? dak[r] : 0.f;
                            bf16_t* mp = (bf16_t*)(rb + 2048 + i * 64 + (((j >> 2) ^ SWZ4(i)) << 4)) + (j & 3);
                            mp[0] = f2bf(j <= i ? drb[r] : 0.f); mp[4] = f2bf(j <= i ? drk[r] : 0.f); }
                    }
                    WAVE_LDS_SYNC();
                    {
#pragma unroll
                        for (int k_ = 0; k_ < 8; ++k_) { OB[(2 * k_) * 72 + lane] = (bf16_t)(bvp[k_] & 0xffffu); OB[(2 * k_ + 1) * 72 + lane] = (bf16_t)(bvp[k_] >> 16); }
                        WAVE_LDS_SYNC();
                        const int ti_ = lane >> 2, pt_ = lane & 3;
                        const u32x4 b0_ = *(const LAS u32x4*)(OB + ti_ * 72 + 16 * pt_), b1_ = *(const LAS u32x4*)(OB + ti_ * 72 + 16 * pt_ + 8);
                        bf16_t* bp_ = BV + (size_t)(row0 + ti_) * 512 + h * 64 + 16 * pt_;
                        *(u32x4*)bp_ = b0_; *(u32x4*)(bp_ + 8) = b1_;
                    }
                    float tt[16];
#pragma unroll
                    for (int mm = 0; mm < 16; ++mm) tt[mm] = mm == fr ? 1.f : 0.f;
#pragma unroll
                    for (int j = 14; j >= 0; --j) { float val = 0.f;
#pragma unroll
                        for (int mm = j + 1; mm < 16; ++mm) val += tt[mm] * LT[mm * 20 + j];
                        tt[j] += val; }
                    WAVE_LDS_SYNC();
                    if (fq == 0) {
#pragma unroll
                        for (int mm = 0; mm < 16; ++mm) LT[fr * 20 + mm] = tt[mm]; }
                    {
                        f32x4 g4 = (f32x4){0.f, 0.f, 0.f, 0.f};
#pragma unroll
                        for (int mm = 0; mm < 16; ++mm) g4 += *(const LAS f32x4*)(LAK + mm * 16 + 4 * fq) * tt[mm];
                        u32x2 w; w.x = pk2bf(g4[0], g4[1]); w.y = pk2bf(g4[2], g4[3]);
                        *(u32x2*)(rb + 3072 + (fr * 16 + 4 * fq) * 2) = w;
                    }
                    WAVE_LDS_SYNC();
                    TP_MARK(25);
                    {
#pragma unroll
                        for (int i = 0; i < 16; ++i) { float acc = 0.f;
                            const f32x4 t0 = *(const LAS f32x4*)(LT + i * 20), t1 = *(const LAS f32x4*)(LT + i * 20 + 4), t2 = *(const LAS f32x4*)(LT + i * 20 + 8), t3 = *(const LAS f32x4*)(LT + i * 20 + 12);
                            const float trow[16] = {t0[0], t0[1], t0[2], t0[3], t1[0], t1[1], t1[2], t1[3], t2[0], t2[1], t2[2], t2[3], t3[0], t3[1], t3[2], t3[3]};
#pragma unroll
                            for (int mm = 0; mm <= i; ++mm) acc += trow[mm] * atil[mm];
                            OK[i * 72 + lane] = f2bf(acc); }
                        WAVE_LDS_SYNC();
                        REC_STORE(OK, ra);
                    }
#undef REC_STORE
                    TP_MARK(26);
                }
            }
            __syncthreads();
#undef PN_DMA
#undef PS_DMA
#undef PSV
            TP_MARK(29);
            TP_MARK(21);
            const float* q_g = inq[16] + lq * 64; const float* k_g = inq[17] + lq * 64; const float* b_f = inq[15] + lq * 8;
            for (int it = gw - (G >= 96 ? 80 * NWAVES : 0); it >= 0 && it < NMETA * NH; it += ngw) {
                const int row = MROWS + (it >> 3), h = it & 7;
                bf16_t* qp = p + (size_t)row * PBW + 1536 + h * 64 + lane; bf16_t* kp = p + (size_t)row * PBW + 2048 + h * 64 + lane;
                const float q = bf2f(*qp), k = bf2f(*kp);
                const float mq = wave_sum(q * q) * (1.f / 64.f), mk = wave_sum(k * k) * (1.f / 64.f);
                *qp = f2bf(q * (1.0f / sqrtf(mq + 1e-6f)) * q_g[lane] * (0.125f * LOG2E));
                *kp = f2bf(k * (1.0f / sqrtf(mk + 1e-6f)) * k_g[lane]);
            }
            for (int it = bid - (G >= 80 ? 16 : 0); it >= 0 && it < NB * NH; it += G) {
                constexpr int PER = 5;
                const int b = it >> 3, h = it & 7;
                float zv[PER], loc[PER], s = 0.f;
#pragma unroll
                for (int i = 0; i < PER; ++i) { const int t = tid * PER + i; zv[i] = pn[(size_t)rowof(b, t < LTOT ? t : LTOT - 1) * PNW + 288 + h]; }
#pragma unroll
                for (int i = 0; i < PER; ++i) { const int t = tid * PER + i;
                    const float v = t < LTOT ? -__builtin_amdgcn_logf(1.f + __builtin_amdgcn_exp2f(-LOG2E * (zv[i] + b_f[h]))) : 0.f;
                    s += v; loc[i] = s; }
                float incl = s;
#pragma unroll
                for (int o = 1; o < 64; o <<= 1) { const float n = __int_as_float(__builtin_amdgcn_ds_bpermute((lane - o) << 2, __float_as_int(incl))); if (lane >= o) incl += n; }
                float base = incl - s;
                if (lane == 63) ((LAS float*)ldsl)[wave] = incl;
                __syncthreads();
#pragma unroll
                for (int w = 0; w < NWAVES - 1; ++w) base += w < wave ? ((const LAS float*)ldsl)[w] : 0.f;
                float* cv = c2 + (size_t)it * 2176;
#pragma unroll
                for (int i = 0; i < PER; ++i) { const int t = tid * PER + i; if (t < LTOT) cv[t < NMETA ? t : t + 112] = base + loc[i]; }
                if (tid < 112) cv[16 + tid] = 1e5f;
                __syncthreads();
            }
        }
        } else if (ph == 2) {
        {
            PHASE_IDS(); PHASE_PTRS(l);
            typedef short s16x4 __attribute__((ext_vector_type(4)));
            constexpr int SLOTB = 12288, NSLOT = 10  , YB_OFF = NSLOT * SLOTB, YB_BYTES = 32 * 68 * 4, NSC = (NCH + 1) / 2;
            static_assert(YB_OFF + 2 * YB_BYTES <= LDSCTL_OFF, "scan LDS map");
#define RAW_BAR() asm volatile("s_waitcnt lgkmcnt(0)\n\ts_barrier" ::: "memory")
#define QXOR1(x) __int_as_float(__builtin_amdgcn_update_dpp(0, __float_as_int(x), 0xB1, 0xf, 0xf, false))
#define QXOR2(x) __int_as_float(__builtin_amdgcn_update_dpp(0, __float_as_int(x), 0x4E, 0xf, 0xf, false))
            for (int unit = bid; unit < 64; unit += G) {
                const int b = unit >> 3, h = unit & 7, fr = lane & 15, fq = lane >> 4;
                const unsigned char* RA0 = ws + WS_RA + (size_t)unit * NCH * RA_BYTES; const unsigned char* RB0 = (const unsigned char*)out + (size_t)unit * NCH * RB_BYTES;
                if (wave < 4) {
                    const int v = 16 * wave + fr;
                    f32x4 Z[4];
#pragma unroll
                    for (int kb = 0; kb < 4; ++kb) Z[kb] = (f32x4){0.f, 0.f, 0.f, 0.f};
                    const int o_ah0 = fr * 128 + (((fq) ^ ((fr >> 1) & 7)) << 4), o_ah1 = fr * 128 + (((4 + fq) ^ ((fr >> 1) & 7)) << 4);
                    const int o_bk = 4096 + fr * 64 + ((fq ^ SWZ4(fr)) << 4), o_mrk = 10240 + fr * 64 + ((fq ^ SWZ4(fr)) << 4);
                    const int o_vt = 8192 + v * 32 + fq * 8, o_g = 11264 + fr * 32 + fq * 8, o_gam = 11776 + fq * 16;
                    RAW_BAR();
                    for (int s = 0; s < NSC; ++s) {
                        LAS float* YB = (LAS float*)(ldsl + YB_OFF + (s & 1) * YB_BYTES);
                        const int nc = (NCH - 2 * s) < 2 ? 1 : 2;
                        for (int cs = 0; cs < nc; ++cs) {
                            const LAS unsigned char* sl = ldsl + ((2 * s + cs) % NSLOT) * SLOTB;
                            const bf16x8 ah0 = *(const LAS bf16x8*)(sl + o_ah0), ah1 = *(const LAS bf16x8*)(sl + o_ah1);
                            const bf16x8 rh0 = *(const LAS bf16x8*)(sl + 2048 + o_ah0), rh1 = *(const LAS bf16x8*)(sl + 2048 + o_ah1);
                            bf16x8 bk[4]; f32x4 gam[4];
#pragma unroll
                            for (int kb = 0; kb < 4; ++kb) { bk[kb] = *(const LAS bf16x8*)(sl + o_bk + kb * 1024); gam[kb] = *(const LAS f32x4*)(sl + o_gam + kb * 64); }
                            const u32x2 vt = *(const LAS u32x2*)(sl + o_vt);
                            const bf16x8 mrk = *(const LAS bf16x8*)(sl + o_mrk);
                            const u32x2 g4 = *(const LAS u32x2*)(sl + o_g);
                            u32x4 zw01, zw23;
                            zw01.x = pk2bf(Z[0][0], Z[0][1]); zw01.y = pk2bf(Z[0][2], Z[0][3]); zw01.z = pk2bf(Z[1][0], Z[1][1]); zw01.w = pk2bf(Z[1][2], Z[1][3]);
                            zw23.x = pk2bf(Z[2][0], Z[2][1]); zw23.y = pk2bf(Z[2][2], Z[2][3]); zw23.z = pk2bf(Z[3][0], Z[3][1]); zw23.w = pk2bf(Z[3][2], Z[3][3]);
                            const bf16x8 zp01 = __builtin_bit_cast(bf16x8, zw01), zp23 = __builtin_bit_cast(bf16x8, zw23);
                            f32x4 U = (f32x4){0.f, 0.f, 0.f, 0.f}, Yv = U;
                            U = __builtin_amdgcn_mfma_f32_16x16x32_bf16(ah0, zp01, U, 0, 0, 0); U = __builtin_amdgcn_mfma_f32_16x16x32_bf16(ah1, zp23, U, 0, 0, 0);
                            U = __builtin_amdgcn_mfma_f32_16x16x16bf16_1k(__builtin_bit_cast(s16x4, g4), __builtin_bit_cast(s16x4, vt), U, 0, 0, 0);
                            Yv = __builtin_amdgcn_mfma_f32_16x16x32_bf16(rh0, zp01, Yv, 0, 0, 0); Yv = __builtin_amdgcn_mfma_f32_16x16x32_bf16(rh1, zp23, Yv, 0, 0, 0);
                            u32x4 uvw; uvw.x = pk2bf(U[0], U[1]); uvw.y = pk2bf(U[2], U[3]); uvw.z = vt.x; uvw.w = vt.y;
                            const bf16x8 uv = __builtin_bit_cast(bf16x8, uvw);
                            Yv = __builtin_amdgcn_mfma_f32_16x16x32_bf16(mrk, uv, Yv, 0, 0, 0);
#pragma unroll
                            for (int kb = 0; kb < 4; ++kb) { Z[kb] = Z[kb] * gam[kb]; Z[kb] = __builtin_amdgcn_mfma_f32_16x16x32_bf16(bk[kb], uv, Z[kb], 0, 0, 0); }
#pragma unroll
                            for (int r = 0; r < 4; ++r) YB[(cs * 16 + 4 * fq + r) * 68 + v] = Yv[r];
                        }
                        RAW_BAR();
                    }
                } else if (wave < 6) {
                    const unsigned lds0 = (unsigned)(uintptr_t)lds; const int lw = wave - 4;
#define DMA_SC(sc) do { const int nc_ = (NCH - 2 * (sc)) < 2 ? 1 : 2; for (int cs_ = 0; cs_ < nc_; ++cs_) { const int ch_ = 2 * (sc) + cs_; \
                        _Pragma("unroll") for (int pc_ = 0; pc_ < 6; ++pc_) { const int pc = lw * 6 + pc_; \
                            const unsigned char* src_ = (pc < 8 ? RA0 + (size_t)ch_ * RA_BYTES + pc * 1024 : RB0 + (size_t)ch_ * RB_BYTES + (pc - 8) * 1024) + lane * 16; \
                            attn_body::glds16(src_, (unsigned)__builtin_amdgcn_readfirstlane(lds0 + (ch_ % NSLOT) * SLOTB + pc * 1024)); } } } while (0)
                    DMA_SC(0); DMA_SC(1); DMA_SC(2); DMA_SC(3);
                    asm volatile("s_waitcnt vmcnt(36)\n\ts_barrier" ::: "memory");
                    for (int s = 0; s < NSC; ++s) {
                        if (s + 4 < NSC) DMA_SC(s + 4);
#define NPC_(sc) ((sc) < NSC ? ((NCH - 2 * (sc)) < 2 ? 6 : 12) : 0)
                        const int fl = NPC_(s + 2) + NPC_(s + 3) + NPC_(s + 4);
#undef NPC_
                        if (fl == 36) asm volatile("s_waitcnt vmcnt(36)\n\ts_barrier" ::: "memory");
                        else if (fl == 30) asm volatile("s_waitcnt vmcnt(30)\n\ts_barrier" ::: "memory");
                        else if (fl == 18) asm volatile("s_waitcnt vmcnt(18)\n\ts_barrier" ::: "memory");
                        else if (fl == 6) asm volatile("s_waitcnt vmcnt(6)\n\ts_barrier" ::: "memory");
                        else asm volatile("s_waitcnt vmcnt(0)\n\ts_barrier" ::: "memory");
                    }
#undef DMA_SC
                } else {
                    const int pw = wave - 6, tk = lane >> 2, part = lane & 3, cgv = h * 64 + part * 16;
                    const bf16_t* BV = (const bf16_t*)(ws + WS_BV);
                    float gnw[16], gnb[16];
#pragma unroll
                    for (int j = 0; j < 16; ++j) { gnw[j] = (inq[13] + lq * 512)[cgv + j]; gnb[j] = (inq[14] + lq * 512)[cgv + j]; }
#define PLOAD(G0, G1, B0, B1, sg) do { const int cn_ = 2 * (sg) + pw; if ((sg) < NSC && cn_ < NCH) { const size_t rown = (size_t)rowof(b, 16 * cn_ + tk); \
                        G0 = *(const u32x4*)(y + rown * DM + cgv); G1 = *(const u32x4*)(y + rown * DM + cgv + 8); B0 = *(const u32x4*)(BV + rown * 512 + cgv); B1 = *(const u32x4*)(BV + rown * 512 + cgv + 8); } } while (0)
                    u32x4 ga0 = (u32x4){0u, 0u, 0u, 0u}, ga1 = ga0, ba0 = ga0, ba1 = ga0, gb0 = ga0, gb1 = ga0, bb0 = ga0, bb1 = ga0, gc0 = ga0, gc1 = ga0, bc0 = ga0, bc1 = ga0;
                    PLOAD(gb0, gb1, bb0, bb1, 0); PLOAD(gc0, gc1, bc0, bc1, 1);
                    RAW_BAR();
                    for (int s = 0; s <= NSC; ++s) {
                        const int cp = 2 * (s - 1) + pw;
                        const bool do_now = s >= 1 && cp < NCH && (cp > 0 || b == 0);
                        const u32x4 g0 = ga0, g1 = ga1, b0 = ba0, b1 = ba1;
                        ga0 = gb0; ga1 = gb1; ba0 = bb0; ba1 = bb1; gb0 = gc0; gb1 = gc1; bb0 = bc0; bb1 = bc1;
                        PLOAD(gc0, gc1, bc0, bc1, s + 2);
                        if (do_now) {
                            const LAS float* yb = (const LAS float*)(ldsl + YB_OFF + ((s - 1) & 1) * YB_BYTES) + (pw * 16 + tk) * 68 + part * 16;
                            float yv[16];
#pragma unroll
                            for (int q4 = 0; q4 < 4; ++q4) { const f32x4 t4 = *(const LAS f32x4*)(yb + 4 * q4); yv[4 * q4] = t4[0]; yv[4 * q4 + 1] = t4[1]; yv[4 * q4 + 2] = t4[2]; yv[4 * q4 + 3] = t4[3]; }
                            float s1 = 0.f;
#pragma unroll
                            for (int j = 0; j < 16; ++j) s1 += yv[j];
                            s1 += QXOR1(s1); s1 += QXOR2(s1);
                            const float mean = s1 * (1.f / 64.f); float s2 = 0.f;
#pragma unroll
                            for (int j = 0; j < 16; ++j) { yv[j] -= mean; s2 += yv[j] * yv[j]; }
                            s2 += QXOR1(s2); s2 += QXOR2(s2);
                            const float rstd = 1.0f / sqrtf(s2 * (1.f / 64.f) + 64e-5f);
                            const unsigned gws[8] = {g0.x, g0.y, g0.z, g0.w, g1.x, g1.y, g1.z, g1.w}, bws[8] = {b0.x, b0.y, b0.z, b0.w, b1.x, b1.y, b1.z, b1.w};
                            unsigned ow[8];
#pragma unroll
                            for (int j2 = 0; j2 < 8; ++j2) {
                                const float oa = (yv[2 * j2] * rstd * gnw[2 * j2] + gnb[2 * j2] + __uint_as_float(bws[j2] << 16)) * __uint_as_float(gws[j2] << 16);
                                const float ob = (yv[2 * j2 + 1] * rstd * gnw[2 * j2 + 1] + gnb[2 * j2 + 1] + __uint_as_float(bws[j2] & 0xffff0000u)) * __uint_as_float(gws[j2] & 0xffff0000u);
                                ow[j2] = pk2bf(oa, ob); }
                            bf16_t* yo = y + (size_t)rowof(b, 16 * cp + tk) * DM + cgv;
                            *(u32x4*)yo = (u32x4){ow[0], ow[1], ow[2], ow[3]}; *(u32x4*)(yo + 8) = (u32x4){ow[4], ow[5], ow[6], ow[7]};
                        }
                        if (s < NSC) RAW_BAR();
                    }
#undef PLOAD
                }
                __syncthreads();
            }
#undef RAW_BAR
#undef QXOR1
#undef QXOR2
        }
        TP_MARK(30);
        {
            PHASE_IDS(); PHASE_PTRS(l);
            if (gw < NH * NMETA) {
                const int h = gw >> 4, t = gw & 15;
                const bf16_t* qrow = p + (size_t)(MROWS + t) * PBW + 1536 + h * 64;
                float s = -INFINITY;
                if (lane <= t) { const bf16_t* kr = p + (size_t)(MROWS + lane) * PBW + 2048 + h * 64; float d = 0.f;
                    for (int e = 0; e < 64; ++e) d += bf2f(qrow[e]) * bf2f(kr[e]);
                    s = d - c2[(size_t)h * 2176 + lane]; }
                const float mx = wave_max(s); const float e = lane <= t ? exp2f(s - mx) : 0.f; const float sum = wave_sum(e);
                float o = 0.f;
                for (int j = 0; j <= t; ++j) o += __int_as_float(__builtin_amdgcn_readlane(__float_as_int(e), j)) * bf2f(p[(size_t)(MROWS + j) * PBW + 2560 + h * 64 + lane]);
                const float og = bf2f(p[(size_t)(MROWS + t) * PBW + 3072 + h * 64 + lane]);
                y[(size_t)(MROWS + t) * DM + 512 + h * 64 + lane] = f2bf(o * __builtin_amdgcn_rcpf(sum) * __builtin_amdgcn_rcpf(1.f + __builtin_amdgcn_exp2f(-LOG2E * og)));
            }
        }
        __syncthreads();
        {
            PHASE_IDS(); PHASE_PTRS(l);
            typedef attn_body::bf16 abf;
            const attn_body::AttnTensors AT{(const abf*)(p + 1536), (const abf*)(p + 2048), (const abf*)(p + 2560), (const abf*)(p + 3072), c2, (abf*)(y + 512)};
            const attn_body::StaticOrder S(G, bid);
            TP_MARK(31);
            attn_body::attn_phase<attn_body::StaticOrder>((char*)lds, AT, S, wave);
            TP_MARK(32);
        }
        } else if (ph == 3) {
        {
            PHASE_IDS(); PHASE_PTRS(l);
            pg8::Gemm g{y, W2, MROWS, DM, DM}; pg8::StaticOrder S; S.init(MROWS, DM, G, bid);
            pg8::EpiRes E{nullptr, hb, ssqp};
            pg8::gemm_phase<pg8::EpiRes, pg8::StaticOrder, true, true>(ldsl, g, S, E, wave);
            meta_gemm<false>(y + (size_t)MROWS * DM, DM, W2, DM, DM, bid, G, wave, lane, (float*)lds, MEpiRes{hm});
        }
        } else if (ph == 5) {
        {
            PHASE_IDS(); PHASE_PTRS(l);
            const float* cw = inq[21] + (size_t)lq * 3 * DFF2; const float* cb = inq[22] + (size_t)lq * DFF2;
            pg8::Gemm g{act, W4, MROWS, DM, DFF}; pg8::StaticOrder S; S.init(MROWS, DM, G, bid);
            {
                pg8::Unit u;
                for (int i = 0; S.next(i, u); ++i) {
                    const int pm = u.pm;
                    const float* own0 = fixb + (size_t)(pm * 4) * DFF2; const float* own1 = own0 + DFF2;
                    const float* pv0 = (pm & 7) ? fixb + (size_t)((pm - 1) * 4 + 2) * DFF2 : rawm + (size_t)14 * DFF2; const float* pv1 = pv0 + DFF2;
                    for (int j = 4 * tid; j < DFF; j += 4 * NWAVES * 64) {
                        const f32x4 w0u = *(const f32x4*)(cw + j), w1u = *(const f32x4*)(cw + DFF2 + j), w2u = *(const f32x4*)(cw + 2 * DFF2 + j), bu = *(const f32x4*)(cb + j);
                        const f32x4 w0g = *(const f32x4*)(cw + DFF + j), w1g = *(const f32x4*)(cw + DFF2 + DFF + j), w2g = *(const f32x4*)(cw + 2 * DFF2 + DFF + j), bg = *(const f32x4*)(cb + DFF + j);
                        const f32x4 au = *(const f32x4*)(pv0 + j), bu_ = *(const f32x4*)(pv1 + j), cu_ = *(const f32x4*)(own0 + j), du = *(const f32x4*)(own1 + j);
                        const f32x4 ag = *(const f32x4*)(pv0 + DFF + j), bg_ = *(const f32x4*)(pv1 + DFF + j), cg_ = *(const f32x4*)(own0 + DFF + j), dg = *(const f32x4*)(own1 + DFF + j);
                        const f32x4 u0 = bu + w0u * au + w1u * bu_ + w2u * cu_, g0 = bg + w0g * ag + w1g * bg_ + w2g * cg_;
                        const f32x4 u1 = bu + w0u * bu_ + w1u * cu_ + w2u * du, g1 = bg + w0g * bg_ + w1g * cg_ + w2g * dg;
                        u32x2 o0, o1;
                        o0.x = pk2bf(g0[0] * sigmoidf_(g0[0]) * u0[0], g0[1] * sigmoidf_(g0[1]) * u0[1]); o0.y = pk2bf(g0[2] * sigmoidf_(g0[2]) * u0[2], g0[3] * sigmoidf_(g0[3]) * u0[3]);
                        o1.x = pk2bf(g1[0] * sigmoidf_(g1[0]) * u1[0], g1[1] * sigmoidf_(g1[1]) * u1[1]); o1.y = pk2bf(g1[2] * sigmoidf_(g1[2]) * u1[2], g1[3] * sigmoidf_(g1[3]) * u1[3]);
                        *(u32x2*)(act + (size_t)(256 * pm) * DFF + j) = o0; *(u32x2*)(act + (size_t)(256 * pm + 1) * DFF + j) = o1;
                    }
                }
                asm volatile("s_waitcnt vmcnt(0)" ::: "memory"); __syncthreads();
            }
            pg8::EpiRes E{lq + 1 == DEPTH ? out : nullptr, hb, ssqp};
            pg8::gemm_phase<pg8::EpiRes, pg8::StaticOrder, true, true>(ldsl, g, S, E, wave);
            meta_gemm<false>(act + (size_t)MROWS * DFF, DFF, W4, DM, DFF, bid, G, wave, lane, (float*)lds, MEpiRes{hm});
        }
        }
#ifdef TPROBE
#ifdef TPROBE_WAIT
        TP_MARK(19);
#endif
        GRID_BAR(); TP_MARK(ph == 0 ? 1 : ph == 1 ? 2 : ph == 2 ? 3 : ph == 3 ? 4 : ph == 4 ? 5 : 6);
#if TPROBE == 40
        GRID_BAR(); TP_MARK(40);
#endif
#else
        if (ph < 5 || l + 1 < DEPTH) GRID_BAR();
#endif
      }
    }
#ifdef TPROBE
#ifndef TPROBE_BLOCK
#define TPROBE_BLOCK 0
#endif
    if (bid0 == TPROBE_BLOCK && wave_s == 0 && lane_id() == 0) a.out[0] += (float)((volatile LAS unsigned*)((LAS unsigned char*)lds + LDSCTL_OFF + 512))[1] * 0.0001f;
#endif
}

extern "C" void kernel_launch(void* const* d_in, const int* in_sizes, int n_in, void* d_out, int out_size, void* d_ws, size_t ws_size, hipStream_t stream) {
    static int grid = 0;
    if (grid == 0) {
        if (n_in != 24 || out_size != MROWS * DM || ws_size < WS_END) { fprintf(stderr, "kernel_launch: unexpected shapes (n_in %d out %d ws %zu)\n", n_in, out_size, ws_size); grid = -1; return; }
        int dev = 0, cus = 0, per_cu = 0;
        hipGetDevice(&dev); hipDeviceGetAttribute(&cus, hipDeviceAttributeMultiprocessorCount, dev);
        if (hipFuncSetAttribute((const void*)mk_fwd, hipFuncAttributeMaxDynamicSharedMemorySize, LDS_BYTES) != hipSuccess) { fprintf(stderr, "kernel_launch: hipFuncSetAttribute failed\n"); grid = -1; return; }
        hipOccupancyMaxActiveBlocksPerMultiprocessor(&per_cu, (const void*)mk_fwd, NWAVES * 64, LDS_BYTES);
        (void)hipGetLastError();
        if (per_cu < 1) { fprintf(stderr, "kernel_launch: occupancy query says %d blocks per CU\n", per_cu); }
        grid = cus;
    }
    if (grid < 0) return;
    hipMemsetAsync((char*)d_ws + WS_CTL, 0, 32768, stream);
    Args a{};
    for (int i = 0; i < 24; ++i) a.in[i] = (const float*)d_in[i];
    a.out = (float*)d_out; a.ws = (unsigned char*)d_ws;
    void* args[] = {&a};
#ifdef PLAIN_LAUNCH
    hipLaunchKernelGGL(mk_fwd, dim3(grid), dim3(NWAVES * 64), LDS_BYTES, stream, a); hipError_t e = hipPeekAtLastError(); (void)args;
#else
    hipError_t e = hipLaunchCooperativeKernel((const void*)mk_fwd, dim3(grid), dim3(NWAVES * 64), args, LDS_BYTES, stream);
#endif
    if (e != hipSuccess) fprintf(stderr, "cooperative launch failed: %s (grid %d)\n", hipGetErrorString(e), grid);
}
```

```cpp
#define PLAIN_LAUNCH 1
#include <hip/hip_runtime.h>
#include <hip/hip_cooperative_groups.h>
#include <stdint.h>
#include <cstdio>
namespace cg = cooperative_groups;

typedef unsigned short bf16_t;
typedef short bf16x8 __attribute__((ext_vector_type(8)));
typedef float f32x4 __attribute__((ext_vector_type(4)));
typedef unsigned u32x4 __attribute__((ext_vector_type(4)));
typedef unsigned u32x2 __attribute__((ext_vector_type(2)));

constexpr int NB = 8, SEQ = 2048, NMETA = 16, LTOT = 2064, DM = 1024, DEPTH = 4, NH = 8, HD = 64;
constexpr int N_IN = 3880, DFF = 2816, DFF2 = 5632;
constexpr int MROWS = NB * SEQ;
constexpr int RROWS = MROWS + NMETA;
constexpr int N1 = 4096;
constexpr int PBW = 3584;
constexpr int PNW = 320;
constexpr float LOG2E = 1.4426950408889634f;

constexpr size_t MiB = 1u << 20;
constexpr size_t WS_CTL = 0, CTL_ZERO_BYTES = 1 * MiB;
constexpr size_t WS_W = 1 * MiB, WL_BYTES = 27 * MiB;
constexpr size_t WO_W1 = 0;
constexpr size_t WO_W2 = 8 * MiB;
constexpr size_t WO_W3 = 10 * MiB;
constexpr size_t WO_W4 = 21 * MiB;
constexpr size_t WO_LUP = 26 * MiB + 512 * 1024;
constexpr size_t WS_SMALL = WS_W + 2 * WL_BYTES;
constexpr size_t WS_HM = WS_SMALL;
constexpr size_t WS_C2 = WS_SMALL + 1 * MiB;
constexpr size_t WS_SSQ = WS_SMALL + 3 * MiB;
constexpr size_t WS_HB = WS_SMALL + 6 * MiB;
constexpr size_t WS_P = WS_HB + 33 * MiB;
constexpr size_t WS_PN = WS_P + 113 * MiB;
constexpr size_t WS_Y = WS_PN + 21 * MiB;
constexpr size_t WS_FREE = WS_Y + 33 * MiB;
constexpr int NCH = 129;
constexpr size_t RA_BYTES = 8192, RB_BYTES = 4096;
constexpr size_t WS_RA = WS_FREE;
#define SWZ4(r) (3 * (((r) >> 3) & 1))
constexpr size_t WS_ACT = WS_P;
constexpr size_t WS_FIX = WS_PN;
constexpr size_t WS_RAWM = WS_PN + 6 * MiB;
constexpr size_t WS_BV = WS_RA + 65 * MiB;
constexpr size_t WS_END = WS_BV + 17 * MiB;

__device__ __forceinline__ float bf2f(bf16_t v) { return __uint_as_float(((unsigned)v) << 16); }
typedef float f32x2_t_ __attribute__((ext_vector_type(2))); typedef __bf16 bf16x2_t_ __attribute__((ext_vector_type(2)));
__device__ __forceinline__ unsigned pk2bf(float lo, float hi) { const f32x2_t_ v = {lo, hi}; return __builtin_bit_cast(unsigned, __builtin_convertvector(v, bf16x2_t_)); }
__device__ __forceinline__ bf16_t f2bf(float f) { return __builtin_bit_cast(bf16_t, (__bf16)f); }
__device__ __forceinline__ float sigmoidf_(float x) { return 1.f / (1.f + __expf(-x)); }
__device__ __forceinline__ float wave_sum_dpp(float v) {
#define DPPF_(x, ctrl, rmask) __int_as_float(__builtin_amdgcn_update_dpp(0, __float_as_int(x), ctrl, rmask, 0xf, false))
    v += DPPF_(v, 0xB1, 0xf);
    v += DPPF_(v, 0x4E, 0xf);
    v += DPPF_(v, 0x141, 0xf);
    v += DPPF_(v, 0x140, 0xf);
    v += DPPF_(v, 0x142, 0xa);
    v += DPPF_(v, 0x143, 0xc);
#undef DPPF_
    return __int_as_float(__builtin_amdgcn_readlane(__float_as_int(v), 63));
}
__device__ __forceinline__ float wave_sum(float v) { return wave_sum_dpp(v); }
__device__ __forceinline__ float wave_max(float v) {
#define DPPF_(x, ctrl, rmask) __int_as_float(__builtin_amdgcn_update_dpp(__float_as_int(x), __float_as_int(x), ctrl, rmask, 0xf, false))
    v = fmaxf(v, DPPF_(v, 0xB1, 0xf)); v = fmaxf(v, DPPF_(v, 0x4E, 0xf)); v = fmaxf(v, DPPF_(v, 0x141, 0xf)); v = fmaxf(v, DPPF_(v, 0x140, 0xf));
    v = fmaxf(v, DPPF_(v, 0x142, 0xa)); v = fmaxf(v, DPPF_(v, 0x143, 0xc));
#undef DPPF_
    return __int_as_float(__builtin_amdgcn_readlane(__float_as_int(v), 63));
}
__device__ __forceinline__ float add_xor16(float x) { const auto r = __builtin_amdgcn_permlane16_swap(__float_as_uint(x), __float_as_uint(x), false, false); return __uint_as_float(r[0]) + __uint_as_float(r[1]); }
__device__ __forceinline__ float add_xor32(float x) { const auto r = __builtin_amdgcn_permlane32_swap(__float_as_uint(x), __float_as_uint(x), false, false); return __uint_as_float(r[0]) + __uint_as_float(r[1]); }
__device__ __forceinline__ int lane_id() { int l; asm volatile("v_mbcnt_lo_u32_b32 %0, -1, 0\n\tv_mbcnt_hi_u32_b32 %0, -1, %0" : "=v"(l)); return l; }
#define WAVE_LDS_SYNC() do { __builtin_amdgcn_s_waitcnt(0xc07f); __builtin_amdgcn_wave_barrier(); } while (0)
__device__ __forceinline__ int rowof(int b, int t) { return t < NMETA ? MROWS + t : b * SEQ + (t - NMETA); }
__device__ __forceinline__ int prevrow(int row) {
    if (row >= MROWS) return row == MROWS ? -1 : row - 1;
    return (row & (SEQ - 1)) ? row - 1 : MROWS + NMETA - 1;
}

#define PERM32(j) (8 * (((j) >> 2) & 3) + 4 * ((j) >> 4) + ((j) & 3))
__device__ __forceinline__ int src_col(int mode, int n) {
    if (mode == 1) {
        const int g = n >> 9, c_ = n & 255, o = (n & 256) + (g < 7 ? ((c_ >> 5) & 3) * 64 + (c_ >> 7) * 32 + PERM32(c_ & 31) : c_);
        switch (g) {
            case 0: return o;
            case 1: return 512 + o;
            case 2: return 1024 + o;
            case 3: return 1824 + o;
            case 4: return 2336 + o;
            case 5: return 2848 + o;
            case 6: return 3360 + o;
            default:
                if (o < 64) return 1536 + o;
                if (o < 128) return 1600 + (o - 64);
                if (o < 288) return 1664 + (o - 128);
                if (o < 296) return 3872 + (o - 288);
                return -1;
        }
    }
    if (mode == 3) { const int t = n >> 8, c = n & 255; return c < 128 ? 128 * t + c : DFF + 128 * t + (c - 128); }
    return (n & ~31) + PERM32(n & 31);
}
__device__ __forceinline__ void wprep_item(const float* W, const float* gk, bf16_t* WT, int K, int Nsrc, int Ndst, int mode, int item, float* scr, int lane) {
    const int nblk = Ndst / 32, kb = item / nblk, nb = item % nblk, k0 = 64 * kb, n0 = 32 * nb;
    const int sc = src_col(mode, n0 + (lane & 31));
    const float* wp = W + (size_t)(k0 + (lane >> 5)) * Nsrc + (sc >= 0 ? sc : 0);
    float v[32];
#pragma unroll
    for (int i = 0; i < 32; ++i) { v[i] = *wp; wp += 2 * (size_t)Nsrc; }
#pragma unroll
    for (int i = 0; i < 32; ++i) scr[(2 * i + (lane >> 5)) * 33 + (lane & 31)] = sc >= 0 ? v[i] : 0.f;
    WAVE_LDS_SYNC();
    const int c = lane & 7;
    f32x4 g0 = (f32x4){1.f, 1.f, 1.f, 1.f}, g1 = g0;
    if (gk) { g0 = *(const f32x4*)(gk + k0 + 8 * c); g1 = *(const f32x4*)(gk + k0 + 8 * c + 4); }
#pragma unroll
    for (int j = 0; j < 4; ++j) {
        const int n = (lane >> 3) + 8 * j; const float* s = scr + (8 * c) * 33 + n;
        u32x4 o;
        o.x = pk2bf(s[0 * 33] * g0[0], s[1 * 33] * g0[1]); o.y = pk2bf(s[2 * 33] * g0[2], s[3 * 33] * g0[3]); o.z = pk2bf(s[4 * 33] * g1[0], s[5 * 33] * g1[1]); o.w = pk2bf(s[6 * 33] * g1[2], s[7 * 33] * g1[3]);
        *(u32x4*)(WT + (size_t)(n0 + n) * K + k0 + 8 * c) = o;
    }
    WAVE_LDS_SYNC();
}
namespace pg8 {
#define PG8_LAS __attribute__((address_space(3)))
typedef unsigned short bf16_t;
typedef short bf16x8 __attribute__((ext_vector_type(8)));
typedef float f32x4 __attribute__((ext_vector_type(4)));
typedef unsigned u32x4 __attribute__((ext_vector_type(4)));
constexpr int BM = 256, BK = 64, HALF = 128, HTB = HALF * BK * 2  , STAGE_BYTES = 8 * HTB, NXCD = 8, WGM = 8;

__host__ __device__ __forceinline__ int lds_byte(int r, int c) { const int st = (r >> 4) * 2 + (c >> 5), rr = r & 15, cc = c & 31, ob = rr * 64 + cc * 2; return st * 1024 + (ob ^ (((ob >> 9) & 1) << 5)); }
__host__ __device__ __forceinline__ void stage_rc(int b, int& R, int& C) { const int st = b / 1024, sb = b % 1024, swz = sb ^ (((sb >> 9) & 1) << 5); R = (st >> 1) * 16 + swz / 64; C = (st & 1) * 32 + (swz % 64) / 2; }
__host__ __device__ __forceinline__ int perm32(int rho) { const int n = rho >> 4, i = rho & 15; return 8 * (i >> 2) + 4 * n + (i & 3); }

struct Unit { int pm, pn, idx; };
struct Gemm { const bf16_t* A; const bf16_t* Bt; int M, N, K; };

struct StaticOrder {
    int nM, nN, nwg, G, c;
    __host__ __device__ void init(int M, int N, int G_, int c_) { nM = M / BM; nN = N / BM; nwg = nM * nN; G = G_; c = c_; }
    __host__ __device__ bool next(int i, Unit& u) const {
        const long L = (long)i * G + c; if (L >= nwg) return false;
        int wgid = (int)L; { const int q = nwg / NXCD, r = nwg % NXCD, xcd = wgid % NXCD, off = wgid / NXCD; wgid = (xcd < r ? xcd * (q + 1) : r * (q + 1) + (xcd - r) * q) + off; }
        const int nig = WGM * nN, gid = wgid / nig, fm = gid * WGM, gsz = (nM - fm) < WGM ? (nM - fm) : WGM;
        u.pm = fm + ((wgid % nig) % gsz); u.pn = (wgid % nig) / gsz; u.idx = i; return true;
    }
    __device__ __forceinline__ void a_ready(const Unit&) const {}
    __device__ __forceinline__ void done(const Unit&) const {}
};

__device__ __forceinline__ float row_rstd(const float* ssqp, int row) {
    const f32x4* sp = (const f32x4*)(ssqp + (size_t)row * 16);
    const f32x4 a = sp[0], b = sp[1], c = sp[2], d = sp[3];
    const float s = (((a.x + a.y) + (a.z + a.w)) + ((b.x + b.y) + (b.z + b.w))) + (((c.x + c.y) + (c.z + c.w)) + ((d.x + d.y) + (d.z + d.w)));
    return 1.0f / sqrtf(s * (1.f / 1024.f) + 1e-6f);
}
struct Epi1 {
    static constexpr bool PERM = false, AFTER_DRAIN = false;
    const PG8_LAS float* rstdl; bf16_t* p; float* pn; const float* q_g; const float* k_g;
    __device__ __forceinline__ void operator()(const f32x4 (&acc)[2][2][4][2], const Unit& u, int wr, int wc, int fr, int fq) const {
        const int row0 = u.pm * BM + wr * 64 + fr;
        const bool isq = (u.pn >> 1) == 3, isk = (u.pn >> 1) == 4;
        f32x4 gsc[2][2];
        if (isq || isk) {
#pragma unroll
            for (int bj = 0; bj < 2; ++bj)
#pragma unroll
                for (int n = 0; n < 2; ++n) gsc[bj][n] = *(const f32x4*)((isq ? q_g : k_g) + 32 * bj + 8 * fq + 4 * n) * (isq ? 0.125f * 1.4426950408889634f : 1.f);
        }
#pragma unroll
        for (int ai = 0; ai < 2; ++ai)
#pragma unroll
            for (int m = 0; m < 4; ++m) {
                const int row = row0 + ai * HALF + m * 16; const float rs = rstdl[u.idx * 256 + wr * 64 + fr + ai * HALF + m * 16];
                f32x4 v[2][2];
#pragma unroll
                for (int bj = 0; bj < 2; ++bj)
#pragma unroll
                    for (int n = 0; n < 2; ++n) v[bj][n] = acc[ai][bj][m][n] * rs;
                if (u.pn < 14) {
                    if (isq || isk) {
                        float ss = 0.f;
#pragma unroll
                        for (int bj = 0; bj < 2; ++bj)
#pragma unroll
                            for (int n = 0; n < 2; ++n) ss += (v[bj][n][0] * v[bj][n][0] + v[bj][n][1] * v[bj][n][1]) + (v[bj][n][2] * v[bj][n][2] + v[bj][n][3] * v[bj][n][3]);
                        ss = add_xor16(ss); ss = add_xor32(ss);
                        const float rn = 1.0f / sqrtf(ss * (1.f / 64.f) + 1e-6f);
#pragma unroll
                        for (int bj = 0; bj < 2; ++bj)
#pragma unroll
                            for (int n = 0; n < 2; ++n) v[bj][n] = v[bj][n] * gsc[bj][n] * rn;
                    }
#pragma unroll
                    for (int bj = 0; bj < 2; ++bj) { u32x4 w; w.x = pk2bf(v[bj][0][0], v[bj][0][1]); w.y = pk2bf(v[bj][0][2], v[bj][0][3]); w.z = pk2bf(v[bj][1][0], v[bj][1][1]); w.w = pk2bf(v[bj][1][2], v[bj][1][3]);
                        *(u32x4*)(p + (size_t)row * PBW + u.pn * BM + wc * 64 + bj * 32 + 8 * fq) = w; }
                } else {
#pragma unroll
                    for (int bj = 0; bj < 2; ++bj)
#pragma unroll
                        for (int n = 0; n < 2; ++n) { const int o = u.pn * BM + wc * 32 + 4 * fq + bj * HALF + n * 16 - PBW; if (o < 296) *(f32x4*)(pn + (size_t)row * PNW + o) = v[bj][n]; }
                }
            }
    }
};
struct EpiRes {
    static constexpr bool PERM = false, AFTER_DRAIN = false;
    float* outp; bf16_t* hb; float* ssqp;
    __device__ __forceinline__ void operator()(const f32x4 (&acc)[2][2][4][2], const Unit& u, int wr, int wc, int fr, int fq) const {
        const int row0 = u.pm * BM + wr * 64 + fr, col0 = u.pn * BM + wc * 32 + 8 * fq;
#pragma unroll
        for (int ai = 0; ai < 2; ++ai) {
            u32x4 hw[4][2];
#pragma unroll
            for (int m = 0; m < 4; ++m)
#pragma unroll
                for (int bj = 0; bj < 2; ++bj) hw[m][bj] = *(const u32x4*)(hb + (size_t)(row0 + ai * HALF + m * 16) * DM + col0 + bj * HALF);
            asm volatile("s_waitcnt vmcnt(0)" ::: "memory");
#pragma unroll
            for (int m = 0; m < 4; ++m) {
                const int row = row0 + ai * HALF + m * 16; float ss = 0.f;
#pragma unroll
                for (int bj = 0; bj < 2; ++bj) {
                    const int col = col0 + bj * HALF; bf16_t* hp = hb + (size_t)row * DM + col;
                    const u32x4 h4 = hw[m][bj];
                    const f32x4 v0 = (f32x4){__uint_as_float(h4.x << 16), __uint_as_float(h4.x & 0xffff0000u), __uint_as_float(h4.y << 16), __uint_as_float(h4.y & 0xffff0000u)} + acc[ai][bj][m][0];
                    const f32x4 v1 = (f32x4){__uint_as_float(h4.z << 16), __uint_as_float(h4.z & 0xffff0000u), __uint_as_float(h4.w << 16), __uint_as_float(h4.w & 0xffff0000u)} + acc[ai][bj][m][1];
                    u32x4 w; w.x = pk2bf(v0[0], v0[1]); w.y = pk2bf(v0[2], v0[3]); w.z = pk2bf(v1[0], v1[1]); w.w = pk2bf(v1[2], v1[3]);
                    *(u32x4*)hp = w;
                    if (outp) { *(f32x4*)(outp + (size_t)row * DM + col) = v0; *(f32x4*)(outp + (size_t)row * DM + col + 4) = v1; }
                    const f32x4 r0 = (f32x4){__uint_as_float(w.x << 16), __uint_as_float(w.x & 0xffff0000u), __uint_as_float(w.y << 16), __uint_as_float(w.y & 0xffff0000u)};
                    const f32x4 r1 = (f32x4){__uint_as_float(w.z << 16), __uint_as_float(w.z & 0xffff0000u), __uint_as_float(w.w << 16), __uint_as_float(w.w & 0xffff0000u)};
                    ss += ((r0[0] * r0[0] + r0[1] * r0[1]) + (r0[2] * r0[2] + r0[3] * r0[3])) + ((r1[0] * r1[0] + r1[1] * r1[1]) + (r1[2] * r1[2] + r1[3] * r1[3]));
                }
                ss = add_xor16(ss); ss = add_xor32(ss);
                if (fq == 0) ssqp[(size_t)row * 16 + u.pn * 4 + wc] = ss;
            }
        }
    }
};
__device__ __forceinline__ float dpp_ror1(float x) { return __int_as_float(__builtin_amdgcn_mov_dpp(__float_as_int(x), 0x121, 0xf, 0xf, true)); }
__device__ __forceinline__ float dpp_ror2(float x) { return __int_as_float(__builtin_amdgcn_mov_dpp(__float_as_int(x), 0x122, 0xf, 0xf, true)); }
__device__ __forceinline__ float vmul_s(float a, float b) { float r; asm volatile("v_mul_f32_e32 %0, %1, %2" : "=v"(r) : "v"(a), "v"(b)); return r; }
struct EpiConv {
    static constexpr bool PERM = false, AFTER_DRAIN = false;
    const PG8_LAS float* rstdl; const float* cw; const float* cb; bf16_t* act; float* fix; PG8_LAS unsigned char* halo; PG8_LAS float* ctab;
    __device__ __forceinline__ void operator()(const f32x4 (&acc)[2][2][4][2], const Unit& u, int wr, int wc, int fr_, int fq_) const {
        int fr = fr_, fq = fq_; asm volatile("" : "+v"(fr), "+v"(fq));
        const int row0 = u.pm * BM + wr * 64 + fr, cl = wc * 32 + 4 * fq;
        {
            const int q = 2 * ((wr * 4 + wc) * 64 + fq * 16 + fr), p = q >> 8, col = q & 255;
            const float* src = (p < 3 ? cw + (size_t)p * DFF2 : cb) + (col < 128 ? 128 * u.pn + col : DFF + 128 * u.pn + (col - 128));
            typedef float f32x2w __attribute__((ext_vector_type(2)));
            *(PG8_LAS f32x2w*)(ctab + q) = *(const f32x2w*)src;
        }
        float rs[2][4];
#pragma unroll
        for (int ai = 0; ai < 2; ++ai)
#pragma unroll
            for (int m = 0; m < 4; ++m) rs[ai][m] = rstdl[u.idx * 256 + wr * 64 + fr + ai * HALF + m * 16];
        if (fr >= 14) {
#pragma unroll
            for (int ai = 0; ai < 2; ++ai)
#pragma unroll
                for (int bj = 0; bj < 2; ++bj)
#pragma unroll
                    for (int n = 0; n < 2; ++n) { const f32x4 v = acc[ai][bj][3][n] * rs[ai][3];
                        *(PG8_LAS f32x4*)(halo + ((((ai * 2 + wr) * 2 + (fr - 14)) * 256) + bj * HALF + cl + n * 16) * 4) = v;
                        if (ai == 1 && wr == 1) *(f32x4*)(fix + (size_t)(u.pm * 4 + 2 + (fr - 14)) * DFF2 + bj * DFF + 128 * u.pn + cl + n * 16) = v; }
        }
        if (fr < 2 && wr == 0) {
#pragma unroll
            for (int bj = 0; bj < 2; ++bj)
#pragma unroll
                for (int n = 0; n < 2; ++n) *(f32x4*)(fix + (size_t)(u.pm * 4 + fr) * DFF2 + bj * DFF + 128 * u.pn + cl + n * 16) = acc[0][bj][0][n] * rs[0][0];
        }
        asm volatile("s_waitcnt lgkmcnt(0)\n\ts_barrier" ::: "memory");
        typedef float f32x2v __attribute__((ext_vector_type(2)));
#pragma unroll
        for (int n = 0; n < 2; ++n) {
            const unsigned la2 = (unsigned)(fr * DFF + cl) * 2u;
            unsigned wpk[2][2][4];
#pragma unroll
            for (int eh = 0; eh < 2; ++eh) {
                asm volatile("" ::: "memory"); __builtin_amdgcn_sched_barrier(0);
                const int e = 2 * eh;
#define CWL(p, g) (*(const PG8_LAS f32x2v*)(ctab + (p) * 256 + (g) * 128 + cl + n * 16 + e))
                const f32x2v wu0 = CWL(0, 0), wu1 = CWL(1, 0), wu2 = CWL(2, 0), bu = CWL(3, 0);
                const f32x2v wg0 = CWL(0, 1), wg1 = CWL(1, 1), wg2 = CWL(2, 1), bg = CWL(3, 1);
#undef CWL
#pragma unroll
                for (int ai = 0; ai < 2; ++ai) {
                    const int ps = (ai * 2 + wr) ? (ai * 2 + wr - 1) : 0;
                    const PG8_LAS float* hp = (const PG8_LAS float*)halo + (ps * 2) * 256 + cl + n * 16 + e;
                    const f32x2v hu62 = *(const PG8_LAS f32x2v*)hp, hu63 = *(const PG8_LAS f32x2v*)(hp + 256), hg62 = *(const PG8_LAS f32x2v*)(hp + 128), hg63 = *(const PG8_LAS f32x2v*)(hp + 256 + 128);
                    f32x2v p1u = hu63, p1g = hg63, p2u = fr == 0 ? hu62 : hu63, p2g = fr == 0 ? hg62 : hg63;
#pragma unroll
                    for (int m = 0; m < 4; ++m) {
                        __builtin_amdgcn_sched_barrier(0);
                        f32x2v xu, xg;
                        xu.x = vmul_s(acc[ai][0][m][n][e], rs[ai][m]); xu.y = vmul_s(acc[ai][0][m][n][e + 1], rs[ai][m]); xg.x = vmul_s(acc[ai][1][m][n][e], rs[ai][m]); xg.y = vmul_s(acc[ai][1][m][n][e + 1], rs[ai][m]);
                        f32x2v r1u, r2u, r1g, r2g;
                        r1u.x = dpp_ror1(xu.x); r1u.y = dpp_ror1(xu.y); r2u.x = dpp_ror2(xu.x); r2u.y = dpp_ror2(xu.y);
                        r1g.x = dpp_ror1(xg.x); r1g.y = dpp_ror1(xg.y); r2g.x = dpp_ror2(xg.x); r2g.y = dpp_ror2(xg.y);
                        const f32x2v x1u = fr >= 1 ? r1u : p1u, x2u = fr >= 2 ? r2u : p2u, x1g = fr >= 1 ? r1g : p1g, x2g = fr >= 2 ? r2g : p2g;
                        p1u = r1u; p2u = r2u; p1g = r1g; p2g = r2g;
                        const f32x2v cu = bu + wu0 * x2u + wu1 * x1u + wu2 * xu, cg = bg + wg0 * x2g + wg1 * x1g + wg2 * xg;
                        const float o0 = cg.x * __builtin_amdgcn_rcpf(1.f + __builtin_amdgcn_exp2f(-1.4426950408889634f * cg.x)) * cu.x;
                        const float o1 = cg.y * __builtin_amdgcn_rcpf(1.f + __builtin_amdgcn_exp2f(-1.4426950408889634f * cg.y)) * cu.y;
                        wpk[eh][ai][m] = pk2bf(o0, o1);
                    }
                }
            }
#pragma unroll
            for (int ai = 0; ai < 2; ++ai)
#pragma unroll
                for (int m = 0; m < 4; ++m)
                {
                    u32x2 w; w.x = wpk[0][ai][m]; w.y = wpk[1][ai][m];
                    *(u32x2*)((char*)(act + (size_t)(u.pm * BM + wr * 64 + ai * HALF + m * 16) * DFF + 128 * u.pn + n * 16) + la2) = w; }
        }
    }
};

#ifdef TPROBE
#ifndef TPROBE_PH
#define TPROBE_PH -1
#endif
#define PG8_TP(ph) do { if (TPROBE < 20) break; const unsigned t_ = (unsigned)__builtin_amdgcn_s_memrealtime(); if (wave_s == 0 && lane_id() == 0) { volatile PG8_LAS unsigned* q_ = (volatile PG8_LAS unsigned*)(lds + (163840 - 1024 + 512)); \
        if ((ph) == TPROBE && (TPROBE_PH < 0 || q_[2] == (unsigned)TPROBE_PH)) q_[1] += t_ - q_[0]; q_[0] = t_; } } while (0)
#else
#define PG8_TP(ph) do {} while (0)
#endif
template <class Epi, class Sched, bool ALIGN_EPI = false, bool SP2 = false>
__device__ __forceinline__ void gemm_phase(PG8_LAS unsigned char* lds, const Gemm g, const Sched& S, const Epi& E, const int wave_s) {
    int tid_ = wave_s * 64 + lane_id(); asm volatile("" : "+v"(tid_));
    const int tid = tid_, wid = wave_s, lane = tid & 63, wr = wid >> 2, wc = wid & 3, fr = lane & 15, fq = lane >> 4;
    const int K = g.K, nt = K / BK;
    unsigned voffA[2], voffB[2];
#pragma unroll
    for (int i = 0; i < 2; ++i) { int R, C; stage_rc(tid * 16 + i * 8192, R, C); const int Rb = Epi::PERM ? ((R & ~31) + perm32(R & 31)) : R;
        voffA[i] = (unsigned)(R * K + C) * 2u; voffB[i] = (unsigned)(Rb * K + C) * 2u; }
    const size_t kstep = (size_t)(BK * 2);
    const size_t hstep = (size_t)HALF * K * 2;
    const size_t tstep = 2 * hstep;
    const unsigned ldsw = (unsigned)wid * 1024u;
    const int aoff = lds_byte(wr * 64 + fr, fq * 8), boff = lds_byte(wc * 32 + fr, fq * 8);
#define PG8_SA(b, h) (((b) * 2 + (h)) * HTB)
#define PG8_SB(b, h) ((4 + (b) * 2 + (h)) * HTB)
#define PG8_STAGE(bufoff, gbase, voff) do { _Pragma("unroll") for (int _i = 0; _i < 2; ++_i) \
        __builtin_amdgcn_global_load_lds((const unsigned*)((const char*)(gbase) + (voff)[_i]), (PG8_LAS unsigned*)(lds + (bufoff) + ldsw + _i * 8192), 16, 0, 0); } while (0)
#define PG8_LDA(dst, b, h) do { _Pragma("unroll") for (int m = 0; m < 4; ++m) _Pragma("unroll") for (int k = 0; k < 2; ++k) dst[m][k] = *(const PG8_LAS bf16x8*)(lds + PG8_SA(b, h) + aoff + m * 2048 + k * 1024); } while (0)
#define PG8_LDB(dst, b, h) do { _Pragma("unroll") for (int n = 0; n < 2; ++n) _Pragma("unroll") for (int k = 0; k < 2; ++k) dst[n][k] = *(const PG8_LAS bf16x8*)(lds + PG8_SB(b, h) + boff + n * 2048 + k * 1024); } while (0)
#define PG8_MMA(ai, bj, At, Bt) do { __builtin_amdgcn_s_setprio(1); _Pragma("unroll") for (int m = 0; m < 4; ++m) _Pragma("unroll") for (int n = 0; n < 2; ++n) _Pragma("unroll") for (int k = 0; k < 2; ++k) \
        acc[ai][bj][m][n] = __builtin_amdgcn_mfma_f32_16x16x32_bf16(Bt[n][k], At[m][k], acc[ai][bj][m][n], 0, 0, 0); __builtin_amdgcn_s_setprio(0); } while (0)
#define PG8_WAIT_V(n) asm volatile("s_waitcnt vmcnt(" #n ")" ::: "memory")
#define PG8_WAIT_L(n) asm volatile("s_waitcnt lgkmcnt(" #n ")" ::: "memory")
#define PG8_BAR __builtin_amdgcn_s_barrier()
#define PG8_SCHED __builtin_amdgcn_sched_barrier(0)
    Unit cur, nxt; int ui = 0;
    if (!S.next(0, cur)) return;
    f32x4 acc[2][2][4][2];
#pragma unroll
    for (int a = 0; a < 2; ++a)
#pragma unroll
        for (int b = 0; b < 2; ++b)
#pragma unroll
            for (int m = 0; m < 4; ++m)
#pragma unroll
                for (int n = 0; n < 2; ++n) acc[a][b][m][n] = (f32x4){0.f, 0.f, 0.f, 0.f};
    bf16x8 At[4][2], B0[2][2], B1[2][2];
    const char* cA = (const char*)g.A + (size_t)cur.pm * tstep; const char* cB = (const char*)g.Bt + (size_t)cur.pn * tstep;
    S.a_ready(cur);
    if constexpr (SP2) {
        PG8_STAGE(PG8_SB(0, 0), cB, voffB); PG8_STAGE(PG8_SB(0, 1), cB + hstep, voffB); PG8_STAGE(PG8_SA(0, 0), cA, voffA); PG8_STAGE(PG8_SA(0, 1), cA + hstep, voffA);
        if (wr == 1) PG8_BAR;
        PG8_WAIT_V(2); PG8_BAR;
        PG8_STAGE(PG8_SB(1, 0), cB + kstep, voffB); PG8_STAGE(PG8_SA(1, 0), cA + kstep, voffA); PG8_STAGE(PG8_SB(1, 1), cB + hstep + kstep, voffB);
        PG8_WAIT_V(6); PG8_BAR;
    } else {
        PG8_STAGE(PG8_SB(0, 0), cB, voffB); PG8_STAGE(PG8_SA(0, 0), cA, voffA); PG8_STAGE(PG8_SB(0, 1), cB + hstep, voffB); PG8_STAGE(PG8_SA(0, 1), cA + hstep, voffA);
        if (wr == 1) PG8_BAR;
        PG8_WAIT_V(4); PG8_BAR;
        PG8_STAGE(PG8_SB(1, 0), cB + kstep, voffB); PG8_STAGE(PG8_SA(1, 0), cA + kstep, voffA); PG8_STAGE(PG8_SB(1, 1), cB + hstep + kstep, voffB);
        PG8_WAIT_V(6); PG8_BAR;
    }
    for (;;) {
        const bool has_next = S.next(ui + 1, nxt);
        const char* nA = has_next ? (const char*)g.A + (size_t)nxt.pm * tstep : cA; const char* nB = has_next ? (const char*)g.Bt + (size_t)nxt.pn * tstep : cB;
        for (int t = 0; t < nt; t += 2) {
            const bool last = (t == nt - 2);
            const char* a1 = cA + (size_t)(t + 1) * kstep;
            const char* a2 = last ? nA : cA + (size_t)(t + 2) * kstep; const char* b2 = last ? nB : cB + (size_t)(t + 2) * kstep;
            const char* a3 = a2 + kstep; const char* b3 = b2 + kstep;
            if (last && has_next) S.a_ready(nxt);
            if constexpr (SP2) {
            PG8_LDB(B0, 0, 0); PG8_LDB(B1, 0, 1); PG8_SCHED; PG8_LDA(At, 0, 0); PG8_STAGE(PG8_SA(1, 1), a1 + hstep, voffA);
            PG8_WAIT_V(8); PG8_WAIT_L(0); PG8_BAR; PG8_MMA(0, 0, At, B0); PG8_MMA(0, 1, At, B1); PG8_BAR; PG8_SCHED;
            PG8_LDA(At, 0, 1); PG8_STAGE(PG8_SB(0, 0), b2, voffB); PG8_STAGE(PG8_SB(0, 1), b2 + hstep, voffB); PG8_STAGE(PG8_SA(0, 0), a2, voffA);
            PG8_WAIT_V(8); PG8_WAIT_L(0); PG8_BAR; PG8_MMA(1, 0, At, B0); PG8_MMA(1, 1, At, B1); PG8_BAR; PG8_SCHED;
            PG8_LDB(B0, 1, 0); PG8_LDB(B1, 1, 1); PG8_SCHED; PG8_LDA(At, 1, 0); PG8_STAGE(PG8_SA(0, 1), a2 + hstep, voffA);
            PG8_WAIT_V(8); PG8_WAIT_L(0); PG8_BAR; PG8_MMA(0, 0, At, B0); PG8_MMA(0, 1, At, B1); PG8_BAR; PG8_SCHED;
            PG8_LDA(At, 1, 1); PG8_STAGE(PG8_SB(1, 0), b3, voffB); PG8_STAGE(PG8_SB(1, 1), b3 + hstep, voffB); PG8_STAGE(PG8_SA(1, 0), a3, voffA);
            PG8_WAIT_V(8); PG8_WAIT_L(0); PG8_BAR; PG8_MMA(1, 0, At, B0); PG8_MMA(1, 1, At, B1); PG8_BAR; PG8_SCHED;
            } else {
            PG8_LDB(B0, 0, 0); PG8_SCHED; PG8_LDA(At, 0, 0); PG8_STAGE(PG8_SA(1, 1), a1 + hstep, voffA);
            PG8_WAIT_L(8); PG8_BAR; PG8_WAIT_L(0); PG8_MMA(0, 0, At, B0); PG8_BAR; PG8_SCHED;
            PG8_LDB(B1, 0, 1); PG8_STAGE(PG8_SB(0, 0), b2, voffB);
            PG8_BAR; PG8_WAIT_L(0); PG8_MMA(0, 1, At, B1); PG8_BAR;
            PG8_LDA(At, 0, 1); PG8_STAGE(PG8_SA(0, 0), a2, voffA);
            PG8_BAR; PG8_WAIT_L(0); PG8_MMA(1, 0, At, B0); PG8_BAR; PG8_SCHED;
            PG8_STAGE(PG8_SB(0, 1), b2 + hstep, voffB);
            PG8_WAIT_V(6); PG8_BAR; PG8_MMA(1, 1, At, B1); PG8_BAR;
            PG8_LDB(B0, 1, 0); PG8_SCHED; PG8_LDA(At, 1, 0); PG8_STAGE(PG8_SA(0, 1), a2 + hstep, voffA);
            PG8_WAIT_L(8); PG8_BAR; PG8_WAIT_L(0); PG8_MMA(0, 0, At, B0); PG8_BAR; PG8_SCHED;
            PG8_LDB(B1, 1, 1); PG8_STAGE(PG8_SB(1, 0), b3, voffB);
            PG8_BAR; PG8_WAIT_L(0); PG8_MMA(0, 1, At, B1); PG8_BAR;
            PG8_LDA(At, 1, 1); PG8_STAGE(PG8_SA(1, 0), a3, voffA);
            PG8_BAR; PG8_WAIT_L(0); PG8_MMA(1, 0, At, B0); PG8_BAR; PG8_SCHED;
            PG8_STAGE(PG8_SB(1, 1), b3 + hstep, voffB);
            PG8_WAIT_V(6); PG8_BAR; PG8_MMA(1, 1, At, B1); PG8_BAR;
            }
        }
        PG8_TP(49);
        if constexpr (ALIGN_EPI) { if (wr == 0) PG8_BAR; }
        if constexpr (!Epi::AFTER_DRAIN) { E(acc, cur, wr, wc, fr, fq); S.done(cur); }
        PG8_TP(50);
        if (!has_next) break;
#pragma unroll
        for (int a = 0; a < 2; ++a)
#pragma unroll
            for (int b = 0; b < 2; ++b)
#pragma unroll
                for (int m = 0; m < 4; ++m)
#pragma unroll
                    for (int n = 0; n < 2; ++n) acc[a][b][m][n] = (f32x4){0.f, 0.f, 0.f, 0.f};
        cur = nxt; cA = nA; cB = nB; ++ui;
        if constexpr (ALIGN_EPI) { if (wr == 1) PG8_BAR; }
    }
    PG8_WAIT_V(0);
    if constexpr (!ALIGN_EPI) { if (wr == 0) PG8_BAR; }
    PG8_BAR;
    if constexpr (Epi::AFTER_DRAIN) { E.fused(acc, cur, wr, wc, fr, fq, lds, wid, lane); S.done(cur); }
#undef PG8_SA
#undef PG8_SB
#undef PG8_STAGE
#undef PG8_LDA
#undef PG8_LDB
#undef PG8_MMA
#undef PG8_WAIT_V
#undef PG8_WAIT_L
#undef PG8_BAR
#undef PG8_SCHED
}
}
#include <hip/hip_bf16.h>
#include <cmath>
namespace attn_body {
using bf16=__hip_bfloat16;
using bf16x8=__attribute__((ext_vector_type(8)))short;
using s16x4=__attribute__((ext_vector_type(4)))short;
using f32x16=__attribute__((ext_vector_type(16)))float;
using u32x4=__attribute__((ext_vector_type(4)))unsigned;
constexpr int BATCH=8,NHEAD=8,SEQ=2048,D=64,PITCH=3584,OPITCH=1024,LEADROW=16384,VK=2176;
constexpr int NW=8,QBLK=32,QB=QBLK*NW,KVBLK=64,NQB=SEQ/QB;
constexpr int ATTN_UNIT_ROWS=QB;
__device__ __forceinline__ int crow(int r,int hi){return (r&3)+8*(r>>2)+4*hi;}
#define SBAR() __builtin_amdgcn_sched_barrier(0)
__device__ __forceinline__ void cmask(f32x16&p0,f32x16&p1,int jb,int qrel,int hi){
  const float NEG=-INFINITY; int kb=64*jb+4*hi;
  #pragma unroll
  for(int r=0;r<16;++r){int kv=kb+(r&3)+8*(r>>2); if(kv>qrel)p0[r]=NEG; if(kv+32>qrel)p1[r]=NEG;}
}

constexpr int NSLOT=3, SLOTB=8192;
constexpr int LDS_K=0, LDS_V=NSLOT*SLOTB, LDS_WS=2*NSLOT*SLOTB, LDS_OST=LDS_WS+NW*64*4, LDS_C2=LDS_OST+NW*4096, LDS_BYTES=LDS_C2+VK*4;
constexpr float C2=0.125f*1.4426950408889634f;
__device__ __forceinline__ void glds16(const void*gsrc,unsigned lds_dst){unsigned keep;
  asm volatile("s_mov_b32 %0, m0\n\ts_mov_b32 m0, %2\n\ts_nop 0\n\tglobal_load_lds_dwordx4 %1, off\n\ts_mov_b32 m0, %0":"=&s"(keep):"v"(gsrc),"s"(lds_dst):"memory");}
__device__ __forceinline__ float max3f(float a,float b,float c){float r;asm("v_max3_f32 %0, %1, %2, %3":"=v"(r):"v"(a),"v"(b),"v"(c));return r;}
__device__ __forceinline__ float max2f(float a,float b){float r;asm("v_max_f32_e32 %0, %1, %2":"=v"(r):"v"(a),"v"(b));return r;}
__device__ __forceinline__ float fadd_s(float a,float b){float r;asm("v_add_f32_e32 %0, %1, %2":"=v"(r):"v"(a),"v"(b));return r;}
__device__ __forceinline__ float fsub_s(float a,float b){float r;asm("v_sub_f32_e32 %0, %1, %2":"=v"(r):"v"(a),"v"(b));return r;}
typedef float f32x2_t __attribute__((ext_vector_type(2))); typedef __bf16 bf16x2_t __attribute__((ext_vector_type(2)));
__device__ __forceinline__ unsigned cvtpk_s(float lo,float hi){f32x2_t v={lo,hi};bf16x2_t b=__builtin_convertvector(v,bf16x2_t);return __builtin_bit_cast(unsigned,b);}
#define WAIT_BAR(N) asm volatile("s_waitcnt vmcnt(" #N ") lgkmcnt(0)\n\ts_barrier":::"memory")

__device__ __forceinline__ void qkt(f32x16&p0,f32x16&p1,const char*Kslot,const bf16x8*qr,int r32,int hi){
  const char*kb=Kslot+hi*1024+r32*16;
  #pragma unroll
  for(int d0=0;d0<4;++d0){
    const bf16x8 b0=*reinterpret_cast<const bf16x8*>(kb+d0*2048);
    const bf16x8 b1=*reinterpret_cast<const bf16x8*>(kb+d0*2048+512);
    p0=__builtin_amdgcn_mfma_f32_32x32x16_bf16(b0,qr[d0],p0,0,0,0);p1=__builtin_amdgcn_mfma_f32_32x32x16_bf16(b1,qr[d0],p1,0,0,0);}
}
typedef __attribute__((address_space(3))) const char* lds_cptr;
typedef short v4i16_t __attribute__((ext_vector_type(4)));
__device__ __forceinline__ void kload8(bf16x8*kf,lds_cptr kp){
  kf[0]=*(const __attribute__((address_space(3))) bf16x8*)(kp);      kf[1]=*(const __attribute__((address_space(3))) bf16x8*)(kp+512);
  kf[2]=*(const __attribute__((address_space(3))) bf16x8*)(kp+2048); kf[3]=*(const __attribute__((address_space(3))) bf16x8*)(kp+2560);
  kf[4]=*(const __attribute__((address_space(3))) bf16x8*)(kp+4096); kf[5]=*(const __attribute__((address_space(3))) bf16x8*)(kp+4608);
  kf[6]=*(const __attribute__((address_space(3))) bf16x8*)(kp+6144); kf[7]=*(const __attribute__((address_space(3))) bf16x8*)(kp+6656);
}
__device__ __forceinline__ void kload2(bf16x8*kf,lds_cptr kp,int j){ kf[2*j]=*(const __attribute__((address_space(3))) bf16x8*)(kp+j*2048); kf[2*j+1]=*(const __attribute__((address_space(3))) bf16x8*)(kp+j*2048+512); }
__device__ __forceinline__ s16x4 vtr(lds_cptr p){ return __builtin_bit_cast(s16x4,__builtin_amdgcn_ds_read_tr16_b64_v4i16((__attribute__((address_space(3))) v4i16_t*)p)); }
__device__ __forceinline__ float rowmax(const f32x16&p0,const f32x16&p1){
  float a=max3f(p0[0],p0[1],p1[0]),b=max3f(p0[2],p0[3],p1[1]);a=max3f(a,p1[2],p1[3]);
  #pragma unroll
  for(int r=4;r<16;r+=4){a=max3f(a,p0[r],p0[r+1]);b=max3f(b,p0[r+2],p0[r+3]);a=max3f(a,p1[r],p1[r+1]);b=max3f(b,p1[r+2],p1[r+3]);}
  const float m=max2f(a,b);
  auto rr=__builtin_amdgcn_permlane32_swap(__float_as_uint(m),__float_as_uint(m),false,false);
  return max2f(__uint_as_float(rr[0]),__uint_as_float(rr[1]));
}
__device__ __forceinline__ void pv(f32x16*o,int vb,bf16x8 pa0,bf16x8 pa1,bf16x8 pa2,bf16x8 pa3){
  #pragma unroll
  for(int d0=0;d0<2;++d0){s16x4 lo[4],hi[4];
    #pragma unroll
    for(int ks=0;ks<4;++ks){
      asm volatile("ds_read_b64_tr_b16 %0,%1 offset:%c2":"=&v"(lo[ks]):"v"(vb),"i"(d0*4096+ks*1024):"memory");
      asm volatile("ds_read_b64_tr_b16 %0,%1 offset:%c2":"=&v"(hi[ks]):"v"(vb),"i"(d0*4096+ks*1024+512):"memory");}
    asm volatile("s_waitcnt lgkmcnt(0)":::"memory");SBAR();
    #define PK(k) (bf16x8){lo[k][0],lo[k][1],lo[k][2],lo[k][3],hi[k][0],hi[k][1],hi[k][2],hi[k][3]}
    o[d0]=__builtin_amdgcn_mfma_f32_32x32x16_bf16(pa0,PK(0),o[d0],0,0,0);
    o[d0]=__builtin_amdgcn_mfma_f32_32x32x16_bf16(pa1,PK(1),o[d0],0,0,0);
    o[d0]=__builtin_amdgcn_mfma_f32_32x32x16_bf16(pa2,PK(2),o[d0],0,0,0);
    o[d0]=__builtin_amdgcn_mfma_f32_32x32x16_bf16(pa3,PK(3),o[d0],0,0,0);
    #undef PK
  }
}

#ifndef ATTN_STORE16
#define ATTN_STORE16(p,v) (*(u32x4*)(p)=(v))
#endif
template<int THRL> __device__ __forceinline__ void attn_unit(int b,int h,int qb,const bf16*Q,const bf16*__restrict__ K,const bf16*__restrict__ V,const bf16*__restrict__ OG,const float*__restrict__ c2v,bf16*O,char*shm,const int wave_s,const bool stage_c2=true){
  int tid_=wave_s*64+lane_id(); asm volatile("":"+v"(tid_));
  const int tid=tid_,lane=tid&63,r32=lane&31,hi=lane>>5; const int wid=wave_s;
  const long rowbase=(long)b*SEQ; const int q0=qb*QB;
  const bf16*Qw=Q+(rowbase+q0+wid*QBLK)*PITCH+h*D;
  const bf16*Kh=K+(rowbase-2*KVBLK)*PITCH+h*D,*Vh=V+(rowbase-2*KVBLK)*PITCH+h*D;
  const bf16*KhL=K+(long)LEADROW*PITCH+h*D,*VhL=V+(long)LEADROW*PITCH+h*D;
  const unsigned lds0=(unsigned)(uintptr_t)shm;
  float*wsf=(float*)(shm+LDS_WS)+wid*64;
  const bf16*ksrc=Kh+(long)lane*PITCH+wid*8,*ksrcL=KhL+(long)lane*PITCH+wid*8;
  const bf16*vsrc=Vh+(long)(16*(wid&3)+(lane>>2))*PITCH+(wid>>2)*32+(lane&3)*8,*vsrcL=VhL+(long)(16*(wid&3)+(lane>>2))*PITCH+(wid>>2)*32+(lane&3)*8;
  const unsigned kdst=lds0+LDS_K+wid*1024, vdst=lds0+LDS_V+wid*1024;
  #define DMA_K(t,slot) glds16(((t)<2?ksrcL:ksrc)+(long)(t)*KVBLK*PITCH,(unsigned)__builtin_amdgcn_readfirstlane(kdst+(slot)))
  #define DMA_V(t,slot) glds16(((t)<2?vsrcL:vsrc)+(long)(t)*KVBLK*PITCH,(unsigned)__builtin_amdgcn_readfirstlane(vdst+(slot)))
  const int vb0=(int)(lds0+LDS_V)+((lane>>4)&1)*32+(lane&3)*8+(4*hi+((lane&15)>>2))*64;
  const char*Kbase=shm+LDS_K; bf16x8 kf[8];
  const lds_cptr shm3=(lds_cptr)shm; const lds_cptr kp0=shm3+LDS_K+hi*1024+r32*16; const lds_cptr vp0=shm3+LDS_V+((lane>>4)&1)*32+(lane&3)*8+(4*hi+((lane&15)>>2))*64;
  const int NT=(q0+QB)/KVBLK+2;
  if(stage_c2){ __attribute__((address_space(3))) float*negc_w=(__attribute__((address_space(3))) float*)((lds_cptr)shm+LDS_C2); const float*cs=c2v+(long)(b*NHEAD+h)*VK;
    float cv_[5];
    _Pragma("unroll") for(int i_=0;i_<5;++i_){const int i=tid+i_*NW*64; cv_[i_]=i<NT*KVBLK?cs[i]:0.f;}
    _Pragma("unroll") for(int i_=0;i_<5;++i_){const int i=tid+i_*NW*64; if(i<NT*KVBLK)negc_w[i]=-cv_[i_];} }
  const __attribute__((address_space(3))) float* negc3=(const __attribute__((address_space(3))) float*)((lds_cptr)shm+LDS_C2)+4*hi;
  typedef float f32x4_t __attribute__((ext_vector_type(4)));
  #define NEGC(t,i) (*(const __attribute__((address_space(3))) f32x4_t*)(negc3+64*(t)+(((i)>>2)*32)+8*((i)&3)))
  DMA_K(0,0);DMA_V(0,0);DMA_K(1,SLOTB);
  bf16x8 qr[4];
  #pragma unroll
  for(int d0=0;d0<4;++d0)qr[d0]=*reinterpret_cast<const bf16x8*>(&Qw[(long)r32*PITCH+d0*16+hi*8]);
  float mhat=0.f,l_reg=0.f;f32x16 o[2];o[0]=f32x16{};o[1]=f32x16{};
  const int qrel=wid*QBLK+r32;
  #define CMASK(P0,P1,t) do{int jb_=(t)-(NT-4); if(jb_>=0)cmask(P0,P1,jb_,qrel,hi);}while(0)
  bool resc=false;
  #define START(P0,P1) do{ const float rm=rowmax(P0,P1); resc=false; \
    { const float dl=rm; mhat=fadd_s(mhat,dl); \
      _Pragma("unroll") for(int r=0;r<16;++r){P0[r]=fsub_s(P0[r],dl);P1[r]=fsub_s(P1[r],dl);} } \
    _Pragma("unroll") for(int r=0;r<16;++r)P0[r]=__builtin_amdgcn_exp2f(P0[r]); }while(0)
  #define RESC() do{ if(resc){ asm volatile("s_waitcnt lgkmcnt(0)":::"memory"); \
      _Pragma("unroll") for(int d_=0;d_<2;++d_) _Pragma("unroll") for(int r=0;r<16;++r)o[d_][r]*=wsf[crow(r,hi)]; } }while(0)
  f32x16 pA0,pA1,pB0,pB1;
  int sl_prev=0,sl_cur=0,sl_next=SLOTB;
  #define ROT() do{sl_prev=sl_cur;sl_cur=sl_next;sl_next=(sl_next==(NSLOT-1)*SLOTB)?0:sl_next+SLOTB;}while(0)
  DMA_K(2,2*SLOTB);
  WAIT_BAR(3);
  #define FILLT(P0,P1,t) do{ _Pragma("unroll") for(int i_=0;i_<4;++i_){ const f32x4_t a_=NEGC(t,i_),b_=NEGC(t,4+i_); \
      P0[4*i_]=a_[0]-mhat;P0[4*i_+1]=a_[1]-mhat;P0[4*i_+2]=a_[2]-mhat;P0[4*i_+3]=a_[3]-mhat; P1[4*i_]=b_[0]-mhat;P1[4*i_+1]=b_[1]-mhat;P1[4*i_+2]=b_[2]-mhat;P1[4*i_+3]=b_[3]-mhat; } }while(0)
  FILLT(pA0,pA1,0);
  qkt(pA0,pA1,Kbase,qr,r32,hi);asm volatile("s_nop 15\n\ts_nop 7":"+v"(pA0),"+v"(pA1));CMASK(pA0,pA1,0);
  START(pA0,pA1);
  FILLT(pB0,pB1,1);
  _Pragma("unroll") for(int r=0;r<16;++r)pA1[r]=__builtin_amdgcn_exp2f(pA1[r]);
  WAIT_BAR(0);
  DMA_K(3,0);DMA_V(1,SLOTB);
  ROT();
  kload8(kf,kp0+sl_cur);
  WAIT_BAR(2);
  s16x4 vlo[8],vhi[8]; u32x4 pw0,pw1,pw2,pw3;
  #define PKW(P,B) cvtpk_s(P[B],P[B+1])
  #define PAF(k) __builtin_bit_cast(bf16x8,pw##k)
  #define VFR(i) (bf16x8){vlo[i][0],vlo[i][1],vlo[i][2],vlo[i][3],vhi[i][0],vhi[i][1],vhi[i][2],vhi[i][3]}
  #define PIN(x) asm volatile("":"+v"(x))
  #define MX3(a,b,c) __builtin_fmaxf(__builtin_fmaxf((a),(b)),(c))
  #define GAPA(MF,A0,A1,A2,A3,W0,W1,PW) do{ MF; sacc+=A0; sacc+=A1; sacc+=A2; sacc+=A3; PIN(sacc); W0; W1; PIN(PW); SBAR(); }while(0)
  #define EX(v) __builtin_amdgcn_exp2f(v)
  #define GAPB(MF,X,B,FP,FB,I,t,GF) do{ MF; X[B]=EX(X[B]); X[B+1]=EX(X[B+1]); X[B+2]=EX(X[B+2]); X[B+3]=EX(X[B+3]); \
      if(GF){ FP[FB]=fsub_s(cn_[0],mhat); FP[FB+1]=fsub_s(cn_[1],mhat); FP[FB+2]=fsub_s(cn_[2],mhat); FP[FB+3]=fsub_s(cn_[3],mhat); PIN(FP); if((I)<7){cn_=NEGC((t)+1,(I)+1);} } \
      PIN(X); SBAR(); }while(0)
  #define VRD(i) do{ vlo[i]=vtr(vp_+(((i)>>2)*4096+((i)&3)*1024)); vhi[i]=vtr(vp_+(((i)>>2)*4096+((i)&3)*1024+512)); }while(0)
  #define KRD(G,j) do{ if(G){ kload2(kf,kp0+sl_next,j); SBAR(); } }while(0)
  #define STEP(C0,C1,P0,P1,t,GK,GV,GL) do{ SBAR(); \
    const lds_cptr vp_=vp0+sl_prev; \
    VRD(0); SBAR(); float sacc=(P0[0]+P0[1]); \
    GAPA(C0=__builtin_amdgcn_mfma_f32_32x32x16_bf16(kf[0],qr[0],C0,0,0,0), P0[2],P0[3],P0[4],P0[5],     pw0[0]=PKW(P0,0), pw0[1]=PKW(P0,2), pw0); \
    VRD(4); SBAR(); GAPA(C1=__builtin_amdgcn_mfma_f32_32x32x16_bf16(kf[1],qr[0],C1,0,0,0), P0[6],P0[7],P0[8],P0[9],     pw0[2]=PKW(P0,4), pw0[3]=PKW(P0,6), pw0); \
    VRD(1); SBAR(); GAPA(C0=__builtin_amdgcn_mfma_f32_32x32x16_bf16(kf[2],qr[1],C0,0,0,0),   P0[10],P0[11],P0[12],P0[13], pw1[0]=PKW(P0,8), pw1[1]=PKW(P0,10), pw1); \
    VRD(5); SBAR(); GAPA(C1=__builtin_amdgcn_mfma_f32_32x32x16_bf16(kf[3],qr[1],C1,0,0,0),   P0[14],P0[15],P1[0],P1[1],   pw1[2]=PKW(P0,12),pw1[3]=PKW(P0,14), pw1); \
    VRD(2); SBAR(); GAPA(C0=__builtin_amdgcn_mfma_f32_32x32x16_bf16(kf[4],qr[2],C0,0,0,0),   P1[2],P1[3],P1[4],P1[5],     pw2[0]=PKW(P1,0), pw2[1]=PKW(P1,2), pw2); \
    VRD(6); SBAR(); GAPA(C1=__builtin_amdgcn_mfma_f32_32x32x16_bf16(kf[5],qr[2],C1,0,0,0),   P1[6],P1[7],P1[8],P1[9],     pw2[2]=PKW(P1,4), pw2[3]=PKW(P1,6), pw2); \
    VRD(3); SBAR(); GAPA(C0=__builtin_amdgcn_mfma_f32_32x32x16_bf16(kf[6],qr[3],C0,0,0,0),   P1[10],P1[11],P1[12],P1[13], pw3[0]=PKW(P1,8), pw3[1]=PKW(P1,10), pw3); \
    VRD(7); SBAR(); GAPA(C1=__builtin_amdgcn_mfma_f32_32x32x16_bf16(kf[7],qr[3],C1,0,0,0),   P1[14],P1[15],0.f,0.f,       pw3[2]=PKW(P1,12),pw3[3]=PKW(P1,14), pw3); \
    l_reg+=sacc; \
    if(GK){DMA_K((t)+3,sl_cur);} if(GV){DMA_V((t)+1,sl_next);} \
    CMASK(C0,C1,t); \
    { float a=MX3(C0[0],C0[1],C1[0]),b=MX3(C0[2],C0[3],C1[1]); a=MX3(a,C1[2],C1[3]); \
      _Pragma("unroll") for(int r=4;r<16;r+=4){a=MX3(a,C0[r],C0[r+1]);b=MX3(b,C0[r+2],C0[r+3]);a=MX3(a,C1[r],C1[r+1]);b=MX3(b,C1[r+2],C1[r+3]);} \
      float rm=__builtin_fmaxf(a,b); { auto rr=__builtin_amdgcn_permlane32_swap(__float_as_uint(rm),__float_as_uint(rm),false,false); rm=__builtin_fmaxf(__uint_as_float(rr[0]),__uint_as_float(rr[1])); } \
      resc=false; \
      if(__builtin_expect(__any(rm>(float)THRL),0)){ const float dl=__builtin_fmaxf(rm,0.f); mhat+=dl; \
        _Pragma("unroll") for(int r=0;r<16;++r){C0[r]-=dl;C1[r]-=dl;} \
        const float f=__builtin_amdgcn_exp2f(-dl); l_reg*=f; if(hi==0)wsf[r32]=f; resc=true; } } \
    f32x4_t cn_=(f32x4_t){0.f,0.f,0.f,0.f}; if(GL){cn_=NEGC((t)+1,0);} \
    SBAR(); \
    GAPB(o[0]=__builtin_amdgcn_mfma_f32_32x32x16_bf16(PAF(0),VFR(0),o[0],0,0,0), C0,0,P0,0,0,t,GL); \
    GAPB(o[1]=__builtin_amdgcn_mfma_f32_32x32x16_bf16(PAF(0),VFR(4),o[1],0,0,0), C0,4,P0,4,1,t,GL); \
    KRD(GL,0); GAPB(o[0]=__builtin_amdgcn_mfma_f32_32x32x16_bf16(PAF(1),VFR(1),o[0],0,0,0), C0,8,P0,8,2,t,GL); \
    KRD(GL,1); GAPB(o[1]=__builtin_amdgcn_mfma_f32_32x32x16_bf16(PAF(1),VFR(5),o[1],0,0,0), C0,12,P0,12,3,t,GL); \
    KRD(GL,2); GAPB(o[0]=__builtin_amdgcn_mfma_f32_32x32x16_bf16(PAF(2),VFR(2),o[0],0,0,0), C1,0,P1,0,4,t,GL); \
    KRD(GL,3); GAPB(o[1]=__builtin_amdgcn_mfma_f32_32x32x16_bf16(PAF(2),VFR(6),o[1],0,0,0), C1,4,P1,4,5,t,GL); \
    GAPB(o[0]=__builtin_amdgcn_mfma_f32_32x32x16_bf16(PAF(3),VFR(3),o[0],0,0,0), C1,8,P1,8,6,t,GL); \
    GAPB(o[1]=__builtin_amdgcn_mfma_f32_32x32x16_bf16(PAF(3),VFR(7),o[1],0,0,0), C1,12,P1,12,7,t,GL); \
    }while(0)
  int t=1;
  #undef CMASK
  #define CMASK(P0,P1,t) do{}while(0)
  for(;t+5<NT;t+=2){
    STEP(pB0,pB1,pA0,pA1,t,true,true,true);     WAIT_BAR(2); RESC(); ROT();
    STEP(pA0,pA1,pB0,pB1,t+1,true,true,true);   WAIT_BAR(2); RESC(); ROT();
  }
  #undef CMASK
  #define CMASK(P0,P1,t) do{int jb_=(t)-(NT-4); if(jb_>=0)cmask(P0,P1,jb_,qrel,hi);}while(0)
  #define ENDW(tt) do{ if((tt)+3<NT){WAIT_BAR(2);} else if((tt)+2<NT){WAIT_BAR(1);} else {WAIT_BAR(0);} }while(0)
  for(;t+1<NT;t+=2){
    STEP(pB0,pB1,pA0,pA1,t,(t+3<NT),(t+1<NT),(t+1<NT));       ENDW(t);   RESC(); ROT();
    STEP(pA0,pA1,pB0,pB1,t+1,(t+4<NT),(t+2<NT),(t+2<NT));     ENDW(t+1); RESC(); ROT();
  }
  STEP(pB0,pB1,pA0,pA1,NT-1,false,false,false); RESC();
  { float sacc=pB0[0]+pB0[1]; _Pragma("unroll") for(int r=2;r<16;++r)sacc+=pB0[r]; _Pragma("unroll") for(int r=0;r<16;++r)sacc+=pB1[r]; l_reg+=sacc;
    pw0=(u32x4){PKW(pB0,0),PKW(pB0,2),PKW(pB0,4),PKW(pB0,6)};pw1=(u32x4){PKW(pB0,8),PKW(pB0,10),PKW(pB0,12),PKW(pB0,14)};pw2=(u32x4){PKW(pB1,0),PKW(pB1,2),PKW(pB1,4),PKW(pB1,6)};pw3=(u32x4){PKW(pB1,8),PKW(pB1,10),PKW(pB1,12),PKW(pB1,14)};
    SBAR(); pv(o,vb0+sl_cur,PAF(0),PAF(1),PAF(2),PAF(3)); }
  #undef PKW
  #undef PAF
  #undef VFR
  #undef PIN
  #undef MX3
  #undef GAPA
  #undef GAPB
  #undef EX
  #undef VRD
  #undef KRD
  #undef STEP
  #undef ENDW
  {auto rr=__builtin_amdgcn_permlane32_swap(__float_as_uint(l_reg),__float_as_uint(l_reg),false,false);l_reg=__uint_as_float(rr[0])+__uint_as_float(rr[1]);}
  if(hi==0)wsf[32+r32]=l_reg;asm volatile("s_waitcnt lgkmcnt(0)":::"memory");
  float rli[16];
  #pragma unroll
  for(int r=0;r<16;++r)rli[r]=__builtin_amdgcn_rcpf(wsf[32+crow(r,hi)]);
  bf16*Ow=O+(rowbase+q0+wid*QBLK)*OPITCH+h*D; const bf16*Gw=OG+(rowbase+q0+wid*QBLK)*PITCH+h*D;
  u32x4 gg[4];
  #pragma unroll
  for(int i=0;i<4;++i){const int row=i*8+(lane>>3),ch=lane&7; gg[i]=*(const u32x4*)(Gw+(long)row*PITCH+ch*8);}
  { bf16*stg=(bf16*)(shm+LDS_OST)+wid*2048;
    #pragma unroll
    for(int r=0;r<16;++r){const int orow=crow(r,hi);
      #pragma unroll
      for(int d0=0;d0<2;++d0)stg[orow*64+d0*32+r32]=__float2bfloat16(o[d0][r]*rli[r]);}
    asm volatile("s_waitcnt lgkmcnt(0)":::"memory");
    #pragma unroll
    for(int i=0;i<4;++i){const int row=i*8+(lane>>3),ch=lane&7; u32x4 v=*(const u32x4*)(stg+row*64+ch*8);
      #pragma unroll
      for(int w=0;w<4;++w){ const float o0=__uint_as_float(v[w]<<16),o1=__uint_as_float(v[w]&0xffff0000u),g0=__uint_as_float(gg[i][w]<<16),g1=__uint_as_float(gg[i][w]&0xffff0000u);
        v[w]=cvtpk_s(o0*__builtin_amdgcn_rcpf(1.f+__builtin_amdgcn_exp2f(-1.4426950408889634f*g0)),o1*__builtin_amdgcn_rcpf(1.f+__builtin_amdgcn_exp2f(-1.4426950408889634f*g1))); }
      ATTN_STORE16(Ow+(long)row*OPITCH+ch*8,v);} }
  asm volatile("s_waitcnt lgkmcnt(0)\n\ts_barrier":::"memory");
  #undef DMA_K
  #undef NEGC
  #undef FILLT
  #undef DMA_V
  #undef CMASK
  #undef START
  #undef RESC
  #undef ROT
}
constexpr int ATTN_LDS_BYTES=LDS_BYTES;
struct AttnTensors { const bf16* Q; const bf16* K; const bf16* V; const bf16* OG; const float* c2v; bf16* O; };
struct AttnUnit { int bh; int qb; };
struct StaticOrder {
  int vcu, G, blk;
  __device__ __forceinline__ explicit StaticOrder(int grid,int block):vcu((grid%8==0)?(block%8)*(grid/8)+block/8:block),G(grid),blk(block){}
  __device__ __forceinline__ bool next(int i,AttnUnit&u)const{
    if(G==256){ if(blk<64){ if(i>=1)return false; u.bh=blk; u.qb=0; return true; } const int j=blk-64,g=j>>6; u.bh=j&63;
      if(g==0){ if(i>=2)return false; u.qb=i?3:7; } else if(g==1){ if(i>=2)return false; u.qb=i?4:6; } else { if(i>=3)return false; u.qb=i==0?5:3-i; }
      return true; }
    const int pair=vcu+(i>>1)*G; if(pair>=BATCH*NHEAD*4)return false; const int s=pair&3; u.bh=pair>>2; u.qb=(i&1)?s:7-s; return true; }
  __device__ __forceinline__ void a_ready(const AttnUnit&)const{}
  __device__ __forceinline__ void done(const AttnUnit&)const{}
};
template<class Sched,int THRL=8> __device__ __forceinline__ void attn_phase(char*lds,const AttnTensors&T,const Sched&S,const int wave_s){
  AttnUnit u;
  int pbh=-1,pqb=-1;
  for(int i=0;S.next(i,u);++i){ S.a_ready(u); attn_unit<THRL>(u.bh/NHEAD,u.bh%NHEAD,u.qb,T.Q,T.K,T.V,T.OG,T.c2v,T.O,lds,wave_s,!(u.bh==pbh&&u.qb<=pqb)); if(u.bh!=pbh||u.qb>pqb){pbh=u.bh;pqb=u.qb;} S.done(u); }
}
#undef SBAR
#undef WAIT_BAR
}
#define GAS __attribute__((address_space(1)))
#define LAS __attribute__((address_space(3)))
typedef unsigned short bf16;
typedef unsigned v4u __attribute__((ext_vector_type(4)));
typedef float f32x4 __attribute__((ext_vector_type(4)));
typedef short bf16x8 __attribute__((ext_vector_type(8)));
typedef GAS unsigned gu32;
typedef GAS unsigned long long gu64;
#define RLX_AGENT __ATOMIC_RELAXED, __HIP_MEMORY_SCOPE_AGENT
#define LDS_WAIT() asm volatile("s_waitcnt lgkmcnt(0)" ::: "memory")
#define VM_WAIT() asm volatile("s_waitcnt vmcnt(0)" ::: "memory")
#define XB_TMO      128
#define XB_XCNT(j)  (256  + 64 * (j))
#define XB_XSUB(j)  (1280 + 64 * (j))
#define XB_XGEN(j)  (2304 + 64 * (j))
#define XB_TOP      3328
#define XB_TOPGEN   3392
#define XCD_BAR_WORDS 3456
#define XB_SPIN_CAP (1u << 18)

__device__ __forceinline__ unsigned xb_ld(unsigned* p)              { return __hip_atomic_load(p, __ATOMIC_RELAXED, __HIP_MEMORY_SCOPE_AGENT); }
__device__ __forceinline__ unsigned xb_add(unsigned* p, unsigned v) { return __hip_atomic_fetch_add(p, v, __ATOMIC_RELAXED, __HIP_MEMORY_SCOPE_AGENT); }
__device__ __forceinline__ unsigned xb_xcc_id() { return (unsigned)__builtin_amdgcn_s_getreg((3 << 11) | 20) & 0xFu; }
#define XB_SPIN(cond, bar) do { unsigned _sp = 0; while (cond) { __builtin_amdgcn_s_sleep(1); \
    if ((++_sp & 255u) == 0u) { if (xb_ld(&(bar)[XB_TMO])) break; if (_sp > XB_SPIN_CAP) { atomicAdd(&(bar)[XB_TMO], 1u); break; } } } } while (0)

struct XcdBarrier {
    unsigned* bar; unsigned x;
    volatile LAS unsigned* st;
};

__device__ __forceinline__ XcdBarrier xcd_barrier_post(unsigned* bar, volatile LAS unsigned* st) {
    XcdBarrier b; b.bar = bar; b.x = xb_xcc_id(); b.st = st;
    if (threadIdx.x == 0) (void)xb_add(&bar[XB_XCNT(b.x)], 1u);
    return b;
}
__device__ __forceinline__ void xcd_barrier_complete(unsigned* bar, unsigned x, unsigned& nloc, unsigned& nx) {
    const unsigned G = gridDim.x * gridDim.y * gridDim.z;
    unsigned sum, cnt, mine, sp = 0u;
    for (;;) {
        sum = 0u; cnt = 0u; mine = 0u;
#pragma unroll
        for (unsigned j = 0; j < 16; ++j) { const unsigned c = xb_ld(&bar[XB_XCNT(j)]); sum += c; cnt += (c > 0u) ? 1u : 0u; mine = (j == x) ? c : mine; }
        if (sum == G) break;
        __builtin_amdgcn_s_sleep(1);
        if ((++sp & 255u) == 0u) { if (xb_ld(&bar[XB_TMO])) break; if (sp > XB_SPIN_CAP) { atomicAdd(&bar[XB_TMO], 1u); break; } }
    }
    nloc = mine > 0u ? mine : 1u; nx = cnt > 0u ? cnt : 1u;
}

__device__ __forceinline__ void xcd_barrier(const XcdBarrier& b, const int wave_s) {
    asm volatile("s_waitcnt vmcnt(0)" ::: "memory");
    __syncthreads();
    if (wave_s == 0 && lane_id() == 0) {
        int z0_ = 0; asm volatile("" : "+s"(z0_));
        unsigned* bar = b.bar + z0_;
        __builtin_amdgcn_s_waitcnt(0);
        unsigned nloc = b.st[0], nx = b.st[1];
        if (nloc == 0u) { xcd_barrier_complete(bar, b.x, nloc, nx); b.st[0] = nloc; b.st[1] = nx; }
        const unsigned old = xb_add(&bar[XB_XSUB(b.x)], 1u);
        const unsigned gen = old / nloc;
        if (old + 1u == (gen + 1u) * nloc) {
            __builtin_amdgcn_fence(__ATOMIC_RELEASE, "agent");
            asm volatile("s_waitcnt vmcnt(0)" ::: "memory");
            const unsigned og = xb_add(&bar[XB_TOP], 1u);
            const unsigned tg = og / nx;
            if (og + 1u == (tg + 1u) * nx) xb_add(&bar[XB_TOPGEN], 1u);
            else XB_SPIN(xb_ld(&bar[XB_TOPGEN]) == tg, bar);
            __builtin_amdgcn_fence(__ATOMIC_ACQUIRE, "agent");
            xb_add(&bar[XB_XGEN(b.x)], 1u);
            asm volatile("s_waitcnt vmcnt(0)" ::: "memory");
        } else {
            XB_SPIN(xb_ld(&bar[XB_XGEN(b.x)]) == gen, bar);
            __builtin_amdgcn_fence(__ATOMIC_ACQUIRE, "agent");
            asm volatile("s_waitcnt vmcnt(0)" ::: "memory");
        }
    }
    __syncthreads();
}

constexpr int NWAVES = 8;
constexpr int RING_BYTES = 131072;
constexpr int LDS_BYTES = 163840;
constexpr int LDSCTL_OFF = LDS_BYTES - 1024, MISC_OFF = LDSCTL_OFF + 320;
constexpr int HALO_OFF = RING_BYTES;
constexpr int RSTD_OFF = HALO_OFF + 8192;
static_assert(RSTD_OFF + 6 * 1024 + 4096 <= LDSCTL_OFF, "LDS map");
constexpr int CW_BAR = 4096;

struct Args { const float* in[24]; float* out; unsigned char* ws; };

template <bool AF32, class F>
__device__ __forceinline__ void meta_gemm(const void* A, int lda, const bf16_t* Wt, int N, int K, int bid, int G, int wave, int lane, float* red, const F& f) {
    const int fr = lane & 15, fq = lane >> 4, kw = K / NWAVES;
    for (int cb = bid; cb < N / 16; cb += G) {
        f32x4 acc = (f32x4){0.f, 0.f, 0.f, 0.f}; float ss = 0.f;
        const bf16_t* bp = Wt + (size_t)(cb * 16 + fr) * K + wave * kw + 8 * fq;
#pragma unroll
        for (int k = 0; k < kw; k += 32) {
            bf16x8 a;
            if (AF32) {
                const float* ap = (const float*)A + (size_t)fr * lda + wave * kw + k + 8 * fq;
                const f32x4 a0 = *(const f32x4*)ap, a1 = *(const f32x4*)(ap + 4);
                ss += ((a0.x * a0.x + a0.y * a0.y) + (a0.z * a0.z + a0.w * a0.w)) + ((a1.x * a1.x + a1.y * a1.y) + (a1.z * a1.z + a1.w * a1.w));
                u32x4 w; w.x = pk2bf(a0.x, a0.y); w.y = pk2bf(a0.z, a0.w); w.z = pk2bf(a1.x, a1.y); w.w = pk2bf(a1.z, a1.w);
                a = __builtin_bit_cast(bf16x8, w);
            } else a = *(const bf16x8*)((const bf16_t*)A + (size_t)fr * lda + wave * kw + k + 8 * fq);
            const bf16x8 b = *(const bf16x8*)(bp + k);
            acc = __builtin_amdgcn_mfma_f32_16x16x32_bf16(a, b, acc, 0, 0, 0);
        }
        float* rw = red + (wave * 64 + lane) * 5;
        rw[0] = acc[0]; rw[1] = acc[1]; rw[2] = acc[2]; rw[3] = acc[3]; rw[4] = ss;
        __syncthreads();
        if (wave == 0) {
            f32x4 t = (f32x4){0.f, 0.f, 0.f, 0.f}; float s2 = 0.f;
#pragma unroll
            for (int w = 0; w < NWAVES; ++w) { const float* r_ = red + (w * 64 + lane) * 5; t[0] += r_[0]; t[1] += r_[1]; t[2] += r_[2]; t[3] += r_[3]; s2 += r_[4]; }
            float rstd = 1.f;
            if (AF32) { s2 = add_xor16(s2); s2 = add_xor32(s2); rstd = 1.0f / sqrtf(s2 * (1.f / DM) + 1e-6f); }
#pragma unroll
            for (int r = 0; r < 4; ++r) { const int row = 4 * fq + r; const float rs = AF32 ? __int_as_float(__builtin_amdgcn_ds_bpermute(row << 2, __float_as_int(rstd))) : 1.f; f(row, cb * 16 + fr, t[r] * rs); }
        }
        __syncthreads();
    }
}
struct MEpi1 { bf16_t* p; float* pn;
    __device__ __forceinline__ void operator()(int r, int col, float v) const {
        const int row = MROWS + r; const int g = col >> 9, c_ = col & 255;
        if (g < 7) p[(size_t)row * PBW + (col & ~255) + ((c_ >> 5) & 3) * 64 + (c_ >> 7) * 32 + PERM32(c_ & 31)] = f2bf(v);
        else { const int o = col & 511; if (o < 296) pn[(size_t)row * PNW + o] = v; } } };
struct MEpiRes { float* hm; __device__ __forceinline__ void operator()(int r, int col, float v) const { float* h = hm + r * DM + (col & ~31) + PERM32(col & 31); *h = *h + v; } };
struct MEpi3 { float* rawm;
    __device__ __forceinline__ void operator()(int r, int col, float v) const { const int t = col >> 8, c = col & 255; rawm[(size_t)r * DFF2 + (c < 128 ? 128 * t + c : DFF + 128 * t + (c - 128))] = v; } };

__device__ __forceinline__ void meta_gemm3(const float* hm, const bf16_t* W3, int bid, int G, int wave, int lane, int tid, float* red, float* rug, const float* cw, const float* cb, float* rawm, bf16_t* am) {
    const int fr = lane & 15, fq = lane >> 4; constexpr int kw = DM / NWAVES;
    for (int pr = bid; pr < DFF / 16; pr += G) {
        const int t = pr >> 3, kk = pr & 7, cbu = 16 * t + kk;
        f32x4 au = (f32x4){0.f, 0.f, 0.f, 0.f}, ag = au; float ss = 0.f;
        const bf16_t* bpu = W3 + (size_t)(cbu * 16 + fr) * DM + wave * kw + 8 * fq; const bf16_t* bpg = bpu + (size_t)128 * DM;
#pragma unroll
        for (int k = 0; k < kw; k += 32) {
            const float* ap = hm + (size_t)fr * DM + wave * kw + k + 8 * fq;
            const f32x4 a0 = *(const f32x4*)ap, a1 = *(const f32x4*)(ap + 4);
            ss += ((a0.x * a0.x + a0.y * a0.y) + (a0.z * a0.z + a0.w * a0.w)) + ((a1.x * a1.x + a1.y * a1.y) + (a1.z * a1.z + a1.w * a1.w));
            u32x4 w; w.x = pk2bf(a0.x, a0.y); w.y = pk2bf(a0.z, a0.w); w.z = pk2bf(a1.x, a1.y); w.w = pk2bf(a1.z, a1.w);
            const bf16x8 a = __builtin_bit_cast(bf16x8, w);
            au = __builtin_amdgcn_mfma_f32_16x16x32_bf16(a, *(const bf16x8*)(bpu + k), au, 0, 0, 0);
            ag = __builtin_amdgcn_mfma_f32_16x16x32_bf16(a, *(const bf16x8*)(bpg + k), ag, 0, 0, 0);
        }
        float* rw = red + (wave * 64 + lane) * 9;
        rw[0] = au[0]; rw[1] = au[1]; rw[2] = au[2]; rw[3] = au[3]; rw[4] = ag[0]; rw[5] = ag[1]; rw[6] = ag[2]; rw[7] = ag[3]; rw[8] = ss;
        __syncthreads();
        if (wave == 0) {
            f32x4 tu = (f32x4){0.f, 0.f, 0.f, 0.f}, tg = tu; float s2 = 0.f;
#pragma unroll
            for (int w = 0; w < NWAVES; ++w) { const float* r_ = red + (w * 64 + lane) * 9; tu[0] += r_[0]; tu[1] += r_[1]; tu[2] += r_[2]; tu[3] += r_[3]; tg[0] += r_[4]; tg[1] += r_[5]; tg[2] += r_[6]; tg[3] += r_[7]; s2 += r_[8]; }
            s2 = add_xor16(s2); s2 = add_xor32(s2); const float rstd = 1.0f / sqrtf(s2 * (1.f / DM) + 1e-6f);
#pragma unroll
            for (int r = 0; r < 4; ++r) { const int row = 4 * fq + r; const float rs = __int_as_float(__builtin_amdgcn_ds_bpermute(row << 2, __float_as_int(rstd)));
                const float vu = tu[r] * rs, vg = tg[r] * rs; rug[row * 16 + fr] = vu; rug[256 + row * 16 + fr] = vg;
                if (row >= 14) { rawm[(size_t)row * DFF2 + 128 * t + 16 * kk + fr] = vu; rawm[(size_t)row * DFF2 + DFF + 128 * t + 16 * kk + fr] = vg; } }
        }
        __syncthreads();
        if (tid < 256) {
            const int row = tid >> 4, j = tid & 15, ch = 128 * t + 16 * kk + j;
            const float xu0 = rug[row * 16 + j], xu1 = row >= 1 ? rug[(row - 1) * 16 + j] : 0.f, xu2 = row >= 2 ? rug[(row - 2) * 16 + j] : 0.f;
            const float xg0 = rug[256 + row * 16 + j], xg1 = row >= 1 ? rug[256 + (row - 1) * 16 + j] : 0.f, xg2 = row >= 2 ? rug[256 + (row - 2) * 16 + j] : 0.f;
            const float cu = cb[ch] + cw[ch] * xu2 + cw[DFF2 + ch] * xu1 + cw[2 * DFF2 + ch] * xu0;
            const float cg = cb[DFF + ch] + cw[DFF + ch] * xg2 + cw[DFF2 + DFF + ch] * xg1 + cw[2 * DFF2 + DFF + ch] * xg0;
            am[(size_t)row * DFF + ch] = f2bf(cg * sigmoidf_(cg) * cu);
        }
        __syncthreads();
    }
}

__device__ __forceinline__ void wprep_layer(const float* const* in, int l, unsigned char* ws, int gw, int ngw, int lane, float* scr, int part) {
    unsigned char* wb = ws + WS_W + (size_t)(l & 1) * WL_BYTES;
    constexpr int I1 = (DM / 64) * (N1 / 32), I2 = (DM / 64) * (DM / 32), I3 = (DM / 64) * (DFF2 / 32), I4 = (DFF / 64) * (DM / 32);
    const int n1 = (part & 1) ? I1 : 0, n2 = (part & 2) ? I2 : 0, n3 = (part & 4) ? I3 : 0, n4 = (part & 8) ? I4 : 0;
    for (int it = gw; it < n1 + n2 + n3 + n4; it += ngw) {
        int r = it, mode = 1, K = DM, Nsrc = N_IN, Ndst = N1; const float* W = in[3] + (size_t)l * DM * N_IN; const float* gk = in[2] + l * DM; bf16_t* WT = (bf16_t*)(wb + WO_W1);
        if (r >= n1) { r -= n1; mode = 2; Nsrc = DM; Ndst = DM; W = in[18] + (size_t)l * DM * DM; gk = nullptr; WT = (bf16_t*)(wb + WO_W2);
            if (r >= n2) { r -= n2; mode = 3; Nsrc = DFF2; Ndst = DFF2; W = in[20] + (size_t)l * DM * DFF2; gk = in[19] + l * DM; WT = (bf16_t*)(wb + WO_W3);
                if (r >= n3) { r -= n3; mode = 4; K = DFF; Nsrc = DM; Ndst = DM; W = in[23] + (size_t)l * DFF * DM; gk = nullptr; WT = (bf16_t*)(wb + WO_W4); } } }
        wprep_item(W, gk, WT, K, Nsrc, Ndst, mode, r, scr, lane);
    }
    if (part & 1) {
        bf16_t* lup = (bf16_t*)(wb + WO_LUP);
        const float* wu = in[6] + (size_t)l * 64 * 512; const float* au = in[8] + (size_t)l * 64 * 512; const float* gu = in[9] + (size_t)l * 160 * 512;
        for (int n = gw; n < 512; n += ngw) {
#pragma unroll
            for (int kq = 0; kq < 5; ++kq) { const int k = lane + 64 * kq;
                if (k < 288) lup[n * 288 + k] = f2bf(k < 64 ? wu[k * 512 + n] : (k < 128 ? au[(k - 64) * 512 + n] : gu[(k - 128) * 512 + n])); }
        }
    }
}

struct RwP { const float* mu; const float* w0; const float* w_up; const float* a0; const float* a_up; const float* g_up; };
struct RwS { const float* mu; const float* k_k; const float* k_a; const float* r_k; const float* gn_w; const float* gn_b; };
constexpr int RCH = 8;

__global__ void __launch_bounds__(NWAVES * 64, 2) mk_fwd(Args a) {
    extern __shared__ __attribute__((aligned(16))) unsigned char lds[];
    const int tid0 = threadIdx.x, wave_s = __builtin_amdgcn_readfirstlane(tid0 >> 6);
    const int G0 = gridDim.x, bid0 = blockIdx.x;
    for (int u = tid0; u < (LDS_BYTES - LDSCTL_OFF) / 4; u += NWAVES * 64) ((LAS unsigned*)((LAS unsigned char*)lds + LDSCTL_OFF))[u] = 0u;
    __syncthreads();
    XcdBarrier bar = xcd_barrier_post((unsigned*)(a.ws + WS_CTL) + CW_BAR, (volatile LAS unsigned*)((LAS unsigned char*)lds + MISC_OFF) + 8);
#ifdef TPROBE
#define TP_MARK(ph) do { if ((ph) >= 20 && TPROBE < 20) break;     \
        const unsigned t_ = (unsigned)__builtin_amdgcn_s_memrealtime(); if (wave_s == 0 && lane_id() == 0) { volatile LAS unsigned* q_ = (volatile LAS unsigned*)((LAS unsigned char*)lds + LDSCTL_OFF + 512); \
        if ((ph) == TPROBE) q_[1] += t_ - q_[0]; q_[0] = t_; } } while (0)
#else
#define TP_MARK(ph) do {} while (0)
#endif
#define GRID_BAR() do { int wv_ = wave_s; asm volatile("" : "+s"(wv_)); xcd_barrier(bar, wv_); } while (0)
#define RSTD_TABLE(S) do { pg8::Unit u_; for (int i_ = 0; S.next(i_, u_); ++i_) for (int r_ = tid; r_ < 256; r_ += NWAVES * 64) \
        ((LAS float*)(ldsl + RSTD_OFF))[i_ * 256 + r_] = pg8::row_rstd(ssqp, u_.pm * 256 + r_); __syncthreads(); } while (0)
    TP_MARK(-1);
#define PHASE_IDS() int G_ = G0, bid_ = bid0, wv_ = wave_s; asm volatile("" : "+s"(G_), "+s"(bid_), "+s"(wv_)); int tid = wv_ * 64 + lane_id(); asm volatile("" : "+v"(tid)); \
    const int G = G_, bid = bid_, ngw = G * NWAVES, lane = tid & 63, wave = wv_, gw = bid * NWAVES + wave; (void)lane; (void)gw; (void)ngw
#define PHASE_PTRS(L) int z0_ = 0; asm volatile("" : "+s"(z0_)); const float* const* inq = a.in + z0_; unsigned char* ws = a.ws + z0_; float* out = a.out + z0_; const int lq = (L) + z0_; \
    float* hm = (float*)(ws + WS_HM); float* c2 = (float*)(ws + WS_C2); float* ssqp = (float*)(ws + WS_SSQ); \
    bf16_t* hb = (bf16_t*)(ws + WS_HB); bf16_t* p = (bf16_t*)(ws + WS_P); float* pn = (float*)(ws + WS_PN); bf16_t* y = (bf16_t*)(ws + WS_Y); \
    bf16_t* act = (bf16_t*)(ws + WS_ACT); float* fixb = (float*)(ws + WS_FIX); float* rawm = (float*)(ws + WS_RAWM); \
    const unsigned char* wbuf = ws + WS_W + (size_t)(lq & 1) * WL_BYTES; \
    const bf16_t* W1 = (const bf16_t*)(wbuf + WO_W1); const bf16_t* W2 = (const bf16_t*)(wbuf + WO_W2); const bf16_t* W3 = (const bf16_t*)(wbuf + WO_W3); const bf16_t* W4 = (const bf16_t*)(wbuf + WO_W4); \
    (void)hm; (void)c2; (void)ssqp; (void)hb; (void)p; (void)pn; (void)y; (void)act; (void)fixb; (void)rawm; (void)out; (void)W1; (void)W2; (void)W3; (void)W4
    LAS unsigned char* ldsl = (LAS unsigned char*)lds;

    {
        PHASE_IDS(); PHASE_PTRS(0);
        for (int row = gw; row < RROWS; row += ngw) {
            const f32x4* xr = (const f32x4*)(row < MROWS ? inq[0] + (size_t)row * DM : inq[1] + (size_t)(row - MROWS) * DM) + lane;
            f32x4* hr = (f32x4*)(hm + (size_t)(row < MROWS ? 0 : row - MROWS) * DM) + lane;
            f32x4 v[4]; float s = 0.f;
#pragma unroll
            for (int j = 0; j < 4; ++j) { v[j] = xr[64 * j]; if (row >= MROWS) hr[64 * j] = v[j]; s += (v[j].x * v[j].x + v[j].y * v[j].y) + (v[j].z * v[j].z + v[j].w * v[j].w); }
            s = wave_sum(s);
            if (lane < 16) ssqp[(size_t)row * 16 + lane] = lane == 0 ? s : 0.f;
            u32x2* o8 = (u32x2*)(hb + (size_t)row * DM) + lane;
#pragma unroll
            for (int j = 0; j < 4; ++j) { u32x2 w; w.x = pk2bf(v[j].x, v[j].y); w.y = pk2bf(v[j].z, v[j].w); o8[64 * j] = w; }
        }
    }
    {
        PHASE_IDS(); PHASE_PTRS(0);
        u32x4* z = (u32x4*)(p + (size_t)RROWS * PBW); const unsigned n16 = (unsigned)((16512 - RROWS) * PBW * 2 / 16);
        for (unsigned i = (unsigned)(bid * (NWAVES * 64) + tid); i < n16; i += (unsigned)(G * (NWAVES * 64))) z[i] = (u32x4){0u, 0u, 0u, 0u};
    }
#ifndef PLAIN_LAUNCH
    cg::this_grid().sync();
#endif
    TP_MARK(0);

#pragma unroll 1
    for (int l = -1; l < DEPTH; ++l) {
#pragma unroll 1
      for (int ph = l < 0 ? 1 : 0; ph < (l < 0 ? 2 : 6); ++ph) {
#ifdef TPROBE
        if (wave_s == 0 && lane_id() == 0) ((volatile LAS unsigned*)((LAS unsigned char*)lds + LDSCTL_OFF + 512))[2] = (unsigned)ph;
#endif
        if (ph == 1 || ph == 4)
        {
            PHASE_IDS(); PHASE_PTRS(l);
            if (lq + 1 < DEPTH) {
                const int first = (G == 256 && lq >= 0) ? (ph == 4 ? 128 : 8) : 0, part = lq < 0 ? 15 : (G == 256 ? (ph == 4 ? 6 : 9) : (ph == 4 ? 0 : 15));
                if (bid >= first && part) wprep_layer(inq, lq + 1, ws, gw - first * NWAVES, ngw - first * NWAVES, lane, (float*)(lds + wave * 16384), part);
            }
            __syncthreads();
        }
        if (ph == 0) {
        {
            PHASE_IDS(); PHASE_PTRS(l);
            const bool mfirst = (bid >> 3) & 1;
            if (mfirst) meta_gemm<true>(hm, DM, W1, N1, DM, bid, G, wave, lane, (float*)lds, MEpi1{p, pn});
            pg8::Gemm g{hb, W1, MROWS, N1, DM}; pg8::StaticOrder S; S.init(MROWS, N1, G, bid);
            RSTD_TABLE(S);
            pg8::Epi1 E{(const LAS float*)(ldsl + RSTD_OFF), p, pn, inq[16] + lq * 64, inq[17] + lq * 64};
            pg8::gemm_phase<pg8::Epi1, pg8::StaticOrder, true, true>(ldsl, g, S, E, wave);
            if (!mfirst) meta_gemm<true>(hm, DM, W1, N1, DM, bid, G, wave, lane, (float*)lds, MEpi1{p, pn});
        }
        } else if (ph == 4) {
        {
            PHASE_IDS(); PHASE_PTRS(l);
            const float* cw = inq[21] + (size_t)lq * 3 * DFF2; const float* cb = inq[22] + (size_t)lq * DFF2;
            pg8::Gemm g{hb, W3, MROWS, DFF2, DM}; pg8::StaticOrder S; S.init(MROWS, DFF2, G, bid);
            RSTD_TABLE(S);
            pg8::EpiConv E{(const LAS float*)(ldsl + RSTD_OFF), cw, cb, act, fixb, ldsl + HALO_OFF, (LAS float*)(ldsl + RSTD_OFF + 6 * 1024)};
            pg8::gemm_phase<pg8::EpiConv, pg8::StaticOrder, true, true>(ldsl, g, S, E, wave);
            meta_gemm3(hm, W3, bid, G, wave, lane, tid, (float*)lds, (float*)(lds + 20480), cw, cb, rawm, act + (size_t)MROWS * DFF);
        }
        }
        if (ph == 1 && l >= 0) {
        {
            PHASE_IDS(); PHASE_PTRS(l);
            __syncthreads(); TP_MARK(20);
            {
                const float* mu = inq[4] + lq * 1824;
                const bf16_t* lup = (const bf16_t*)(wbuf + WO_LUP);
                const int h = wave, cg = h * 64 + lane, fr = lane & 15, fq = lane >> 4;
                const float mu_r = mu[cg], mu_k = mu[512 + cg], mu_v = mu[1024 + cg];
                const float w0c = (inq[5] + lq * 512)[cg], a0c = (inq[7] + lq * 512)[cg];
                const float kkc = (inq[10] + lq * 512)[cg], kac = (inq[11] + lq * 512)[cg], rkc = (inq[12] + lq * 512)[cg];
                LAS unsigned char* PNS = ldsl;
                LAS unsigned char* PSW = ldsl + 22528 + wave * 6528;
                LAS unsigned char* LW = ldsl + 74752 + wave * 9216;
                LAS unsigned char* LIN = ldsl + 148480;
                LAS float* MU = (LAS float*)(ldsl + 158720);
                LAS float* TR = (LAS float*)LW; LAS float* LT = (LAS float*)LW; LAS float* LAK = (LAS float*)(LW + 1280);
#define PN_DMA(uu) do { const int c_ = (uu) % NCH, r0_ = rowof((uu) / NCH, 16 * c_), p0_ = prevrow(r0_); \
                    for (int pc_ = wave; pc_ < (p0_ >= 0 ? 22 : 20); pc_ += NWAVES) { \
                        const char* src_ = (pc_ < 20 ? (const char*)(pn + (size_t)r0_ * PNW) + pc_ * 1024 : (const char*)(pn + (size_t)p0_ * PNW) + (pc_ - 20) * 1024) + lane * 16; \
                        __builtin_amdgcn_global_load_lds((const unsigned*)src_, (LAS unsigned*)(PNS + pc_ * 1024), 16, 0, 0); } } while (0)
#define PS_DMA(uu) do { const int c_ = (uu) % NCH, r0_ = rowof((uu) / NCH, 16 * c_), p0_ = prevrow(r0_); int ln_ = lane; asm volatile("" : "+v"(ln_));     \
                    _Pragma("unroll") for (int j_ = 0; j_ < 7; ++j_) { const int s_ = j_ * 8 + (ln_ >> 3); \
                        if (s_ < 51) { const int i_ = s_ / 3, sg_ = s_ - 3 * i_, rw_ = i_ ? r0_ + i_ - 1 : (p0_ >= 0 ? p0_ : r0_); \
                            const char* src_ = (const char*)(p + (size_t)rw_ * PBW) + sg_ * 1024 + wave * 128 + (ln_ & 7) * 16; \
                            __builtin_amdgcn_global_load_lds((const unsigned*)src_, (LAS unsigned*)(PSW + j_ * 1024), 16, 0, 0); } } } while (0)
#define PSV(i, sg) bf2f(((const LAS bf16_t*)PSW)[(3 * (i) + (sg)) * 64 + lane])
                if (tid < 288) MU[tid] = mu[1536 + tid];
                if (bid < NB * NCH) { PN_DMA(bid); PS_DMA(bid); }
                asm volatile("s_waitcnt vmcnt(0)" ::: "memory");
                bf16x8 bw_[2][4];
                {   const int fru = lane & 15, fqu = lane >> 4;
#pragma unroll
                    for (int nb = 0; nb < 4; ++nb) { const bf16_t* bp_ = lup + (size_t)(h * 64 + 16 * nb + fru) * 288 + 8 * fqu;
#pragma unroll
                        for (int ks = 0; ks < 2; ++ks) bw_[ks][nb] = *(const bf16x8*)(bp_ + 32 * ks);
                    } }
                for (int u = bid; u < NB * NCH; u += G) {
                    const int b = u / NCH, c = u % NCH, row0 = rowof(b, 16 * c), prow0 = prevrow(row0);
                    int tidu = tid; asm volatile("" : "+v"(tidu));
                    const int fr = tidu & 15, fq = (tidu >> 4) & 3;
                    bf16x8 ba_[2][4], bg_[5][4];
                    {   const int fru = fr, fqu = fq;
#pragma unroll
                        for (int nb = 0; nb < 4; ++nb) { const bf16_t* bp_ = lup + (size_t)(h * 64 + 16 * nb + fru) * 288 + 8 * fqu;
#pragma unroll
                            for (int ks = 0; ks < 2; ++ks) ba_[ks][nb] = *(const bf16x8*)(bp_ + 64 + 32 * ks);
                        } }
                    TP_MARK(27);
                    asm volatile("s_waitcnt lgkmcnt(0)\n\ts_barrier" ::: "memory");
                    {
                        float cur_[9], prv_[9], mu_[9];
#pragma unroll
                        for (int i = 0; i < 9; ++i) { const int e = tidu + 512 * i, ti = e / 288, j = e - 288 * ti;
                            cur_[i] = ((const LAS float*)PNS)[ti * 320 + j]; prv_[i] = ((const LAS float*)PNS)[(ti ? ti - 1 : 16) * 320 + j]; mu_[i] = MU[j]; }
#pragma unroll
                        for (int i = 0; i < 9; ++i) { const int e = tidu + 512 * i, ti = e / 288, j = e - 288 * ti;
                            const float prv = (ti || prow0 >= 0) ? prv_[i] : 0.f, s = cur_[i] + mu_[i] * (prv - cur_[i]);
                            const float ex = __builtin_amdgcn_exp2f((j < 64 ? 2.f * LOG2E : -LOG2E) * s), rc = __builtin_amdgcn_rcpf(1.f + ex);
                            ((LAS bf16_t*)LIN)[ti * 296 + j] = f2bf(j < 64 ? 1.f - 2.f * rc : (j < 128 ? s : rc)); }
                    }
                    {   const int fru = fr, fqu = fq;
#pragma unroll
                        for (int nb = 0; nb < 4; ++nb) { const bf16_t* bp_ = lup + (size_t)(h * 64 + 16 * nb + fru) * 288 + 8 * fqu;
#pragma unroll
                            for (int ks = 0; ks < 5; ++ks) bg_[ks][nb] = *(const bf16x8*)(bp_ + 128 + 32 * ks); } }
                    TP_MARK(28);
                    asm volatile("s_waitcnt lgkmcnt(0)\n\ts_barrier" ::: "memory");
                    if (u + G < NB * NCH) PN_DMA(u + G);
                    TP_MARK(22);
#define LORA_PRE(ZA, KB0, NKS, BF) do { f32x4 acc_[4]; _Pragma("unroll") for (int nb = 0; nb < 4; ++nb) acc_[nb] = (f32x4){0.f, 0.f, 0.f, 0.f}; \
                        _Pragma("unroll") for (int ks = 0; ks < (NKS); ++ks) { const bf16x8 af = *(const LAS bf16x8*)(LIN + fr * 592 + ((KB0) + 32 * ks + 8 * fq) * 2); \
                            _Pragma("unroll") for (int nb = 0; nb < 4; ++nb) acc_[nb] = __builtin_amdgcn_mfma_f32_16x16x32_bf16(af, BF[ks][nb], acc_[nb], 0, 0, 0); } \
                        WAVE_LDS_SYNC(); \
                        _Pragma("unroll") for (int nb = 0; nb < 4; ++nb) _Pragma("unroll") for (int r = 0; r < 4; ++r) TR[(4 * fq + r) * 65 + 16 * nb + fr] = acc_[nb][r]; \
                        WAVE_LDS_SYNC(); \
                        _Pragma("unroll") for (int i = 0; i < 16; ++i) ZA[i] = TR[i * 65 + lane]; } while (0)
                    float zw[16], za[16];
                    LORA_PRE(zw, 0, 2, bw_); LORA_PRE(za, 64, 2, ba_);
                    {
                        float zg[16]; LORA_PRE(zg, 128, 5, bg_); (void)zg;
                        asm volatile("s_waitcnt vmcnt(0)" ::: "memory");
                        {
                            const int ti_ = lane >> 2, pt_ = lane & 3; float gv_[16];
#pragma unroll
                            for (int k_ = 0; k_ < 16; ++k_) gv_[k_] = TR[ti_ * 65 + 16 * pt_ + k_];
                            u32x4 o0_, o1_;
                            o0_.x = pk2bf(gv_[0], gv_[1]); o0_.y = pk2bf(gv_[2], gv_[3]); o0_.z = pk2bf(gv_[4], gv_[5]); o0_.w = pk2bf(gv_[6], gv_[7]);
                            o1_.x = pk2bf(gv_[8], gv_[9]); o1_.y = pk2bf(gv_[10], gv_[11]); o1_.z = pk2bf(gv_[12], gv_[13]); o1_.w = pk2bf(gv_[14], gv_[15]);
                            bf16_t* yp_ = y + (size_t)(row0 + ti_) * DM + h * 64 + 16 * pt_;
                            *(u32x4*)yp_ = o0_; *(u32x4*)(yp_ + 8) = o1_; } }
#undef LORA_PRE
                    WAVE_LDS_SYNC();
                    const int ci = (b * 8 + h) * NCH + c;
                    unsigned char* ra = ws + WS_RA + (size_t)ci * RA_BYTES; unsigned char* rb = (unsigned char*)out + (size_t)ci * RB_BYTES;
                    bf16_t* BV = (bf16_t*)(ws + WS_BV);
                    LAS bf16_t* OA = (LAS bf16_t*)LW; LAS bf16_t* OB = OA + 16 * 72; LAS bf16_t* OK = OB + 16 * 72; LAS bf16_t* OR = OK + 16 * 72;
                    const int cxk = (lane >> 5) * 4 + ((lane >> 2) & 3), jk2 = (((lane >> 4) & 1) * 4 + (lane & 3)) * 2;
                    TP_MARK(23);
                    float atil[16]; unsigned bkB[8], bkK[8], vtp[8];
                    float cumC = 0.f;
#pragma unroll
                    for (int i = 0; i < 16; ++i) { zw[i] = 0.6065306597126334f * __builtin_amdgcn_rcpf(1.f + __builtin_amdgcn_exp2f(-LOG2E * (zw[i] + w0c))); cumC += zw[i]; }
                    float cum = 0.f, gprev = 1.f, rp = 0.f, kp_ = 0.f, vp = 0.f, be = 0.f, ke = 0.f, ve = 0.f, bve = 0.f; unsigned bvp[8];
                    unsigned short prr[17], pkk[17], pvv[17];
#pragma unroll
                    for (int i = 0; i < 17; ++i) { prr[i] = ((const LAS bf16_t*)PSW)[(3 * i) * 64 + lane]; pkk[i] = ((const LAS bf16_t*)PSW)[(3 * i + 1) * 64 + lane]; pvv[i] = ((const LAS bf16_t*)PSW)[(3 * i + 2) * 64 + lane]; }
                    WAVE_LDS_SYNC();
                    if (u + G < NB * NCH) PS_DMA(u + G);
                    rp = bf2f(prr[0]); kp_ = bf2f(pkk[0]); vp = bf2f(pvv[0]);
                    const float hp0 = prow0 >= 0 ? 1.f : 0.f;
#pragma unroll
                    for (int i = 0; i < 16; ++i) {
                        const float rc = bf2f(prr[i + 1]), kc = bf2f(pkk[i + 1]), vc = bf2f(pvv[i + 1]);
                        const float hp = i ? 1.f : hp0;
                        const float rs = rc + mu_r * (hp * rp - rc), ks_ = kc + mu_k * (hp * kp_ - kc), vs = vc + mu_v * (hp * vp - vc);
                        rp = rc; kp_ = kc; vp = vc;
                        cum += zw[i];
                        const float alr = __builtin_amdgcn_rcpf(1.f + __builtin_amdgcn_exp2f(-LOG2E * (za[i] + a0c)));
                        const float kkr = ks_ * kkc; const float kk = kkr * __builtin_amdgcn_rsqf(fmaxf(wave_sum_dpp(kkr * kkr), 1e-24f));
                        const float kpr = ks_ * (1.f + (alr - 1.f) * kac);
                        const float bon = wave_sum_dpp(rs * kpr * rkc);
                        const float eg = __builtin_amdgcn_exp2f(LOG2E * cum), gi = __builtin_amdgcn_exp2f(-LOG2E * cum), tail = __builtin_amdgcn_exp2f(LOG2E * (cum - cumC));
                        atil[i] = -kk * gprev;
                        const float bb = kk * alr, rtil = rs * gi; gprev = gi;
                        OA[i * 72 + lane] = f2bf(atil[i]); OB[i * 72 + lane] = f2bf(bb * eg); OK[i * 72 + lane] = f2bf(kpr * eg); OR[i * 72 + lane] = f2bf(rtil);
                        if (i & 1) { bkB[i >> 1] = pk2bf(be, bb * tail); bkK[i >> 1] = pk2bf(ke, kpr * tail); vtp[i >> 1] = pk2bf(ve, vs); } else { be = bb * tail; ke = kpr * tail; ve = vs; }
                        if (i & 1) bvp[i >> 1] = pk2bf(bve, bon * vs); else bve = bon * vs;
                    }
                    {
                        ((float*)(rb + 3584))[lane] = gprev;
#pragma unroll
                        for (int q = 0; q < 4; ++q) *(u32x4*)(ra + 4096 + lane * 64 + ((q ^ SWZ4(lane)) << 4)) = (u32x4){bkB[2 * q], bkB[2 * q + 1], bkK[2 * q], bkK[2 * q + 1]};
                        *(u32x4*)(rb + lane * 32) = (u32x4){vtp[0], vtp[1], vtp[2], vtp[3]}; *(u32x4*)(rb + lane * 32 + 16) = (u32x4){vtp[4], vtp[5], vtp[6], vtp[7]};
                    }
                    WAVE_LDS_SYNC();
                    TP_MARK(24);
#define REC_STORE(TILE, DST) do { _Pragma("unroll") for (int hh_ = 0; hh_ < 2; ++hh_) { const int i_ = (lane >> 3) + 8 * hh_, pc_ = lane & 7, c_ = pc_ ^ ((i_ >> 1) & 7), base_ = (c_ >> 2) * 32 + (c_ & 3) * 4; \
                        const u32x2 lo_ = *(const LAS u32x2*)((TILE) + i_ * 72 + base_), hi_ = *(const LAS u32x2*)((TILE) + i_ * 72 + base_ + 16); \
                        *(u32x4*)((DST) + i_ * 128 + pc_ * 16) = (u32x4){lo_.x, lo_.y, hi_.x, hi_.y}; } } while (0)
                    REC_STORE(OR, ra + 2048);
                    {
                        f32x4 dab = (f32x4){0.f, 0.f, 0.f, 0.f}, dak = dab, drb = dab, drk = dab;
#pragma unroll
                        for (int ks = 0; ks < 2; ++ks) {
                            const int off = fr * 72 + 32 * ks + 8 * fq;
                            const bf16x8 fa = *(const LAS bf16x8*)(OA + off), fb = *(const LAS bf16x8*)(OB + off), fk = *(const LAS bf16x8*)(OK + off), frr = *(const LAS bf16x8*)(OR + off);
                            dab = __builtin_amdgcn_mfma_f32_16x16x32_bf16(fa, fb, dab, 0, 0, 0); dak = __builtin_amdgcn_mfma_f32_16x16x32_bf16(fa, fk, dak, 0, 0, 0);
                            drb = __builtin_amdgcn_mfma_f32_16x16x32_bf16(frr, fb, drb, 0, 0, 0); drk = __builtin_amdgcn_mfma_f32_16x16x32_bf16(frr, fk, drk, 0, 0, 0);
                        }
#pragma unroll
                        for (int r = 0; r < 4; ++r) { const int i = 4 * fq + r, j = fr;
                            LT[i * 20 + j] = j < i ? dab[r] : 0.f; LAK[i * 16 + j] = j < i ? dak[r] : 0.f;
                            bf16_t* mp = (bf16_t*)(rb + 2048 + i * 64 + (((j >> 2) ^ SWZ4(i)) << 4)) + (j & 3);
                            mp[0] = f2bf(j <= i ? drb[r] : 0.f); mp[4] = f2bf(j <= i ? drk[r] : 0.f); }
                    }
                    WAVE_LDS_SYNC();
                    {
#pragma unroll
                        for (int k_ = 0; k_ < 8; ++k_) { OB[(2 * k_) * 72 + lane] = (bf16_t)(bvp[k_] & 0xffffu); OB[(2 * k_ + 1) * 72 + lane] = (bf16_t)(bvp[k_] >> 16); }
                        WAVE_LDS_SYNC();
                        const int ti_ = lane >> 2, pt_ = lane & 3;
                        const u32x4 b0_ = *(const LAS u32x4*)(OB + ti_ * 72 + 16 * pt_), b1_ = *(const LAS u32x4*)(OB + ti_ * 72 + 16 * pt_ + 8);
                        bf16_t* bp_ = BV + (size_t)(row0 + ti_) * 512 + h * 64 + 16 * pt_;
                        *(u32x4*)bp_ = b0_; *(u32x4*)(bp_ + 8) = b1_;
                    }
                    float tt[16];
#pragma unroll
                    for (int mm = 0; mm < 16; ++mm) tt[mm] = mm == fr ? 1.f : 0.f;
#pragma unroll
                    for (int j = 14; j >= 0; --j) { float val = 0.f;
#pragma unroll
                        for (int mm = j + 1; mm < 16; ++mm) val += tt[mm] * LT[mm * 20 + j];
                        tt[j] += val; }
                    WAVE_LDS_SYNC();
                    if (fq == 0) {
#pragma unroll
                        for (int mm = 0; mm < 16; ++mm) LT[fr * 20 + mm] = tt[mm]; }
                    {
                        f32x4 g4 = (f32x4){0.f, 0.f, 0.f, 0.f};
#pragma unroll
                        for (int mm = 0; mm < 16; ++mm) g4 += *(const LAS f32x4*)(LAK + mm * 16 + 4 * fq) * tt[mm];
                        u32x2 w; w.x = pk2bf(g4[0], g4[1]); w.y = pk2bf(g4[2], g4[3]);
                        *(u32x2*)(rb + 3072 + (fr * 16 + 4 * fq) * 2) = w;
                    }
                    WAVE_LDS_SYNC();
                    TP_MARK(25);
                    {
#pragma unroll
                        for (int i = 0; i < 16; ++i) { float acc = 0.f;
                            const f32x4 t0 = *(const LAS f32x4*)(LT + i * 20), t1 = *(const LAS f32x4*)(LT + i * 20 + 4), t2 = *(const LAS f32x4*)(LT + i * 20 + 8), t3 = *(const LAS f32x4*)(LT + i * 20 + 12);
                            const float trow[16] = {t0[0], t0[1], t0[2], t0[3], t1[0], t1[1], t1[2], t1[3], t2[0], t2[1], t2[2], t2[3], t3[0], t3[1], t3[2], t3[3]};
#pragma unroll
                            for (int mm = 0; mm <= i; ++mm) acc += trow[mm] * atil[mm];
                            OK[i * 72 + lane] = f2bf(acc); }
                        WAVE_LDS_SYNC();
                        REC_STORE(OK, ra);
                    }
#undef REC_STORE
                    TP_MARK(26);
                }
            }
            __syncthreads();
#undef PN_DMA
#undef PS_DMA
#undef PSV
            TP_MARK(29);
            TP_MARK(21);
            const float* q_g = inq[16] + lq * 64; const float* k_g = inq[17] + lq * 64; const float* b_f = inq[15] + lq * 8;
            for (int it = gw - (G >= 96 ? 80 * NWAVES : 0); it >= 0 && it < NMETA * NH; it += ngw) {
                const int row = MROWS + (it >> 3), h = it & 7;
                bf16_t* qp = p + (size_t)row * PBW + 1536 + h * 64 + lane; bf16_t* kp = p + (size_t)row * PBW + 2048 + h * 64 + lane;
                const float q = bf2f(*qp), k = bf2f(*kp);
                const float mq = wave_sum(q * q) * (1.f / 64.f), mk = wave_sum(k * k) * (1.f / 64.f);
                *qp = f2bf(q * (1.0f / sqrtf(mq + 1e-6f)) * q_g[lane] * (0.125f * LOG2E));
                *kp = f2bf(k * (1.0f / sqrtf(mk + 1e-6f)) * k_g[lane]);
            }
            for (int it = bid - (G >= 80 ? 16 : 0); it >= 0 && it < NB * NH; it += G) {
                constexpr int PER = 5;
                const int b = it >> 3, h = it & 7;
                float zv[PER], loc[PER], s = 0.f;
#pragma unroll
                for (int i = 0; i < PER; ++i) { const int t = tid * PER + i; zv[i] = pn[(size_t)rowof(b, t < LTOT ? t : LTOT - 1) * PNW + 288 + h]; }
#pragma unroll
                for (int i = 0; i < PER; ++i) { const int t = tid * PER + i;
                    const float v = t < LTOT ? -__builtin_amdgcn_logf(1.f + __builtin_amdgcn_exp2f(-LOG2E * (zv[i] + b_f[h]))) : 0.f;
                    s += v; loc[i] = s; }
                float incl = s;
#pragma unroll
                for (int o = 1; o < 64; o <<= 1) { const float n = __int_as_float(__builtin_amdgcn_ds_bpermute((lane - o) << 2, __float_as_int(incl))); if (lane >= o) incl += n; }
                float base = incl - s;
                if (lane == 63) ((LAS float*)ldsl)[wave] = incl;
                __syncthreads();
#pragma unroll
                for (int w = 0; w < NWAVES - 1; ++w) base += w < wave ? ((const LAS float*)ldsl)[w] : 0.f;
                float* cv = c2 + (size_t)it * 2176;
#pragma unroll
                for (int i = 0; i < PER; ++i) { const int t = tid * PER + i; if (t < LTOT) cv[t < NMETA ? t : t + 112] = base + loc[i]; }
                if (tid < 112) cv[16 + tid] = 1e5f;
                __syncthreads();
            }
        }
        } else if (ph == 2) {
        {
            PHASE_IDS(); PHASE_PTRS(l);
            typedef short s16x4 __attribute__((ext_vector_type(4)));
            constexpr int SLOTB = 12288, NSLOT = 10  , YB_OFF = NSLOT * SLOTB, YB_BYTES = 32 * 68 * 4, NSC = (NCH + 1) / 2;
            static_assert(YB_OFF + 2 * YB_BYTES <= LDSCTL_OFF, "scan LDS map");
#define RAW_BAR() asm volatile("s_waitcnt lgkmcnt(0)\n\ts_barrier" ::: "memory")
#define QXOR1(x) __int_as_float(__builtin_amdgcn_update_dpp(0, __float_as_int(x), 0xB1, 0xf, 0xf, false))
#define QXOR2(x) __int_as_float(__builtin_amdgcn_update_dpp(0, __float_as_int(x), 0x4E, 0xf, 0xf, false))
            for (int unit = bid; unit < 64; unit += G) {
                const int b = unit >> 3, h = unit & 7, fr = lane & 15, fq = lane >> 4;
                const unsigned char* RA0 = ws + WS_RA + (size_t)unit * NCH * RA_BYTES; const unsigned char* RB0 = (const unsigned char*)out + (size_t)unit * NCH * RB_BYTES;
                if (wave < 4) {
                    const int v = 16 * wave + fr;
                    f32x4 Z[4];
#pragma unroll
                    for (int kb = 0; kb < 4; ++kb) Z[kb] = (f32x4){0.f, 0.f, 0.f, 0.f};
                    const int o_ah0 = fr * 128 + (((fq) ^ ((fr >> 1) & 7)) << 4), o_ah1 = fr * 128 + (((4 + fq) ^ ((fr >> 1) & 7)) << 4);
                    const int o_bk = 4096 + fr * 64 + ((fq ^ SWZ4(fr)) << 4), o_mrk = 10240 + fr * 64 + ((fq ^ SWZ4(fr)) << 4);
                    const int o_vt = 8192 + v * 32 + fq * 8, o_g = 11264 + fr * 32 + fq * 8, o_gam = 11776 + fq * 16;
                    RAW_BAR();
                    for (int s = 0; s < NSC; ++s) {
                        LAS float* YB = (LAS float*)(ldsl + YB_OFF + (s & 1) * YB_BYTES);
                        const int nc = (NCH - 2 * s) < 2 ? 1 : 2;
                        for (int cs = 0; cs < nc; ++cs) {
                            const LAS unsigned char* sl = ldsl + ((2 * s + cs) % NSLOT) * SLOTB;
                            const bf16x8 ah0 = *(const LAS bf16x8*)(sl + o_ah0), ah1 = *(const LAS bf16x8*)(sl + o_ah1);
                            const bf16x8 rh0 = *(const LAS bf16x8*)(sl + 2048 + o_ah0), rh1 = *(const LAS bf16x8*)(sl + 2048 + o_ah1);
                            bf16x8 bk[4]; f32x4 gam[4];
#pragma unroll
                            for (int kb = 0; kb < 4; ++kb) { bk[kb] = *(const LAS bf16x8*)(sl + o_bk + kb * 1024); gam[kb] = *(const LAS f32x4*)(sl + o_gam + kb * 64); }
                            const u32x2 vt = *(const LAS u32x2*)(sl + o_vt);
                            const bf16x8 mrk = *(const LAS bf16x8*)(sl + o_mrk);
                            const u32x2 g4 = *(const LAS u32x2*)(sl + o_g);
                            u32x4 zw01, zw23;
                            zw01.x = pk2bf(Z[0][0], Z[0][1]); zw01.y = pk2bf(Z[0][2], Z[0][3]); zw01.z = pk2bf(Z[1][0], Z[1][1]); zw01.w = pk2bf(Z[1][2], Z[1][3]);
                            zw23.x = pk2bf(Z[2][0], Z[2][1]); zw23.y = pk2bf(Z[2][2], Z[2][3]); zw23.z = pk2bf(Z[3][0], Z[3][1]); zw23.w = pk2bf(Z[3][2], Z[3][3]);
                            const bf16x8 zp01 = __builtin_bit_cast(bf16x8, zw01), zp23 = __builtin_bit_cast(bf16x8, zw23);
                            f32x4 U = (f32x4){0.f, 0.f, 0.f, 0.f}, Yv = U;
                            U = __builtin_amdgcn_mfma_f32_16x16x32_bf16(ah0, zp01, U, 0, 0, 0); U = __builtin_amdgcn_mfma_f32_16x16x32_bf16(ah1, zp23, U, 0, 0, 0);
                            U = __builtin_amdgcn_mfma_f32_16x16x16bf16_1k(__builtin_bit_cast(s16x4, g4), __builtin_bit_cast(s16x4, vt), U, 0, 0, 0);
                            Yv = __builtin_amdgcn_mfma_f32_16x16x32_bf16(rh0, zp01, Yv, 0, 0, 0); Yv = __builtin_amdgcn_mfma_f32_16x16x32_bf16(rh1, zp23, Yv, 0, 0, 0);
                            u32x4 uvw; uvw.x = pk2bf(U[0], U[1]); uvw.y = pk2bf(U[2], U[3]); uvw.z = vt.x; uvw.w = vt.y;
                            const bf16x8 uv = __builtin_bit_cast(bf16x8, uvw);
                            Yv = __builtin_amdgcn_mfma_f32_16x16x32_bf16(mrk, uv, Yv, 0, 0, 0);
#pragma unroll
                            for (int kb = 0; kb < 4; ++kb) { Z[kb] = Z[kb] * gam[kb]; Z[kb] = __builtin_amdgcn_mfma_f32_16x16x32_bf16(bk[kb], uv, Z[kb], 0, 0, 0); }
#pragma unroll
                            for (int r = 0; r < 4; ++r) YB[(cs * 16 + 4 * fq + r) * 68 + v] = Yv[r];
                        }
                        RAW_BAR();
                    }
                } else if (wave < 6) {
                    const unsigned lds0 = (unsigned)(uintptr_t)lds; const int lw = wave - 4;
#define DMA_SC(sc) do { const int nc_ = (NCH - 2 * (sc)) < 2 ? 1 : 2; for (int cs_ = 0; cs_ < nc_; ++cs_) { const int ch_ = 2 * (sc) + cs_; \
                        _Pragma("unroll") for (int pc_ = 0; pc_ < 6; ++pc_) { const int pc = lw * 6 + pc_; \
                            const unsigned char* src_ = (pc < 8 ? RA0 + (size_t)ch_ * RA_BYTES + pc * 1024 : RB0 + (size_t)ch_ * RB_BYTES + (pc - 8) * 1024) + lane * 16; \
                            attn_body::glds16(src_, (unsigned)__builtin_amdgcn_readfirstlane(lds0 + (ch_ % NSLOT) * SLOTB + pc * 1024)); } } } while (0)
                    DMA_SC(0); DMA_SC(1); DMA_SC(2); DMA_SC(3);
                    asm volatile("s_waitcnt vmcnt(36)\n\ts_barrier" ::: "memory");
                    for (int s = 0; s < NSC; ++s) {
                        if (s + 4 < NSC) DMA_SC(s + 4);
#define NPC_(sc) ((sc) < NSC ? ((NCH - 2 * (sc)) < 2 ? 6 : 12) : 0)
                        const int fl = NPC_(s + 2) + NPC_(s + 3) + NPC_(s + 4);
#undef NPC_
                        if (fl == 36) asm volatile("s_waitcnt vmcnt(36)\n\ts_barrier" ::: "memory");
                        else if (fl == 30) asm volatile("s_waitcnt vmcnt(30)\n\ts_barrier" ::: "memory");
                        else if (fl == 18) asm volatile("s_waitcnt vmcnt(18)\n\ts_barrier" ::: "memory");
                        else if (fl == 6) asm volatile("s_waitcnt vmcnt(6)\n\ts_barrier" ::: "memory");
                        else asm volatile("s_waitcnt vmcnt(0)\n\ts_barrier" ::: "memory");
                    }
#undef DMA_SC
                } else {
                    const int pw = wave - 6, tk = lane >> 2, part = lane & 3, cgv = h * 64 + part * 16;
                    const bf16_t* BV = (const bf16_t*)(ws + WS_BV);
                    float gnw[16], gnb[16];
#pragma unroll
                    for (int j = 0; j < 16; ++j) { gnw[j] = (inq[13] + lq * 512)[cgv + j]; gnb[j] = (inq[14] + lq * 512)[cgv + j]; }
#define PLOAD(G0, G1, B0, B1, sg) do { const int cn_ = 2 * (sg) + pw; if ((sg) < NSC && cn_ < NCH) { const size_t rown = (size_t)rowof(b, 16 * cn_ + tk); \
                        G0 = *(const u32x4*)(y + rown * DM + cgv); G1 = *(const u32x4*)(y + rown * DM + cgv + 8); B0 = *(const u32x4*)(BV + rown * 512 + cgv); B1 = *(const u32x4*)(BV + rown * 512 + cgv + 8); } } while (0)
                    u32x4 ga0 = (u32x4){0u, 0u, 0u, 0u}, ga1 = ga0, ba0 = ga0, ba1 = ga0, gb0 = ga0, gb1 = ga0, bb0 = ga0, bb1 = ga0, gc0 = ga0, gc1 = ga0, bc0 = ga0, bc1 = ga0;
                    PLOAD(gb0, gb1, bb0, bb1, 0); PLOAD(gc0, gc1, bc0, bc1, 1);
                    RAW_BAR();
                    for (int s = 0; s <= NSC; ++s) {
                        const int cp = 2 * (s - 1) + pw;
                        const bool do_now = s >= 1 && cp < NCH && (cp > 0 || b == 0);
                        const u32x4 g0 = ga0, g1 = ga1, b0 = ba0, b1 = ba1;
                        ga0 = gb0; ga1 = gb1; ba0 = bb0; ba1 = bb1; gb0 = gc0; gb1 = gc1; bb0 = bc0; bb1 = bc1;
                        PLOAD(gc0, gc1, bc0, bc1, s + 2);
                        if (do_now) {
                            const LAS float* yb = (const LAS float*)(ldsl + YB_OFF + ((s - 1) & 1) * YB_BYTES) + (pw * 16 + tk) * 68 + part * 16;
                            float yv[16];
#pragma unroll
                            for (int q4 = 0; q4 < 4; ++q4) { const f32x4 t4 = *(const LAS f32x4*)(yb + 4 * q4); yv[4 * q4] = t4[0]; yv[4 * q4 + 1] = t4[1]; yv[4 * q4 + 2] = t4[2]; yv[4 * q4 + 3] = t4[3]; }
                            float s1 = 0.f;
#pragma unroll
                            for (int j = 0; j < 16; ++j) s1 += yv[j];
                            s1 += QXOR1(s1); s1 += QXOR2(s1);
                            const float mean = s1 * (1.f / 64.f); float s2 = 0.f;
#pragma unroll
                            for (int j = 0; j < 16; ++j) { yv[j] -= mean; s2 += yv[j] * yv[j]; }
                            s2 += QXOR1(s2); s2 += QXOR2(s2);
                            const float rstd = 1.0f / sqrtf(s2 * (1.f / 64.f) + 64e-5f);
                            const unsigned gws[8] = {g0.x, g0.y, g0.z, g0.w, g1.x, g1.y, g1.z, g1.w}, bws[8] = {b0.x, b0.y, b0.z, b0.w, b1.x, b1.y, b1.z, b1.w};
                            unsigned ow[8];
#pragma unroll
                            for (int j2 = 0; j2 < 8; ++j2) {
                                const float oa = (yv[2 * j2] * rstd * gnw[2 * j2] + gnb[2 * j2] + __uint_as_float(bws[j2] << 16)) * __uint_as_float(gws[j2] << 16);
                                const float ob = (yv[2 * j2 + 1] * rstd * gnw[2 * j2 + 1] + gnb[2 * j2 + 1] + __uint_as_float(bws[j2] & 0xffff0000u)) * __uint_as_float(gws[j2] & 0xffff0000u);
                                ow[j2] = pk2bf(oa, ob); }
                            bf16_t* yo = y + (size_t)rowof(b, 16 * cp + tk) * DM + cgv;
                            *(u32x4*)yo = (u32x4){ow[0], ow[1], ow[2], ow[3]}; *(u32x4*)(yo + 8) = (u32x4){ow[4], ow[5], ow[6], ow[7]};
                        }
                        if (s < NSC) RAW_BAR();
                    }
#undef PLOAD
                }
                __syncthreads();
            }
#undef RAW_BAR
#undef QXOR1
#undef QXOR2
        }
        TP_MARK(30);
        {
            PHASE_IDS(); PHASE_PTRS(l);
            if (gw < NH * NMETA) {
                const int h = gw >> 4, t = gw & 15;
                const bf16_t* qrow = p + (size_t)(MROWS + t) * PBW + 1536 + h * 64;
                float s = -INFINITY;
                if (lane <= t) { const bf16_t* kr = p + (size_t)(MROWS + lane) * PBW + 2048 + h * 64; float d = 0.f;
                    for (int e = 0; e < 64; ++e) d += bf2f(qrow[e]) * bf2f(kr[e]);
                    s = d - c2[(size_t)h * 2176 + lane]; }
                const float mx = wave_max(s); const float e = lane <= t ? exp2f(s - mx) : 0.f; const float sum = wave_sum(e);
                float o = 0.f;
                for (int j = 0; j <= t; ++j) o += __int_as_float(__builtin_amdgcn_readlane(__float_as_int(e), j)) * bf2f(p[(size_t)(MROWS + j) * PBW + 2560 + h * 64 + lane]);
                const float og = bf2f(p[(size_t)(MROWS + t) * PBW + 3072 + h * 64 + lane]);
                y[(size_t)(MROWS + t) * DM + 512 + h * 64 + lane] = f2bf(o * __builtin_amdgcn_rcpf(sum) * __builtin_amdgcn_rcpf(1.f + __builtin_amdgcn_exp2f(-LOG2E * og)));
            }
        }
        __syncthreads();
        {
            PHASE_IDS(); PHASE_PTRS(l);
            typedef attn_body::bf16 abf;
            const attn_body::AttnTensors AT{(const abf*)(p + 1536), (const abf*)(p + 2048), (const abf*)(p + 2560), (const abf*)(p + 3072), c2, (abf*)(y + 512)};
            const attn_body::StaticOrder S(G, bid);
            TP_MARK(31);
            attn_body::attn_phase<attn_body::StaticOrder>((char*)lds, AT, S, wave);
            TP_MARK(32);
        }
        } else if (ph == 3) {
        {
            PHASE_IDS(); PHASE_PTRS(l);
            pg8::Gemm g{y, W2, MROWS, DM, DM}; pg8::StaticOrder S; S.init(MROWS, DM, G, bid);
            pg8::EpiRes E{nullptr, hb, ssqp};
            pg8::gemm_phase<pg8::EpiRes, pg8::StaticOrder, true, true>(ldsl, g, S, E, wave);
            meta_gemm<false>(y + (size_t)MROWS * DM, DM, W2, DM, DM, bid, G, wave, lane, (float*)lds, MEpiRes{hm});
        }
        } else if (ph == 5) {
        {
            PHASE_IDS(); PHASE_PTRS(l);
            const float* cw = inq[21] + (size_t)lq * 3 * DFF2; const float* cb = inq[22] + (size_t)lq * DFF2;
            pg8::Gemm g{act, W4, MROWS, DM, DFF}; pg8::StaticOrder S; S.init(MROWS, DM, G, bid);
            {
                pg8::Unit u;
                for (int i = 0; S.next(i, u); ++i) {
                    const int pm = u.pm;
                    const float* own0 = fixb + (size_t)(pm * 4) * DFF2; const float* own1 = own0 + DFF2;
                    const float* pv0 = (pm & 7) ? fixb + (size_t)((pm - 1) * 4 + 2) * DFF2 : rawm + (size_t)14 * DFF2; const float* pv1 = pv0 + DFF2;
                    for (int j = 4 * tid; j < DFF; j += 4 * NWAVES * 64) {
                        const f32x4 w0u = *(const f32x4*)(cw + j), w1u = *(const f32x4*)(cw + DFF2 + j), w2u = *(const f32x4*)(cw + 2 * DFF2 + j), bu = *(const f32x4*)(cb + j);
                        const f32x4 w0g = *(const f32x4*)(cw + DFF + j), w1g = *(const f32x4*)(cw + DFF2 + DFF + j), w2g = *(const f32x4*)(cw + 2 * DFF2 + DFF + j), bg = *(const f32x4*)(cb + DFF + j);
                        const f32x4 au = *(const f32x4*)(pv0 + j), bu_ = *(const f32x4*)(pv1 + j), cu_ = *(const f32x4*)(own0 + j), du = *(const f32x4*)(own1 + j);
                        const f32x4 ag = *(const f32x4*)(pv0 + DFF + j), bg_ = *(const f32x4*)(pv1 + DFF + j), cg_ = *(const f32x4*)(own0 + DFF + j), dg = *(const f32x4*)(own1 + DFF + j);
                        const f32x4 u0 = bu + w0u * au + w1u * bu_ + w2u * cu_, g0 = bg + w0g * ag + w1g * bg_ + w2g * cg_;
                        const f32x4 u1 = bu + w0u * bu_ + w1u * cu_ + w2u * du, g1 = bg + w0g * bg_ + w1g * cg_ + w2g * dg;
                        u32x2 o0, o1;
                        o0.x = pk2bf(g0[0] * sigmoidf_(g0[0]) * u0[0], g0[1] * sigmoidf_(g0[1]) * u0[1]); o0.y = pk2bf(g0[2] * sigmoidf_(g0[2]) * u0[2], g0[3] * sigmoidf_(g0[3]) * u0[3]);
                        o1.x = pk2bf(g1[0] * sigmoidf_(g1[0]) * u1[0], g1[1] * sigmoidf_(g1[1]) * u1[1]); o1.y = pk2bf(g1[2] * sigmoidf_(g1[2]) * u1[2], g1[3] * sigmoidf_(g1[3]) * u1[3]);
                        *(u32x2*)(act + (size_t)(256 * pm) * DFF + j) = o0; *(u32x2*)(act + (size_t)(256 * pm + 1) * DFF + j) = o1;
                    }
                }
                asm volatile("s_waitcnt vmcnt(0)" ::: "memory"); __syncthreads();
            }
            pg8::EpiRes E{lq + 1 == DEPTH ? out : nullptr, hb, ssqp};
            pg8::gemm_phase<pg8::EpiRes, pg8::StaticOrder, true, true>(ldsl, g, S, E, wave);
            meta_gemm<false>(act + (size_t)MROWS * DFF, DFF, W4, DM, DFF, bid, G, wave, lane, (float*)lds, MEpiRes{hm});
        }
        }
#ifdef TPROBE
#ifdef TPROBE_WAIT
        TP_MARK(19);
#endif
        GRID_BAR(); TP_MARK(ph == 0 ? 1 : ph == 1 ? 2 : ph == 2 ? 3 : ph == 3 ? 4 : ph == 4 ? 5 : 6);
#if TPROBE == 40
        GRID_BAR(); TP_MARK(40);
#endif
#else
        if (ph < 5 || l + 1 < DEPTH) GRID_BAR();
#endif
      }
    }
#ifdef TPROBE
#ifndef TPROBE_BLOCK
#define TPROBE_BLOCK 0
#endif
    if (bid0 == TPROBE_BLOCK && wave_s == 0 && lane_id() == 0) a.out[0] += (float)((volatile LAS unsigned*)((LAS unsigned char*)lds + LDSCTL_OFF + 512))[1] * 0.0001f;
#endif
}

extern "C" void kernel_launch(void* const* d_in, const int* in_sizes, int n_in, void* d_out, int out_size, void* d_ws, size_t ws_size, hipStream_t stream) {
    static int grid = 0;
    if (grid == 0) {
        if (n_in != 24 || out_size != MROWS * DM || ws_size < WS_END) { fprintf(stderr, "kernel_launch: unexpected shapes (n_in %d out %d ws %zu)\n", n_in, out_size, ws_size); grid = -1; return; }
        int dev = 0, cus = 0, per_cu = 0;
        hipGetDevice(&dev); hipDeviceGetAttribute(&cus, hipDeviceAttributeMultiprocessorCount, dev);
        if (hipFuncSetAttribute((const void*)mk_fwd, hipFuncAttributeMaxDynamicSharedMemorySize, LDS_BYTES) != hipSuccess) { fprintf(stderr, "kernel_launch: hipFuncSetAttribute failed\n"); grid = -1; return; }
        hipOccupancyMaxActiveBlocksPerMultiprocessor(&per_cu, (const void*)mk_fwd, NWAVES * 64, LDS_BYTES);
        (void)hipGetLastError();
        if (per_cu < 1) { fprintf(stderr, "kernel_launch: occupancy query says %d blocks per CU\n", per_cu); }
        grid = cus;
    }
    if (grid < 0) return;
    hipMemsetAsync((char*)d_ws + WS_CTL, 0, 32768, stream);
    Args a{};
    for (int i = 0; i < 24; ++i) a.in[i] = (const float*)d_in[i];
    a.out = (float*)d_out; a.ws = (unsigned char*)d_ws;
    void* args[] = {&a};
#ifdef PLAIN_LAUNCH
    hipLaunchKernelGGL(mk_fwd, dim3(grid), dim3(NWAVES * 64), LDS_BYTES, stream, a); hipError_t e = hipPeekAtLastError(); (void)args;
#else
    hipError_t e = hipLaunchCooperativeKernel((const void*)mk_fwd, dim3(grid), dim3(NWAVES * 64), args, LDS_BYTES, stream);
#endif
    if (e != hipSuccess) fprintf(stderr, "cooperative launch failed: %s (grid %d)\n", hipGetErrorString(e), grid);
}
```

```cpp
#define PLAIN_LAUNCH 1
#include <hip/hip_runtime.h>
#include <hip/hip_cooperative_groups.h>
#include <stdint.h>
#include <cstdio>
namespace cg = cooperative_groups;

typedef unsigned short bf16_t;
typedef short bf16x8 __attribute__((ext_vector_type(8)));
typedef float f32x4 __attribute__((ext_vector_type(4)));
typedef unsigned u32x4 __attribute__((ext_vector_type(4)));
typedef unsigned u32x2 __attribute__((ext_vector_type(2)));

constexpr int NB = 8, SEQ = 2048, NMETA = 16, LTOT = 2064, DM = 1024, DEPTH = 4, NH = 8, HD = 64;
constexpr int N_IN = 3880, DFF = 2816, DFF2 = 5632;
constexpr int MROWS = NB * SEQ;
constexpr int RROWS = MROWS + NMETA;
constexpr int N1 = 4096;
constexpr int PBW = 3584;
constexpr int PNW = 320;
constexpr float LOG2E = 1.4426950408889634f;

constexpr size_t MiB = 1u << 20;
constexpr size_t WS_CTL = 0, CTL_ZERO_BYTES = 1 * MiB;
constexpr size_t WS_W = 1 * MiB, WL_BYTES = 27 * MiB;
constexpr size_t WO_W1 = 0;
constexpr size_t WO_W2 = 8 * MiB;
constexpr size_t WO_W3 = 10 * MiB;
constexpr size_t WO_W4 = 21 * MiB;
constexpr size_t WO_LUP = 26 * MiB + 512 * 1024;
constexpr size_t WS_SMALL = WS_W + 2 * WL_BYTES;
constexpr size_t WS_HM = WS_SMALL;
constexpr size_t WS_C2 = WS_SMALL + 1 * MiB;
constexpr size_t WS_SSQ = WS_SMALL + 3 * MiB;
constexpr size_t WS_HB = WS_SMALL + 6 * MiB;
constexpr size_t WS_P = WS_HB + 33 * MiB;
constexpr size_t WS_PN = WS_P + 113 * MiB;
constexpr size_t WS_Y = WS_PN + 21 * MiB;
constexpr size_t WS_FREE = WS_Y + 33 * MiB;
constexpr int NCH = 129;
constexpr size_t RA_BYTES = 8192, RB_BYTES = 4096;
constexpr size_t WS_RA = WS_FREE;
#define SWZ4(r) (3 * (((r) >> 3) & 1))
constexpr size_t WS_ACT = WS_P;
constexpr size_t WS_FIX = WS_PN;
constexpr size_t WS_RAWM = WS_PN + 6 * MiB;
constexpr size_t WS_BV = WS_RA + 65 * MiB;
constexpr size_t WS_END = WS_BV + 17 * MiB;

__device__ __forceinline__ float bf2f(bf16_t v) { return __uint_as_float(((unsigned)v) << 16); }
typedef float f32x2_t_ __attribute__((ext_vector_type(2))); typedef __bf16 bf16x2_t_ __attribute__((ext_vector_type(2)));
__device__ __forceinline__ unsigned pk2bf(float lo, float hi) { const f32x2_t_ v = {lo, hi}; return __builtin_bit_cast(unsigned, __builtin_convertvector(v, bf16x2_t_)); }
__device__ __forceinline__ bf16_t f2bf(float f) { return __builtin_bit_cast(bf16_t, (__bf16)f); }
__device__ __forceinline__ float sigmoidf_(float x) { return 1.f / (1.f + __expf(-x)); }
__device__ __forceinline__ float wave_sum_dpp(float v) {
#define DPPF_(x, ctrl, rmask) __int_as_float(__builtin_amdgcn_update_dpp(0, __float_as_int(x), ctrl, rmask, 0xf, false))
    v += DPPF_(v, 0xB1, 0xf);
    v += DPPF_(v, 0x4E, 0xf);
    v += DPPF_(v, 0x141, 0xf);
    v += DPPF_(v, 0x140, 0xf);
    v += DPPF_(v, 0x142, 0xa);
    v += DPPF_(v, 0x143, 0xc);
#undef DPPF_
    return __int_as_float(__builtin_amdgcn_readlane(__float_as_int(v), 63));
}
__device__ __forceinline__ float wave_sum(float v) { return wave_sum_dpp(v); }
__device__ __forceinline__ void wave_sum_dpp8(float (&v)[8]) {
#define DPPF_(x, ctrl, rmask) __int_as_float(__builtin_amdgcn_update_dpp(0, __float_as_int(x), ctrl, rmask, 0xf, false))
#define DPPS_(ctrl, rmask) _Pragma("unroll") for (int j_ = 0; j_ < 8; ++j_) v[j_] += DPPF_(v[j_], ctrl, rmask);
    DPPS_(0xB1, 0xf) DPPS_(0x4E, 0xf) DPPS_(0x141, 0xf) DPPS_(0x140, 0xf) DPPS_(0x142, 0xa) DPPS_(0x143, 0xc)
#undef DPPS_
#undef DPPF_
#pragma unroll
    for (int j_ = 0; j_ < 8; ++j_) v[j_] = __int_as_float(__builtin_amdgcn_readlane(__float_as_int(v[j_]), 63));
}
__device__ __forceinline__ float wave_max(float v) {
#define DPPF_(x, ctrl, rmask) __int_as_float(__builtin_amdgcn_update_dpp(__float_as_int(x), __float_as_int(x), ctrl, rmask, 0xf, false))
    v = fmaxf(v, DPPF_(v, 0xB1, 0xf)); v = fmaxf(v, DPPF_(v, 0x4E, 0xf)); v = fmaxf(v, DPPF_(v, 0x141, 0xf)); v = fmaxf(v, DPPF_(v, 0x140, 0xf));
    v = fmaxf(v, DPPF_(v, 0x142, 0xa)); v = fmaxf(v, DPPF_(v, 0x143, 0xc));
#undef DPPF_
    return __int_as_float(__builtin_amdgcn_readlane(__float_as_int(v), 63));
}
__device__ __forceinline__ float add_xor16(float x) { const auto r = __builtin_amdgcn_permlane16_swap(__float_as_uint(x), __float_as_uint(x), false, false); return __uint_as_float(r[0]) + __uint_as_float(r[1]); }
__device__ __forceinline__ float add_xor32(float x) { const auto r = __builtin_amdgcn_permlane32_swap(__float_as_uint(x), __float_as_uint(x), false, false); return __uint_as_float(r[0]) + __uint_as_float(r[1]); }
__device__ __forceinline__ int lane_id() { int l; asm volatile("v_mbcnt_lo_u32_b32 %0, -1, 0\n\tv_mbcnt_hi_u32_b32 %0, -1, %0" : "=v"(l)); return l; }
#define WAVE_LDS_SYNC() do { __builtin_amdgcn_s_waitcnt(0xc07f); __builtin_amdgcn_wave_barrier(); } while (0)
__device__ __forceinline__ int rowof(int b, int t) { return t < NMETA ? MROWS + t : b * SEQ + (t - NMETA); }
__device__ __forceinline__ int prevrow(int row) {
    if (row >= MROWS) return row == MROWS ? -1 : row - 1;
    return (row & (SEQ - 1)) ? row - 1 : MROWS + NMETA - 1;
}

#define PERM32(j) (8 * (((j) >> 2) & 3) + 4 * ((j) >> 4) + ((j) & 3))
__device__ __forceinline__ int src_col(int mode, int n) {
    if (mode == 1) {
        const int g = n >> 9, c_ = n & 255, o = (n & 256) + (g < 7 ? ((c_ >> 5) & 3) * 64 + (c_ >> 7) * 32 + PERM32(c_ & 31) : c_);
        switch (g) {
            case 0: return o;
            case 1: return 512 + o;
            case 2: return 1024 + o;
            case 3: return 1824 + o;
            case 4: return 2336 + o;
            case 5: return 2848 + o;
            case 6: return 3360 + o;
            default:
                if (o < 64) return 1536 + o;
                if (o < 128) return 1600 + (o - 64);
                if (o < 288) return 1664 + (o - 128);
                if (o < 296) return 3872 + (o - 288);
                return -1;
        }
    }
    if (mode == 3) { const int t = n >> 8, c = n & 255; return c < 128 ? 128 * t + c : DFF + 128 * t + (c - 128); }
    return (n & ~31) + PERM32(n & 31);
}
__device__ __forceinline__ void wprep_item(const float* W, const float* gk, bf16_t* WT, int K, int Nsrc, int Ndst, int mode, int item, float* scr, int lane) {
    const int nblk = Ndst / 32, kb = item / nblk, nb = item % nblk, k0 = 64 * kb, n0 = 32 * nb;
    const int sc = src_col(mode, n0 + (lane & 31));
    const float* wp = W + (size_t)(k0 + (lane >> 5)) * Nsrc + (sc >= 0 ? sc : 0);
    float v[32];
#pragma unroll
    for (int i = 0; i < 32; ++i) { v[i] = *wp; wp += 2 * (size_t)Nsrc; }
#pragma unroll
    for (int i = 0; i < 32; ++i) scr[(2 * i + (lane >> 5)) * 33 + (lane & 31)] = sc >= 0 ? v[i] : 0.f;
    WAVE_LDS_SYNC();
    const int c = lane & 7;
    f32x4 g0 = (f32x4){1.f, 1.f, 1.f, 1.f}, g1 = g0;
    if (gk) { g0 = *(const f32x4*)(gk + k0 + 8 * c); g1 = *(const f32x4*)(gk + k0 + 8 * c + 4); }
#pragma unroll
    for (int j = 0; j < 4; ++j) {
        const int n = (lane >> 3) + 8 * j; const float* s = scr + (8 * c) * 33 + n;
        u32x4 o;
        o.x = pk2bf(s[0 * 33] * g0[0], s[1 * 33] * g0[1]); o.y = pk2bf(s[2 * 33] * g0[2], s[3 * 33] * g0[3]); o.z = pk2bf(s[4 * 33] * g1[0], s[5 * 33] * g1[1]); o.w = pk2bf(s[6 * 33] * g1[2], s[7 * 33] * g1[3]);
        *(u32x4*)(WT + (size_t)(n0 + n) * K + k0 + 8 * c) = o;
    }
    WAVE_LDS_SYNC();
}
namespace pg8 {
#define PG8_LAS __attribute__((address_space(3)))
typedef unsigned short bf16_t;
typedef short bf16x8 __attribute__((ext_vector_type(8)));
typedef float f32x4 __attribute__((ext_vector_type(4)));
typedef unsigned u32x4 __attribute__((ext_vector_type(4)));
constexpr int BM = 256, BK = 64, HALF = 128, HTB = HALF * BK * 2  , STAGE_BYTES = 8 * HTB, NXCD = 8, WGM = 8;

__host__ __device__ __forceinline__ int lds_byte(int r, int c) { const int st = (r >> 4) * 2 + (c >> 5), rr = r & 15, cc = c & 31, ob = rr * 64 + cc * 2; return st * 1024 + (ob ^ (((ob >> 9) & 1) << 5)); }
__host__ __device__ __forceinline__ void stage_rc(int b, int& R, int& C) { const int st = b / 1024, sb = b % 1024, swz = sb ^ (((sb >> 9) & 1) << 5); R = (st >> 1) * 16 + swz / 64; C = (st & 1) * 32 + (swz % 64) / 2; }
__host__ __device__ __forceinline__ int perm32(int rho) { const int n = rho >> 4, i = rho & 15; return 8 * (i >> 2) + 4 * n + (i & 3); }

struct Unit { int pm, pn, idx; };
struct Gemm { const bf16_t* A; const bf16_t* Bt; int M, N, K; };

struct StaticOrder {
    int nM, nN, nwg, G, c;
    __host__ __device__ void init(int M, int N, int G_, int c_) { nM = M / BM; nN = N / BM; nwg = nM * nN; G = G_; c = c_; }
    __host__ __device__ bool next(int i, Unit& u) const {
        const long L = (long)i * G + c; if (L >= nwg) return false;
        int wgid = (int)L; { const int q = nwg / NXCD, r = nwg % NXCD, xcd = wgid % NXCD, off = wgid / NXCD; wgid = (xcd < r ? xcd * (q + 1) : r * (q + 1) + (xcd - r) * q) + off; }
        const int nig = WGM * nN, gid = wgid / nig, fm = gid * WGM, gsz = (nM - fm) < WGM ? (nM - fm) : WGM;
        u.pm = fm + ((wgid % nig) % gsz); u.pn = (wgid % nig) / gsz; u.idx = i; return true;
    }
    __device__ __forceinline__ void a_ready(const Unit&) const {}
    __device__ __forceinline__ void done(const Unit&) const {}
};

__device__ __forceinline__ float row_rstd(const float* ssqp, int row) {
    const f32x4* sp = (const f32x4*)(ssqp + (size_t)row * 16);
    const f32x4 a = sp[0], b = sp[1], c = sp[2], d = sp[3];
    const float s = (((a.x + a.y) + (a.z + a.w)) + ((b.x + b.y) + (b.z + b.w))) + (((c.x + c.y) + (c.z + c.w)) + ((d.x + d.y) + (d.z + d.w)));
    return 1.0f / sqrtf(s * (1.f / 1024.f) + 1e-6f);
}
struct Epi1 {
    static constexpr bool PERM = false, AFTER_DRAIN = false;
    const PG8_LAS float* rstdl; bf16_t* p; float* pn; const float* q_g; const float* k_g;
    __device__ __forceinline__ void operator()(const f32x4 (&acc)[2][2][4][2], const Unit& u, int wr, int wc, int fr, int fq) const {
        const int row0 = u.pm * BM + wr * 64 + fr;
        const bool isq = (u.pn >> 1) == 3, isk = (u.pn >> 1) == 4;
        f32x4 gsc[2][2];
        if (isq || isk) {
#pragma unroll
            for (int bj = 0; bj < 2; ++bj)
#pragma unroll
                for (int n = 0; n < 2; ++n) gsc[bj][n] = *(const f32x4*)((isq ? q_g : k_g) + 32 * bj + 8 * fq + 4 * n) * (isq ? 0.125f * 1.4426950408889634f : 1.f);
        }
#pragma unroll
        for (int ai = 0; ai < 2; ++ai)
#pragma unroll
            for (int m = 0; m < 4; ++m) {
                const int row = row0 + ai * HALF + m * 16; const float rs = rstdl[u.idx * 256 + wr * 64 + fr + ai * HALF + m * 16];
                f32x4 v[2][2];
#pragma unroll
                for (int bj = 0; bj < 2; ++bj)
#pragma unroll
                    for (int n = 0; n < 2; ++n) v[bj][n] = acc[ai][bj][m][n] * rs;
                if (u.pn < 14) {
                    if (isq || isk) {
                        float ss = 0.f;
#pragma unroll
                        for (int bj = 0; bj < 2; ++bj)
#pragma unroll
                            for (int n = 0; n < 2; ++n) ss += (v[bj][n][0] * v[bj][n][0] + v[bj][n][1] * v[bj][n][1]) + (v[bj][n][2] * v[bj][n][2] + v[bj][n][3] * v[bj][n][3]);
                        ss = add_xor16(ss); ss = add_xor32(ss);
                        const float rn = 1.0f / sqrtf(ss * (1.f / 64.f) + 1e-6f);
#pragma unroll
                        for (int bj = 0; bj < 2; ++bj)
#pragma unroll
                            for (int n = 0; n < 2; ++n) v[bj][n] = v[bj][n] * gsc[bj][n] * rn;
                    }
#pragma unroll
                    for (int bj = 0; bj < 2; ++bj) { u32x4 w; w.x = pk2bf(v[bj][0][0], v[bj][0][1]); w.y = pk2bf(v[bj][0][2], v[bj][0][3]); w.z = pk2bf(v[bj][1][0], v[bj][1][1]); w.w = pk2bf(v[bj][1][2], v[bj][1][3]);
                        *(u32x4*)(p + (size_t)row * PBW + u.pn * BM + wc * 64 + bj * 32 + 8 * fq) = w; }
                } else {
#pragma unroll
                    for (int bj = 0; bj < 2; ++bj)
#pragma unroll
                        for (int n = 0; n < 2; ++n) { const int o = u.pn * BM + wc * 32 + 4 * fq + bj * HALF + n * 16 - PBW; if (o < 296) *(f32x4*)(pn + (size_t)row * PNW + o) = v[bj][n]; }
                }
            }
    }
};
struct EpiRes {
    static constexpr bool PERM = false, AFTER_DRAIN = false;
    float* outp; bf16_t* hb; float* ssqp;
    __device__ __forceinline__ void operator()(const f32x4 (&acc)[2][2][4][2], const Unit& u, int wr, int wc, int fr, int fq) const {
        const int row0 = u.pm * BM + wr * 64 + fr, col0 = u.pn * BM + wc * 32 + 8 * fq;
#pragma unroll
        for (int ai = 0; ai < 2; ++ai) {
            u32x4 hw[4][2];
#pragma unroll
            for (int m = 0; m < 4; ++m)
#pragma unroll
                for (int bj = 0; bj < 2; ++bj) hw[m][bj] = *(const u32x4*)(hb + (size_t)(row0 + ai * HALF + m * 16) * DM + col0 + bj * HALF);
            asm volatile("s_waitcnt vmcnt(0)" ::: "memory");
#pragma unroll
            for (int m = 0; m < 4; ++m) {
                const int row = row0 + ai * HALF + m * 16; float ss = 0.f;
#pragma unroll
                for (int bj = 0; bj < 2; ++bj) {
                    const int col = col0 + bj * HALF; bf16_t* hp = hb + (size_t)row * DM + col;
                    const u32x4 h4 = hw[m][bj];
                    const f32x4 v0 = (f32x4){__uint_as_float(h4.x << 16), __uint_as_float(h4.x & 0xffff0000u), __uint_as_float(h4.y << 16), __uint_as_float(h4.y & 0xffff0000u)} + acc[ai][bj][m][0];
                    const f32x4 v1 = (f32x4){__uint_as_float(h4.z << 16), __uint_as_float(h4.z & 0xffff0000u), __uint_as_float(h4.w << 16), __uint_as_float(h4.w & 0xffff0000u)} + acc[ai][bj][m][1];
                    u32x4 w; w.x = pk2bf(v0[0], v0[1]); w.y = pk2bf(v0[2], v0[3]); w.z = pk2bf(v1[0], v1[1]); w.w = pk2bf(v1[2], v1[3]);
                    *(u32x4*)hp = w;
                    if (outp) { *(f32x4*)(outp + (size_t)row * DM + col) = v0; *(f32x4*)(outp + (size_t)row * DM + col + 4) = v1; }
                    const f32x4 r0 = (f32x4){__uint_as_float(w.x << 16), __uint_as_float(w.x & 0xffff0000u), __uint_as_float(w.y << 16), __uint_as_float(w.y & 0xffff0000u)};
                    const f32x4 r1 = (f32x4){__uint_as_float(w.z << 16), __uint_as_float(w.z & 0xffff0000u), __uint_as_float(w.w << 16), __uint_as_float(w.w & 0xffff0000u)};
                    ss += ((r0[0] * r0[0] + r0[1] * r0[1]) + (r0[2] * r0[2] + r0[3] * r0[3])) + ((r1[0] * r1[0] + r1[1] * r1[1]) + (r1[2] * r1[2] + r1[3] * r1[3]));
                }
                ss = add_xor16(ss); ss = add_xor32(ss);
                if (fq == 0) ssqp[(size_t)row * 16 + u.pn * 4 + wc] = ss;
            }
        }
    }
};
__device__ __forceinline__ float dpp_ror1(float x) { return __int_as_float(__builtin_amdgcn_mov_dpp(__float_as_int(x), 0x121, 0xf, 0xf, true)); }
__device__ __forceinline__ float dpp_ror2(float x) { return __int_as_float(__builtin_amdgcn_mov_dpp(__float_as_int(x), 0x122, 0xf, 0xf, true)); }
__device__ __forceinline__ float vmul_s(float a, float b) { float r; asm volatile("v_mul_f32_e32 %0, %1, %2" : "=v"(r) : "v"(a), "v"(b)); return r; }
struct EpiConv {
    static constexpr bool PERM = false, AFTER_DRAIN = false;
    const PG8_LAS float* rstdl; const float* cw; const float* cb; bf16_t* act; float* fix; PG8_LAS unsigned char* halo; PG8_LAS float* ctab;
    __device__ __forceinline__ void operator()(const f32x4 (&acc)[2][2][4][2], const Unit& u, int wr, int wc, int fr_, int fq_) const {
        int fr = fr_, fq = fq_; asm volatile("" : "+v"(fr), "+v"(fq));
        const int row0 = u.pm * BM + wr * 64 + fr, cl = wc * 32 + 4 * fq;
        {
            const int q = 2 * ((wr * 4 + wc) * 64 + fq * 16 + fr), p = q >> 8, col = q & 255;
            const float* src = (p < 3 ? cw + (size_t)p * DFF2 : cb) + (col < 128 ? 128 * u.pn + col : DFF + 128 * u.pn + (col - 128));
            typedef float f32x2w __attribute__((ext_vector_type(2)));
            *(PG8_LAS f32x2w*)(ctab + q) = *(const f32x2w*)src;
        }
        float rs[2][4];
#pragma unroll
        for (int ai = 0; ai < 2; ++ai)
#pragma unroll
            for (int m = 0; m < 4; ++m) rs[ai][m] = rstdl[u.idx * 256 + wr * 64 + fr + ai * HALF + m * 16];
        if (fr >= 14) {
#pragma unroll
            for (int ai = 0; ai < 2; ++ai)
#pragma unroll
                for (int bj = 0; bj < 2; ++bj)
#pragma unroll
                    for (int n = 0; n < 2; ++n) { const f32x4 v = acc[ai][bj][3][n] * rs[ai][3];
                        *(PG8_LAS f32x4*)(halo + ((((ai * 2 + wr) * 2 + (fr - 14)) * 256) + bj * HALF + cl + n * 16) * 4) = v;
                        if (ai == 1 && wr == 1) *(f32x4*)(fix + (size_t)(u.pm * 4 + 2 + (fr - 14)) * DFF2 + bj * DFF + 128 * u.pn + cl + n * 16) = v; }
        }
        if (fr < 2 && wr == 0) {
#pragma unroll
            for (int bj = 0; bj < 2; ++bj)
#pragma unroll
                for (int n = 0; n < 2; ++n) *(f32x4*)(fix + (size_t)(u.pm * 4 + fr) * DFF2 + bj * DFF + 128 * u.pn + cl + n * 16) = acc[0][bj][0][n] * rs[0][0];
        }
        asm volatile("s_waitcnt lgkmcnt(0)\n\ts_barrier" ::: "memory");
        typedef float f32x2v __attribute__((ext_vector_type(2)));
#pragma unroll
        for (int n = 0; n < 2; ++n) {
            const unsigned la2 = (unsigned)(fr * DFF + cl) * 2u;
            unsigned wpk[2][2][4];
#pragma unroll
            for (int eh = 0; eh < 2; ++eh) {
                asm volatile("" ::: "memory"); __builtin_amdgcn_sched_barrier(0);
                const int e = 2 * eh;
#define CWL(p, g) (*(const PG8_LAS f32x2v*)(ctab + (p) * 256 + (g) * 128 + cl + n * 16 + e))
                const f32x2v wu0 = CWL(0, 0), wu1 = CWL(1, 0), wu2 = CWL(2, 0), bu = CWL(3, 0);
                const f32x2v wg0 = CWL(0, 1), wg1 = CWL(1, 1), wg2 = CWL(2, 1), bg = CWL(3, 1);
#undef CWL
#pragma unroll
                for (int ai = 0; ai < 2; ++ai) {
                    const int ps = (ai * 2 + wr) ? (ai * 2 + wr - 1) : 0;
                    const PG8_LAS float* hp = (const PG8_LAS float*)halo + (ps * 2) * 256 + cl + n * 16 + e;
                    const f32x2v hu62 = *(const PG8_LAS f32x2v*)hp, hu63 = *(const PG8_LAS f32x2v*)(hp + 256), hg62 = *(const PG8_LAS f32x2v*)(hp + 128), hg63 = *(const PG8_LAS f32x2v*)(hp + 256 + 128);
                    f32x2v p1u = hu63, p1g = hg63, p2u = fr == 0 ? hu62 : hu63, p2g = fr == 0 ? hg62 : hg63;
#pragma unroll
                    for (int m = 0; m < 4; ++m) {
                        __builtin_amdgcn_sched_barrier(0);
                        f32x2v xu, xg;
                        xu.x = vmul_s(acc[ai][0][m][n][e], rs[ai][m]); xu.y = vmul_s(acc[ai][0][m][n][e + 1], rs[ai][m]); xg.x = vmul_s(acc[ai][1][m][n][e], rs[ai][m]); xg.y = vmul_s(acc[ai][1][m][n][e + 1], rs[ai][m]);
                        f32x2v r1u, r2u, r1g, r2g;
                        r1u.x = dpp_ror1(xu.x); r1u.y = dpp_ror1(xu.y); r2u.x = dpp_ror2(xu.x); r2u.y = dpp_ror2(xu.y);
                        r1g.x = dpp_ror1(xg.x); r1g.y = dpp_ror1(xg.y); r2g.x = dpp_ror2(xg.x); r2g.y = dpp_ror2(xg.y);
                        const f32x2v x1u = fr >= 1 ? r1u : p1u, x2u = fr >= 2 ? r2u : p2u, x1g = fr >= 1 ? r1g : p1g, x2g = fr >= 2 ? r2g : p2g;
                        p1u = r1u; p2u = r2u; p1g = r1g; p2g = r2g;
                        const f32x2v cu = bu + wu0 * x2u + wu1 * x1u + wu2 * xu, cg = bg + wg0 * x2g + wg1 * x1g + wg2 * xg;
                        const float o0 = cg.x * __builtin_amdgcn_rcpf(1.f + __builtin_amdgcn_exp2f(-1.4426950408889634f * cg.x)) * cu.x;
                        const float o1 = cg.y * __builtin_amdgcn_rcpf(1.f + __builtin_amdgcn_exp2f(-1.4426950408889634f * cg.y)) * cu.y;
                        wpk[eh][ai][m] = pk2bf(o0, o1);
                    }
                }
            }
#pragma unroll
            for (int ai = 0; ai < 2; ++ai)
#pragma unroll
                for (int m = 0; m < 4; ++m)
                {
                    u32x2 w; w.x = wpk[0][ai][m]; w.y = wpk[1][ai][m];
                    *(u32x2*)((char*)(act + (size_t)(u.pm * BM + wr * 64 + ai * HALF + m * 16) * DFF + 128 * u.pn + n * 16) + la2) = w; }
        }
    }
};

#ifdef TPROBE
#ifndef TPROBE_PH
#define TPROBE_PH -1
#endif
#define PG8_TP(ph) do { if (TPROBE < 20) break; const unsigned t_ = (unsigned)__builtin_amdgcn_s_memrealtime(); if (wave_s == 0 && lane_id() == 0) { volatile PG8_LAS unsigned* q_ = (volatile PG8_LAS unsigned*)(lds + (163840 - 1024 + 512)); \
        if ((ph) == TPROBE && (TPROBE_PH < 0 || q_[2] == (unsigned)TPROBE_PH)) q_[1] += t_ - q_[0]; q_[0] = t_; } } while (0)
#else
#define PG8_TP(ph) do {} while (0)
#endif
template <class Epi, class Sched, bool ALIGN_EPI = false, bool SP2 = false>
__device__ __forceinline__ void gemm_phase(PG8_LAS unsigned char* lds, const Gemm g, const Sched& S, const Epi& E, const int wave_s) {
    int tid_ = wave_s * 64 + lane_id(); asm volatile("" : "+v"(tid_));
    const int tid = tid_, wid = wave_s, lane = tid & 63, wr = wid >> 2, wc = wid & 3, fr = lane & 15, fq = lane >> 4;
    const int K = g.K, nt = K / BK;
    unsigned voffA[2], voffB[2];
#pragma unroll
    for (int i = 0; i < 2; ++i) { int R, C; stage_rc(tid * 16 + i * 8192, R, C); const int Rb = Epi::PERM ? ((R & ~31) + perm32(R & 31)) : R;
        voffA[i] = (unsigned)(R * K + C) * 2u; voffB[i] = (unsigned)(Rb * K + C) * 2u; }
    const size_t kstep = (size_t)(BK * 2);
    const size_t hstep = (size_t)HALF * K * 2;
    const size_t tstep = 2 * hstep;
    const unsigned ldsw = (unsigned)wid * 1024u;
    const int aoff = lds_byte(wr * 64 + fr, fq * 8), boff = lds_byte(wc * 32 + fr, fq * 8);
#define PG8_SA(b, h) (((b) * 2 + (h)) * HTB)
#define PG8_SB(b, h) ((4 + (b) * 2 + (h)) * HTB)
#define PG8_STAGE(bufoff, gbase, voff) do { _Pragma("unroll") for (int _i = 0; _i < 2; ++_i) \
        __builtin_amdgcn_global_load_lds((const unsigned*)((const char*)(gbase) + (voff)[_i]), (PG8_LAS unsigned*)(lds + (bufoff) + ldsw + _i * 8192), 16, 0, 0); } while (0)
#define PG8_LDA(dst, b, h) do { _Pragma("unroll") for (int m = 0; m < 4; ++m) _Pragma("unroll") for (int k = 0; k < 2; ++k) dst[m][k] = *(const PG8_LAS bf16x8*)(lds + PG8_SA(b, h) + aoff + m * 2048 + k * 1024); } while (0)
#define PG8_LDB(dst, b, h) do { _Pragma("unroll") for (int n = 0; n < 2; ++n) _Pragma("unroll") for (int k = 0; k < 2; ++k) dst[n][k] = *(const PG8_LAS bf16x8*)(lds + PG8_SB(b, h) + boff + n * 2048 + k * 1024); } while (0)
#define PG8_MMA(ai, bj, At, Bt) do { __builtin_amdgcn_s_setprio(1); _Pragma("unroll") for (int m = 0; m < 4; ++m) _Pragma("unroll") for (int n = 0; n < 2; ++n) _Pragma("unroll") for (int k = 0; k < 2; ++k) \
        acc[ai][bj][m][n] = __builtin_amdgcn_mfma_f32_16x16x32_bf16(Bt[n][k], At[m][k], acc[ai][bj][m][n], 0, 0, 0); __builtin_amdgcn_s_setprio(0); } while (0)
#define PG8_WAIT_V(n) asm volatile("s_waitcnt vmcnt(" #n ")" ::: "memory")
#define PG8_WAIT_L(n) asm volatile("s_waitcnt lgkmcnt(" #n ")" ::: "memory")
#define PG8_BAR __builtin_amdgcn_s_barrier()
#define PG8_SCHED __builtin_amdgcn_sched_barrier(0)
    Unit cur, nxt; int ui = 0;
    if (!S.next(0, cur)) return;
    f32x4 acc[2][2][4][2];
#pragma unroll
    for (int a = 0; a < 2; ++a)
#pragma unroll
        for (int b = 0; b < 2; ++b)
#pragma unroll
            for (int m = 0; m < 4; ++m)
#pragma unroll
                for (int n = 0; n < 2; ++n) acc[a][b][m][n] = (f32x4){0.f, 0.f, 0.f, 0.f};
    bf16x8 At[4][2], B0[2][2], B1[2][2];
    const char* cA = (const char*)g.A + (size_t)cur.pm * tstep; const char* cB = (const char*)g.Bt + (size_t)cur.pn * tstep;
    S.a_ready(cur);
    if constexpr (SP2) {
        PG8_STAGE(PG8_SB(0, 0), cB, voffB); PG8_STAGE(PG8_SB(0, 1), cB + hstep, voffB); PG8_STAGE(PG8_SA(0, 0), cA, voffA); PG8_STAGE(PG8_SA(0, 1), cA + hstep, voffA);
        if (wr == 1) PG8_BAR;
        PG8_WAIT_V(2); PG8_BAR;
        PG8_STAGE(PG8_SB(1, 0), cB + kstep, voffB); PG8_STAGE(PG8_SA(1, 0), cA + kstep, voffA); PG8_STAGE(PG8_SB(1, 1), cB + hstep + kstep, voffB);
        PG8_WAIT_V(6); PG8_BAR;
    } else {
        PG8_STAGE(PG8_SB(0, 0), cB, voffB); PG8_STAGE(PG8_SA(0, 0), cA, voffA); PG8_STAGE(PG8_SB(0, 1), cB + hstep, voffB); PG8_STAGE(PG8_SA(0, 1), cA + hstep, voffA);
        if (wr == 1) PG8_BAR;
        PG8_WAIT_V(4); PG8_BAR;
        PG8_STAGE(PG8_SB(1, 0), cB + kstep, voffB); PG8_STAGE(PG8_SA(1, 0), cA + kstep, voffA); PG8_STAGE(PG8_SB(1, 1), cB + hstep + kstep, voffB);
        PG8_WAIT_V(6); PG8_BAR;
    }
    for (;;) {
        const bool has_next = S.next(ui + 1, nxt);
        const char* nA = has_next ? (const char*)g.A + (size_t)nxt.pm * tstep : cA; const char* nB = has_next ? (const char*)g.Bt + (size_t)nxt.pn * tstep : cB;
        for (int t = 0; t < nt; t += 2) {
            const bool last = (t == nt - 2);
            const char* a1 = cA + (size_t)(t + 1) * kstep;
            const char* a2 = last ? nA : cA + (size_t)(t + 2) * kstep; const char* b2 = last ? nB : cB + (size_t)(t + 2) * kstep;
            const char* a3 = a2 + kstep; const char* b3 = b2 + kstep;
            if (last && has_next) S.a_ready(nxt);
            if constexpr (SP2) {
            PG8_LDB(B0, 0, 0); PG8_LDB(B1, 0, 1); PG8_SCHED; PG8_LDA(At, 0, 0); PG8_STAGE(PG8_SA(1, 1), a1 + hstep, voffA);
            PG8_WAIT_V(8); PG8_WAIT_L(0); PG8_BAR; PG8_MMA(0, 0, At, B0); PG8_MMA(0, 1, At, B1); PG8_BAR; PG8_SCHED;
            PG8_LDA(At, 0, 1); PG8_STAGE(PG8_SB(0, 0), b2, voffB); PG8_STAGE(PG8_SB(0, 1), b2 + hstep, voffB); PG8_STAGE(PG8_SA(0, 0), a2, voffA);
            PG8_WAIT_V(8); PG8_WAIT_L(0); PG8_BAR; PG8_MMA(1, 0, At, B0); PG8_MMA(1, 1, At, B1); PG8_BAR; PG8_SCHED;
            PG8_LDB(B0, 1, 0); PG8_LDB(B1, 1, 1); PG8_SCHED; PG8_LDA(At, 1, 0); PG8_STAGE(PG8_SA(0, 1), a2 + hstep, voffA);
            PG8_WAIT_V(8); PG8_WAIT_L(0); PG8_BAR; PG8_MMA(0, 0, At, B0); PG8_MMA(0, 1, At, B1); PG8_BAR; PG8_SCHED;
            PG8_LDA(At, 1, 1); PG8_STAGE(PG8_SB(1, 0), b3, voffB); PG8_STAGE(PG8_SB(1, 1), b3 + hstep, voffB); PG8_STAGE(PG8_SA(1, 0), a3, voffA);
            PG8_WAIT_V(8); PG8_WAIT_L(0); PG8_BAR; PG8_MMA(1, 0, At, B0); PG8_MMA(1, 1, At, B1); PG8_BAR; PG8_SCHED;
            } else {
            PG8_LDB(B0, 0, 0); PG8_SCHED; PG8_LDA(At, 0, 0); PG8_STAGE(PG8_SA(1, 1), a1 + hstep, voffA);
            PG8_WAIT_L(8); PG8_BAR; PG8_WAIT_L(0); PG8_MMA(0, 0, At, B0); PG8_BAR; PG8_SCHED;
            PG8_LDB(B1, 0, 1); PG8_STAGE(PG8_SB(0, 0), b2, voffB);
            PG8_BAR; PG8_WAIT_L(0); PG8_MMA(0, 1, At, B1); PG8_BAR;
            PG8_LDA(At, 0, 1); PG8_STAGE(PG8_SA(0, 0), a2, voffA);
            PG8_BAR; PG8_WAIT_L(0); PG8_MMA(1, 0, At, B0); PG8_BAR; PG8_SCHED;
            PG8_STAGE(PG8_SB(0, 1), b2 + hstep, voffB);
            PG8_WAIT_V(6); PG8_BAR; PG8_MMA(1, 1, At, B1); PG8_BAR;
            PG8_LDB(B0, 1, 0); PG8_SCHED; PG8_LDA(At, 1, 0); PG8_STAGE(PG8_SA(0, 1), a2 + hstep, voffA);
            PG8_WAIT_L(8); PG8_BAR; PG8_WAIT_L(0); PG8_MMA(0, 0, At, B0); PG8_BAR; PG8_SCHED;
            PG8_LDB(B1, 1, 1); PG8_STAGE(PG8_SB(1, 0), b3, voffB);
            PG8_BAR; PG8_WAIT_L(0); PG8_MMA(0, 1, At, B1); PG8_BAR;
            PG8_LDA(At, 1, 1); PG8_STAGE(PG8_SA(1, 0), a3, voffA);
            PG8_BAR; PG8_WAIT_L(0); PG8_MMA(1, 0, At, B0); PG8_BAR; PG8_SCHED;
            PG8_STAGE(PG8_SB(1, 1), b3 + hstep, voffB);
            PG8_WAIT_V(6); PG8_BAR; PG8_MMA(1, 1, At, B1); PG8_BAR;
            }
        }
        PG8_TP(49);
        if constexpr (ALIGN_EPI) { if (wr == 0) PG8_BAR; }
        if constexpr (!Epi::AFTER_DRAIN) { E(acc, cur, wr, wc, fr, fq); S.done(cur); }
        PG8_TP(50);
        if (!has_next) break;
#pragma unroll
        for (int a = 0; a < 2; ++a)
#pragma unroll
            for (int b = 0; b < 2; ++b)
#pragma unroll
                for (int m = 0; m < 4; ++m)
#pragma unroll
                    for (int n = 0; n < 2; ++n) acc[a][b][m][n] = (f32x4){0.f, 0.f, 0.f, 0.f};
        cur = nxt; cA = nA; cB = nB; ++ui;
        if constexpr (ALIGN_EPI) { if (wr == 1) PG8_BAR; }
    }
    PG8_WAIT_V(0);
    if constexpr (!ALIGN_EPI) { if (wr == 0) PG8_BAR; }
    PG8_BAR;
    if constexpr (Epi::AFTER_DRAIN) { E.fused(acc, cur, wr, wc, fr, fq, lds, wid, lane); S.done(cur); }
#undef PG8_SA
#undef PG8_SB
#undef PG8_STAGE
#undef PG8_LDA
#undef PG8_LDB
#undef PG8_MMA
#undef PG8_WAIT_V
#undef PG8_WAIT_L
#undef PG8_BAR
#undef PG8_SCHED
}
}
#include <hip/hip_bf16.h>
#include <cmath>
namespace attn_body {
using bf16=__hip_bfloat16;
using bf16x8=__attribute__((ext_vector_type(8)))short;
using s16x4=__attribute__((ext_vector_type(4)))short;
using f32x16=__attribute__((ext_vector_type(16)))float;
using u32x4=__attribute__((ext_vector_type(4)))unsigned;
constexpr int BATCH=8,NHEAD=8,SEQ=2048,D=64,PITCH=3584,OPITCH=1024,LEADROW=16384,VK=2176;
constexpr int NW=8,QBLK=32,QB=QBLK*NW,KVBLK=64,NQB=SEQ/QB;
constexpr int ATTN_UNIT_ROWS=QB;
__device__ __forceinline__ int crow(int r,int hi){return (r&3)+8*(r>>2)+4*hi;}
#define SBAR() __builtin_amdgcn_sched_barrier(0)
__device__ __forceinline__ void cmask(f32x16&p0,f32x16&p1,int jb,int qrel,int hi){
  const float NEG=-INFINITY; int kb=64*jb+4*hi;
  #pragma unroll
  for(int r=0;r<16;++r){int kv=kb+(r&3)+8*(r>>2); if(kv>qrel)p0[r]=NEG; if(kv+32>qrel)p1[r]=NEG;}
}

constexpr int NSLOT=3, SLOTB=8192;
constexpr int LDS_K=0, LDS_V=NSLOT*SLOTB, LDS_WS=2*NSLOT*SLOTB, LDS_OST=LDS_WS+NW*64*4, LDS_C2=LDS_OST+NW*4096, LDS_BYTES=LDS_C2+VK*4;
constexpr float C2=0.125f*1.4426950408889634f;
__device__ __forceinline__ void glds16(const void*gsrc,unsigned lds_dst){unsigned keep;
  asm volatile("s_mov_b32 %0, m0\n\ts_mov_b32 m0, %2\n\ts_nop 0\n\tglobal_load_lds_dwordx4 %1, off\n\ts_mov_b32 m0, %0":"=&s"(keep):"v"(gsrc),"s"(lds_dst):"memory");}
__device__ __forceinline__ float max3f(float a,float b,float c){float r;asm("v_max3_f32 %0, %1, %2, %3":"=v"(r):"v"(a),"v"(b),"v"(c));return r;}
__device__ __forceinline__ float max2f(float a,float b){float r;asm("v_max_f32_e32 %0, %1, %2":"=v"(r):"v"(a),"v"(b));return r;}
__device__ __forceinline__ float fadd_s(float a,float b){float r;asm("v_add_f32_e32 %0, %1, %2":"=v"(r):"v"(a),"v"(b));return r;}
__device__ __forceinline__ float fsub_s(float a,float b){float r;asm("v_sub_f32_e32 %0, %1, %2":"=v"(r):"v"(a),"v"(b));return r;}
typedef float f32x2_t __attribute__((ext_vector_type(2))); typedef __bf16 bf16x2_t __attribute__((ext_vector_type(2)));
__device__ __forceinline__ unsigned cvtpk_s(float lo,float hi){f32x2_t v={lo,hi};bf16x2_t b=__builtin_convertvector(v,bf16x2_t);return __builtin_bit_cast(unsigned,b);}
#define WAIT_BAR(N) asm volatile("s_waitcnt vmcnt(" #N ") lgkmcnt(0)\n\ts_barrier":::"memory")

__device__ __forceinline__ void qkt(f32x16&p0,f32x16&p1,const char*Kslot,const bf16x8*qr,int r32,int hi){
  const char*kb=Kslot+hi*1024+r32*16;
  #pragma unroll
  for(int d0=0;d0<4;++d0){
    const bf16x8 b0=*reinterpret_cast<const bf16x8*>(kb+d0*2048);
    const bf16x8 b1=*reinterpret_cast<const bf16x8*>(kb+d0*2048+512);
    p0=__builtin_amdgcn_mfma_f32_32x32x16_bf16(b0,qr[d0],p0,0,0,0);p1=__builtin_amdgcn_mfma_f32_32x32x16_bf16(b1,qr[d0],p1,0,0,0);}
}
typedef __attribute__((address_space(3))) const char* lds_cptr;
typedef short v4i16_t __attribute__((ext_vector_type(4)));
__device__ __forceinline__ void kload8(bf16x8*kf,lds_cptr kp){
  kf[0]=*(const __attribute__((address_space(3))) bf16x8*)(kp);      kf[1]=*(const __attribute__((address_space(3))) bf16x8*)(kp+512);
  kf[2]=*(const __attribute__((address_space(3))) bf16x8*)(kp+2048); kf[3]=*(const __attribute__((address_space(3))) bf16x8*)(kp+2560);
  kf[4]=*(const __attribute__((address_space(3))) bf16x8*)(kp+4096); kf[5]=*(const __attribute__((address_space(3))) bf16x8*)(kp+4608);
  kf[6]=*(const __attribute__((address_space(3))) bf16x8*)(kp+6144); kf[7]=*(const __attribute__((address_space(3))) bf16x8*)(kp+6656);
}
__device__ __forceinline__ void kload2(bf16x8*kf,lds_cptr kp,int j){ kf[2*j]=*(const __attribute__((address_space(3))) bf16x8*)(kp+j*2048); kf[2*j+1]=*(const __attribute__((address_space(3))) bf16x8*)(kp+j*2048+512); }
__device__ __forceinline__ s16x4 vtr(lds_cptr p){ return __builtin_bit_cast(s16x4,__builtin_amdgcn_ds_read_tr16_b64_v4i16((__attribute__((address_space(3))) v4i16_t*)p)); }
__device__ __forceinline__ float rowmax(const f32x16&p0,const f32x16&p1){
  float a=max3f(p0[0],p0[1],p1[0]),b=max3f(p0[2],p0[3],p1[1]);a=max3f(a,p1[2],p1[3]);
  #pragma unroll
  for(int r=4;r<16;r+=4){a=max3f(a,p0[r],p0[r+1]);b=max3f(b,p0[r+2],p0[r+3]);a=max3f(a,p1[r],p1[r+1]);b=max3f(b,p1[r+2],p1[r+3]);}
  const float m=max2f(a,b);
  auto rr=__builtin_amdgcn_permlane32_swap(__float_as_uint(m),__float_as_uint(m),false,false);
  return max2f(__uint_as_float(rr[0]),__uint_as_float(rr[1]));
}
__device__ __forceinline__ void pv(f32x16*o,int vb,bf16x8 pa0,bf16x8 pa1,bf16x8 pa2,bf16x8 pa3){
  #pragma unroll
  for(int d0=0;d0<2;++d0){s16x4 lo[4],hi[4];
    #pragma unroll
    for(int ks=0;ks<4;++ks){
      asm volatile("ds_read_b64_tr_b16 %0,%1 offset:%c2":"=&v"(lo[ks]):"v"(vb),"i"(d0*4096+ks*1024):"memory");
      asm volatile("ds_read_b64_tr_b16 %0,%1 offset:%c2":"=&v"(hi[ks]):"v"(vb),"i"(d0*4096+ks*1024+512):"memory");}
    asm volatile("s_waitcnt lgkmcnt(0)":::"memory");SBAR();
    #define PK(k) (bf16x8){lo[k][0],lo[k][1],lo[k][2],lo[k][3],hi[k][0],hi[k][1],hi[k][2],hi[k][3]}
    o[d0]=__builtin_amdgcn_mfma_f32_32x32x16_bf16(pa0,PK(0),o[d0],0,0,0);
    o[d0]=__builtin_amdgcn_mfma_f32_32x32x16_bf16(pa1,PK(1),o[d0],0,0,0);
    o[d0]=__builtin_amdgcn_mfma_f32_32x32x16_bf16(pa2,PK(2),o[d0],0,0,0);
    o[d0]=__builtin_amdgcn_mfma_f32_32x32x16_bf16(pa3,PK(3),o[d0],0,0,0);
    #undef PK
  }
}

#ifndef ATTN_STORE16
#define ATTN_STORE16(p,v) (*(u32x4*)(p)=(v))
#endif
template<int THRL> __device__ __forceinline__ void attn_unit(int b,int h,int qb,const bf16*Q,const bf16*__restrict__ K,const bf16*__restrict__ V,const bf16*__restrict__ OG,const float*__restrict__ c2v,bf16*O,char*shm,const int wave_s,const bool stage_c2=true){
  int tid_=wave_s*64+lane_id(); asm volatile("":"+v"(tid_));
  const int tid=tid_,lane=tid&63,r32=lane&31,hi=lane>>5; const int wid=wave_s;
  const long rowbase=(long)b*SEQ; const int q0=qb*QB;
  const bf16*Qw=Q+(rowbase+q0+wid*QBLK)*PITCH+h*D;
  const bf16*Kh=K+(rowbase-2*KVBLK)*PITCH+h*D,*Vh=V+(rowbase-2*KVBLK)*PITCH+h*D;
  const bf16*KhL=K+(long)LEADROW*PITCH+h*D,*VhL=V+(long)LEADROW*PITCH+h*D;
  const unsigned lds0=(unsigned)(uintptr_t)shm;
  float*wsf=(float*)(shm+LDS_WS)+wid*64;
  const bf16*ksrc=Kh+(long)lane*PITCH+wid*8,*ksrcL=KhL+(long)lane*PITCH+wid*8;
  const bf16*vsrc=Vh+(long)(16*(wid&3)+(lane>>2))*PITCH+(wid>>2)*32+(lane&3)*8,*vsrcL=VhL+(long)(16*(wid&3)+(lane>>2))*PITCH+(wid>>2)*32+(lane&3)*8;
  const unsigned kdst=lds0+LDS_K+wid*1024, vdst=lds0+LDS_V+wid*1024;
  #define DMA_K(t,slot) glds16(((t)<2?ksrcL:ksrc)+(long)(t)*KVBLK*PITCH,(unsigned)__builtin_amdgcn_readfirstlane(kdst+(slot)))
  #define DMA_V(t,slot) glds16(((t)<2?vsrcL:vsrc)+(long)(t)*KVBLK*PITCH,(unsigned)__builtin_amdgcn_readfirstlane(vdst+(slot)))
  const int vb0=(int)(lds0+LDS_V)+((lane>>4)&1)*32+(lane&3)*8+(4*hi+((lane&15)>>2))*64;
  const char*Kbase=shm+LDS_K; bf16x8 kf[8];
  const lds_cptr shm3=(lds_cptr)shm; const lds_cptr kp0=shm3+LDS_K+hi*1024+r32*16; const lds_cptr vp0=shm3+LDS_V+((lane>>4)&1)*32+(lane&3)*8+(4*hi+((lane&15)>>2))*64;
  const int NT=(q0+QB)/KVBLK+2;
  if(stage_c2){ __attribute__((address_space(3))) float*negc_w=(__attribute__((address_space(3))) float*)((lds_cptr)shm+LDS_C2); const float*cs=c2v+(long)(b*NHEAD+h)*VK;
    float cv_[5];
    _Pragma("unroll") for(int i_=0;i_<5;++i_){const int i=tid+i_*NW*64; cv_[i_]=i<NT*KVBLK?cs[i]:0.f;}
    _Pragma("unroll") for(int i_=0;i_<5;++i_){const int i=tid+i_*NW*64; if(i<NT*KVBLK)negc_w[i]=-cv_[i_];} }
  const __attribute__((address_space(3))) float* negc3=(const __attribute__((address_space(3))) float*)((lds_cptr)shm+LDS_C2)+4*hi;
  typedef float f32x4_t __attribute__((ext_vector_type(4)));
  #define NEGC(t,i) (*(const __attribute__((address_space(3))) f32x4_t*)(negc3+64*(t)+(((i)>>2)*32)+8*((i)&3)))
  DMA_K(0,0);DMA_V(0,0);DMA_K(1,SLOTB);
  bf16x8 qr[4];
  #pragma unroll
  for(int d0=0;d0<4;++d0)qr[d0]=*reinterpret_cast<const bf16x8*>(&Qw[(long)r32*PITCH+d0*16+hi*8]);
  float mhat=0.f,l_reg=0.f;f32x16 o[2];o[0]=f32x16{};o[1]=f32x16{};
  const int qrel=wid*QBLK+r32;
  #define CMASK(P0,P1,t) do{int jb_=(t)-(NT-4); if(jb_>=0)cmask(P0,P1,jb_,qrel,hi);}while(0)
  bool resc=false;
  #define START(P0,P1) do{ const float rm=rowmax(P0,P1); resc=false; \
    { const float dl=rm; mhat=fadd_s(mhat,dl); \
      _Pragma("unroll") for(int r=0;r<16;++r){P0[r]=fsub_s(P0[r],dl);P1[r]=fsub_s(P1[r],dl);} } \
    _Pragma("unroll") for(int r=0;r<16;++r)P0[r]=__builtin_amdgcn_exp2f(P0[r]); }while(0)
  #define RESC() do{ if(resc){ asm volatile("s_waitcnt lgkmcnt(0)":::"memory"); \
      _Pragma("unroll") for(int d_=0;d_<2;++d_) _Pragma("unroll") for(int r=0;r<16;++r)o[d_][r]*=wsf[crow(r,hi)]; } }while(0)
  f32x16 pA0,pA1,pB0,pB1;
  int sl_prev=0,sl_cur=0,sl_next=SLOTB;
  #define ROT() do{sl_prev=sl_cur;sl_cur=sl_next;sl_next=(sl_next==(NSLOT-1)*SLOTB)?0:sl_next+SLOTB;}while(0)
  DMA_K(2,2*SLOTB);
  WAIT_BAR(3);
  #define FILLT(P0,P1,t) do{ _Pragma("unroll") for(int i_=0;i_<4;++i_){ const f32x4_t a_=NEGC(t,i_),b_=NEGC(t,4+i_); \
      P0[4*i_]=a_[0]-mhat;P0[4*i_+1]=a_[1]-mhat;P0[4*i_+2]=a_[2]-mhat;P0[4*i_+3]=a_[3]-mhat; P1[4*i_]=b_[0]-mhat;P1[4*i_+1]=b_[1]-mhat;P1[4*i_+2]=b_[2]-mhat;P1[4*i_+3]=b_[3]-mhat; } }while(0)
  FILLT(pA0,pA1,0);
  qkt(pA0,pA1,Kbase,qr,r32,hi);asm volatile("s_nop 15\n\ts_nop 7":"+v"(pA0),"+v"(pA1));CMASK(pA0,pA1,0);
  START(pA0,pA1);
  FILLT(pB0,pB1,1);
  _Pragma("unroll") for(int r=0;r<16;++r)pA1[r]=__builtin_amdgcn_exp2f(pA1[r]);
  WAIT_BAR(0);
  DMA_K(3,0);DMA_V(1,SLOTB);
  ROT();
  kload8(kf,kp0+sl_cur);
  WAIT_BAR(2);
  s16x4 vlo[8],vhi[8]; u32x4 pw0,pw1,pw2,pw3;
  #define PKW(P,B) cvtpk_s(P[B],P[B+1])
  #define PAF(k) __builtin_bit_cast(bf16x8,pw##k)
  #define VFR(i) (bf16x8){vlo[i][0],vlo[i][1],vlo[i][2],vlo[i][3],vhi[i][0],vhi[i][1],vhi[i][2],vhi[i][3]}
  #define PIN(x) asm volatile("":"+v"(x))
  #define MX3(a,b,c) __builtin_fmaxf(__builtin_fmaxf((a),(b)),(c))
  #define GAPA(MF,A0,A1,A2,A3,W0,W1,PW) do{ MF; sacc+=A0; sacc+=A1; sacc+=A2; sacc+=A3; PIN(sacc); W0; W1; PIN(PW); SBAR(); }while(0)
  #define EX(v) __builtin_amdgcn_exp2f(v)
  #define GAPB(MF,X,B,FP,FB,I,t,GF) do{ MF; X[B]=EX(X[B]); X[B+1]=EX(X[B+1]); X[B+2]=EX(X[B+2]); X[B+3]=EX(X[B+3]); \
      if(GF){ FP[FB]=fsub_s(cn_[0],mhat); FP[FB+1]=fsub_s(cn_[1],mhat); FP[FB+2]=fsub_s(cn_[2],mhat); FP[FB+3]=fsub_s(cn_[3],mhat); PIN(FP); if((I)<7){cn_=NEGC((t)+1,(I)+1);} } \
      PIN(X); SBAR(); }while(0)
  #define VRD(i) do{ vlo[i]=vtr(vp_+(((i)>>2)*4096+((i)&3)*1024)); vhi[i]=vtr(vp_+(((i)>>2)*4096+((i)&3)*1024+512)); }while(0)
  #define KRD(G,j) do{ if(G){ kload2(kf,kp0+sl_next,j); SBAR(); } }while(0)
  #define STEP(C0,C1,P0,P1,t,GK,GV,GL) do{ SBAR(); \
    const lds_cptr vp_=vp0+sl_prev; \
    VRD(0); SBAR(); float sacc=(P0[0]+P0[1]); \
    GAPA(C0=__builtin_amdgcn_mfma_f32_32x32x16_bf16(kf[0],qr[0],C0,0,0,0), P0[2],P0[3],P0[4],P0[5],     pw0[0]=PKW(P0,0), pw0[1]=PKW(P0,2), pw0); \
    VRD(4); SBAR(); GAPA(C1=__builtin_amdgcn_mfma_f32_32x32x16_bf16(kf[1],qr[0],C1,0,0,0), P0[6],P0[7],P0[8],P0[9],     pw0[2]=PKW(P0,4), pw0[3]=PKW(P0,6), pw0); \
    VRD(1); SBAR(); GAPA(C0=__builtin_amdgcn_mfma_f32_32x32x16_bf16(kf[2],qr[1],C0,0,0,0),   P0[10],P0[11],P0[12],P0[13], pw1[0]=PKW(P0,8), pw1[1]=PKW(P0,10), pw1); \
    VRD(5); SBAR(); GAPA(C1=__builtin_amdgcn_mfma_f32_32x32x16_bf16(kf[3],qr[1],C1,0,0,0),   P0[14],P0[15],P1[0],P1[1],   pw1[2]=PKW(P0,12),pw1[3]=PKW(P0,14), pw1); \
    VRD(2); SBAR(); GAPA(C0=__builtin_amdgcn_mfma_f32_32x32x16_bf16(kf[4],qr[2],C0,0,0,0),   P1[2],P1[3],P1[4],P1[5],     pw2[0]=PKW(P1,0), pw2[1]=PKW(P1,2), pw2); \
    VRD(6); SBAR(); GAPA(C1=__builtin_amdgcn_mfma_f32_32x32x16_bf16(kf[5],qr[2],C1,0,0,0),   P1[6],P1[7],P1[8],P1[9],     pw2[2]=PKW(P1,4), pw2[3]=PKW(P1,6), pw2); \
    VRD(3); SBAR(); GAPA(C0=__builtin_amdgcn_mfma_f32_32x32x16_bf16(kf[6],qr[3],C0,0,0,0),   P1[10],P1[11],P1[12],P1[13], pw3[0]=PKW(P1,8), pw3[1]=PKW(P1,10), pw3); \
    VRD(7); SBAR(); GAPA(C1=__builtin_amdgcn_mfma_f32_32x32x16_bf16(kf[7],qr[3],C1,0,0,0),   P1[14],P1[15],0.f,0.f,       pw3[2]=PKW(P1,12),pw3[3]=PKW(P1,14), pw3); \
    l_reg+=sacc; \
    if(GK){DMA_K((t)+3,sl_cur);} if(GV){DMA_V((t)+1,sl_next);} \
    CMASK(C0,C1,t); \
    { float a=MX3(C0[0],C0[1],C1[0]),b=MX3(C0[2],C0[3],C1[1]); a=MX3(a,C1[2],C1[3]); \
      _Pragma("unroll") for(int r=4;r<16;r+=4){a=MX3(a,C0[r],C0[r+1]);b=MX3(b,C0[r+2],C0[r+3]);a=MX3(a,C1[r],C1[r+1]);b=MX3(b,C1[r+2],C1[r+3]);} \
      float rm=__builtin_fmaxf(a,b); { auto rr=__builtin_amdgcn_permlane32_swap(__float_as_uint(rm),__float_as_uint(rm),false,false); rm=__builtin_fmaxf(__uint_as_float(rr[0]),__uint_as_float(rr[1])); } \
      resc=false; \
      if(__builtin_expect(__any(rm>(float)THRL),0)){ const float dl=__builtin_fmaxf(rm,0.f); mhat+=dl; \
        _Pragma("unroll") for(int r=0;r<16;++r){C0[r]-=dl;C1[r]-=dl;} \
        const float f=__builtin_amdgcn_exp2f(-dl); l_reg*=f; if(hi==0)wsf[r32]=f; resc=true; } } \
    f32x4_t cn_=(f32x4_t){0.f,0.f,0.f,0.f}; if(GL){cn_=NEGC((t)+1,0);} \
    SBAR(); \
    GAPB(o[0]=__builtin_amdgcn_mfma_f32_32x32x16_bf16(PAF(0),VFR(0),o[0],0,0,0), C0,0,P0,0,0,t,GL); \
    GAPB(o[1]=__builtin_amdgcn_mfma_f32_32x32x16_bf16(PAF(0),VFR(4),o[1],0,0,0), C0,4,P0,4,1,t,GL); \
    KRD(GL,0); GAPB(o[0]=__builtin_amdgcn_mfma_f32_32x32x16_bf16(PAF(1),VFR(1),o[0],0,0,0), C0,8,P0,8,2,t,GL); \
    KRD(GL,1); GAPB(o[1]=__builtin_amdgcn_mfma_f32_32x32x16_bf16(PAF(1),VFR(5),o[1],0,0,0), C0,12,P0,12,3,t,GL); \
    KRD(GL,2); GAPB(o[0]=__builtin_amdgcn_mfma_f32_32x32x16_bf16(PAF(2),VFR(2),o[0],0,0,0), C1,0,P1,0,4,t,GL); \
    KRD(GL,3); GAPB(o[1]=__builtin_amdgcn_mfma_f32_32x32x16_bf16(PAF(2),VFR(6),o[1],0,0,0), C1,4,P1,4,5,t,GL); \
    GAPB(o[0]=__builtin_amdgcn_mfma_f32_32x32x16_bf16(PAF(3),VFR(3),o[0],0,0,0), C1,8,P1,8,6,t,GL); \
    GAPB(o[1]=__builtin_amdgcn_mfma_f32_32x32x16_bf16(PAF(3),VFR(7),o[1],0,0,0), C1,12,P1,12,7,t,GL); \
    }while(0)
  int t=1;
  #undef CMASK
  #define CMASK(P0,P1,t) do{}while(0)
  for(;t+5<NT;t+=2){
    STEP(pB0,pB1,pA0,pA1,t,true,true,true);     WAIT_BAR(2); RESC(); ROT();
    STEP(pA0,pA1,pB0,pB1,t+1,true,true,true);   WAIT_BAR(2); RESC(); ROT();
  }
  #undef CMASK
  #define CMASK(P0,P1,t) do{int jb_=(t)-(NT-4); if(jb_>=0)cmask(P0,P1,jb_,qrel,hi);}while(0)
  #define ENDW(tt) do{ if((tt)+3<NT){WAIT_BAR(2);} else if((tt)+2<NT){WAIT_BAR(1);} else {WAIT_BAR(0);} }while(0)
  for(;t+1<NT;t+=2){
    STEP(pB0,pB1,pA0,pA1,t,(t+3<NT),(t+1<NT),(t+1<NT));       ENDW(t);   RESC(); ROT();
    STEP(pA0,pA1,pB0,pB1,t+1,(t+4<NT),(t+2<NT),(t+2<NT));     ENDW(t+1); RESC(); ROT();
  }
  STEP(pB0,pB1,pA0,pA1,NT-1,false,false,false); RESC();
  { float sacc=pB0[0]+pB0[1]; _Pragma("unroll") for(int r=2;r<16;++r)sacc+=pB0[r]; _Pragma("unroll") for(int r=0;r<16;++r)sacc+=pB1[r]; l_reg+=sacc;
    pw0=(u32x4){PKW(pB0,0),PKW(pB0,2),PKW(pB0,4),PKW(pB0,6)};pw1=(u32x4){PKW(pB0,8),PKW(pB0,10),PKW(pB0,12),PKW(pB0,14)};pw2=(u32x4){PKW(pB1,0),PKW(pB1,2),PKW(pB1,4),PKW(pB1,6)};pw3=(u32x4){PKW(pB1,8),PKW(pB1,10),PKW(pB1,12),PKW(pB1,14)};
    SBAR(); pv(o,vb0+sl_cur,PAF(0),PAF(1),PAF(2),PAF(3)); }
  #undef PKW
  #undef PAF
  #undef VFR
  #undef PIN
  #undef MX3
  #undef GAPA
  #undef GAPB
  #undef EX
  #undef VRD
  #undef KRD
  #undef STEP
  #undef ENDW
  {auto rr=__builtin_amdgcn_permlane32_swap(__float_as_uint(l_reg),__float_as_uint(l_reg),false,false);l_reg=__uint_as_float(rr[0])+__uint_as_float(rr[1]);}
  if(hi==0)wsf[32+r32]=l_reg;asm volatile("s_waitcnt lgkmcnt(0)":::"memory");
  float rli[16];
  #pragma unroll
  for(int r=0;r<16;++r)rli[r]=__builtin_amdgcn_rcpf(wsf[32+crow(r,hi)]);
  bf16*Ow=O+(rowbase+q0+wid*QBLK)*OPITCH+h*D; const bf16*Gw=OG+(rowbase+q0+wid*QBLK)*PITCH+h*D;
  u32x4 gg[4];
  #pragma unroll
  for(int i=0;i<4;++i){const int row=i*8+(lane>>3),ch=lane&7; gg[i]=*(const u32x4*)(Gw+(long)row*PITCH+ch*8);}
  { bf16*stg=(bf16*)(shm+LDS_OST)+wid*2048;
    #pragma unroll
    for(int r=0;r<16;++r){const int orow=crow(r,hi);
      #pragma unroll
      for(int d0=0;d0<2;++d0)stg[orow*64+d0*32+r32]=__float2bfloat16(o[d0][r]*rli[r]);}
    asm volatile("s_waitcnt lgkmcnt(0)":::"memory");
    #pragma unroll
    for(int i=0;i<4;++i){const int row=i*8+(lane>>3),ch=lane&7; u32x4 v=*(const u32x4*)(stg+row*64+ch*8);
      #pragma unroll
      for(int w=0;w<4;++w){ const float o0=__uint_as_float(v[w]<<16),o1=__uint_as_float(v[w]&0xffff0000u),g0=__uint_as_float(gg[i][w]<<16),g1=__uint_as_float(gg[i][w]&0xffff0000u);
        v[w]=cvtpk_s(o0*__builtin_amdgcn_rcpf(1.f+__builtin_amdgcn_exp2f(-1.4426950408889634f*g0)),o1*__builtin_amdgcn_rcpf(1.f+__builtin_amdgcn_exp2f(-1.4426950408889634f*g1))); }
      ATTN_STORE16(Ow+(long)row*OPITCH+ch*8,v);} }
  asm volatile("s_waitcnt lgkmcnt(0)\n\ts_barrier":::"memory");
  #undef DMA_K
  #undef NEGC
  #undef FILLT
  #undef DMA_V
  #undef CMASK
  #undef START
  #undef RESC
  #undef ROT
}
constexpr int ATTN_LDS_BYTES=LDS_BYTES;
struct AttnTensors { const bf16* Q; const bf16* K; const bf16* V; const bf16* OG; const float* c2v; bf16* O; };
struct AttnUnit { int bh; int qb; };
struct StaticOrder {
  int vcu, G, blk;
  __device__ __forceinline__ explicit StaticOrder(int grid,int block):vcu((grid%8==0)?(block%8)*(grid/8)+block/8:block),G(grid),blk(block){}
  __device__ __forceinline__ bool next(int i,AttnUnit&u)const{
    if(G==256){ if(blk<64){ if(i>=1)return false; u.bh=blk; u.qb=0; return true; } const int j=blk-64,g=j>>6; u.bh=j&63;
      if(g==0){ if(i>=2)return false; u.qb=i?3:7; } else if(g==1){ if(i>=2)return false; u.qb=i?4:6; } else { if(i>=3)return false; u.qb=i==0?5:3-i; }
      return true; }
    const int pair=vcu+(i>>1)*G; if(pair>=BATCH*NHEAD*4)return false; const int s=pair&3; u.bh=pair>>2; u.qb=(i&1)?s:7-s; return true; }
  __device__ __forceinline__ void a_ready(const AttnUnit&)const{}
  __device__ __forceinline__ void done(const AttnUnit&)const{}
};
template<class Sched,int THRL=8> __device__ __forceinline__ void attn_phase(char*lds,const AttnTensors&T,const Sched&S,const int wave_s){
  AttnUnit u;
  int pbh=-1,pqb=-1;
  for(int i=0;S.next(i,u);++i){ S.a_ready(u); attn_unit<THRL>(u.bh/NHEAD,u.bh%NHEAD,u.qb,T.Q,T.K,T.V,T.OG,T.c2v,T.O,lds,wave_s,!(u.bh==pbh&&u.qb<=pqb)); if(u.bh!=pbh||u.qb>pqb){pbh=u.bh;pqb=u.qb;} S.done(u); }
}
#undef SBAR
#undef WAIT_BAR
}
#define GAS __attribute__((address_space(1)))
#define LAS __attribute__((address_space(3)))
typedef unsigned short bf16;
typedef unsigned v4u __attribute__((ext_vector_type(4)));
typedef float f32x4 __attribute__((ext_vector_type(4)));
typedef short bf16x8 __attribute__((ext_vector_type(8)));
typedef GAS unsigned gu32;
typedef GAS unsigned long long gu64;
#define RLX_AGENT __ATOMIC_RELAXED, __HIP_MEMORY_SCOPE_AGENT
#define LDS_WAIT() asm volatile("s_waitcnt lgkmcnt(0)" ::: "memory")
#define VM_WAIT() asm volatile("s_waitcnt vmcnt(0)" ::: "memory")
#define XB_TMO      128
#define XB_XCNT(j)  (256  + 64 * (j))
#define XB_XSUB(j)  (1280 + 64 * (j))
#define XB_XGEN(j)  (2304 + 64 * (j))
#define XB_TOP      3328
#define XB_TOPGEN   3392
#define XCD_BAR_WORDS 3456
#define XB_SPIN_CAP (1u << 18)

__device__ __forceinline__ unsigned xb_ld(unsigned* p)              { return __hip_atomic_load(p, __ATOMIC_RELAXED, __HIP_MEMORY_SCOPE_AGENT); }
__device__ __forceinline__ unsigned xb_add(unsigned* p, unsigned v) { return __hip_atomic_fetch_add(p, v, __ATOMIC_RELAXED, __HIP_MEMORY_SCOPE_AGENT); }
__device__ __forceinline__ unsigned xb_xcc_id() { return (unsigned)__builtin_amdgcn_s_getreg((3 << 11) | 20) & 0xFu; }
#define XB_SPIN(cond, bar) do { unsigned _sp = 0; while (cond) { __builtin_amdgcn_s_sleep(1); \
    if ((++_sp & 255u) == 0u) { if (xb_ld(&(bar)[XB_TMO])) break; if (_sp > XB_SPIN_CAP) { atomicAdd(&(bar)[XB_TMO], 1u); break; } } } } while (0)

struct XcdBarrier {
    unsigned* bar; unsigned x;
    volatile LAS unsigned* st;
};

__device__ __forceinline__ XcdBarrier xcd_barrier_post(unsigned* bar, volatile LAS unsigned* st) {
    XcdBarrier b; b.bar = bar; b.x = xb_xcc_id(); b.st = st;
    if (threadIdx.x == 0) (void)xb_add(&bar[XB_XCNT(b.x)], 1u);
    return b;
}
__device__ __forceinline__ void xcd_barrier_complete(unsigned* bar, unsigned x, unsigned& nloc, unsigned& nx) {
    const unsigned G = gridDim.x * gridDim.y * gridDim.z;
    unsigned sum, cnt, mine, sp = 0u;
    for (;;) {
        sum = 0u; cnt = 0u; mine = 0u;
#pragma unroll
        for (unsigned j = 0; j < 16; ++j) { const unsigned c = xb_ld(&bar[XB_XCNT(j)]); sum += c; cnt += (c > 0u) ? 1u : 0u; mine = (j == x) ? c : mine; }
        if (sum == G) break;
        __builtin_amdgcn_s_sleep(1);
        if ((++sp & 255u) == 0u) { if (xb_ld(&bar[XB_TMO])) break; if (sp > XB_SPIN_CAP) { atomicAdd(&bar[XB_TMO], 1u); break; } }
    }
    nloc = mine > 0u ? mine : 1u; nx = cnt > 0u ? cnt : 1u;
}

__device__ __forceinline__ void xcd_barrier(const XcdBarrier& b, const int wave_s) {
    asm volatile("s_waitcnt vmcnt(0)" ::: "memory");
    __syncthreads();
    if (wave_s == 0 && lane_id() == 0) {
        int z0_ = 0; asm volatile("" : "+s"(z0_));
        unsigned* bar = b.bar + z0_;
        __builtin_amdgcn_s_waitcnt(0);
        unsigned nloc = b.st[0], nx = b.st[1];
        if (nloc == 0u) { xcd_barrier_complete(bar, b.x, nloc, nx); b.st[0] = nloc; b.st[1] = nx; }
        const unsigned old = xb_add(&bar[XB_XSUB(b.x)], 1u);
        const unsigned gen = old / nloc;
        if (old + 1u == (gen + 1u) * nloc) {
            __builtin_amdgcn_fence(__ATOMIC_RELEASE, "agent");
            asm volatile("s_waitcnt vmcnt(0)" ::: "memory");
            const unsigned og = xb_add(&bar[XB_TOP], 1u);
            const unsigned tg = og / nx;
            if (og + 1u == (tg + 1u) * nx) xb_add(&bar[XB_TOPGEN], 1u);
            else XB_SPIN(xb_ld(&bar[XB_TOPGEN]) == tg, bar);
            __builtin_amdgcn_fence(__ATOMIC_ACQUIRE, "agent");
            xb_add(&bar[XB_XGEN(b.x)], 1u);
            asm volatile("s_waitcnt vmcnt(0)" ::: "memory");
        } else {
            XB_SPIN(xb_ld(&bar[XB_XGEN(b.x)]) == gen, bar);
            __builtin_amdgcn_fence(__ATOMIC_ACQUIRE, "agent");
            asm volatile("s_waitcnt vmcnt(0)" ::: "memory");
        }
    }
    __syncthreads();
}

constexpr int NWAVES = 8;
constexpr int RING_BYTES = 131072;
constexpr int LDS_BYTES = 163840;
constexpr int LDSCTL_OFF = LDS_BYTES - 1024, MISC_OFF = LDSCTL_OFF + 320;
constexpr int HALO_OFF = RING_BYTES;
constexpr int RSTD_OFF = HALO_OFF + 8192;
static_assert(RSTD_OFF + 6 * 1024 + 4096 <= LDSCTL_OFF, "LDS map");
constexpr int CW_BAR = 4096;

struct Args { const float* in[24]; float* out; unsigned char* ws; };

template <bool AF32, class F>
__device__ __forceinline__ void meta_gemm(const void* A, int lda, const bf16_t* Wt, int N, int K, int bid, int G, int wave, int lane, float* red, const F& f) {
    const int fr = lane & 15, fq = lane >> 4, kw = K / NWAVES;
    for (int cb = bid; cb < N / 16; cb += G) {
        f32x4 acc = (f32x4){0.f, 0.f, 0.f, 0.f}; float ss = 0.f;
        const bf16_t* bp = Wt + (size_t)(cb * 16 + fr) * K + wave * kw + 8 * fq;
#pragma unroll
        for (int k = 0; k < kw; k += 32) {
            bf16x8 a;
            if (AF32) {
                const float* ap = (const float*)A + (size_t)fr * lda + wave * kw + k + 8 * fq;
                const f32x4 a0 = *(const f32x4*)ap, a1 = *(const f32x4*)(ap + 4);
                ss += ((a0.x * a0.x + a0.y * a0.y) + (a0.z * a0.z + a0.w * a0.w)) + ((a1.x * a1.x + a1.y * a1.y) + (a1.z * a1.z + a1.w * a1.w));
                u32x4 w; w.x = pk2bf(a0.x, a0.y); w.y = pk2bf(a0.z, a0.w); w.z = pk2bf(a1.x, a1.y); w.w = pk2bf(a1.z, a1.w);
                a = __builtin_bit_cast(bf16x8, w);
            } else a = *(const bf16x8*)((const bf16_t*)A + (size_t)fr * lda + wave * kw + k + 8 * fq);
            const bf16x8 b = *(const bf16x8*)(bp + k);
            acc = __builtin_amdgcn_mfma_f32_16x16x32_bf16(a, b, acc, 0, 0, 0);
        }
        float* rw = red + (wave * 64 + lane) * 5;
        rw[0] = acc[0]; rw[1] = acc[1]; rw[2] = acc[2]; rw[3] = acc[3]; rw[4] = ss;
        __syncthreads();
        if (wave == 0) {
            f32x4 t = (f32x4){0.f, 0.f, 0.f, 0.f}; float s2 = 0.f;
#pragma unroll
            for (int w = 0; w < NWAVES; ++w) { const float* r_ = red + (w * 64 + lane) * 5; t[0] += r_[0]; t[1] += r_[1]; t[2] += r_[2]; t[3] += r_[3]; s2 += r_[4]; }
            float rstd = 1.f;
            if (AF32) { s2 = add_xor16(s2); s2 = add_xor32(s2); rstd = 1.0f / sqrtf(s2 * (1.f / DM) + 1e-6f); }
#pragma unroll
            for (int r = 0; r < 4; ++r) { const int row = 4 * fq + r; const float rs = AF32 ? __int_as_float(__builtin_amdgcn_ds_bpermute(row << 2, __float_as_int(rstd))) : 1.f; f(row, cb * 16 + fr, t[r] * rs); }
        }
        __syncthreads();
    }
}
struct MEpi1 { bf16_t* p; float* pn;
    __device__ __forceinline__ void operator()(int r, int col, float v) const {
        const int row = MROWS + r; const int g = col >> 9, c_ = col & 255;
        if (g < 7) p[(size_t)row * PBW + (col & ~255) + ((c_ >> 5) & 3) * 64 + (c_ >> 7) * 32 + PERM32(c_ & 31)] = f2bf(v);
        else { const int o = col & 511; if (o < 296) pn[(size_t)row * PNW + o] = v; } } };
struct MEpiRes { float* hm; __device__ __forceinline__ void operator()(int r, int col, float v) const { float* h = hm + r * DM + (col & ~31) + PERM32(col & 31); *h = *h + v; } };
struct MEpi3 { float* rawm;
    __device__ __forceinline__ void operator()(int r, int col, float v) const { const int t = col >> 8, c = col & 255; rawm[(size_t)r * DFF2 + (c < 128 ? 128 * t + c : DFF + 128 * t + (c - 128))] = v; } };

__device__ __forceinline__ void meta_gemm3(const float* hm, const bf16_t* W3, int bid, int G, int wave, int lane, int tid, float* red, float* rug, const float* cw, const float* cb, float* rawm, bf16_t* am) {
    const int fr = lane & 15, fq = lane >> 4; constexpr int kw = DM / NWAVES;
    for (int pr = bid; pr < DFF / 16; pr += G) {
        const int t = pr >> 3, kk = pr & 7, cbu = 16 * t + kk;
        f32x4 au = (f32x4){0.f, 0.f, 0.f, 0.f}, ag = au; float ss = 0.f;
        const bf16_t* bpu = W3 + (size_t)(cbu * 16 + fr) * DM + wave * kw + 8 * fq; const bf16_t* bpg = bpu + (size_t)128 * DM;
#pragma unroll
        for (int k = 0; k < kw; k += 32) {
            const float* ap = hm + (size_t)fr * DM + wave * kw + k + 8 * fq;
            const f32x4 a0 = *(const f32x4*)ap, a1 = *(const f32x4*)(ap + 4);
            ss += ((a0.x * a0.x + a0.y * a0.y) + (a0.z * a0.z + a0.w * a0.w)) + ((a1.x * a1.x + a1.y * a1.y) + (a1.z * a1.z + a1.w * a1.w));
            u32x4 w; w.x = pk2bf(a0.x, a0.y); w.y = pk2bf(a0.z, a0.w); w.z = pk2bf(a1.x, a1.y); w.w = pk2bf(a1.z, a1.w);
            const bf16x8 a = __builtin_bit_cast(bf16x8, w);
            au = __builtin_amdgcn_mfma_f32_16x16x32_bf16(a, *(const bf16x8*)(bpu + k), au, 0, 0, 0);
            ag = __builtin_amdgcn_mfma_f32_16x16x32_bf16(a, *(const bf16x8*)(bpg + k), ag, 0, 0, 0);
        }
        float* rw = red + (wave * 64 + lane) * 9;
        rw[0] = au[0]; rw[1] = au[1]; rw[2] = au[2]; rw[3] = au[3]; rw[4] = ag[0]; rw[5] = ag[1]; rw[6] = ag[2]; rw[7] = ag[3]; rw[8] = ss;
        __syncthreads();
        if (wave == 0) {
            f32x4 tu = (f32x4){0.f, 0.f, 0.f, 0.f}, tg = tu; float s2 = 0.f;
#pragma unroll
            for (int w = 0; w < NWAVES; ++w) { const float* r_ = red + (w * 64 + lane) * 9; tu[0] += r_[0]; tu[1] += r_[1]; tu[2] += r_[2]; tu[3] += r_[3]; tg[0] += r_[4]; tg[1] += r_[5]; tg[2] += r_[6]; tg[3] += r_[7]; s2 += r_[8]; }
            s2 = add_xor16(s2); s2 = add_xor32(s2); const float rstd = 1.0f / sqrtf(s2 * (1.f / DM) + 1e-6f);
#pragma unroll
            for (int r = 0; r < 4; ++r) { const int row = 4 * fq + r; const float rs = __int_as_float(__builtin_amdgcn_ds_bpermute(row << 2, __float_as_int(rstd)));
                const float vu = tu[r] * rs, vg = tg[r] * rs; rug[row * 16 + fr] = vu; rug[256 + row * 16 + fr] = vg;
                if (row >= 14) { rawm[(size_t)row * DFF2 + 128 * t + 16 * kk + fr] = vu; rawm[(size_t)row * DFF2 + DFF + 128 * t + 16 * kk + fr] = vg; } }
        }
        __syncthreads();
        if (tid < 256) {
            const int row = tid >> 4, j = tid & 15, ch = 128 * t + 16 * kk + j;
            const float xu0 = rug[row * 16 + j], xu1 = row >= 1 ? rug[(row - 1) * 16 + j] : 0.f, xu2 = row >= 2 ? rug[(row - 2) * 16 + j] : 0.f;
            const float xg0 = rug[256 + row * 16 + j], xg1 = row >= 1 ? rug[256 + (row - 1) * 16 + j] : 0.f, xg2 = row >= 2 ? rug[256 + (row - 2) * 16 + j] : 0.f;
            const float cu = cb[ch] + cw[ch] * xu2 + cw[DFF2 + ch] * xu1 + cw[2 * DFF2 + ch] * xu0;
            const float cg = cb[DFF + ch] + cw[DFF + ch] * xg2 + cw[DFF2 + DFF + ch] * xg1 + cw[2 * DFF2 + DFF + ch] * xg0;
            am[(size_t)row * DFF + ch] = f2bf(cg * sigmoidf_(cg) * cu);
        }
        __syncthreads();
    }
}

__device__ __forceinline__ void wprep_layer(const float* const* in, int l, unsigned char* ws, int gw, int ngw, int lane, float* scr, int part) {
    unsigned char* wb = ws + WS_W + (size_t)(l & 1) * WL_BYTES;
    constexpr int I1 = (DM / 64) * (N1 / 32), I2 = (DM / 64) * (DM / 32), I3 = (DM / 64) * (DFF2 / 32), I4 = (DFF / 64) * (DM / 32);
    const int n1 = (part & 1) ? I1 : 0, n2 = (part & 2) ? I2 : 0, n3 = (part & 4) ? I3 : 0, n4 = (part & 8) ? I4 : 0;
    for (int it = gw; it < n1 + n2 + n3 + n4; it += ngw) {
        int r = it, mode = 1, K = DM, Nsrc = N_IN, Ndst = N1; const float* W = in[3] + (size_t)l * DM * N_IN; const float* gk = in[2] + l * DM; bf16_t* WT = (bf16_t*)(wb + WO_W1);
        if (r >= n1) { r -= n1; mode = 2; Nsrc = DM; Ndst = DM; W = in[18] + (size_t)l * DM * DM; gk = nullptr; WT = (bf16_t*)(wb + WO_W2);
            if (r >= n2) { r -= n2; mode = 3; Nsrc = DFF2; Ndst = DFF2; W = in[20] + (size_t)l * DM * DFF2; gk = in[19] + l * DM; WT = (bf16_t*)(wb + WO_W3);
                if (r >= n3) { r -= n3; mode = 4; K = DFF; Nsrc = DM; Ndst = DM; W = in[23] + (size_t)l * DFF * DM; gk = nullptr; WT = (bf16_t*)(wb + WO_W4); } } }
        wprep_item(W, gk, WT, K, Nsrc, Ndst, mode, r, scr, lane);
    }
    if (part & 1) {
        bf16_t* lup = (bf16_t*)(wb + WO_LUP);
        const float* wu = in[6] + (size_t)l * 64 * 512; const float* au = in[8] + (size_t)l * 64 * 512; const float* gu = in[9] + (size_t)l * 160 * 512;
        for (int n = gw; n < 512; n += ngw) {
#pragma unroll
            for (int kq = 0; kq < 5; ++kq) { const int k = lane + 64 * kq;
                if (k < 288) lup[n * 288 + k] = f2bf(k < 64 ? wu[k * 512 + n] : (k < 128 ? au[(k - 64) * 512 + n] : gu[(k - 128) * 512 + n])); }
        }
    }
}

struct RwP { const float* mu; const float* w0; const float* w_up; const float* a0; const float* a_up; const float* g_up; };
struct RwS { const float* mu; const float* k_k; const float* k_a; const float* r_k; const float* gn_w; const float* gn_b; };
constexpr int RCH = 8;

__global__ void __launch_bounds__(NWAVES * 64, 2) mk_fwd(Args a) {
    extern __shared__ __attribute__((aligned(16))) unsigned char lds[];
    const int tid0 = threadIdx.x, wave_s = __builtin_amdgcn_readfirstlane(tid0 >> 6);
    const int G0 = gridDim.x, bid0 = blockIdx.x;
    for (int u = tid0; u < (LDS_BYTES - LDSCTL_OFF) / 4; u += NWAVES * 64) ((LAS unsigned*)((LAS unsigned char*)lds + LDSCTL_OFF))[u] = 0u;
    __syncthreads();
    XcdBarrier bar = xcd_barrier_post((unsigned*)(a.ws + WS_CTL) + CW_BAR, (volatile LAS unsigned*)((LAS unsigned char*)lds + MISC_OFF) + 8);
#ifdef TPROBE
#define TP_MARK(ph) do { if ((ph) >= 20 && TPROBE < 20) break;     \
        const unsigned t_ = (unsigned)__builtin_amdgcn_s_memrealtime(); if (wave_s == 0 && lane_id() == 0) { volatile LAS unsigned* q_ = (volatile LAS unsigned*)((LAS unsigned char*)lds + LDSCTL_OFF + 512); \
        if ((ph) == TPROBE) q_[1] += t_ - q_[0]; q_[0] = t_; } } while (0)
#else
#define TP_MARK(ph) do {} while (0)
#endif
#define GRID_BAR() do { int wv_ = wave_s; asm volatile("" : "+s"(wv_)); xcd_barrier(bar, wv_); } while (0)
#define RSTD_TABLE(S) do { pg8::Unit u_; for (int i_ = 0; S.next(i_, u_); ++i_) for (int r_ = tid; r_ < 256; r_ += NWAVES * 64) \
        ((LAS float*)(ldsl + RSTD_OFF))[i_ * 256 + r_] = pg8::row_rstd(ssqp, u_.pm * 256 + r_); __syncthreads(); } while (0)
    TP_MARK(-1);
#define PHASE_IDS() int G_ = G0, bid_ = bid0, wv_ = wave_s; asm volatile("" : "+s"(G_), "+s"(bid_), "+s"(wv_)); int tid = wv_ * 64 + lane_id(); asm volatile("" : "+v"(tid)); \
    const int G = G_, bid = bid_, ngw = G * NWAVES, lane = tid & 63, wave = wv_, gw = bid * NWAVES + wave; (void)lane; (void)gw; (void)ngw
#define PHASE_PTRS(L) int z0_ = 0; asm volatile("" : "+s"(z0_)); const float* const* inq = a.in + z0_; unsigned char* ws = a.ws + z0_; float* out = a.out + z0_; const int lq = (L) + z0_; \
    float* hm = (float*)(ws + WS_HM); float* c2 = (float*)(ws + WS_C2); float* ssqp = (float*)(ws + WS_SSQ); \
    bf16_t* hb = (bf16_t*)(ws + WS_HB); bf16_t* p = (bf16_t*)(ws + WS_P); float* pn = (float*)(ws + WS_PN); bf16_t* y = (bf16_t*)(ws + WS_Y); \
    bf16_t* act = (bf16_t*)(ws + WS_ACT); float* fixb = (float*)(ws + WS_FIX); float* rawm = (float*)(ws + WS_RAWM); \
    const unsigned char* wbuf = ws + WS_W + (size_t)(lq & 1) * WL_BYTES; \
    const bf16_t* W1 = (const bf16_t*)(wbuf + WO_W1); const bf16_t* W2 = (const bf16_t*)(wbuf + WO_W2); const bf16_t* W3 = (const bf16_t*)(wbuf + WO_W3); const bf16_t* W4 = (const bf16_t*)(wbuf + WO_W4); \
    (void)hm; (void)c2; (void)ssqp; (void)hb; (void)p; (void)pn; (void)y; (void)act; (void)fixb; (void)rawm; (void)out; (void)W1; (void)W2; (void)W3; (void)W4
    LAS unsigned char* ldsl = (LAS unsigned char*)lds;

    {
        PHASE_IDS(); PHASE_PTRS(0);
        for (int row = gw; row < RROWS; row += ngw) {
            const f32x4* xr = (const f32x4*)(row < MROWS ? inq[0] + (size_t)row * DM : inq[1] + (size_t)(row - MROWS) * DM) + lane;
            f32x4* hr = (f32x4*)(hm + (size_t)(row < MROWS ? 0 : row - MROWS) * DM) + lane;
            f32x4 v[4]; float s = 0.f;
#pragma unroll
            for (int j = 0; j < 4; ++j) { v[j] = xr[64 * j]; if (row >= MROWS) hr[64 * j] = v[j]; s += (v[j].x * v[j].x + v[j].y * v[j].y) + (v[j].z * v[j].z + v[j].w * v[j].w); }
            s = wave_sum(s);
            if (lane < 16) ssqp[(size_t)row * 16 + lane] = lane == 0 ? s : 0.f;
            u32x2* o8 = (u32x2*)(hb + (size_t)row * DM) + lane;
#pragma unroll
            for (int j = 0; j < 4; ++j) { u32x2 w; w.x = pk2bf(v[j].x, v[j].y); w.y = pk2bf(v[j].z, v[j].w); o8[64 * j] = w; }
        }
    }
    {
        PHASE_IDS(); PHASE_PTRS(0);
        u32x4* z = (u32x4*)(p + (size_t)RROWS * PBW); const unsigned n16 = (unsigned)((16512 - RROWS) * PBW * 2 / 16);
        for (unsigned i = (unsigned)(bid * (NWAVES * 64) + tid); i < n16; i += (unsigned)(G * (NWAVES * 64))) z[i] = (u32x4){0u, 0u, 0u, 0u};
    }
#ifndef PLAIN_LAUNCH
    cg::this_grid().sync();
#endif
    TP_MARK(0);

#pragma unroll 1
    for (int l = -1; l < DEPTH; ++l) {
#pragma unroll 1
      for (int ph = l < 0 ? 1 : 0; ph < (l < 0 ? 2 : 6); ++ph) {
#ifdef TPROBE
        if (wave_s == 0 && lane_id() == 0) ((volatile LAS unsigned*)((LAS unsigned char*)lds + LDSCTL_OFF + 512))[2] = (unsigned)ph;
#endif
        if (ph == 1 || ph == 4)
        {
            PHASE_IDS(); PHASE_PTRS(l);
            if (lq + 1 < DEPTH) {
                const int first = (G == 256 && lq >= 0) ? (ph == 4 ? 128 : 8) : 0, part = lq < 0 ? 15 : (G == 256 ? (ph == 4 ? 6 : 9) : (ph == 4 ? 0 : 15));
                if (bid >= first && part) wprep_layer(inq, lq + 1, ws, gw - first * NWAVES, ngw - first * NWAVES, lane, (float*)(lds + wave * 16384), part);
            }
            __syncthreads();
        }
        if (ph == 0) {
        {
            PHASE_IDS(); PHASE_PTRS(l);
            pg8::Gemm g{hb, W1, MROWS, N1, DM}; pg8::StaticOrder S; S.init(MROWS, N1, G, bid);
            RSTD_TABLE(S);
            pg8::Epi1 E{(const LAS float*)(ldsl + RSTD_OFF), p, pn, inq[16] + lq * 64, inq[17] + lq * 64};
            pg8::gemm_phase<pg8::Epi1, pg8::StaticOrder, true, true>(ldsl, g, S, E, wave);
            meta_gemm<true>(hm, DM, W1, N1, DM, bid, G, wave, lane, (float*)lds, MEpi1{p, pn});
        }
        } else if (ph == 4) {
        {
            PHASE_IDS(); PHASE_PTRS(l);
            const float* cw = inq[21] + (size_t)lq * 3 * DFF2; const float* cb = inq[22] + (size_t)lq * DFF2;
            pg8::Gemm g{hb, W3, MROWS, DFF2, DM}; pg8::StaticOrder S; S.init(MROWS, DFF2, G, bid);
            RSTD_TABLE(S);
            pg8::EpiConv E{(const LAS float*)(ldsl + RSTD_OFF), cw, cb, act, fixb, ldsl + HALO_OFF, (LAS float*)(ldsl + RSTD_OFF + 6 * 1024)};
            pg8::gemm_phase<pg8::EpiConv, pg8::StaticOrder, true, true>(ldsl, g, S, E, wave);
            meta_gemm3(hm, W3, bid, G, wave, lane, tid, (float*)lds, (float*)(lds + 20480), cw, cb, rawm, act + (size_t)MROWS * DFF);
        }
        }
        if (ph == 1 && l >= 0) {
        {
            PHASE_IDS(); PHASE_PTRS(l);
            __syncthreads(); TP_MARK(20);
            {
                const float* mu = inq[4] + lq * 1824;
                const bf16_t* lup = (const bf16_t*)(wbuf + WO_LUP);
                const int h = wave, cg = h * 64 + lane, fr = lane & 15, fq = lane >> 4;
                const float mu_r = mu[cg], mu_k = mu[512 + cg], mu_v = mu[1024 + cg];
                const float w0c = (inq[5] + lq * 512)[cg], a0c = (inq[7] + lq * 512)[cg];
                const float kkc = (inq[10] + lq * 512)[cg], kac = (inq[11] + lq * 512)[cg], rkc = (inq[12] + lq * 512)[cg];
                LAS unsigned char* PNS = ldsl;
                LAS unsigned char* PSW = ldsl + 22528 + wave * 6528;
                LAS unsigned char* LW = ldsl + 74752 + wave * 9216;
                LAS unsigned char* LIN = ldsl + 148480;
                LAS float* MU = (LAS float*)(ldsl + 158720);
                LAS float* TR = (LAS float*)LW; LAS float* LT = (LAS float*)LW; LAS float* LAK = (LAS float*)(LW + 1280);
#define PN_DMA(uu) do { const int c_ = (uu) % NCH, r0_ = rowof((uu) / NCH, 16 * c_), p0_ = prevrow(r0_); \
                    for (int pc_ = wave; pc_ < (p0_ >= 0 ? 22 : 20); pc_ += NWAVES) { \
                        const char* src_ = (pc_ < 20 ? (const char*)(pn + (size_t)r0_ * PNW) + pc_ * 1024 : (const char*)(pn + (size_t)p0_ * PNW) + (pc_ - 20) * 1024) + lane * 16; \
                        __builtin_amdgcn_global_load_lds((const unsigned*)src_, (LAS unsigned*)(PNS + pc_ * 1024), 16, 0, 0); } } while (0)
#define PS_DMA(uu) do { const int c_ = (uu) % NCH, r0_ = rowof((uu) / NCH, 16 * c_), p0_ = prevrow(r0_); int ln_ = lane; asm volatile("" : "+v"(ln_));     \
                    _Pragma("unroll") for (int j_ = 0; j_ < 7; ++j_) { const int s_ = j_ * 8 + (ln_ >> 3); \
                        if (s_ < 51) { const int i_ = s_ / 3, sg_ = s_ - 3 * i_, rw_ = i_ ? r0_ + i_ - 1 : (p0_ >= 0 ? p0_ : r0_); \
                            const char* src_ = (const char*)(p + (size_t)rw_ * PBW) + sg_ * 1024 + wave * 128 + (ln_ & 7) * 16; \
                            __builtin_amdgcn_global_load_lds((const unsigned*)src_, (LAS unsigned*)(PSW + j_ * 1024), 16, 0, 0); } } } while (0)
#define PSV(i, sg) bf2f(((const LAS bf16_t*)PSW)[(3 * (i) + (sg)) * 64 + lane])
                if (tid < 288) MU[tid] = mu[1536 + tid];
                if (bid < NB * NCH) { PN_DMA(bid); PS_DMA(bid); }
                asm volatile("s_waitcnt vmcnt(0)" ::: "memory");
                bf16x8 bw_[2][4];
                {   const int fru = lane & 15, fqu = lane >> 4;
#pragma unroll
                    for (int nb = 0; nb < 4; ++nb) { const bf16_t* bp_ = lup + (size_t)(h * 64 + 16 * nb + fru) * 288 + 8 * fqu;
#pragma unroll
                        for (int ks = 0; ks < 2; ++ks) bw_[ks][nb] = *(const bf16x8*)(bp_ + 32 * ks);
                    } }
                for (int u = bid; u < NB * NCH; u += G) {
                    const int b = u / NCH, c = u % NCH, row0 = rowof(b, 16 * c), prow0 = prevrow(row0);
                    int tidu = tid; asm volatile("" : "+v"(tidu));
                    const int fr = tidu & 15, fq = (tidu >> 4) & 3;
                    bf16x8 ba_[2][4], bg_[5][4];
                    {   const int fru = fr, fqu = fq;
#pragma unroll
                        for (int nb = 0; nb < 4; ++nb) { const bf16_t* bp_ = lup + (size_t)(h * 64 + 16 * nb + fru) * 288 + 8 * fqu;
#pragma unroll
                            for (int ks = 0; ks < 2; ++ks) ba_[ks][nb] = *(const bf16x8*)(bp_ + 64 + 32 * ks);
                        } }
                    TP_MARK(27);
                    asm volatile("s_waitcnt lgkmcnt(0)\n\ts_barrier" ::: "memory");
                    {
                        float cur_[9], prv_[9], mu_[9];
#pragma unroll
                        for (int i = 0; i < 9; ++i) { const int e = tidu + 512 * i, ti = e / 288, j = e - 288 * ti;
                            cur_[i] = ((const LAS float*)PNS)[ti * 320 + j]; prv_[i] = ((const LAS float*)PNS)[(ti ? ti - 1 : 16) * 320 + j]; mu_[i] = MU[j]; }
#pragma unroll
                        for (int i = 0; i < 9; ++i) { const int e = tidu + 512 * i, ti = e / 288, j = e - 288 * ti;
                            const float prv = (ti || prow0 >= 0) ? prv_[i] : 0.f, s = cur_[i] + mu_[i] * (prv - cur_[i]);
                            const float ex = __builtin_amdgcn_exp2f((j < 64 ? 2.f * LOG2E : -LOG2E) * s), rc = __builtin_amdgcn_rcpf(1.f + ex);
                            ((LAS bf16_t*)LIN)[ti * 296 + j] = f2bf(j < 64 ? 1.f - 2.f * rc : (j < 128 ? s : rc)); }
                    }
                    {   const int fru = fr, fqu = fq;
#pragma unroll
                        for (int nb = 0; nb < 4; ++nb) { const bf16_t* bp_ = lup + (size_t)(h * 64 + 16 * nb + fru) * 288 + 8 * fqu;
#pragma unroll
                            for (int ks = 0; ks < 5; ++ks) bg_[ks][nb] = *(const bf16x8*)(bp_ + 128 + 32 * ks); } }
                    TP_MARK(28);
                    asm volatile("s_waitcnt lgkmcnt(0)\n\ts_barrier" ::: "memory");
                    if (u + G < NB * NCH) PN_DMA(u + G);
                    TP_MARK(22);
#define LORA_PRE(ZA, KB0, NKS, BF) do { f32x4 acc_[4]; _Pragma("unroll") for (int nb = 0; nb < 4; ++nb) acc_[nb] = (f32x4){0.f, 0.f, 0.f, 0.f}; \
                        _Pragma("unroll") for (int ks = 0; ks < (NKS); ++ks) { const bf16x8 af = *(const LAS bf16x8*)(LIN + fr * 592 + ((KB0) + 32 * ks + 8 * fq) * 2); \
                            _Pragma("unroll") for (int nb = 0; nb < 4; ++nb) acc_[nb] = __builtin_amdgcn_mfma_f32_16x16x32_bf16(af, BF[ks][nb], acc_[nb], 0, 0, 0); } \
                        WAVE_LDS_SYNC(); \
                        _Pragma("unroll") for (int nb = 0; nb < 4; ++nb) _Pragma("unroll") for (int r = 0; r < 4; ++r) TR[(4 * fq + r) * 65 + 16 * nb + fr] = acc_[nb][r]; \
                        WAVE_LDS_SYNC(); \
                        _Pragma("unroll") for (int i = 0; i < 16; ++i) ZA[i] = TR[i * 65 + lane]; } while (0)
                    float zw[16], za[16];
                    LORA_PRE(zw, 0, 2, bw_); LORA_PRE(za, 64, 2, ba_);
                    {
                        float zg[16]; LORA_PRE(zg, 128, 5, bg_); (void)zg;
                        asm volatile("s_waitcnt vmcnt(0)" ::: "memory");
                        {
                            const int ti_ = lane >> 2, pt_ = lane & 3; float gv_[16];
#pragma unroll
                            for (int k_ = 0; k_ < 16; ++k_) gv_[k_] = TR[ti_ * 65 + 16 * pt_ + k_];
                            u32x4 o0_, o1_;
                            o0_.x = pk2bf(gv_[0], gv_[1]); o0_.y = pk2bf(gv_[2], gv_[3]); o0_.z = pk2bf(gv_[4], gv_[5]); o0_.w = pk2bf(gv_[6], gv_[7]);
                            o1_.x = pk2bf(gv_[8], gv_[9]); o1_.y = pk2bf(gv_[10], gv_[11]); o1_.z = pk2bf(gv_[12], gv_[13]); o1_.w = pk2bf(gv_[14], gv_[15]);
                            bf16_t* yp_ = y + (size_t)(row0 + ti_) * DM + h * 64 + 16 * pt_;
                            *(u32x4*)yp_ = o0_; *(u32x4*)(yp_ + 8) = o1_; } }
#undef LORA_PRE
                    WAVE_LDS_SYNC();
                    const int ci = (b * 8 + h) * NCH + c;
                    unsigned char* ra = ws + WS_RA + (size_t)ci * RA_BYTES; unsigned char* rb = (unsigned char*)out + (size_t)ci * RB_BYTES;
                    bf16_t* BV = (bf16_t*)(ws + WS_BV);
                    LAS bf16_t* OA = (LAS bf16_t*)LW; LAS bf16_t* OB = OA + 16 * 72; LAS bf16_t* OK = OB + 16 * 72; LAS bf16_t* OR = OK + 16 * 72;
                    const int cxk = (lane >> 5) * 4 + ((lane >> 2) & 3), jk2 = (((lane >> 4) & 1) * 4 + (lane & 3)) * 2;
                    TP_MARK(23);
                    float atil[16]; unsigned bkB[8], bkK[8], vtp[8];
                    float cumC = 0.f;
#pragma unroll
                    for (int i = 0; i < 16; ++i) { zw[i] = 0.6065306597126334f * __builtin_amdgcn_rcpf(1.f + __builtin_amdgcn_exp2f(-LOG2E * (zw[i] + w0c))); cumC += zw[i]; }
                    float cum = 0.f, gprev = 1.f, rp = 0.f, kp_ = 0.f, vp = 0.f, be = 0.f, ke = 0.f, ve = 0.f, bve = 0.f; unsigned bvp[8];
                    unsigned short prr[17], pkk[17], pvv[17];
#pragma unroll
                    for (int i = 0; i < 17; ++i) { prr[i] = ((const LAS bf16_t*)PSW)[(3 * i) * 64 + lane]; pkk[i] = ((const LAS bf16_t*)PSW)[(3 * i + 1) * 64 + lane]; pvv[i] = ((const LAS bf16_t*)PSW)[(3 * i + 2) * 64 + lane]; }
                    WAVE_LDS_SYNC();
                    if (u + G < NB * NCH) PS_DMA(u + G);
                    rp = bf2f(prr[0]); kp_ = bf2f(pkk[0]); vp = bf2f(pvv[0]);
                    const float hp0 = prow0 >= 0 ? 1.f : 0.f;
#pragma unroll
                    for (int i0 = 0; i0 < 16; i0 += 4) {
                        float rs4[4], vs4[4], alr4[4], kkr4[4], kpr4[4], red[8];
#pragma unroll
                        for (int j = 0; j < 4; ++j) { const int i = i0 + j;
                            const float rc = bf2f(prr[i + 1]), kc = bf2f(pkk[i + 1]), vc = bf2f(pvv[i + 1]);
                            const float hp = i ? 1.f : hp0;
                            const float rs = rc + mu_r * (hp * rp - rc), ks_ = kc + mu_k * (hp * kp_ - kc), vs = vc + mu_v * (hp * vp - vc);
                            rp = rc; kp_ = kc; vp = vc;
                            const float alr = __builtin_amdgcn_rcpf(1.f + __builtin_amdgcn_exp2f(-LOG2E * (za[i] + a0c)));
                            const float kkr = ks_ * kkc, kpr = ks_ * (1.f + (alr - 1.f) * kac);
                            rs4[j] = rs; vs4[j] = vs; alr4[j] = alr; kkr4[j] = kkr; kpr4[j] = kpr; red[2 * j] = kkr * kkr; red[2 * j + 1] = rs * kpr * rkc; }
                        wave_sum_dpp8(red);
#pragma unroll
                        for (int j = 0; j < 4; ++j) { const int i = i0 + j;
                            cum += zw[i];
                            const float kk = kkr4[j] * __builtin_amdgcn_rsqf(fmaxf(red[2 * j], 1e-24f)), bon = red[2 * j + 1], kpr = kpr4[j], vs = vs4[j];
                            const float eg = __builtin_amdgcn_exp2f(LOG2E * cum), gi = __builtin_amdgcn_exp2f(-LOG2E * cum), tail = __builtin_amdgcn_exp2f(LOG2E * (cum - cumC));
                            atil[i] = -kk * gprev;
                            const float bb = kk * alr4[j], rtil = rs4[j] * gi; gprev = gi;
                            OA[i * 72 + lane] = f2bf(atil[i]); OB[i * 72 + lane] = f2bf(bb * eg); OK[i * 72 + lane] = f2bf(kpr * eg); OR[i * 72 + lane] = f2bf(rtil);
                            if (i & 1) { bkB[i >> 1] = pk2bf(be, bb * tail); bkK[i >> 1] = pk2bf(ke, kpr * tail); vtp[i >> 1] = pk2bf(ve, vs); } else { be = bb * tail; ke = kpr * tail; ve = vs; }
                            if (i & 1) bvp[i >> 1] = pk2bf(bve, bon * vs); else bve = bon * vs; }
                    }
                    {
                        ((float*)(rb + 3584))[lane] = gprev;
#pragma unroll
                        for (int q = 0; q < 4; ++q) *(u32x4*)(ra + 4096 + lane * 64 + ((q ^ SWZ4(lane)) << 4)) = (u32x4){bkB[2 * q], bkB[2 * q + 1], bkK[2 * q], bkK[2 * q + 1]};
                        *(u32x4*)(rb + lane * 32) = (u32x4){vtp[0], vtp[1], vtp[2], vtp[3]}; *(u32x4*)(rb + lane * 32 + 16) = (u32x4){vtp[4], vtp[5], vtp[6], vtp[7]};
                    }
                    WAVE_LDS_SYNC();
                    TP_MARK(24);
#define REC_STORE(TILE, DST) do { _Pragma("unroll") for (int hh_ = 0; hh_ < 2; ++hh_) { const int i_ = (lane >> 3) + 8 * hh_, pc_ = lane & 7, c_ = pc_ ^ ((i_ >> 1) & 7), base_ = (c_ >> 2) * 32 + (c_ & 3) * 4; \
                        const u32x2 lo_ = *(const LAS u32x2*)((TILE) + i_ * 72 + base_), hi_ = *(const LAS u32x2*)((TILE) + i_ * 72 + base_ + 16); \
                        *(u32x4*)((DST) + i_ * 128 + pc_ * 16) = (u32x4){lo_.x, lo_.y, hi_.x, hi_.y}; } } while (0)
                    REC_STORE(OR, ra + 2048);
                    {
                        f32x4 dab = (f32x4){0.f, 0.f, 0.f, 0.f}, dak = dab, drb = dab, drk = dab;
#pragma unroll
                        for (int ks = 0; ks < 2; ++ks) {
                            const int off = fr * 72 + 32 * ks + 8 * fq;
                            const bf16x8 fa = *(const LAS bf16x8*)(OA + off), fb = *(const LAS bf16x8*)(OB + off), fk = *(const LAS bf16x8*)(OK + off), frr = *(const LAS bf16x8*)(OR + off);
                            dab = __builtin_amdgcn_mfma_f32_16x16x32_bf16(fa, fb, dab, 0, 0, 0); dak = __builtin_amdgcn_mfma_f32_16x16x32_bf16(fa, fk, dak, 0, 0, 0);
                            drb = __builtin_amdgcn_mfma_f32_16x16x32_bf16(frr, fb, drb, 0, 0, 0); drk = __builtin_amdgcn_mfma_f32_16x16x32_bf16(frr, fk, drk, 0, 0, 0);
                        }
#pragma unroll
                        for (int r = 0; r < 4; ++r) { const int i = 4 * fq + r, j = fr;
                            LT[i * 20 + j] = j < i ? dab[r] : 0.f; LAK[i * 16 + j] = j < i ? dak[r] : 0.f;
                            bf16_t* mp = (bf16_t*)(rb + 2048 + i * 64 + (((j >> 2) ^ SWZ4(i)) << 4)) + (j & 3);
                            mp[0] = f2bf(j <= i ? drb[r] : 0.f); mp[4] = f2bf(j <= i ? drk[r] : 0.f); }
                    }
                    WAVE_LDS_SYNC();
                    {
#pragma unroll
                        for (int k_ = 0; k_ < 8; ++k_) { OB[(2 * k_) * 72 + lane] = (bf16_t)(bvp[k_] & 0xffffu); OB[(2 * k_ + 1) * 72 + lane] = (bf16_t)(bvp[k_] >> 16); }
                        WAVE_LDS_SYNC();
                        const int ti_ = lane >> 2, pt_ = lane & 3;
                        const u32x4 b0_ = *(const LAS u32x4*)(OB + ti_ * 72 + 16 * pt_), b1_ = *(const LAS u32x4*)(OB + ti_ * 72 + 16 * pt_ + 8);
                        bf16_t* bp_ = BV + (size_t)(row0 + ti_) * 512 + h * 64 + 16 * pt_;
                        *(u32x4*)bp_ = b0_; *(u32x4*)(bp_ + 8) = b1_;
                    }
                    float tt[16];
#pragma unroll
                    for (int mm = 0; mm < 16; ++mm) tt[mm] = mm == fr ? 1.f : 0.f;
#pragma unroll
                    for (int j = 14; j >= 0; --j) { float val = 0.f;
#pragma unroll
                        for (int mm = j + 1; mm < 16; ++mm) val += tt[mm] * LT[mm * 20 + j];
                        tt[j] += val; }
                    WAVE_LDS_SYNC();
                    if (fq == 0) {
#pragma unroll
                        for (int mm = 0; mm < 16; ++mm) LT[fr * 20 + mm] = tt[mm]; }
                    {
                        f32x4 g4 = (f32x4){0.f, 0.f, 0.f, 0.f};
#pragma unroll
                        for (int mm = 0; mm < 16; ++mm) g4 += *(const LAS f32x4*)(LAK + mm * 16 + 4 * fq) * tt[mm];
                        u32x2 w; w.x = pk2bf(g4[0], g4[1]); w.y = pk2bf(g4[2], g4[3]);
                        *(u32x2*)(rb + 3072 + (fr * 16 + 4 * fq) * 2) = w;
                    }
                    WAVE_LDS_SYNC();
                    TP_MARK(25);
                    {
#pragma unroll
                        for (int i = 0; i < 16; ++i) { float acc = 0.f;
                            const f32x4 t0 = *(const LAS f32x4*)(LT + i * 20), t1 = *(const LAS f32x4*)(LT + i * 20 + 4), t2 = *(const LAS f32x4*)(LT + i * 20 + 8), t3 = *(const LAS f32x4*)(LT + i * 20 + 12);
                            const float trow[16] = {t0[0], t0[1], t0[2], t0[3], t1[0], t1[1], t1[2], t1[3], t2[0], t2[1], t2[2], t2[3], t3[0], t3[1], t3[2], t3[3]};
#pragma unroll
                            for (int mm = 0; mm <= i; ++mm) acc += trow[mm] * atil[mm];
                            OK[i * 72 + lane] = f2bf(acc); }
                        WAVE_LDS_SYNC();
                        REC_STORE(OK, ra);
                    }
#undef REC_STORE
                    TP_MARK(26);
                }
            }
            __syncthreads();
#undef PN_DMA
#undef PS_DMA
#undef PSV
            TP_MARK(29);
            TP_MARK(21);
            const float* q_g = inq[16] + lq * 64; const float* k_g = inq[17] + lq * 64; const float* b_f = inq[15] + lq * 8;
            for (int it = gw - (G >= 96 ? 80 * NWAVES : 0); it >= 0 && it < NMETA * NH; it += ngw) {
                const int row = MROWS + (it >> 3), h = it & 7;
                bf16_t* qp = p + (size_t)row * PBW + 1536 + h * 64 + lane; bf16_t* kp = p + (size_t)row * PBW + 2048 + h * 64 + lane;
                const float q = bf2f(*qp), k = bf2f(*kp);
                const float mq = wave_sum(q * q) * (1.f / 64.f), mk = wave_sum(k * k) * (1.f / 64.f);
                *qp = f2bf(q * (1.0f / sqrtf(mq + 1e-6f)) * q_g[lane] * (0.125f * LOG2E));
                *kp = f2bf(k * (1.0f / sqrtf(mk + 1e-6f)) * k_g[lane]);
            }
            for (int it = bid - (G >= 80 ? 16 : 0); it >= 0 && it < NB * NH; it += G) {
                constexpr int PER = 5;
                const int b = it >> 3, h = it & 7;
                float zv[PER], loc[PER], s = 0.f;
#pragma unroll
                for (int i = 0; i < PER; ++i) { const int t = tid * PER + i; zv[i] = pn[(size_t)rowof(b, t < LTOT ? t : LTOT - 1) * PNW + 288 + h]; }
#pragma unroll
                for (int i = 0; i < PER; ++i) { const int t = tid * PER + i;
                    const float v = t < LTOT ? -__builtin_amdgcn_logf(1.f + __builtin_amdgcn_exp2f(-LOG2E * (zv[i] + b_f[h]))) : 0.f;
                    s += v; loc[i] = s; }
                float incl = s;
#pragma unroll
                for (int o = 1; o < 64; o <<= 1) { const float n = __int_as_float(__builtin_amdgcn_ds_bpermute((lane - o) << 2, __float_as_int(incl))); if (lane >= o) incl += n; }
                float base = incl - s;
                if (lane == 63) ((LAS float*)ldsl)[wave] = incl;
                __syncthreads();
#pragma unroll
                for (int w = 0; w < NWAVES - 1; ++w) base += w < wave ? ((const LAS float*)ldsl)[w] : 0.f;
                float* cv = c2 + (size_t)it * 2176;
#pragma unroll
                for (int i = 0; i < PER; ++i) { const int t = tid * PER + i; if (t < LTOT) cv[t < NMETA ? t : t + 112] = base + loc[i]; }
                if (tid < 112) cv[16 + tid] = 1e5f;
                __syncthreads();
            }
        }
        } else if (ph == 2) {
        {
            PHASE_IDS(); PHASE_PTRS(l);
            typedef short s16x4 __attribute__((ext_vector_type(4)));
            constexpr int SLOTB = 12288, NSLOT = 10  , YB_OFF = NSLOT * SLOTB, YB_BYTES = 32 * 68 * 4, NSC = (NCH + 1) / 2;
            static_assert(YB_OFF + 2 * YB_BYTES <= LDSCTL_OFF, "scan LDS map");
#define RAW_BAR() asm volatile("s_waitcnt lgkmcnt(0)\n\ts_barrier" ::: "memory")
#define QXOR1(x) __int_as_float(__builtin_amdgcn_update_dpp(0, __float_as_int(x), 0xB1, 0xf, 0xf, false))
#define QXOR2(x) __int_as_float(__builtin_amdgcn_update_dpp(0, __float_as_int(x), 0x4E, 0xf, 0xf, false))
            for (int unit = bid; unit < 64; unit += G) {
                const int b = unit >> 3, h = unit & 7, fr = lane & 15, fq = lane >> 4;
                const unsigned char* RA0 = ws + WS_RA + (size_t)unit * NCH * RA_BYTES; const unsigned char* RB0 = (const unsigned char*)out + (size_t)unit * NCH * RB_BYTES;
                if (wave < 4) {
                    const int v = 16 * wave + fr;
                    f32x4 Z[4];
#pragma unroll
                    for (int kb = 0; kb < 4; ++kb) Z[kb] = (f32x4){0.f, 0.f, 0.f, 0.f};
                    const int o_ah0 = fr * 128 + (((fq) ^ ((fr >> 1) & 7)) << 4), o_ah1 = fr * 128 + (((4 + fq) ^ ((fr >> 1) & 7)) << 4);
                    const int o_bk = 4096 + fr * 64 + ((fq ^ SWZ4(fr)) << 4), o_mrk = 10240 + fr * 64 + ((fq ^ SWZ4(fr)) << 4);
                    const int o_vt = 8192 + v * 32 + fq * 8, o_g = 11264 + fr * 32 + fq * 8, o_gam = 11776 + fq * 16;
                    RAW_BAR();
                    for (int s = 0; s < NSC; ++s) {
                        LAS float* YB = (LAS float*)(ldsl + YB_OFF + (s & 1) * YB_BYTES);
                        const int nc = (NCH - 2 * s) < 2 ? 1 : 2;
                        for (int cs = 0; cs < nc; ++cs) {
                            const LAS unsigned char* sl = ldsl + ((2 * s + cs) % NSLOT) * SLOTB;
                            const bf16x8 ah0 = *(const LAS bf16x8*)(sl + o_ah0), ah1 = *(const LAS bf16x8*)(sl + o_ah1);
                            const bf16x8 rh0 = *(const LAS bf16x8*)(sl + 2048 + o_ah0), rh1 = *(const LAS bf16x8*)(sl + 2048 + o_ah1);
                            bf16x8 bk[4]; f32x4 gam[4];
#pragma unroll
                            for (int kb = 0; kb < 4; ++kb) { bk[kb] = *(const LAS bf16x8*)(sl + o_bk + kb * 1024); gam[kb] = *(const LAS f32x4*)(sl + o_gam + kb * 64); }
                            const u32x2 vt = *(const LAS u32x2*)(sl + o_vt);
                            const bf16x8 mrk = *(const LAS bf16x8*)(sl + o_mrk);
                            const u32x2 g4 = *(const LAS u32x2*)(sl + o_g);
                            u32x4 zw01, zw23;
                            zw01.x = pk2bf(Z[0][0], Z[0][1]); zw01.y = pk2bf(Z[0][2], Z[0][3]); zw01.z = pk2bf(Z[1][0], Z[1][1]); zw01.w = pk2bf(Z[1][2], Z[1][3]);
                            zw23.x = pk2bf(Z[2][0], Z[2][1]); zw23.y = pk2bf(Z[2][2], Z[2][3]); zw23.z = pk2bf(Z[3][0], Z[3][1]); zw23.w = pk2bf(Z[3][2], Z[3][3]);
                            const bf16x8 zp01 = __builtin_bit_cast(bf16x8, zw01), zp23 = __builtin_bit_cast(bf16x8, zw23);
                            f32x4 U = (f32x4){0.f, 0.f, 0.f, 0.f}, Yv = U;
                            U = __builtin_amdgcn_mfma_f32_16x16x32_bf16(ah0, zp01, U, 0, 0, 0); U = __builtin_amdgcn_mfma_f32_16x16x32_bf16(ah1, zp23, U, 0, 0, 0);
                            U = __builtin_amdgcn_mfma_f32_16x16x16bf16_1k(__builtin_bit_cast(s16x4, g4), __builtin_bit_cast(s16x4, vt), U, 0, 0, 0);
                            Yv = __builtin_amdgcn_mfma_f32_16x16x32_bf16(rh0, zp01, Yv, 0, 0, 0); Yv = __builtin_amdgcn_mfma_f32_16x16x32_bf16(rh1, zp23, Yv, 0, 0, 0);
                            u32x4 uvw; uvw.x = pk2bf(U[0], U[1]); uvw.y = pk2bf(U[2], U[3]); uvw.z = vt.x; uvw.w = vt.y;
                            const bf16x8 uv = __builtin_bit_cast(bf16x8, uvw);
                            Yv = __builtin_amdgcn_mfma_f32_16x16x32_bf16(mrk, uv, Yv, 0, 0, 0);
#pragma unroll
                            for (int kb = 0; kb < 4; ++kb) { Z[kb] = Z[kb] * gam[kb]; Z[kb] = __builtin_amdgcn_mfma_f32_16x16x32_bf16(bk[kb], uv, Z[kb], 0, 0, 0); }
#pragma unroll
                            for (int r = 0; r < 4; ++r) YB[(cs * 16 + 4 * fq + r) * 68 + v] = Yv[r];
                        }
                        RAW_BAR();
                    }
                } else if (wave < 6) {
                    const unsigned lds0 = (unsigned)(uintptr_t)lds; const int lw = wave - 4;
#define DMA_SC(sc) do { const int nc_ = (NCH - 2 * (sc)) < 2 ? 1 : 2; for (int cs_ = 0; cs_ < nc_; ++cs_) { const int ch_ = 2 * (sc) + cs_; \
                        _Pragma("unroll") for (int pc_ = 0; pc_ < 6; ++pc_) { const int pc = lw * 6 + pc_; \
                            const unsigned char* src_ = (pc < 8 ? RA0 + (size_t)ch_ * RA_BYTES + pc * 1024 : RB0 + (size_t)ch_ * RB_BYTES + (pc - 8) * 1024) + lane * 16; \
                            attn_body::glds16(src_, (unsigned)__builtin_amdgcn_readfirstlane(lds0 + (ch_ % NSLOT) * SLOTB + pc * 1024)); } } } while (0)
                    DMA_SC(0); DMA_SC(1); DMA_SC(2); DMA_SC(3);
                    asm volatile("s_waitcnt vmcnt(36)\n\ts_barrier" ::: "memory");
                    for (int s = 0; s < NSC; ++s) {
                        if (s + 4 < NSC) DMA_SC(s + 4);
#define NPC_(sc) ((sc) < NSC ? ((NCH - 2 * (sc)) < 2 ? 6 : 12) : 0)
                        const int fl = NPC_(s + 2) + NPC_(s + 3) + NPC_(s + 4);
#undef NPC_
                        if (fl == 36) asm volatile("s_waitcnt vmcnt(36)\n\ts_barrier" ::: "memory");
                        else if (fl == 30) asm volatile("s_waitcnt vmcnt(30)\n\ts_barrier" ::: "memory");
                        else if (fl == 18) asm volatile("s_waitcnt vmcnt(18)\n\ts_barrier" ::: "memory");
                        else if (fl == 6) asm volatile("s_waitcnt vmcnt(6)\n\ts_barrier" ::: "memory");
                        else asm volatile("s_waitcnt vmcnt(0)\n\ts_barrier" ::: "memory");
                    }
#undef DMA_SC
                } else {
                    const int pw = wave - 6, tk = lane >> 2, part = lane & 3, cgv = h * 64 + part * 16;
                    const bf16_t* BV = (const bf16_t*)(ws + WS_BV);
                    float gnw[16], gnb[16];
#pragma unroll
                    for (int j = 0; j < 16; ++j) { gnw[j] = (inq[13] + lq * 512)[cgv + j]; gnb[j] = (inq[14] + lq * 512)[cgv + j]; }
#define PLOAD(G0, G1, B0, B1, sg) do { const int cn_ = 2 * (sg) + pw; if ((sg) < NSC && cn_ < NCH) { const size_t rown = (size_t)rowof(b, 16 * cn_ + tk); \
                        G0 = *(const u32x4*)(y + rown * DM + cgv); G1 = *(const u32x4*)(y + rown * DM + cgv + 8); B0 = *(const u32x4*)(BV + rown * 512 + cgv); B1 = *(const u32x4*)(BV + rown * 512 + cgv + 8); } } while (0)
                    u32x4 ga0 = (u32x4){0u, 0u, 0u, 0u}, ga1 = ga0, ba0 = ga0, ba1 = ga0, gb0 = ga0, gb1 = ga0, bb0 = ga0, bb1 = ga0, gc0 = ga0, gc1 = ga0, bc0 = ga0, bc1 = ga0;
                    PLOAD(gb0, gb1, bb0, bb1, 0); PLOAD(gc0, gc1, bc0, bc1, 1);
                    RAW_BAR();
                    for (int s = 0; s <= NSC; ++s) {
                        const int cp = 2 * (s - 1) + pw;
                        const bool do_now = s >= 1 && cp < NCH && (cp > 0 || b == 0);
                        const u32x4 g0 = ga0, g1 = ga1, b0 = ba0, b1 = ba1;
                        ga0 = gb0; ga1 = gb1; ba0 = bb0; ba1 = bb1; gb0 = gc0; gb1 = gc1; bb0 = bc0; bb1 = bc1;
                        PLOAD(gc0, gc1, bc0, bc1, s + 2);
                        if (do_now) {
                            const LAS float* yb = (const LAS float*)(ldsl + YB_OFF + ((s - 1) & 1) * YB_BYTES) + (pw * 16 + tk) * 68 + part * 16;
                            float yv[16];
#pragma unroll
                            for (int q4 = 0; q4 < 4; ++q4) { const f32x4 t4 = *(const LAS f32x4*)(yb + 4 * q4); yv[4 * q4] = t4[0]; yv[4 * q4 + 1] = t4[1]; yv[4 * q4 + 2] = t4[2]; yv[4 * q4 + 3] = t4[3]; }
                            float s1 = 0.f;
#pragma unroll
                            for (int j = 0; j < 16; ++j) s1 += yv[j];
                            s1 += QXOR1(s1); s1 += QXOR2(s1);
                            const float mean = s1 * (1.f / 64.f); float s2 = 0.f;
#pragma unroll
                            for (int j = 0; j < 16; ++j) { yv[j] -= mean; s2 += yv[j] * yv[j]; }
                            s2 += QXOR1(s2); s2 += QXOR2(s2);
                            const float rstd = 1.0f / sqrtf(s2 * (1.f / 64.f) + 64e-5f);
                            const unsigned gws[8] = {g0.x, g0.y, g0.z, g0.w, g1.x, g1.y, g1.z, g1.w}, bws[8] = {b0.x, b0.y, b0.z, b0.w, b1.x, b1.y, b1.z, b1.w};
                            unsigned ow[8];
#pragma unroll
                            for (int j2 = 0; j2 < 8; ++j2) {
                                const float oa = (yv[2 * j2] * rstd * gnw[2 * j2] + gnb[2 * j2] + __uint_as_float(bws[j2] << 16)) * __uint_as_float(gws[j2] << 16);
                                const float ob = (yv[2 * j2 + 1] * rstd * gnw[2 * j2 + 1] + gnb[2 * j2 + 1] + __uint_as_float(bws[j2] & 0xffff0000u)) * __uint_as_float(gws[j2] & 0xffff0000u);
                                ow[j2] = pk2bf(oa, ob); }
                            bf16_t* yo = y + (size_t)rowof(b, 16 * cp + tk) * DM + cgv;
                            *(u32x4*)yo = (u32x4){ow[0], ow[1], ow[2], ow[3]}; *(u32x4*)(yo + 8) = (u32x4){ow[4], ow[5], ow[6], ow[7]};
                        }
                        if (s < NSC) RAW_BAR();
                    }
#undef PLOAD
                }
                __syncthreads();
            }
#undef RAW_BAR
#undef QXOR1
#undef QXOR2
        }
        TP_MARK(30);
        {
            PHASE_IDS(); PHASE_PTRS(l);
            if (gw < NH * NMETA) {
                const int h = gw >> 4, t = gw & 15;
                const bf16_t* qrow = p + (size_t)(MROWS + t) * PBW + 1536 + h * 64;
                float s = -INFINITY;
                if (lane <= t) { const bf16_t* kr = p + (size_t)(MROWS + lane) * PBW + 2048 + h * 64; float d = 0.f;
                    for (int e = 0; e < 64; ++e) d += bf2f(qrow[e]) * bf2f(kr[e]);
                    s = d - c2[(size_t)h * 2176 + lane]; }
                const float mx = wave_max(s); const float e = lane <= t ? exp2f(s - mx) : 0.f; const float sum = wave_sum(e);
                float o = 0.f;
                for (int j = 0; j <= t; ++j) o += __int_as_float(__builtin_amdgcn_readlane(__float_as_int(e), j)) * bf2f(p[(size_t)(MROWS + j) * PBW + 2560 + h * 64 + lane]);
                const float og = bf2f(p[(size_t)(MROWS + t) * PBW + 3072 + h * 64 + lane]);
                y[(size_t)(MROWS + t) * DM + 512 + h * 64 + lane] = f2bf(o * __builtin_amdgcn_rcpf(sum) * __builtin_amdgcn_rcpf(1.f + __builtin_amdgcn_exp2f(-LOG2E * og)));
            }
        }
        __syncthreads();
        {
            PHASE_IDS(); PHASE_PTRS(l);
            typedef attn_body::bf16 abf;
            const attn_body::AttnTensors AT{(const abf*)(p + 1536), (const abf*)(p + 2048), (const abf*)(p + 2560), (const abf*)(p + 3072), c2, (abf*)(y + 512)};
            const attn_body::StaticOrder S(G, bid);
            TP_MARK(31);
            attn_body::attn_phase<attn_body::StaticOrder>((char*)lds, AT, S, wave);
            TP_MARK(32);
        }
        } else if (ph == 3) {
        {
            PHASE_IDS(); PHASE_PTRS(l);
            pg8::Gemm g{y, W2, MROWS, DM, DM}; pg8::StaticOrder S; S.init(MROWS, DM, G, bid);
            pg8::EpiRes E{nullptr, hb, ssqp};
            pg8::gemm_phase<pg8::EpiRes, pg8::StaticOrder, true, true>(ldsl, g, S, E, wave);
            meta_gemm<false>(y + (size_t)MROWS * DM, DM, W2, DM, DM, bid, G, wave, lane, (float*)lds, MEpiRes{hm});
        }
        } else if (ph == 5) {
        {
            PHASE_IDS(); PHASE_PTRS(l);
            const float* cw = inq[21] + (size_t)lq * 3 * DFF2; const float* cb = inq[22] + (size_t)lq * DFF2;
            pg8::Gemm g{act, W4, MROWS, DM, DFF}; pg8::StaticOrder S; S.init(MROWS, DM, G, bid);
            {
                pg8::Unit u;
                for (int i = 0; S.next(i, u); ++i) {
                    const int pm = u.pm;
                    const float* own0 = fixb + (size_t)(pm * 4) * DFF2; const float* own1 = own0 + DFF2;
                    const float* pv0 = (pm & 7) ? fixb + (size_t)((pm - 1) * 4 + 2) * DFF2 : rawm + (size_t)14 * DFF2; const float* pv1 = pv0 + DFF2;
                    for (int j = 4 * tid; j < DFF; j += 4 * NWAVES * 64) {
                        const f32x4 w0u = *(const f32x4*)(cw + j), w1u = *(const f32x4*)(cw + DFF2 + j), w2u = *(const f32x4*)(cw + 2 * DFF2 + j), bu = *(const f32x4*)(cb + j);
                        const f32x4 w0g = *(const f32x4*)(cw + DFF + j), w1g = *(const f32x4*)(cw + DFF2 + DFF + j), w2g = *(const f32x4*)(cw + 2 * DFF2 + DFF + j), bg = *(const f32x4*)(cb + DFF + j);
                        const f32x4 au = *(const f32x4*)(pv0 + j), bu_ = *(const f32x4*)(pv1 + j), cu_ = *(const f32x4*)(own0 + j), du = *(const f32x4*)(own1 + j);
                        const f32x4 ag = *(const f32x4*)(pv0 + DFF + j), bg_ = *(const f32x4*)(pv1 + DFF + j), cg_ = *(const f32x4*)(own0 + DFF + j), dg = *(const f32x4*)(own1 + DFF + j);
                        const f32x4 u0 = bu + w0u * au + w1u * bu_ + w2u * cu_, g0 = bg + w0g * ag + w1g * bg_ + w2g * cg_;
                        const f32x4 u1 = bu + w0u * bu_ + w1u * cu_ + w2u * du, g1 = bg + w0g * bg_ + w1g * cg_ + w2g * dg;
                        u32x2 o0, o1;
                        o0.x = pk2bf(g0[0] * sigmoidf_(g0[0]) * u0[0], g0[1] * sigmoidf_(g0[1]) * u0[1]); o0.y = pk2bf(g0[2] * sigmoidf_(g0[2]) * u0[2], g0[3] * sigmoidf_(g0[3]) * u0[3]);
                        o1.x = pk2bf(g1[0] * sigmoidf_(g1[0]) * u1[0], g1[1] * sigmoidf_(g1[1]) * u1[1]); o1.y = pk2bf(g1[2] * sigmoidf_(g1[2]) * u1[2], g1[3] * sigmoidf_(g1[3]) * u1[3]);
                        *(u32x2*)(act + (size_t)(256 * pm) * DFF + j) = o0; *(u32x2*)(act + (size_t)(256 * pm + 1) * DFF + j) = o1;
                    }
                }
                asm volatile("s_waitcnt vmcnt(0)" ::: "memory"); __syncthreads();
            }
            pg8::EpiRes E{lq + 1 == DEPTH ? out : nullptr, hb, ssqp};
            pg8::gemm_phase<pg8::EpiRes, pg8::StaticOrder, true, true>(ldsl, g, S, E, wave);
            meta_gemm<false>(act + (size_t)MROWS * DFF, DFF, W4, DM, DFF, bid, G, wave, lane, (float*)lds, MEpiRes{hm});
        }
        }
#ifdef TPROBE
#ifdef TPROBE_WAIT
        TP_MARK(19);
#endif
        GRID_BAR(); TP_MARK(ph == 0 ? 1 : ph == 1 ? 2 : ph == 2 ? 3 : ph == 3 ? 4 : ph == 4 ? 5 : 6);
#if TPROBE == 40
        GRID_BAR(); TP_MARK(40);
#endif
#else
        if (ph < 5 || l + 1 < DEPTH) GRID_BAR();
#endif
      }
    }
#ifdef TPROBE
#ifndef TPROBE_BLOCK
#define TPROBE_BLOCK 0
#endif
    if (bid0 == TPROBE_BLOCK && wave_s == 0 && lane_id() == 0) a.out[0] += (float)((volatile LAS unsigned*)((LAS unsigned char*)lds + LDSCTL_OFF + 512))[1] * 0.0001f;
#endif
}

extern "C" void kernel_launch(void* const* d_in, const int* in_sizes, int n_in, void* d_out, int out_size, void* d_ws, size_t ws_size, hipStream_t stream) {
    static int grid = 0;
    if (grid == 0) {
        if (n_in != 24 || out_size != MROWS * DM || ws_size < WS_END) { fprintf(stderr, "kernel_launch: unexpected shapes (n_in %d out %d ws %zu)\n", n_in, out_size, ws_size); grid = -1; return; }
        int dev = 0, cus = 0, per_cu = 0;
        hipGetDevice(&dev); hipDeviceGetAttribute(&cus, hipDeviceAttributeMultiprocessorCount, dev);
        if (hipFuncSetAttribute((const void*)mk_fwd, hipFuncAttributeMaxDynamicSharedMemorySize, LDS_BYTES) != hipSuccess) { fprintf(stderr, "kernel_launch: hipFuncSetAttribute failed\n"); grid = -1; return; }
        hipOccupancyMaxActiveBlocksPerMultiprocessor(&per_cu, (const void*)mk_fwd, NWAVES * 64, LDS_BYTES);
        (void)hipGetLastError();
        if (per_cu < 1) { fprintf(stderr, "kernel_launch: occupancy query says %d blocks per CU\n", per_cu); }
        grid = cus;
    }
    if (grid < 0) return;
    hipMemsetAsync((char*)d_ws + WS_CTL, 0, 32768, stream);
    Args a{};
    for (int i = 0; i < 24; ++i) a.in[i] = (const float*)d_in[i];
    a.out = (float*)d_out; a.ws = (unsigned char*)d_ws;
    void* args[] = {&a};
#ifdef PLAIN_LAUNCH
    hipLaunchKernelGGL(mk_fwd, dim3(grid), dim3(NWAVES * 64), LDS_BYTES, stream, a); hipError_t e = hipPeekAtLastError(); (void)args;
#else
    hipError_t e = hipLaunchCooperativeKernel((const void*)mk_fwd, dim3(grid), dim3(NWAVES * 64), args, LDS_BYTES, stream);
#endif
    if (e != hipSuccess) fprintf(stderr, "cooperative launch failed: %s (grid %d)\n", hipGetErrorString(e), grid);
}
```

```cpp
#define PLAIN_LAUNCH 1
#include <hip/hip_runtime.h>
#include <hip/hip_cooperative_groups.h>
#include <stdint.h>
#include <cstdio>
namespace cg = cooperative_groups;

typedef unsigned short bf16_t;
typedef short bf16x8 __attribute__((ext_vector_type(8)));
typedef float f32x4 __attribute__((ext_vector_type(4)));
typedef unsigned u32x4 __attribute__((ext_vector_type(4)));
typedef unsigned u32x2 __attribute__((ext_vector_type(2)));

constexpr int NB = 8, SEQ = 2048, NMETA = 16, LTOT = 2064, DM = 1024, DEPTH = 4, NH = 8, HD = 64;
constexpr int N_IN = 3880, DFF = 2816, DFF2 = 5632;
constexpr int MROWS = NB * SEQ;
constexpr int RROWS = MROWS + NMETA;
constexpr int N1 = 4096;
constexpr int PBW = 3584;
constexpr int PNW = 320;
constexpr float LOG2E = 1.4426950408889634f;

constexpr size_t MiB = 1u << 20;
constexpr size_t WS_CTL = 0, CTL_ZERO_BYTES = 1 * MiB;
constexpr size_t WS_W = 1 * MiB, WL_BYTES = 27 * MiB;
constexpr size_t WO_W1 = 0;
constexpr size_t WO_W2 = 8 * MiB;
constexpr size_t WO_W3 = 10 * MiB;
constexpr size_t WO_W4 = 21 * MiB;
constexpr size_t WO_LUP = 26 * MiB + 512 * 1024;
constexpr size_t WS_SMALL = WS_W + 2 * WL_BYTES;
constexpr size_t WS_HM = WS_SMALL;
constexpr size_t WS_C2 = WS_SMALL + 1 * MiB;
constexpr size_t WS_SSQ = WS_SMALL + 3 * MiB;
constexpr size_t WS_HB = WS_SMALL + 6 * MiB;
constexpr size_t WS_P = WS_HB + 33 * MiB;
constexpr size_t WS_PN = WS_P + 113 * MiB;
constexpr size_t WS_Y = WS_PN + 21 * MiB;
constexpr size_t WS_FREE = WS_Y + 33 * MiB;
constexpr int NCH = 129;
constexpr size_t RA_BYTES = 8192, RB_BYTES = 4096;
constexpr size_t WS_RA = WS_FREE;
#define SWZ4(r) (3 * (((r) >> 3) & 1))
constexpr size_t WS_ACT = WS_P;
constexpr size_t WS_FIX = WS_PN;
constexpr size_t WS_RAWM = WS_PN + 6 * MiB;
constexpr size_t WS_BV = WS_RA + 65 * MiB;
constexpr size_t WS_END = WS_BV + 17 * MiB;

__device__ __forceinline__ float bf2f(bf16_t v) { return __uint_as_float(((unsigned)v) << 16); }
typedef float f32x2_t_ __attribute__((ext_vector_type(2))); typedef __bf16 bf16x2_t_ __attribute__((ext_vector_type(2)));
__device__ __forceinline__ unsigned pk2bf(float lo, float hi) { const f32x2_t_ v = {lo, hi}; return __builtin_bit_cast(unsigned, __builtin_convertvector(v, bf16x2_t_)); }
__device__ __forceinline__ bf16_t f2bf(float f) { return __builtin_bit_cast(bf16_t, (__bf16)f); }
__device__ __forceinline__ float sigmoidf_(float x) { return 1.f / (1.f + __expf(-x)); }
__device__ __forceinline__ float wave_sum_dpp(float v) {
#define DPPF_(x, ctrl, rmask) __int_as_float(__builtin_amdgcn_update_dpp(0, __float_as_int(x), ctrl, rmask, 0xf, false))
    v += DPPF_(v, 0xB1, 0xf);
    v += DPPF_(v, 0x4E, 0xf);
    v += DPPF_(v, 0x141, 0xf);
    v += DPPF_(v, 0x140, 0xf);
    v += DPPF_(v, 0x142, 0xa);
    v += DPPF_(v, 0x143, 0xc);
#undef DPPF_
    return __int_as_float(__builtin_amdgcn_readlane(__float_as_int(v), 63));
}
__device__ __forceinline__ float wave_sum(float v) { return wave_sum_dpp(v); }
__device__ __forceinline__ void wave_sum_dpp8(float (&v)[8]) {
#define DPPF_(x, ctrl, rmask) __int_as_float(__builtin_amdgcn_update_dpp(0, __float_as_int(x), ctrl, rmask, 0xf, false))
#define DPPS_(ctrl, rmask) _Pragma("unroll") for (int j_ = 0; j_ < 8; ++j_) v[j_] += DPPF_(v[j_], ctrl, rmask); __builtin_amdgcn_sched_barrier(0);
    DPPS_(0xB1, 0xf) DPPS_(0x4E, 0xf) DPPS_(0x141, 0xf) DPPS_(0x140, 0xf) DPPS_(0x142, 0xa) DPPS_(0x143, 0xc)
#undef DPPS_
#undef DPPF_
#pragma unroll
    for (int j_ = 0; j_ < 8; ++j_) v[j_] = __int_as_float(__builtin_amdgcn_readlane(__float_as_int(v[j_]), 63));
}
__device__ __forceinline__ float wave_max(float v) {
#define DPPF_(x, ctrl, rmask) __int_as_float(__builtin_amdgcn_update_dpp(__float_as_int(x), __float_as_int(x), ctrl, rmask, 0xf, false))
    v = fmaxf(v, DPPF_(v, 0xB1, 0xf)); v = fmaxf(v, DPPF_(v, 0x4E, 0xf)); v = fmaxf(v, DPPF_(v, 0x141, 0xf)); v = fmaxf(v, DPPF_(v, 0x140, 0xf));
    v = fmaxf(v, DPPF_(v, 0x142, 0xa)); v = fmaxf(v, DPPF_(v, 0x143, 0xc));
#undef DPPF_
    return __int_as_float(__builtin_amdgcn_readlane(__float_as_int(v), 63));
}
__device__ __forceinline__ float add_xor16(float x) { const auto r = __builtin_amdgcn_permlane16_swap(__float_as_uint(x), __float_as_uint(x), false, false); return __uint_as_float(r[0]) + __uint_as_float(r[1]); }
__device__ __forceinline__ float add_xor32(float x) { const auto r = __builtin_amdgcn_permlane32_swap(__float_as_uint(x), __float_as_uint(x), false, false); return __uint_as_float(r[0]) + __uint_as_float(r[1]); }
__device__ __forceinline__ int lane_id() { int l; asm volatile("v_mbcnt_lo_u32_b32 %0, -1, 0\n\tv_mbcnt_hi_u32_b32 %0, -1, %0" : "=v"(l)); return l; }
#define WAVE_LDS_SYNC() do { __builtin_amdgcn_s_waitcnt(0xc07f); __builtin_amdgcn_wave_barrier(); } while (0)
__device__ __forceinline__ int rowof(int b, int t) { return t < NMETA ? MROWS + t : b * SEQ + (t - NMETA); }
__device__ __forceinline__ int prevrow(int row) {
    if (row >= MROWS) return row == MROWS ? -1 : row - 1;
    return (row & (SEQ - 1)) ? row - 1 : MROWS + NMETA - 1;
}

#define PERM32(j) (8 * (((j) >> 2) & 3) + 4 * ((j) >> 4) + ((j) & 3))
__device__ __forceinline__ int src_col(int mode, int n) {
    if (mode == 1) {
        const int g = n >> 9, c_ = n & 255, o = (n & 256) + (g < 7 ? ((c_ >> 5) & 3) * 64 + (c_ >> 7) * 32 + PERM32(c_ & 31) : c_);
        switch (g) {
            case 0: return o;
            case 1: return 512 + o;
            case 2: return 1024 + o;
            case 3: return 1824 + o;
            case 4: return 2336 + o;
            case 5: return 2848 + o;
            case 6: return 3360 + o;
            default:
                if (o < 64) return 1536 + o;
                if (o < 128) return 1600 + (o - 64);
                if (o < 288) return 1664 + (o - 128);
                if (o < 296) return 3872 + (o - 288);
                return -1;
        }
    }
    if (mode == 3) { const int t = n >> 8, c = n & 255; return c < 128 ? 128 * t + c : DFF + 128 * t + (c - 128); }
    return (n & ~31) + PERM32(n & 31);
}
__device__ __forceinline__ void wprep_item(const float* W, const float* gk, bf16_t* WT, int K, int Nsrc, int Ndst, int mode, int item, float* scr, int lane) {
    const int nblk = Ndst / 32, kb = item / nblk, nb = item % nblk, k0 = 64 * kb, n0 = 32 * nb;
    const int sc = src_col(mode, n0 + (lane & 31));
    const float* wp = W + (size_t)(k0 + (lane >> 5)) * Nsrc + (sc >= 0 ? sc : 0);
    float v[32];
#pragma unroll
    for (int i = 0; i < 32; ++i) { v[i] = *wp; wp += 2 * (size_t)Nsrc; }
#pragma unroll
    for (int i = 0; i < 32; ++i) scr[(2 * i + (lane >> 5)) * 33 + (lane & 31)] = sc >= 0 ? v[i] : 0.f;
    WAVE_LDS_SYNC();
    const int c = lane & 7;
    f32x4 g0 = (f32x4){1.f, 1.f, 1.f, 1.f}, g1 = g0;
    if (gk) { g0 = *(const f32x4*)(gk + k0 + 8 * c); g1 = *(const f32x4*)(gk + k0 + 8 * c + 4); }
#pragma unroll
    for (int j = 0; j < 4; ++j) {
        const int n = (lane >> 3) + 8 * j; const float* s = scr + (8 * c) * 33 + n;
        u32x4 o;
        o.x = pk2bf(s[0 * 33] * g0[0], s[1 * 33] * g0[1]); o.y = pk2bf(s[2 * 33] * g0[2], s[3 * 33] * g0[3]); o.z = pk2bf(s[4 * 33] * g1[0], s[5 * 33] * g1[1]); o.w = pk2bf(s[6 * 33] * g1[2], s[7 * 33] * g1[3]);
        *(u32x4*)(WT + (size_t)(n0 + n) * K + k0 + 8 * c) = o;
    }
    WAVE_LDS_SYNC();
}
namespace pg8 {
#define PG8_LAS __attribute__((address_space(3)))
typedef unsigned short bf16_t;
typedef short bf16x8 __attribute__((ext_vector_type(8)));
typedef float f32x4 __attribute__((ext_vector_type(4)));
typedef unsigned u32x4 __attribute__((ext_vector_type(4)));
constexpr int BM = 256, BK = 64, HALF = 128, HTB = HALF * BK * 2  , STAGE_BYTES = 8 * HTB, NXCD = 8, WGM = 8;

__host__ __device__ __forceinline__ int lds_byte(int r, int c) { const int st = (r >> 4) * 2 + (c >> 5), rr = r & 15, cc = c & 31, ob = rr * 64 + cc * 2; return st * 1024 + (ob ^ (((ob >> 9) & 1) << 5)); }
__host__ __device__ __forceinline__ void stage_rc(int b, int& R, int& C) { const int st = b / 1024, sb = b % 1024, swz = sb ^ (((sb >> 9) & 1) << 5); R = (st >> 1) * 16 + swz / 64; C = (st & 1) * 32 + (swz % 64) / 2; }
__host__ __device__ __forceinline__ int perm32(int rho) { const int n = rho >> 4, i = rho & 15; return 8 * (i >> 2) + 4 * n + (i & 3); }

struct Unit { int pm, pn, idx; };
struct Gemm { const bf16_t* A; const bf16_t* Bt; int M, N, K; };

struct StaticOrder {
    int nM, nN, nwg, G, c;
    __host__ __device__ void init(int M, int N, int G_, int c_) { nM = M / BM; nN = N / BM; nwg = nM * nN; G = G_; c = c_; }
    __host__ __device__ bool next(int i, Unit& u) const {
        const long L = (long)i * G + c; if (L >= nwg) return false;
        int wgid = (int)L; { const int q = nwg / NXCD, r = nwg % NXCD, xcd = wgid % NXCD, off = wgid / NXCD; wgid = (xcd < r ? xcd * (q + 1) : r * (q + 1) + (xcd - r) * q) + off; }
        const int nig = WGM * nN, gid = wgid / nig, fm = gid * WGM, gsz = (nM - fm) < WGM ? (nM - fm) : WGM;
        u.pm = fm + ((wgid % nig) % gsz); u.pn = (wgid % nig) / gsz; u.idx = i; return true;
    }
    __device__ __forceinline__ void a_ready(const Unit&) const {}
    __device__ __forceinline__ void done(const Unit&) const {}
};

__device__ __forceinline__ float row_rstd(const float* ssqp, int row) {
    const f32x4* sp = (const f32x4*)(ssqp + (size_t)row * 16);
    const f32x4 a = sp[0], b = sp[1], c = sp[2], d = sp[3];
    const float s = (((a.x + a.y) + (a.z + a.w)) + ((b.x + b.y) + (b.z + b.w))) + (((c.x + c.y) + (c.z + c.w)) + ((d.x + d.y) + (d.z + d.w)));
    return 1.0f / sqrtf(s * (1.f / 1024.f) + 1e-6f);
}
struct Epi1 {
    static constexpr bool PERM = false, AFTER_DRAIN = false;
    const PG8_LAS float* rstdl; bf16_t* p; float* pn; const float* q_g; const float* k_g;
    __device__ __forceinline__ void operator()(const f32x4 (&acc)[2][2][4][2], const Unit& u, int wr, int wc, int fr, int fq) const {
        const int row0 = u.pm * BM + wr * 64 + fr;
        const bool isq = (u.pn >> 1) == 3, isk = (u.pn >> 1) == 4;
        f32x4 gsc[2][2];
        if (isq || isk) {
#pragma unroll
            for (int bj = 0; bj < 2; ++bj)
#pragma unroll
                for (int n = 0; n < 2; ++n) gsc[bj][n] = *(const f32x4*)((isq ? q_g : k_g) + 32 * bj + 8 * fq + 4 * n) * (isq ? 0.125f * 1.4426950408889634f : 1.f);
        }
#pragma unroll
        for (int ai = 0; ai < 2; ++ai)
#pragma unroll
            for (int m = 0; m < 4; ++m) {
                const int row = row0 + ai * HALF + m * 16; const float rs = rstdl[u.idx * 256 + wr * 64 + fr + ai * HALF + m * 16];
                f32x4 v[2][2];
#pragma unroll
                for (int bj = 0; bj < 2; ++bj)
#pragma unroll
                    for (int n = 0; n < 2; ++n) v[bj][n] = acc[ai][bj][m][n] * rs;
                if (u.pn < 14) {
                    if (isq || isk) {
                        float ss = 0.f;
#pragma unroll
                        for (int bj = 0; bj < 2; ++bj)
#pragma unroll
                            for (int n = 0; n < 2; ++n) ss += (v[bj][n][0] * v[bj][n][0] + v[bj][n][1] * v[bj][n][1]) + (v[bj][n][2] * v[bj][n][2] + v[bj][n][3] * v[bj][n][3]);
                        ss = add_xor16(ss); ss = add_xor32(ss);
                        const float rn = 1.0f / sqrtf(ss * (1.f / 64.f) + 1e-6f);
#pragma unroll
                        for (int bj = 0; bj < 2; ++bj)
#pragma unroll
                            for (int n = 0; n < 2; ++n) v[bj][n] = v[bj][n] * gsc[bj][n] * rn;
                    }
#pragma unroll
                    for (int bj = 0; bj < 2; ++bj) { u32x4 w; w.x = pk2bf(v[bj][0][0], v[bj][0][1]); w.y = pk2bf(v[bj][0][2], v[bj][0][3]); w.z = pk2bf(v[bj][1][0], v[bj][1][1]); w.w = pk2bf(v[bj][1][2], v[bj][1][3]);
                        *(u32x4*)(p + (size_t)row * PBW + u.pn * BM + wc * 64 + bj * 32 + 8 * fq) = w; }
                } else {
#pragma unroll
                    for (int bj = 0; bj < 2; ++bj)
#pragma unroll
                        for (int n = 0; n < 2; ++n) { const int o = u.pn * BM + wc * 32 + 4 * fq + bj * HALF + n * 16 - PBW; if (o < 296) *(f32x4*)(pn + (size_t)row * PNW + o) = v[bj][n]; }
                }
            }
    }
};
struct EpiRes {
    static constexpr bool PERM = false, AFTER_DRAIN = false;
    float* outp; bf16_t* hb; float* ssqp;
    __device__ __forceinline__ void operator()(const f32x4 (&acc)[2][2][4][2], const Unit& u, int wr, int wc, int fr, int fq) const {
        const int row0 = u.pm * BM + wr * 64 + fr, col0 = u.pn * BM + wc * 32 + 8 * fq;
#pragma unroll
        for (int ai = 0; ai < 2; ++ai) {
            u32x4 hw[4][2];
#pragma unroll
            for (int m = 0; m < 4; ++m)
#pragma unroll
                for (int bj = 0; bj < 2; ++bj) hw[m][bj] = *(const u32x4*)(hb + (size_t)(row0 + ai * HALF + m * 16) * DM + col0 + bj * HALF);
            asm volatile("s_waitcnt vmcnt(0)" ::: "memory");
#pragma unroll
            for (int m = 0; m < 4; ++m) {
                const int row = row0 + ai * HALF + m * 16; float ss = 0.f;
#pragma unroll
                for (int bj = 0; bj < 2; ++bj) {
                    const int col = col0 + bj * HALF; bf16_t* hp = hb + (size_t)row * DM + col;
                    const u32x4 h4 = hw[m][bj];
                    const f32x4 v0 = (f32x4){__uint_as_float(h4.x << 16), __uint_as_float(h4.x & 0xffff0000u), __uint_as_float(h4.y << 16), __uint_as_float(h4.y & 0xffff0000u)} + acc[ai][bj][m][0];
                    const f32x4 v1 = (f32x4){__uint_as_float(h4.z << 16), __uint_as_float(h4.z & 0xffff0000u), __uint_as_float(h4.w << 16), __uint_as_float(h4.w & 0xffff0000u)} + acc[ai][bj][m][1];
                    u32x4 w; w.x = pk2bf(v0[0], v0[1]); w.y = pk2bf(v0[2], v0[3]); w.z = pk2bf(v1[0], v1[1]); w.w = pk2bf(v1[2], v1[3]);
                    *(u32x4*)hp = w;
                    if (outp) { *(f32x4*)(outp + (size_t)row * DM + col) = v0; *(f32x4*)(outp + (size_t)row * DM + col + 4) = v1; }
                    const f32x4 r0 = (f32x4){__uint_as_float(w.x << 16), __uint_as_float(w.x & 0xffff0000u), __uint_as_float(w.y << 16), __uint_as_float(w.y & 0xffff0000u)};
                    const f32x4 r1 = (f32x4){__uint_as_float(w.z << 16), __uint_as_float(w.z & 0xffff0000u), __uint_as_float(w.w << 16), __uint_as_float(w.w & 0xffff0000u)};
                    ss += ((r0[0] * r0[0] + r0[1] * r0[1]) + (r0[2] * r0[2] + r0[3] * r0[3])) + ((r1[0] * r1[0] + r1[1] * r1[1]) + (r1[2] * r1[2] + r1[3] * r1[3]));
                }
                ss = add_xor16(ss); ss = add_xor32(ss);
                if (fq == 0) ssqp[(size_t)row * 16 + u.pn * 4 + wc] = ss;
            }
        }
    }
};
__device__ __forceinline__ float dpp_ror1(float x) { return __int_as_float(__builtin_amdgcn_mov_dpp(__float_as_int(x), 0x121, 0xf, 0xf, true)); }
__device__ __forceinline__ float dpp_ror2(float x) { return __int_as_float(__builtin_amdgcn_mov_dpp(__float_as_int(x), 0x122, 0xf, 0xf, true)); }
__device__ __forceinline__ float vmul_s(float a, float b) { float r; asm volatile("v_mul_f32_e32 %0, %1, %2" : "=v"(r) : "v"(a), "v"(b)); return r; }
struct EpiConv {
    static constexpr bool PERM = false, AFTER_DRAIN = false;
    const PG8_LAS float* rstdl; const float* cw; const float* cb; bf16_t* act; float* fix; PG8_LAS unsigned char* halo; PG8_LAS float* ctab;
    __device__ __forceinline__ void operator()(const f32x4 (&acc)[2][2][4][2], const Unit& u, int wr, int wc, int fr_, int fq_) const {
        int fr = fr_, fq = fq_; asm volatile("" : "+v"(fr), "+v"(fq));
        const int row0 = u.pm * BM + wr * 64 + fr, cl = wc * 32 + 4 * fq;
        {
            const int q = 2 * ((wr * 4 + wc) * 64 + fq * 16 + fr), p = q >> 8, col = q & 255;
            const float* src = (p < 3 ? cw + (size_t)p * DFF2 : cb) + (col < 128 ? 128 * u.pn + col : DFF + 128 * u.pn + (col - 128));
            typedef float f32x2w __attribute__((ext_vector_type(2)));
            *(PG8_LAS f32x2w*)(ctab + q) = *(const f32x2w*)src;
        }
        float rs[2][4];
#pragma unroll
        for (int ai = 0; ai < 2; ++ai)
#pragma unroll
            for (int m = 0; m < 4; ++m) rs[ai][m] = rstdl[u.idx * 256 + wr * 64 + fr + ai * HALF + m * 16];
        if (fr >= 14) {
#pragma unroll
            for (int ai = 0; ai < 2; ++ai)
#pragma unroll
                for (int bj = 0; bj < 2; ++bj)
#pragma unroll
                    for (int n = 0; n < 2; ++n) { const f32x4 v = acc[ai][bj][3][n] * rs[ai][3];
                        *(PG8_LAS f32x4*)(halo + ((((ai * 2 + wr) * 2 + (fr - 14)) * 256) + bj * HALF + cl + n * 16) * 4) = v;
                        if (ai == 1 && wr == 1) *(f32x4*)(fix + (size_t)(u.pm * 4 + 2 + (fr - 14)) * DFF2 + bj * DFF + 128 * u.pn + cl + n * 16) = v; }
        }
        if (fr < 2 && wr == 0) {
#pragma unroll
            for (int bj = 0; bj < 2; ++bj)
#pragma unroll
                for (int n = 0; n < 2; ++n) *(f32x4*)(fix + (size_t)(u.pm * 4 + fr) * DFF2 + bj * DFF + 128 * u.pn + cl + n * 16) = acc[0][bj][0][n] * rs[0][0];
        }
        asm volatile("s_waitcnt lgkmcnt(0)\n\ts_barrier" ::: "memory");
        typedef float f32x2v __attribute__((ext_vector_type(2)));
#pragma unroll
        for (int n = 0; n < 2; ++n) {
            const unsigned la2 = (unsigned)(fr * DFF + cl) * 2u;
            unsigned wpk[2][2][4];
#pragma unroll
            for (int eh = 0; eh < 2; ++eh) {
                asm volatile("" ::: "memory"); __builtin_amdgcn_sched_barrier(0);
                const int e = 2 * eh;
#define CWL(p, g) (*(const PG8_LAS f32x2v*)(ctab + (p) * 256 + (g) * 128 + cl + n * 16 + e))
                const f32x2v wu0 = CWL(0, 0), wu1 = CWL(1, 0), wu2 = CWL(2, 0), bu = CWL(3, 0);
                const f32x2v wg0 = CWL(0, 1), wg1 = CWL(1, 1), wg2 = CWL(2, 1), bg = CWL(3, 1);
#undef CWL
#pragma unroll
                for (int ai = 0; ai < 2; ++ai) {
                    const int ps = (ai * 2 + wr) ? (ai * 2 + wr - 1) : 0;
                    const PG8_LAS float* hp = (const PG8_LAS float*)halo + (ps * 2) * 256 + cl + n * 16 + e;
                    const f32x2v hu62 = *(const PG8_LAS f32x2v*)hp, hu63 = *(const PG8_LAS f32x2v*)(hp + 256), hg62 = *(const PG8_LAS f32x2v*)(hp + 128), hg63 = *(const PG8_LAS f32x2v*)(hp + 256 + 128);
                    f32x2v p1u = hu63, p1g = hg63, p2u = fr == 0 ? hu62 : hu63, p2g = fr == 0 ? hg62 : hg63;
#pragma unroll
                    for (int m = 0; m < 4; ++m) {
                        __builtin_amdgcn_sched_barrier(0);
                        f32x2v xu, xg;
                        xu.x = vmul_s(acc[ai][0][m][n][e], rs[ai][m]); xu.y = vmul_s(acc[ai][0][m][n][e + 1], rs[ai][m]); xg.x = vmul_s(acc[ai][1][m][n][e], rs[ai][m]); xg.y = vmul_s(acc[ai][1][m][n][e + 1], rs[ai][m]);
                        f32x2v r1u, r2u, r1g, r2g;
                        r1u.x = dpp_ror1(xu.x); r1u.y = dpp_ror1(xu.y); r2u.x = dpp_ror2(xu.x); r2u.y = dpp_ror2(xu.y);
                        r1g.x = dpp_ror1(xg.x); r1g.y = dpp_ror1(xg.y); r2g.x = dpp_ror2(xg.x); r2g.y = dpp_ror2(xg.y);
                        const f32x2v x1u = fr >= 1 ? r1u : p1u, x2u = fr >= 2 ? r2u : p2u, x1g = fr >= 1 ? r1g : p1g, x2g = fr >= 2 ? r2g : p2g;
                        p1u = r1u; p2u = r2u; p1g = r1g; p2g = r2g;
                        const f32x2v cu = bu + wu0 * x2u + wu1 * x1u + wu2 * xu, cg = bg + wg0 * x2g + wg1 * x1g + wg2 * xg;
                        const float o0 = cg.x * __builtin_amdgcn_rcpf(1.f + __builtin_amdgcn_exp2f(-1.4426950408889634f * cg.x)) * cu.x;
                        const float o1 = cg.y * __builtin_amdgcn_rcpf(1.f + __builtin_amdgcn_exp2f(-1.4426950408889634f * cg.y)) * cu.y;
                        wpk[eh][ai][m] = pk2bf(o0, o1);
                    }
                }
            }
#pragma unroll
            for (int ai = 0; ai < 2; ++ai)
#pragma unroll
                for (int m = 0; m < 4; ++m)
                {
                    u32x2 w; w.x = wpk[0][ai][m]; w.y = wpk[1][ai][m];
                    *(u32x2*)((char*)(act + (size_t)(u.pm * BM + wr * 64 + ai * HALF + m * 16) * DFF + 128 * u.pn + n * 16) + la2) = w; }
        }
    }
};

#ifdef TPROBE
#ifndef TPROBE_PH
#define TPROBE_PH -1
#endif
#define PG8_TP(ph) do { if (TPROBE < 20) break; const unsigned t_ = (unsigned)__builtin_amdgcn_s_memrealtime(); if (wave_s == 0 && lane_id() == 0) { volatile PG8_LAS unsigned* q_ = (volatile PG8_LAS unsigned*)(lds + (163840 - 1024 + 512)); \
        if ((ph) == TPROBE && (TPROBE_PH < 0 || q_[2] == (unsigned)TPROBE_PH)) q_[1] += t_ - q_[0]; q_[0] = t_; } } while (0)
#else
#define PG8_TP(ph) do {} while (0)
#endif
template <class Epi, class Sched, bool ALIGN_EPI = false, bool SP2 = false>
__device__ __forceinline__ void gemm_phase(PG8_LAS unsigned char* lds, const Gemm g, const Sched& S, const Epi& E, const int wave_s) {
    int tid_ = wave_s * 64 + lane_id(); asm volatile("" : "+v"(tid_));
    const int tid = tid_, wid = wave_s, lane = tid & 63, wr = wid >> 2, wc = wid & 3, fr = lane & 15, fq = lane >> 4;
    const int K = g.K, nt = K / BK;
    unsigned voffA[2], voffB[2];
#pragma unroll
    for (int i = 0; i < 2; ++i) { int R, C; stage_rc(tid * 16 + i * 8192, R, C); const int Rb = Epi::PERM ? ((R & ~31) + perm32(R & 31)) : R;
        voffA[i] = (unsigned)(R * K + C) * 2u; voffB[i] = (unsigned)(Rb * K + C) * 2u; }
    const size_t kstep = (size_t)(BK * 2);
    const size_t hstep = (size_t)HALF * K * 2;
    const size_t tstep = 2 * hstep;
    const unsigned ldsw = (unsigned)wid * 1024u;
    const int aoff = lds_byte(wr * 64 + fr, fq * 8), boff = lds_byte(wc * 32 + fr, fq * 8);
#define PG8_SA(b, h) (((b) * 2 + (h)) * HTB)
#define PG8_SB(b, h) ((4 + (b) * 2 + (h)) * HTB)
#define PG8_STAGE(bufoff, gbase, voff) do { _Pragma("unroll") for (int _i = 0; _i < 2; ++_i) \
        __builtin_amdgcn_global_load_lds((const unsigned*)((const char*)(gbase) + (voff)[_i]), (PG8_LAS unsigned*)(lds + (bufoff) + ldsw + _i * 8192), 16, 0, 0); } while (0)
#define PG8_LDA(dst, b, h) do { _Pragma("unroll") for (int m = 0; m < 4; ++m) _Pragma("unroll") for (int k = 0; k < 2; ++k) dst[m][k] = *(const PG8_LAS bf16x8*)(lds + PG8_SA(b, h) + aoff + m * 2048 + k * 1024); } while (0)
#define PG8_LDB(dst, b, h) do { _Pragma("unroll") for (int n = 0; n < 2; ++n) _Pragma("unroll") for (int k = 0; k < 2; ++k) dst[n][k] = *(const PG8_LAS bf16x8*)(lds + PG8_SB(b, h) + boff + n * 2048 + k * 1024); } while (0)
#define PG8_MMA(ai, bj, At, Bt) do { __builtin_amdgcn_s_setprio(1); _Pragma("unroll") for (int m = 0; m < 4; ++m) _Pragma("unroll") for (int n = 0; n < 2; ++n) _Pragma("unroll") for (int k = 0; k < 2; ++k) \
        acc[ai][bj][m][n] = __builtin_amdgcn_mfma_f32_16x16x32_bf16(Bt[n][k], At[m][k], acc[ai][bj][m][n], 0, 0, 0); __builtin_amdgcn_s_setprio(0); } while (0)
#define PG8_WAIT_V(n) asm volatile("s_waitcnt vmcnt(" #n ")" ::: "memory")
#define PG8_WAIT_L(n) asm volatile("s_waitcnt lgkmcnt(" #n ")" ::: "memory")
#define PG8_BAR __builtin_amdgcn_s_barrier()
#define PG8_SCHED __builtin_amdgcn_sched_barrier(0)
    Unit cur, nxt; int ui = 0;
    if (!S.next(0, cur)) return;
    f32x4 acc[2][2][4][2];
#pragma unroll
    for (int a = 0; a < 2; ++a)
#pragma unroll
        for (int b = 0; b < 2; ++b)
#pragma unroll
            for (int m = 0; m < 4; ++m)
#pragma unroll
                for (int n = 0; n < 2; ++n) acc[a][b][m][n] = (f32x4){0.f, 0.f, 0.f, 0.f};
    bf16x8 At[4][2], B0[2][2], B1[2][2];
    const char* cA = (const char*)g.A + (size_t)cur.pm * tstep; const char* cB = (const char*)g.Bt + (size_t)cur.pn * tstep;
    S.a_ready(cur);
    if constexpr (SP2) {
        PG8_STAGE(PG8_SB(0, 0), cB, voffB); PG8_STAGE(PG8_SB(0, 1), cB + hstep, voffB); PG8_STAGE(PG8_SA(0, 0), cA, voffA); PG8_STAGE(PG8_SA(0, 1), cA + hstep, voffA);
        if (wr == 1) PG8_BAR;
        PG8_WAIT_V(2); PG8_BAR;
        PG8_STAGE(PG8_SB(1, 0), cB + kstep, voffB); PG8_STAGE(PG8_SA(1, 0), cA + kstep, voffA); PG8_STAGE(PG8_SB(1, 1), cB + hstep + kstep, voffB);
        PG8_WAIT_V(6); PG8_BAR;
    } else {
        PG8_STAGE(PG8_SB(0, 0), cB, voffB); PG8_STAGE(PG8_SA(0, 0), cA, voffA); PG8_STAGE(PG8_SB(0, 1), cB + hstep, voffB); PG8_STAGE(PG8_SA(0, 1), cA + hstep, voffA);
        if (wr == 1) PG8_BAR;
        PG8_WAIT_V(4); PG8_BAR;
        PG8_STAGE(PG8_SB(1, 0), cB + kstep, voffB); PG8_STAGE(PG8_SA(1, 0), cA + kstep, voffA); PG8_STAGE(PG8_SB(1, 1), cB + hstep + kstep, voffB);
        PG8_WAIT_V(6); PG8_BAR;
    }
    for (;;) {
        const bool has_next = S.next(ui + 1, nxt);
        const char* nA = has_next ? (const char*)g.A + (size_t)nxt.pm * tstep : cA; const char* nB = has_next ? (const char*)g.Bt + (size_t)nxt.pn * tstep : cB;
        for (int t = 0; t < nt; t += 2) {
            const bool last = (t == nt - 2);
            const char* a1 = cA + (size_t)(t + 1) * kstep;
            const char* a2 = last ? nA : cA + (size_t)(t + 2) * kstep; const char* b2 = last ? nB : cB + (size_t)(t + 2) * kstep;
            const char* a3 = a2 + kstep; const char* b3 = b2 + kstep;
            if (last && has_next) S.a_ready(nxt);
            if constexpr (SP2) {
            PG8_LDB(B0, 0, 0); PG8_LDB(B1, 0, 1); PG8_SCHED; PG8_LDA(At, 0, 0); PG8_STAGE(PG8_SA(1, 1), a1 + hstep, voffA);
            PG8_WAIT_V(8); PG8_WAIT_L(0); PG8_BAR; PG8_MMA(0, 0, At, B0); PG8_MMA(0, 1, At, B1); PG8_BAR; PG8_SCHED;
            PG8_LDA(At, 0, 1); PG8_STAGE(PG8_SB(0, 0), b2, voffB); PG8_STAGE(PG8_SB(0, 1), b2 + hstep, voffB); PG8_STAGE(PG8_SA(0, 0), a2, voffA);
            PG8_WAIT_V(8); PG8_WAIT_L(0); PG8_BAR; PG8_MMA(1, 0, At, B0); PG8_MMA(1, 1, At, B1); PG8_BAR; PG8_SCHED;
            PG8_LDB(B0, 1, 0); PG8_LDB(B1, 1, 1); PG8_SCHED; PG8_LDA(At, 1, 0); PG8_STAGE(PG8_SA(0, 1), a2 + hstep, voffA);
            PG8_WAIT_V(8); PG8_WAIT_L(0); PG8_BAR; PG8_MMA(0, 0, At, B0); PG8_MMA(0, 1, At, B1); PG8_BAR; PG8_SCHED;
            PG8_LDA(At, 1, 1); PG8_STAGE(PG8_SB(1, 0), b3, voffB); PG8_STAGE(PG8_SB(1, 1), b3 + hstep, voffB); PG8_STAGE(PG8_SA(1, 0), a3, voffA);
            PG8_WAIT_V(8); PG8_WAIT_L(0); PG8_BAR; PG8_MMA(1, 0, At, B0); PG8_MMA(1, 1, At, B1); PG8_BAR; PG8_SCHED;
            } else {
            PG8_LDB(B0, 0, 0); PG8_SCHED; PG8_LDA(At, 0, 0); PG8_STAGE(PG8_SA(1, 1), a1 + hstep, voffA);
            PG8_WAIT_L(8); PG8_BAR; PG8_WAIT_L(0); PG8_MMA(0, 0, At, B0); PG8_BAR; PG8_SCHED;
            PG8_LDB(B1, 0, 1); PG8_STAGE(PG8_SB(0, 0), b2, voffB);
            PG8_BAR; PG8_WAIT_L(0); PG8_MMA(0, 1, At, B1); PG8_BAR;
            PG8_LDA(At, 0, 1); PG8_STAGE(PG8_SA(0, 0), a2, voffA);
            PG8_BAR; PG8_WAIT_L(0); PG8_MMA(1, 0, At, B0); PG8_BAR; PG8_SCHED;
            PG8_STAGE(PG8_SB(0, 1), b2 + hstep, voffB);
            PG8_WAIT_V(6); PG8_BAR; PG8_MMA(1, 1, At, B1); PG8_BAR;
            PG8_LDB(B0, 1, 0); PG8_SCHED; PG8_LDA(At, 1, 0); PG8_STAGE(PG8_SA(0, 1), a2 + hstep, voffA);
            PG8_WAIT_L(8); PG8_BAR; PG8_WAIT_L(0); PG8_MMA(0, 0, At, B0); PG8_BAR; PG8_SCHED;
            PG8_LDB(B1, 1, 1); PG8_STAGE(PG8_SB(1, 0), b3, voffB);
            PG8_BAR; PG8_WAIT_L(0); PG8_MMA(0, 1, At, B1); PG8_BAR;
            PG8_LDA(At, 1, 1); PG8_STAGE(PG8_SA(1, 0), a3, voffA);
            PG8_BAR; PG8_WAIT_L(0); PG8_MMA(1, 0, At, B0); PG8_BAR; PG8_SCHED;
            PG8_STAGE(PG8_SB(1, 1), b3 + hstep, voffB);
            PG8_WAIT_V(6); PG8_BAR; PG8_MMA(1, 1, At, B1); PG8_BAR;
            }
        }
        PG8_TP(49);
        if constexpr (ALIGN_EPI) { if (wr == 0) PG8_BAR; }
        if constexpr (!Epi::AFTER_DRAIN) { E(acc, cur, wr, wc, fr, fq); S.done(cur); }
        PG8_TP(50);
        if (!has_next) break;
#pragma unroll
        for (int a = 0; a < 2; ++a)
#pragma unroll
            for (int b = 0; b < 2; ++b)
#pragma unroll
                for (int m = 0; m < 4; ++m)
#pragma unroll
                    for (int n = 0; n < 2; ++n) acc[a][b][m][n] = (f32x4){0.f, 0.f, 0.f, 0.f};
        cur = nxt; cA = nA; cB = nB; ++ui;
        if constexpr (ALIGN_EPI) { if (wr == 1) PG8_BAR; }
    }
    PG8_WAIT_V(0);
    if constexpr (!ALIGN_EPI) { if (wr == 0) PG8_BAR; }
    PG8_BAR;
    if constexpr (Epi::AFTER_DRAIN) { E.fused(acc, cur, wr, wc, fr, fq, lds, wid, lane); S.done(cur); }
#undef PG8_SA
#undef PG8_SB
#undef PG8_STAGE
#undef PG8_LDA
#undef PG8_LDB
#undef PG8_MMA
#undef PG8_WAIT_V
#undef PG8_WAIT_L
#undef PG8_BAR
#undef PG8_SCHED
}
}
#include <hip/hip_bf16.h>
#include <cmath>
namespace attn_body {
using bf16=__hip_bfloat16;
using bf16x8=__attribute__((ext_vector_type(8)))short;
using s16x4=__attribute__((ext_vector_type(4)))short;
using f32x16=__attribute__((ext_vector_type(16)))float;
using u32x4=__attribute__((ext_vector_type(4)))unsigned;
constexpr int BATCH=8,NHEAD=8,SEQ=2048,D=64,PITCH=3584,OPITCH=1024,LEADROW=16384,VK=2176;
constexpr int NW=8,QBLK=32,QB=QBLK*NW,KVBLK=64,NQB=SEQ/QB;
constexpr int ATTN_UNIT_ROWS=QB;
__device__ __forceinline__ int crow(int r,int hi){return (r&3)+8*(r>>2)+4*hi;}
#define SBAR() __builtin_amdgcn_sched_barrier(0)
__device__ __forceinline__ void cmask(f32x16&p0,f32x16&p1,int jb,int qrel,int hi){
  const float NEG=-INFINITY; int kb=64*jb+4*hi;
  #pragma unroll
  for(int r=0;r<16;++r){int kv=kb+(r&3)+8*(r>>2); if(kv>qrel)p0[r]=NEG; if(kv+32>qrel)p1[r]=NEG;}
}

constexpr int NSLOT=3, SLOTB=8192;
constexpr int LDS_K=0, LDS_V=NSLOT*SLOTB, LDS_WS=2*NSLOT*SLOTB, LDS_OST=LDS_WS+NW*64*4, LDS_C2=LDS_OST+NW*4096, LDS_BYTES=LDS_C2+VK*4;
constexpr float C2=0.125f*1.4426950408889634f;
__device__ __forceinline__ void glds16(const void*gsrc,unsigned lds_dst){unsigned keep;
  asm volatile("s_mov_b32 %0, m0\n\ts_mov_b32 m0, %2\n\ts_nop 0\n\tglobal_load_lds_dwordx4 %1, off\n\ts_mov_b32 m0, %0":"=&s"(keep):"v"(gsrc),"s"(lds_dst):"memory");}
__device__ __forceinline__ float max3f(float a,float b,float c){float r;asm("v_max3_f32 %0, %1, %2, %3":"=v"(r):"v"(a),"v"(b),"v"(c));return r;}
__device__ __forceinline__ float max2f(float a,float b){float r;asm("v_max_f32_e32 %0, %1, %2":"=v"(r):"v"(a),"v"(b));return r;}
__device__ __forceinline__ float fadd_s(float a,float b){float r;asm("v_add_f32_e32 %0, %1, %2":"=v"(r):"v"(a),"v"(b));return r;}
__device__ __forceinline__ float fsub_s(float a,float b){float r;asm("v_sub_f32_e32 %0, %1, %2":"=v"(r):"v"(a),"v"(b));return r;}
typedef float f32x2_t __attribute__((ext_vector_type(2))); typedef __bf16 bf16x2_t __attribute__((ext_vector_type(2)));
__device__ __forceinline__ unsigned cvtpk_s(float lo,float hi){f32x2_t v={lo,hi};bf16x2_t b=__builtin_convertvector(v,bf16x2_t);return __builtin_bit_cast(unsigned,b);}
#define WAIT_BAR(N) asm volatile("s_waitcnt vmcnt(" #N ") lgkmcnt(0)\n\ts_barrier":::"memory")

__device__ __forceinline__ void qkt(f32x16&p0,f32x16&p1,const char*Kslot,const bf16x8*qr,int r32,int hi){
  const char*kb=Kslot+hi*1024+r32*16;
  #pragma unroll
  for(int d0=0;d0<4;++d0){
    const bf16x8 b0=*reinterpret_cast<const bf16x8*>(kb+d0*2048);
    const bf16x8 b1=*reinterpret_cast<const bf16x8*>(kb+d0*2048+512);
    p0=__builtin_amdgcn_mfma_f32_32x32x16_bf16(b0,qr[d0],p0,0,0,0);p1=__builtin_amdgcn_mfma_f32_32x32x16_bf16(b1,qr[d0],p1,0,0,0);}
}
typedef __attribute__((address_space(3))) const char* lds_cptr;
typedef short v4i16_t __attribute__((ext_vector_type(4)));
__device__ __forceinline__ void kload8(bf16x8*kf,lds_cptr kp){
  kf[0]=*(const __attribute__((address_space(3))) bf16x8*)(kp);      kf[1]=*(const __attribute__((address_space(3))) bf16x8*)(kp+512);
  kf[2]=*(const __attribute__((address_space(3))) bf16x8*)(kp+2048); kf[3]=*(const __attribute__((address_space(3))) bf16x8*)(kp+2560);
  kf[4]=*(const __attribute__((address_space(3))) bf16x8*)(kp+4096); kf[5]=*(const __attribute__((address_space(3))) bf16x8*)(kp+4608);
  kf[6]=*(const __attribute__((address_space(3))) bf16x8*)(kp+6144); kf[7]=*(const __attribute__((address_space(3))) bf16x8*)(kp+6656);
}
__device__ __forceinline__ void kload2(bf16x8*kf,lds_cptr kp,int j){ kf[2*j]=*(const __attribute__((address_space(3))) bf16x8*)(kp+j*2048); kf[2*j+1]=*(const __attribute__((address_space(3))) bf16x8*)(kp+j*2048+512); }
__device__ __forceinline__ s16x4 vtr(lds_cptr p){ return __builtin_bit_cast(s16x4,__builtin_amdgcn_ds_read_tr16_b64_v4i16((__attribute__((address_space(3))) v4i16_t*)p)); }
__device__ __forceinline__ float rowmax(const f32x16&p0,const f32x16&p1){
  float a=max3f(p0[0],p0[1],p1[0]),b=max3f(p0[2],p0[3],p1[1]);a=max3f(a,p1[2],p1[3]);
  #pragma unroll
  for(int r=4;r<16;r+=4){a=max3f(a,p0[r],p0[r+1]);b=max3f(b,p0[r+2],p0[r+3]);a=max3f(a,p1[r],p1[r+1]);b=max3f(b,p1[r+2],p1[r+3]);}
  const float m=max2f(a,b);
  auto rr=__builtin_amdgcn_permlane32_swap(__float_as_uint(m),__float_as_uint(m),false,false);
  return max2f(__uint_as_float(rr[0]),__uint_as_float(rr[1]));
}
__device__ __forceinline__ void pv(f32x16*o,int vb,bf16x8 pa0,bf16x8 pa1,bf16x8 pa2,bf16x8 pa3){
  #pragma unroll
  for(int d0=0;d0<2;++d0){s16x4 lo[4],hi[4];
    #pragma unroll
    for(int ks=0;ks<4;++ks){
      asm volatile("ds_read_b64_tr_b16 %0,%1 offset:%c2":"=&v"(lo[ks]):"v"(vb),"i"(d0*4096+ks*1024):"memory");
      asm volatile("ds_read_b64_tr_b16 %0,%1 offset:%c2":"=&v"(hi[ks]):"v"(vb),"i"(d0*4096+ks*1024+512):"memory");}
    asm volatile("s_waitcnt lgkmcnt(0)":::"memory");SBAR();
    #define PK(k) (bf16x8){lo[k][0],lo[k][1],lo[k][2],lo[k][3],hi[k][0],hi[k][1],hi[k][2],hi[k][3]}
    o[d0]=__builtin_amdgcn_mfma_f32_32x32x16_bf16(pa0,PK(0),o[d0],0,0,0);
    o[d0]=__builtin_amdgcn_mfma_f32_32x32x16_bf16(pa1,PK(1),o[d0],0,0,0);
    o[d0]=__builtin_amdgcn_mfma_f32_32x32x16_bf16(pa2,PK(2),o[d0],0,0,0);
    o[d0]=__builtin_amdgcn_mfma_f32_32x32x16_bf16(pa3,PK(3),o[d0],0,0,0);
    #undef PK
  }
}

#ifndef ATTN_STORE16
#define ATTN_STORE16(p,v) (*(u32x4*)(p)=(v))
#endif
template<int THRL> __device__ __forceinline__ void attn_unit(int b,int h,int qb,const bf16*Q,const bf16*__restrict__ K,const bf16*__restrict__ V,const bf16*__restrict__ OG,const float*__restrict__ c2v,bf16*O,char*shm,const int wave_s,const bool stage_c2=true){
  int tid_=wave_s*64+lane_id(); asm volatile("":"+v"(tid_));
  const int tid=tid_,lane=tid&63,r32=lane&31,hi=lane>>5; const int wid=wave_s;
  const long rowbase=(long)b*SEQ; const int q0=qb*QB;
  const bf16*Qw=Q+(rowbase+q0+wid*QBLK)*PITCH+h*D;
  const bf16*Kh=K+(rowbase-2*KVBLK)*PITCH+h*D,*Vh=V+(rowbase-2*KVBLK)*PITCH+h*D;
  const bf16*KhL=K+(long)LEADROW*PITCH+h*D,*VhL=V+(long)LEADROW*PITCH+h*D;
  const unsigned lds0=(unsigned)(uintptr_t)shm;
  float*wsf=(float*)(shm+LDS_WS)+wid*64;
  const bf16*ksrc=Kh+(long)lane*PITCH+wid*8,*ksrcL=KhL+(long)lane*PITCH+wid*8;
  const bf16*vsrc=Vh+(long)(16*(wid&3)+(lane>>2))*PITCH+(wid>>2)*32+(lane&3)*8,*vsrcL=VhL+(long)(16*(wid&3)+(lane>>2))*PITCH+(wid>>2)*32+(lane&3)*8;
  const unsigned kdst=lds0+LDS_K+wid*1024, vdst=lds0+LDS_V+wid*1024;
  #define DMA_K(t,slot) glds16(((t)<2?ksrcL:ksrc)+(long)(t)*KVBLK*PITCH,(unsigned)__builtin_amdgcn_readfirstlane(kdst+(slot)))
  #define DMA_V(t,slot) glds16(((t)<2?vsrcL:vsrc)+(long)(t)*KVBLK*PITCH,(unsigned)__builtin_amdgcn_readfirstlane(vdst+(slot)))
  const int vb0=(int)(lds0+LDS_V)+((lane>>4)&1)*32+(lane&3)*8+(4*hi+((lane&15)>>2))*64;
  const char*Kbase=shm+LDS_K; bf16x8 kf[8];
  const lds_cptr shm3=(lds_cptr)shm; const lds_cptr kp0=shm3+LDS_K+hi*1024+r32*16; const lds_cptr vp0=shm3+LDS_V+((lane>>4)&1)*32+(lane&3)*8+(4*hi+((lane&15)>>2))*64;
  const int NT=(q0+QB)/KVBLK+2;
  if(stage_c2){ __attribute__((address_space(3))) float*negc_w=(__attribute__((address_space(3))) float*)((lds_cptr)shm+LDS_C2); const float*cs=c2v+(long)(b*NHEAD+h)*VK;
    float cv_[5];
    _Pragma("unroll") for(int i_=0;i_<5;++i_){const int i=tid+i_*NW*64; cv_[i_]=i<NT*KVBLK?cs[i]:0.f;}
    _Pragma("unroll") for(int i_=0;i_<5;++i_){const int i=tid+i_*NW*64; if(i<NT*KVBLK)negc_w[i]=-cv_[i_];} }
  const __attribute__((address_space(3))) float* negc3=(const __attribute__((address_space(3))) float*)((lds_cptr)shm+LDS_C2)+4*hi;
  typedef float f32x4_t __attribute__((ext_vector_type(4)));
  #define NEGC(t,i) (*(const __attribute__((address_space(3))) f32x4_t*)(negc3+64*(t)+(((i)>>2)*32)+8*((i)&3)))
  DMA_K(0,0);DMA_V(0,0);DMA_K(1,SLOTB);
  bf16x8 qr[4];
  #pragma unroll
  for(int d0=0;d0<4;++d0)qr[d0]=*reinterpret_cast<const bf16x8*>(&Qw[(long)r32*PITCH+d0*16+hi*8]);
  float mhat=0.f,l_reg=0.f;f32x16 o[2];o[0]=f32x16{};o[1]=f32x16{};
  const int qrel=wid*QBLK+r32;
  #define CMASK(P0,P1,t) do{int jb_=(t)-(NT-4); if(jb_>=0)cmask(P0,P1,jb_,qrel,hi);}while(0)
  bool resc=false;
  #define START(P0,P1) do{ const float rm=rowmax(P0,P1); resc=false; \
    { const float dl=rm; mhat=fadd_s(mhat,dl); \
      _Pragma("unroll") for(int r=0;r<16;++r){P0[r]=fsub_s(P0[r],dl);P1[r]=fsub_s(P1[r],dl);} } \
    _Pragma("unroll") for(int r=0;r<16;++r)P0[r]=__builtin_amdgcn_exp2f(P0[r]); }while(0)
  #define RESC() do{ if(resc){ asm volatile("s_waitcnt lgkmcnt(0)":::"memory"); \
      _Pragma("unroll") for(int d_=0;d_<2;++d_) _Pragma("unroll") for(int r=0;r<16;++r)o[d_][r]*=wsf[crow(r,hi)]; } }while(0)
  f32x16 pA0,pA1,pB0,pB1;
  int sl_prev=0,sl_cur=0,sl_next=SLOTB;
  #define ROT() do{sl_prev=sl_cur;sl_cur=sl_next;sl_next=(sl_next==(NSLOT-1)*SLOTB)?0:sl_next+SLOTB;}while(0)
  DMA_K(2,2*SLOTB);
  WAIT_BAR(3);
  #define FILLT(P0,P1,t) do{ _Pragma("unroll") for(int i_=0;i_<4;++i_){ const f32x4_t a_=NEGC(t,i_),b_=NEGC(t,4+i_); \
      P0[4*i_]=a_[0]-mhat;P0[4*i_+1]=a_[1]-mhat;P0[4*i_+2]=a_[2]-mhat;P0[4*i_+3]=a_[3]-mhat; P1[4*i_]=b_[0]-mhat;P1[4*i_+1]=b_[1]-mhat;P1[4*i_+2]=b_[2]-mhat;P1[4*i_+3]=b_[3]-mhat; } }while(0)
  FILLT(pA0,pA1,0);
  qkt(pA0,pA1,Kbase,qr,r32,hi);asm volatile("s_nop 15\n\ts_nop 7":"+v"(pA0),"+v"(pA1));CMASK(pA0,pA1,0);
  START(pA0,pA1);
  FILLT(pB0,pB1,1);
  _Pragma("unroll") for(int r=0;r<16;++r)pA1[r]=__builtin_amdgcn_exp2f(pA1[r]);
  WAIT_BAR(0);
  DMA_K(3,0);DMA_V(1,SLOTB);
  ROT();
  kload8(kf,kp0+sl_cur);
  WAIT_BAR(2);
  s16x4 vlo[8],vhi[8]; u32x4 pw0,pw1,pw2,pw3;
  #define PKW(P,B) cvtpk_s(P[B],P[B+1])
  #define PAF(k) __builtin_bit_cast(bf16x8,pw##k)
  #define VFR(i) (bf16x8){vlo[i][0],vlo[i][1],vlo[i][2],vlo[i][3],vhi[i][0],vhi[i][1],vhi[i][2],vhi[i][3]}
  #define PIN(x) asm volatile("":"+v"(x))
  #define MX3(a,b,c) __builtin_fmaxf(__builtin_fmaxf((a),(b)),(c))
  #define GAPA(MF,A0,A1,A2,A3,W0,W1,PW) do{ MF; sacc+=A0; sacc+=A1; sacc+=A2; sacc+=A3; PIN(sacc); W0; W1; PIN(PW); SBAR(); }while(0)
  #define EX(v) __builtin_amdgcn_exp2f(v)
  #define GAPB(MF,X,B,FP,FB,I,t,GF) do{ MF; X[B]=EX(X[B]); X[B+1]=EX(X[B+1]); X[B+2]=EX(X[B+2]); X[B+3]=EX(X[B+3]); \
      if(GF){ FP[FB]=fsub_s(cn_[0],mhat); FP[FB+1]=fsub_s(cn_[1],mhat); FP[FB+2]=fsub_s(cn_[2],mhat); FP[FB+3]=fsub_s(cn_[3],mhat); PIN(FP); if((I)<7){cn_=NEGC((t)+1,(I)+1);} } \
      PIN(X); SBAR(); }while(0)
  #define VRD(i) do{ vlo[i]=vtr(vp_+(((i)>>2)*4096+((i)&3)*1024)); vhi[i]=vtr(vp_+(((i)>>2)*4096+((i)&3)*1024+512)); }while(0)
  #define KRD(G,j) do{ if(G){ kload2(kf,kp0+sl_next,j); SBAR(); } }while(0)
  #define STEP(C0,C1,P0,P1,t,GK,GV,GL) do{ SBAR(); \
    const lds_cptr vp_=vp0+sl_prev; \
    VRD(0); SBAR(); float sacc=(P0[0]+P0[1]); \
    GAPA(C0=__builtin_amdgcn_mfma_f32_32x32x16_bf16(kf[0],qr[0],C0,0,0,0), P0[2],P0[3],P0[4],P0[5],     pw0[0]=PKW(P0,0), pw0[1]=PKW(P0,2), pw0); \
    VRD(4); SBAR(); GAPA(C1=__builtin_amdgcn_mfma_f32_32x32x16_bf16(kf[1],qr[0],C1,0,0,0), P0[6],P0[7],P0[8],P0[9],     pw0[2]=PKW(P0,4), pw0[3]=PKW(P0,6), pw0); \
    VRD(1); SBAR(); GAPA(C0=__builtin_amdgcn_mfma_f32_32x32x16_bf16(kf[2],qr[1],C0,0,0,0),   P0[10],P0[11],P0[12],P0[13], pw1[0]=PKW(P0,8), pw1[1]=PKW(P0,10), pw1); \
    VRD(5); SBAR(); GAPA(C1=__builtin_amdgcn_mfma_f32_32x32x16_bf16(kf[3],qr[1],C1,0,0,0),   P0[14],P0[15],P1[0],P1[1],   pw1[2]=PKW(P0,12),pw1[3]=PKW(P0,14), pw1); \
    VRD(2); SBAR(); GAPA(C0=__builtin_amdgcn_mfma_f32_32x32x16_bf16(kf[4],qr[2],C0,0,0,0),   P1[2],P1[3],P1[4],P1[5],     pw2[0]=PKW(P1,0), pw2[1]=PKW(P1,2), pw2); \
    VRD(6); SBAR(); GAPA(C1=__builtin_amdgcn_mfma_f32_32x32x16_bf16(kf[5],qr[2],C1,0,0,0),   P1[6],P1[7],P1[8],P1[9],     pw2[2]=PKW(P1,4), pw2[3]=PKW(P1,6), pw2); \
    VRD(3); SBAR(); GAPA(C0=__builtin_amdgcn_mfma_f32_32x32x16_bf16(kf[6],qr[3],C0,0,0,0),   P1[10],P1[11],P1[12],P1[13], pw3[0]=PKW(P1,8), pw3[1]=PKW(P1,10), pw3); \
    VRD(7); SBAR(); GAPA(C1=__builtin_amdgcn_mfma_f32_32x32x16_bf16(kf[7],qr[3],C1,0,0,0),   P1[14],P1[15],0.f,0.f,       pw3[2]=PKW(P1,12),pw3[3]=PKW(P1,14), pw3); \
    l_reg+=sacc; \
    if(GK){DMA_K((t)+3,sl_cur);} if(GV){DMA_V((t)+1,sl_next);} \
    CMASK(C0,C1,t); \
    { float a=MX3(C0[0],C0[1],C1[0]),b=MX3(C0[2],C0[3],C1[1]); a=MX3(a,C1[2],C1[3]); \
      _Pragma("unroll") for(int r=4;r<16;r+=4){a=MX3(a,C0[r],C0[r+1]);b=MX3(b,C0[r+2],C0[r+3]);a=MX3(a,C1[r],C1[r+1]);b=MX3(b,C1[r+2],C1[r+3]);} \
      float rm=__builtin_fmaxf(a,b); { auto rr=__builtin_amdgcn_permlane32_swap(__float_as_uint(rm),__float_as_uint(rm),false,false); rm=__builtin_fmaxf(__uint_as_float(rr[0]),__uint_as_float(rr[1])); } \
      resc=false; \
      if(__builtin_expect(__any(rm>(float)THRL),0)){ const float dl=__builtin_fmaxf(rm,0.f); mhat+=dl; \
        _Pragma("unroll") for(int r=0;r<16;++r){C0[r]-=dl;C1[r]-=dl;} \
        const float f=__builtin_amdgcn_exp2f(-dl); l_reg*=f; if(hi==0)wsf[r32]=f; resc=true; } } \
    f32x4_t cn_=(f32x4_t){0.f,0.f,0.f,0.f}; if(GL){cn_=NEGC((t)+1,0);} \
    SBAR(); \
    GAPB(o[0]=__builtin_amdgcn_mfma_f32_32x32x16_bf16(PAF(0),VFR(0),o[0],0,0,0), C0,0,P0,0,0,t,GL); \
    GAPB(o[1]=__builtin_amdgcn_mfma_f32_32x32x16_bf16(PAF(0),VFR(4),o[1],0,0,0), C0,4,P0,4,1,t,GL); \
    KRD(GL,0); GAPB(o[0]=__builtin_amdgcn_mfma_f32_32x32x16_bf16(PAF(1),VFR(1),o[0],0,0,0), C0,8,P0,8,2,t,GL); \
    KRD(GL,1); GAPB(o[1]=__builtin_amdgcn_mfma_f32_32x32x16_bf16(PAF(1),VFR(5),o[1],0,0,0), C0,12,P0,12,3,t,GL); \
    KRD(GL,2); GAPB(o[0]=__builtin_amdgcn_mfma_f32_32x32x16_bf16(PAF(2),VFR(2),o[0],0,0,0), C1,0,P1,0,4,t,GL); \
    KRD(GL,3); GAPB(o[1]=__builtin_amdgcn_mfma_f32_32x32x16_bf16(PAF(2),VFR(6),o[1],0,0,0), C1,4,P1,4,5,t,GL); \
    GAPB(o[0]=__builtin_amdgcn_mfma_f32_32x32x16_bf16(PAF(3),VFR(3),o[0],0,0,0), C1,8,P1,8,6,t,GL); \
    GAPB(o[1]=__builtin_amdgcn_mfma_f32_32x32x16_bf16(PAF(3),VFR(7),o[1],0,0,0), C1,12,P1,12,7,t,GL); \
    }while(0)
  int t=1;
  #undef CMASK
  #define CMASK(P0,P1,t) do{}while(0)
  for(;t+5<NT;t+=2){
    STEP(pB0,pB1,pA0,pA1,t,true,true,true);     WAIT_BAR(2); RESC(); ROT();
    STEP(pA0,pA1,pB0,pB1,t+1,true,true,true);   WAIT_BAR(2); RESC(); ROT();
  }
  #undef CMASK
  #define CMASK(P0,P1,t) do{int jb_=(t)-(NT-4); if(jb_>=0)cmask(P0,P1,jb_,qrel,hi);}while(0)
  #define ENDW(tt) do{ if((tt)+3<NT){WAIT_BAR(2);} else if((tt)+2<NT){WAIT_BAR(1);} else {WAIT_BAR(0);} }while(0)
  for(;t+1<NT;t+=2){
    STEP(pB0,pB1,pA0,pA1,t,(t+3<NT),(t+1<NT),(t+1<NT));       ENDW(t);   RESC(); ROT();
    STEP(pA0,pA1,pB0,pB1,t+1,(t+4<NT),(t+2<NT),(t+2<NT));     ENDW(t+1); RESC(); ROT();
  }
  STEP(pB0,pB1,pA0,pA1,NT-1,false,false,false); RESC();
  { float sacc=pB0[0]+pB0[1]; _Pragma("unroll") for(int r=2;r<16;++r)sacc+=pB0[r]; _Pragma("unroll") for(int r=0;r<16;++r)sacc+=pB1[r]; l_reg+=sacc;
    pw0=(u32x4){PKW(pB0,0),PKW(pB0,2),PKW(pB0,4),PKW(pB0,6)};pw1=(u32x4){PKW(pB0,8),PKW(pB0,10),PKW(pB0,12),PKW(pB0,14)};pw2=(u32x4){PKW(pB1,0),PKW(pB1,2),PKW(pB1,4),PKW(pB1,6)};pw3=(u32x4){PKW(pB1,8),PKW(pB1,10),PKW(pB1,12),PKW(pB1,14)};
    SBAR(); pv(o,vb0+sl_cur,PAF(0),PAF(1),PAF(2),PAF(3)); }
  #undef PKW
  #undef PAF
  #undef VFR
  #undef PIN
  #undef MX3
  #undef GAPA
  #undef GAPB
  #undef EX
  #undef VRD
  #undef KRD
  #undef STEP
  #undef ENDW
  {auto rr=__builtin_amdgcn_permlane32_swap(__float_as_uint(l_reg),__float_as_uint(l_reg),false,false);l_reg=__uint_as_float(rr[0])+__uint_as_float(rr[1]);}
  if(hi==0)wsf[32+r32]=l_reg;asm volatile("s_waitcnt lgkmcnt(0)":::"memory");
  float rli[16];
  #pragma unroll
  for(int r=0;r<16;++r)rli[r]=__builtin_amdgcn_rcpf(wsf[32+crow(r,hi)]);
  bf16*Ow=O+(rowbase+q0+wid*QBLK)*OPITCH+h*D; const bf16*Gw=OG+(rowbase+q0+wid*QBLK)*PITCH+h*D;
  u32x4 gg[4];
  #pragma unroll
  for(int i=0;i<4;++i){const int row=i*8+(lane>>3),ch=lane&7; gg[i]=*(const u32x4*)(Gw+(long)row*PITCH+ch*8);}
  { bf16*stg=(bf16*)(shm+LDS_OST)+wid*2048;
    #pragma unroll
    for(int r=0;r<16;++r){const int orow=crow(r,hi);
      #pragma unroll
      for(int d0=0;d0<2;++d0)stg[orow*64+d0*32+r32]=__float2bfloat16(o[d0][r]*rli[r]);}
    asm volatile("s_waitcnt lgkmcnt(0)":::"memory");
    #pragma unroll
    for(int i=0;i<4;++i){const int row=i*8+(lane>>3),ch=lane&7; u32x4 v=*(const u32x4*)(stg+row*64+ch*8);
      #pragma unroll
      for(int w=0;w<4;++w){ const float o0=__uint_as_float(v[w]<<16),o1=__uint_as_float(v[w]&0xffff0000u),g0=__uint_as_float(gg[i][w]<<16),g1=__uint_as_float(gg[i][w]&0xffff0000u);
        v[w]=cvtpk_s(o0*__builtin_amdgcn_rcpf(1.f+__builtin_amdgcn_exp2f(-1.4426950408889634f*g0)),o1*__builtin_amdgcn_rcpf(1.f+__builtin_amdgcn_exp2f(-1.4426950408889634f*g1))); }
      ATTN_STORE16(Ow+(long)row*OPITCH+ch*8,v);} }
  asm volatile("s_waitcnt lgkmcnt(0)\n\ts_barrier":::"memory");
  #undef DMA_K
  #undef NEGC
  #undef FILLT
  #undef DMA_V
  #undef CMASK
  #undef START
  #undef RESC
  #undef ROT
}
constexpr int ATTN_LDS_BYTES=LDS_BYTES;
struct AttnTensors { const bf16* Q; const bf16* K; const bf16* V; const bf16* OG; const float* c2v; bf16* O; };
struct AttnUnit { int bh; int qb; };
struct StaticOrder {
  int vcu, G, blk;
  __device__ __forceinline__ explicit StaticOrder(int grid,int block):vcu((grid%8==0)?(block%8)*(grid/8)+block/8:block),G(grid),blk(block){}
  __device__ __forceinline__ bool next(int i,AttnUnit&u)const{
    if(G==256){ if(blk<64){ if(i>=1)return false; u.bh=blk; u.qb=0; return true; } const int j=blk-64,g=j>>6; u.bh=j&63;
      if(g==0){ if(i>=2)return false; u.qb=i?3:7; } else if(g==1){ if(i>=2)return false; u.qb=i?4:6; } else { if(i>=3)return false; u.qb=i==0?5:3-i; }
      return true; }
    const int pair=vcu+(i>>1)*G; if(pair>=BATCH*NHEAD*4)return false; const int s=pair&3; u.bh=pair>>2; u.qb=(i&1)?s:7-s; return true; }
  __device__ __forceinline__ void a_ready(const AttnUnit&)const{}
  __device__ __forceinline__ void done(const AttnUnit&)const{}
};
template<class Sched,int THRL=8> __device__ __forceinline__ void attn_phase(char*lds,const AttnTensors&T,const Sched&S,const int wave_s){
  AttnUnit u;
  int pbh=-1,pqb=-1;
  for(int i=0;S.next(i,u);++i){ S.a_ready(u); attn_unit<THRL>(u.bh/NHEAD,u.bh%NHEAD,u.qb,T.Q,T.K,T.V,T.OG,T.c2v,T.O,lds,wave_s,!(u.bh==pbh&&u.qb<=pqb)); if(u.bh!=pbh||u.qb>pqb){pbh=u.bh;pqb=u.qb;} S.done(u); }
}
#undef SBAR
#undef WAIT_BAR
}
#define GAS __attribute__((address_space(1)))
#define LAS __attribute__((address_space(3)))
typedef unsigned short bf16;
typedef unsigned v4u __attribute__((ext_vector_type(4)));
typedef float f32x4 __attribute__((ext_vector_type(4)));
typedef short bf16x8 __attribute__((ext_vector_type(8)));
typedef GAS unsigned gu32;
typedef GAS unsigned long long gu64;
#define RLX_AGENT __ATOMIC_RELAXED, __HIP_MEMORY_SCOPE_AGENT
#define LDS_WAIT() asm volatile("s_waitcnt lgkmcnt(0)" ::: "memory")
#define VM_WAIT() asm volatile("s_waitcnt vmcnt(0)" ::: "memory")
#define XB_TMO      128
#define XB_XCNT(j)  (256  + 64 * (j))
#define XB_XSUB(j)  (1280 + 64 * (j))
#define XB_XGEN(j)  (2304 + 64 * (j))
#define XB_TOP      3328
#define XB_TOPGEN   3392
#define XCD_BAR_WORDS 3456
#define XB_SPIN_CAP (1u << 18)

__device__ __forceinline__ unsigned xb_ld(unsigned* p)              { return __hip_atomic_load(p, __ATOMIC_RELAXED, __HIP_MEMORY_SCOPE_AGENT); }
__device__ __forceinline__ unsigned xb_add(unsigned* p, unsigned v) { return __hip_atomic_fetch_add(p, v, __ATOMIC_RELAXED, __HIP_MEMORY_SCOPE_AGENT); }
__device__ __forceinline__ unsigned xb_xcc_id() { return (unsigned)__builtin_amdgcn_s_getreg((3 << 11) | 20) & 0xFu; }
#define XB_SPIN(cond, bar) do { unsigned _sp = 0; while (cond) { __builtin_amdgcn_s_sleep(1); \
    if ((++_sp & 255u) == 0u) { if (xb_ld(&(bar)[XB_TMO])) break; if (_sp > XB_SPIN_CAP) { atomicAdd(&(bar)[XB_TMO], 1u); break; } } } } while (0)

struct XcdBarrier {
    unsigned* bar; unsigned x;
    volatile LAS unsigned* st;
};

__device__ __forceinline__ XcdBarrier xcd_barrier_post(unsigned* bar, volatile LAS unsigned* st) {
    XcdBarrier b; b.bar = bar; b.x = xb_xcc_id(); b.st = st;
    if (threadIdx.x == 0) (void)xb_add(&bar[XB_XCNT(b.x)], 1u);
    return b;
}
__device__ __forceinline__ void xcd_barrier_complete(unsigned* bar, unsigned x, unsigned& nloc, unsigned& nx) {
    const unsigned G = gridDim.x * gridDim.y * gridDim.z;
    unsigned sum, cnt, mine, sp = 0u;
    for (;;) {
        sum = 0u; cnt = 0u; mine = 0u;
#pragma unroll
        for (unsigned j = 0; j < 16; ++j) { const unsigned c = xb_ld(&bar[XB_XCNT(j)]); sum += c; cnt += (c > 0u) ? 1u : 0u; mine = (j == x) ? c : mine; }
        if (sum == G) break;
        __builtin_amdgcn_s_sleep(1);
        if ((++sp & 255u) == 0u) { if (xb_ld(&bar[XB_TMO])) break; if (sp > XB_SPIN_CAP) { atomicAdd(&bar[XB_TMO], 1u); break; } }
    }
    nloc = mine > 0u ? mine : 1u; nx = cnt > 0u ? cnt : 1u;
}

__device__ __forceinline__ void xcd_barrier(const XcdBarrier& b, const int wave_s) {
    asm volatile("s_waitcnt vmcnt(0)" ::: "memory");
    __syncthreads();
    if (wave_s == 0 && lane_id() == 0) {
        int z0_ = 0; asm volatile("" : "+s"(z0_));
        unsigned* bar = b.bar + z0_;
        __builtin_amdgcn_s_waitcnt(0);
        unsigned nloc = b.st[0], nx = b.st[1];
        if (nloc == 0u) { xcd_barrier_complete(bar, b.x, nloc, nx); b.st[0] = nloc; b.st[1] = nx; }
        const unsigned old = xb_add(&bar[XB_XSUB(b.x)], 1u);
        const unsigned gen = old / nloc;
        if (old + 1u == (gen + 1u) * nloc) {
            __builtin_amdgcn_fence(__ATOMIC_RELEASE, "agent");
            asm volatile("s_waitcnt vmcnt(0)" ::: "memory");
            const unsigned og = xb_add(&bar[XB_TOP], 1u);
            const unsigned tg = og / nx;
            if (og + 1u == (tg + 1u) * nx) xb_add(&bar[XB_TOPGEN], 1u);
            else XB_SPIN(xb_ld(&bar[XB_TOPGEN]) == tg, bar);
            __builtin_amdgcn_fence(__ATOMIC_ACQUIRE, "agent");
            xb_add(&bar[XB_XGEN(b.x)], 1u);
            asm volatile("s_waitcnt vmcnt(0)" ::: "memory");
        } else {
            XB_SPIN(xb_ld(&bar[XB_XGEN(b.x)]) == gen, bar);
            __builtin_amdgcn_fence(__ATOMIC_ACQUIRE, "agent");
            asm volatile("s_waitcnt vmcnt(0)" ::: "memory");
        }
    }
    __syncthreads();
}

constexpr int NWAVES = 8;
constexpr int RING_BYTES = 131072;
constexpr int LDS_BYTES = 163840;
constexpr int LDSCTL_OFF = LDS_BYTES - 1024, MISC_OFF = LDSCTL_OFF + 320;
constexpr int HALO_OFF = RING_BYTES;
constexpr int RSTD_OFF = HALO_OFF + 8192;
static_assert(RSTD_OFF + 6 * 1024 + 4096 <= LDSCTL_OFF, "LDS map");
constexpr int CW_BAR = 4096;

struct Args { const float* in[24]; float* out; unsigned char* ws; };

template <bool AF32, class F>
__device__ __forceinline__ void meta_gemm(const void* A, int lda, const bf16_t* Wt, int N, int K, int bid, int G, int wave, int lane, float* red, const F& f) {
    const int fr = lane & 15, fq = lane >> 4, kw = K / NWAVES;
    for (int cb = bid; cb < N / 16; cb += G) {
        f32x4 acc = (f32x4){0.f, 0.f, 0.f, 0.f}; float ss = 0.f;
        const bf16_t* bp = Wt + (size_t)(cb * 16 + fr) * K + wave * kw + 8 * fq;
#pragma unroll
        for (int k = 0; k < kw; k += 32) {
            bf16x8 a;
            if (AF32) {
                const float* ap = (const float*)A + (size_t)fr * lda + wave * kw + k + 8 * fq;
                const f32x4 a0 = *(const f32x4*)ap, a1 = *(const f32x4*)(ap + 4);
                ss += ((a0.x * a0.x + a0.y * a0.y) + (a0.z * a0.z + a0.w * a0.w)) + ((a1.x * a1.x + a1.y * a1.y) + (a1.z * a1.z + a1.w * a1.w));
                u32x4 w; w.x = pk2bf(a0.x, a0.y); w.y = pk2bf(a0.z, a0.w); w.z = pk2bf(a1.x, a1.y); w.w = pk2bf(a1.z, a1.w);
                a = __builtin_bit_cast(bf16x8, w);
            } else a = *(const bf16x8*)((const bf16_t*)A + (size_t)fr * lda + wave * kw + k + 8 * fq);
            const bf16x8 b = *(const bf16x8*)(bp + k);
            acc = __builtin_amdgcn_mfma_f32_16x16x32_bf16(a, b, acc, 0, 0, 0);
        }
        float* rw = red + (wave * 64 + lane) * 5;
        rw[0] = acc[0]; rw[1] = acc[1]; rw[2] = acc[2]; rw[3] = acc[3]; rw[4] = ss;
        __syncthreads();
        if (wave == 0) {
            f32x4 t = (f32x4){0.f, 0.f, 0.f, 0.f}; float s2 = 0.f;
#pragma unroll
            for (int w = 0; w < NWAVES; ++w) { const float* r_ = red + (w * 64 + lane) * 5; t[0] += r_[0]; t[1] += r_[1]; t[2] += r_[2]; t[3] += r_[3]; s2 += r_[4]; }
            float rstd = 1.f;
            if (AF32) { s2 = add_xor16(s2); s2 = add_xor32(s2); rstd = 1.0f / sqrtf(s2 * (1.f / DM) + 1e-6f); }
#pragma unroll
            for (int r = 0; r < 4; ++r) { const int row = 4 * fq + r; const float rs = AF32 ? __int_as_float(__builtin_amdgcn_ds_bpermute(row << 2, __float_as_int(rstd))) : 1.f; f(row, cb * 16 + fr, t[r] * rs); }
        }
        __syncthreads();
    }
}
struct MEpi1 { bf16_t* p; float* pn;
    __device__ __forceinline__ void operator()(int r, int col, float v) const {
        const int row = MROWS + r; const int g = col >> 9, c_ = col & 255;
        if (g < 7) p[(size_t)row * PBW + (col & ~255) + ((c_ >> 5) & 3) * 64 + (c_ >> 7) * 32 + PERM32(c_ & 31)] = f2bf(v);
        else { const int o = col & 511; if (o < 296) pn[(size_t)row * PNW + o] = v; } } };
struct MEpiRes { float* hm; __device__ __forceinline__ void operator()(int r, int col, float v) const { float* h = hm + r * DM + (col & ~31) + PERM32(col & 31); *h = *h + v; } };
struct MEpi3 { float* rawm;
    __device__ __forceinline__ void operator()(int r, int col, float v) const { const int t = col >> 8, c = col & 255; rawm[(size_t)r * DFF2 + (c < 128 ? 128 * t + c : DFF + 128 * t + (c - 128))] = v; } };

__device__ __forceinline__ void meta_gemm3(const float* hm, const bf16_t* W3, int bid, int G, int wave, int lane, int tid, float* red, float* rug, const float* cw, const float* cb, float* rawm, bf16_t* am) {
    const int fr = lane & 15, fq = lane >> 4; constexpr int kw = DM / NWAVES;
    for (int pr = bid; pr < DFF / 16; pr += G) {
        const int t = pr >> 3, kk = pr & 7, cbu = 16 * t + kk;
        f32x4 au = (f32x4){0.f, 0.f, 0.f, 0.f}, ag = au; float ss = 0.f;
        const bf16_t* bpu = W3 + (size_t)(cbu * 16 + fr) * DM + wave * kw + 8 * fq; const bf16_t* bpg = bpu + (size_t)128 * DM;
#pragma unroll
        for (int k = 0; k < kw; k += 32) {
            const float* ap = hm + (size_t)fr * DM + wave * kw + k + 8 * fq;
            const f32x4 a0 = *(const f32x4*)ap, a1 = *(const f32x4*)(ap + 4);
            ss += ((a0.x * a0.x + a0.y * a0.y) + (a0.z * a0.z + a0.w * a0.w)) + ((a1.x * a1.x + a1.y * a1.y) + (a1.z * a1.z + a1.w * a1.w));
            u32x4 w; w.x = pk2bf(a0.x, a0.y); w.y = pk2bf(a0.z, a0.w); w.z = pk2bf(a1.x, a1.y); w.w = pk2bf(a1.z, a1.w);
            const bf16x8 a = __builtin_bit_cast(bf16x8, w);
            au = __builtin_amdgcn_mfma_f32_16x16x32_bf16(a, *(const bf16x8*)(bpu + k), au, 0, 0, 0);
            ag = __builtin_amdgcn_mfma_f32_16x16x32_bf16(a, *(const bf16x8*)(bpg + k), ag, 0, 0, 0);
        }
        float* rw = red + (wave * 64 + lane) * 9;
        rw[0] = au[0]; rw[1] = au[1]; rw[2] = au[2]; rw[3] = au[3]; rw[4] = ag[0]; rw[5] = ag[1]; rw[6] = ag[2]; rw[7] = ag[3]; rw[8] = ss;
        __syncthreads();
        if (wave == 0) {
            f32x4 tu = (f32x4){0.f, 0.f, 0.f, 0.f}, tg = tu; float s2 = 0.f;
#pragma unroll
            for (int w = 0; w < NWAVES; ++w) { const float* r_ = red + (w * 64 + lane) * 9; tu[0] += r_[0]; tu[1] += r_[1]; tu[2] += r_[2]; tu[3] += r_[3]; tg[0] += r_[4]; tg[1] += r_[5]; tg[2] += r_[6]; tg[3] += r_[7]; s2 += r_[8]; }
            s2 = add_xor16(s2); s2 = add_xor32(s2); const float rstd = 1.0f / sqrtf(s2 * (1.f / DM) + 1e-6f);
#pragma unroll
            for (int r = 0; r < 4; ++r) { const int row = 4 * fq + r; const float rs = __int_as_float(__builtin_amdgcn_ds_bpermute(row << 2, __float_as_int(rstd)));
                const float vu = tu[r] * rs, vg = tg[r] * rs; rug[row * 16 + fr] = vu; rug[256 + row * 16 + fr] = vg;
                if (row >= 14) { rawm[(size_t)row * DFF2 + 128 * t + 16 * kk + fr] = vu; rawm[(size_t)row * DFF2 + DFF + 128 * t + 16 * kk + fr] = vg; } }
        }
        __syncthreads();
        if (tid < 256) {
            const int row = tid >> 4, j = tid & 15, ch = 128 * t + 16 * kk + j;
            const float xu0 = rug[row * 16 + j], xu1 = row >= 1 ? rug[(row - 1) * 16 + j] : 0.f, xu2 = row >= 2 ? rug[(row - 2) * 16 + j] : 0.f;
            const float xg0 = rug[256 + row * 16 + j], xg1 = row >= 1 ? rug[256 + (row - 1) * 16 + j] : 0.f, xg2 = row >= 2 ? rug[256 + (row - 2) * 16 + j] : 0.f;
            const float cu = cb[ch] + cw[ch] * xu2 + cw[DFF2 + ch] * xu1 + cw[2 * DFF2 + ch] * xu0;
            const float cg = cb[DFF + ch] + cw[DFF + ch] * xg2 + cw[DFF2 + DFF + ch] * xg1 + cw[2 * DFF2 + DFF + ch] * xg0;
            am[(size_t)row * DFF + ch] = f2bf(cg * sigmoidf_(cg) * cu);
        }
        __syncthreads();
    }
}

__device__ __forceinline__ void wprep_layer(const float* const* in, int l, unsigned char* ws, int gw, int ngw, int lane, float* scr, int part) {
    unsigned char* wb = ws + WS_W + (size_t)(l & 1) * WL_BYTES;
    constexpr int I1 = (DM / 64) * (N1 / 32), I2 = (DM / 64) * (DM / 32), I3 = (DM / 64) * (DFF2 / 32), I4 = (DFF / 64) * (DM / 32);
    const int n1 = (part & 1) ? I1 : 0, n2 = (part & 2) ? I2 : 0, n3 = (part & 4) ? I3 : 0, n4 = (part & 8) ? I4 : 0;
    for (int it = gw; it < n1 + n2 + n3 + n4; it += ngw) {
        int r = it, mode = 1, K = DM, Nsrc = N_IN, Ndst = N1; const float* W = in[3] + (size_t)l * DM * N_IN; const float* gk = in[2] + l * DM; bf16_t* WT = (bf16_t*)(wb + WO_W1);
        if (r >= n1) { r -= n1; mode = 2; Nsrc = DM; Ndst = DM; W = in[18] + (size_t)l * DM * DM; gk = nullptr; WT = (bf16_t*)(wb + WO_W2);
            if (r >= n2) { r -= n2; mode = 3; Nsrc = DFF2; Ndst = DFF2; W = in[20] + (size_t)l * DM * DFF2; gk = in[19] + l * DM; WT = (bf16_t*)(wb + WO_W3);
                if (r >= n3) { r -= n3; mode = 4; K = DFF; Nsrc = DM; Ndst = DM; W = in[23] + (size_t)l * DFF * DM; gk = nullptr; WT = (bf16_t*)(wb + WO_W4); } } }
        wprep_item(W, gk, WT, K, Nsrc, Ndst, mode, r, scr, lane);
    }
    if (part & 1) {
        bf16_t* lup = (bf16_t*)(wb + WO_LUP);
        const float* wu = in[6] + (size_t)l * 64 * 512; const float* au = in[8] + (size_t)l * 64 * 512; const float* gu = in[9] + (size_t)l * 160 * 512;
        for (int n = gw; n < 512; n += ngw) {
#pragma unroll
            for (int kq = 0; kq < 5; ++kq) { const int k = lane + 64 * kq;
                if (k < 288) lup[n * 288 + k] = f2bf(k < 64 ? wu[k * 512 + n] : (k < 128 ? au[(k - 64) * 512 + n] : gu[(k - 128) * 512 + n])); }
        }
    }
}

struct RwP { const float* mu; const float* w0; const float* w_up; const float* a0; const float* a_up; const float* g_up; };
struct RwS { const float* mu; const float* k_k; const float* k_a; const float* r_k; const float* gn_w; const float* gn_b; };
constexpr int RCH = 8;

__global__ void __launch_bounds__(NWAVES * 64, 2) mk_fwd(Args a) {
    extern __shared__ __attribute__((aligned(16))) unsigned char lds[];
    const int tid0 = threadIdx.x, wave_s = __builtin_amdgcn_readfirstlane(tid0 >> 6);
    const int G0 = gridDim.x, bid0 = blockIdx.x;
    for (int u = tid0; u < (LDS_BYTES - LDSCTL_OFF) / 4; u += NWAVES * 64) ((LAS unsigned*)((LAS unsigned char*)lds + LDSCTL_OFF))[u] = 0u;
    __syncthreads();
    XcdBarrier bar = xcd_barrier_post((unsigned*)(a.ws + WS_CTL) + CW_BAR, (volatile LAS unsigned*)((LAS unsigned char*)lds + MISC_OFF) + 8);
#ifdef TPROBE
#define TP_MARK(ph) do { if ((ph) >= 20 && TPROBE < 20) break;     \
        const unsigned t_ = (unsigned)__builtin_amdgcn_s_memrealtime(); if (wave_s == 0 && lane_id() == 0) { volatile LAS unsigned* q_ = (volatile LAS unsigned*)((LAS unsigned char*)lds + LDSCTL_OFF + 512); \
        if ((ph) == TPROBE) q_[1] += t_ - q_[0]; q_[0] = t_; } } while (0)
#else
#define TP_MARK(ph) do {} while (0)
#endif
#define GRID_BAR() do { int wv_ = wave_s; asm volatile("" : "+s"(wv_)); xcd_barrier(bar, wv_); } while (0)
#define RSTD_TABLE(S) do { pg8::Unit u_; for (int i_ = 0; S.next(i_, u_); ++i_) for (int r_ = tid; r_ < 256; r_ += NWAVES * 64) \
        ((LAS float*)(ldsl + RSTD_OFF))[i_ * 256 + r_] = pg8::row_rstd(ssqp, u_.pm * 256 + r_); __syncthreads(); } while (0)
    TP_MARK(-1);
#define PHASE_IDS() int G_ = G0, bid_ = bid0, wv_ = wave_s; asm volatile("" : "+s"(G_), "+s"(bid_), "+s"(wv_)); int tid = wv_ * 64 + lane_id(); asm volatile("" : "+v"(tid)); \
    const int G = G_, bid = bid_, ngw = G * NWAVES, lane = tid & 63, wave = wv_, gw = bid * NWAVES + wave; (void)lane; (void)gw; (void)ngw
#define PHASE_PTRS(L) int z0_ = 0; asm volatile("" : "+s"(z0_)); const float* const* inq = a.in + z0_; unsigned char* ws = a.ws + z0_; float* out = a.out + z0_; const int lq = (L) + z0_; \
    float* hm = (float*)(ws + WS_HM); float* c2 = (float*)(ws + WS_C2); float* ssqp = (float*)(ws + WS_SSQ); \
    bf16_t* hb = (bf16_t*)(ws + WS_HB); bf16_t* p = (bf16_t*)(ws + WS_P); float* pn = (float*)(ws + WS_PN); bf16_t* y = (bf16_t*)(ws + WS_Y); \
    bf16_t* act = (bf16_t*)(ws + WS_ACT); float* fixb = (float*)(ws + WS_FIX); float* rawm = (float*)(ws + WS_RAWM); \
    const unsigned char* wbuf = ws + WS_W + (size_t)(lq & 1) * WL_BYTES; \
    const bf16_t* W1 = (const bf16_t*)(wbuf + WO_W1); const bf16_t* W2 = (const bf16_t*)(wbuf + WO_W2); const bf16_t* W3 = (const bf16_t*)(wbuf + WO_W3); const bf16_t* W4 = (const bf16_t*)(wbuf + WO_W4); \
    (void)hm; (void)c2; (void)ssqp; (void)hb; (void)p; (void)pn; (void)y; (void)act; (void)fixb; (void)rawm; (void)out; (void)W1; (void)W2; (void)W3; (void)W4
    LAS unsigned char* ldsl = (LAS unsigned char*)lds;

    {
        PHASE_IDS(); PHASE_PTRS(0);
        for (int row = gw; row < RROWS; row += ngw) {
            const f32x4* xr = (const f32x4*)(row < MROWS ? inq[0] + (size_t)row * DM : inq[1] + (size_t)(row - MROWS) * DM) + lane;
            f32x4* hr = (f32x4*)(hm + (size_t)(row < MROWS ? 0 : row - MROWS) * DM) + lane;
            f32x4 v[4]; float s = 0.f;
#pragma unroll
            for (int j = 0; j < 4; ++j) { v[j] = xr[64 * j]; if (row >= MROWS) hr[64 * j] = v[j]; s += (v[j].x * v[j].x + v[j].y * v[j].y) + (v[j].z * v[j].z + v[j].w * v[j].w); }
            s = wave_sum(s);
            if (lane < 16) ssqp[(size_t)row * 16 + lane] = lane == 0 ? s : 0.f;
            u32x2* o8 = (u32x2*)(hb + (size_t)row * DM) + lane;
#pragma unroll
            for (int j = 0; j < 4; ++j) { u32x2 w; w.x = pk2bf(v[j].x, v[j].y); w.y = pk2bf(v[j].z, v[j].w); o8[64 * j] = w; }
        }
    }
    {
        PHASE_IDS(); PHASE_PTRS(0);
        u32x4* z = (u32x4*)(p + (size_t)RROWS * PBW); const unsigned n16 = (unsigned)((16512 - RROWS) * PBW * 2 / 16);
        for (unsigned i = (unsigned)(bid * (NWAVES * 64) + tid); i < n16; i += (unsigned)(G * (NWAVES * 64))) z[i] = (u32x4){0u, 0u, 0u, 0u};
    }
#ifndef PLAIN_LAUNCH
    cg::this_grid().sync();
#endif
    TP_MARK(0);

#pragma unroll 1
    for (int l = -1; l < DEPTH; ++l) {
#pragma unroll 1
      for (int ph = l < 0 ? 1 : 0; ph < (l < 0 ? 2 : 6); ++ph) {
#ifdef TPROBE
        if (wave_s == 0 && lane_id() == 0) ((volatile LAS unsigned*)((LAS unsigned char*)lds + LDSCTL_OFF + 512))[2] = (unsigned)ph;
#endif
        if (ph == 1 || ph == 4)
        {
            PHASE_IDS(); PHASE_PTRS(l);
            if (lq + 1 < DEPTH) {
                const int first = (G == 256 && lq >= 0) ? (ph == 4 ? 128 : 8) : 0, part = lq < 0 ? 15 : (G == 256 ? (ph == 4 ? 6 : 9) : (ph == 4 ? 0 : 15));
                if (bid >= first && part) wprep_layer(inq, lq + 1, ws, gw - first * NWAVES, ngw - first * NWAVES, lane, (float*)(lds + wave * 16384), part);
            }
            __syncthreads();
        }
        if (ph == 0) {
        {
            PHASE_IDS(); PHASE_PTRS(l);
            pg8::Gemm g{hb, W1, MROWS, N1, DM}; pg8::StaticOrder S; S.init(MROWS, N1, G, bid);
            RSTD_TABLE(S);
            pg8::Epi1 E{(const LAS float*)(ldsl + RSTD_OFF), p, pn, inq[16] + lq * 64, inq[17] + lq * 64};
            pg8::gemm_phase<pg8::Epi1, pg8::StaticOrder, true, true>(ldsl, g, S, E, wave);
            meta_gemm<true>(hm, DM, W1, N1, DM, bid, G, wave, lane, (float*)lds, MEpi1{p, pn});
        }
        } else if (ph == 4) {
        {
            PHASE_IDS(); PHASE_PTRS(l);
            const float* cw = inq[21] + (size_t)lq * 3 * DFF2; const float* cb = inq[22] + (size_t)lq * DFF2;
            pg8::Gemm g{hb, W3, MROWS, DFF2, DM}; pg8::StaticOrder S; S.init(MROWS, DFF2, G, bid);
            RSTD_TABLE(S);
            pg8::EpiConv E{(const LAS float*)(ldsl + RSTD_OFF), cw, cb, act, fixb, ldsl + HALO_OFF, (LAS float*)(ldsl + RSTD_OFF + 6 * 1024)};
            pg8::gemm_phase<pg8::EpiConv, pg8::StaticOrder, true, true>(ldsl, g, S, E, wave);
            meta_gemm3(hm, W3, bid, G, wave, lane, tid, (float*)lds, (float*)(lds + 20480), cw, cb, rawm, act + (size_t)MROWS * DFF);
        }
        }
        if (ph == 1 && l >= 0) {
        {
            PHASE_IDS(); PHASE_PTRS(l);
            __syncthreads(); TP_MARK(20);
            {
                const float* mu = inq[4] + lq * 1824;
                const bf16_t* lup = (const bf16_t*)(wbuf + WO_LUP);
                const int h = wave, cg = h * 64 + lane, fr = lane & 15, fq = lane >> 4;
                const float mu_r = mu[cg], mu_k = mu[512 + cg], mu_v = mu[1024 + cg];
                const float w0c = (inq[5] + lq * 512)[cg], a0c = (inq[7] + lq * 512)[cg];
                const float kkc = (inq[10] + lq * 512)[cg], kac = (inq[11] + lq * 512)[cg], rkc = (inq[12] + lq * 512)[cg];
                LAS unsigned char* PNS = ldsl;
                LAS unsigned char* PSW = ldsl + 22528 + wave * 6528;
                LAS unsigned char* LW = ldsl + 74752 + wave * 9216;
                LAS unsigned char* LIN = ldsl + 148480;
                LAS float* MU = (LAS float*)(ldsl + 158720);
                LAS float* TR = (LAS float*)LW; LAS float* LT = (LAS float*)LW; LAS float* LAK = (LAS float*)(LW + 1280);
#define PN_DMA(uu) do { const int c_ = (uu) % NCH, r0_ = rowof((uu) / NCH, 16 * c_), p0_ = prevrow(r0_); \
                    for (int pc_ = wave; pc_ < (p0_ >= 0 ? 22 : 20); pc_ += NWAVES) { \
                        const char* src_ = (pc_ < 20 ? (const char*)(pn + (size_t)r0_ * PNW) + pc_ * 1024 : (const char*)(pn + (size_t)p0_ * PNW) + (pc_ - 20) * 1024) + lane * 16; \
                        __builtin_amdgcn_global_load_lds((const unsigned*)src_, (LAS unsigned*)(PNS + pc_ * 1024), 16, 0, 0); } } while (0)
#define PS_DMA(uu) do { const int c_ = (uu) % NCH, r0_ = rowof((uu) / NCH, 16 * c_), p0_ = prevrow(r0_); int ln_ = lane; asm volatile("" : "+v"(ln_));     \
                    _Pragma("unroll") for (int j_ = 0; j_ < 7; ++j_) { const int s_ = j_ * 8 + (ln_ >> 3); \
                        if (s_ < 51) { const int i_ = s_ / 3, sg_ = s_ - 3 * i_, rw_ = i_ ? r0_ + i_ - 1 : (p0_ >= 0 ? p0_ : r0_); \
                            const char* src_ = (const char*)(p + (size_t)rw_ * PBW) + sg_ * 1024 + wave * 128 + (ln_ & 7) * 16; \
                            __builtin_amdgcn_global_load_lds((const unsigned*)src_, (LAS unsigned*)(PSW + j_ * 1024), 16, 0, 0); } } } while (0)
#define PSV(i, sg) bf2f(((const LAS bf16_t*)PSW)[(3 * (i) + (sg)) * 64 + lane])
                if (tid < 288) MU[tid] = mu[1536 + tid];
                if (bid < NB * NCH) { PN_DMA(bid); PS_DMA(bid); }
                asm volatile("s_waitcnt vmcnt(0)" ::: "memory");
                bf16x8 bw_[2][4], ba_[2][4];
                {   const int fru = lane & 15, fqu = lane >> 4;
#pragma unroll
                    for (int nb = 0; nb < 4; ++nb) { const bf16_t* bp_ = lup + (size_t)(h * 64 + 16 * nb + fru) * 288 + 8 * fqu;
#pragma unroll
                        for (int ks = 0; ks < 2; ++ks) { bw_[ks][nb] = *(const bf16x8*)(bp_ + 32 * ks); ba_[ks][nb] = *(const bf16x8*)(bp_ + 64 + 32 * ks); }
                    } }
                for (int u = bid; u < NB * NCH; u += G) {
                    const int b = u / NCH, c = u % NCH, row0 = rowof(b, 16 * c), prow0 = prevrow(row0);
                    int tidu = tid; asm volatile("" : "+v"(tidu));
                    const int fr = tidu & 15, fq = (tidu >> 4) & 3;
                    bf16x8 bg_[5][4];
                    TP_MARK(27);
                    asm volatile("s_waitcnt lgkmcnt(0)\n\ts_barrier" ::: "memory");
                    {
                        float cur_[9], prv_[9], mu_[9];
#pragma unroll
                        for (int i = 0; i < 9; ++i) { const int e = tidu + 512 * i, ti = e / 288, j = e - 288 * ti;
                            cur_[i] = ((const LAS float*)PNS)[ti * 320 + j]; prv_[i] = ((const LAS float*)PNS)[(ti ? ti - 1 : 16) * 320 + j]; mu_[i] = MU[j]; }
#pragma unroll
                        for (int i = 0; i < 9; ++i) { const int e = tidu + 512 * i, ti = e / 288, j = e - 288 * ti;
                            const float prv = (ti || prow0 >= 0) ? prv_[i] : 0.f, s = cur_[i] + mu_[i] * (prv - cur_[i]);
                            const float ex = __builtin_amdgcn_exp2f((j < 64 ? 2.f * LOG2E : -LOG2E) * s), rc = __builtin_amdgcn_rcpf(1.f + ex);
                            ((LAS bf16_t*)LIN)[ti * 296 + j] = f2bf(j < 64 ? 1.f - 2.f * rc : (j < 128 ? s : rc)); }
                    }
                    {   const int fru = fr, fqu = fq;
#pragma unroll
                        for (int nb = 0; nb < 4; ++nb) { const bf16_t* bp_ = lup + (size_t)(h * 64 + 16 * nb + fru) * 288 + 8 * fqu;
#pragma unroll
                            for (int ks = 0; ks < 5; ++ks) bg_[ks][nb] = *(const bf16x8*)(bp_ + 128 + 32 * ks); } }
                    TP_MARK(28);
                    asm volatile("s_waitcnt lgkmcnt(0)\n\ts_barrier" ::: "memory");
                    if (u + G < NB * NCH) PN_DMA(u + G);
                    TP_MARK(22);
#define LORA_PRE(ZA, KB0, NKS, BF) do { f32x4 acc_[4]; _Pragma("unroll") for (int nb = 0; nb < 4; ++nb) acc_[nb] = (f32x4){0.f, 0.f, 0.f, 0.f}; \
                        _Pragma("unroll") for (int ks = 0; ks < (NKS); ++ks) { const bf16x8 af = *(const LAS bf16x8*)(LIN + fr * 592 + ((KB0) + 32 * ks + 8 * fq) * 2); \
                            _Pragma("unroll") for (int nb = 0; nb < 4; ++nb) acc_[nb] = __builtin_amdgcn_mfma_f32_16x16x32_bf16(af, BF[ks][nb], acc_[nb], 0, 0, 0); } \
                        WAVE_LDS_SYNC(); \
                        _Pragma("unroll") for (int nb = 0; nb < 4; ++nb) _Pragma("unroll") for (int r = 0; r < 4; ++r) TR[(4 * fq + r) * 65 + 16 * nb + fr] = acc_[nb][r]; \
                        WAVE_LDS_SYNC(); \
                        _Pragma("unroll") for (int i = 0; i < 16; ++i) ZA[i] = TR[i * 65 + lane]; } while (0)
                    float zw[16], za[16];
                    LORA_PRE(zw, 0, 2, bw_); LORA_PRE(za, 64, 2, ba_);
                    {
                        float zg[16]; LORA_PRE(zg, 128, 5, bg_); (void)zg;
                        asm volatile("s_waitcnt vmcnt(0)" ::: "memory");
                        {
                            const int ti_ = lane >> 2, pt_ = lane & 3; float gv_[16];
#pragma unroll
                            for (int k_ = 0; k_ < 16; ++k_) gv_[k_] = TR[ti_ * 65 + 16 * pt_ + k_];
                            u32x4 o0_, o1_;
                            o0_.x = pk2bf(gv_[0], gv_[1]); o0_.y = pk2bf(gv_[2], gv_[3]); o0_.z = pk2bf(gv_[4], gv_[5]); o0_.w = pk2bf(gv_[6], gv_[7]);
                            o1_.x = pk2bf(gv_[8], gv_[9]); o1_.y = pk2bf(gv_[10], gv_[11]); o1_.z = pk2bf(gv_[12], gv_[13]); o1_.w = pk2bf(gv_[14], gv_[15]);
                            bf16_t* yp_ = y + (size_t)(row0 + ti_) * DM + h * 64 + 16 * pt_;
                            *(u32x4*)yp_ = o0_; *(u32x4*)(yp_ + 8) = o1_; } }
#undef LORA_PRE
                    WAVE_LDS_SYNC();
                    const int ci = (b * 8 + h) * NCH + c;
                    unsigned char* ra = ws + WS_RA + (size_t)ci * RA_BYTES; unsigned char* rb = (unsigned char*)out + (size_t)ci * RB_BYTES;
                    bf16_t* BV = (bf16_t*)(ws + WS_BV);
                    LAS bf16_t* OA = (LAS bf16_t*)LW; LAS bf16_t* OB = OA + 16 * 72; LAS bf16_t* OK = OB + 16 * 72; LAS bf16_t* OR = OK + 16 * 72;
                    const int cxk = (lane >> 5) * 4 + ((lane >> 2) & 3), jk2 = (((lane >> 4) & 1) * 4 + (lane & 3)) * 2;
                    TP_MARK(23);
                    float atil[16]; unsigned bkB[8], bkK[8], vtp[8];
                    float cumC = 0.f;
#pragma unroll
                    for (int i = 0; i < 16; ++i) { zw[i] = 0.6065306597126334f * __builtin_amdgcn_rcpf(1.f + __builtin_amdgcn_exp2f(-LOG2E * (zw[i] + w0c))); cumC += zw[i]; }
                    float cum = 0.f, gprev = 1.f, rp = 0.f, kp_ = 0.f, vp = 0.f, be = 0.f, ke = 0.f, ve = 0.f, bve = 0.f; unsigned bvp[8];
                    unsigned short prr[17], pkk[17], pvv[17];
#pragma unroll
                    for (int i = 0; i < 17; ++i) { prr[i] = ((const LAS bf16_t*)PSW)[(3 * i) * 64 + lane]; pkk[i] = ((const LAS bf16_t*)PSW)[(3 * i + 1) * 64 + lane]; pvv[i] = ((const LAS bf16_t*)PSW)[(3 * i + 2) * 64 + lane]; }
                    WAVE_LDS_SYNC();
                    if (u + G < NB * NCH) PS_DMA(u + G);
                    rp = bf2f(prr[0]); kp_ = bf2f(pkk[0]); vp = bf2f(pvv[0]);
                    const float hp0 = prow0 >= 0 ? 1.f : 0.f;
#pragma unroll
                    for (int i0 = 0; i0 < 16; i0 += 4) {
                        float rs4[4], vs4[4], alr4[4], kkr4[4], kpr4[4], red[8];
#pragma unroll
                        for (int j = 0; j < 4; ++j) { const int i = i0 + j;
                            const float rc = bf2f(prr[i + 1]), kc = bf2f(pkk[i + 1]), vc = bf2f(pvv[i + 1]);
                            const float hp = i ? 1.f : hp0;
                            const float rs = rc + mu_r * (hp * rp - rc), ks_ = kc + mu_k * (hp * kp_ - kc), vs = vc + mu_v * (hp * vp - vc);
                            rp = rc; kp_ = kc; vp = vc;
                            const float alr = __builtin_amdgcn_rcpf(1.f + __builtin_amdgcn_exp2f(-LOG2E * (za[i] + a0c)));
                            const float kkr = ks_ * kkc, kpr = ks_ * (1.f + (alr - 1.f) * kac);
                            rs4[j] = rs; vs4[j] = vs; alr4[j] = alr; kkr4[j] = kkr; kpr4[j] = kpr; red[2 * j] = kkr * kkr; red[2 * j + 1] = rs * kpr * rkc; }
                        wave_sum_dpp8(red);
#pragma unroll
                        for (int j = 0; j < 4; ++j) { const int i = i0 + j;
                            cum += zw[i];
                            const float kk = kkr4[j] * __builtin_amdgcn_rsqf(fmaxf(red[2 * j], 1e-24f)), bon = red[2 * j + 1], kpr = kpr4[j], vs = vs4[j];
                            const float eg = __builtin_amdgcn_exp2f(LOG2E * cum), gi = __builtin_amdgcn_exp2f(-LOG2E * cum), tail = __builtin_amdgcn_exp2f(LOG2E * (cum - cumC));
                            atil[i] = -kk * gprev;
                            const float bb = kk * alr4[j], rtil = rs4[j] * gi; gprev = gi;
                            OA[i * 72 + lane] = f2bf(atil[i]); OB[i * 72 + lane] = f2bf(bb * eg); OK[i * 72 + lane] = f2bf(kpr * eg); OR[i * 72 + lane] = f2bf(rtil);
                            if (i & 1) { bkB[i >> 1] = pk2bf(be, bb * tail); bkK[i >> 1] = pk2bf(ke, kpr * tail); vtp[i >> 1] = pk2bf(ve, vs); } else { be = bb * tail; ke = kpr * tail; ve = vs; }
                            if (i & 1) bvp[i >> 1] = pk2bf(bve, bon * vs); else bve = bon * vs; }
                    }
                    {
                        ((float*)(rb + 3584))[lane] = gprev;
#pragma unroll
                        for (int q = 0; q < 4; ++q) *(u32x4*)(ra + 4096 + lane * 64 + ((q ^ SWZ4(lane)) << 4)) = (u32x4){bkB[2 * q], bkB[2 * q + 1], bkK[2 * q], bkK[2 * q + 1]};
                        *(u32x4*)(rb + lane * 32) = (u32x4){vtp[0], vtp[1], vtp[2], vtp[3]}; *(u32x4*)(rb + lane * 32 + 16) = (u32x4){vtp[4], vtp[5], vtp[6], vtp[7]};
                    }
                    WAVE_LDS_SYNC();
                    TP_MARK(24);
#define REC_STORE(TILE, DST) do { _Pragma("unroll") for (int hh_ = 0; hh_ < 2; ++hh_) { const int i_ = (lane >> 3) + 8 * hh_, pc_ = lane & 7, c_ = pc_ ^ ((i_ >> 1) & 7), base_ = (c_ >> 2) * 32 + (c_ & 3) * 4; \
                        const u32x2 lo_ = *(const LAS u32x2*)((TILE) + i_ * 72 + base_), hi_ = *(const LAS u32x2*)((TILE) + i_ * 72 + base_ + 16); \
                        *(u32x4*)((DST) + i_ * 128 + pc_ * 16) = (u32x4){lo_.x, lo_.y, hi_.x, hi_.y}; } } while (0)
                    REC_STORE(OR, ra + 2048);
                    {
                        f32x4 dab = (f32x4){0.f, 0.f, 0.f, 0.f}, dak = dab, drb = dab, drk = dab;
#pragma unroll
                        for (int ks = 0; ks < 2; ++ks) {
                            const int off = fr * 72 + 32 * ks + 8 * fq;
                            const bf16x8 fa = *(const LAS bf16x8*)(OA + off), fb = *(const LAS bf16x8*)(OB + off), fk = *(const LAS bf16x8*)(OK + off), frr = *(const LAS bf16x8*)(OR + off);
                            dab = __builtin_amdgcn_mfma_f32_16x16x32_bf16(fa, fb, dab, 0, 0, 0); dak = __builtin_amdgcn_mfma_f32_16x16x32_bf16(fa, fk, dak, 0, 0, 0);
                            drb = __builtin_amdgcn_mfma_f32_16x16x32_bf16(frr, fb, drb, 0, 0, 0); drk = __builtin_amdgcn_mfma_f32_16x16x32_bf16(frr, fk, drk, 0, 0, 0);
                        }
#pragma unroll
                        for (int r = 0; r < 4; ++r) { const int i = 4 * fq + r, j = fr;
                            LT[i * 20 + j] = j < i ? dab[r] : 0.f; LAK[i * 16 + j] = j < i ? dak[r] : 0.f;
                            bf16_t* mp = (bf16_t*)(rb + 2048 + i * 64 + (((j >> 2) ^ SWZ4(i)) << 4)) + (j & 3);
                            mp[0] = f2bf(j <= i ? drb[r] : 0.f); mp[4] = f2bf(j <= i ? drk[r] : 0.f); }
                    }
                    WAVE_LDS_SYNC();
                    {
#pragma unroll
                        for (int k_ = 0; k_ < 8; ++k_) { OB[(2 * k_) * 72 + lane] = (bf16_t)(bvp[k_] & 0xffffu); OB[(2 * k_ + 1) * 72 + lane] = (bf16_t)(bvp[k_] >> 16); }
                        WAVE_LDS_SYNC();
                        const int ti_ = lane >> 2, pt_ = lane & 3;
                        const u32x4 b0_ = *(const LAS u32x4*)(OB + ti_ * 72 + 16 * pt_), b1_ = *(const LAS u32x4*)(OB + ti_ * 72 + 16 * pt_ + 8);
                        bf16_t* bp_ = BV + (size_t)(row0 + ti_) * 512 + h * 64 + 16 * pt_;
                        *(u32x4*)bp_ = b0_; *(u32x4*)(bp_ + 8) = b1_;
                    }
                    float tt[16];
#pragma unroll
                    for (int mm = 0; mm < 16; ++mm) tt[mm] = mm == fr ? 1.f : 0.f;
#pragma unroll
                    for (int j = 14; j >= 0; --j) { float val = 0.f;
#pragma unroll
                        for (int mm = j + 1; mm < 16; ++mm) val += tt[mm] * LT[mm * 20 + j];
                        tt[j] += val; }
                    WAVE_LDS_SYNC();
                    if (fq == 0) {
#pragma unroll
                        for (int mm = 0; mm < 16; ++mm) LT[fr * 20 + mm] = tt[mm]; }
                    {
                        f32x4 g4 = (f32x4){0.f, 0.f, 0.f, 0.f};
#pragma unroll
                        for (int mm = 0; mm < 16; ++mm) g4 += *(const LAS f32x4*)(LAK + mm * 16 + 4 * fq) * tt[mm];
                        u32x2 w; w.x = pk2bf(g4[0], g4[1]); w.y = pk2bf(g4[2], g4[3]);
                        *(u32x2*)(rb + 3072 + (fr * 16 + 4 * fq) * 2) = w;
                    }
                    WAVE_LDS_SYNC();
                    TP_MARK(25);
                    {
#pragma unroll
                        for (int i = 0; i < 16; ++i) { float acc = 0.f;
                            const f32x4 t0 = *(const LAS f32x4*)(LT + i * 20), t1 = *(const LAS f32x4*)(LT + i * 20 + 4), t2 = *(const LAS f32x4*)(LT + i * 20 + 8), t3 = *(const LAS f32x4*)(LT + i * 20 + 12);
                            const float trow[16] = {t0[0], t0[1], t0[2], t0[3], t1[0], t1[1], t1[2], t1[3], t2[0], t2[1], t2[2], t2[3], t3[0], t3[1], t3[2], t3[3]};
#pragma unroll
                            for (int mm = 0; mm <= i; ++mm) acc += trow[mm] * atil[mm];
                            OK[i * 72 + lane] = f2bf(acc); }
                        WAVE_LDS_SYNC();
                        REC_STORE(OK, ra);
                    }
#undef REC_STORE
                    TP_MARK(26);
                }
            }
            __syncthreads();
            TP_MARK(18);
#undef PN_DMA
#undef PS_DMA
#undef PSV
            TP_MARK(29);
            TP_MARK(21);
            const float* q_g = inq[16] + lq * 64; const float* k_g = inq[17] + lq * 64; const float* b_f = inq[15] + lq * 8;
            for (int it = gw - (G >= 96 ? 80 * NWAVES : 0); it >= 0 && it < NMETA * NH; it += ngw) {
                const int row = MROWS + (it >> 3), h = it & 7;
                bf16_t* qp = p + (size_t)row * PBW + 1536 + h * 64 + lane; bf16_t* kp = p + (size_t)row * PBW + 2048 + h * 64 + lane;
                const float q = bf2f(*qp), k = bf2f(*kp);
                const float mq = wave_sum(q * q) * (1.f / 64.f), mk = wave_sum(k * k) * (1.f / 64.f);
                *qp = f2bf(q * (1.0f / sqrtf(mq + 1e-6f)) * q_g[lane] * (0.125f * LOG2E));
                *kp = f2bf(k * (1.0f / sqrtf(mk + 1e-6f)) * k_g[lane]);
            }
            for (int it = bid - (G >= 80 ? 16 : 0); it >= 0 && it < NB * NH; it += G) {
                constexpr int PER = 5;
                const int b = it >> 3, h = it & 7;
                float zv[PER], loc[PER], s = 0.f;
#pragma unroll
                for (int i = 0; i < PER; ++i) { const int t = tid * PER + i; zv[i] = pn[(size_t)rowof(b, t < LTOT ? t : LTOT - 1) * PNW + 288 + h]; }
#pragma unroll
                for (int i = 0; i < PER; ++i) { const int t = tid * PER + i;
                    const float v = t < LTOT ? -__builtin_amdgcn_logf(1.f + __builtin_amdgcn_exp2f(-LOG2E * (zv[i] + b_f[h]))) : 0.f;
                    s += v; loc[i] = s; }
                float incl = s;
#pragma unroll
                for (int o = 1; o < 64; o <<= 1) { const float n = __int_as_float(__builtin_amdgcn_ds_bpermute((lane - o) << 2, __float_as_int(incl))); if (lane >= o) incl += n; }
                float base = incl - s;
                if (lane == 63) ((LAS float*)ldsl)[wave] = incl;
                __syncthreads();
#pragma unroll
                for (int w = 0; w < NWAVES - 1; ++w) base += w < wave ? ((const LAS float*)ldsl)[w] : 0.f;
                float* cv = c2 + (size_t)it * 2176;
#pragma unroll
                for (int i = 0; i < PER; ++i) { const int t = tid * PER + i; if (t < LTOT) cv[t < NMETA ? t : t + 112] = base + loc[i]; }
                if (tid < 112) cv[16 + tid] = 1e5f;
                __syncthreads();
            }
        }
        } else if (ph == 2) {
        {
            PHASE_IDS(); PHASE_PTRS(l);
            typedef short s16x4 __attribute__((ext_vector_type(4)));
            constexpr int SLOTB = 12288, NSLOT = 10  , YB_OFF = NSLOT * SLOTB, YB_BYTES = 32 * 68 * 4, NSC = (NCH + 1) / 2;
            static_assert(YB_OFF + 2 * YB_BYTES <= LDSCTL_OFF, "scan LDS map");
#define RAW_BAR() asm volatile("s_waitcnt lgkmcnt(0)\n\ts_barrier" ::: "memory")
#define QXOR1(x) __int_as_float(__builtin_amdgcn_update_dpp(0, __float_as_int(x), 0xB1, 0xf, 0xf, false))
#define QXOR2(x) __int_as_float(__builtin_amdgcn_update_dpp(0, __float_as_int(x), 0x4E, 0xf, 0xf, false))
            for (int unit = bid; unit < 64; unit += G) {
                const int b = unit >> 3, h = unit & 7, fr = lane & 15, fq = lane >> 4;
                const unsigned char* RA0 = ws + WS_RA + (size_t)unit * NCH * RA_BYTES; const unsigned char* RB0 = (const unsigned char*)out + (size_t)unit * NCH * RB_BYTES;
                if (wave < 4) {
                    const int v = 16 * wave + fr;
                    f32x4 Z[4];
#pragma unroll
                    for (int kb = 0; kb < 4; ++kb) Z[kb] = (f32x4){0.f, 0.f, 0.f, 0.f};
                    const int o_ah0 = fr * 128 + (((fq) ^ ((fr >> 1) & 7)) << 4), o_ah1 = fr * 128 + (((4 + fq) ^ ((fr >> 1) & 7)) << 4);
                    const int o_bk = 4096 + fr * 64 + ((fq ^ SWZ4(fr)) << 4), o_mrk = 10240 + fr * 64 + ((fq ^ SWZ4(fr)) << 4);
                    const int o_vt = 8192 + v * 32 + fq * 8, o_g = 11264 + fr * 32 + fq * 8, o_gam = 11776 + fq * 16;
                    RAW_BAR();
                    for (int s = 0; s < NSC; ++s) {
                        LAS float* YB = (LAS float*)(ldsl + YB_OFF + (s & 1) * YB_BYTES);
                        const int nc = (NCH - 2 * s) < 2 ? 1 : 2;
                        for (int cs = 0; cs < nc; ++cs) {
                            const LAS unsigned char* sl = ldsl + ((2 * s + cs) % NSLOT) * SLOTB;
                            const bf16x8 ah0 = *(const LAS bf16x8*)(sl + o_ah0), ah1 = *(const LAS bf16x8*)(sl + o_ah1);
                            const bf16x8 rh0 = *(const LAS bf16x8*)(sl + 2048 + o_ah0), rh1 = *(const LAS bf16x8*)(sl + 2048 + o_ah1);
                            bf16x8 bk[4]; f32x4 gam[4];
#pragma unroll
                            for (int kb = 0; kb < 4; ++kb) { bk[kb] = *(const LAS bf16x8*)(sl + o_bk + kb * 1024); gam[kb] = *(const LAS f32x4*)(sl + o_gam + kb * 64); }
                            const u32x2 vt = *(const LAS u32x2*)(sl + o_vt);
                            const bf16x8 mrk = *(const LAS bf16x8*)(sl + o_mrk);
                            const u32x2 g4 = *(const LAS u32x2*)(sl + o_g);
                            u32x4 zw01, zw23;
                            zw01.x = pk2bf(Z[0][0], Z[0][1]); zw01.y = pk2bf(Z[0][2], Z[0][3]); zw01.z = pk2bf(Z[1][0], Z[1][1]); zw01.w = pk2bf(Z[1][2], Z[1][3]);
                            zw23.x = pk2bf(Z[2][0], Z[2][1]); zw23.y = pk2bf(Z[2][2], Z[2][3]); zw23.z = pk2bf(Z[3][0], Z[3][1]); zw23.w = pk2bf(Z[3][2], Z[3][3]);
                            const bf16x8 zp01 = __builtin_bit_cast(bf16x8, zw01), zp23 = __builtin_bit_cast(bf16x8, zw23);
                            f32x4 U = (f32x4){0.f, 0.f, 0.f, 0.f}, Yv = U;
                            U = __builtin_amdgcn_mfma_f32_16x16x32_bf16(ah0, zp01, U, 0, 0, 0); U = __builtin_amdgcn_mfma_f32_16x16x32_bf16(ah1, zp23, U, 0, 0, 0);
                            U = __builtin_amdgcn_mfma_f32_16x16x16bf16_1k(__builtin_bit_cast(s16x4, g4), __builtin_bit_cast(s16x4, vt), U, 0, 0, 0);
                            Yv = __builtin_amdgcn_mfma_f32_16x16x32_bf16(rh0, zp01, Yv, 0, 0, 0); Yv = __builtin_amdgcn_mfma_f32_16x16x32_bf16(rh1, zp23, Yv, 0, 0, 0);
                            u32x4 uvw; uvw.x = pk2bf(U[0], U[1]); uvw.y = pk2bf(U[2], U[3]); uvw.z = vt.x; uvw.w = vt.y;
                            const bf16x8 uv = __builtin_bit_cast(bf16x8, uvw);
                            Yv = __builtin_amdgcn_mfma_f32_16x16x32_bf16(mrk, uv, Yv, 0, 0, 0);
#pragma unroll
                            for (int kb = 0; kb < 4; ++kb) { Z[kb] = Z[kb] * gam[kb]; Z[kb] = __builtin_amdgcn_mfma_f32_16x16x32_bf16(bk[kb], uv, Z[kb], 0, 0, 0); }
#pragma unroll
                            for (int r = 0; r < 4; ++r) YB[(cs * 16 + 4 * fq + r) * 68 + v] = Yv[r];
                        }
                        RAW_BAR();
                    }
                } else if (wave < 6) {
                    const unsigned lds0 = (unsigned)(uintptr_t)lds; const int lw = wave - 4;
#define DMA_SC(sc) do { const int nc_ = (NCH - 2 * (sc)) < 2 ? 1 : 2; for (int cs_ = 0; cs_ < nc_; ++cs_) { const int ch_ = 2 * (sc) + cs_; \
                        _Pragma("unroll") for (int pc_ = 0; pc_ < 6; ++pc_) { const int pc = lw * 6 + pc_; \
                            const unsigned char* src_ = (pc < 8 ? RA0 + (size_t)ch_ * RA_BYTES + pc * 1024 : RB0 + (size_t)ch_ * RB_BYTES + (pc - 8) * 1024) + lane * 16; \
                            attn_body::glds16(src_, (unsigned)__builtin_amdgcn_readfirstlane(lds0 + (ch_ % NSLOT) * SLOTB + pc * 1024)); } } } while (0)
                    DMA_SC(0); DMA_SC(1); DMA_SC(2); DMA_SC(3);
                    asm volatile("s_waitcnt vmcnt(36)\n\ts_barrier" ::: "memory");
                    for (int s = 0; s < NSC; ++s) {
                        if (s + 4 < NSC) DMA_SC(s + 4);
#define NPC_(sc) ((sc) < NSC ? ((NCH - 2 * (sc)) < 2 ? 6 : 12) : 0)
                        const int fl = NPC_(s + 2) + NPC_(s + 3) + NPC_(s + 4);
#undef NPC_
                        if (fl == 36) asm volatile("s_waitcnt vmcnt(36)\n\ts_barrier" ::: "memory");
                        else if (fl == 30) asm volatile("s_waitcnt vmcnt(30)\n\ts_barrier" ::: "memory");
                        else if (fl == 18) asm volatile("s_waitcnt vmcnt(18)\n\ts_barrier" ::: "memory");
                        else if (fl == 6) asm volatile("s_waitcnt vmcnt(6)\n\ts_barrier" ::: "memory");
                        else asm volatile("s_waitcnt vmcnt(0)\n\ts_barrier" ::: "memory");
                    }
#undef DMA_SC
                } else {
                    const int pw = wave - 6, tk = lane >> 2, part = lane & 3, cgv = h * 64 + part * 16;
                    const bf16_t* BV = (const bf16_t*)(ws + WS_BV);
                    float gnw[16], gnb[16];
#pragma unroll
                    for (int j = 0; j < 16; ++j) { gnw[j] = (inq[13] + lq * 512)[cgv + j]; gnb[j] = (inq[14] + lq * 512)[cgv + j]; }
#define PLOAD(G0, G1, B0, B1, sg) do { const int cn_ = 2 * (sg) + pw; if ((sg) < NSC && cn_ < NCH) { const size_t rown = (size_t)rowof(b, 16 * cn_ + tk); \
                        G0 = *(const u32x4*)(y + rown * DM + cgv); G1 = *(const u32x4*)(y + rown * DM + cgv + 8); B0 = *(const u32x4*)(BV + rown * 512 + cgv); B1 = *(const u32x4*)(BV + rown * 512 + cgv + 8); } } while (0)
                    u32x4 ga0 = (u32x4){0u, 0u, 0u, 0u}, ga1 = ga0, ba0 = ga0, ba1 = ga0, gb0 = ga0, gb1 = ga0, bb0 = ga0, bb1 = ga0, gc0 = ga0, gc1 = ga0, bc0 = ga0, bc1 = ga0;
                    PLOAD(gb0, gb1, bb0, bb1, 0); PLOAD(gc0, gc1, bc0, bc1, 1);
                    RAW_BAR();
                    for (int s = 0; s <= NSC; ++s) {
                        const int cp = 2 * (s - 1) + pw;
                        const bool do_now = s >= 1 && cp < NCH && (cp > 0 || b == 0);
                        const u32x4 g0 = ga0, g1 = ga1, b0 = ba0, b1 = ba1;
                        ga0 = gb0; ga1 = gb1; ba0 = bb0; ba1 = bb1; gb0 = gc0; gb1 = gc1; bb0 = bc0; bb1 = bc1;
                        PLOAD(gc0, gc1, bc0, bc1, s + 2);
                        if (do_now) {
                            const LAS float* yb = (const LAS float*)(ldsl + YB_OFF + ((s - 1) & 1) * YB_BYTES) + (pw * 16 + tk) * 68 + part * 16;
                            float yv[16];
#pragma unroll
                            for (int q4 = 0; q4 < 4; ++q4) { const f32x4 t4 = *(const LAS f32x4*)(yb + 4 * q4); yv[4 * q4] = t4[0]; yv[4 * q4 + 1] = t4[1]; yv[4 * q4 + 2] = t4[2]; yv[4 * q4 + 3] = t4[3]; }
                            float s1 = 0.f;
#pragma unroll
                            for (int j = 0; j < 16; ++j) s1 += yv[j];
                            s1 += QXOR1(s1); s1 += QXOR2(s1);
                            const float mean = s1 * (1.f / 64.f); float s2 = 0.f;
#pragma unroll
                            for (int j = 0; j < 16; ++j) { yv[j] -= mean; s2 += yv[j] * yv[j]; }
                            s2 += QXOR1(s2); s2 += QXOR2(s2);
                            const float rstd = 1.0f / sqrtf(s2 * (1.f / 64.f) + 64e-5f);
                            const unsigned gws[8] = {g0.x, g0.y, g0.z, g0.w, g1.x, g1.y, g1.z, g1.w}, bws[8] = {b0.x, b0.y, b0.z, b0.w, b1.x, b1.y, b1.z, b1.w};
                            unsigned ow[8];
#pragma unroll
                            for (int j2 = 0; j2 < 8; ++j2) {
                                const float oa = (yv[2 * j2] * rstd * gnw[2 * j2] + gnb[2 * j2] + __uint_as_float(bws[j2] << 16)) * __uint_as_float(gws[j2] << 16);
                                const float ob = (yv[2 * j2 + 1] * rstd * gnw[2 * j2 + 1] + gnb[2 * j2 + 1] + __uint_as_float(bws[j2] & 0xffff0000u)) * __uint_as_float(gws[j2] & 0xffff0000u);
                                ow[j2] = pk2bf(oa, ob); }
                            bf16_t* yo = y + (size_t)rowof(b, 16 * cp + tk) * DM + cgv;
                            *(u32x4*)yo = (u32x4){ow[0], ow[1], ow[2], ow[3]}; *(u32x4*)(yo + 8) = (u32x4){ow[4], ow[5], ow[6], ow[7]};
                        }
                        if (s < NSC) RAW_BAR();
                    }
#undef PLOAD
                }
                __syncthreads();
            }
#undef RAW_BAR
#undef QXOR1
#undef QXOR2
        }
        TP_MARK(30);
        {
            PHASE_IDS(); PHASE_PTRS(l);
            if (gw < NH * NMETA) {
                const int h = gw >> 4, t = gw & 15;
                const bf16_t* qrow = p + (size_t)(MROWS + t) * PBW + 1536 + h * 64;
                float s = -INFINITY;
                if (lane <= t) { const bf16_t* kr = p + (size_t)(MROWS + lane) * PBW + 2048 + h * 64; float d = 0.f;
                    for (int e = 0; e < 64; ++e) d += bf2f(qrow[e]) * bf2f(kr[e]);
                    s = d - c2[(size_t)h * 2176 + lane]; }
                const float mx = wave_max(s); const float e = lane <= t ? exp2f(s - mx) : 0.f; const float sum = wave_sum(e);
                float o = 0.f;
                for (int j = 0; j <= t; ++j) o += __int_as_float(__builtin_amdgcn_readlane(__float_as_int(e), j)) * bf2f(p[(size_t)(MROWS + j) * PBW + 2560 + h * 64 + lane]);
                const float og = bf2f(p[(size_t)(MROWS + t) * PBW + 3072 + h * 64 + lane]);
                y[(size_t)(MROWS + t) * DM + 512 + h * 64 + lane] = f2bf(o * __builtin_amdgcn_rcpf(sum) * __builtin_amdgcn_rcpf(1.f + __builtin_amdgcn_exp2f(-LOG2E * og)));
            }
        }
        __syncthreads();
        {
            PHASE_IDS(); PHASE_PTRS(l);
            typedef attn_body::bf16 abf;
            const attn_body::AttnTensors AT{(const abf*)(p + 1536), (const abf*)(p + 2048), (const abf*)(p + 2560), (const abf*)(p + 3072), c2, (abf*)(y + 512)};
            const attn_body::StaticOrder S(G, bid);
            TP_MARK(31);
            attn_body::attn_phase<attn_body::StaticOrder>((char*)lds, AT, S, wave);
            TP_MARK(32);
        }
        } else if (ph == 3) {
        {
            PHASE_IDS(); PHASE_PTRS(l);
            pg8::Gemm g{y, W2, MROWS, DM, DM}; pg8::StaticOrder S; S.init(MROWS, DM, G, bid);
            pg8::EpiRes E{nullptr, hb, ssqp};
            pg8::gemm_phase<pg8::EpiRes, pg8::StaticOrder, true, true>(ldsl, g, S, E, wave);
            meta_gemm<false>(y + (size_t)MROWS * DM, DM, W2, DM, DM, bid, G, wave, lane, (float*)lds, MEpiRes{hm});
        }
        } else if (ph == 5) {
        {
            PHASE_IDS(); PHASE_PTRS(l);
            const float* cw = inq[21] + (size_t)lq * 3 * DFF2; const float* cb = inq[22] + (size_t)lq * DFF2;
            pg8::Gemm g{act, W4, MROWS, DM, DFF}; pg8::StaticOrder S; S.init(MROWS, DM, G, bid);
            {
                pg8::Unit u;
                for (int i = 0; S.next(i, u); ++i) {
                    const int pm = u.pm;
                    const float* own0 = fixb + (size_t)(pm * 4) * DFF2; const float* own1 = own0 + DFF2;
                    const float* pv0 = (pm & 7) ? fixb + (size_t)((pm - 1) * 4 + 2) * DFF2 : rawm + (size_t)14 * DFF2; const float* pv1 = pv0 + DFF2;
                    for (int j = 4 * tid; j < DFF; j += 4 * NWAVES * 64) {
                        const f32x4 w0u = *(const f32x4*)(cw + j), w1u = *(const f32x4*)(cw + DFF2 + j), w2u = *(const f32x4*)(cw + 2 * DFF2 + j), bu = *(const f32x4*)(cb + j);
                        const f32x4 w0g = *(const f32x4*)(cw + DFF + j), w1g = *(const f32x4*)(cw + DFF2 + DFF + j), w2g = *(const f32x4*)(cw + 2 * DFF2 + DFF + j), bg = *(const f32x4*)(cb + DFF + j);
                        const f32x4 au = *(const f32x4*)(pv0 + j), bu_ = *(const f32x4*)(pv1 + j), cu_ = *(const f32x4*)(own0 + j), du = *(const f32x4*)(own1 + j);
                        const f32x4 ag = *(const f32x4*)(pv0 + DFF + j), bg_ = *(const f32x4*)(pv1 + DFF + j), cg_ = *(const f32x4*)(own0 + DFF + j), dg = *(const f32x4*)(own1 + DFF + j);
                        const f32x4 u0 = bu + w0u * au + w1u * bu_ + w2u * cu_, g0 = bg + w0g * ag + w1g * bg_ + w2g * cg_;
                        const f32x4 u1 = bu + w0u * bu_ + w1u * cu_ + w2u * du, g1 = bg + w0g * bg_ + w1g * cg_ + w2g * dg;
                        u32x2 o0, o1;
                        o0.x = pk2bf(g0[0] * sigmoidf_(g0[0]) * u0[0], g0[1] * sigmoidf_(g0[1]) * u0[1]); o0.y = pk2bf(g0[2] * sigmoidf_(g0[2]) * u0[2], g0[3] * sigmoidf_(g0[3]) * u0[3]);
                        o1.x = pk2bf(g1[0] * sigmoidf_(g1[0]) * u1[0], g1[1] * sigmoidf_(g1[1]) * u1[1]); o1.y = pk2bf(g1[2] * sigmoidf_(g1[2]) * u1[2], g1[3] * sigmoidf_(g1[3]) * u1[3]);
                        *(u32x2*)(act + (size_t)(256 * pm) * DFF + j) = o0; *(u32x2*)(act + (size_t)(256 * pm + 1) * DFF + j) = o1;
                    }
                }
                asm volatile("s_waitcnt vmcnt(0)" ::: "memory"); __syncthreads();
            }
            pg8::EpiRes E{lq + 1 == DEPTH ? out : nullptr, hb, ssqp};
            pg8::gemm_phase<pg8::EpiRes, pg8::StaticOrder, true, true>(ldsl, g, S, E, wave);
            meta_gemm<false>(act + (size_t)MROWS * DFF, DFF, W4, DM, DFF, bid, G, wave, lane, (float*)lds, MEpiRes{hm});
        }
        }
#ifdef TPROBE
#ifdef TPROBE_WAIT
        TP_MARK(19);
#endif
        GRID_BAR(); TP_MARK(ph == 0 ? 1 : ph == 1 ? 2 : ph == 2 ? 3 : ph == 3 ? 4 : ph == 4 ? 5 : 6);
#if TPROBE == 40
        GRID_BAR(); TP_MARK(40);
#endif
#else
        if (ph < 5 || l + 1 < DEPTH) GRID_BAR();
#endif
      }
    }
#ifdef TPROBE
#ifndef TPROBE_BLOCK
#define TPROBE_BLOCK 0
#endif
    if (bid0 == TPROBE_BLOCK && wave_s == 0 && lane_id() == 0) a.out[0] += (float)((volatile LAS unsigned*)((LAS unsigned char*)lds + LDSCTL_OFF + 512))[1] * 0.0001f;
#endif
}

extern "C" void kernel_launch(void* const* d_in, const int* in_sizes, int n_in, void* d_out, int out_size, void* d_ws, size_t ws_size, hipStream_t stream) {
    static int grid = 0;
    if (grid == 0) {
        if (n_in != 24 || out_size != MROWS * DM || ws_size < WS_END) { fprintf(stderr, "kernel_launch: unexpected shapes (n_in %d out %d ws %zu)\n", n_in, out_size, ws_size); grid = -1; return; }
        int dev = 0, cus = 0, per_cu = 0;
        hipGetDevice(&dev); hipDeviceGetAttribute(&cus, hipDeviceAttributeMultiprocessorCount, dev);
        if (hipFuncSetAttribute((const void*)mk_fwd, hipFuncAttributeMaxDynamicSharedMemorySize, LDS_BYTES) != hipSuccess) { fprintf(stderr, "kernel_launch: hipFuncSetAttribute failed\n"); grid = -1; return; }
        hipOccupancyMaxActiveBlocksPerMultiprocessor(&per_cu, (const void*)mk_fwd, NWAVES * 64, LDS_BYTES);
        (void)hipGetLastError();
        if (per_cu < 1) { fprintf(stderr, "kernel_launch: occupancy query says %d blocks per CU\n", per_cu); }
        grid = cus;
    }
    if (grid < 0) return;
    hipMemsetAsync((char*)d_ws + WS_CTL, 0, 32768, stream);
    Args a{};
    for (int i = 0; i < 24; ++i) a.in[i] = (const float*)d_in[i];
    a.out = (float*)d_out; a.ws = (unsigned char*)d_ws;
    void* args[] = {&a};
#ifdef PLAIN_LAUNCH
    hipLaunchKernelGGL(mk_fwd, dim3(grid), dim3(NWAVES * 64), LDS_BYTES, stream, a); hipError_t e = hipPeekAtLastError(); (void)args;
#else
    hipError_t e = hipLaunchCooperativeKernel((const void*)mk_fwd, dim3(grid), dim3(NWAVES * 64), args, LDS_BYTES, stream);
#endif
    if (e != hipSuccess) fprintf(stderr, "cooperative launch failed: %s (grid %d)\n", hipGetErrorString(e), grid);
}
```

```cpp
#define PLAIN_LAUNCH 1
#include <hip/hip_runtime.h>
#include <hip/hip_cooperative_groups.h>
#include <stdint.h>
#include <cstdio>
namespace cg = cooperative_groups;

typedef unsigned short bf16_t;
typedef short bf16x8 __attribute__((ext_vector_type(8)));
typedef float f32x4 __attribute__((ext_vector_type(4)));
typedef unsigned u32x4 __attribute__((ext_vector_type(4)));
typedef unsigned u32x2 __attribute__((ext_vector_type(2)));

constexpr int NB = 8, SEQ = 2048, NMETA = 16, LTOT = 2064, DM = 1024, DEPTH = 4, NH = 8, HD = 64;
constexpr int N_IN = 3880, DFF = 2816, DFF2 = 5632;
constexpr int MROWS = NB * SEQ;
constexpr int RROWS = MROWS + NMETA;
constexpr int N1 = 4096;
constexpr int PBW = 3584;
constexpr int PNW = 320;
constexpr float LOG2E = 1.4426950408889634f;

constexpr size_t MiB = 1u << 20;
constexpr size_t WS_CTL = 0, CTL_ZERO_BYTES = 1 * MiB;
constexpr size_t WS_W = 1 * MiB, WL_BYTES = 27 * MiB;
constexpr size_t WO_W1 = 0;
constexpr size_t WO_W2 = 8 * MiB;
constexpr size_t WO_W3 = 10 * MiB;
constexpr size_t WO_W4 = 21 * MiB;
constexpr size_t WO_LUP = 26 * MiB + 512 * 1024;
constexpr size_t WS_SMALL = WS_W + 2 * WL_BYTES;
constexpr size_t WS_HM = WS_SMALL;
constexpr size_t WS_C2 = WS_SMALL + 1 * MiB;
constexpr size_t WS_SSQ = WS_SMALL + 3 * MiB;
constexpr size_t WS_HB = WS_SMALL + 6 * MiB;
constexpr size_t WS_P = WS_HB + 33 * MiB;
constexpr size_t WS_PN = WS_P + 113 * MiB;
constexpr size_t WS_Y = WS_PN + 21 * MiB;
constexpr size_t WS_FREE = WS_Y + 33 * MiB;
constexpr int NCH = 129;
constexpr size_t RA_BYTES = 8192, RB_BYTES = 4096;
constexpr size_t WS_RA = WS_FREE;
#define SWZ4(r) (3 * (((r) >> 3) & 1))
constexpr size_t WS_ACT = WS_P;
constexpr size_t WS_FIX = WS_PN;
constexpr size_t WS_RAWM = WS_PN + 6 * MiB;
constexpr size_t WS_BV = WS_RA + 65 * MiB;
constexpr size_t WS_END = WS_BV + 17 * MiB;

__device__ __forceinline__ float bf2f(bf16_t v) { return __uint_as_float(((unsigned)v) << 16); }
typedef float f32x2_t_ __attribute__((ext_vector_type(2))); typedef __bf16 bf16x2_t_ __attribute__((ext_vector_type(2)));
__device__ __forceinline__ unsigned pk2bf(float lo, float hi) { const f32x2_t_ v = {lo, hi}; return __builtin_bit_cast(unsigned, __builtin_convertvector(v, bf16x2_t_)); }
__device__ __forceinline__ bf16_t f2bf(float f) { return __builtin_bit_cast(bf16_t, (__bf16)f); }
__device__ __forceinline__ float sigmoidf_(float x) { return 1.f / (1.f + __expf(-x)); }
__device__ __forceinline__ float wave_sum_dpp(float v) {
#define DPPF_(x, ctrl, rmask) __int_as_float(__builtin_amdgcn_update_dpp(0, __float_as_int(x), ctrl, rmask, 0xf, false))
    v += DPPF_(v, 0xB1, 0xf);
    v += DPPF_(v, 0x4E, 0xf);
    v += DPPF_(v, 0x141, 0xf);
    v += DPPF_(v, 0x140, 0xf);
    v += DPPF_(v, 0x142, 0xa);
    v += DPPF_(v, 0x143, 0xc);
#undef DPPF_
    return __int_as_float(__builtin_amdgcn_readlane(__float_as_int(v), 63));
}
__device__ __forceinline__ float wave_sum(float v) { return wave_sum_dpp(v); }
__device__ __forceinline__ void wave_sum_dpp8(float (&v)[8]) {
#define DPPF_(x, ctrl, rmask) __int_as_float(__builtin_amdgcn_update_dpp(0, __float_as_int(x), ctrl, rmask, 0xf, false))
#define DPPS_(ctrl, rmask) _Pragma("unroll") for (int j_ = 0; j_ < 8; ++j_) v[j_] += DPPF_(v[j_], ctrl, rmask);
    DPPS_(0xB1, 0xf) DPPS_(0x4E, 0xf) DPPS_(0x141, 0xf) DPPS_(0x140, 0xf) DPPS_(0x142, 0xa) DPPS_(0x143, 0xc)
#undef DPPS_
#undef DPPF_
#pragma unroll
    for (int j_ = 0; j_ < 8; ++j_) v[j_] = __int_as_float(__builtin_amdgcn_readlane(__float_as_int(v[j_]), 63));
}
__device__ __forceinline__ float wave_max(float v) {
#define DPPF_(x, ctrl, rmask) __int_as_float(__builtin_amdgcn_update_dpp(__float_as_int(x), __float_as_int(x), ctrl, rmask, 0xf, false))
    v = fmaxf(v, DPPF_(v, 0xB1, 0xf)); v = fmaxf(v, DPPF_(v, 0x4E, 0xf)); v = fmaxf(v, DPPF_(v, 0x141, 0xf)); v = fmaxf(v, DPPF_(v, 0x140, 0xf));
    v = fmaxf(v, DPPF_(v, 0x142, 0xa)); v = fmaxf(v, DPPF_(v, 0x143, 0xc));
#undef DPPF_
    return __int_as_float(__builtin_amdgcn_readlane(__float_as_int(v), 63));
}
__device__ __forceinline__ float add_xor16(float x) { const auto r = __builtin_amdgcn_permlane16_swap(__float_as_uint(x), __float_as_uint(x), false, false); return __uint_as_float(r[0]) + __uint_as_float(r[1]); }
__device__ __forceinline__ float add_xor32(float x) { const auto r = __builtin_amdgcn_permlane32_swap(__float_as_uint(x), __float_as_uint(x), false, false); return __uint_as_float(r[0]) + __uint_as_float(r[1]); }
__device__ __forceinline__ int lane_id() { int l; asm volatile("v_mbcnt_lo_u32_b32 %0, -1, 0\n\tv_mbcnt_hi_u32_b32 %0, -1, %0" : "=v"(l)); return l; }
#define WAVE_LDS_SYNC() do { __builtin_amdgcn_s_waitcnt(0xc07f); __builtin_amdgcn_wave_barrier(); } while (0)
__device__ __forceinline__ int rowof(int b, int t) { return t < NMETA ? MROWS + t : b * SEQ + (t - NMETA); }
__device__ __forceinline__ int prevrow(int row) {
    if (row >= MROWS) return row == MROWS ? -1 : row - 1;
    return (row & (SEQ - 1)) ? row - 1 : MROWS + NMETA - 1;
}

#define PERM32(j) (8 * (((j) >> 2) & 3) + 4 * ((j) >> 4) + ((j) & 3))
__device__ __forceinline__ int src_col(int mode, int n) {
    if (mode == 1) {
        const int g = n >> 9, c_ = n & 255, o = (n & 256) + (g < 7 ? ((c_ >> 5) & 3) * 64 + (c_ >> 7) * 32 + PERM32(c_ & 31) : c_);
        switch (g) {
            case 0: return o;
            case 1: return 512 + o;
            case 2: return 1024 + o;
            case 3: return 1824 + o;
            case 4: return 2336 + o;
            case 5: return 2848 + o;
            case 6: return 3360 + o;
            default:
                if (o < 64) return 1536 + o;
                if (o < 128) return 1600 + (o - 64);
                if (o < 288) return 1664 + (o - 128);
                if (o < 296) return 3872 + (o - 288);
                return -1;
        }
    }
    if (mode == 3) { const int t = n >> 8, c = n & 255; return c < 128 ? 128 * t + c : DFF + 128 * t + (c - 128); }
    return (n & ~31) + PERM32(n & 31);
}
__device__ __forceinline__ void wprep_item(const float* W, const float* gk, bf16_t* WT, int K, int Nsrc, int Ndst, int mode, int item, float* scr, int lane) {
    const int nblk = Ndst / 32, kb = item / nblk, nb = item % nblk, k0 = 64 * kb, n0 = 32 * nb;
    const int sc = src_col(mode, n0 + (lane & 31));
    const float* wp = W + (size_t)(k0 + (lane >> 5)) * Nsrc + (sc >= 0 ? sc : 0);
    float v[32];
#pragma unroll
    for (int i = 0; i < 32; ++i) { v[i] = *wp; wp += 2 * (size_t)Nsrc; }
#pragma unroll
    for (int i = 0; i < 32; ++i) scr[(2 * i + (lane >> 5)) * 33 + (lane & 31)] = sc >= 0 ? v[i] : 0.f;
    WAVE_LDS_SYNC();
    const int c = lane & 7;
    f32x4 g0 = (f32x4){1.f, 1.f, 1.f, 1.f}, g1 = g0;
    if (gk) { g0 = *(const f32x4*)(gk + k0 + 8 * c); g1 = *(const f32x4*)(gk + k0 + 8 * c + 4); }
#pragma unroll
    for (int j = 0; j < 4; ++j) {
        const int n = (lane >> 3) + 8 * j; const float* s = scr + (8 * c) * 33 + n;
        u32x4 o;
        o.x = pk2bf(s[0 * 33] * g0[0], s[1 * 33] * g0[1]); o.y = pk2bf(s[2 * 33] * g0[2], s[3 * 33] * g0[3]); o.z = pk2bf(s[4 * 33] * g1[0], s[5 * 33] * g1[1]); o.w = pk2bf(s[6 * 33] * g1[2], s[7 * 33] * g1[3]);
        *(u32x4*)(WT + (size_t)(n0 + n) * K + k0 + 8 * c) = o;
    }
    WAVE_LDS_SYNC();
}
namespace pg8 {
#define PG8_LAS __attribute__((address_space(3)))
typedef unsigned short bf16_t;
typedef short bf16x8 __attribute__((ext_vector_type(8)));
typedef float f32x4 __attribute__((ext_vector_type(4)));
typedef unsigned u32x4 __attribute__((ext_vector_type(4)));
constexpr int BM = 256, BK = 64, HALF = 128, HTB = HALF * BK * 2  , STAGE_BYTES = 8 * HTB, NXCD = 8, WGM = 8;

__host__ __device__ __forceinline__ int lds_byte(int r, int c) { const int st = (r >> 4) * 2 + (c >> 5), rr = r & 15, cc = c & 31, ob = rr * 64 + cc * 2; return st * 1024 + (ob ^ (((ob >> 9) & 1) << 5)); }
__host__ __device__ __forceinline__ void stage_rc(int b, int& R, int& C) { const int st = b / 1024, sb = b % 1024, swz = sb ^ (((sb >> 9) & 1) << 5); R = (st >> 1) * 16 + swz / 64; C = (st & 1) * 32 + (swz % 64) / 2; }
__host__ __device__ __forceinline__ int perm32(int rho) { const int n = rho >> 4, i = rho & 15; return 8 * (i >> 2) + 4 * n + (i & 3); }

struct Unit { int pm, pn, idx; };
struct Gemm { const bf16_t* A; const bf16_t* Bt; int M, N, K; };

struct StaticOrder {
    int nM, nN, nwg, G, c;
    __host__ __device__ void init(int M, int N, int G_, int c_) { nM = M / BM; nN = N / BM; nwg = nM * nN; G = G_; c = c_; }
    __host__ __device__ bool next(int i, Unit& u) const {
        const long L = (long)i * G + c; if (L >= nwg) return false;
        int wgid = (int)L; { const int q = nwg / NXCD, r = nwg % NXCD, xcd = wgid % NXCD, off = wgid / NXCD; wgid = (xcd < r ? xcd * (q + 1) : r * (q + 1) + (xcd - r) * q) + off; }
        const int nig = WGM * nN, gid = wgid / nig, fm = gid * WGM, gsz = (nM - fm) < WGM ? (nM - fm) : WGM;
        u.pm = fm + ((wgid % nig) % gsz); u.pn = (wgid % nig) / gsz; u.idx = i; return true;
    }
    __device__ __forceinline__ void a_ready(const Unit&) const {}
    __device__ __forceinline__ void done(const Unit&) const {}
};

__device__ __forceinline__ float row_rstd(const float* ssqp, int row) {
    const f32x4* sp = (const f32x4*)(ssqp + (size_t)row * 16);
    const f32x4 a = sp[0], b = sp[1], c = sp[2], d = sp[3];
    const float s = (((a.x + a.y) + (a.z + a.w)) + ((b.x + b.y) + (b.z + b.w))) + (((c.x + c.y) + (c.z + c.w)) + ((d.x + d.y) + (d.z + d.w)));
    return 1.0f / sqrtf(s * (1.f / 1024.f) + 1e-6f);
}
struct Epi1 {
    static constexpr bool PERM = false, AFTER_DRAIN = false;
    const PG8_LAS float* rstdl; bf16_t* p; float* pn; const float* q_g; const float* k_g;
    __device__ __forceinline__ void operator()(const f32x4 (&acc)[2][2][4][2], const Unit& u, int wr, int wc, int fr, int fq) const {
        const int row0 = u.pm * BM + wr * 64 + fr;
        const bool isq = (u.pn >> 1) == 3, isk = (u.pn >> 1) == 4;
        f32x4 gsc[2][2];
        if (isq || isk) {
#pragma unroll
            for (int bj = 0; bj < 2; ++bj)
#pragma unroll
                for (int n = 0; n < 2; ++n) gsc[bj][n] = *(const f32x4*)((isq ? q_g : k_g) + 32 * bj + 8 * fq + 4 * n) * (isq ? 0.125f * 1.4426950408889634f : 1.f);
        }
#pragma unroll
        for (int ai = 0; ai < 2; ++ai)
#pragma unroll
            for (int m = 0; m < 4; ++m) {
                const int row = row0 + ai * HALF + m * 16; const float rs = rstdl[u.idx * 256 + wr * 64 + fr + ai * HALF + m * 16];
                f32x4 v[2][2];
#pragma unroll
                for (int bj = 0; bj < 2; ++bj)
#pragma unroll
                    for (int n = 0; n < 2; ++n) v[bj][n] = acc[ai][bj][m][n] * rs;
                if (u.pn < 14) {
                    if (isq || isk) {
                        float ss = 0.f;
#pragma unroll
                        for (int bj = 0; bj < 2; ++bj)
#pragma unroll
                            for (int n = 0; n < 2; ++n) ss += (v[bj][n][0] * v[bj][n][0] + v[bj][n][1] * v[bj][n][1]) + (v[bj][n][2] * v[bj][n][2] + v[bj][n][3] * v[bj][n][3]);
                        ss = add_xor16(ss); ss = add_xor32(ss);
                        const float rn = 1.0f / sqrtf(ss * (1.f / 64.f) + 1e-6f);
#pragma unroll
                        for (int bj = 0; bj < 2; ++bj)
#pragma unroll
                            for (int n = 0; n < 2; ++n) v[bj][n] = v[bj][n] * gsc[bj][n] * rn;
                    }
#pragma unroll
                    for (int bj = 0; bj < 2; ++bj) { u32x4 w; w.x = pk2bf(v[bj][0][0], v[bj][0][1]); w.y = pk2bf(v[bj][0][2], v[bj][0][3]); w.z = pk2bf(v[bj][1][0], v[bj][1][1]); w.w = pk2bf(v[bj][1][2], v[bj][1][3]);
                        *(u32x4*)(p + (size_t)row * PBW + u.pn * BM + wc * 64 + bj * 32 + 8 * fq) = w; }
                } else {
#pragma unroll
                    for (int bj = 0; bj < 2; ++bj)
#pragma unroll
                        for (int n = 0; n < 2; ++n) { const int o = u.pn * BM + wc * 32 + 4 * fq + bj * HALF + n * 16 - PBW; if (o < 296) *(f32x4*)(pn + (size_t)row * PNW + o) = v[bj][n]; }
                }
            }
    }
};
struct EpiRes {
    static constexpr bool PERM = false, AFTER_DRAIN = false;
    float* outp; bf16_t* hb; float* ssqp;
    __device__ __forceinline__ void operator()(const f32x4 (&acc)[2][2][4][2], const Unit& u, int wr, int wc, int fr, int fq) const {
        const int row0 = u.pm * BM + wr * 64 + fr, col0 = u.pn * BM + wc * 32 + 8 * fq;
#pragma unroll
        for (int ai = 0; ai < 2; ++ai) {
            u32x4 hw[4][2];
#pragma unroll
            for (int m = 0; m < 4; ++m)
#pragma unroll
                for (int bj = 0; bj < 2; ++bj) hw[m][bj] = *(const u32x4*)(hb + (size_t)(row0 + ai * HALF + m * 16) * DM + col0 + bj * HALF);
            asm volatile("s_waitcnt vmcnt(0)" ::: "memory");
#pragma unroll
            for (int m = 0; m < 4; ++m) {
                const int row = row0 + ai * HALF + m * 16; float ss = 0.f;
#pragma unroll
                for (int bj = 0; bj < 2; ++bj) {
                    const int col = col0 + bj * HALF; bf16_t* hp = hb + (size_t)row * DM + col;
                    const u32x4 h4 = hw[m][bj];
                    const f32x4 v0 = (f32x4){__uint_as_float(h4.x << 16), __uint_as_float(h4.x & 0xffff0000u), __uint_as_float(h4.y << 16), __uint_as_float(h4.y & 0xffff0000u)} + acc[ai][bj][m][0];
                    const f32x4 v1 = (f32x4){__uint_as_float(h4.z << 16), __uint_as_float(h4.z & 0xffff0000u), __uint_as_float(h4.w << 16), __uint_as_float(h4.w & 0xffff0000u)} + acc[ai][bj][m][1];
                    u32x4 w; w.x = pk2bf(v0[0], v0[1]); w.y = pk2bf(v0[2], v0[3]); w.z = pk2bf(v1[0], v1[1]); w.w = pk2bf(v1[2], v1[3]);
                    *(u32x4*)hp = w;
                    if (outp) { *(f32x4*)(outp + (size_t)row * DM + col) = v0; *(f32x4*)(outp + (size_t)row * DM + col + 4) = v1; }
                    const f32x4 r0 = (f32x4){__uint_as_float(w.x << 16), __uint_as_float(w.x & 0xffff0000u), __uint_as_float(w.y << 16), __uint_as_float(w.y & 0xffff0000u)};
                    const f32x4 r1 = (f32x4){__uint_as_float(w.z << 16), __uint_as_float(w.z & 0xffff0000u), __uint_as_float(w.w << 16), __uint_as_float(w.w & 0xffff0000u)};
                    ss += ((r0[0] * r0[0] + r0[1] * r0[1]) + (r0[2] * r0[2] + r0[3] * r0[3])) + ((r1[0] * r1[0] + r1[1] * r1[1]) + (r1[2] * r1[2] + r1[3] * r1[3]));
                }
                ss = add_xor16(ss); ss = add_xor32(ss);
                if (fq == 0) ssqp[(size_t)row * 16 + u.pn * 4 + wc] = ss;
            }
        }
    }
};
__device__ __forceinline__ float dpp_ror1(float x) { return __int_as_float(__builtin_amdgcn_mov_dpp(__float_as_int(x), 0x121, 0xf, 0xf, true)); }
__device__ __forceinline__ float dpp_ror2(float x) { return __int_as_float(__builtin_amdgcn_mov_dpp(__float_as_int(x), 0x122, 0xf, 0xf, true)); }
__device__ __forceinline__ float vmul_s(float a, float b) { float r; asm volatile("v_mul_f32_e32 %0, %1, %2" : "=v"(r) : "v"(a), "v"(b)); return r; }
struct EpiConv {
    static constexpr bool PERM = false, AFTER_DRAIN = false;
    const PG8_LAS float* rstdl; const float* cw; const float* cb; bf16_t* act; float* fix; PG8_LAS unsigned char* halo; PG8_LAS float* ctab;
    __device__ __forceinline__ void operator()(const f32x4 (&acc)[2][2][4][2], const Unit& u, int wr, int wc, int fr_, int fq_) const {
        int fr = fr_, fq = fq_; asm volatile("" : "+v"(fr), "+v"(fq));
        const int row0 = u.pm * BM + wr * 64 + fr, cl = wc * 32 + 4 * fq;
        {
            const int q = 2 * ((wr * 4 + wc) * 64 + fq * 16 + fr), p = q >> 8, col = q & 255;
            const float* src = (p < 3 ? cw + (size_t)p * DFF2 : cb) + (col < 128 ? 128 * u.pn + col : DFF + 128 * u.pn + (col - 128));
            typedef float f32x2w __attribute__((ext_vector_type(2)));
            *(PG8_LAS f32x2w*)(ctab + q) = *(const f32x2w*)src;
        }
        float rs[2][4];
#pragma unroll
        for (int ai = 0; ai < 2; ++ai)
#pragma unroll
            for (int m = 0; m < 4; ++m) rs[ai][m] = rstdl[u.idx * 256 + wr * 64 + fr + ai * HALF + m * 16];
        if (fr >= 14) {
#pragma unroll
            for (int ai = 0; ai < 2; ++ai)
#pragma unroll
                for (int bj = 0; bj < 2; ++bj)
#pragma unroll
                    for (int n = 0; n < 2; ++n) { const f32x4 v = acc[ai][bj][3][n] * rs[ai][3];
                        *(PG8_LAS f32x4*)(halo + ((((ai * 2 + wr) * 2 + (fr - 14)) * 256) + bj * HALF + cl + n * 16) * 4) = v;
                        if (ai == 1 && wr == 1) *(f32x4*)(fix + (size_t)(u.pm * 4 + 2 + (fr - 14)) * DFF2 + bj * DFF + 128 * u.pn + cl + n * 16) = v; }
        }
        if (fr < 2 && wr == 0) {
#pragma unroll
            for (int bj = 0; bj < 2; ++bj)
#pragma unroll
                for (int n = 0; n < 2; ++n) *(f32x4*)(fix + (size_t)(u.pm * 4 + fr) * DFF2 + bj * DFF + 128 * u.pn + cl + n * 16) = acc[0][bj][0][n] * rs[0][0];
        }
        asm volatile("s_waitcnt lgkmcnt(0)\n\ts_barrier" ::: "memory");
        typedef float f32x2v __attribute__((ext_vector_type(2)));
#pragma unroll
        for (int n = 0; n < 2; ++n) {
            const unsigned la2 = (unsigned)(fr * DFF + cl) * 2u;
            unsigned wpk[2][2][4];
#pragma unroll
            for (int eh = 0; eh < 2; ++eh) {
                asm volatile("" ::: "memory"); __builtin_amdgcn_sched_barrier(0);
                const int e = 2 * eh;
#define CWL(p, g) (*(const PG8_LAS f32x2v*)(ctab + (p) * 256 + (g) * 128 + cl + n * 16 + e))
                const f32x2v wu0 = CWL(0, 0), wu1 = CWL(1, 0), wu2 = CWL(2, 0), bu = CWL(3, 0);
                const f32x2v wg0 = CWL(0, 1), wg1 = CWL(1, 1), wg2 = CWL(2, 1), bg = CWL(3, 1);
#undef CWL
#pragma unroll
                for (int ai = 0; ai < 2; ++ai) {
                    const int ps = (ai * 2 + wr) ? (ai * 2 + wr - 1) : 0;
                    const PG8_LAS float* hp = (const PG8_LAS float*)halo + (ps * 2) * 256 + cl + n * 16 + e;
                    const f32x2v hu62 = *(const PG8_LAS f32x2v*)hp, hu63 = *(const PG8_LAS f32x2v*)(hp + 256), hg62 = *(const PG8_LAS f32x2v*)(hp + 128), hg63 = *(const PG8_LAS f32x2v*)(hp + 256 + 128);
                    f32x2v p1u = hu63, p1g = hg63, p2u = fr == 0 ? hu62 : hu63, p2g = fr == 0 ? hg62 : hg63;
#pragma unroll
                    for (int m = 0; m < 4; ++m) {
                        __builtin_amdgcn_sched_barrier(0);
                        f32x2v xu, xg;
                        xu.x = vmul_s(acc[ai][0][m][n][e], rs[ai][m]); xu.y = vmul_s(acc[ai][0][m][n][e + 1], rs[ai][m]); xg.x = vmul_s(acc[ai][1][m][n][e], rs[ai][m]); xg.y = vmul_s(acc[ai][1][m][n][e + 1], rs[ai][m]);
                        f32x2v r1u, r2u, r1g, r2g;
                        r1u.x = dpp_ror1(xu.x); r1u.y = dpp_ror1(xu.y); r2u.x = dpp_ror2(xu.x); r2u.y = dpp_ror2(xu.y);
                        r1g.x = dpp_ror1(xg.x); r1g.y = dpp_ror1(xg.y); r2g.x = dpp_ror2(xg.x); r2g.y = dpp_ror2(xg.y);
                        const f32x2v x1u = fr >= 1 ? r1u : p1u, x2u = fr >= 2 ? r2u : p2u, x1g = fr >= 1 ? r1g : p1g, x2g = fr >= 2 ? r2g : p2g;
                        p1u = r1u; p2u = r2u; p1g = r1g; p2g = r2g;
                        const f32x2v cu = bu + wu0 * x2u + wu1 * x1u + wu2 * xu, cg = bg + wg0 * x2g + wg1 * x1g + wg2 * xg;
                        const float o0 = cg.x * __builtin_amdgcn_rcpf(1.f + __builtin_amdgcn_exp2f(-1.4426950408889634f * cg.x)) * cu.x;
                        const float o1 = cg.y * __builtin_amdgcn_rcpf(1.f + __builtin_amdgcn_exp2f(-1.4426950408889634f * cg.y)) * cu.y;
                        wpk[eh][ai][m] = pk2bf(o0, o1);
                    }
                }
            }
#pragma unroll
            for (int ai = 0; ai < 2; ++ai)
#pragma unroll
                for (int m = 0; m < 4; ++m)
                {
                    u32x2 w; w.x = wpk[0][ai][m]; w.y = wpk[1][ai][m];
                    *(u32x2*)((char*)(act + (size_t)(u.pm * BM + wr * 64 + ai * HALF + m * 16) * DFF + 128 * u.pn + n * 16) + la2) = w; }
        }
    }
};

#ifdef TPROBE
#ifndef TPROBE_PH
#define TPROBE_PH -1
#endif
#define PG8_TP(ph) do { if (TPROBE < 20) break; const unsigned t_ = (unsigned)__builtin_amdgcn_s_memrealtime(); if (wave_s == 0 && lane_id() == 0) { volatile PG8_LAS unsigned* q_ = (volatile PG8_LAS unsigned*)(lds + (163840 - 1024 + 512)); \
        if ((ph) == TPROBE && (TPROBE_PH < 0 || q_[2] == (unsigned)TPROBE_PH)) q_[1] += t_ - q_[0]; q_[0] = t_; } } while (0)
#else
#define PG8_TP(ph) do {} while (0)
#endif
template <class Epi, class Sched, bool ALIGN_EPI = false, bool SP2 = false>
__device__ __forceinline__ void gemm_phase(PG8_LAS unsigned char* lds, const Gemm g, const Sched& S, const Epi& E, const int wave_s) {
    int tid_ = wave_s * 64 + lane_id(); asm volatile("" : "+v"(tid_));
    const int tid = tid_, wid = wave_s, lane = tid & 63, wr = wid >> 2, wc = wid & 3, fr = lane & 15, fq = lane >> 4;
    const int K = g.K, nt = K / BK;
    unsigned voffA[2], voffB[2];
#pragma unroll
    for (int i = 0; i < 2; ++i) { int R, C; stage_rc(tid * 16 + i * 8192, R, C); const int Rb = Epi::PERM ? ((R & ~31) + perm32(R & 31)) : R;
        voffA[i] = (unsigned)(R * K + C) * 2u; voffB[i] = (unsigned)(Rb * K + C) * 2u; }
    const size_t kstep = (size_t)(BK * 2);
    const size_t hstep = (size_t)HALF * K * 2;
    const size_t tstep = 2 * hstep;
    const unsigned ldsw = (unsigned)wid * 1024u;
    const int aoff = lds_byte(wr * 64 + fr, fq * 8), boff = lds_byte(wc * 32 + fr, fq * 8);
#define PG8_SA(b, h) (((b) * 2 + (h)) * HTB)
#define PG8_SB(b, h) ((4 + (b) * 2 + (h)) * HTB)
#define PG8_STAGE(bufoff, gbase, voff) do { _Pragma("unroll") for (int _i = 0; _i < 2; ++_i) \
        __builtin_amdgcn_global_load_lds((const unsigned*)((const char*)(gbase) + (voff)[_i]), (PG8_LAS unsigned*)(lds + (bufoff) + ldsw + _i * 8192), 16, 0, 0); } while (0)
#define PG8_LDA(dst, b, h) do { _Pragma("unroll") for (int m = 0; m < 4; ++m) _Pragma("unroll") for (int k = 0; k < 2; ++k) dst[m][k] = *(const PG8_LAS bf16x8*)(lds + PG8_SA(b, h) + aoff + m * 2048 + k * 1024); } while (0)
#define PG8_LDB(dst, b, h) do { _Pragma("unroll") for (int n = 0; n < 2; ++n) _Pragma("unroll") for (int k = 0; k < 2; ++k) dst[n][k] = *(const PG8_LAS bf16x8*)(lds + PG8_SB(b, h) + boff + n * 2048 + k * 1024); } while (0)
#define PG8_MMA(ai, bj, At, Bt) do { __builtin_amdgcn_s_setprio(1); _Pragma("unroll") for (int m = 0; m < 4; ++m) _Pragma("unroll") for (int n = 0; n < 2; ++n) _Pragma("unroll") for (int k = 0; k < 2; ++k) \
        acc[ai][bj][m][n] = __builtin_amdgcn_mfma_f32_16x16x32_bf16(Bt[n][k], At[m][k], acc[ai][bj][m][n], 0, 0, 0); __builtin_amdgcn_s_setprio(0); } while (0)
#define PG8_WAIT_V(n) asm volatile("s_waitcnt vmcnt(" #n ")" ::: "memory")
#define PG8_WAIT_L(n) asm volatile("s_waitcnt lgkmcnt(" #n ")" ::: "memory")
#define PG8_BAR __builtin_amdgcn_s_barrier()
#define PG8_SCHED __builtin_amdgcn_sched_barrier(0)
    Unit cur, nxt; int ui = 0;
    if (!S.next(0, cur)) return;
    f32x4 acc[2][2][4][2];
#pragma unroll
    for (int a = 0; a < 2; ++a)
#pragma unroll
        for (int b = 0; b < 2; ++b)
#pragma unroll
            for (int m = 0; m < 4; ++m)
#pragma unroll
                for (int n = 0; n < 2; ++n) acc[a][b][m][n] = (f32x4){0.f, 0.f, 0.f, 0.f};
    bf16x8 At[4][2], B0[2][2], B1[2][2];
    const char* cA = (const char*)g.A + (size_t)cur.pm * tstep; const char* cB = (const char*)g.Bt + (size_t)cur.pn * tstep;
    S.a_ready(cur);
    if constexpr (SP2) {
        PG8_STAGE(PG8_SB(0, 0), cB, voffB); PG8_STAGE(PG8_SB(0, 1), cB + hstep, voffB); PG8_STAGE(PG8_SA(0, 0), cA, voffA); PG8_STAGE(PG8_SA(0, 1), cA + hstep, voffA);
        if (wr == 1) PG8_BAR;
        PG8_WAIT_V(2); PG8_BAR;
        PG8_STAGE(PG8_SB(1, 0), cB + kstep, voffB); PG8_STAGE(PG8_SA(1, 0), cA + kstep, voffA); PG8_STAGE(PG8_SB(1, 1), cB + hstep + kstep, voffB);
        PG8_WAIT_V(6); PG8_BAR;
    } else {
        PG8_STAGE(PG8_SB(0, 0), cB, voffB); PG8_STAGE(PG8_SA(0, 0), cA, voffA); PG8_STAGE(PG8_SB(0, 1), cB + hstep, voffB); PG8_STAGE(PG8_SA(0, 1), cA + hstep, voffA);
        if (wr == 1) PG8_BAR;
        PG8_WAIT_V(4); PG8_BAR;
        PG8_STAGE(PG8_SB(1, 0), cB + kstep, voffB); PG8_STAGE(PG8_SA(1, 0), cA + kstep, voffA); PG8_STAGE(PG8_SB(1, 1), cB + hstep + kstep, voffB);
        PG8_WAIT_V(6); PG8_BAR;
    }
    for (;;) {
        const bool has_next = S.next(ui + 1, nxt);
        const char* nA = has_next ? (const char*)g.A + (size_t)nxt.pm * tstep : cA; const char* nB = has_next ? (const char*)g.Bt + (size_t)nxt.pn * tstep : cB;
        for (int t = 0; t < nt; t += 2) {
            const bool last = (t == nt - 2);
            const char* a1 = cA + (size_t)(t + 1) * kstep;
            const char* a2 = last ? nA : cA + (size_t)(t + 2) * kstep; const char* b2 = last ? nB : cB + (size_t)(t + 2) * kstep;
            const char* a3 = a2 + kstep; const char* b3 = b2 + kstep;
            if (last && has_next) S.a_ready(nxt);
            if constexpr (SP2) {
            PG8_LDB(B0, 0, 0); PG8_LDB(B1, 0, 1); PG8_SCHED; PG8_LDA(At, 0, 0); PG8_STAGE(PG8_SA(1, 1), a1 + hstep, voffA);
            PG8_WAIT_V(8); PG8_WAIT_L(0); PG8_BAR; PG8_MMA(0, 0, At, B0); PG8_MMA(0, 1, At, B1); PG8_BAR; PG8_SCHED;
            PG8_LDA(At, 0, 1); PG8_STAGE(PG8_SB(0, 0), b2, voffB); PG8_STAGE(PG8_SB(0, 1), b2 + hstep, voffB); PG8_STAGE(PG8_SA(0, 0), a2, voffA);
            PG8_WAIT_V(8); PG8_WAIT_L(0); PG8_BAR; PG8_MMA(1, 0, At, B0); PG8_MMA(1, 1, At, B1); PG8_BAR; PG8_SCHED;
            PG8_LDB(B0, 1, 0); PG8_LDB(B1, 1, 1); PG8_SCHED; PG8_LDA(At, 1, 0); PG8_STAGE(PG8_SA(0, 1), a2 + hstep, voffA);
            PG8_WAIT_V(8); PG8_WAIT_L(0); PG8_BAR; PG8_MMA(0, 0, At, B0); PG8_MMA(0, 1, At, B1); PG8_BAR; PG8_SCHED;
            PG8_LDA(At, 1, 1); PG8_STAGE(PG8_SB(1, 0), b3, voffB); PG8_STAGE(PG8_SB(1, 1), b3 + hstep, voffB); PG8_STAGE(PG8_SA(1, 0), a3, voffA);
            PG8_WAIT_V(8); PG8_WAIT_L(0); PG8_BAR; PG8_MMA(1, 0, At, B0); PG8_MMA(1, 1, At, B1); PG8_BAR; PG8_SCHED;
            } else {
            PG8_LDB(B0, 0, 0); PG8_SCHED; PG8_LDA(At, 0, 0); PG8_STAGE(PG8_SA(1, 1), a1 + hstep, voffA);
            PG8_WAIT_L(8); PG8_BAR; PG8_WAIT_L(0); PG8_MMA(0, 0, At, B0); PG8_BAR; PG8_SCHED;
            PG8_LDB(B1, 0, 1); PG8_STAGE(PG8_SB(0, 0), b2, voffB);
            PG8_BAR; PG8_WAIT_L(0); PG8_MMA(0, 1, At, B1); PG8_BAR;
            PG8_LDA(At, 0, 1); PG8_STAGE(PG8_SA(0, 0), a2, voffA);
            PG8_BAR; PG8_WAIT_L(0); PG8_MMA(1, 0, At, B0); PG8_BAR; PG8_SCHED;
            PG8_STAGE(PG8_SB(0, 1), b2 + hstep, voffB);
            PG8_WAIT_V(6); PG8_BAR; PG8_MMA(1, 1, At, B1); PG8_BAR;
            PG8_LDB(B0, 1, 0); PG8_SCHED; PG8_LDA(At, 1, 0); PG8_STAGE(PG8_SA(0, 1), a2 + hstep, voffA);
            PG8_WAIT_L(8); PG8_BAR; PG8_WAIT_L(0); PG8_MMA(0, 0, At, B0); PG8_BAR; PG8_SCHED;
            PG8_LDB(B1, 1, 1); PG8_STAGE(PG8_SB(1, 0), b3, voffB);
            PG8_BAR; PG8_WAIT_L(0); PG8_MMA(0, 1, At, B1); PG8_BAR;
            PG8_LDA(At, 1, 1); PG8_STAGE(PG8_SA(1, 0), a3, voffA);
            PG8_BAR; PG8_WAIT_L(0); PG8_MMA(1, 0, At, B0); PG8_BAR; PG8_SCHED;
            PG8_STAGE(PG8_SB(1, 1), b3 + hstep, voffB);
            PG8_WAIT_V(6); PG8_BAR; PG8_MMA(1, 1, At, B1); PG8_BAR;
            }
        }
        PG8_TP(49);
        if constexpr (ALIGN_EPI) { if (wr == 0) PG8_BAR; }
        if constexpr (!Epi::AFTER_DRAIN) { E(acc, cur, wr, wc, fr, fq); S.done(cur); }
        PG8_TP(50);
        if (!has_next) break;
#pragma unroll
        for (int a = 0; a < 2; ++a)
#pragma unroll
            for (int b = 0; b < 2; ++b)
#pragma unroll
                for (int m = 0; m < 4; ++m)
#pragma unroll
                    for (int n = 0; n < 2; ++n) acc[a][b][m][n] = (f32x4){0.f, 0.f, 0.f, 0.f};
        cur = nxt; cA = nA; cB = nB; ++ui;
        if constexpr (ALIGN_EPI) { if (wr == 1) PG8_BAR; }
    }
    PG8_WAIT_V(0);
    if constexpr (!ALIGN_EPI) { if (wr == 0) PG8_BAR; }
    PG8_BAR;
    if constexpr (Epi::AFTER_DRAIN) { E.fused(acc, cur, wr, wc, fr, fq, lds, wid, lane); S.done(cur); }
#undef PG8_SA
#undef PG8_SB
#undef PG8_STAGE
#undef PG8_LDA
#undef PG8_LDB
#undef PG8_MMA
#undef PG8_WAIT_V
#undef PG8_WAIT_L
#undef PG8_BAR
#undef PG8_SCHED
}
}
#include <hip/hip_bf16.h>
#include <cmath>
namespace attn_body {
using bf16=__hip_bfloat16;
using bf16x8=__attribute__((ext_vector_type(8)))short;
using s16x4=__attribute__((ext_vector_type(4)))short;
using f32x16=__attribute__((ext_vector_type(16)))float;
using u32x4=__attribute__((ext_vector_type(4)))unsigned;
constexpr int BATCH=8,NHEAD=8,SEQ=2048,D=64,PITCH=3584,OPITCH=1024,LEADROW=16384,VK=2176;
constexpr int NW=8,QBLK=32,QB=QBLK*NW,KVBLK=64,NQB=SEQ/QB;
constexpr int ATTN_UNIT_ROWS=QB;
__device__ __forceinline__ int crow(int r,int hi){return (r&3)+8*(r>>2)+4*hi;}
#define SBAR() __builtin_amdgcn_sched_barrier(0)
__device__ __forceinline__ void cmask(f32x16&p0,f32x16&p1,int jb,int qrel,int hi){
  const float NEG=-INFINITY; int kb=64*jb+4*hi;
  #pragma unroll
  for(int r=0;r<16;++r){int kv=kb+(r&3)+8*(r>>2); if(kv>qrel)p0[r]=NEG; if(kv+32>qrel)p1[r]=NEG;}
}

constexpr int NSLOT=3, SLOTB=8192;
constexpr int LDS_K=0, LDS_V=NSLOT*SLOTB, LDS_WS=2*NSLOT*SLOTB, LDS_OST=LDS_WS+NW*64*4, LDS_C2=LDS_OST+NW*4096, LDS_BYTES=LDS_C2+VK*4;
constexpr float C2=0.125f*1.4426950408889634f;
__device__ __forceinline__ void glds16(const void*gsrc,unsigned lds_dst){unsigned keep;
  asm volatile("s_mov_b32 %0, m0\n\ts_mov_b32 m0, %2\n\ts_nop 0\n\tglobal_load_lds_dwordx4 %1, off\n\ts_mov_b32 m0, %0":"=&s"(keep):"v"(gsrc),"s"(lds_dst):"memory");}
__device__ __forceinline__ float max3f(float a,float b,float c){float r;asm("v_max3_f32 %0, %1, %2, %3":"=v"(r):"v"(a),"v"(b),"v"(c));return r;}
__device__ __forceinline__ float max2f(float a,float b){float r;asm("v_max_f32_e32 %0, %1, %2":"=v"(r):"v"(a),"v"(b));return r;}
__device__ __forceinline__ float fadd_s(float a,float b){float r;asm("v_add_f32_e32 %0, %1, %2":"=v"(r):"v"(a),"v"(b));return r;}
__device__ __forceinline__ float fsub_s(float a,float b){float r;asm("v_sub_f32_e32 %0, %1, %2":"=v"(r):"v"(a),"v"(b));return r;}
typedef float f32x2_t __attribute__((ext_vector_type(2))); typedef __bf16 bf16x2_t __attribute__((ext_vector_type(2)));
__device__ __forceinline__ unsigned cvtpk_s(float lo,float hi){f32x2_t v={lo,hi};bf16x2_t b=__builtin_convertvector(v,bf16x2_t);return __builtin_bit_cast(unsigned,b);}
#define WAIT_BAR(N) asm volatile("s_waitcnt vmcnt(" #N ") lgkmcnt(0)\n\ts_barrier":::"memory")

__device__ __forceinline__ void qkt(f32x16&p0,f32x16&p1,const char*Kslot,const bf16x8*qr,int r32,int hi){
  const char*kb=Kslot+hi*1024+r32*16;
  #pragma unroll
  for(int d0=0;d0<4;++d0){
    const bf16x8 b0=*reinterpret_cast<const bf16x8*>(kb+d0*2048);
    const bf16x8 b1=*reinterpret_cast<const bf16x8*>(kb+d0*2048+512);
    p0=__builtin_amdgcn_mfma_f32_32x32x16_bf16(b0,qr[d0],p0,0,0,0);p1=__builtin_amdgcn_mfma_f32_32x32x16_bf16(b1,qr[d0],p1,0,0,0);}
}
typedef __attribute__((address_space(3))) const char* lds_cptr;
typedef short v4i16_t __attribute__((ext_vector_type(4)));
__device__ __forceinline__ void kload8(bf16x8*kf,lds_cptr kp){
  kf[0]=*(const __attribute__((address_space(3))) bf16x8*)(kp);      kf[1]=*(const __attribute__((address_space(3))) bf16x8*)(kp+512);
  kf[2]=*(const __attribute__((address_space(3))) bf16x8*)(kp+2048); kf[3]=*(const __attribute__((address_space(3))) bf16x8*)(kp+2560);
  kf[4]=*(const __attribute__((address_space(3))) bf16x8*)(kp+4096); kf[5]=*(const __attribute__((address_space(3))) bf16x8*)(kp+4608);
  kf[6]=*(const __attribute__((address_space(3))) bf16x8*)(kp+6144); kf[7]=*(const __attribute__((address_space(3))) bf16x8*)(kp+6656);
}
__device__ __forceinline__ void kload2(bf16x8*kf,lds_cptr kp,int j){ kf[2*j]=*(const __attribute__((address_space(3))) bf16x8*)(kp+j*2048); kf[2*j+1]=*(const __attribute__((address_space(3))) bf16x8*)(kp+j*2048+512); }
__device__ __forceinline__ s16x4 vtr(lds_cptr p){ return __builtin_bit_cast(s16x4,__builtin_amdgcn_ds_read_tr16_b64_v4i16((__attribute__((address_space(3))) v4i16_t*)p)); }
__device__ __forceinline__ float rowmax(const f32x16&p0,const f32x16&p1){
  float a=max3f(p0[0],p0[1],p1[0]),b=max3f(p0[2],p0[3],p1[1]);a=max3f(a,p1[2],p1[3]);
  #pragma unroll
  for(int r=4;r<16;r+=4){a=max3f(a,p0[r],p0[r+1]);b=max3f(b,p0[r+2],p0[r+3]);a=max3f(a,p1[r],p1[r+1]);b=max3f(b,p1[r+2],p1[r+3]);}
  const float m=max2f(a,b);
  auto rr=__builtin_amdgcn_permlane32_swap(__float_as_uint(m),__float_as_uint(m),false,false);
  return max2f(__uint_as_float(rr[0]),__uint_as_float(rr[1]));
}
__device__ __forceinline__ void pv(f32x16*o,int vb,bf16x8 pa0,bf16x8 pa1,bf16x8 pa2,bf16x8 pa3){
  #pragma unroll
  for(int d0=0;d0<2;++d0){s16x4 lo[4],hi[4];
    #pragma unroll
    for(int ks=0;ks<4;++ks){
      asm volatile("ds_read_b64_tr_b16 %0,%1 offset:%c2":"=&v"(lo[ks]):"v"(vb),"i"(d0*4096+ks*1024):"memory");
      asm volatile("ds_read_b64_tr_b16 %0,%1 offset:%c2":"=&v"(hi[ks]):"v"(vb),"i"(d0*4096+ks*1024+512):"memory");}
    asm volatile("s_waitcnt lgkmcnt(0)":::"memory");SBAR();
    #define PK(k) (bf16x8){lo[k][0],lo[k][1],lo[k][2],lo[k][3],hi[k][0],hi[k][1],hi[k][2],hi[k][3]}
    o[d0]=__builtin_amdgcn_mfma_f32_32x32x16_bf16(pa0,PK(0),o[d0],0,0,0);
    o[d0]=__builtin_amdgcn_mfma_f32_32x32x16_bf16(pa1,PK(1),o[d0],0,0,0);
    o[d0]=__builtin_amdgcn_mfma_f32_32x32x16_bf16(pa2,PK(2),o[d0],0,0,0);
    o[d0]=__builtin_amdgcn_mfma_f32_32x32x16_bf16(pa3,PK(3),o[d0],0,0,0);
    #undef PK
  }
}

#ifndef ATTN_STORE16
#define ATTN_STORE16(p,v) (*(u32x4*)(p)=(v))
#endif
template<int THRL> __device__ __forceinline__ void attn_unit(int b,int h,int qb,const bf16*Q,const bf16*__restrict__ K,const bf16*__restrict__ V,const bf16*__restrict__ OG,const float*__restrict__ c2v,bf16*O,char*shm,const int wave_s,const bool stage_c2=true){
  int tid_=wave_s*64+lane_id(); asm volatile("":"+v"(tid_));
  const int tid=tid_,lane=tid&63,r32=lane&31,hi=lane>>5; const int wid=wave_s;
  const long rowbase=(long)b*SEQ; const int q0=qb*QB;
  const bf16*Qw=Q+(rowbase+q0+wid*QBLK)*PITCH+h*D;
  const bf16*Kh=K+(rowbase-2*KVBLK)*PITCH+h*D,*Vh=V+(rowbase-2*KVBLK)*PITCH+h*D;
  const bf16*KhL=K+(long)LEADROW*PITCH+h*D,*VhL=V+(long)LEADROW*PITCH+h*D;
  const unsigned lds0=(unsigned)(uintptr_t)shm;
  float*wsf=(float*)(shm+LDS_WS)+wid*64;
  const bf16*ksrc=Kh+(long)lane*PITCH+wid*8,*ksrcL=KhL+(long)lane*PITCH+wid*8;
  const bf16*vsrc=Vh+(long)(16*(wid&3)+(lane>>2))*PITCH+(wid>>2)*32+(lane&3)*8,*vsrcL=VhL+(long)(16*(wid&3)+(lane>>2))*PITCH+(wid>>2)*32+(lane&3)*8;
  const unsigned kdst=lds0+LDS_K+wid*1024, vdst=lds0+LDS_V+wid*1024;
  #define DMA_K(t,slot) glds16(((t)<2?ksrcL:ksrc)+(long)(t)*KVBLK*PITCH,(unsigned)__builtin_amdgcn_readfirstlane(kdst+(slot)))
  #define DMA_V(t,slot) glds16(((t)<2?vsrcL:vsrc)+(long)(t)*KVBLK*PITCH,(unsigned)__builtin_amdgcn_readfirstlane(vdst+(slot)))
  const int vb0=(int)(lds0+LDS_V)+((lane>>4)&1)*32+(lane&3)*8+(4*hi+((lane&15)>>2))*64;
  const char*Kbase=shm+LDS_K; bf16x8 kf[8];
  const lds_cptr shm3=(lds_cptr)shm; const lds_cptr kp0=shm3+LDS_K+hi*1024+r32*16; const lds_cptr vp0=shm3+LDS_V+((lane>>4)&1)*32+(lane&3)*8+(4*hi+((lane&15)>>2))*64;
  const int NT=(q0+QB)/KVBLK+2;
  if(stage_c2){ __attribute__((address_space(3))) float*negc_w=(__attribute__((address_space(3))) float*)((lds_cptr)shm+LDS_C2); const float*cs=c2v+(long)(b*NHEAD+h)*VK;
    float cv_[5];
    _Pragma("unroll") for(int i_=0;i_<5;++i_){const int i=tid+i_*NW*64; cv_[i_]=i<NT*KVBLK?cs[i]:0.f;}
    _Pragma("unroll") for(int i_=0;i_<5;++i_){const int i=tid+i_*NW*64; if(i<NT*KVBLK)negc_w[i]=-cv_[i_];} }
  const __attribute__((address_space(3))) float* negc3=(const __attribute__((address_space(3))) float*)((lds_cptr)shm+LDS_C2)+4*hi;
  typedef float f32x4_t __attribute__((ext_vector_type(4)));
  #define NEGC(t,i) (*(const __attribute__((address_space(3))) f32x4_t*)(negc3+64*(t)+(((i)>>2)*32)+8*((i)&3)))
  DMA_K(0,0);DMA_V(0,0);DMA_K(1,SLOTB);
  bf16x8 qr[4];
  #pragma unroll
  for(int d0=0;d0<4;++d0)qr[d0]=*reinterpret_cast<const bf16x8*>(&Qw[(long)r32*PITCH+d0*16+hi*8]);
  float mhat=0.f,l_reg=0.f;f32x16 o[2];o[0]=f32x16{};o[1]=f32x16{};
  const int qrel=wid*QBLK+r32;
  #define CMASK(P0,P1,t) do{int jb_=(t)-(NT-4); if(jb_>=0)cmask(P0,P1,jb_,qrel,hi);}while(0)
  bool resc=false;
  #define START(P0,P1) do{ const float rm=rowmax(P0,P1); resc=false; \
    { const float dl=rm; mhat=fadd_s(mhat,dl); \
      _Pragma("unroll") for(int r=0;r<16;++r){P0[r]=fsub_s(P0[r],dl);P1[r]=fsub_s(P1[r],dl);} } \
    _Pragma("unroll") for(int r=0;r<16;++r)P0[r]=__builtin_amdgcn_exp2f(P0[r]); }while(0)
  #define RESC() do{ if(resc){ asm volatile("s_waitcnt lgkmcnt(0)":::"memory"); \
      _Pragma("unroll") for(int d_=0;d_<2;++d_) _Pragma("unroll") for(int r=0;r<16;++r)o[d_][r]*=wsf[crow(r,hi)]; } }while(0)
  f32x16 pA0,pA1,pB0,pB1;
  int sl_prev=0,sl_cur=0,sl_next=SLOTB;
  #define ROT() do{sl_prev=sl_cur;sl_cur=sl_next;sl_next=(sl_next==(NSLOT-1)*SLOTB)?0:sl_next+SLOTB;}while(0)
  DMA_K(2,2*SLOTB);
  WAIT_BAR(3);
  #define FILLT(P0,P1,t) do{ _Pragma("unroll") for(int i_=0;i_<4;++i_){ const f32x4_t a_=NEGC(t,i_),b_=NEGC(t,4+i_); \
      P0[4*i_]=a_[0]-mhat;P0[4*i_+1]=a_[1]-mhat;P0[4*i_+2]=a_[2]-mhat;P0[4*i_+3]=a_[3]-mhat; P1[4*i_]=b_[0]-mhat;P1[4*i_+1]=b_[1]-mhat;P1[4*i_+2]=b_[2]-mhat;P1[4*i_+3]=b_[3]-mhat; } }while(0)
  FILLT(pA0,pA1,0);
  qkt(pA0,pA1,Kbase,qr,r32,hi);asm volatile("s_nop 15\n\ts_nop 7":"+v"(pA0),"+v"(pA1));CMASK(pA0,pA1,0);
  START(pA0,pA1);
  FILLT(pB0,pB1,1);
  _Pragma("unroll") for(int r=0;r<16;++r)pA1[r]=__builtin_amdgcn_exp2f(pA1[r]);
  WAIT_BAR(0);
  DMA_K(3,0);DMA_V(1,SLOTB);
  ROT();
  kload8(kf,kp0+sl_cur);
  WAIT_BAR(2);
  s16x4 vlo[8],vhi[8]; u32x4 pw0,pw1,pw2,pw3;
  #define PKW(P,B) cvtpk_s(P[B],P[B+1])
  #define PAF(k) __builtin_bit_cast(bf16x8,pw##k)
  #define VFR(i) (bf16x8){vlo[i][0],vlo[i][1],vlo[i][2],vlo[i][3],vhi[i][0],vhi[i][1],vhi[i][2],vhi[i][3]}
  #define PIN(x) asm volatile("":"+v"(x))
  #define MX3(a,b,c) __builtin_fmaxf(__builtin_fmaxf((a),(b)),(c))
  #define GAPA(MF,A0,A1,A2,A3,W0,W1,PW) do{ MF; sacc+=A0; sacc+=A1; sacc+=A2; sacc+=A3; PIN(sacc); W0; W1; PIN(PW); SBAR(); }while(0)
  #define EX(v) __builtin_amdgcn_exp2f(v)
  #define GAPB(MF,X,B,FP,FB,I,t,GF) do{ MF; X[B]=EX(X[B]); X[B+1]=EX(X[B+1]); X[B+2]=EX(X[B+2]); X[B+3]=EX(X[B+3]); \
      if(GF){ FP[FB]=fsub_s(cn_[0],mhat); FP[FB+1]=fsub_s(cn_[1],mhat); FP[FB+2]=fsub_s(cn_[2],mhat); FP[FB+3]=fsub_s(cn_[3],mhat); PIN(FP); if((I)<7){cn_=NEGC((t)+1,(I)+1);} } \
      PIN(X); SBAR(); }while(0)
  #define VRD(i) do{ vlo[i]=vtr(vp_+(((i)>>2)*4096+((i)&3)*1024)); vhi[i]=vtr(vp_+(((i)>>2)*4096+((i)&3)*1024+512)); }while(0)
  #define KRD(G,j) do{ if(G){ kload2(kf,kp0+sl_next,j); SBAR(); } }while(0)
  #define STEP(C0,C1,P0,P1,t,GK,GV,GL) do{ SBAR(); \
    const lds_cptr vp_=vp0+sl_prev; \
    VRD(0); SBAR(); float sacc=(P0[0]+P0[1]); \
    GAPA(C0=__builtin_amdgcn_mfma_f32_32x32x16_bf16(kf[0],qr[0],C0,0,0,0), P0[2],P0[3],P0[4],P0[5],     pw0[0]=PKW(P0,0), pw0[1]=PKW(P0,2), pw0); \
    VRD(4); SBAR(); GAPA(C1=__builtin_amdgcn_mfma_f32_32x32x16_bf16(kf[1],qr[0],C1,0,0,0), P0[6],P0[7],P0[8],P0[9],     pw0[2]=PKW(P0,4), pw0[3]=PKW(P0,6), pw0); \
    VRD(1); SBAR(); GAPA(C0=__builtin_amdgcn_mfma_f32_32x32x16_bf16(kf[2],qr[1],C0,0,0,0),   P0[10],P0[11],P0[12],P0[13], pw1[0]=PKW(P0,8), pw1[1]=PKW(P0,10), pw1); \
    VRD(5); SBAR(); GAPA(C1=__builtin_amdgcn_mfma_f32_32x32x16_bf16(kf[3],qr[1],C1,0,0,0),   P0[14],P0[15],P1[0],P1[1],   pw1[2]=PKW(P0,12),pw1[3]=PKW(P0,14), pw1); \
    VRD(2); SBAR(); GAPA(C0=__builtin_amdgcn_mfma_f32_32x32x16_bf16(kf[4],qr[2],C0,0,0,0),   P1[2],P1[3],P1[4],P1[5],     pw2[0]=PKW(P1,0), pw2[1]=PKW(P1,2), pw2); \
    VRD(6); SBAR(); GAPA(C1=__builtin_amdgcn_mfma_f32_32x32x16_bf16(kf[5],qr[2],C1,0,0,0),   P1[6],P1[7],P1[8],P1[9],     pw2[2]=PKW(P1,4), pw2[3]=PKW(P1,6), pw2); \
    VRD(3); SBAR(); GAPA(C0=__builtin_amdgcn_mfma_f32_32x32x16_bf16(kf[6],qr[3],C0,0,0,0),   P1[10],P1[11],P1[12],P1[13], pw3[0]=PKW(P1,8), pw3[1]=PKW(P1,10), pw3); \
    VRD(7); SBAR(); GAPA(C1=__builtin_amdgcn_mfma_f32_32x32x16_bf16(kf[7],qr[3],C1,0,0,0),   P1[14],P1[15],0.f,0.f,       pw3[2]=PKW(P1,12),pw3[3]=PKW(P1,14), pw3); \
    l_reg+=sacc; \
    if(GK){DMA_K((t)+3,sl_cur);} if(GV){DMA_V((t)+1,sl_next);} \
    CMASK(C0,C1,t); \
    { float a=MX3(C0[0],C0[1],C1[0]),b=MX3(C0[2],C0[3],C1[1]); a=MX3(a,C1[2],C1[3]); \
      _Pragma("unroll") for(int r=4;r<16;r+=4){a=MX3(a,C0[r],C0[r+1]);b=MX3(b,C0[r+2],C0[r+3]);a=MX3(a,C1[r],C1[r+1]);b=MX3(b,C1[r+2],C1[r+3]);} \
      float rm=__builtin_fmaxf(a,b); { auto rr=__builtin_amdgcn_permlane32_swap(__float_as_uint(rm),__float_as_uint(rm),false,false); rm=__builtin_fmaxf(__uint_as_float(rr[0]),__uint_as_float(rr[1])); } \
      resc=false; \
      if(__builtin_expect(__any(rm>(float)THRL),0)){ const float dl=__builtin_fmaxf(rm,0.f); mhat+=dl; \
        _Pragma("unroll") for(int r=0;r<16;++r){C0[r]-=dl;C1[r]-=dl;} \
        const float f=__builtin_amdgcn_exp2f(-dl); l_reg*=f; if(hi==0)wsf[r32]=f; resc=true; } } \
    f32x4_t cn_=(f32x4_t){0.f,0.f,0.f,0.f}; if(GL){cn_=NEGC((t)+1,0);} \
    SBAR(); \
    GAPB(o[0]=__builtin_amdgcn_mfma_f32_32x32x16_bf16(PAF(0),VFR(0),o[0],0,0,0), C0,0,P0,0,0,t,GL); \
    GAPB(o[1]=__builtin_amdgcn_mfma_f32_32x32x16_bf16(PAF(0),VFR(4),o[1],0,0,0), C0,4,P0,4,1,t,GL); \
    KRD(GL,0); GAPB(o[0]=__builtin_amdgcn_mfma_f32_32x32x16_bf16(PAF(1),VFR(1),o[0],0,0,0), C0,8,P0,8,2,t,GL); \
    KRD(GL,1); GAPB(o[1]=__builtin_amdgcn_mfma_f32_32x32x16_bf16(PAF(1),VFR(5),o[1],0,0,0), C0,12,P0,12,3,t,GL); \
    KRD(GL,2); GAPB(o[0]=__builtin_amdgcn_mfma_f32_32x32x16_bf16(PAF(2),VFR(2),o[0],0,0,0), C1,0,P1,0,4,t,GL); \
    KRD(GL,3); GAPB(o[1]=__builtin_amdgcn_mfma_f32_32x32x16_bf16(PAF(2),VFR(6),o[1],0,0,0), C1,4,P1,4,5,t,GL); \
    GAPB(o[0]=__builtin_amdgcn_mfma_f32_32x32x16_bf16(PAF(3),VFR(3),o[0],0,0,0), C1,8,P1,8,6,t,GL); \
    GAPB(o[1]=__builtin_amdgcn_mfma_f32_32x32x16_bf16(PAF(3),VFR(7),o[1],0,0,0), C1,12,P1,12,7,t,GL); \
    }while(0)
  int t=1;
  #undef CMASK
  #define CMASK(P0,P1,t) do{}while(0)
  for(;t+5<NT;t+=2){
    STEP(pB0,pB1,pA0,pA1,t,true,true,true);     WAIT_BAR(2); RESC(); ROT();
    STEP(pA0,pA1,pB0,pB1,t+1,true,true,true);   WAIT_BAR(2); RESC(); ROT();
  }
  #undef CMASK
  #define CMASK(P0,P1,t) do{int jb_=(t)-(NT-4); if(jb_>=0)cmask(P0,P1,jb_,qrel,hi);}while(0)
  #define ENDW(tt) do{ if((tt)+3<NT){WAIT_BAR(2);} else if((tt)+2<NT){WAIT_BAR(1);} else {WAIT_BAR(0);} }while(0)
  for(;t+1<NT;t+=2){
    STEP(pB0,pB1,pA0,pA1,t,(t+3<NT),(t+1<NT),(t+1<NT));       ENDW(t);   RESC(); ROT();
    STEP(pA0,pA1,pB0,pB1,t+1,(t+4<NT),(t+2<NT),(t+2<NT));     ENDW(t+1); RESC(); ROT();
  }
  STEP(pB0,pB1,pA0,pA1,NT-1,false,false,false); RESC();
  { float sacc=pB0[0]+pB0[1]; _Pragma("unroll") for(int r=2;r<16;++r)sacc+=pB0[r]; _Pragma("unroll") for(int r=0;r<16;++r)sacc+=pB1[r]; l_reg+=sacc;
    pw0=(u32x4){PKW(pB0,0),PKW(pB0,2),PKW(pB0,4),PKW(pB0,6)};pw1=(u32x4){PKW(pB0,8),PKW(pB0,10),PKW(pB0,12),PKW(pB0,14)};pw2=(u32x4){PKW(pB1,0),PKW(pB1,2),PKW(pB1,4),PKW(pB1,6)};pw3=(u32x4){PKW(pB1,8),PKW(pB1,10),PKW(pB1,12),PKW(pB1,14)};
    SBAR(); pv(o,vb0+sl_cur,PAF(0),PAF(1),PAF(2),PAF(3)); }
  #undef PKW
  #undef PAF
  #undef VFR
  #undef PIN
  #undef MX3
  #undef GAPA
  #undef GAPB
  #undef EX
  #undef VRD
  #undef KRD
  #undef STEP
  #undef ENDW
  {auto rr=__builtin_amdgcn_permlane32_swap(__float_as_uint(l_reg),__float_as_uint(l_reg),false,false);l_reg=__uint_as_float(rr[0])+__uint_as_float(rr[1]);}
  if(hi==0)wsf[32+r32]=l_reg;asm volatile("s_waitcnt lgkmcnt(0)":::"memory");
  float rli[16];
  #pragma unroll
  for(int r=0;r<16;++r)rli[r]=__builtin_amdgcn_rcpf(wsf[32+crow(r,hi)]);
  bf16*Ow=O+(rowbase+q0+wid*QBLK)*OPITCH+h*D; const bf16*Gw=OG+(rowbase+q0+wid*QBLK)*PITCH+h*D;
  u32x4 gg[4];
  #pragma unroll
  for(int i=0;i<4;++i){const int row=i*8+(lane>>3),ch=lane&7; gg[i]=*(const u32x4*)(Gw+(long)row*PITCH+ch*8);}
  { bf16*stg=(bf16*)(shm+LDS_OST)+wid*2048;
    #pragma unroll
    for(int r=0;r<16;++r){const int orow=crow(r,hi);
      #pragma unroll
      for(int d0=0;d0<2;++d0)stg[orow*64+d0*32+r32]=__float2bfloat16(o[d0][r]*rli[r]);}
    asm volatile("s_waitcnt lgkmcnt(0)":::"memory");
    #pragma unroll
    for(int i=0;i<4;++i){const int row=i*8+(lane>>3),ch=lane&7; u32x4 v=*(const u32x4*)(stg+row*64+ch*8);
      #pragma unroll
      for(int w=0;w<4;++w){ const float o0=__uint_as_float(v[w]<<16),o1=__uint_as_float(v[w]&0xffff0000u),g0=__uint_as_float(gg[i][w]<<16),g1=__uint_as_float(gg[i][w]&0xffff0000u);
        v[w]=cvtpk_s(o0*__builtin_amdgcn_rcpf(1.f+__builtin_amdgcn_exp2f(-1.4426950408889634f*g0)),o1*__builtin_amdgcn_rcpf(1.f+__builtin_amdgcn_exp2f(-1.4426950408889634f*g1))); }
      ATTN_STORE16(Ow+(long)row*OPITCH+ch*8,v);} }
  asm volatile("s_waitcnt lgkmcnt(0)\n\ts_barrier":::"memory");
  #undef DMA_K
  #undef NEGC
  #undef FILLT
  #undef DMA_V
  #undef CMASK
  #undef START
  #undef RESC
  #undef ROT
}
constexpr int ATTN_LDS_BYTES=LDS_BYTES;
struct AttnTensors { const bf16* Q; const bf16* K; const bf16* V; const bf16* OG; const float* c2v; bf16* O; };
struct AttnUnit { int bh; int qb; };
struct StaticOrder {
  int vcu, G, blk;
  __device__ __forceinline__ explicit StaticOrder(int grid,int block):vcu((grid%8==0)?(block%8)*(grid/8)+block/8:block),G(grid),blk(block){}
  __device__ __forceinline__ bool next(int i,AttnUnit&u)const{
    if(G==256){ if(blk<64){ if(i>=1)return false; u.bh=blk; u.qb=0; return true; } const int j=blk-64,g=j>>6; u.bh=j&63;
      if(g==0){ if(i>=2)return false; u.qb=i?3:7; } else if(g==1){ if(i>=2)return false; u.qb=i?4:6; } else { if(i>=3)return false; u.qb=i==0?5:3-i; }
      return true; }
    const int pair=vcu+(i>>1)*G; if(pair>=BATCH*NHEAD*4)return false; const int s=pair&3; u.bh=pair>>2; u.qb=(i&1)?s:7-s; return true; }
  __device__ __forceinline__ void a_ready(const AttnUnit&)const{}
  __device__ __forceinline__ void done(const AttnUnit&)const{}
};
template<class Sched,int THRL=8> __device__ __forceinline__ void attn_phase(char*lds,const AttnTensors&T,const Sched&S,const int wave_s){
  AttnUnit u;
  int pbh=-1,pqb=-1;
  for(int i=0;S.next(i,u);++i){ S.a_ready(u); attn_unit<THRL>(u.bh/NHEAD,u.bh%NHEAD,u.qb,T.Q,T.K,T.V,T.OG,T.c2v,T.O,lds,wave_s,!(u.bh==pbh&&u.qb<=pqb)); if(u.bh!=pbh||u.qb>pqb){pbh=u.bh;pqb=u.qb;} S.done(u); }
}
#undef SBAR
#undef WAIT_BAR
}
#define GAS __attribute__((address_space(1)))
#define LAS __attribute__((address_space(3)))
typedef unsigned short bf16;
typedef unsigned v4u __attribute__((ext_vector_type(4)));
typedef float f32x4 __attribute__((ext_vector_type(4)));
typedef short bf16x8 __attribute__((ext_vector_type(8)));
typedef GAS unsigned gu32;
typedef GAS unsigned long long gu64;
#define RLX_AGENT __ATOMIC_RELAXED, __HIP_MEMORY_SCOPE_AGENT
#define LDS_WAIT() asm volatile("s_waitcnt lgkmcnt(0)" ::: "memory")
#define VM_WAIT() asm volatile("s_waitcnt vmcnt(0)" ::: "memory")
#define XB_TMO      128
#define XB_XCNT(j)  (256  + 64 * (j))
#define XB_XSUB(j)  (1280 + 64 * (j))
#define XB_XGEN(j)  (2304 + 64 * (j))
#define XB_TOP      3328
#define XB_TOPGEN   3392
#define XCD_BAR_WORDS 3456
#define XB_SPIN_CAP (1u << 18)

__device__ __forceinline__ unsigned xb_ld(unsigned* p)              { return __hip_atomic_load(p, __ATOMIC_RELAXED, __HIP_MEMORY_SCOPE_AGENT); }
__device__ __forceinline__ unsigned xb_add(unsigned* p, unsigned v) { return __hip_atomic_fetch_add(p, v, __ATOMIC_RELAXED, __HIP_MEMORY_SCOPE_AGENT); }
__device__ __forceinline__ unsigned xb_xcc_id() { return (unsigned)__builtin_amdgcn_s_getreg((3 << 11) | 20) & 0xFu; }
#define XB_SPIN(cond, bar) do { unsigned _sp = 0; while (cond) { __builtin_amdgcn_s_sleep(1); \
    if ((++_sp & 255u) == 0u) { if (xb_ld(&(bar)[XB_TMO])) break; if (_sp > XB_SPIN_CAP) { atomicAdd(&(bar)[XB_TMO], 1u); break; } } } } while (0)

struct XcdBarrier {
    unsigned* bar; unsigned x;
    volatile LAS unsigned* st;
};

__device__ __forceinline__ XcdBarrier xcd_barrier_post(unsigned* bar, volatile LAS unsigned* st) {
    XcdBarrier b; b.bar = bar; b.x = xb_xcc_id(); b.st = st;
    if (threadIdx.x == 0) (void)xb_add(&bar[XB_XCNT(b.x)], 1u);
    return b;
}
__device__ __forceinline__ void xcd_barrier_complete(unsigned* bar, unsigned x, unsigned& nloc, unsigned& nx) {
    const unsigned G = gridDim.x * gridDim.y * gridDim.z;
    unsigned sum, cnt, mine, sp = 0u;
    for (;;) {
        sum = 0u; cnt = 0u; mine = 0u;
#pragma unroll
        for (unsigned j = 0; j < 16; ++j) { const unsigned c = xb_ld(&bar[XB_XCNT(j)]); sum += c; cnt += (c > 0u) ? 1u : 0u; mine = (j == x) ? c : mine; }
        if (sum == G) break;
        __builtin_amdgcn_s_sleep(1);
        if ((++sp & 255u) == 0u) { if (xb_ld(&bar[XB_TMO])) break; if (sp > XB_SPIN_CAP) { atomicAdd(&bar[XB_TMO], 1u); break; } }
    }
    nloc = mine > 0u ? mine : 1u; nx = cnt > 0u ? cnt : 1u;
}

__device__ __forceinline__ void xcd_barrier(const XcdBarrier& b, const int wave_s) {
    asm volatile("s_waitcnt vmcnt(0)" ::: "memory");
    __syncthreads();
    if (wave_s == 0 && lane_id() == 0) {
        int z0_ = 0; asm volatile("" : "+s"(z0_));
        unsigned* bar = b.bar + z0_;
        __builtin_amdgcn_s_waitcnt(0);
        unsigned nloc = b.st[0], nx = b.st[1];
        if (nloc == 0u) { xcd_barrier_complete(bar, b.x, nloc, nx); b.st[0] = nloc; b.st[1] = nx; }
        const unsigned old = xb_add(&bar[XB_XSUB(b.x)], 1u);
        const unsigned gen = old / nloc;
        if (old + 1u == (gen + 1u) * nloc) {
            __builtin_amdgcn_fence(__ATOMIC_RELEASE, "agent");
            asm volatile("s_waitcnt vmcnt(0)" ::: "memory");
            const unsigned og = xb_add(&bar[XB_TOP], 1u);
            const unsigned tg = og / nx;
            if (og + 1u == (tg + 1u) * nx) xb_add(&bar[XB_TOPGEN], 1u);
            else XB_SPIN(xb_ld(&bar[XB_TOPGEN]) == tg, bar);
            __builtin_amdgcn_fence(__ATOMIC_ACQUIRE, "agent");
            xb_add(&bar[XB_XGEN(b.x)], 1u);
            asm volatile("s_waitcnt vmcnt(0)" ::: "memory");
        } else {
            XB_SPIN(xb_ld(&bar[XB_XGEN(b.x)]) == gen, bar);
            __builtin_amdgcn_fence(__ATOMIC_ACQUIRE, "agent");
            asm volatile("s_waitcnt vmcnt(0)" ::: "memory");
        }
    }
    __syncthreads();
}

constexpr int NWAVES = 8;
constexpr int RING_BYTES = 131072;
constexpr int LDS_BYTES = 163840;
constexpr int LDSCTL_OFF = LDS_BYTES - 1024, MISC_OFF = LDSCTL_OFF + 320;
constexpr int HALO_OFF = RING_BYTES;
constexpr int RSTD_OFF = HALO_OFF + 8192;
static_assert(RSTD_OFF + 6 * 1024 + 4096 <= LDSCTL_OFF, "LDS map");
constexpr int CW_BAR = 4096;

struct Args { const float* in[24]; float* out; unsigned char* ws; };

template <bool AF32, class F>
__device__ __forceinline__ void meta_gemm(const void* A, int lda, const bf16_t* Wt, int N, int K, int bid, int G, int wave, int lane, float* red, const F& f) {
    const int fr = lane & 15, fq = lane >> 4, kw = K / NWAVES;
    for (int cb = bid; cb < N / 16; cb += G) {
        f32x4 acc = (f32x4){0.f, 0.f, 0.f, 0.f}; float ss = 0.f;
        const bf16_t* bp = Wt + (size_t)(cb * 16 + fr) * K + wave * kw + 8 * fq;
#pragma unroll
        for (int k = 0; k < kw; k += 32) {
            bf16x8 a;
            if (AF32) {
                const float* ap = (const float*)A + (size_t)fr * lda + wave * kw + k + 8 * fq;
                const f32x4 a0 = *(const f32x4*)ap, a1 = *(const f32x4*)(ap + 4);
                ss += ((a0.x * a0.x + a0.y * a0.y) + (a0.z * a0.z + a0.w * a0.w)) + ((a1.x * a1.x + a1.y * a1.y) + (a1.z * a1.z + a1.w * a1.w));
                u32x4 w; w.x = pk2bf(a0.x, a0.y); w.y = pk2bf(a0.z, a0.w); w.z = pk2bf(a1.x, a1.y); w.w = pk2bf(a1.z, a1.w);
                a = __builtin_bit_cast(bf16x8, w);
            } else a = *(const bf16x8*)((const bf16_t*)A + (size_t)fr * lda + wave * kw + k + 8 * fq);
            const bf16x8 b = *(const bf16x8*)(bp + k);
            acc = __builtin_amdgcn_mfma_f32_16x16x32_bf16(a, b, acc, 0, 0, 0);
        }
        float* rw = red + (wave * 64 + lane) * 5;
        rw[0] = acc[0]; rw[1] = acc[1]; rw[2] = acc[2]; rw[3] = acc[3]; rw[4] = ss;
        __syncthreads();
        if (wave == 0) {
            f32x4 t = (f32x4){0.f, 0.f, 0.f, 0.f}; float s2 = 0.f;
#pragma unroll
            for (int w = 0; w < NWAVES; ++w) { const float* r_ = red + (w * 64 + lane) * 5; t[0] += r_[0]; t[1] += r_[1]; t[2] += r_[2]; t[3] += r_[3]; s2 += r_[4]; }
            float rstd = 1.f;
            if (AF32) { s2 = add_xor16(s2); s2 = add_xor32(s2); rstd = 1.0f / sqrtf(s2 * (1.f / DM) + 1e-6f); }
#pragma unroll
            for (int r = 0; r < 4; ++r) { const int row = 4 * fq + r; const float rs = AF32 ? __int_as_float(__builtin_amdgcn_ds_bpermute(row << 2, __float_as_int(rstd))) : 1.f; f(row, cb * 16 + fr, t[r] * rs); }
        }
        __syncthreads();
    }
}
struct MEpi1 { bf16_t* p; float* pn;
    __device__ __forceinline__ void operator()(int r, int col, float v) const {
        const int row = MROWS + r; const int g = col >> 9, c_ = col & 255;
        if (g < 7) p[(size_t)row * PBW + (col & ~255) + ((c_ >> 5) & 3) * 64 + (c_ >> 7) * 32 + PERM32(c_ & 31)] = f2bf(v);
        else { const int o = col & 511; if (o < 296) pn[(size_t)row * PNW + o] = v; } } };
struct MEpiRes { float* hm; __device__ __forceinline__ void operator()(int r, int col, float v) const { float* h = hm + r * DM + (col & ~31) + PERM32(col & 31); *h = *h + v; } };
struct MEpi3 { float* rawm;
    __device__ __forceinline__ void operator()(int r, int col, float v) const { const int t = col >> 8, c = col & 255; rawm[(size_t)r * DFF2 + (c < 128 ? 128 * t + c : DFF + 128 * t + (c - 128))] = v; } };

__device__ __forceinline__ void meta_gemm3(const float* hm, const bf16_t* W3, int bid, int G, int wave, int lane, int tid, float* red, float* rug, const float* cw, const float* cb, float* rawm, bf16_t* am) {
    const int fr = lane & 15, fq = lane >> 4; constexpr int kw = DM / NWAVES;
    for (int pr = bid; pr < DFF / 16; pr += G) {
        const int t = pr >> 3, kk = pr & 7, cbu = 16 * t + kk;
        f32x4 au = (f32x4){0.f, 0.f, 0.f, 0.f}, ag = au; float ss = 0.f;
        const bf16_t* bpu = W3 + (size_t)(cbu * 16 + fr) * DM + wave * kw + 8 * fq; const bf16_t* bpg = bpu + (size_t)128 * DM;
#pragma unroll
        for (int k = 0; k < kw; k += 32) {
            const float* ap = hm + (size_t)fr * DM + wave * kw + k + 8 * fq;
            const f32x4 a0 = *(const f32x4*)ap, a1 = *(const f32x4*)(ap + 4);
            ss += ((a0.x * a0.x + a0.y * a0.y) + (a0.z * a0.z + a0.w * a0.w)) + ((a1.x * a1.x + a1.y * a1.y) + (a1.z * a1.z + a1.w * a1.w));
            u32x4 w; w.x = pk2bf(a0.x, a0.y); w.y = pk2bf(a0.z, a0.w); w.z = pk2bf(a1.x, a1.y); w.w = pk2bf(a1.z, a1.w);
            const bf16x8 a = __builtin_bit_cast(bf16x8, w);
            au = __builtin_amdgcn_mfma_f32_16x16x32_bf16(a, *(const bf16x8*)(bpu + k), au, 0, 0, 0);
            ag = __builtin_amdgcn_mfma_f32_16x16x32_bf16(a, *(const bf16x8*)(bpg + k), ag, 0, 0, 0);
        }
        float* rw = red + (wave * 64 + lane) * 9;
        rw[0] = au[0]; rw[1] = au[1]; rw[2] = au[2]; rw[3] = au[3]; rw[4] = ag[0]; rw[5] = ag[1]; rw[6] = ag[2]; rw[7] = ag[3]; rw[8] = ss;
        __syncthreads();
        if (wave == 0) {
            f32x4 tu = (f32x4){0.f, 0.f, 0.f, 0.f}, tg = tu; float s2 = 0.f;
#pragma unroll
            for (int w = 0; w < NWAVES; ++w) { const float* r_ = red + (w * 64 + lane) * 9; tu[0] += r_[0]; tu[1] += r_[1]; tu[2] += r_[2]; tu[3] += r_[3]; tg[0] += r_[4]; tg[1] += r_[5]; tg[2] += r_[6]; tg[3] += r_[7]; s2 += r_[8]; }
            s2 = add_xor16(s2); s2 = add_xor32(s2); const float rstd = 1.0f / sqrtf(s2 * (1.f / DM) + 1e-6f);
#pragma unroll
            for (int r = 0; r < 4; ++r) { const int row = 4 * fq + r; const float rs = __int_as_float(__builtin_amdgcn_ds_bpermute(row << 2, __float_as_int(rstd)));
                const float vu = tu[r] * rs, vg = tg[r] * rs; rug[row * 16 + fr] = vu; rug[256 + row * 16 + fr] = vg;
                if (row >= 14) { rawm[(size_t)row * DFF2 + 128 * t + 16 * kk + fr] = vu; rawm[(size_t)row * DFF2 + DFF + 128 * t + 16 * kk + fr] = vg; } }
        }
        __syncthreads();
        if (tid < 256) {
            const int row = tid >> 4, j = tid & 15, ch = 128 * t + 16 * kk + j;
            const float xu0 = rug[row * 16 + j], xu1 = row >= 1 ? rug[(row - 1) * 16 + j] : 0.f, xu2 = row >= 2 ? rug[(row - 2) * 16 + j] : 0.f;
            const float xg0 = rug[256 + row * 16 + j], xg1 = row >= 1 ? rug[256 + (row - 1) * 16 + j] : 0.f, xg2 = row >= 2 ? rug[256 + (row - 2) * 16 + j] : 0.f;
            const float cu = cb[ch] + cw[ch] * xu2 + cw[DFF2 + ch] * xu1 + cw[2 * DFF2 + ch] * xu0;
            const float cg = cb[DFF + ch] + cw[DFF + ch] * xg2 + cw[DFF2 + DFF + ch] * xg1 + cw[2 * DFF2 + DFF + ch] * xg0;
            am[(size_t)row * DFF + ch] = f2bf(cg * sigmoidf_(cg) * cu);
        }
        __syncthreads();
    }
}

__device__ __forceinline__ void wprep_layer(const float* const* in, int l, unsigned char* ws, int gw, int ngw, int lane, float* scr, int part) {
    unsigned char* wb = ws + WS_W + (size_t)(l & 1) * WL_BYTES;
    constexpr int I1 = (DM / 64) * (N1 / 32), I2 = (DM / 64) * (DM / 32), I3 = (DM / 64) * (DFF2 / 32), I4 = (DFF / 64) * (DM / 32);
    const int n1 = (part & 1) ? I1 : 0, n2 = (part & 2) ? I2 : 0, n3 = (part & 4) ? I3 : 0, n4 = (part & 8) ? I4 : 0;
    for (int it = gw; it < n1 + n2 + n3 + n4; it += ngw) {
        int r = it, mode = 1, K = DM, Nsrc = N_IN, Ndst = N1; const float* W = in[3] + (size_t)l * DM * N_IN; const float* gk = in[2] + l * DM; bf16_t* WT = (bf16_t*)(wb + WO_W1);
        if (r >= n1) { r -= n1; mode = 2; Nsrc = DM; Ndst = DM; W = in[18] + (size_t)l * DM * DM; gk = nullptr; WT = (bf16_t*)(wb + WO_W2);
            if (r >= n2) { r -= n2; mode = 3; Nsrc = DFF2; Ndst = DFF2; W = in[20] + (size_t)l * DM * DFF2; gk = in[19] + l * DM; WT = (bf16_t*)(wb + WO_W3);
                if (r >= n3) { r -= n3; mode = 4; K = DFF; Nsrc = DM; Ndst = DM; W = in[23] + (size_t)l * DFF * DM; gk = nullptr; WT = (bf16_t*)(wb + WO_W4); } } }
        wprep_item(W, gk, WT, K, Nsrc, Ndst, mode, r, scr, lane);
    }
    if (part & 1) {
        bf16_t* lup = (bf16_t*)(wb + WO_LUP);
        const float* wu = in[6] + (size_t)l * 64 * 512; const float* au = in[8] + (size_t)l * 64 * 512; const float* gu = in[9] + (size_t)l * 160 * 512;
        for (int n = gw; n < 512; n += ngw) {
#pragma unroll
            for (int kq = 0; kq < 5; ++kq) { const int k = lane + 64 * kq;
                if (k < 288) lup[n * 288 + k] = f2bf(k < 64 ? wu[k * 512 + n] : (k < 128 ? au[(k - 64) * 512 + n] : gu[(k - 128) * 512 + n])); }
        }
    }
}

struct RwP { const float* mu; const float* w0; const float* w_up; const float* a0; const float* a_up; const float* g_up; };
struct RwS { const float* mu; const float* k_k; const float* k_a; const float* r_k; const float* gn_w; const float* gn_b; };
constexpr int RCH = 8;

__global__ void __launch_bounds__(NWAVES * 64, 2) mk_fwd(Args a) {
    extern __shared__ __attribute__((aligned(16))) unsigned char lds[];
    const int tid0 = threadIdx.x, wave_s = __builtin_amdgcn_readfirstlane(tid0 >> 6);
    const int G0 = gridDim.x, bid0 = blockIdx.x;
    for (int u = tid0; u < (LDS_BYTES - LDSCTL_OFF) / 4; u += NWAVES * 64) ((LAS unsigned*)((LAS unsigned char*)lds + LDSCTL_OFF))[u] = 0u;
    __syncthreads();
    XcdBarrier bar = xcd_barrier_post((unsigned*)(a.ws + WS_CTL) + CW_BAR, (volatile LAS unsigned*)((LAS unsigned char*)lds + MISC_OFF) + 8);
#ifdef TPROBE
#define TP_MARK(ph) do { if ((ph) >= 20 && TPROBE < 20) break;     \
        const unsigned t_ = (unsigned)__builtin_amdgcn_s_memrealtime(); if (wave_s == 0 && lane_id() == 0) { volatile LAS unsigned* q_ = (volatile LAS unsigned*)((LAS unsigned char*)lds + LDSCTL_OFF + 512); \
        if ((ph) == TPROBE) q_[1] += t_ - q_[0]; q_[0] = t_; } } while (0)
#else
#define TP_MARK(ph) do {} while (0)
#endif
#define GRID_BAR() do { int wv_ = wave_s; asm volatile("" : "+s"(wv_)); xcd_barrier(bar, wv_); } while (0)
#define RSTD_TABLE(S) do { pg8::Unit u_; for (int i_ = 0; S.next(i_, u_); ++i_) for (int r_ = tid; r_ < 256; r_ += NWAVES * 64) \
        ((LAS float*)(ldsl + RSTD_OFF))[i_ * 256 + r_] = pg8::row_rstd(ssqp, u_.pm * 256 + r_); __syncthreads(); } while (0)
    TP_MARK(-1);
#define PHASE_IDS() int G_ = G0, bid_ = bid0, wv_ = wave_s; asm volatile("" : "+s"(G_), "+s"(bid_), "+s"(wv_)); int tid = wv_ * 64 + lane_id(); asm volatile("" : "+v"(tid)); \
    const int G = G_, bid = bid_, ngw = G * NWAVES, lane = tid & 63, wave = wv_, gw = bid * NWAVES + wave; (void)lane; (void)gw; (void)ngw
#define PHASE_PTRS(L) int z0_ = 0; asm volatile("" : "+s"(z0_)); const float* const* inq = a.in + z0_; unsigned char* ws = a.ws + z0_; float* out = a.out + z0_; const int lq = (L) + z0_; \
    float* hm = (float*)(ws + WS_HM); float* c2 = (float*)(ws + WS_C2); float* ssqp = (float*)(ws + WS_SSQ); \
    bf16_t* hb = (bf16_t*)(ws + WS_HB); bf16_t* p = (bf16_t*)(ws + WS_P); float* pn = (float*)(ws + WS_PN); bf16_t* y = (bf16_t*)(ws + WS_Y); \
    bf16_t* act = (bf16_t*)(ws + WS_ACT); float* fixb = (float*)(ws + WS_FIX); float* rawm = (float*)(ws + WS_RAWM); \
    const unsigned char* wbuf = ws + WS_W + (size_t)(lq & 1) * WL_BYTES; \
    const bf16_t* W1 = (const bf16_t*)(wbuf + WO_W1); const bf16_t* W2 = (const bf16_t*)(wbuf + WO_W2); const bf16_t* W3 = (const bf16_t*)(wbuf + WO_W3); const bf16_t* W4 = (const bf16_t*)(wbuf + WO_W4); \
    (void)hm; (void)c2; (void)ssqp; (void)hb; (void)p; (void)pn; (void)y; (void)act; (void)fixb; (void)rawm; (void)out; (void)W1; (void)W2; (void)W3; (void)W4
    LAS unsigned char* ldsl = (LAS unsigned char*)lds;

    {
        PHASE_IDS(); PHASE_PTRS(0);
        for (int row = gw; row < RROWS; row += ngw) {
            const f32x4* xr = (const f32x4*)(row < MROWS ? inq[0] + (size_t)row * DM : inq[1] + (size_t)(row - MROWS) * DM) + lane;
            f32x4* hr = (f32x4*)(hm + (size_t)(row < MROWS ? 0 : row - MROWS) * DM) + lane;
            f32x4 v[4]; float s = 0.f;
#pragma unroll
            for (int j = 0; j < 4; ++j) { v[j] = xr[64 * j]; if (row >= MROWS) hr[64 * j] = v[j]; s += (v[j].x * v[j].x + v[j].y * v[j].y) + (v[j].z * v[j].z + v[j].w * v[j].w); }
            s = wave_sum(s);
            if (lane < 16) ssqp[(size_t)row * 16 + lane] = lane == 0 ? s : 0.f;
            u32x2* o8 = (u32x2*)(hb + (size_t)row * DM) + lane;
#pragma unroll
            for (int j = 0; j < 4; ++j) { u32x2 w; w.x = pk2bf(v[j].x, v[j].y); w.y = pk2bf(v[j].z, v[j].w); o8[64 * j] = w; }
        }
    }
    {
        PHASE_IDS(); PHASE_PTRS(0);
        u32x4* z = (u32x4*)(p + (size_t)RROWS * PBW); const unsigned n16 = (unsigned)((16512 - RROWS) * PBW * 2 / 16);
        for (unsigned i = (unsigned)(bid * (NWAVES * 64) + tid); i < n16; i += (unsigned)(G * (NWAVES * 64))) z[i] = (u32x4){0u, 0u, 0u, 0u};
    }
#ifndef PLAIN_LAUNCH
    cg::this_grid().sync();
#endif
    TP_MARK(0);

#pragma unroll 1
    for (int l = -1; l < DEPTH; ++l) {
#pragma unroll 1
      for (int ph = l < 0 ? 1 : 0; ph < (l < 0 ? 2 : 6); ++ph) {
#ifdef TPROBE
        if (wave_s == 0 && lane_id() == 0) ((volatile LAS unsigned*)((LAS unsigned char*)lds + LDSCTL_OFF + 512))[2] = (unsigned)ph;
#endif
        if (ph == 1 || ph == 4)
        {
            PHASE_IDS(); PHASE_PTRS(l);
            if (lq + 1 < DEPTH) {
                const int first = (G == 256 && lq >= 0) ? (ph == 4 ? 128 : 8) : 0, part = lq < 0 ? 15 : (G == 256 ? (ph == 4 ? 6 : 9) : (ph == 4 ? 0 : 15));
                if (bid >= first && part) wprep_layer(inq, lq + 1, ws, gw - first * NWAVES, ngw - first * NWAVES, lane, (float*)(lds + wave * 16384), part);
            }
            __syncthreads();
        }
        if (ph == 0) {
        {
            PHASE_IDS(); PHASE_PTRS(l);
            pg8::Gemm g{hb, W1, MROWS, N1, DM}; pg8::StaticOrder S; S.init(MROWS, N1, G, bid);
            RSTD_TABLE(S);
            pg8::Epi1 E{(const LAS float*)(ldsl + RSTD_OFF), p, pn, inq[16] + lq * 64, inq[17] + lq * 64};
            pg8::gemm_phase<pg8::Epi1, pg8::StaticOrder, true, true>(ldsl, g, S, E, wave);
            meta_gemm<true>(hm, DM, W1, N1, DM, bid, G, wave, lane, (float*)lds, MEpi1{p, pn});
        }
        } else if (ph == 4) {
        {
            PHASE_IDS(); PHASE_PTRS(l);
            const float* cw = inq[21] + (size_t)lq * 3 * DFF2; const float* cb = inq[22] + (size_t)lq * DFF2;
            pg8::Gemm g{hb, W3, MROWS, DFF2, DM}; pg8::StaticOrder S; S.init(MROWS, DFF2, G, bid);
            RSTD_TABLE(S);
            pg8::EpiConv E{(const LAS float*)(ldsl + RSTD_OFF), cw, cb, act, fixb, ldsl + HALO_OFF, (LAS float*)(ldsl + RSTD_OFF + 6 * 1024)};
            pg8::gemm_phase<pg8::EpiConv, pg8::StaticOrder, true, true>(ldsl, g, S, E, wave);
            meta_gemm3(hm, W3, bid, G, wave, lane, tid, (float*)lds, (float*)(lds + 20480), cw, cb, rawm, act + (size_t)MROWS * DFF);
        }
        }
        if (ph == 1 && l >= 0) {
        {
            PHASE_IDS(); PHASE_PTRS(l);
            __syncthreads(); TP_MARK(20);
            {
                const float* mu = inq[4] + lq * 1824;
                const bf16_t* lup = (const bf16_t*)(wbuf + WO_LUP);
                const int h = wave, cg = h * 64 + lane, fr = lane & 15, fq = lane >> 4;
                const float mu_r = mu[cg], mu_k = mu[512 + cg], mu_v = mu[1024 + cg];
                const float w0c = (inq[5] + lq * 512)[cg], a0c = (inq[7] + lq * 512)[cg];
                const float kkc = (inq[10] + lq * 512)[cg], kac = (inq[11] + lq * 512)[cg], rkc = (inq[12] + lq * 512)[cg];
                LAS unsigned char* PNS = ldsl;
                LAS unsigned char* PSW = ldsl + 22528 + wave * 6528;
                LAS unsigned char* LW = ldsl + 74752 + wave * 9216;
                LAS unsigned char* LIN = ldsl + 148480;
                LAS float* MU = (LAS float*)(ldsl + 158720);
                LAS float* TR = (LAS float*)LW; LAS float* LT = (LAS float*)LW; LAS float* LAK = (LAS float*)(LW + 1280);
#define PN_DMA(uu) do { const int c_ = (uu) % NCH, r0_ = rowof((uu) / NCH, 16 * c_), p0_ = prevrow(r0_); \
                    for (int pc_ = wave; pc_ < (p0_ >= 0 ? 22 : 20); pc_ += NWAVES) { \
                        const char* src_ = (pc_ < 20 ? (const char*)(pn + (size_t)r0_ * PNW) + pc_ * 1024 : (const char*)(pn + (size_t)p0_ * PNW) + (pc_ - 20) * 1024) + lane * 16; \
                        __builtin_amdgcn_global_load_lds((const unsigned*)src_, (LAS unsigned*)(PNS + pc_ * 1024), 16, 0, 0); } } while (0)
#define PS_DMA(uu) do { const int c_ = (uu) % NCH, r0_ = rowof((uu) / NCH, 16 * c_), p0_ = prevrow(r0_); int ln_ = lane; asm volatile("" : "+v"(ln_));     \
                    _Pragma("unroll") for (int j_ = 0; j_ < 7; ++j_) { const int s_ = j_ * 8 + (ln_ >> 3); \
                        if (s_ < 51) { const int i_ = s_ / 3, sg_ = s_ - 3 * i_, rw_ = i_ ? r0_ + i_ - 1 : (p0_ >= 0 ? p0_ : r0_); \
                            const char* src_ = (const char*)(p + (size_t)rw_ * PBW) + sg_ * 1024 + wave * 128 + (ln_ & 7) * 16; \
                            __builtin_amdgcn_global_load_lds((const unsigned*)src_, (LAS unsigned*)(PSW + j_ * 1024), 16, 0, 0); } } } while (0)
#define PSV(i, sg) bf2f(((const LAS bf16_t*)PSW)[(3 * (i) + (sg)) * 64 + lane])
                if (tid < 288) MU[tid] = mu[1536 + tid];
                if (bid < NB * NCH) { PN_DMA(bid); PS_DMA(bid); }
                asm volatile("s_waitcnt vmcnt(0)" ::: "memory");
                bf16x8 bw_[2][4], ba_[2][4];
                {   const int fru = lane & 15, fqu = lane >> 4;
#pragma unroll
                    for (int nb = 0; nb < 4; ++nb) { const bf16_t* bp_ = lup + (size_t)(h * 64 + 16 * nb + fru) * 288 + 8 * fqu;
#pragma unroll
                        for (int ks = 0; ks < 2; ++ks) { bw_[ks][nb] = *(const bf16x8*)(bp_ + 32 * ks); ba_[ks][nb] = *(const bf16x8*)(bp_ + 64 + 32 * ks); }
                    } }
                for (int u = bid; u < NB * NCH; u += G) {
                    const int b = u / NCH, c = u % NCH, row0 = rowof(b, 16 * c), prow0 = prevrow(row0);
                    int tidu = tid; asm volatile("" : "+v"(tidu));
                    const int fr = tidu & 15, fq = (tidu >> 4) & 3;
                    bf16x8 bg_[5][4];
                    TP_MARK(27);
                    asm volatile("s_waitcnt lgkmcnt(0)\n\ts_barrier" ::: "memory");
                    {
                        float cur_[9], prv_[9], mu_[9];
#pragma unroll
                        for (int i = 0; i < 9; ++i) { const int e = tidu + 512 * i, ti = e / 288, j = e - 288 * ti;
                            cur_[i] = ((const LAS float*)PNS)[ti * 320 + j]; prv_[i] = ((const LAS float*)PNS)[(ti ? ti - 1 : 16) * 320 + j]; mu_[i] = MU[j]; }
#pragma unroll
                        for (int i = 0; i < 9; ++i) { const int e = tidu + 512 * i, ti = e / 288, j = e - 288 * ti;
                            const float prv = (ti || prow0 >= 0) ? prv_[i] : 0.f, s = cur_[i] + mu_[i] * (prv - cur_[i]);
                            const float ex = __builtin_amdgcn_exp2f((j < 64 ? 2.f * LOG2E : -LOG2E) * s), rc = __builtin_amdgcn_rcpf(1.f + ex);
                            ((LAS bf16_t*)LIN)[ti * 296 + j] = f2bf(j < 64 ? 1.f - 2.f * rc : (j < 128 ? s : rc)); }
                    }
                    {   const int fru = fr, fqu = fq;
#pragma unroll
                        for (int nb = 0; nb < 4; ++nb) { const bf16_t* bp_ = lup + (size_t)(h * 64 + 16 * nb + fru) * 288 + 8 * fqu;
#pragma unroll
                            for (int ks = 0; ks < 5; ++ks) bg_[ks][nb] = *(const bf16x8*)(bp_ + 128 + 32 * ks); } }
                    TP_MARK(28);
                    asm volatile("s_waitcnt lgkmcnt(0)\n\ts_barrier" ::: "memory");
                    if (u + G < NB * NCH) PN_DMA(u + G);
                    TP_MARK(22);
#define LORA_PRE(ZA, KB0, NKS, BF) do { f32x4 acc_[4]; _Pragma("unroll") for (int nb = 0; nb < 4; ++nb) acc_[nb] = (f32x4){0.f, 0.f, 0.f, 0.f}; \
                        _Pragma("unroll") for (int ks = 0; ks < (NKS); ++ks) { const bf16x8 af = *(const LAS bf16x8*)(LIN + fr * 592 + ((KB0) + 32 * ks + 8 * fq) * 2); \
                            _Pragma("unroll") for (int nb = 0; nb < 4; ++nb) acc_[nb] = __builtin_amdgcn_mfma_f32_16x16x32_bf16(af, BF[ks][nb], acc_[nb], 0, 0, 0); } \
                        WAVE_LDS_SYNC(); \
                        _Pragma("unroll") for (int nb = 0; nb < 4; ++nb) _Pragma("unroll") for (int r = 0; r < 4; ++r) TR[(4 * fq + r) * 65 + 16 * nb + fr] = acc_[nb][r]; \
                        WAVE_LDS_SYNC(); \
                        _Pragma("unroll") for (int i = 0; i < 16; ++i) ZA[i] = TR[i * 65 + lane]; } while (0)
                    float zw[16], za[16];
                    LORA_PRE(zw, 0, 2, bw_); LORA_PRE(za, 64, 2, ba_);
                    {
                        float zg[16]; LORA_PRE(zg, 128, 5, bg_); (void)zg;
                        asm volatile("s_waitcnt vmcnt(0)" ::: "memory");
                        {
                            const int ti_ = lane >> 2, pt_ = lane & 3; float gv_[16];
#pragma unroll
                            for (int k_ = 0; k_ < 16; ++k_) gv_[k_] = TR[ti_ * 65 + 16 * pt_ + k_];
                            u32x4 o0_, o1_;
                            o0_.x = pk2bf(gv_[0], gv_[1]); o0_.y = pk2bf(gv_[2], gv_[3]); o0_.z = pk2bf(gv_[4], gv_[5]); o0_.w = pk2bf(gv_[6], gv_[7]);
                            o1_.x = pk2bf(gv_[8], gv_[9]); o1_.y = pk2bf(gv_[10], gv_[11]); o1_.z = pk2bf(gv_[12], gv_[13]); o1_.w = pk2bf(gv_[14], gv_[15]);
                            bf16_t* yp_ = y + (size_t)(row0 + ti_) * DM + h * 64 + 16 * pt_;
                            *(u32x4*)yp_ = o0_; *(u32x4*)(yp_ + 8) = o1_; } }
#undef LORA_PRE
                    WAVE_LDS_SYNC();
                    const int ci = (b * 8 + h) * NCH + c;
                    unsigned char* ra = ws + WS_RA + (size_t)ci * RA_BYTES; unsigned char* rb = (unsigned char*)out + (size_t)ci * RB_BYTES;
                    bf16_t* BV = (bf16_t*)(ws + WS_BV);
                    LAS bf16_t* OA = (LAS bf16_t*)LW; LAS bf16_t* OB = OA + 16 * 72; LAS bf16_t* OK = OB + 16 * 72; LAS bf16_t* OR = OK + 16 * 72;
                    const int cxk = (lane >> 5) * 4 + ((lane >> 2) & 3), jk2 = (((lane >> 4) & 1) * 4 + (lane & 3)) * 2;
                    TP_MARK(23);
                    float atil[16]; unsigned bkB[8], bkK[8], vtp[8];
                    float cumC = 0.f;
#pragma unroll
                    for (int i = 0; i < 16; ++i) { zw[i] = 0.6065306597126334f * __builtin_amdgcn_rcpf(1.f + __builtin_amdgcn_exp2f(-LOG2E * (zw[i] + w0c))); cumC += zw[i]; }
                    float cum = 0.f, gprev = 1.f, rp = 0.f, kp_ = 0.f, vp = 0.f, be = 0.f, ke = 0.f, ve = 0.f, bve = 0.f; unsigned bvp[8];
                    unsigned short prr[17], pkk[17], pvv[17];
#pragma unroll
                    for (int i = 0; i < 17; ++i) { prr[i] = ((const LAS bf16_t*)PSW)[(3 * i) * 64 + lane]; pkk[i] = ((const LAS bf16_t*)PSW)[(3 * i + 1) * 64 + lane]; pvv[i] = ((const LAS bf16_t*)PSW)[(3 * i + 2) * 64 + lane]; }
                    WAVE_LDS_SYNC();
                    if (u + G < NB * NCH) PS_DMA(u + G);
                    rp = bf2f(prr[0]); kp_ = bf2f(pkk[0]); vp = bf2f(pvv[0]);
                    const float hp0 = prow0 >= 0 ? 1.f : 0.f;
#pragma unroll
                    for (int i0 = 0; i0 < 16; i0 += 4) {
                        float rs4[4], vs4[4], alr4[4], kkr4[4], kpr4[4], red[8];
#pragma unroll
                        for (int j = 0; j < 4; ++j) { const int i = i0 + j;
                            const float rc = bf2f(prr[i + 1]), kc = bf2f(pkk[i + 1]), vc = bf2f(pvv[i + 1]);
                            const float hp = i ? 1.f : hp0;
                            const float rs = rc + mu_r * (hp * rp - rc), ks_ = kc + mu_k * (hp * kp_ - kc), vs = vc + mu_v * (hp * vp - vc);
                            rp = rc; kp_ = kc; vp = vc;
                            const float alr = __builtin_amdgcn_rcpf(1.f + __builtin_amdgcn_exp2f(-LOG2E * (za[i] + a0c)));
                            const float kkr = ks_ * kkc, kpr = ks_ * (1.f + (alr - 1.f) * kac);
                            rs4[j] = rs; vs4[j] = vs; alr4[j] = alr; kkr4[j] = kkr; kpr4[j] = kpr; red[2 * j] = kkr * kkr; red[2 * j + 1] = rs * kpr * rkc; }
                        wave_sum_dpp8(red);
#pragma unroll
                        for (int j = 0; j < 4; ++j) { const int i = i0 + j;
                            cum += zw[i];
                            const float kk = kkr4[j] * __builtin_amdgcn_rsqf(fmaxf(red[2 * j], 1e-24f)), bon = red[2 * j + 1], kpr = kpr4[j], vs = vs4[j];
                            const float eg = __builtin_amdgcn_exp2f(LOG2E * cum), gi = __builtin_amdgcn_exp2f(-LOG2E * cum), tail = __builtin_amdgcn_exp2f(LOG2E * (cum - cumC));
                            atil[i] = -kk * gprev;
                            const float bb = kk * alr4[j], rtil = rs4[j] * gi; gprev = gi;
                            OA[i * 72 + lane] = f2bf(atil[i]); OB[i * 72 + lane] = f2bf(bb * eg); OK[i * 72 + lane] = f2bf(kpr * eg); OR[i * 72 + lane] = f2bf(rtil);
                            if (i & 1) { bkB[i >> 1] = pk2bf(be, bb * tail); bkK[i >> 1] = pk2bf(ke, kpr * tail); vtp[i >> 1] = pk2bf(ve, vs); } else { be = bb * tail; ke = kpr * tail; ve = vs; }
                            if (i & 1) bvp[i >> 1] = pk2bf(bve, bon * vs); else bve = bon * vs; }
                    }
                    {
                        ((float*)(rb + 3584))[lane] = gprev;
#pragma unroll
                        for (int q = 0; q < 4; ++q) *(u32x4*)(ra + 4096 + lane * 64 + ((q ^ SWZ4(lane)) << 4)) = (u32x4){bkB[2 * q], bkB[2 * q + 1], bkK[2 * q], bkK[2 * q + 1]};
                        *(u32x4*)(rb + lane * 32) = (u32x4){vtp[0], vtp[1], vtp[2], vtp[3]}; *(u32x4*)(rb + lane * 32 + 16) = (u32x4){vtp[4], vtp[5], vtp[6], vtp[7]};
                    }
                    WAVE_LDS_SYNC();
                    TP_MARK(24);
#define REC_STORE(TILE, DST) do { _Pragma("unroll") for (int hh_ = 0; hh_ < 2; ++hh_) { const int i_ = (lane >> 3) + 8 * hh_, pc_ = lane & 7, c_ = pc_ ^ ((i_ >> 1) & 7), base_ = (c_ >> 2) * 32 + (c_ & 3) * 4; \
                        const u32x2 lo_ = *(const LAS u32x2*)((TILE) + i_ * 72 + base_), hi_ = *(const LAS u32x2*)((TILE) + i_ * 72 + base_ + 16); \
                        *(u32x4*)((DST) + i_ * 128 + pc_ * 16) = (u32x4){lo_.x, lo_.y, hi_.x, hi_.y}; } } while (0)
                    REC_STORE(OR, ra + 2048);
                    {
                        f32x4 dab = (f32x4){0.f, 0.f, 0.f, 0.f}, dak = dab, drb = dab, drk = dab;
#pragma unroll
                        for (int ks = 0; ks < 2; ++ks) {
                            const int off = fr * 72 + 32 * ks + 8 * fq;
                            const bf16x8 fa = *(const LAS bf16x8*)(OA + off), fb = *(const LAS bf16x8*)(OB + off), fk = *(const LAS bf16x8*)(OK + off), frr = *(const LAS bf16x8*)(OR + off);
                            dab = __builtin_amdgcn_mfma_f32_16x16x32_bf16(fa, fb, dab, 0, 0, 0); dak = __builtin_amdgcn_mfma_f32_16x16x32_bf16(fa, fk, dak, 0, 0, 0);
                            drb = __builtin_amdgcn_mfma_f32_16x16x32_bf16(frr, fb, drb, 0, 0, 0); drk = __builtin_amdgcn_mfma_f32_16x16x32_bf16(frr, fk, drk, 0, 0, 0);
                        }
#pragma unroll
                        for (int r = 0; r < 4; ++r) { const int i = 4 * fq + r, j = fr;
                            LT[i * 20 + j] = j < i ? dab[r] : 0.f; LAK[i * 16 + j] = j < i ? dak[r] : 0.f;
                            bf16_t* mp = (bf16_t*)(rb + 2048 + i * 64 + (((j >> 2) ^ SWZ4(i)) << 4)) + (j & 3);
                            mp[0] = f2bf(j <= i ? drb[r] : 0.f); mp[4] = f2bf(j <= i ? drk[r] : 0.f); }
                    }
                    WAVE_LDS_SYNC();
                    {
#pragma unroll
                        for (int k_ = 0; k_ < 8; ++k_) { OB[(2 * k_) * 72 + lane] = (bf16_t)(bvp[k_] & 0xffffu); OB[(2 * k_ + 1) * 72 + lane] = (bf16_t)(bvp[k_] >> 16); }
                        WAVE_LDS_SYNC();
                        const int ti_ = lane >> 2, pt_ = lane & 3;
                        const u32x4 b0_ = *(const LAS u32x4*)(OB + ti_ * 72 + 16 * pt_), b1_ = *(const LAS u32x4*)(OB + ti_ * 72 + 16 * pt_ + 8);
                        bf16_t* bp_ = BV + (size_t)(row0 + ti_) * 512 + h * 64 + 16 * pt_;
                        *(u32x4*)bp_ = b0_; *(u32x4*)(bp_ + 8) = b1_;
                    }
                    float tt[16];
#pragma unroll
                    for (int mm = 0; mm < 16; ++mm) tt[mm] = mm == fr ? 1.f : 0.f;
#pragma unroll
                    for (int j = 14; j >= 0; --j) { float val = 0.f;
#pragma unroll
                        for (int mm = j + 1; mm < 16; ++mm) val += tt[mm] * LT[mm * 20 + j];
                        tt[j] += val; }
                    WAVE_LDS_SYNC();
                    if (fq == 0) {
#pragma unroll
                        for (int mm = 0; mm < 16; ++mm) LT[fr * 20 + mm] = tt[mm]; }
                    {
                        f32x4 g4 = (f32x4){0.f, 0.f, 0.f, 0.f};
#pragma unroll
                        for (int mm = 0; mm < 16; ++mm) g4 += *(const LAS f32x4*)(LAK + mm * 16 + 4 * fq) * tt[mm];
                        u32x2 w; w.x = pk2bf(g4[0], g4[1]); w.y = pk2bf(g4[2], g4[3]);
                        *(u32x2*)(rb + 3072 + (fr * 16 + 4 * fq) * 2) = w;
                    }
                    WAVE_LDS_SYNC();
                    TP_MARK(25);
                    {
#pragma unroll
                        for (int i = 0; i < 16; ++i) { float acc = 0.f;
                            const f32x4 t0 = *(const LAS f32x4*)(LT + i * 20), t1 = *(const LAS f32x4*)(LT + i * 20 + 4), t2 = *(const LAS f32x4*)(LT + i * 20 + 8), t3 = *(const LAS f32x4*)(LT + i * 20 + 12);
                            const float trow[16] = {t0[0], t0[1], t0[2], t0[3], t1[0], t1[1], t1[2], t1[3], t2[0], t2[1], t2[2], t2[3], t3[0], t3[1], t3[2], t3[3]};
#pragma unroll
                            for (int mm = 0; mm <= i; ++mm) acc += trow[mm] * atil[mm];
                            OK[i * 72 + lane] = f2bf(acc); }
                        WAVE_LDS_SYNC();
                        REC_STORE(OK, ra);
                    }
#undef REC_STORE
                    TP_MARK(26);
                }
            }
            __syncthreads();
#undef PN_DMA
#undef PS_DMA
#undef PSV
            TP_MARK(29);
            TP_MARK(21);
            const float* q_g = inq[16] + lq * 64; const float* k_g = inq[17] + lq * 64; const float* b_f = inq[15] + lq * 8;
            for (int it = gw - (G >= 96 ? 80 * NWAVES : 0); it >= 0 && it < NMETA * NH; it += ngw) {
                const int row = MROWS + (it >> 3), h = it & 7;
                bf16_t* qp = p + (size_t)row * PBW + 1536 + h * 64 + lane; bf16_t* kp = p + (size_t)row * PBW + 2048 + h * 64 + lane;
                const float q = bf2f(*qp), k = bf2f(*kp);
                const float mq = wave_sum(q * q) * (1.f / 64.f), mk = wave_sum(k * k) * (1.f / 64.f);
                *qp = f2bf(q * (1.0f / sqrtf(mq + 1e-6f)) * q_g[lane] * (0.125f * LOG2E));
                *kp = f2bf(k * (1.0f / sqrtf(mk + 1e-6f)) * k_g[lane]);
            }
            for (int it = bid - (G >= 80 ? 16 : 0); it >= 0 && it < NB * NH; it += G) {
                constexpr int PER = 5;
                const int b = it >> 3, h = it & 7;
                float zv[PER], loc[PER], s = 0.f;
#pragma unroll
                for (int i = 0; i < PER; ++i) { const int t = tid * PER + i; zv[i] = pn[(size_t)rowof(b, t < LTOT ? t : LTOT - 1) * PNW + 288 + h]; }
#pragma unroll
                for (int i = 0; i < PER; ++i) { const int t = tid * PER + i;
                    const float v = t < LTOT ? -__builtin_amdgcn_logf(1.f + __builtin_amdgcn_exp2f(-LOG2E * (zv[i] + b_f[h]))) : 0.f;
                    s += v; loc[i] = s; }
                float incl = s;
#pragma unroll
                for (int o = 1; o < 64; o <<= 1) { const float n = __int_as_float(__builtin_amdgcn_ds_bpermute((lane - o) << 2, __float_as_int(incl))); if (lane >= o) incl += n; }
                float base = incl - s;
                if (lane == 63) ((LAS float*)ldsl)[wave] = incl;
                __syncthreads();
#pragma unroll
                for (int w = 0; w < NWAVES - 1; ++w) base += w < wave ? ((const LAS float*)ldsl)[w] : 0.f;
                float* cv = c2 + (size_t)it * 2176;
#pragma unroll
                for (int i = 0; i < PER; ++i) { const int t = tid * PER + i; if (t < LTOT) cv[t < NMETA ? t : t + 112] = base + loc[i]; }
                if (tid < 112) cv[16 + tid] = 1e5f;
                __syncthreads();
            }
        }
        } else if (ph == 2) {
        {
            PHASE_IDS(); PHASE_PTRS(l);
            typedef short s16x4 __attribute__((ext_vector_type(4)));
            constexpr int SLOTB = 12288, NSLOT = 10  , YB_OFF = NSLOT * SLOTB, YB_BYTES = 32 * 68 * 4, NSC = (NCH + 1) / 2;
            static_assert(YB_OFF + 2 * YB_BYTES <= LDSCTL_OFF, "scan LDS map");
#define RAW_BAR() asm volatile("s_waitcnt lgkmcnt(0)\n\ts_barrier" ::: "memory")
#define QXOR1(x) __int_as_float(__builtin_amdgcn_update_dpp(0, __float_as_int(x), 0xB1, 0xf, 0xf, false))
#define QXOR2(x) __int_as_float(__builtin_amdgcn_update_dpp(0, __float_as_int(x), 0x4E, 0xf, 0xf, false))
            for (int unit = bid; unit < 64; unit += G) {
                const int b = unit >> 3, h = unit & 7, fr = lane & 15, fq = lane >> 4;
                const unsigned char* RA0 = ws + WS_RA + (size_t)unit * NCH * RA_BYTES; const unsigned char* RB0 = (const unsigned char*)out + (size_t)unit * NCH * RB_BYTES;
                if (wave < 4) {
                    const int v = 16 * wave + fr;
                    f32x4 Z[4];
#pragma unroll
                    for (int kb = 0; kb < 4; ++kb) Z[kb] = (f32x4){0.f, 0.f, 0.f, 0.f};
                    const int o_ah0 = fr * 128 + (((fq) ^ ((fr >> 1) & 7)) << 4), o_ah1 = fr * 128 + (((4 + fq) ^ ((fr >> 1) & 7)) << 4);
                    const int o_bk = 4096 + fr * 64 + ((fq ^ SWZ4(fr)) << 4), o_mrk = 10240 + fr * 64 + ((fq ^ SWZ4(fr)) << 4);
                    const int o_vt = 8192 + v * 32 + fq * 8, o_g = 11264 + fr * 32 + fq * 8, o_gam = 11776 + fq * 16;
                    RAW_BAR();
                    for (int s = 0; s < NSC; ++s) {
                        LAS float* YB = (LAS float*)(ldsl + YB_OFF + (s & 1) * YB_BYTES);
                        const int nc = (NCH - 2 * s) < 2 ? 1 : 2;
                        for (int cs = 0; cs < nc; ++cs) {
                            const LAS unsigned char* sl = ldsl + ((2 * s + cs) % NSLOT) * SLOTB;
                            const bf16x8 ah0 = *(const LAS bf16x8*)(sl + o_ah0), ah1 = *(const LAS bf16x8*)(sl + o_ah1);
                            const bf16x8 rh0 = *(const LAS bf16x8*)(sl + 2048 + o_ah0), rh1 = *(const LAS bf16x8*)(sl + 2048 + o_ah1);
                            bf16x8 bk[4]; f32x4 gam[4];
#pragma unroll
                            for (int kb = 0; kb < 4; ++kb) { bk[kb] = *(const LAS bf16x8*)(sl + o_bk + kb * 1024); gam[kb] = *(const LAS f32x4*)(sl + o_gam + kb * 64); }
                            const u32x2 vt = *(const LAS u32x2*)(sl + o_vt);
                            const bf16x8 mrk = *(const LAS bf16x8*)(sl + o_mrk);
                            const u32x2 g4 = *(const LAS u32x2*)(sl + o_g);
                            u32x4 zw01, zw23;
                            zw01.x = pk2bf(Z[0][0], Z[0][1]); zw01.y = pk2bf(Z[0][2], Z[0][3]); zw01.z = pk2bf(Z[1][0], Z[1][1]); zw01.w = pk2bf(Z[1][2], Z[1][3]);
                            zw23.x = pk2bf(Z[2][0], Z[2][1]); zw23.y = pk2bf(Z[2][2], Z[2][3]); zw23.z = pk2bf(Z[3][0], Z[3][1]); zw23.w = pk2bf(Z[3][2], Z[3][3]);
                            const bf16x8 zp01 = __builtin_bit_cast(bf16x8, zw01), zp23 = __builtin_bit_cast(bf16x8, zw23);
                            f32x4 U = (f32x4){0.f, 0.f, 0.f, 0.f}, Yv = U;
                            U = __builtin_amdgcn_mfma_f32_16x16x32_bf16(ah0, zp01, U, 0, 0, 0); U = __builtin_amdgcn_mfma_f32_16x16x32_bf16(ah1, zp23, U, 0, 0, 0);
                            U = __builtin_amdgcn_mfma_f32_16x16x16bf16_1k(__builtin_bit_cast(s16x4, g4), __builtin_bit_cast(s16x4, vt), U, 0, 0, 0);
                            Yv = __builtin_amdgcn_mfma_f32_16x16x32_bf16(rh0, zp01, Yv, 0, 0, 0); Yv = __builtin_amdgcn_mfma_f32_16x16x32_bf16(rh1, zp23, Yv, 0, 0, 0);
                            u32x4 uvw; uvw.x = pk2bf(U[0], U[1]); uvw.y = pk2bf(U[2], U[3]); uvw.z = vt.x; uvw.w = vt.y;
                            const bf16x8 uv = __builtin_bit_cast(bf16x8, uvw);
                            Yv = __builtin_amdgcn_mfma_f32_16x16x32_bf16(mrk, uv, Yv, 0, 0, 0);
#pragma unroll
                            for (int kb = 0; kb < 4; ++kb) { Z[kb] = Z[kb] * gam[kb]; Z[kb] = __builtin_amdgcn_mfma_f32_16x16x32_bf16(bk[kb], uv, Z[kb], 0, 0, 0); }
#pragma unroll
                            for (int r = 0; r < 4; ++r) YB[(cs * 16 + 4 * fq + r) * 68 + v] = Yv[r];
                        }
                        RAW_BAR();
                    }
                } else if (wave < 6) {
                    const unsigned lds0 = (unsigned)(uintptr_t)lds; const int lw = wave - 4;
#define DMA_SC(sc) do { const int nc_ = (NCH - 2 * (sc)) < 2 ? 1 : 2; for (int cs_ = 0; cs_ < nc_; ++cs_) { const int ch_ = 2 * (sc) + cs_; \
                        _Pragma("unroll") for (int pc_ = 0; pc_ < 6; ++pc_) { const int pc = lw * 6 + pc_; \
                            const unsigned char* src_ = (pc < 8 ? RA0 + (size_t)ch_ * RA_BYTES + pc * 1024 : RB0 + (size_t)ch_ * RB_BYTES + (pc - 8) * 1024) + lane * 16; \
                            attn_body::glds16(src_, (unsigned)__builtin_amdgcn_readfirstlane(lds0 + (ch_ % NSLOT) * SLOTB + pc * 1024)); } } } while (0)
                    DMA_SC(0); DMA_SC(1); DMA_SC(2); DMA_SC(3);
                    asm volatile("s_waitcnt vmcnt(36)\n\ts_barrier" ::: "memory");
                    for (int s = 0; s < NSC; ++s) {
                        if (s + 4 < NSC) DMA_SC(s + 4);
#define NPC_(sc) ((sc) < NSC ? ((NCH - 2 * (sc)) < 2 ? 6 : 12) : 0)
                        const int fl = NPC_(s + 2) + NPC_(s + 3) + NPC_(s + 4);
#undef NPC_
                        if (fl == 36) asm volatile("s_waitcnt vmcnt(36)\n\ts_barrier" ::: "memory");
                        else if (fl == 30) asm volatile("s_waitcnt vmcnt(30)\n\ts_barrier" ::: "memory");
                        else if (fl == 18) asm volatile("s_waitcnt vmcnt(18)\n\ts_barrier" ::: "memory");
                        else if (fl == 6) asm volatile("s_waitcnt vmcnt(6)\n\ts_barrier" ::: "memory");
                        else asm volatile("s_waitcnt vmcnt(0)\n\ts_barrier" ::: "memory");
                    }
#undef DMA_SC
                } else {
                    const int pw = wave - 6, tk = lane >> 2, part = lane & 3, cgv = h * 64 + part * 16;
                    const bf16_t* BV = (const bf16_t*)(ws + WS_BV);
                    float gnw[16], gnb[16];
#pragma unroll
                    for (int j = 0; j < 16; ++j) { gnw[j] = (inq[13] + lq * 512)[cgv + j]; gnb[j] = (inq[14] + lq * 512)[cgv + j]; }
#define PLOAD(G0, G1, B0, B1, sg) do { const int cn_ = 2 * (sg) + pw; if ((sg) < NSC && cn_ < NCH) { const size_t rown = (size_t)rowof(b, 16 * cn_ + tk); \
                        G0 = *(const u32x4*)(y + rown * DM + cgv); G1 = *(const u32x4*)(y + rown * DM + cgv + 8); B0 = *(const u32x4*)(BV + rown * 512 + cgv); B1 = *(const u32x4*)(BV + rown * 512 + cgv + 8); } } while (0)
                    u32x4 ga0 = (u32x4){0u, 0u, 0u, 0u}, ga1 = ga0, ba0 = ga0, ba1 = ga0, gb0 = ga0, gb1 = ga0, bb0 = ga0, bb1 = ga0, gc0 = ga0, gc1 = ga0, bc0 = ga0, bc1 = ga0;
                    PLOAD(gb0, gb1, bb0, bb1, 0); PLOAD(gc0, gc1, bc0, bc1, 1);
                    RAW_BAR();
                    for (int s = 0; s <= NSC; ++s) {
                        const int cp = 2 * (s - 1) + pw;
                        const bool do_now = s >= 1 && cp < NCH && (cp > 0 || b == 0);
                        const u32x4 g0 = ga0, g1 = ga1, b0 = ba0, b1 = ba1;
                        ga0 = gb0; ga1 = gb1; ba0 = bb0; ba1 = bb1; gb0 = gc0; gb1 = gc1; bb0 = bc0; bb1 = bc1;
                        PLOAD(gc0, gc1, bc0, bc1, s + 2);
                        if (do_now) {
                            const LAS float* yb = (const LAS float*)(ldsl + YB_OFF + ((s - 1) & 1) * YB_BYTES) + (pw * 16 + tk) * 68 + part * 16;
                            float yv[16];
#pragma unroll
                            for (int q4 = 0; q4 < 4; ++q4) { const f32x4 t4 = *(const LAS f32x4*)(yb + 4 * q4); yv[4 * q4] = t4[0]; yv[4 * q4 + 1] = t4[1]; yv[4 * q4 + 2] = t4[2]; yv[4 * q4 + 3] = t4[3]; }
                            float s1 = 0.f;
#pragma unroll
                            for (int j = 0; j < 16; ++j) s1 += yv[j];
                            s1 += QXOR1(s1); s1 += QXOR2(s1);
                            const float mean = s1 * (1.f / 64.f); float s2 = 0.f;
#pragma unroll
                            for (int j = 0; j < 16; ++j) { yv[j] -= mean; s2 += yv[j] * yv[j]; }
                            s2 += QXOR1(s2); s2 += QXOR2(s2);
                            const float rstd = 1.0f / sqrtf(s2 * (1.f / 64.f) + 64e-5f);
                            const unsigned gws[8] = {g0.x, g0.y, g0.z, g0.w, g1.x, g1.y, g1.z, g1.w}, bws[8] = {b0.x, b0.y, b0.z, b0.w, b1.x, b1.y, b1.z, b1.w};
                            unsigned ow[8];
#pragma unroll
                            for (int j2 = 0; j2 < 8; ++j2) {
                                const float oa = (yv[2 * j2] * rstd * gnw[2 * j2] + gnb[2 * j2] + __uint_as_float(bws[j2] << 16)) * __uint_as_float(gws[j2] << 16);
                                const float ob = (yv[2 * j2 + 1] * rstd * gnw[2 * j2 + 1] + gnb[2 * j2 + 1] + __uint_as_float(bws[j2] & 0xffff0000u)) * __uint_as_float(gws[j2] & 0xffff0000u);
                                ow[j2] = pk2bf(oa, ob); }
                            bf16_t* yo = y + (size_t)rowof(b, 16 * cp + tk) * DM + cgv;
                            *(u32x4*)yo = (u32x4){ow[0], ow[1], ow[2], ow[3]}; *(u32x4*)(yo + 8) = (u32x4){ow[4], ow[5], ow[6], ow[7]};
                        }
                        if (s < NSC) RAW_BAR();
                    }
#undef PLOAD
                }
                __syncthreads();
            }
#undef RAW_BAR
#undef QXOR1
#undef QXOR2
        }
        TP_MARK(30);
        {
            PHASE_IDS(); PHASE_PTRS(l);
            if (gw < NH * NMETA) {
                const int h = gw >> 4, t = gw & 15;
                const bf16_t* qrow = p + (size_t)(MROWS + t) * PBW + 1536 + h * 64;
                float s = -INFINITY;
                if (lane <= t) { const bf16_t* kr = p + (size_t)(MROWS + lane) * PBW + 2048 + h * 64; float d = 0.f;
                    for (int e = 0; e < 64; ++e) d += bf2f(qrow[e]) * bf2f(kr[e]);
                    s = d - c2[(size_t)h * 2176 + lane]; }
                const float mx = wave_max(s); const float e = lane <= t ? exp2f(s - mx) : 0.f; const float sum = wave_sum(e);
                float o = 0.f;
                for (int j = 0; j <= t; ++j) o += __int_as_float(__builtin_amdgcn_readlane(__float_as_int(e), j)) * bf2f(p[(size_t)(MROWS + j) * PBW + 2560 + h * 64 + lane]);
                const float og = bf2f(p[(size_t)(MROWS + t) * PBW + 3072 + h * 64 + lane]);
                y[(size_t)(MROWS + t) * DM + 512 + h * 64 + lane] = f2bf(o * __builtin_amdgcn_rcpf(sum) * __builtin_amdgcn_rcpf(1.f + __builtin_amdgcn_exp2f(-LOG2E * og)));
            }
        }
        __syncthreads();
        {
            PHASE_IDS(); PHASE_PTRS(l);
            typedef attn_body::bf16 abf;
            const attn_body::AttnTensors AT{(const abf*)(p + 1536), (const abf*)(p + 2048), (const abf*)(p + 2560), (const abf*)(p + 3072), c2, (abf*)(y + 512)};
            const attn_body::StaticOrder S(G, bid);
            TP_MARK(31);
            attn_body::attn_phase<attn_body::StaticOrder>((char*)lds, AT, S, wave);
            TP_MARK(32);
        }
        } else if (ph == 3) {
        {
            PHASE_IDS(); PHASE_PTRS(l);
            pg8::Gemm g{y, W2, MROWS, DM, DM}; pg8::StaticOrder S; S.init(MROWS, DM, G, bid);
            pg8::EpiRes E{nullptr, hb, ssqp};
            pg8::gemm_phase<pg8::EpiRes, pg8::StaticOrder, true, true>(ldsl, g, S, E, wave);
            meta_gemm<false>(y + (size_t)MROWS * DM, DM, W2, DM, DM, bid, G, wave, lane, (float*)lds, MEpiRes{hm});
        }
        } else if (ph == 5) {
        {
            PHASE_IDS(); PHASE_PTRS(l);
            const float* cw = inq[21] + (size_t)lq * 3 * DFF2; const float* cb = inq[22] + (size_t)lq * DFF2;
            pg8::Gemm g{act, W4, MROWS, DM, DFF}; pg8::StaticOrder S; S.init(MROWS, DM, G, bid);
            {
                pg8::Unit u;
                for (int i = 0; S.next(i, u); ++i) {
                    const int pm = u.pm;
                    const float* own0 = fixb + (size_t)(pm * 4) * DFF2; const float* own1 = own0 + DFF2;
                    const float* pv0 = (pm & 7) ? fixb + (size_t)((pm - 1) * 4 + 2) * DFF2 : rawm + (size_t)14 * DFF2; const float* pv1 = pv0 + DFF2;
                    for (int j = 4 * tid; j < DFF; j += 4 * NWAVES * 64) {
                        const f32x4 w0u = *(const f32x4*)(cw + j), w1u = *(const f32x4*)(cw + DFF2 + j), w2u = *(const f32x4*)(cw + 2 * DFF2 + j), bu = *(const f32x4*)(cb + j);
                        const f32x4 w0g = *(const f32x4*)(cw + DFF + j), w1g = *(const f32x4*)(cw + DFF2 + DFF + j), w2g = *(const f32x4*)(cw + 2 * DFF2 + DFF + j), bg = *(const f32x4*)(cb + DFF + j);
                        const f32x4 au = *(const f32x4*)(pv0 + j), bu_ = *(const f32x4*)(pv1 + j), cu_ = *(const f32x4*)(own0 + j), du = *(const f32x4*)(own1 + j);
                        const f32x4 ag = *(const f32x4*)(pv0 + DFF + j), bg_ = *(const f32x4*)(pv1 + DFF + j), cg_ = *(const f32x4*)(own0 + DFF + j), dg = *(const f32x4*)(own1 + DFF + j);
                        const f32x4 u0 = bu + w0u * au + w1u * bu_ + w2u * cu_, g0 = bg + w0g * ag + w1g * bg_ + w2g * cg_;
                        const f32x4 u1 = bu + w0u * bu_ + w1u * cu_ + w2u * du, g1 = bg + w0g * bg_ + w1g * cg_ + w2g * dg;
                        u32x2 o0, o1;
                        o0.x = pk2bf(g0[0] * sigmoidf_(g0[0]) * u0[0], g0[1] * sigmoidf_(g0[1]) * u0[1]); o0.y = pk2bf(g0[2] * sigmoidf_(g0[2]) * u0[2], g0[3] * sigmoidf_(g0[3]) * u0[3]);
                        o1.x = pk2bf(g1[0] * sigmoidf_(g1[0]) * u1[0], g1[1] * sigmoidf_(g1[1]) * u1[1]); o1.y = pk2bf(g1[2] * sigmoidf_(g1[2]) * u1[2], g1[3] * sigmoidf_(g1[3]) * u1[3]);
                        *(u32x2*)(act + (size_t)(256 * pm) * DFF + j) = o0; *(u32x2*)(act + (size_t)(256 * pm + 1) * DFF + j) = o1;
                    }
                }
                asm volatile("s_waitcnt vmcnt(0)" ::: "memory"); __syncthreads();
            }
            pg8::EpiRes E{lq + 1 == DEPTH ? out : nullptr, hb, ssqp};
            pg8::gemm_phase<pg8::EpiRes, pg8::StaticOrder, true, true>(ldsl, g, S, E, wave);
            meta_gemm<false>(act + (size_t)MROWS * DFF, DFF, W4, DM, DFF, bid, G, wave, lane, (float*)lds, MEpiRes{hm});
        }
        }
#ifdef TPROBE
#ifdef TPROBE_WAIT
        TP_MARK(19);
#endif
        GRID_BAR(); TP_MARK(ph == 0 ? 1 : ph == 1 ? 2 : ph == 2 ? 3 : ph == 3 ? 4 : ph == 4 ? 5 : 6);
#if TPROBE == 40
        GRID_BAR(); TP_MARK(40);
#endif
#else
        if (ph < 5 || l + 1 < DEPTH) GRID_BAR();
#endif
      }
    }
#ifdef TPROBE
#ifndef TPROBE_BLOCK
#define TPROBE_BLOCK 0
#endif
    if (bid0 == TPROBE_BLOCK && wave_s == 0 && lane_id() == 0) a.out[0] += (float)((volatile LAS unsigned*)((LAS unsigned char*)lds + LDSCTL_OFF + 512))[1] * 0.0001f;
#endif
}

extern "C" void kernel_launch(void* const* d_in, const int* in_sizes, int n_in, void* d_out, int out_size, void* d_ws, size_t ws_size, hipStream_t stream) {
    static int grid = 0;
    if (grid == 0) {
        if (n_in != 24 || out_size != MROWS * DM || ws_size < WS_END) { fprintf(stderr, "kernel_launch: unexpected shapes (n_in %d out %d ws %zu)\n", n_in, out_size, ws_size); grid = -1; return; }
        int dev = 0, cus = 0, per_cu = 0;
        hipGetDevice(&dev); hipDeviceGetAttribute(&cus, hipDeviceAttributeMultiprocessorCount, dev);
        if (hipFuncSetAttribute((const void*)mk_fwd, hipFuncAttributeMaxDynamicSharedMemorySize, LDS_BYTES) != hipSuccess) { fprintf(stderr, "kernel_launch: hipFuncSetAttribute failed\n"); grid = -1; return; }
        hipOccupancyMaxActiveBlocksPerMultiprocessor(&per_cu, (const void*)mk_fwd, NWAVES * 64, LDS_BYTES);
        (void)hipGetLastError();
        if (per_cu < 1) { fprintf(stderr, "kernel_launch: occupancy query says %d blocks per CU\n", per_cu); }
        grid = cus;
    }
    if (grid < 0) return;
    hipMemsetAsync((char*)d_ws + WS_CTL, 0, 32768, stream);
    Args a{};
    for (int i = 0; i < 24; ++i) a.in[i] = (const float*)d_in[i];
    a.out = (float*)d_out; a.ws = (unsigned char*)d_ws;
    void* args[] = {&a};
#ifdef PLAIN_LAUNCH
    hipLaunchKernelGGL(mk_fwd, dim3(grid), dim3(NWAVES * 64), LDS_BYTES, stream, a); hipError_t e = hipPeekAtLastError(); (void)args;
#else
    hipError_t e = hipLaunchCooperativeKernel((const void*)mk_fwd, dim3(grid), dim3(NWAVES * 64), args, LDS_BYTES, stream);
#endif
    if (e != hipSuccess) fprintf(stderr, "cooperative launch failed: %s (grid %d)\n", hipGetErrorString(e), grid);
}
```

```cpp
#define PLAIN_LAUNCH 1
#include <hip/hip_runtime.h>
#include <hip/hip_cooperative_groups.h>
#include <stdint.h>
#include <cstdio>
namespace cg = cooperative_groups;

typedef unsigned short bf16_t;
typedef short bf16x8 __attribute__((ext_vector_type(8)));
typedef float f32x4 __attribute__((ext_vector_type(4)));
typedef unsigned u32x4 __attribute__((ext_vector_type(4)));
typedef unsigned u32x2 __attribute__((ext_vector_type(2)));

constexpr int NB = 8, SEQ = 2048, NMETA = 16, LTOT = 2064, DM = 1024, DEPTH = 4, NH = 8, HD = 64;
constexpr int N_IN = 3880, DFF = 2816, DFF2 = 5632;
constexpr int MROWS = NB * SEQ;
constexpr int RROWS = MROWS + NMETA;
constexpr int N1 = 4096;
constexpr int PBW = 3584;
constexpr int PNW = 320;
constexpr float LOG2E = 1.4426950408889634f;

constexpr size_t MiB = 1u << 20;
constexpr size_t WS_CTL = 0, CTL_ZERO_BYTES = 1 * MiB;
constexpr size_t WS_W = 1 * MiB, WL_BYTES = 27 * MiB;
constexpr size_t WO_W1 = 0;
constexpr size_t WO_W2 = 8 * MiB;
constexpr size_t WO_W3 = 10 * MiB;
constexpr size_t WO_W4 = 21 * MiB;
constexpr size_t WO_LUP = 26 * MiB + 512 * 1024;
constexpr size_t WS_SMALL = WS_W + 2 * WL_BYTES;
constexpr size_t WS_HM = WS_SMALL;
constexpr size_t WS_C2 = WS_SMALL + 1 * MiB;
constexpr size_t WS_SSQ = WS_SMALL + 3 * MiB;
constexpr size_t WS_HB = WS_SMALL + 6 * MiB;
constexpr size_t WS_P = WS_HB + 33 * MiB;
constexpr size_t WS_PN = WS_P + 113 * MiB;
constexpr size_t WS_Y = WS_PN + 21 * MiB;
constexpr size_t WS_FREE = WS_Y + 33 * MiB;
constexpr int NCH = 129;
constexpr size_t RA_BYTES = 8192, RB_BYTES = 4096;
constexpr size_t WS_RA = WS_FREE;
#define SWZ4(r) (3 * (((r) >> 3) & 1))
constexpr size_t WS_ACT = WS_P;
constexpr size_t WS_FIX = WS_PN;
constexpr size_t WS_RAWM = WS_PN + 6 * MiB;
constexpr size_t WS_BV = WS_RA + 65 * MiB;
constexpr size_t WS_END = WS_BV + 17 * MiB;

__device__ __forceinline__ float bf2f(bf16_t v) { return __uint_as_float(((unsigned)v) << 16); }
typedef float f32x2_t_ __attribute__((ext_vector_type(2))); typedef __bf16 bf16x2_t_ __attribute__((ext_vector_type(2)));
__device__ __forceinline__ unsigned pk2bf(float lo, float hi) { const f32x2_t_ v = {lo, hi}; return __builtin_bit_cast(unsigned, __builtin_convertvector(v, bf16x2_t_)); }
__device__ __forceinline__ bf16_t f2bf(float f) { return __builtin_bit_cast(bf16_t, (__bf16)f); }
__device__ __forceinline__ float sigmoidf_(float x) { return 1.f / (1.f + __expf(-x)); }
__device__ __forceinline__ float wave_sum_dpp(float v) {
#define DPPF_(x, ctrl, rmask) __int_as_float(__builtin_amdgcn_update_dpp(0, __float_as_int(x), ctrl, rmask, 0xf, false))
    v += DPPF_(v, 0xB1, 0xf);
    v += DPPF_(v, 0x4E, 0xf);
    v += DPPF_(v, 0x141, 0xf);
    v += DPPF_(v, 0x140, 0xf);
    v += DPPF_(v, 0x142, 0xa);
    v += DPPF_(v, 0x143, 0xc);
#undef DPPF_
    return __int_as_float(__builtin_amdgcn_readlane(__float_as_int(v), 63));
}
__device__ __forceinline__ float wave_sum(float v) { return wave_sum_dpp(v); }
__device__ __forceinline__ void wave_sum_dpp8(float (&v)[8]) {
#define DPPF_(x, ctrl, rmask) __int_as_float(__builtin_amdgcn_update_dpp(0, __float_as_int(x), ctrl, rmask, 0xf, false))
#define DPPS_(ctrl, rmask) _Pragma("unroll") for (int j_ = 0; j_ < 8; ++j_) v[j_] += DPPF_(v[j_], ctrl, rmask);
    DPPS_(0xB1, 0xf) DPPS_(0x4E, 0xf) DPPS_(0x141, 0xf) DPPS_(0x140, 0xf) DPPS_(0x142, 0xa) DPPS_(0x143, 0xc)
#undef DPPS_
#undef DPPF_
#pragma unroll
    for (int j_ = 0; j_ < 8; ++j_) v[j_] = __int_as_float(__builtin_amdgcn_readlane(__float_as_int(v[j_]), 63));
}
__device__ __forceinline__ float wave_max(float v) {
#define DPPF_(x, ctrl, rmask) __int_as_float(__builtin_amdgcn_update_dpp(__float_as_int(x), __float_as_int(x), ctrl, rmask, 0xf, false))
    v = fmaxf(v, DPPF_(v, 0xB1, 0xf)); v = fmaxf(v, DPPF_(v, 0x4E, 0xf)); v = fmaxf(v, DPPF_(v, 0x141, 0xf)); v = fmaxf(v, DPPF_(v, 0x140, 0xf));
    v = fmaxf(v, DPPF_(v, 0x142, 0xa)); v = fmaxf(v, DPPF_(v, 0x143, 0xc));
#undef DPPF_
    return __int_as_float(__builtin_amdgcn_readlane(__float_as_int(v), 63));
}
__device__ __forceinline__ float add_xor16(float x) { const auto r = __builtin_amdgcn_permlane16_swap(__float_as_uint(x), __float_as_uint(x), false, false); return __uint_as_float(r[0]) + __uint_as_float(r[1]); }
__device__ __forceinline__ float add_xor32(float x) { const auto r = __builtin_amdgcn_permlane32_swap(__float_as_uint(x), __float_as_uint(x), false, false); return __uint_as_float(r[0]) + __uint_as_float(r[1]); }
__device__ __forceinline__ int lane_id() { int l; asm volatile("v_mbcnt_lo_u32_b32 %0, -1, 0\n\tv_mbcnt_hi_u32_b32 %0, -1, %0" : "=v"(l)); return l; }
#define WAVE_LDS_SYNC() do { __builtin_amdgcn_s_waitcnt(0xc07f); __builtin_amdgcn_wave_barrier(); } while (0)
__device__ __forceinline__ int rowof(int b, int t) { return t < NMETA ? MROWS + t : b * SEQ + (t - NMETA); }
__device__ __forceinline__ int prevrow(int row) {
    if (row >= MROWS) return row == MROWS ? -1 : row - 1;
    return (row & (SEQ - 1)) ? row - 1 : MROWS + NMETA - 1;
}

#define PERM32(j) (8 * (((j) >> 2) & 3) + 4 * ((j) >> 4) + ((j) & 3))
__device__ __forceinline__ int src_col(int mode, int n) {
    if (mode == 1) {
        const int g = n >> 9, c_ = n & 255, o = (n & 256) + (g < 7 ? ((c_ >> 5) & 3) * 64 + (c_ >> 7) * 32 + PERM32(c_ & 31) : c_);
        switch (g) {
            case 0: return o;
            case 1: return 512 + o;
            case 2: return 1024 + o;
            case 3: return 1824 + o;
            case 4: return 2336 + o;
            case 5: return 2848 + o;
            case 6: return 3360 + o;
            default:
                if (o < 64) return 1536 + o;
                if (o < 128) return 1600 + (o - 64);
                if (o < 288) return 1664 + (o - 128);
                if (o < 296) return 3872 + (o - 288);
                return -1;
        }
    }
    if (mode == 3) { const int t = n >> 8, c = n & 255; return c < 128 ? 128 * t + c : DFF + 128 * t + (c - 128); }
    return (n & ~31) + PERM32(n & 31);
}
__device__ __forceinline__ void wprep_item(const float* W, const float* gk, bf16_t* WT, int K, int Nsrc, int Ndst, int mode, int item, float* scr, int lane) {
    const int nblk = Ndst / 32, kb = item / nblk, nb = item % nblk, k0 = 64 * kb, n0 = 32 * nb;
    const int sc = src_col(mode, n0 + (lane & 31));
    const float* wp = W + (size_t)(k0 + (lane >> 5)) * Nsrc + (sc >= 0 ? sc : 0);
    float v[32];
#pragma unroll
    for (int i = 0; i < 32; ++i) { v[i] = *wp; wp += 2 * (size_t)Nsrc; }
#pragma unroll
    for (int i = 0; i < 32; ++i) scr[(2 * i + (lane >> 5)) * 33 + (lane & 31)] = sc >= 0 ? v[i] : 0.f;
    WAVE_LDS_SYNC();
    const int c = lane & 7;
    f32x4 g0 = (f32x4){1.f, 1.f, 1.f, 1.f}, g1 = g0;
    if (gk) { g0 = *(const f32x4*)(gk + k0 + 8 * c); g1 = *(const f32x4*)(gk + k0 + 8 * c + 4); }
#pragma unroll
    for (int j = 0; j < 4; ++j) {
        const int n = (lane >> 3) + 8 * j; const float* s = scr + (8 * c) * 33 + n;
        u32x4 o;
        o.x = pk2bf(s[0 * 33] * g0[0], s[1 * 33] * g0[1]); o.y = pk2bf(s[2 * 33] * g0[2], s[3 * 33] * g0[3]); o.z = pk2bf(s[4 * 33] * g1[0], s[5 * 33] * g1[1]); o.w = pk2bf(s[6 * 33] * g1[2], s[7 * 33] * g1[3]);
        *(u32x4*)(WT + (size_t)(n0 + n) * K + k0 + 8 * c) = o;
    }
    WAVE_LDS_SYNC();
}
namespace pg8 {
#define PG8_LAS __attribute__((address_space(3)))
typedef unsigned short bf16_t;
typedef short bf16x8 __attribute__((ext_vector_type(8)));
typedef float f32x4 __attribute__((ext_vector_type(4)));
typedef unsigned u32x4 __attribute__((ext_vector_type(4)));
constexpr int BM = 256, BK = 64, HALF = 128, HTB = HALF * BK * 2  , STAGE_BYTES = 8 * HTB, NXCD = 8, WGM = 8;

__host__ __device__ __forceinline__ int lds_byte(int r, int c) { const int st = (r >> 4) * 2 + (c >> 5), rr = r & 15, cc = c & 31, ob = rr * 64 + cc * 2; return st * 1024 + (ob ^ (((ob >> 9) & 1) << 5)); }
__host__ __device__ __forceinline__ void stage_rc(int b, int& R, int& C) { const int st = b / 1024, sb = b % 1024, swz = sb ^ (((sb >> 9) & 1) << 5); R = (st >> 1) * 16 + swz / 64; C = (st & 1) * 32 + (swz % 64) / 2; }
__host__ __device__ __forceinline__ int perm32(int rho) { const int n = rho >> 4, i = rho & 15; return 8 * (i >> 2) + 4 * n + (i & 3); }

struct Unit { int pm, pn, idx; };
struct Gemm { const bf16_t* A; const bf16_t* Bt; int M, N, K; };

struct StaticOrder {
    int nM, nN, nwg, G, c;
    __host__ __device__ void init(int M, int N, int G_, int c_) { nM = M / BM; nN = N / BM; nwg = nM * nN; G = G_; c = c_; }
    __host__ __device__ bool next(int i, Unit& u) const {
        const long L = (long)i * G + c; if (L >= nwg) return false;
        int wgid = (int)L; { const int q = nwg / NXCD, r = nwg % NXCD, xcd = wgid % NXCD, off = wgid / NXCD; wgid = (xcd < r ? xcd * (q + 1) : r * (q + 1) + (xcd - r) * q) + off; }
        const int nig = WGM * nN, gid = wgid / nig, fm = gid * WGM, gsz = (nM - fm) < WGM ? (nM - fm) : WGM;
        u.pm = fm + ((wgid % nig) % gsz); u.pn = (wgid % nig) / gsz; u.idx = i; return true;
    }
    __device__ __forceinline__ void a_ready(const Unit&) const {}
    __device__ __forceinline__ void done(const Unit&) const {}
};

__device__ __forceinline__ float row_rstd(const float* ssqp, int row) {
    const f32x4* sp = (const f32x4*)(ssqp + (size_t)row * 16);
    const f32x4 a = sp[0], b = sp[1], c = sp[2], d = sp[3];
    const float s = (((a.x + a.y) + (a.z + a.w)) + ((b.x + b.y) + (b.z + b.w))) + (((c.x + c.y) + (c.z + c.w)) + ((d.x + d.y) + (d.z + d.w)));
    return 1.0f / sqrtf(s * (1.f / 1024.f) + 1e-6f);
}
struct Epi1 {
    static constexpr bool PERM = false, AFTER_DRAIN = false;
    const PG8_LAS float* rstdl; bf16_t* p; float* pn; const float* q_g; const float* k_g;
    __device__ __forceinline__ void operator()(const f32x4 (&acc)[2][2][4][2], const Unit& u, int wr, int wc, int fr, int fq) const {
        const int row0 = u.pm * BM + wr * 64 + fr;
        const bool isq = (u.pn >> 1) == 3, isk = (u.pn >> 1) == 4;
        f32x4 gsc[2][2];
        if (isq || isk) {
#pragma unroll
            for (int bj = 0; bj < 2; ++bj)
#pragma unroll
                for (int n = 0; n < 2; ++n) gsc[bj][n] = *(const f32x4*)((isq ? q_g : k_g) + 32 * bj + 8 * fq + 4 * n) * (isq ? 0.125f * 1.4426950408889634f : 1.f);
        }
#pragma unroll
        for (int ai = 0; ai < 2; ++ai)
#pragma unroll
            for (int m = 0; m < 4; ++m) {
                const int row = row0 + ai * HALF + m * 16; const float rs = rstdl[u.idx * 256 + wr * 64 + fr + ai * HALF + m * 16];
                f32x4 v[2][2];
#pragma unroll
                for (int bj = 0; bj < 2; ++bj)
#pragma unroll
                    for (int n = 0; n < 2; ++n) v[bj][n] = acc[ai][bj][m][n] * rs;
                if (u.pn < 14) {
                    if (isq || isk) {
                        float ss = 0.f;
#pragma unroll
                        for (int bj = 0; bj < 2; ++bj)
#pragma unroll
                            for (int n = 0; n < 2; ++n) ss += (v[bj][n][0] * v[bj][n][0] + v[bj][n][1] * v[bj][n][1]) + (v[bj][n][2] * v[bj][n][2] + v[bj][n][3] * v[bj][n][3]);
                        ss = add_xor16(ss); ss = add_xor32(ss);
                        const float rn = 1.0f / sqrtf(ss * (1.f / 64.f) + 1e-6f);
#pragma unroll
                        for (int bj = 0; bj < 2; ++bj)
#pragma unroll
                            for (int n = 0; n < 2; ++n) v[bj][n] = v[bj][n] * gsc[bj][n] * rn;
                    }
#pragma unroll
                    for (int bj = 0; bj < 2; ++bj) { u32x4 w; w.x = pk2bf(v[bj][0][0], v[bj][0][1]); w.y = pk2bf(v[bj][0][2], v[bj][0][3]); w.z = pk2bf(v[bj][1][0], v[bj][1][1]); w.w = pk2bf(v[bj][1][2], v[bj][1][3]);
                        *(u32x4*)(p + (size_t)row * PBW + u.pn * BM + wc * 64 + bj * 32 + 8 * fq) = w; }
                } else {
#pragma unroll
                    for (int bj = 0; bj < 2; ++bj)
#pragma unroll
                        for (int n = 0; n < 2; ++n) { const int o = u.pn * BM + wc * 32 + 4 * fq + bj * HALF + n * 16 - PBW; if (o < 296) *(f32x4*)(pn + (size_t)row * PNW + o) = v[bj][n]; }
                }
            }
    }
};
struct EpiRes {
    static constexpr bool PERM = false, AFTER_DRAIN = false;
    float* outp; bf16_t* hb; float* ssqp;
    __device__ __forceinline__ void operator()(const f32x4 (&acc)[2][2][4][2], const Unit& u, int wr, int wc, int fr, int fq) const {
        const int row0 = u.pm * BM + wr * 64 + fr, col0 = u.pn * BM + wc * 32 + 8 * fq;
#pragma unroll
        for (int ai = 0; ai < 2; ++ai) {
            u32x4 hw[4][2];
#pragma unroll
            for (int m = 0; m < 4; ++m)
#pragma unroll
                for (int bj = 0; bj < 2; ++bj) hw[m][bj] = *(const u32x4*)(hb + (size_t)(row0 + ai * HALF + m * 16) * DM + col0 + bj * HALF);
            asm volatile("s_waitcnt vmcnt(0)" ::: "memory");
#pragma unroll
            for (int m = 0; m < 4; ++m) {
                const int row = row0 + ai * HALF + m * 16; float ss = 0.f;
#pragma unroll
                for (int bj = 0; bj < 2; ++bj) {
                    const int col = col0 + bj * HALF; bf16_t* hp = hb + (size_t)row * DM + col;
                    const u32x4 h4 = hw[m][bj];
                    const f32x4 v0 = (f32x4){__uint_as_float(h4.x << 16), __uint_as_float(h4.x & 0xffff0000u), __uint_as_float(h4.y << 16), __uint_as_float(h4.y & 0xffff0000u)} + acc[ai][bj][m][0];
                    const f32x4 v1 = (f32x4){__uint_as_float(h4.z << 16), __uint_as_float(h4.z & 0xffff0000u), __uint_as_float(h4.w << 16), __uint_as_float(h4.w & 0xffff0000u)} + acc[ai][bj][m][1];
                    u32x4 w; w.x = pk2bf(v0[0], v0[1]); w.y = pk2bf(v0[2], v0[3]); w.z = pk2bf(v1[0], v1[1]); w.w = pk2bf(v1[2], v1[3]);
                    *(u32x4*)hp = w;
                    if (outp) { *(f32x4*)(outp + (size_t)row * DM + col) = v0; *(f32x4*)(outp + (size_t)row * DM + col + 4) = v1; }
                    const f32x4 r0 = (f32x4){__uint_as_float(w.x << 16), __uint_as_float(w.x & 0xffff0000u), __uint_as_float(w.y << 16), __uint_as_float(w.y & 0xffff0000u)};
                    const f32x4 r1 = (f32x4){__uint_as_float(w.z << 16), __uint_as_float(w.z & 0xffff0000u), __uint_as_float(w.w << 16), __uint_as_float(w.w & 0xffff0000u)};
                    ss += ((r0[0] * r0[0] + r0[1] * r0[1]) + (r0[2] * r0[2] + r0[3] * r0[3])) + ((r1[0] * r1[0] + r1[1] * r1[1]) + (r1[2] * r1[2] + r1[3] * r1[3]));
                }
                ss = add_xor16(ss); ss = add_xor32(ss);
                if (fq == 0) ssqp[(size_t)row * 16 + u.pn * 4 + wc] = ss;
            }
        }
    }
};
__device__ __forceinline__ float dpp_ror1(float x) { return __int_as_float(__builtin_amdgcn_mov_dpp(__float_as_int(x), 0x121, 0xf, 0xf, true)); }
__device__ __forceinline__ float dpp_ror2(float x) { return __int_as_float(__builtin_amdgcn_mov_dpp(__float_as_int(x), 0x122, 0xf, 0xf, true)); }
__device__ __forceinline__ float vmul_s(float a, float b) { float r; asm volatile("v_mul_f32_e32 %0, %1, %2" : "=v"(r) : "v"(a), "v"(b)); return r; }
struct EpiConv {
    static constexpr bool PERM = false, AFTER_DRAIN = false;
    const PG8_LAS float* rstdl; const float* cw; const float* cb; bf16_t* act; float* fix; PG8_LAS unsigned char* halo; PG8_LAS float* ctab;
    __device__ __forceinline__ void operator()(const f32x4 (&acc)[2][2][4][2], const Unit& u, int wr, int wc, int fr_, int fq_) const {
        int fr = fr_, fq = fq_; asm volatile("" : "+v"(fr), "+v"(fq));
        const int row0 = u.pm * BM + wr * 64 + fr, cl = wc * 32 + 4 * fq;
        {
            const int q = 2 * ((wr * 4 + wc) * 64 + fq * 16 + fr), p = q >> 8, col = q & 255;
            const float* src = (p < 3 ? cw + (size_t)p * DFF2 : cb) + (col < 128 ? 128 * u.pn + col : DFF + 128 * u.pn + (col - 128));
            typedef float f32x2w __attribute__((ext_vector_type(2)));
            *(PG8_LAS f32x2w*)(ctab + q) = *(const f32x2w*)src;
        }
        float rs[2][4];
#pragma unroll
        for (int ai = 0; ai < 2; ++ai)
#pragma unroll
            for (int m = 0; m < 4; ++m) rs[ai][m] = rstdl[u.idx * 256 + wr * 64 + fr + ai * HALF + m * 16];
        if (fr >= 14) {
#pragma unroll
            for (int ai = 0; ai < 2; ++ai)
#pragma unroll
                for (int bj = 0; bj < 2; ++bj)
#pragma unroll
                    for (int n = 0; n < 2; ++n) { const f32x4 v = acc[ai][bj][3][n] * rs[ai][3];
                        *(PG8_LAS f32x4*)(halo + ((((ai * 2 + wr) * 2 + (fr - 14)) * 256) + bj * HALF + cl + n * 16) * 4) = v;
                        if (ai == 1 && wr == 1) *(f32x4*)(fix + (size_t)(u.pm * 4 + 2 + (fr - 14)) * DFF2 + bj * DFF + 128 * u.pn + cl + n * 16) = v; }
        }
        if (fr < 2 && wr == 0) {
#pragma unroll
            for (int bj = 0; bj < 2; ++bj)
#pragma unroll
                for (int n = 0; n < 2; ++n) *(f32x4*)(fix + (size_t)(u.pm * 4 + fr) * DFF2 + bj * DFF + 128 * u.pn + cl + n * 16) = acc[0][bj][0][n] * rs[0][0];
        }
        asm volatile("s_waitcnt lgkmcnt(0)\n\ts_barrier" ::: "memory");
        typedef float f32x2v __attribute__((ext_vector_type(2)));
#pragma unroll
        for (int n = 0; n < 2; ++n) {
            const unsigned la2 = (unsigned)(fr * DFF + cl) * 2u;
            unsigned wpk[2][2][4];
#pragma unroll
            for (int eh = 0; eh < 2; ++eh) {
                asm volatile("" ::: "memory"); __builtin_amdgcn_sched_barrier(0);
                const int e = 2 * eh;
#define CWL(p, g) (*(const PG8_LAS f32x2v*)(ctab + (p) * 256 + (g) * 128 + cl + n * 16 + e))
                const f32x2v wu0 = CWL(0, 0), wu1 = CWL(1, 0), wu2 = CWL(2, 0), bu = CWL(3, 0);
                const f32x2v wg0 = CWL(0, 1), wg1 = CWL(1, 1), wg2 = CWL(2, 1), bg = CWL(3, 1);
#undef CWL
#pragma unroll
                for (int ai = 0; ai < 2; ++ai) {
                    const int ps = (ai * 2 + wr) ? (ai * 2 + wr - 1) : 0;
                    const PG8_LAS float* hp = (const PG8_LAS float*)halo + (ps * 2) * 256 + cl + n * 16 + e;
                    const f32x2v hu62 = *(const PG8_LAS f32x2v*)hp, hu63 = *(const PG8_LAS f32x2v*)(hp + 256), hg62 = *(const PG8_LAS f32x2v*)(hp + 128), hg63 = *(const PG8_LAS f32x2v*)(hp + 256 + 128);
                    f32x2v p1u = hu63, p1g = hg63, p2u = fr == 0 ? hu62 : hu63, p2g = fr == 0 ? hg62 : hg63;
#pragma unroll
                    for (int m = 0; m < 4; ++m) {
                        __builtin_amdgcn_sched_barrier(0);
                        f32x2v xu, xg;
                        xu.x = vmul_s(acc[ai][0][m][n][e], rs[ai][m]); xu.y = vmul_s(acc[ai][0][m][n][e + 1], rs[ai][m]); xg.x = vmul_s(acc[ai][1][m][n][e], rs[ai][m]); xg.y = vmul_s(acc[ai][1][m][n][e + 1], rs[ai][m]);
                        f32x2v r1u, r2u, r1g, r2g;
                        r1u.x = dpp_ror1(xu.x); r1u.y = dpp_ror1(xu.y); r2u.x = dpp_ror2(xu.x); r2u.y = dpp_ror2(xu.y);
                        r1g.x = dpp_ror1(xg.x); r1g.y = dpp_ror1(xg.y); r2g.x = dpp_ror2(xg.x); r2g.y = dpp_ror2(xg.y);
                        const f32x2v x1u = fr >= 1 ? r1u : p1u, x2u = fr >= 2 ? r2u : p2u, x1g = fr >= 1 ? r1g : p1g, x2g = fr >= 2 ? r2g : p2g;
                        p1u = r1u; p2u = r2u; p1g = r1g; p2g = r2g;
                        const f32x2v cu = bu + wu0 * x2u + wu1 * x1u + wu2 * xu, cg = bg + wg0 * x2g + wg1 * x1g + wg2 * xg;
                        const float o0 = cg.x * __builtin_amdgcn_rcpf(1.f + __builtin_amdgcn_exp2f(-1.4426950408889634f * cg.x)) * cu.x;
                        const float o1 = cg.y * __builtin_amdgcn_rcpf(1.f + __builtin_amdgcn_exp2f(-1.4426950408889634f * cg.y)) * cu.y;
                        wpk[eh][ai][m] = pk2bf(o0, o1);
                    }
                }
            }
#pragma unroll
            for (int ai = 0; ai < 2; ++ai)
#pragma unroll
                for (int m = 0; m < 4; ++m)
                {
                    u32x2 w; w.x = wpk[0][ai][m]; w.y = wpk[1][ai][m];
                    *(u32x2*)((char*)(act + (size_t)(u.pm * BM + wr * 64 + ai * HALF + m * 16) * DFF + 128 * u.pn + n * 16) + la2) = w; }
        }
    }
};

#ifdef TPROBE
#ifndef TPROBE_PH
#define TPROBE_PH -1
#endif
#define PG8_TP(ph) do { if (TPROBE < 20) break; const unsigned t_ = (unsigned)__builtin_amdgcn_s_memrealtime(); if (wave_s == 0 && lane_id() == 0) { volatile PG8_LAS unsigned* q_ = (volatile PG8_LAS unsigned*)(lds + (163840 - 1024 + 512)); \
        if ((ph) == TPROBE && (TPROBE_PH < 0 || q_[2] == (unsigned)TPROBE_PH)) q_[1] += t_ - q_[0]; q_[0] = t_; } } while (0)
#else
#define PG8_TP(ph) do {} while (0)
#endif
template <class Epi, class Sched, bool ALIGN_EPI = false, bool SP2 = false>
__device__ __forceinline__ void gemm_phase(PG8_LAS unsigned char* lds, const Gemm g, const Sched& S, const Epi& E, const int wave_s) {
    int tid_ = wave_s * 64 + lane_id(); asm volatile("" : "+v"(tid_));
    const int tid = tid_, wid = wave_s, lane = tid & 63, wr = wid >> 2, wc = wid & 3, fr = lane & 15, fq = lane >> 4;
    const int K = g.K, nt = K / BK;
    unsigned voffA[2], voffB[2];
#pragma unroll
    for (int i = 0; i < 2; ++i) { int R, C; stage_rc(tid * 16 + i * 8192, R, C); const int Rb = Epi::PERM ? ((R & ~31) + perm32(R & 31)) : R;
        voffA[i] = (unsigned)(R * K + C) * 2u; voffB[i] = (unsigned)(Rb * K + C) * 2u; }
    const size_t kstep = (size_t)(BK * 2);
    const size_t hstep = (size_t)HALF * K * 2;
    const size_t tstep = 2 * hstep;
    const unsigned ldsw = (unsigned)wid * 1024u;
    const int aoff = lds_byte(wr * 64 + fr, fq * 8), boff = lds_byte(wc * 32 + fr, fq * 8);
#define PG8_SA(b, h) (((b) * 2 + (h)) * HTB)
#define PG8_SB(b, h) ((4 + (b) * 2 + (h)) * HTB)
#define PG8_STAGE(bufoff, gbase, voff) do { _Pragma("unroll") for (int _i = 0; _i < 2; ++_i) \
        __builtin_amdgcn_global_load_lds((const unsigned*)((const char*)(gbase) + (voff)[_i]), (PG8_LAS unsigned*)(lds + (bufoff) + ldsw + _i * 8192), 16, 0, 0); } while (0)
#define PG8_LDA(dst, b, h) do { _Pragma("unroll") for (int m = 0; m < 4; ++m) _Pragma("unroll") for (int k = 0; k < 2; ++k) dst[m][k] = *(const PG8_LAS bf16x8*)(lds + PG8_SA(b, h) + aoff + m * 2048 + k * 1024); } while (0)
#define PG8_LDB(dst, b, h) do { _Pragma("unroll") for (int n = 0; n < 2; ++n) _Pragma("unroll") for (int k = 0; k < 2; ++k) dst[n][k] = *(const PG8_LAS bf16x8*)(lds + PG8_SB(b, h) + boff + n * 2048 + k * 1024); } while (0)
#define PG8_MMA(ai, bj, At, Bt) do { __builtin_amdgcn_s_setprio(1); _Pragma("unroll") for (int m = 0; m < 4; ++m) _Pragma("unroll") for (int n = 0; n < 2; ++n) _Pragma("unroll") for (int k = 0; k < 2; ++k) \
        acc[ai][bj][m][n] = __builtin_amdgcn_mfma_f32_16x16x32_bf16(Bt[n][k], At[m][k], acc[ai][bj][m][n], 0, 0, 0); __builtin_amdgcn_s_setprio(0); } while (0)
#define PG8_WAIT_V(n) asm volatile("s_waitcnt vmcnt(" #n ")" ::: "memory")
#define PG8_WAIT_L(n) asm volatile("s_waitcnt lgkmcnt(" #n ")" ::: "memory")
#define PG8_BAR __builtin_amdgcn_s_barrier()
#define PG8_SCHED __builtin_amdgcn_sched_barrier(0)
    Unit cur, nxt; int ui = 0;
    if (!S.next(0, cur)) return;
    f32x4 acc[2][2][4][2];
#pragma unroll
    for (int a = 0; a < 2; ++a)
#pragma unroll
        for (int b = 0; b < 2; ++b)
#pragma unroll
            for (int m = 0; m < 4; ++m)
#pragma unroll
                for (int n = 0; n < 2; ++n) acc[a][b][m][n] = (f32x4){0.f, 0.f, 0.f, 0.f};
    bf16x8 At[4][2], B0[2][2], B1[2][2];
    const char* cA = (const char*)g.A + (size_t)cur.pm * tstep; const char* cB = (const char*)g.Bt + (size_t)cur.pn * tstep;
    S.a_ready(cur);
    if constexpr (SP2) {
        PG8_STAGE(PG8_SB(0, 0), cB, voffB); PG8_STAGE(PG8_SB(0, 1), cB + hstep, voffB); PG8_STAGE(PG8_SA(0, 0), cA, voffA); PG8_STAGE(PG8_SA(0, 1), cA + hstep, voffA);
        if (wr == 1) PG8_BAR;
        PG8_WAIT_V(2); PG8_BAR;
        PG8_STAGE(PG8_SB(1, 0), cB + kstep, voffB); PG8_STAGE(PG8_SA(1, 0), cA + kstep, voffA); PG8_STAGE(PG8_SB(1, 1), cB + hstep + kstep, voffB);
        PG8_WAIT_V(6); PG8_BAR;
    } else {
        PG8_STAGE(PG8_SB(0, 0), cB, voffB); PG8_STAGE(PG8_SA(0, 0), cA, voffA); PG8_STAGE(PG8_SB(0, 1), cB + hstep, voffB); PG8_STAGE(PG8_SA(0, 1), cA + hstep, voffA);
        if (wr == 1) PG8_BAR;
        PG8_WAIT_V(4); PG8_BAR;
        PG8_STAGE(PG8_SB(1, 0), cB + kstep, voffB); PG8_STAGE(PG8_SA(1, 0), cA + kstep, voffA); PG8_STAGE(PG8_SB(1, 1), cB + hstep + kstep, voffB);
        PG8_WAIT_V(6); PG8_BAR;
    }
    for (;;) {
        const bool has_next = S.next(ui + 1, nxt);
        const char* nA = has_next ? (const char*)g.A + (size_t)nxt.pm * tstep : cA; const char* nB = has_next ? (const char*)g.Bt + (size_t)nxt.pn * tstep : cB;
        for (int t = 0; t < nt; t += 2) {
            const bool last = (t == nt - 2);
            const char* a1 = cA + (size_t)(t + 1) * kstep;
            const char* a2 = last ? nA : cA + (size_t)(t + 2) * kstep; const char* b2 = last ? nB : cB + (size_t)(t + 2) * kstep;
            const char* a3 = a2 + kstep; const char* b3 = b2 + kstep;
            if (last && has_next) S.a_ready(nxt);
            if constexpr (SP2) {
            PG8_LDB(B0, 0, 0); PG8_LDB(B1, 0, 1); PG8_SCHED; PG8_LDA(At, 0, 0); PG8_STAGE(PG8_SA(1, 1), a1 + hstep, voffA);
            PG8_WAIT_V(8); PG8_WAIT_L(0); PG8_BAR; PG8_MMA(0, 0, At, B0); PG8_MMA(0, 1, At, B1); PG8_BAR; PG8_SCHED;
            PG8_LDA(At, 0, 1); PG8_STAGE(PG8_SB(0, 0), b2, voffB); PG8_STAGE(PG8_SB(0, 1), b2 + hstep, voffB); PG8_STAGE(PG8_SA(0, 0), a2, voffA);
            PG8_WAIT_V(8); PG8_WAIT_L(0); PG8_BAR; PG8_MMA(1, 0, At, B0); PG8_MMA(1, 1, At, B1); PG8_BAR; PG8_SCHED;
            PG8_LDB(B0, 1, 0); PG8_LDB(B1, 1, 1); PG8_SCHED; PG8_LDA(At, 1, 0); PG8_STAGE(PG8_SA(0, 1), a2 + hstep, voffA);
            PG8_WAIT_V(8); PG8_WAIT_L(0); PG8_BAR; PG8_MMA(0, 0, At, B0); PG8_MMA(0, 1, At, B1); PG8_BAR; PG8_SCHED;
            PG8_LDA(At, 1, 1); PG8_STAGE(PG8_SB(1, 0), b3, voffB); PG8_STAGE(PG8_SB(1, 1), b3 + hstep, voffB); PG8_STAGE(PG8_SA(1, 0), a3, voffA);
            PG8_WAIT_V(8); PG8_WAIT_L(0); PG8_BAR; PG8_MMA(1, 0, At, B0); PG8_MMA(1, 1, At, B1); PG8_BAR; PG8_SCHED;
            } else {
            PG8_LDB(B0, 0, 0); PG8_SCHED; PG8_LDA(At, 0, 0); PG8_STAGE(PG8_SA(1, 1), a1 + hstep, voffA);
            PG8_WAIT_L(8); PG8_BAR; PG8_WAIT_L(0); PG8_MMA(0, 0, At, B0); PG8_BAR; PG8_SCHED;
            PG8_LDB(B1, 0, 1); PG8_STAGE(PG8_SB(0, 0), b2, voffB);
            PG8_BAR; PG8_WAIT_L(0); PG8_MMA(0, 1, At, B1); PG8_BAR;
            PG8_LDA(At, 0, 1); PG8_STAGE(PG8_SA(0, 0), a2, voffA);
            PG8_BAR; PG8_WAIT_L(0); PG8_MMA(1, 0, At, B0); PG8_BAR; PG8_SCHED;
            PG8_STAGE(PG8_SB(0, 1), b2 + hstep, voffB);
            PG8_WAIT_V(6); PG8_BAR; PG8_MMA(1, 1, At, B1); PG8_BAR;
            PG8_LDB(B0, 1, 0); PG8_SCHED; PG8_LDA(At, 1, 0); PG8_STAGE(PG8_SA(0, 1), a2 + hstep, voffA);
            PG8_WAIT_L(8); PG8_BAR; PG8_WAIT_L(0); PG8_MMA(0, 0, At, B0); PG8_BAR; PG8_SCHED;
            PG8_LDB(B1, 1, 1); PG8_STAGE(PG8_SB(1, 0), b3, voffB);
            PG8_BAR; PG8_WAIT_L(0); PG8_MMA(0, 1, At, B1); PG8_BAR;
            PG8_LDA(At, 1, 1); PG8_STAGE(PG8_SA(1, 0), a3, voffA);
            PG8_BAR; PG8_WAIT_L(0); PG8_MMA(1, 0, At, B0); PG8_BAR; PG8_SCHED;
            PG8_STAGE(PG8_SB(1, 1), b3 + hstep, voffB);
            PG8_WAIT_V(6); PG8_BAR; PG8_MMA(1, 1, At, B1); PG8_BAR;
            }
        }
        PG8_TP(49);
        if constexpr (ALIGN_EPI) { if (wr == 0) PG8_BAR; }
        if constexpr (!Epi::AFTER_DRAIN) { E(acc, cur, wr, wc, fr, fq); S.done(cur); }
        PG8_TP(50);
        if (!has_next) break;
#pragma unroll
        for (int a = 0; a < 2; ++a)
#pragma unroll
            for (int b = 0; b < 2; ++b)
#pragma unroll
                for (int m = 0; m < 4; ++m)
#pragma unroll
                    for (int n = 0; n < 2; ++n) acc[a][b][m][n] = (f32x4){0.f, 0.f, 0.f, 0.f};
        cur = nxt; cA = nA; cB = nB; ++ui;
        if constexpr (ALIGN_EPI) { if (wr == 1) PG8_BAR; }
    }
    PG8_WAIT_V(0);
    if constexpr (!ALIGN_EPI) { if (wr == 0) PG8_BAR; }
    PG8_BAR;
    if constexpr (Epi::AFTER_DRAIN) { E.fused(acc, cur, wr, wc, fr, fq, lds, wid, lane); S.done(cur); }
#undef PG8_SA
#undef PG8_SB
#undef PG8_STAGE
#undef PG8_LDA
#undef PG8_LDB
#undef PG8_MMA
#undef PG8_WAIT_V
#undef PG8_WAIT_L
#undef PG8_BAR
#undef PG8_SCHED
}
}
#include <hip/hip_bf16.h>
#include <cmath>
namespace attn_body {
using bf16=__hip_bfloat16;
using bf16x8=__attribute__((ext_vector_type(8)))short;
using s16x4=__attribute__((ext_vector_type(4)))short;
using f32x16=__attribute__((ext_vector_type(16)))float;
using u32x4=__attribute__((ext_vector_type(4)))unsigned;
constexpr int BATCH=8,NHEAD=8,SEQ=2048,D=64,PITCH=3584,OPITCH=1024,LEADROW=16384,VK=2176;
constexpr int NW=8,QBLK=32,QB=QBLK*NW,KVBLK=64,NQB=SEQ/QB;
constexpr int ATTN_UNIT_ROWS=QB;
__device__ __forceinline__ int crow(int r,int hi){return (r&3)+8*(r>>2)+4*hi;}
#define SBAR() __builtin_amdgcn_sched_barrier(0)
__device__ __forceinline__ void cmask(f32x16&p0,f32x16&p1,int jb,int qrel,int hi){
  const float NEG=-INFINITY; int kb=64*jb+4*hi;
  #pragma unroll
  for(int r=0;r<16;++r){int kv=kb+(r&3)+8*(r>>2); if(kv>qrel)p0[r]=NEG; if(kv+32>qrel)p1[r]=NEG;}
}

constexpr int NSLOT=3, SLOTB=8192;
constexpr int LDS_K=0, LDS_V=NSLOT*SLOTB, LDS_WS=2*NSLOT*SLOTB, LDS_OST=LDS_WS+NW*64*4, LDS_C2=LDS_OST+NW*4096, LDS_BYTES=LDS_C2+VK*4;
constexpr float C2=0.125f*1.4426950408889634f;
__device__ __forceinline__ void glds16(const void*gsrc,unsigned lds_dst){unsigned keep;
  asm volatile("s_mov_b32 %0, m0\n\ts_mov_b32 m0, %2\n\ts_nop 0\n\tglobal_load_lds_dwordx4 %1, off\n\ts_mov_b32 m0, %0":"=&s"(keep):"v"(gsrc),"s"(lds_dst):"memory");}
__device__ __forceinline__ float max3f(float a,float b,float c){float r;asm("v_max3_f32 %0, %1, %2, %3":"=v"(r):"v"(a),"v"(b),"v"(c));return r;}
__device__ __forceinline__ float max2f(float a,float b){float r;asm("v_max_f32_e32 %0, %1, %2":"=v"(r):"v"(a),"v"(b));return r;}
__device__ __forceinline__ float fadd_s(float a,float b){float r;asm("v_add_f32_e32 %0, %1, %2":"=v"(r):"v"(a),"v"(b));return r;}
__device__ __forceinline__ float fsub_s(float a,float b){float r;asm("v_sub_f32_e32 %0, %1, %2":"=v"(r):"v"(a),"v"(b));return r;}
typedef float f32x2_t __attribute__((ext_vector_type(2))); typedef __bf16 bf16x2_t __attribute__((ext_vector_type(2)));
__device__ __forceinline__ unsigned cvtpk_s(float lo,float hi){f32x2_t v={lo,hi};bf16x2_t b=__builtin_convertvector(v,bf16x2_t);return __builtin_bit_cast(unsigned,b);}
#define WAIT_BAR(N) asm volatile("s_waitcnt vmcnt(" #N ") lgkmcnt(0)\n\ts_barrier":::"memory")

__device__ __forceinline__ void qkt(f32x16&p0,f32x16&p1,const char*Kslot,const bf16x8*qr,int r32,int hi){
  const char*kb=Kslot+hi*1024+r32*16;
  #pragma unroll
  for(int d0=0;d0<4;++d0){
    const bf16x8 b0=*reinterpret_cast<const bf16x8*>(kb+d0*2048);
    const bf16x8 b1=*reinterpret_cast<const bf16x8*>(kb+d0*2048+512);
    p0=__builtin_amdgcn_mfma_f32_32x32x16_bf16(b0,qr[d0],p0,0,0,0);p1=__builtin_amdgcn_mfma_f32_32x32x16_bf16(b1,qr[d0],p1,0,0,0);}
}
typedef __attribute__((address_space(3))) const char* lds_cptr;
typedef short v4i16_t __attribute__((ext_vector_type(4)));
__device__ __forceinline__ void kload8(bf16x8*kf,lds_cptr kp){
  kf[0]=*(const __attribute__((address_space(3))) bf16x8*)(kp);      kf[1]=*(const __attribute__((address_space(3))) bf16x8*)(kp+512);
  kf[2]=*(const __attribute__((address_space(3))) bf16x8*)(kp+2048); kf[3]=*(const __attribute__((address_space(3))) bf16x8*)(kp+2560);
  kf[4]=*(const __attribute__((address_space(3))) bf16x8*)(kp+4096); kf[5]=*(const __attribute__((address_space(3))) bf16x8*)(kp+4608);
  kf[6]=*(const __attribute__((address_space(3))) bf16x8*)(kp+6144); kf[7]=*(const __attribute__((address_space(3))) bf16x8*)(kp+6656);
}
__device__ __forceinline__ void kload2(bf16x8*kf,lds_cptr kp,int j){ kf[2*j]=*(const __attribute__((address_space(3))) bf16x8*)(kp+j*2048); kf[2*j+1]=*(const __attribute__((address_space(3))) bf16x8*)(kp+j*2048+512); }
__device__ __forceinline__ s16x4 vtr(lds_cptr p){ return __builtin_bit_cast(s16x4,__builtin_amdgcn_ds_read_tr16_b64_v4i16((__attribute__((address_space(3))) v4i16_t*)p)); }
__device__ __forceinline__ float rowmax(const f32x16&p0,const f32x16&p1){
  float a=max3f(p0[0],p0[1],p1[0]),b=max3f(p0[2],p0[3],p1[1]);a=max3f(a,p1[2],p1[3]);
  #pragma unroll
  for(int r=4;r<16;r+=4){a=max3f(a,p0[r],p0[r+1]);b=max3f(b,p0[r+2],p0[r+3]);a=max3f(a,p1[r],p1[r+1]);b=max3f(b,p1[r+2],p1[r+3]);}
  const float m=max2f(a,b);
  auto rr=__builtin_amdgcn_permlane32_swap(__float_as_uint(m),__float_as_uint(m),false,false);
  return max2f(__uint_as_float(rr[0]),__uint_as_float(rr[1]));
}
__device__ __forceinline__ void pv(f32x16*o,int vb,bf16x8 pa0,bf16x8 pa1,bf16x8 pa2,bf16x8 pa3){
  #pragma unroll
  for(int d0=0;d0<2;++d0){s16x4 lo[4],hi[4];
    #pragma unroll
    for(int ks=0;ks<4;++ks){
      asm volatile("ds_read_b64_tr_b16 %0,%1 offset:%c2":"=&v"(lo[ks]):"v"(vb),"i"(d0*4096+ks*1024):"memory");
      asm volatile("ds_read_b64_tr_b16 %0,%1 offset:%c2":"=&v"(hi[ks]):"v"(vb),"i"(d0*4096+ks*1024+512):"memory");}
    asm volatile("s_waitcnt lgkmcnt(0)":::"memory");SBAR();
    #define PK(k) (bf16x8){lo[k][0],lo[k][1],lo[k][2],lo[k][3],hi[k][0],hi[k][1],hi[k][2],hi[k][3]}
    o[d0]=__builtin_amdgcn_mfma_f32_32x32x16_bf16(pa0,PK(0),o[d0],0,0,0);
    o[d0]=__builtin_amdgcn_mfma_f32_32x32x16_bf16(pa1,PK(1),o[d0],0,0,0);
    o[d0]=__builtin_amdgcn_mfma_f32_32x32x16_bf16(pa2,PK(2),o[d0],0,0,0);
    o[d0]=__builtin_amdgcn_mfma_f32_32x32x16_bf16(pa3,PK(3),o[d0],0,0,0);
    #undef PK
  }
}

#ifndef ATTN_STORE16
#define ATTN_STORE16(p,v) (*(u32x4*)(p)=(v))
#endif
template<int THRL> __device__ __forceinline__ void attn_unit(int b,int h,int qb,const bf16*Q,const bf16*__restrict__ K,const bf16*__restrict__ V,const bf16*__restrict__ OG,const float*__restrict__ c2v,bf16*O,char*shm,const int wave_s,const bool stage_c2=true){
  int tid_=wave_s*64+lane_id(); asm volatile("":"+v"(tid_));
  const int tid=tid_,lane=tid&63,r32=lane&31,hi=lane>>5; const int wid=wave_s;
  const long rowbase=(long)b*SEQ; const int q0=qb*QB;
  const bf16*Qw=Q+(rowbase+q0+wid*QBLK)*PITCH+h*D;
  const bf16*Kh=K+(rowbase-2*KVBLK)*PITCH+h*D,*Vh=V+(rowbase-2*KVBLK)*PITCH+h*D;
  const bf16*KhL=K+(long)LEADROW*PITCH+h*D,*VhL=V+(long)LEADROW*PITCH+h*D;
  const unsigned lds0=(unsigned)(uintptr_t)shm;
  float*wsf=(float*)(shm+LDS_WS)+wid*64;
  const bf16*ksrc=Kh+(long)lane*PITCH+wid*8,*ksrcL=KhL+(long)lane*PITCH+wid*8;
  const bf16*vsrc=Vh+(long)(16*(wid&3)+(lane>>2))*PITCH+(wid>>2)*32+(lane&3)*8,*vsrcL=VhL+(long)(16*(wid&3)+(lane>>2))*PITCH+(wid>>2)*32+(lane&3)*8;
  const unsigned kdst=lds0+LDS_K+wid*1024, vdst=lds0+LDS_V+wid*1024;
  #define DMA_K(t,slot) glds16(((t)<2?ksrcL:ksrc)+(long)(t)*KVBLK*PITCH,(unsigned)__builtin_amdgcn_readfirstlane(kdst+(slot)))
  #define DMA_V(t,slot) glds16(((t)<2?vsrcL:vsrc)+(long)(t)*KVBLK*PITCH,(unsigned)__builtin_amdgcn_readfirstlane(vdst+(slot)))
  const int vb0=(int)(lds0+LDS_V)+((lane>>4)&1)*32+(lane&3)*8+(4*hi+((lane&15)>>2))*64;
  const char*Kbase=shm+LDS_K; bf16x8 kf[8];
  const lds_cptr shm3=(lds_cptr)shm; const lds_cptr kp0=shm3+LDS_K+hi*1024+r32*16; const lds_cptr vp0=shm3+LDS_V+((lane>>4)&1)*32+(lane&3)*8+(4*hi+((lane&15)>>2))*64;
  const int NT=(q0+QB)/KVBLK+2;
  if(stage_c2){ __attribute__((address_space(3))) float*negc_w=(__attribute__((address_space(3))) float*)((lds_cptr)shm+LDS_C2); const float*cs=c2v+(long)(b*NHEAD+h)*VK;
    float cv_[5];
    _Pragma("unroll") for(int i_=0;i_<5;++i_){const int i=tid+i_*NW*64; cv_[i_]=i<NT*KVBLK?cs[i]:0.f;}
    _Pragma("unroll") for(int i_=0;i_<5;++i_){const int i=tid+i_*NW*64; if(i<NT*KVBLK)negc_w[i]=-cv_[i_];} }
  const __attribute__((address_space(3))) float* negc3=(const __attribute__((address_space(3))) float*)((lds_cptr)shm+LDS_C2)+4*hi;
  typedef float f32x4_t __attribute__((ext_vector_type(4)));
  #define NEGC(t,i) (*(const __attribute__((address_space(3))) f32x4_t*)(negc3+64*(t)+(((i)>>2)*32)+8*((i)&3)))
  DMA_K(0,0);DMA_V(0,0);DMA_K(1,SLOTB);
  bf16x8 qr[4];
  #pragma unroll
  for(int d0=0;d0<4;++d0)qr[d0]=*reinterpret_cast<const bf16x8*>(&Qw[(long)r32*PITCH+d0*16+hi*8]);
  float mhat=0.f,l_reg=0.f;f32x16 o[2];o[0]=f32x16{};o[1]=f32x16{};
  const int qrel=wid*QBLK+r32;
  #define CMASK(P0,P1,t) do{int jb_=(t)-(NT-4); if(jb_>=0)cmask(P0,P1,jb_,qrel,hi);}while(0)
  bool resc=false;
  #define START(P0,P1) do{ const float rm=rowmax(P0,P1); resc=false; \
    { const float dl=rm; mhat=fadd_s(mhat,dl); \
      _Pragma("unroll") for(int r=0;r<16;++r){P0[r]=fsub_s(P0[r],dl);P1[r]=fsub_s(P1[r],dl);} } \
    _Pragma("unroll") for(int r=0;r<16;++r)P0[r]=__builtin_amdgcn_exp2f(P0[r]); }while(0)
  #define RESC() do{ if(resc){ asm volatile("s_waitcnt lgkmcnt(0)":::"memory"); \
      _Pragma("unroll") for(int d_=0;d_<2;++d_) _Pragma("unroll") for(int r=0;r<16;++r)o[d_][r]*=wsf[crow(r,hi)]; } }while(0)
  f32x16 pA0,pA1,pB0,pB1;
  int sl_prev=0,sl_cur=0,sl_next=SLOTB;
  #define ROT() do{sl_prev=sl_cur;sl_cur=sl_next;sl_next=(sl_next==(NSLOT-1)*SLOTB)?0:sl_next+SLOTB;}while(0)
  DMA_K(2,2*SLOTB);
  WAIT_BAR(3);
  #define FILLT(P0,P1,t) do{ _Pragma("unroll") for(int i_=0;i_<4;++i_){ const f32x4_t a_=NEGC(t,i_),b_=NEGC(t,4+i_); \
      P0[4*i_]=a_[0]-mhat;P0[4*i_+1]=a_[1]-mhat;P0[4*i_+2]=a_[2]-mhat;P0[4*i_+3]=a_[3]-mhat; P1[4*i_]=b_[0]-mhat;P1[4*i_+1]=b_[1]-mhat;P1[4*i_+2]=b_[2]-mhat;P1[4*i_+3]=b_[3]-mhat; } }while(0)
  FILLT(pA0,pA1,0);
  qkt(pA0,pA1,Kbase,qr,r32,hi);asm volatile("s_nop 15\n\ts_nop 7":"+v"(pA0),"+v"(pA1));CMASK(pA0,pA1,0);
  START(pA0,pA1);
  FILLT(pB0,pB1,1);
  _Pragma("unroll") for(int r=0;r<16;++r)pA1[r]=__builtin_amdgcn_exp2f(pA1[r]);
  WAIT_BAR(0);
  DMA_K(3,0);DMA_V(1,SLOTB);
  ROT();
  kload8(kf,kp0+sl_cur);
  WAIT_BAR(2);
  s16x4 vlo[8],vhi[8]; u32x4 pw0,pw1,pw2,pw3;
  #define PKW(P,B) cvtpk_s(P[B],P[B+1])
  #define PAF(k) __builtin_bit_cast(bf16x8,pw##k)
  #define VFR(i) (bf16x8){vlo[i][0],vlo[i][1],vlo[i][2],vlo[i][3],vhi[i][0],vhi[i][1],vhi[i][2],vhi[i][3]}
  #define PIN(x) asm volatile("":"+v"(x))
  #define MX3(a,b,c) __builtin_fmaxf(__builtin_fmaxf((a),(b)),(c))
  #define GAPA(MF,A0,A1,A2,A3,W0,W1,PW) do{ MF; sacc+=A0; sacc+=A1; sacc+=A2; sacc+=A3; PIN(sacc); W0; W1; PIN(PW); SBAR(); }while(0)
  #define EX(v) __builtin_amdgcn_exp2f(v)
  #define GAPB(MF,X,B,FP,FB,I,t,GF) do{ MF; X[B]=EX(X[B]); X[B+1]=EX(X[B+1]); X[B+2]=EX(X[B+2]); X[B+3]=EX(X[B+3]); \
      if(GF){ FP[FB]=fsub_s(cn_[0],mhat); FP[FB+1]=fsub_s(cn_[1],mhat); FP[FB+2]=fsub_s(cn_[2],mhat); FP[FB+3]=fsub_s(cn_[3],mhat); PIN(FP); if((I)<7){cn_=NEGC((t)+1,(I)+1);} } \
      PIN(X); SBAR(); }while(0)
  #define VRD(i) do{ vlo[i]=vtr(vp_+(((i)>>2)*4096+((i)&3)*1024)); vhi[i]=vtr(vp_+(((i)>>2)*4096+((i)&3)*1024+512)); }while(0)
  #define KRD(G,j) do{ if(G){ kload2(kf,kp0+sl_next,j); SBAR(); } }while(0)
  #define STEP(C0,C1,P0,P1,t,GK,GV,GL) do{ SBAR(); \
    const lds_cptr vp_=vp0+sl_prev; \
    VRD(0); SBAR(); float sacc=(P0[0]+P0[1]); \
    GAPA(C0=__builtin_amdgcn_mfma_f32_32x32x16_bf16(kf[0],qr[0],C0,0,0,0), P0[2],P0[3],P0[4],P0[5],     pw0[0]=PKW(P0,0), pw0[1]=PKW(P0,2), pw0); \
    VRD(4); SBAR(); GAPA(C1=__builtin_amdgcn_mfma_f32_32x32x16_bf16(kf[1],qr[0],C1,0,0,0), P0[6],P0[7],P0[8],P0[9],     pw0[2]=PKW(P0,4), pw0[3]=PKW(P0,6), pw0); \
    VRD(1); SBAR(); GAPA(C0=__builtin_amdgcn_mfma_f32_32x32x16_bf16(kf[2],qr[1],C0,0,0,0),   P0[10],P0[11],P0[12],P0[13], pw1[0]=PKW(P0,8), pw1[1]=PKW(P0,10), pw1); \
    VRD(5); SBAR(); GAPA(C1=__builtin_amdgcn_mfma_f32_32x32x16_bf16(kf[3],qr[1],C1,0,0,0),   P0[14],P0[15],P1[0],P1[1],   pw1[2]=PKW(P0,12),pw1[3]=PKW(P0,14), pw1); \
    VRD(2); SBAR(); GAPA(C0=__builtin_amdgcn_mfma_f32_32x32x16_bf16(kf[4],qr[2],C0,0,0,0),   P1[2],P1[3],P1[4],P1[5],     pw2[0]=PKW(P1,0), pw2[1]=PKW(P1,2), pw2); \
    VRD(6); SBAR(); GAPA(C1=__builtin_amdgcn_mfma_f32_32x32x16_bf16(kf[5],qr[2],C1,0,0,0),   P1[6],P1[7],P1[8],P1[9],     pw2[2]=PKW(P1,4), pw2[3]=PKW(P1,6), pw2); \
    VRD(3); SBAR(); GAPA(C0=__builtin_amdgcn_mfma_f32_32x32x16_bf16(kf[6],qr[3],C0,0,0,0),   P1[10],P1[11],P1[12],P1[13], pw3[0]=PKW(P1,8), pw3[1]=PKW(P1,10), pw3); \
    VRD(7); SBAR(); GAPA(C1=__builtin_amdgcn_mfma_f32_32x32x16_bf16(kf[7],qr[3],C1,0,0,0),   P1[14],P1[15],0.f,0.f,       pw3[2]=PKW(P1,12),pw3[3]=PKW(P1,14), pw3); \
    l_reg+=sacc; \
    if(GK){DMA_K((t)+3,sl_cur);} if(GV){DMA_V((t)+1,sl_next);} \
    CMASK(C0,C1,t); \
    { float a=MX3(C0[0],C0[1],C1[0]),b=MX3(C0[2],C0[3],C1[1]); a=MX3(a,C1[2],C1[3]); \
      _Pragma("unroll") for(int r=4;r<16;r+=4){a=MX3(a,C0[r],C0[r+1]);b=MX3(b,C0[r+2],C0[r+3]);a=MX3(a,C1[r],C1[r+1]);b=MX3(b,C1[r+2],C1[r+3]);} \
      float rm=__builtin_fmaxf(a,b); { auto rr=__builtin_amdgcn_permlane32_swap(__float_as_uint(rm),__float_as_uint(rm),false,false); rm=__builtin_fmaxf(__uint_as_float(rr[0]),__uint_as_float(rr[1])); } \
      resc=false; \
      if(__builtin_expect(__any(rm>(float)THRL),0)){ const float dl=__builtin_fmaxf(rm,0.f); mhat+=dl; \
        _Pragma("unroll") for(int r=0;r<16;++r){C0[r]-=dl;C1[r]-=dl;} \
        const float f=__builtin_amdgcn_exp2f(-dl); l_reg*=f; if(hi==0)wsf[r32]=f; resc=true; } } \
    f32x4_t cn_=(f32x4_t){0.f,0.f,0.f,0.f}; if(GL){cn_=NEGC((t)+1,0);} \
    SBAR(); \
    GAPB(o[0]=__builtin_amdgcn_mfma_f32_32x32x16_bf16(PAF(0),VFR(0),o[0],0,0,0), C0,0,P0,0,0,t,GL); \
    GAPB(o[1]=__builtin_amdgcn_mfma_f32_32x32x16_bf16(PAF(0),VFR(4),o[1],0,0,0), C0,4,P0,4,1,t,GL); \
    KRD(GL,0); GAPB(o[0]=__builtin_amdgcn_mfma_f32_32x32x16_bf16(PAF(1),VFR(1),o[0],0,0,0), C0,8,P0,8,2,t,GL); \
    KRD(GL,1); GAPB(o[1]=__builtin_amdgcn_mfma_f32_32x32x16_bf16(PAF(1),VFR(5),o[1],0,0,0), C0,12,P0,12,3,t,GL); \
    KRD(GL,2); GAPB(o[0]=__builtin_amdgcn_mfma_f32_32x32x16_bf16(PAF(2),VFR(2),o[0],0,0,0), C1,0,P1,0,4,t,GL); \
    KRD(GL,3); GAPB(o[1]=__builtin_amdgcn_mfma_f32_32x32x16_bf16(PAF(2),VFR(6),o[1],0,0,0), C1,4,P1,4,5,t,GL); \
    GAPB(o[0]=__builtin_amdgcn_mfma_f32_32x32x16_bf16(PAF(3),VFR(3),o[0],0,0,0), C1,8,P1,8,6,t,GL); \
    GAPB(o[1]=__builtin_amdgcn_mfma_f32_32x32x16_bf16(PAF(3),VFR(7),o[1],0,0,0), C1,12,P1,12,7,t,GL); \
    }while(0)
  int t=1;
  #undef CMASK
  #define CMASK(P0,P1,t) do{}while(0)
  for(;t+5<NT;t+=2){
    STEP(pB0,pB1,pA0,pA1,t,true,true,true);     WAIT_BAR(2); RESC(); ROT();
    STEP(pA0,pA1,pB0,pB1,t+1,true,true,true);   WAIT_BAR(2); RESC(); ROT();
  }
  #undef CMASK
  #define CMASK(P0,P1,t) do{int jb_=(t)-(NT-4); if(jb_>=0)cmask(P0,P1,jb_,qrel,hi);}while(0)
  #define ENDW(tt) do{ if((tt)+3<NT){WAIT_BAR(2);} else if((tt)+2<NT){WAIT_BAR(1);} else {WAIT_BAR(0);} }while(0)
  for(;t+1<NT;t+=2){
    STEP(pB0,pB1,pA0,pA1,t,(t+3<NT),(t+1<NT),(t+1<NT));       ENDW(t);   RESC(); ROT();
    STEP(pA0,pA1,pB0,pB1,t+1,(t+4<NT),(t+2<NT),(t+2<NT));     ENDW(t+1); RESC(); ROT();
  }
  STEP(pB0,pB1,pA0,pA1,NT-1,false,false,false); RESC();
  { float sacc=pB0[0]+pB0[1]; _Pragma("unroll") for(int r=2;r<16;++r)sacc+=pB0[r]; _Pragma("unroll") for(int r=0;r<16;++r)sacc+=pB1[r]; l_reg+=sacc;
    pw0=(u32x4){PKW(pB0,0),PKW(pB0,2),PKW(pB0,4),PKW(pB0,6)};pw1=(u32x4){PKW(pB0,8),PKW(pB0,10),PKW(pB0,12),PKW(pB0,14)};pw2=(u32x4){PKW(pB1,0),PKW(pB1,2),PKW(pB1,4),PKW(pB1,6)};pw3=(u32x4){PKW(pB1,8),PKW(pB1,10),PKW(pB1,12),PKW(pB1,14)};
    SBAR(); pv(o,vb0+sl_cur,PAF(0),PAF(1),PAF(2),PAF(3)); }
  #undef PKW
  #undef PAF
  #undef VFR
  #undef PIN
  #undef MX3
  #undef GAPA
  #undef GAPB
  #undef EX
  #undef VRD
  #undef KRD
  #undef STEP
  #undef ENDW
  {auto rr=__builtin_amdgcn_permlane32_swap(__float_as_uint(l_reg),__float_as_uint(l_reg),false,false);l_reg=__uint_as_float(rr[0])+__uint_as_float(rr[1]);}
  if(hi==0)wsf[32+r32]=l_reg;asm volatile("s_waitcnt lgkmcnt(0)":::"memory");
  float rli[16];
  #pragma unroll
  for(int r=0;r<16;++r)rli[r]=__builtin_amdgcn_rcpf(wsf[32+crow(r,hi)]);
  bf16*Ow=O+(rowbase+q0+wid*QBLK)*OPITCH+h*D; const bf16*Gw=OG+(rowbase+q0+wid*QBLK)*PITCH+h*D;
  u32x4 gg[4];
  #pragma unroll
  for(int i=0;i<4;++i){const int row=i*8+(lane>>3),ch=lane&7; gg[i]=*(const u32x4*)(Gw+(long)row*PITCH+ch*8);}
  { bf16*stg=(bf16*)(shm+LDS_OST)+wid*2048;
    #pragma unroll
    for(int r=0;r<16;++r){const int orow=crow(r,hi);
      #pragma unroll
      for(int d0=0;d0<2;++d0)stg[orow*64+d0*32+r32]=__float2bfloat16(o[d0][r]*rli[r]);}
    asm volatile("s_waitcnt lgkmcnt(0)":::"memory");
    #pragma unroll
    for(int i=0;i<4;++i){const int row=i*8+(lane>>3),ch=lane&7; u32x4 v=*(const u32x4*)(stg+row*64+ch*8);
      #pragma unroll
      for(int w=0;w<4;++w){ const float o0=__uint_as_float(v[w]<<16),o1=__uint_as_float(v[w]&0xffff0000u),g0=__uint_as_float(gg[i][w]<<16),g1=__uint_as_float(gg[i][w]&0xffff0000u);
        v[w]=cvtpk_s(o0*__builtin_amdgcn_rcpf(1.f+__builtin_amdgcn_exp2f(-1.4426950408889634f*g0)),o1*__builtin_amdgcn_rcpf(1.f+__builtin_amdgcn_exp2f(-1.4426950408889634f*g1))); }
      ATTN_STORE16(Ow+(long)row*OPITCH+ch*8,v);} }
  asm volatile("s_waitcnt lgkmcnt(0)\n\ts_barrier":::"memory");
  #undef DMA_K
  #undef NEGC
  #undef FILLT
  #undef DMA_V
  #undef CMASK
  #undef START
  #undef RESC
  #undef ROT
}
constexpr int ATTN_LDS_BYTES=LDS_BYTES;
struct AttnTensors { const bf16* Q; const bf16* K; const bf16* V; const bf16* OG; const float* c2v; bf16* O; };
struct AttnUnit { int bh; int qb; };
struct StaticOrder {
  int vcu, G, blk;
  __device__ __forceinline__ explicit StaticOrder(int grid,int block):vcu((grid%8==0)?(block%8)*(grid/8)+block/8:block),G(grid),blk(block){}
  __device__ __forceinline__ bool next(int i,AttnUnit&u)const{
    if(G==256){ if(blk<64){ if(i>=1)return false; u.bh=blk; u.qb=0; return true; } const int j=blk-64,g=j>>6; u.bh=j&63;
      if(g==0){ if(i>=2)return false; u.qb=i?3:7; } else if(g==1){ if(i>=2)return false; u.qb=i?4:6; } else { if(i>=3)return false; u.qb=i==0?5:3-i; }
      return true; }
    const int pair=vcu+(i>>1)*G; if(pair>=BATCH*NHEAD*4)return false; const int s=pair&3; u.bh=pair>>2; u.qb=(i&1)?s:7-s; return true; }
  __device__ __forceinline__ void a_ready(const AttnUnit&)const{}
  __device__ __forceinline__ void done(const AttnUnit&)const{}
};
template<class Sched,int THRL=8> __device__ __forceinline__ void attn_phase(char*lds,const AttnTensors&T,const Sched&S,const int wave_s){
  AttnUnit u;
  int pbh=-1,pqb=-1;
  for(int i=0;S.next(i,u);++i){ S.a_ready(u); attn_unit<THRL>(u.bh/NHEAD,u.bh%NHEAD,u.qb,T.Q,T.K,T.V,T.OG,T.c2v,T.O,lds,wave_s,!(u.bh==pbh&&u.qb<=pqb)); if(u.bh!=pbh||u.qb>pqb){pbh=u.bh;pqb=u.qb;} S.done(u); }
}
#undef SBAR
#undef WAIT_BAR
}
#define GAS __attribute__((address_space(1)))
#define LAS __attribute__((address_space(3)))
typedef unsigned short bf16;
typedef unsigned v4u __attribute__((ext_vector_type(4)));
typedef float f32x4 __attribute__((ext_vector_type(4)));
typedef short bf16x8 __attribute__((ext_vector_type(8)));
typedef GAS unsigned gu32;
typedef GAS unsigned long long gu64;
#define RLX_AGENT __ATOMIC_RELAXED, __HIP_MEMORY_SCOPE_AGENT
#define LDS_WAIT() asm volatile("s_waitcnt lgkmcnt(0)" ::: "memory")
#define VM_WAIT() asm volatile("s_waitcnt vmcnt(0)" ::: "memory")
#define XB_TMO      128
#define XB_XCNT(j)  (256  + 64 * (j))
#define XB_XSUB(j)  (1280 + 64 * (j))
#define XB_XGEN(j)  (2304 + 64 * (j))
#define XB_TOP      3328
#define XB_TOPGEN   3392
#define XCD_BAR_WORDS 3456
#define XB_SPIN_CAP (1u << 18)

__device__ __forceinline__ unsigned xb_ld(unsigned* p)              { return __hip_atomic_load(p, __ATOMIC_RELAXED, __HIP_MEMORY_SCOPE_AGENT); }
__device__ __forceinline__ unsigned xb_add(unsigned* p, unsigned v) { return __hip_atomic_fetch_add(p, v, __ATOMIC_RELAXED, __HIP_MEMORY_SCOPE_AGENT); }
__device__ __forceinline__ unsigned xb_xcc_id() { return (unsigned)__builtin_amdgcn_s_getreg((3 << 11) | 20) & 0xFu; }
#define XB_SPIN(cond, bar) do { unsigned _sp = 0; while (cond) { __builtin_amdgcn_s_sleep(1); \
    if ((++_sp & 255u) == 0u) { if (xb_ld(&(bar)[XB_TMO])) break; if (_sp > XB_SPIN_CAP) { atomicAdd(&(bar)[XB_TMO], 1u); break; } } } } while (0)

struct XcdBarrier {
    unsigned* bar; unsigned x;
    volatile LAS unsigned* st;
};

__device__ __forceinline__ XcdBarrier xcd_barrier_post(unsigned* bar, volatile LAS unsigned* st) {
    XcdBarrier b; b.bar = bar; b.x = xb_xcc_id(); b.st = st;
    if (threadIdx.x == 0) (void)xb_add(&bar[XB_XCNT(b.x)], 1u);
    return b;
}
__device__ __forceinline__ void xcd_barrier_complete(unsigned* bar, unsigned x, unsigned& nloc, unsigned& nx) {
    const unsigned G = gridDim.x * gridDim.y * gridDim.z;
    unsigned sum, cnt, mine, sp = 0u;
    for (;;) {
        sum = 0u; cnt = 0u; mine = 0u;
#pragma unroll
        for (unsigned j = 0; j < 16; ++j) { const unsigned c = xb_ld(&bar[XB_XCNT(j)]); sum += c; cnt += (c > 0u) ? 1u : 0u; mine = (j == x) ? c : mine; }
        if (sum == G) break;
        __builtin_amdgcn_s_sleep(1);
        if ((++sp & 255u) == 0u) { if (xb_ld(&bar[XB_TMO])) break; if (sp > XB_SPIN_CAP) { atomicAdd(&bar[XB_TMO], 1u); break; } }
    }
    nloc = mine > 0u ? mine : 1u; nx = cnt > 0u ? cnt : 1u;
}

__device__ __forceinline__ void xcd_barrier(const XcdBarrier& b, const int wave_s) {
    asm volatile("s_waitcnt vmcnt(0)" ::: "memory");
    __syncthreads();
    if (wave_s == 0 && lane_id() == 0) {
        int z0_ = 0; asm volatile("" : "+s"(z0_));
        unsigned* bar = b.bar + z0_;
        __builtin_amdgcn_s_waitcnt(0);
        unsigned nloc = b.st[0], nx = b.st[1];
        if (nloc == 0u) { xcd_barrier_complete(bar, b.x, nloc, nx); b.st[0] = nloc; b.st[1] = nx; }
        const unsigned old = xb_add(&bar[XB_XSUB(b.x)], 1u);
        const unsigned gen = old / nloc;
        if (old + 1u == (gen + 1u) * nloc) {
            __builtin_amdgcn_fence(__ATOMIC_RELEASE, "agent");
            asm volatile("s_waitcnt vmcnt(0)" ::: "memory");
            const unsigned og = xb_add(&bar[XB_TOP], 1u);
            const unsigned tg = og / nx;
            if (og + 1u == (tg + 1u) * nx) xb_add(&bar[XB_TOPGEN], 1u);
            else XB_SPIN(xb_ld(&bar[XB_TOPGEN]) == tg, bar);
            __builtin_amdgcn_fence(__ATOMIC_ACQUIRE, "agent");
            xb_add(&bar[XB_XGEN(b.x)], 1u);
            asm volatile("s_waitcnt vmcnt(0)" ::: "memory");
        } else {
            XB_SPIN(xb_ld(&bar[XB_XGEN(b.x)]) == gen, bar);
            __builtin_amdgcn_fence(__ATOMIC_ACQUIRE, "agent");
            asm volatile("s_waitcnt vmcnt(0)" ::: "memory");
        }
    }
    __syncthreads();
}

constexpr int NWAVES = 8;
constexpr int RING_BYTES = 131072;
constexpr int LDS_BYTES = 163840;
constexpr int LDSCTL_OFF = LDS_BYTES - 1024, MISC_OFF = LDSCTL_OFF + 320;
constexpr int HALO_OFF = RING_BYTES;
constexpr int RSTD_OFF = HALO_OFF + 8192;
static_assert(RSTD_OFF + 6 * 1024 + 4096 <= LDSCTL_OFF, "LDS map");
constexpr int CW_BAR = 4096;

struct Args { const float* in[24]; float* out; unsigned char* ws; };

template <bool AF32, class F>
__device__ __forceinline__ void meta_gemm(const void* A, int lda, const bf16_t* Wt, int N, int K, int bid, int G, int wave, int lane, float* red, const F& f) {
    const int fr = lane & 15, fq = lane >> 4, kw = K / NWAVES;
    for (int cb = bid; cb < N / 16; cb += G) {
        f32x4 acc = (f32x4){0.f, 0.f, 0.f, 0.f}; float ss = 0.f;
        const bf16_t* bp = Wt + (size_t)(cb * 16 + fr) * K + wave * kw + 8 * fq;
#pragma unroll
        for (int k = 0; k < kw; k += 32) {
            bf16x8 a;
            if (AF32) {
                const float* ap = (const float*)A + (size_t)fr * lda + wave * kw + k + 8 * fq;
                const f32x4 a0 = *(const f32x4*)ap, a1 = *(const f32x4*)(ap + 4);
                ss += ((a0.x * a0.x + a0.y * a0.y) + (a0.z * a0.z + a0.w * a0.w)) + ((a1.x * a1.x + a1.y * a1.y) + (a1.z * a1.z + a1.w * a1.w));
                u32x4 w; w.x = pk2bf(a0.x, a0.y); w.y = pk2bf(a0.z, a0.w); w.z = pk2bf(a1.x, a1.y); w.w = pk2bf(a1.z, a1.w);
                a = __builtin_bit_cast(bf16x8, w);
            } else a = *(const bf16x8*)((const bf16_t*)A + (size_t)fr * lda + wave * kw + k + 8 * fq);
            const bf16x8 b = *(const bf16x8*)(bp + k);
            acc = __builtin_amdgcn_mfma_f32_16x16x32_bf16(a, b, acc, 0, 0, 0);
        }
        float* rw = red + (wave * 64 + lane) * 5;
        rw[0] = acc[0]; rw[1] = acc[1]; rw[2] = acc[2]; rw[3] = acc[3]; rw[4] = ss;
        __syncthreads();
        if (wave == 0) {
            f32x4 t = (f32x4){0.f, 0.f, 0.f, 0.f}; float s2 = 0.f;
#pragma unroll
            for (int w = 0; w < NWAVES; ++w) { const float* r_ = red + (w * 64 + lane) * 5; t[0] += r_[0]; t[1] += r_[1]; t[2] += r_[2]; t[3] += r_[3]; s2 += r_[4]; }
            float rstd = 1.f;
            if (AF32) { s2 = add_xor16(s2); s2 = add_xor32(s2); rstd = 1.0f / sqrtf(s2 * (1.f / DM) + 1e-6f); }
#pragma unroll
            for (int r = 0; r < 4; ++r) { const int row = 4 * fq + r; const float rs = AF32 ? __int_as_float(__builtin_amdgcn_ds_bpermute(row << 2, __float_as_int(rstd))) : 1.f; f(row, cb * 16 + fr, t[r] * rs); }
        }
        __syncthreads();
    }
}
struct MEpi1 { bf16_t* p; float* pn;
    __device__ __forceinline__ void operator()(int r, int col, float v) const {
        const int row = MROWS + r; const int g = col >> 9, c_ = col & 255;
        if (g < 7) p[(size_t)row * PBW + (col & ~255) + ((c_ >> 5) & 3) * 64 + (c_ >> 7) * 32 + PERM32(c_ & 31)] = f2bf(v);
        else { const int o = col & 511; if (o < 296) pn[(size_t)row * PNW + o] = v; } } };
struct MEpiRes { float* hm; __device__ __forceinline__ void operator()(int r, int col, float v) const { float* h = hm + r * DM + (col & ~31) + PERM32(col & 31); *h = *h + v; } };
struct MEpi3 { float* rawm;
    __device__ __forceinline__ void operator()(int r, int col, float v) const { const int t = col >> 8, c = col & 255; rawm[(size_t)r * DFF2 + (c < 128 ? 128 * t + c : DFF + 128 * t + (c - 128))] = v; } };

__device__ __forceinline__ void meta_gemm3(const float* hm, const bf16_t* W3, int bid, int G, int wave, int lane, int tid, float* red, float* rug, const float* cw, const float* cb, float* rawm, bf16_t* am) {
    const int fr = lane & 15, fq = lane >> 4; constexpr int kw = DM / NWAVES;
    const int pb0 = G == 256 ? 128 : 0, pst = G == 256 ? 128 : G;
    for (int pr = bid - pb0; pr >= 0 && pr < DFF / 16; pr += pst) {
        const int t = pr >> 3, kk = pr & 7, cbu = 16 * t + kk;
        f32x4 au = (f32x4){0.f, 0.f, 0.f, 0.f}, ag = au; float ss = 0.f;
        const bf16_t* bpu = W3 + (size_t)(cbu * 16 + fr) * DM + wave * kw + 8 * fq; const bf16_t* bpg = bpu + (size_t)128 * DM;
#pragma unroll
        for (int k = 0; k < kw; k += 32) {
            const float* ap = hm + (size_t)fr * DM + wave * kw + k + 8 * fq;
            const f32x4 a0 = *(const f32x4*)ap, a1 = *(const f32x4*)(ap + 4);
            ss += ((a0.x * a0.x + a0.y * a0.y) + (a0.z * a0.z + a0.w * a0.w)) + ((a1.x * a1.x + a1.y * a1.y) + (a1.z * a1.z + a1.w * a1.w));
            u32x4 w; w.x = pk2bf(a0.x, a0.y); w.y = pk2bf(a0.z, a0.w); w.z = pk2bf(a1.x, a1.y); w.w = pk2bf(a1.z, a1.w);
            const bf16x8 a = __builtin_bit_cast(bf16x8, w);
            au = __builtin_amdgcn_mfma_f32_16x16x32_bf16(a, *(const bf16x8*)(bpu + k), au, 0, 0, 0);
            ag = __builtin_amdgcn_mfma_f32_16x16x32_bf16(a, *(const bf16x8*)(bpg + k), ag, 0, 0, 0);
        }
        float* rw = red + (wave * 64 + lane) * 9;
        rw[0] = au[0]; rw[1] = au[1]; rw[2] = au[2]; rw[3] = au[3]; rw[4] = ag[0]; rw[5] = ag[1]; rw[6] = ag[2]; rw[7] = ag[3]; rw[8] = ss;
        __syncthreads();
        if (wave == 0) {
            f32x4 tu = (f32x4){0.f, 0.f, 0.f, 0.f}, tg = tu; float s2 = 0.f;
#pragma unroll
            for (int w = 0; w < NWAVES; ++w) { const float* r_ = red + (w * 64 + lane) * 9; tu[0] += r_[0]; tu[1] += r_[1]; tu[2] += r_[2]; tu[3] += r_[3]; tg[0] += r_[4]; tg[1] += r_[5]; tg[2] += r_[6]; tg[3] += r_[7]; s2 += r_[8]; }
            s2 = add_xor16(s2); s2 = add_xor32(s2); const float rstd = 1.0f / sqrtf(s2 * (1.f / DM) + 1e-6f);
#pragma unroll
            for (int r = 0; r < 4; ++r) { const int row = 4 * fq + r; const float rs = __int_as_float(__builtin_amdgcn_ds_bpermute(row << 2, __float_as_int(rstd)));
                const float vu = tu[r] * rs, vg = tg[r] * rs; rug[row * 16 + fr] = vu; rug[256 + row * 16 + fr] = vg;
                if (row >= 14) { rawm[(size_t)row * DFF2 + 128 * t + 16 * kk + fr] = vu; rawm[(size_t)row * DFF2 + DFF + 128 * t + 16 * kk + fr] = vg; } }
        }
        __syncthreads();
        if (tid < 256) {
            const int row = tid >> 4, j = tid & 15, ch = 128 * t + 16 * kk + j;
            const float xu0 = rug[row * 16 + j], xu1 = row >= 1 ? rug[(row - 1) * 16 + j] : 0.f, xu2 = row >= 2 ? rug[(row - 2) * 16 + j] : 0.f;
            const float xg0 = rug[256 + row * 16 + j], xg1 = row >= 1 ? rug[256 + (row - 1) * 16 + j] : 0.f, xg2 = row >= 2 ? rug[256 + (row - 2) * 16 + j] : 0.f;
            const float cu = cb[ch] + cw[ch] * xu2 + cw[DFF2 + ch] * xu1 + cw[2 * DFF2 + ch] * xu0;
            const float cg = cb[DFF + ch] + cw[DFF + ch] * xg2 + cw[DFF2 + DFF + ch] * xg1 + cw[2 * DFF2 + DFF + ch] * xg0;
            am[(size_t)row * DFF + ch] = f2bf(cg * sigmoidf_(cg) * cu);
        }
        __syncthreads();
    }
}

__device__ __forceinline__ void wprep_layer(const float* const* in, int l, unsigned char* ws, int gw, int ngw, int lane, float* scr, int part) {
    unsigned char* wb = ws + WS_W + (size_t)(l & 1) * WL_BYTES;
    constexpr int I1 = (DM / 64) * (N1 / 32), I2 = (DM / 64) * (DM / 32), I3 = (DM / 64) * (DFF2 / 32), I4 = (DFF / 64) * (DM / 32);
    const int n1 = (part & 1) ? I1 : 0, n2 = (part & 2) ? I2 : 0, n3 = (part & 4) ? I3 : 0, n4 = (part & 8) ? I4 : 0;
    for (int it = gw; it < n1 + n2 + n3 + n4; it += ngw) {
        int r = it, mode = 1, K = DM, Nsrc = N_IN, Ndst = N1; const float* W = in[3] + (size_t)l * DM * N_IN; const float* gk = in[2] + l * DM; bf16_t* WT = (bf16_t*)(wb + WO_W1);
        if (r >= n1) { r -= n1; mode = 2; Nsrc = DM; Ndst = DM; W = in[18] + (size_t)l * DM * DM; gk = nullptr; WT = (bf16_t*)(wb + WO_W2);
            if (r >= n2) { r -= n2; mode = 3; Nsrc = DFF2; Ndst = DFF2; W = in[20] + (size_t)l * DM * DFF2; gk = in[19] + l * DM; WT = (bf16_t*)(wb + WO_W3);
                if (r >= n3) { r -= n3; mode = 4; K = DFF; Nsrc = DM; Ndst = DM; W = in[23] + (size_t)l * DFF * DM; gk = nullptr; WT = (bf16_t*)(wb + WO_W4); } } }
        wprep_item(W, gk, WT, K, Nsrc, Ndst, mode, r, scr, lane);
    }
    if (part & 1) {
        bf16_t* lup = (bf16_t*)(wb + WO_LUP);
        const float* wu = in[6] + (size_t)l * 64 * 512; const float* au = in[8] + (size_t)l * 64 * 512; const float* gu = in[9] + (size_t)l * 160 * 512;
        for (int n = gw; n < 512; n += ngw) {
#pragma unroll
            for (int kq = 0; kq < 5; ++kq) { const int k = lane + 64 * kq;
                if (k < 288) lup[n * 288 + k] = f2bf(k < 64 ? wu[k * 512 + n] : (k < 128 ? au[(k - 64) * 512 + n] : gu[(k - 128) * 512 + n])); }
        }
    }
}

struct RwP { const float* mu; const float* w0; const float* w_up; const float* a0; const float* a_up; const float* g_up; };
struct RwS { const float* mu; const float* k_k; const float* k_a; const float* r_k; const float* gn_w; const float* gn_b; };
constexpr int RCH = 8;

__global__ void __launch_bounds__(NWAVES * 64, 2) mk_fwd(Args a) {
    extern __shared__ __attribute__((aligned(16))) unsigned char lds[];
    const int tid0 = threadIdx.x, wave_s = __builtin_amdgcn_readfirstlane(tid0 >> 6);
    const int G0 = gridDim.x, bid0 = blockIdx.x;
    for (int u = tid0; u < (LDS_BYTES - LDSCTL_OFF) / 4; u += NWAVES * 64) ((LAS unsigned*)((LAS unsigned char*)lds + LDSCTL_OFF))[u] = 0u;
    __syncthreads();
    XcdBarrier bar = xcd_barrier_post((unsigned*)(a.ws + WS_CTL) + CW_BAR, (volatile LAS unsigned*)((LAS unsigned char*)lds + MISC_OFF) + 8);
#ifdef TPROBE
#define TP_MARK(ph) do { if ((ph) >= 20 && TPROBE < 20) break;     \
        const unsigned t_ = (unsigned)__builtin_amdgcn_s_memrealtime(); if (wave_s == 0 && lane_id() == 0) { volatile LAS unsigned* q_ = (volatile LAS unsigned*)((LAS unsigned char*)lds + LDSCTL_OFF + 512); \
        if ((ph) == TPROBE) q_[1] += t_ - q_[0]; q_[0] = t_; } } while (0)
#else
#define TP_MARK(ph) do {} while (0)
#endif
#define GRID_BAR() do { int wv_ = wave_s; asm volatile("" : "+s"(wv_)); xcd_barrier(bar, wv_); } while (0)
#define RSTD_TABLE(S) do { pg8::Unit u0_, u_; if (S.next(0, u0_)) { float rv_ = 0.f; if (tid < 256) rv_ = pg8::row_rstd(ssqp, u0_.pm * 256 + tid); \
        for (int i_ = 0; S.next(i_, u_); ++i_) if (tid < 256) ((LAS float*)(ldsl + RSTD_OFF))[i_ * 256 + tid] = u_.pm == u0_.pm ? rv_ : pg8::row_rstd(ssqp, u_.pm * 256 + tid); } \
        __syncthreads(); } while (0)
    TP_MARK(-1);
#define PHASE_IDS() int G_ = G0, bid_ = bid0, wv_ = wave_s; asm volatile("" : "+s"(G_), "+s"(bid_), "+s"(wv_)); int tid = wv_ * 64 + lane_id(); asm volatile("" : "+v"(tid)); \
    const int G = G_, bid = bid_, ngw = G * NWAVES, lane = tid & 63, wave = wv_, gw = bid * NWAVES + wave; (void)lane; (void)gw; (void)ngw
#define PHASE_PTRS(L) int z0_ = 0; asm volatile("" : "+s"(z0_)); const float* const* inq = a.in + z0_; unsigned char* ws = a.ws + z0_; float* out = a.out + z0_; const int lq = (L) + z0_; \
    float* hm = (float*)(ws + WS_HM); float* c2 = (float*)(ws + WS_C2); float* ssqp = (float*)(ws + WS_SSQ); \
    bf16_t* hb = (bf16_t*)(ws + WS_HB); bf16_t* p = (bf16_t*)(ws + WS_P); float* pn = (float*)(ws + WS_PN); bf16_t* y = (bf16_t*)(ws + WS_Y); \
    bf16_t* act = (bf16_t*)(ws + WS_ACT); float* fixb = (float*)(ws + WS_FIX); float* rawm = (float*)(ws + WS_RAWM); \
    const unsigned char* wbuf = ws + WS_W + (size_t)(lq & 1) * WL_BYTES; \
    const bf16_t* W1 = (const bf16_t*)(wbuf + WO_W1); const bf16_t* W2 = (const bf16_t*)(wbuf + WO_W2); const bf16_t* W3 = (const bf16_t*)(wbuf + WO_W3); const bf16_t* W4 = (const bf16_t*)(wbuf + WO_W4); \
    (void)hm; (void)c2; (void)ssqp; (void)hb; (void)p; (void)pn; (void)y; (void)act; (void)fixb; (void)rawm; (void)out; (void)W1; (void)W2; (void)W3; (void)W4
    LAS unsigned char* ldsl = (LAS unsigned char*)lds;

    {
        PHASE_IDS(); PHASE_PTRS(0);
        for (int row = gw; row < RROWS; row += ngw) {
            const f32x4* xr = (const f32x4*)(row < MROWS ? inq[0] + (size_t)row * DM : inq[1] + (size_t)(row - MROWS) * DM) + lane;
            f32x4* hr = (f32x4*)(hm + (size_t)(row < MROWS ? 0 : row - MROWS) * DM) + lane;
            f32x4 v[4]; float s = 0.f;
#pragma unroll
            for (int j = 0; j < 4; ++j) { v[j] = xr[64 * j]; if (row >= MROWS) hr[64 * j] = v[j]; s += (v[j].x * v[j].x + v[j].y * v[j].y) + (v[j].z * v[j].z + v[j].w * v[j].w); }
            s = wave_sum(s);
            if (lane < 16) ssqp[(size_t)row * 16 + lane] = lane == 0 ? s : 0.f;
            u32x2* o8 = (u32x2*)(hb + (size_t)row * DM) + lane;
#pragma unroll
            for (int j = 0; j < 4; ++j) { u32x2 w; w.x = pk2bf(v[j].x, v[j].y); w.y = pk2bf(v[j].z, v[j].w); o8[64 * j] = w; }
        }
    }
    {
        PHASE_IDS(); PHASE_PTRS(0);
        u32x4* z = (u32x4*)(p + (size_t)RROWS * PBW); const unsigned n16 = (unsigned)((16512 - RROWS) * PBW * 2 / 16);
        for (unsigned i = (unsigned)(bid * (NWAVES * 64) + tid); i < n16; i += (unsigned)(G * (NWAVES * 64))) z[i] = (u32x4){0u, 0u, 0u, 0u};
    }
#ifndef PLAIN_LAUNCH
    cg::this_grid().sync();
#endif
    TP_MARK(0);

#pragma unroll 1
    for (int l = -1; l < DEPTH; ++l) {
#pragma unroll 1
      for (int ph = l < 0 ? 1 : 0; ph < (l < 0 ? 2 : 6); ++ph) {
#ifdef TPROBE
        if (wave_s == 0 && lane_id() == 0) ((volatile LAS unsigned*)((LAS unsigned char*)lds + LDSCTL_OFF + 512))[2] = (unsigned)ph;
#endif
        if (ph == 1 || ph == 4)
        {
            PHASE_IDS(); PHASE_PTRS(l);
            if (lq + 1 < DEPTH) {
                const int first = (G == 256 && lq >= 0) ? (ph == 4 ? 128 : 8) : 0, part = lq < 0 ? 15 : (G == 256 ? (ph == 4 ? 6 : 9) : (ph == 4 ? 0 : 15));
                if (bid >= first && part) wprep_layer(inq, lq + 1, ws, gw - first * NWAVES, ngw - first * NWAVES, lane, (float*)(lds + wave * 16384), part);
            }
            __syncthreads();
        }
        if (ph == 0) {
        {
            PHASE_IDS(); PHASE_PTRS(l);
            pg8::Gemm g{hb, W1, MROWS, N1, DM}; pg8::StaticOrder S; S.init(MROWS, N1, G, bid);
            RSTD_TABLE(S);
            pg8::Epi1 E{(const LAS float*)(ldsl + RSTD_OFF), p, pn, inq[16] + lq * 64, inq[17] + lq * 64};
            pg8::gemm_phase<pg8::Epi1, pg8::StaticOrder, true, true>(ldsl, g, S, E, wave);
            meta_gemm<true>(hm, DM, W1, N1, DM, bid, G, wave, lane, (float*)lds, MEpi1{p, pn});
        }
        } else if (ph == 4) {
        {
            PHASE_IDS(); PHASE_PTRS(l);
            const float* cw = inq[21] + (size_t)lq * 3 * DFF2; const float* cb = inq[22] + (size_t)lq * DFF2;
            pg8::Gemm g{hb, W3, MROWS, DFF2, DM}; pg8::StaticOrder S; S.init(MROWS, DFF2, G, bid);
            RSTD_TABLE(S);
            pg8::EpiConv E{(const LAS float*)(ldsl + RSTD_OFF), cw, cb, act, fixb, ldsl + HALO_OFF, (LAS float*)(ldsl + RSTD_OFF + 6 * 1024)};
            pg8::gemm_phase<pg8::EpiConv, pg8::StaticOrder, true, true>(ldsl, g, S, E, wave);
            meta_gemm3(hm, W3, bid, G, wave, lane, tid, (float*)lds, (float*)(lds + 20480), cw, cb, rawm, act + (size_t)MROWS * DFF);
        }
        }
        if (ph == 1 && l >= 0) {
        {
            PHASE_IDS(); PHASE_PTRS(l);
            __syncthreads(); TP_MARK(20);
            {
                const float* mu = inq[4] + lq * 1824;
                const bf16_t* lup = (const bf16_t*)(wbuf + WO_LUP);
                const int h = wave, cg = h * 64 + lane, fr = lane & 15, fq = lane >> 4;
                const float mu_r = mu[cg], mu_k = mu[512 + cg], mu_v = mu[1024 + cg];
                const float w0c = (inq[5] + lq * 512)[cg], a0c = (inq[7] + lq * 512)[cg];
                const float kkc = (inq[10] + lq * 512)[cg], kac = (inq[11] + lq * 512)[cg], rkc = (inq[12] + lq * 512)[cg];
                LAS unsigned char* PNS = ldsl;
                LAS unsigned char* PSW = ldsl + 22528 + wave * 6528;
                LAS unsigned char* LW = ldsl + 74752 + wave * 9216;
                LAS unsigned char* LIN = ldsl + 148480;
                LAS float* MU = (LAS float*)(ldsl + 158720);
                LAS float* TR = (LAS float*)LW; LAS float* LT = (LAS float*)LW; LAS float* LAK = (LAS float*)(LW + 1280);
#define PN_DMA(uu) do { const int c_ = (uu) % NCH, r0_ = rowof((uu) / NCH, 16 * c_), p0_ = prevrow(r0_); \
                    for (int pc_ = wave; pc_ < (p0_ >= 0 ? 22 : 20); pc_ += NWAVES) { \
                        const char* src_ = (pc_ < 20 ? (const char*)(pn + (size_t)r0_ * PNW) + pc_ * 1024 : (const char*)(pn + (size_t)p0_ * PNW) + (pc_ - 20) * 1024) + lane * 16; \
                        __builtin_amdgcn_global_load_lds((const unsigned*)src_, (LAS unsigned*)(PNS + pc_ * 1024), 16, 0, 0); } } while (0)
#define PS_DMA(uu) do { const int c_ = (uu) % NCH, r0_ = rowof((uu) / NCH, 16 * c_), p0_ = prevrow(r0_); int ln_ = lane; asm volatile("" : "+v"(ln_));     \
                    _Pragma("unroll") for (int j_ = 0; j_ < 7; ++j_) { const int s_ = j_ * 8 + (ln_ >> 3); \
                        if (s_ < 51) { const int i_ = s_ / 3, sg_ = s_ - 3 * i_, rw_ = i_ ? r0_ + i_ - 1 : (p0_ >= 0 ? p0_ : r0_); \
                            const char* src_ = (const char*)(p + (size_t)rw_ * PBW) + sg_ * 1024 + wave * 128 + (ln_ & 7) * 16; \
                            __builtin_amdgcn_global_load_lds((const unsigned*)src_, (LAS unsigned*)(PSW + j_ * 1024), 16, 0, 0); } } } while (0)
#define PSV(i, sg) bf2f(((const LAS bf16_t*)PSW)[(3 * (i) + (sg)) * 64 + lane])
                if (tid < 288) MU[tid] = mu[1536 + tid];
                if (bid < NB * NCH) { PN_DMA(bid); PS_DMA(bid); }
                asm volatile("s_waitcnt vmcnt(0)" ::: "memory");
                bf16x8 bw_[2][4];
                {   const int fru = lane & 15, fqu = lane >> 4;
#pragma unroll
                    for (int nb = 0; nb < 4; ++nb) { const bf16_t* bp_ = lup + (size_t)(h * 64 + 16 * nb + fru) * 288 + 8 * fqu;
#pragma unroll
                        for (int ks = 0; ks < 2; ++ks) bw_[ks][nb] = *(const bf16x8*)(bp_ + 32 * ks);
                    } }
                for (int u = bid; u < NB * NCH; u += G) {
                    const int b = u / NCH, c = u % NCH, row0 = rowof(b, 16 * c), prow0 = prevrow(row0);
                    int tidu = tid; asm volatile("" : "+v"(tidu));
                    const int fr = tidu & 15, fq = (tidu >> 4) & 3;
                    bf16x8 ba_[2][4], bg_[5][4];
                    {   const int fru = fr, fqu = fq;
#pragma unroll
                        for (int nb = 0; nb < 4; ++nb) { const bf16_t* bp_ = lup + (size_t)(h * 64 + 16 * nb + fru) * 288 + 8 * fqu;
#pragma unroll
                            for (int ks = 0; ks < 2; ++ks) ba_[ks][nb] = *(const bf16x8*)(bp_ + 64 + 32 * ks);
                        } }
                    TP_MARK(27);
                    asm volatile("s_waitcnt lgkmcnt(0)\n\ts_barrier" ::: "memory");
                    {
                        float cur_[9], prv_[9], mu_[9];
#pragma unroll
                        for (int i = 0; i < 9; ++i) { const int e = tidu + 512 * i, ti = e / 288, j = e - 288 * ti;
                            cur_[i] = ((const LAS float*)PNS)[ti * 320 + j]; prv_[i] = ((const LAS float*)PNS)[(ti ? ti - 1 : 16) * 320 + j]; mu_[i] = MU[j]; }
#pragma unroll
                        for (int i = 0; i < 9; ++i) { const int e = tidu + 512 * i, ti = e / 288, j = e - 288 * ti;
                            const float prv = (ti || prow0 >= 0) ? prv_[i] : 0.f, s = cur_[i] + mu_[i] * (prv - cur_[i]);
                            const float ex = __builtin_amdgcn_exp2f((j < 64 ? 2.f * LOG2E : -LOG2E) * s), rc = __builtin_amdgcn_rcpf(1.f + ex);
                            ((LAS bf16_t*)LIN)[ti * 296 + j] = f2bf(j < 64 ? 1.f - 2.f * rc : (j < 128 ? s : rc)); }
                    }
                    {   const int fru = fr, fqu = fq;
#pragma unroll
                        for (int nb = 0; nb < 4; ++nb) { const bf16_t* bp_ = lup + (size_t)(h * 64 + 16 * nb + fru) * 288 + 8 * fqu;
#pragma unroll
                            for (int ks = 0; ks < 5; ++ks) bg_[ks][nb] = *(const bf16x8*)(bp_ + 128 + 32 * ks); } }
                    TP_MARK(28);
                    asm volatile("s_waitcnt lgkmcnt(0)\n\ts_barrier" ::: "memory");
                    if (u + G < NB * NCH) PN_DMA(u + G);
                    TP_MARK(22);
#define LORA_PRE(ZA, KB0, NKS, BF) do { f32x4 acc_[4]; _Pragma("unroll") for (int nb = 0; nb < 4; ++nb) acc_[nb] = (f32x4){0.f, 0.f, 0.f, 0.f}; \
                        _Pragma("unroll") for (int ks = 0; ks < (NKS); ++ks) { const bf16x8 af = *(const LAS bf16x8*)(LIN + fr * 592 + ((KB0) + 32 * ks + 8 * fq) * 2); \
                            _Pragma("unroll") for (int nb = 0; nb < 4; ++nb) acc_[nb] = __builtin_amdgcn_mfma_f32_16x16x32_bf16(af, BF[ks][nb], acc_[nb], 0, 0, 0); } \
                        WAVE_LDS_SYNC(); \
                        _Pragma("unroll") for (int nb = 0; nb < 4; ++nb) _Pragma("unroll") for (int r = 0; r < 4; ++r) TR[(4 * fq + r) * 65 + 16 * nb + fr] = acc_[nb][r]; \
                        WAVE_LDS_SYNC(); \
                        _Pragma("unroll") for (int i = 0; i < 16; ++i) ZA[i] = TR[i * 65 + lane]; } while (0)
                    float zw[16], za[16];
                    LORA_PRE(zw, 0, 2, bw_); LORA_PRE(za, 64, 2, ba_);
                    {
                        float zg[16]; LORA_PRE(zg, 128, 5, bg_); (void)zg;
                        asm volatile("s_waitcnt vmcnt(0)" ::: "memory");
                        {
                            const int ti_ = lane >> 2, pt_ = lane & 3; float gv_[16];
#pragma unroll
                            for (int k_ = 0; k_ < 16; ++k_) gv_[k_] = TR[ti_ * 65 + 16 * pt_ + k_];
                            u32x4 o0_, o1_;
                            o0_.x = pk2bf(gv_[0], gv_[1]); o0_.y = pk2bf(gv_[2], gv_[3]); o0_.z = pk2bf(gv_[4], gv_[5]); o0_.w = pk2bf(gv_[6], gv_[7]);
                            o1_.x = pk2bf(gv_[8], gv_[9]); o1_.y = pk2bf(gv_[10], gv_[11]); o1_.z = pk2bf(gv_[12], gv_[13]); o1_.w = pk2bf(gv_[14], gv_[15]);
                            bf16_t* yp_ = y + (size_t)(row0 + ti_) * DM + h * 64 + 16 * pt_;
                            *(u32x4*)yp_ = o0_; *(u32x4*)(yp_ + 8) = o1_; } }
#undef LORA_PRE
                    WAVE_LDS_SYNC();
                    const int ci = (b * 8 + h) * NCH + c;
                    unsigned char* ra = ws + WS_RA + (size_t)ci * RA_BYTES; unsigned char* rb = (unsigned char*)out + (size_t)ci * RB_BYTES;
                    bf16_t* BV = (bf16_t*)(ws + WS_BV);
                    LAS bf16_t* OA = (LAS bf16_t*)LW; LAS bf16_t* OB = OA + 16 * 72; LAS bf16_t* OK = OB + 16 * 72; LAS bf16_t* OR = OK + 16 * 72;
                    const int cxk = (lane >> 5) * 4 + ((lane >> 2) & 3), jk2 = (((lane >> 4) & 1) * 4 + (lane & 3)) * 2;
                    TP_MARK(23);
                    float atil[16]; unsigned bkB[8], bkK[8], vtp[8];
                    float cumC = 0.f;
#pragma unroll
                    for (int i = 0; i < 16; ++i) { zw[i] = 0.6065306597126334f * __builtin_amdgcn_rcpf(1.f + __builtin_amdgcn_exp2f(-LOG2E * (zw[i] + w0c))); cumC += zw[i]; }
                    float cum = 0.f, gprev = 1.f, rp = 0.f, kp_ = 0.f, vp = 0.f, be = 0.f, ke = 0.f, ve = 0.f, bve = 0.f; unsigned bvp[8];
                    unsigned short prr[17], pkk[17], pvv[17];
#pragma unroll
                    for (int i = 0; i < 17; ++i) { prr[i] = ((const LAS bf16_t*)PSW)[(3 * i) * 64 + lane]; pkk[i] = ((const LAS bf16_t*)PSW)[(3 * i + 1) * 64 + lane]; pvv[i] = ((const LAS bf16_t*)PSW)[(3 * i + 2) * 64 + lane]; }
                    WAVE_LDS_SYNC();
                    if (u + G < NB * NCH) PS_DMA(u + G);
                    rp = bf2f(prr[0]); kp_ = bf2f(pkk[0]); vp = bf2f(pvv[0]);
                    const float hp0 = prow0 >= 0 ? 1.f : 0.f;
#pragma unroll
                    for (int i0 = 0; i0 < 16; i0 += 4) {
                        float rs4[4], vs4[4], alr4[4], kkr4[4], kpr4[4], red[8];
#pragma unroll
                        for (int j = 0; j < 4; ++j) { const int i = i0 + j;
                            const float rc = bf2f(prr[i + 1]), kc = bf2f(pkk[i + 1]), vc = bf2f(pvv[i + 1]);
                            const float hp = i ? 1.f : hp0;
                            const float rs = rc + mu_r * (hp * rp - rc), ks_ = kc + mu_k * (hp * kp_ - kc), vs = vc + mu_v * (hp * vp - vc);
                            rp = rc; kp_ = kc; vp = vc;
                            const float alr = __builtin_amdgcn_rcpf(1.f + __builtin_amdgcn_exp2f(-LOG2E * (za[i] + a0c)));
                            const float kkr = ks_ * kkc, kpr = ks_ * (1.f + (alr - 1.f) * kac);
                            rs4[j] = rs; vs4[j] = vs; alr4[j] = alr; kkr4[j] = kkr; kpr4[j] = kpr; red[2 * j] = kkr * kkr; red[2 * j + 1] = rs * kpr * rkc; }
                        wave_sum_dpp8(red);
#pragma unroll
                        for (int j = 0; j < 4; ++j) { const int i = i0 + j;
                            cum += zw[i];
                            const float kk = kkr4[j] * __builtin_amdgcn_rsqf(fmaxf(red[2 * j], 1e-24f)), bon = red[2 * j + 1], kpr = kpr4[j], vs = vs4[j];
                            const float eg = __builtin_amdgcn_exp2f(LOG2E * cum), gi = __builtin_amdgcn_exp2f(-LOG2E * cum), tail = __builtin_amdgcn_exp2f(LOG2E * (cum - cumC));
                            atil[i] = -kk * gprev;
                            const float bb = kk * alr4[j], rtil = rs4[j] * gi; gprev = gi;
                            OA[i * 72 + lane] = f2bf(atil[i]); OB[i * 72 + lane] = f2bf(bb * eg); OK[i * 72 + lane] = f2bf(kpr * eg); OR[i * 72 + lane] = f2bf(rtil);
                            if (i & 1) { bkB[i >> 1] = pk2bf(be, bb * tail); bkK[i >> 1] = pk2bf(ke, kpr * tail); vtp[i >> 1] = pk2bf(ve, vs); } else { be = bb * tail; ke = kpr * tail; ve = vs; }
                            if (i & 1) bvp[i >> 1] = pk2bf(bve, bon * vs); else bve = bon * vs; }
                    }
                    {
                        ((float*)(rb + 3584))[lane] = gprev;
#pragma unroll
                        for (int q = 0; q < 4; ++q) *(u32x4*)(ra + 4096 + lane * 64 + ((q ^ SWZ4(lane)) << 4)) = (u32x4){bkB[2 * q], bkB[2 * q + 1], bkK[2 * q], bkK[2 * q + 1]};
                        *(u32x4*)(rb + lane * 32) = (u32x4){vtp[0], vtp[1], vtp[2], vtp[3]}; *(u32x4*)(rb + lane * 32 + 16) = (u32x4){vtp[4], vtp[5], vtp[6], vtp[7]};
                    }
                    WAVE_LDS_SYNC();
                    TP_MARK(24);
#define REC_STORE(TILE, DST) do { _Pragma("unroll") for (int hh_ = 0; hh_ < 2; ++hh_) { const int i_ = (lane >> 3) + 8 * hh_, pc_ = lane & 7, c_ = pc_ ^ ((i_ >> 1) & 7), base_ = (c_ >> 2) * 32 + (c_ & 3) * 4; \
                        const u32x2 lo_ = *(const LAS u32x2*)((TILE) + i_ * 72 + base_), hi_ = *(const LAS u32x2*)((TILE) + i_ * 72 + base_ + 16); \
                        *(u32x4*)((DST) + i_ * 128 + pc_ * 16) = (u32x4){lo_.x, lo_.y, hi_.x, hi_.y}; } } while (0)
                    REC_STORE(OR, ra + 2048);
                    {
                        f32x4 dab = (f32x4){0.f, 0.f, 0.f, 0.f}, dak = dab, drb = dab, drk = dab;
#pragma unroll
                        for (int ks = 0; ks < 2; ++ks) {
                            const int off = fr * 72 + 32 * ks + 8 * fq;
                            const bf16x8 fa = *(const LAS bf16x8*)(OA + off), fb = *(const LAS bf16x8*)(OB + off), fk = *(const LAS bf16x8*)(OK + off), frr = *(const LAS bf16x8*)(OR + off);
                            dab = __builtin_amdgcn_mfma_f32_16x16x32_bf16(fa, fb, dab, 0, 0, 0); dak = __builtin_amdgcn_mfma_f32_16x16x32_bf16(fa, fk, dak, 0, 0, 0);
                            drb = __builtin_amdgcn_mfma_f32_16x16x32_bf16(frr, fb, drb, 0, 0, 0); drk = __builtin_amdgcn_mfma_f32_16x16x32_bf16(frr, fk, drk, 0, 0, 0);
                        }
#pragma unroll
                        for (int r = 0; r < 4; ++r) { const int i = 4 * fq + r, j = fr;
                            LT[i * 20 + j] = j < i ? dab[r] : 0.f; LAK[i * 16 + j] = j < i ? dak[r] : 0.f;
                            bf16_t* mp = (bf16_t*)(rb + 2048 + i * 64 + (((j >> 2) ^ SWZ4(i)) << 4)) + (j & 3);
                            mp[0] = f2bf(j <= i ? drb[r] : 0.f); mp[4] = f2bf(j <= i ? drk[r] : 0.f); }
                    }
                    WAVE_LDS_SYNC();
                    {
#pragma unroll
                        for (int k_ = 0; k_ < 8; ++k_) { OB[(2 * k_) * 72 + lane] = (bf16_t)(bvp[k_] & 0xffffu); OB[(2 * k_ + 1) * 72 + lane] = (bf16_t)(bvp[k_] >> 16); }
                        WAVE_LDS_SYNC();
                        const int ti_ = lane >> 2, pt_ = lane & 3;
                        const u32x4 b0_ = *(const LAS u32x4*)(OB + ti_ * 72 + 16 * pt_), b1_ = *(const LAS u32x4*)(OB + ti_ * 72 + 16 * pt_ + 8);
                        bf16_t* bp_ = BV + (size_t)(row0 + ti_) * 512 + h * 64 + 16 * pt_;
                        *(u32x4*)bp_ = b0_; *(u32x4*)(bp_ + 8) = b1_;
                    }
                    float tt[16];
#pragma unroll
                    for (int mm = 0; mm < 16; ++mm) tt[mm] = mm == fr ? 1.f : 0.f;
#pragma unroll
                    for (int j = 14; j >= 0; --j) { float val = 0.f;
#pragma unroll
                        for (int mm = j + 1; mm < 16; ++mm) val += tt[mm] * LT[mm * 20 + j];
                        tt[j] += val; }
                    WAVE_LDS_SYNC();
                    if (fq == 0) {
#pragma unroll
                        for (int mm = 0; mm < 16; ++mm) LT[fr * 20 + mm] = tt[mm]; }
                    {
                        f32x4 g4 = (f32x4){0.f, 0.f, 0.f, 0.f};
#pragma unroll
                        for (int mm = 0; mm < 16; ++mm) g4 += *(const LAS f32x4*)(LAK + mm * 16 + 4 * fq) * tt[mm];
                        u32x2 w; w.x = pk2bf(g4[0], g4[1]); w.y = pk2bf(g4[2], g4[3]);
                        *(u32x2*)(rb + 3072 + (fr * 16 + 4 * fq) * 2) = w;
                    }
                    WAVE_LDS_SYNC();
                    TP_MARK(25);
                    {
#pragma unroll
                        for (int i = 0; i < 16; ++i) { float acc = 0.f;
                            const f32x4 t0 = *(const LAS f32x4*)(LT + i * 20), t1 = *(const LAS f32x4*)(LT + i * 20 + 4), t2 = *(const LAS f32x4*)(LT + i * 20 + 8), t3 = *(const LAS f32x4*)(LT + i * 20 + 12);
                            const float trow[16] = {t0[0], t0[1], t0[2], t0[3], t1[0], t1[1], t1[2], t1[3], t2[0], t2[1], t2[2], t2[3], t3[0], t3[1], t3[2], t3[3]};
#pragma unroll
                            for (int mm = 0; mm <= i; ++mm) acc += trow[mm] * atil[mm];
                            OK[i * 72 + lane] = f2bf(acc); }
                        WAVE_LDS_SYNC();
                        REC_STORE(OK, ra);
                    }
#undef REC_STORE
                    TP_MARK(26);
                }
            }
            __syncthreads();
#undef PN_DMA
#undef PS_DMA
#undef PSV
            TP_MARK(29);
            TP_MARK(21);
            const float* q_g = inq[16] + lq * 64; const float* k_g = inq[17] + lq * 64; const float* b_f = inq[15] + lq * 8;
            for (int it = gw - (G >= 96 ? 80 * NWAVES : 0); it >= 0 && it < NMETA * NH; it += ngw) {
                const int row = MROWS + (it >> 3), h = it & 7;
                bf16_t* qp = p + (size_t)row * PBW + 1536 + h * 64 + lane; bf16_t* kp = p + (size_t)row * PBW + 2048 + h * 64 + lane;
                const float q = bf2f(*qp), k = bf2f(*kp);
                const float mq = wave_sum(q * q) * (1.f / 64.f), mk = wave_sum(k * k) * (1.f / 64.f);
                *qp = f2bf(q * (1.0f / sqrtf(mq + 1e-6f)) * q_g[lane] * (0.125f * LOG2E));
                *kp = f2bf(k * (1.0f / sqrtf(mk + 1e-6f)) * k_g[lane]);
            }
            for (int it = bid - (G >= 80 ? 16 : 0); it >= 0 && it < NB * NH; it += G) {
                constexpr int PER = 5;
                const int b = it >> 3, h = it & 7;
                float zv[PER], loc[PER], s = 0.f;
#pragma unroll
                for (int i = 0; i < PER; ++i) { const int t = tid * PER + i; zv[i] = pn[(size_t)rowof(b, t < LTOT ? t : LTOT - 1) * PNW + 288 + h]; }
#pragma unroll
                for (int i = 0; i < PER; ++i) { const int t = tid * PER + i;
                    const float v = t < LTOT ? -__builtin_amdgcn_logf(1.f + __builtin_amdgcn_exp2f(-LOG2E * (zv[i] + b_f[h]))) : 0.f;
                    s += v; loc[i] = s; }
                float incl = s;
#pragma unroll
                for (int o = 1; o < 64; o <<= 1) { const float n = __int_as_float(__builtin_amdgcn_ds_bpermute((lane - o) << 2, __float_as_int(incl))); if (lane >= o) incl += n; }
                float base = incl - s;
                if (lane == 63) ((LAS float*)ldsl)[wave] = incl;
                __syncthreads();
#pragma unroll
                for (int w = 0; w < NWAVES - 1; ++w) base += w < wave ? ((const LAS float*)ldsl)[w] : 0.f;
                float* cv = c2 + (size_t)it * 2176;
#pragma unroll
                for (int i = 0; i < PER; ++i) { const int t = tid * PER + i; if (t < LTOT) cv[t < NMETA ? t : t + 112] = base + loc[i]; }
                if (tid < 112) cv[16 + tid] = 1e5f;
                __syncthreads();
            }
        }
        } else if (ph == 2) {
        {
            PHASE_IDS(); PHASE_PTRS(l);
            typedef short s16x4 __attribute__((ext_vector_type(4)));
            constexpr int SLOTB = 12288, NSLOT = 10  , YB_OFF = NSLOT * SLOTB, YB_BYTES = 32 * 68 * 4, NSC = (NCH + 1) / 2;
            static_assert(YB_OFF + 2 * YB_BYTES <= LDSCTL_OFF, "scan LDS map");
#define RAW_BAR() asm volatile("s_waitcnt lgkmcnt(0)\n\ts_barrier" ::: "memory")
#define QXOR1(x) __int_as_float(__builtin_amdgcn_update_dpp(0, __float_as_int(x), 0xB1, 0xf, 0xf, false))
#define QXOR2(x) __int_as_float(__builtin_amdgcn_update_dpp(0, __float_as_int(x), 0x4E, 0xf, 0xf, false))
            for (int unit = bid; unit < 64; unit += G) {
                const int b = unit >> 3, h = unit & 7, fr = lane & 15, fq = lane >> 4;
                const unsigned char* RA0 = ws + WS_RA + (size_t)unit * NCH * RA_BYTES; const unsigned char* RB0 = (const unsigned char*)out + (size_t)unit * NCH * RB_BYTES;
                if (wave < 4) {
                    const int v = 16 * wave + fr;
                    f32x4 Z[4];
#pragma unroll
                    for (int kb = 0; kb < 4; ++kb) Z[kb] = (f32x4){0.f, 0.f, 0.f, 0.f};
                    const int o_ah0 = fr * 128 + (((fq) ^ ((fr >> 1) & 7)) << 4), o_ah1 = fr * 128 + (((4 + fq) ^ ((fr >> 1) & 7)) << 4);
                    const int o_bk = 4096 + fr * 64 + ((fq ^ SWZ4(fr)) << 4), o_mrk = 10240 + fr * 64 + ((fq ^ SWZ4(fr)) << 4);
                    const int o_vt = 8192 + v * 32 + fq * 8, o_g = 11264 + fr * 32 + fq * 8, o_gam = 11776 + fq * 16;
                    RAW_BAR();
                    for (int s = 0; s < NSC; ++s) {
                        LAS float* YB = (LAS float*)(ldsl + YB_OFF + (s & 1) * YB_BYTES);
                        const int nc = (NCH - 2 * s) < 2 ? 1 : 2;
                        for (int cs = 0; cs < nc; ++cs) {
                            const LAS unsigned char* sl = ldsl + ((2 * s + cs) % NSLOT) * SLOTB;
                            const bf16x8 ah0 = *(const LAS bf16x8*)(sl + o_ah0), ah1 = *(const LAS bf16x8*)(sl + o_ah1);
                            const bf16x8 rh0 = *(const LAS bf16x8*)(sl + 2048 + o_ah0), rh1 = *(const LAS bf16x8*)(sl + 2048 + o_ah1);
                            bf16x8 bk[4]; f32x4 gam[4];
#pragma unroll
                            for (int kb = 0; kb < 4; ++kb) { bk[kb] = *(const LAS bf16x8*)(sl + o_bk + kb * 1024); gam[kb] = *(const LAS f32x4*)(sl + o_gam + kb * 64); }
                            const u32x2 vt = *(const LAS u32x2*)(sl + o_vt);
                            const bf16x8 mrk = *(const LAS bf16x8*)(sl + o_mrk);
                            const u32x2 g4 = *(const LAS u32x2*)(sl + o_g);
                            u32x4 zw01, zw23;
                            zw01.x = pk2bf(Z[0][0], Z[0][1]); zw01.y = pk2bf(Z[0][2], Z[0][3]); zw01.z = pk2bf(Z[1][0], Z[1][1]); zw01.w = pk2bf(Z[1][2], Z[1][3]);
                            zw23.x = pk2bf(Z[2][0], Z[2][1]); zw23.y = pk2bf(Z[2][2], Z[2][3]); zw23.z = pk2bf(Z[3][0], Z[3][1]); zw23.w = pk2bf(Z[3][2], Z[3][3]);
                            const bf16x8 zp01 = __builtin_bit_cast(bf16x8, zw01), zp23 = __builtin_bit_cast(bf16x8, zw23);
                            f32x4 U = (f32x4){0.f, 0.f, 0.f, 0.f}, Yv = U;
                            U = __builtin_amdgcn_mfma_f32_16x16x32_bf16(ah0, zp01, U, 0, 0, 0); U = __builtin_amdgcn_mfma_f32_16x16x32_bf16(ah1, zp23, U, 0, 0, 0);
                            U = __builtin_amdgcn_mfma_f32_16x16x16bf16_1k(__builtin_bit_cast(s16x4, g4), __builtin_bit_cast(s16x4, vt), U, 0, 0, 0);
                            Yv = __builtin_amdgcn_mfma_f32_16x16x32_bf16(rh0, zp01, Yv, 0, 0, 0); Yv = __builtin_amdgcn_mfma_f32_16x16x32_bf16(rh1, zp23, Yv, 0, 0, 0);
                            u32x4 uvw; uvw.x = pk2bf(U[0], U[1]); uvw.y = pk2bf(U[2], U[3]); uvw.z = vt.x; uvw.w = vt.y;
                            const bf16x8 uv = __builtin_bit_cast(bf16x8, uvw);
                            Yv = __builtin_amdgcn_mfma_f32_16x16x32_bf16(mrk, uv, Yv, 0, 0, 0);
#pragma unroll
                            for (int kb = 0; kb < 4; ++kb) { Z[kb] = Z[kb] * gam[kb]; Z[kb] = __builtin_amdgcn_mfma_f32_16x16x32_bf16(bk[kb], uv, Z[kb], 0, 0, 0); }
#pragma unroll
                            for (int r = 0; r < 4; ++r) YB[(cs * 16 + 4 * fq + r) * 68 + v] = Yv[r];
                        }
                        RAW_BAR();
                    }
                } else if (wave < 6) {
                    const unsigned lds0 = (unsigned)(uintptr_t)lds; const int lw = wave - 4;
#define DMA_SC(sc) do { const int nc_ = (NCH - 2 * (sc)) < 2 ? 1 : 2; for (int cs_ = 0; cs_ < nc_; ++cs_) { const int ch_ = 2 * (sc) + cs_; \
                        _Pragma("unroll") for (int pc_ = 0; pc_ < 6; ++pc_) { const int pc = lw * 6 + pc_; \
                            const unsigned char* src_ = (pc < 8 ? RA0 + (size_t)ch_ * RA_BYTES + pc * 1024 : RB0 + (size_t)ch_ * RB_BYTES + (pc - 8) * 1024) + lane * 16; \
                            attn_body::glds16(src_, (unsigned)__builtin_amdgcn_readfirstlane(lds0 + (ch_ % NSLOT) * SLOTB + pc * 1024)); } } } while (0)
                    DMA_SC(0); DMA_SC(1); DMA_SC(2); DMA_SC(3);
                    asm volatile("s_waitcnt vmcnt(36)\n\ts_barrier" ::: "memory");
                    for (int s = 0; s < NSC; ++s) {
                        if (s + 4 < NSC) DMA_SC(s + 4);
#define NPC_(sc) ((sc) < NSC ? ((NCH - 2 * (sc)) < 2 ? 6 : 12) : 0)
                        const int fl = NPC_(s + 2) + NPC_(s + 3) + NPC_(s + 4);
#undef NPC_
                        if (fl == 36) asm volatile("s_waitcnt vmcnt(36)\n\ts_barrier" ::: "memory");
                        else if (fl == 30) asm volatile("s_waitcnt vmcnt(30)\n\ts_barrier" ::: "memory");
                        else if (fl == 18) asm volatile("s_waitcnt vmcnt(18)\n\ts_barrier" ::: "memory");
                        else if (fl == 6) asm volatile("s_waitcnt vmcnt(6)\n\ts_barrier" ::: "memory");
                        else asm volatile("s_waitcnt vmcnt(0)\n\ts_barrier" ::: "memory");
                    }
#undef DMA_SC
                } else {
                    const int pw = wave - 6, tk = lane >> 2, part = lane & 3, cgv = h * 64 + part * 16;
                    const bf16_t* BV = (const bf16_t*)(ws + WS_BV);
                    float gnw[16], gnb[16];
#pragma unroll
                    for (int j = 0; j < 16; ++j) { gnw[j] = (inq[13] + lq * 512)[cgv + j]; gnb[j] = (inq[14] + lq * 512)[cgv + j]; }
#define PLOAD(G0, G1, B0, B1, sg) do { const int cn_ = 2 * (sg) + pw; if ((sg) < NSC && cn_ < NCH) { const size_t rown = (size_t)rowof(b, 16 * cn_ + tk); \
                        G0 = *(const u32x4*)(y + rown * DM + cgv); G1 = *(const u32x4*)(y + rown * DM + cgv + 8); B0 = *(const u32x4*)(BV + rown * 512 + cgv); B1 = *(const u32x4*)(BV + rown * 512 + cgv + 8); } } while (0)
                    u32x4 ga0 = (u32x4){0u, 0u, 0u, 0u}, ga1 = ga0, ba0 = ga0, ba1 = ga0, gb0 = ga0, gb1 = ga0, bb0 = ga0, bb1 = ga0, gc0 = ga0, gc1 = ga0, bc0 = ga0, bc1 = ga0;
                    PLOAD(gb0, gb1, bb0, bb1, 0); PLOAD(gc0, gc1, bc0, bc1, 1);
                    RAW_BAR();
                    for (int s = 0; s <= NSC; ++s) {
                        const int cp = 2 * (s - 1) + pw;
                        const bool do_now = s >= 1 && cp < NCH && (cp > 0 || b == 0);
                        const u32x4 g0 = ga0, g1 = ga1, b0 = ba0, b1 = ba1;
                        ga0 = gb0; ga1 = gb1; ba0 = bb0; ba1 = bb1; gb0 = gc0; gb1 = gc1; bb0 = bc0; bb1 = bc1;
                        PLOAD(gc0, gc1, bc0, bc1, s + 2);
                        if (do_now) {
                            const LAS float* yb = (const LAS float*)(ldsl + YB_OFF + ((s - 1) & 1) * YB_BYTES) + (pw * 16 + tk) * 68 + part * 16;
                            float yv[16];
#pragma unroll
                            for (int q4 = 0; q4 < 4; ++q4) { const f32x4 t4 = *(const LAS f32x4*)(yb + 4 * q4); yv[4 * q4] = t4[0]; yv[4 * q4 + 1] = t4[1]; yv[4 * q4 + 2] = t4[2]; yv[4 * q4 + 3] = t4[3]; }
                            float s1 = 0.f;
#pragma unroll
                            for (int j = 0; j < 16; ++j) s1 += yv[j];
                            s1 += QXOR1(s1); s1 += QXOR2(s1);
                            const float mean = s1 * (1.f / 64.f); float s2 = 0.f;
#pragma unroll
                            for (int j = 0; j < 16; ++j) { yv[j] -= mean; s2 += yv[j] * yv[j]; }
                            s2 += QXOR1(s2); s2 += QXOR2(s2);
                            const float rstd = 1.0f / sqrtf(s2 * (1.f / 64.f) + 64e-5f);
                            const unsigned gws[8] = {g0.x, g0.y, g0.z, g0.w, g1.x, g1.y, g1.z, g1.w}, bws[8] = {b0.x, b0.y, b0.z, b0.w, b1.x, b1.y, b1.z, b1.w};
                            unsigned ow[8];
#pragma unroll
                            for (int j2 = 0; j2 < 8; ++j2) {
                                const float oa = (yv[2 * j2] * rstd * gnw[2 * j2] + gnb[2 * j2] + __uint_as_float(bws[j2] << 16)) * __uint_as_float(gws[j2] << 16);
                                const float ob = (yv[2 * j2 + 1] * rstd * gnw[2 * j2 + 1] + gnb[2 * j2 + 1] + __uint_as_float(bws[j2] & 0xffff0000u)) * __uint_as_float(gws[j2] & 0xffff0000u);
                                ow[j2] = pk2bf(oa, ob); }
                            bf16_t* yo = y + (size_t)rowof(b, 16 * cp + tk) * DM + cgv;
                            *(u32x4*)yo = (u32x4){ow[0], ow[1], ow[2], ow[3]}; *(u32x4*)(yo + 8) = (u32x4){ow[4], ow[5], ow[6], ow[7]};
                        }
                        if (s < NSC) RAW_BAR();
                    }
#undef PLOAD
                }
                __syncthreads();
            }
#undef RAW_BAR
#undef QXOR1
#undef QXOR2
        }
        TP_MARK(30);
        {
            PHASE_IDS(); PHASE_PTRS(l);
            if (gw < NH * NMETA) {
                const int h = gw >> 4, t = gw & 15;
                const bf16_t* qrow = p + (size_t)(MROWS + t) * PBW + 1536 + h * 64;
                float s = -INFINITY;
                if (lane <= t) { const bf16_t* kr = p + (size_t)(MROWS + lane) * PBW + 2048 + h * 64; float d = 0.f;
                    for (int e = 0; e < 64; ++e) d += bf2f(qrow[e]) * bf2f(kr[e]);
                    s = d - c2[(size_t)h * 2176 + lane]; }
                const float mx = wave_max(s); const float e = lane <= t ? exp2f(s - mx) : 0.f; const float sum = wave_sum(e);
                float o = 0.f;
                for (int j = 0; j <= t; ++j) o += __int_as_float(__builtin_amdgcn_readlane(__float_as_int(e), j)) * bf2f(p[(size_t)(MROWS + j) * PBW + 2560 + h * 64 + lane]);
                const float og = bf2f(p[(size_t)(MROWS + t) * PBW + 3072 + h * 64 + lane]);
                y[(size_t)(MROWS + t) * DM + 512 + h * 64 + lane] = f2bf(o * __builtin_amdgcn_rcpf(sum) * __builtin_amdgcn_rcpf(1.f + __builtin_amdgcn_exp2f(-LOG2E * og)));
            }
        }
        __syncthreads();
        {
            PHASE_IDS(); PHASE_PTRS(l);
            typedef attn_body::bf16 abf;
            const attn_body::AttnTensors AT{(const abf*)(p + 1536), (const abf*)(p + 2048), (const abf*)(p + 2560), (const abf*)(p + 3072), c2, (abf*)(y + 512)};
            const attn_body::StaticOrder S(G, bid);
            TP_MARK(31);
            attn_body::attn_phase<attn_body::StaticOrder>((char*)lds, AT, S, wave);
            TP_MARK(32);
        }
        } else if (ph == 3) {
        {
            PHASE_IDS(); PHASE_PTRS(l);
            pg8::Gemm g{y, W2, MROWS, DM, DM}; pg8::StaticOrder S; S.init(MROWS, DM, G, bid);
            pg8::EpiRes E{nullptr, hb, ssqp};
            pg8::gemm_phase<pg8::EpiRes, pg8::StaticOrder, true, true>(ldsl, g, S, E, wave);
            meta_gemm<false>(y + (size_t)MROWS * DM, DM, W2, DM, DM, bid, G, wave, lane, (float*)lds, MEpiRes{hm});
        }
        } else if (ph == 5) {
        {
            PHASE_IDS(); PHASE_PTRS(l);
            const float* cw = inq[21] + (size_t)lq * 3 * DFF2; const float* cb = inq[22] + (size_t)lq * DFF2;
            pg8::Gemm g{act, W4, MROWS, DM, DFF}; pg8::StaticOrder S; S.init(MROWS, DM, G, bid);
            {
                pg8::Unit u;
                for (int i = 0; S.next(i, u); ++i) {
                    const int pm = u.pm;
                    const float* own0 = fixb + (size_t)(pm * 4) * DFF2; const float* own1 = own0 + DFF2;
                    const float* pv0 = (pm & 7) ? fixb + (size_t)((pm - 1) * 4 + 2) * DFF2 : rawm + (size_t)14 * DFF2; const float* pv1 = pv0 + DFF2;
                    for (int j = 4 * tid; j < DFF; j += 4 * NWAVES * 64) {
                        const f32x4 w0u = *(const f32x4*)(cw + j), w1u = *(const f32x4*)(cw + DFF2 + j), w2u = *(const f32x4*)(cw + 2 * DFF2 + j), bu = *(const f32x4*)(cb + j);
                        const f32x4 w0g = *(const f32x4*)(cw + DFF + j), w1g = *(const f32x4*)(cw + DFF2 + DFF + j), w2g = *(const f32x4*)(cw + 2 * DFF2 + DFF + j), bg = *(const f32x4*)(cb + DFF + j);
                        const f32x4 au = *(const f32x4*)(pv0 + j), bu_ = *(const f32x4*)(pv1 + j), cu_ = *(const f32x4*)(own0 + j), du = *(const f32x4*)(own1 + j);
                        const f32x4 ag = *(const f32x4*)(pv0 + DFF + j), bg_ = *(const f32x4*)(pv1 + DFF + j), cg_ = *(const f32x4*)(own0 + DFF + j), dg = *(const f32x4*)(own1 + DFF + j);
                        const f32x4 u0 = bu + w0u * au + w1u * bu_ + w2u * cu_, g0 = bg + w0g * ag + w1g * bg_ + w2g * cg_;
                        const f32x4 u1 = bu + w0u * bu_ + w1u * cu_ + w2u * du, g1 = bg + w0g * bg_ + w1g * cg_ + w2g * dg;
                        u32x2 o0, o1;
                        o0.x = pk2bf(g0[0] * sigmoidf_(g0[0]) * u0[0], g0[1] * sigmoidf_(g0[1]) * u0[1]); o0.y = pk2bf(g0[2] * sigmoidf_(g0[2]) * u0[2], g0[3] * sigmoidf_(g0[3]) * u0[3]);
                        o1.x = pk2bf(g1[0] * sigmoidf_(g1[0]) * u1[0], g1[1] * sigmoidf_(g1[1]) * u1[1]); o1.y = pk2bf(g1[2] * sigmoidf_(g1[2]) * u1[2], g1[3] * sigmoidf_(g1[3]) * u1[3]);
                        *(u32x2*)(act + (size_t)(256 * pm) * DFF + j) = o0; *(u32x2*)(act + (size_t)(256 * pm + 1) * DFF + j) = o1;
                    }
                }
                asm volatile("s_waitcnt vmcnt(0)" ::: "memory"); __syncthreads();
            }
            pg8::EpiRes E{lq + 1 == DEPTH ? out : nullptr, hb, ssqp};
            pg8::gemm_phase<pg8::EpiRes, pg8::StaticOrder, true, true>(ldsl, g, S, E, wave);
            meta_gemm<false>(act + (size_t)MROWS * DFF, DFF, W4, DM, DFF, bid, G, wave, lane, (float*)lds, MEpiRes{hm});
        }
        }
#ifdef TPROBE
#ifdef TPROBE_WAIT
        TP_MARK(19);
#endif
        GRID_BAR(); TP_MARK(ph == 0 ? 1 : ph == 1 ? 2 : ph == 2 ? 3 : ph == 3 ? 4 : ph == 4 ? 5 : 6);
#if TPROBE == 40
        GRID_BAR(); TP_MARK(40);
#endif
#else
        if (ph < 5 || l + 1 < DEPTH) GRID_BAR();
#endif
      }
    }
#ifdef TPROBE
#ifndef TPROBE_BLOCK
#define TPROBE_BLOCK 0
#endif
    if (bid0 == TPROBE_BLOCK && wave_s == 0 && lane_id() == 0) a.out[0] += (float)((volatile LAS unsigned*)((LAS unsigned char*)lds + LDSCTL_OFF + 512))[1] * 0.0001f;
#endif
}

extern "C" void kernel_launch(void* const* d_in, const int* in_sizes, int n_in, void* d_out, int out_size, void* d_ws, size_t ws_size, hipStream_t stream) {
    static int grid = 0;
    if (grid == 0) {
        if (n_in != 24 || out_size != MROWS * DM || ws_size < WS_END) { fprintf(stderr, "kernel_launch: unexpected shapes (n_in %d out %d ws %zu)\n", n_in, out_size, ws_size); grid = -1; return; }
        int dev = 0, cus = 0, per_cu = 0;
        hipGetDevice(&dev); hipDeviceGetAttribute(&cus, hipDeviceAttributeMultiprocessorCount, dev);
        if (hipFuncSetAttribute((const void*)mk_fwd, hipFuncAttributeMaxDynamicSharedMemorySize, LDS_BYTES) != hipSuccess) { fprintf(stderr, "kernel_launch: hipFuncSetAttribute failed\n"); grid = -1; return; }
        hipOccupancyMaxActiveBlocksPerMultiprocessor(&per_cu, (const void*)mk_fwd, NWAVES * 64, LDS_BYTES);
        (void)hipGetLastError();
        if (per_cu < 1) { fprintf(stderr, "kernel_launch: occupancy query says %d blocks per CU\n", per_cu); }
        grid = cus;
    }
    if (grid < 0) return;
    hipMemsetAsync((char*)d_ws + WS_CTL, 0, 32768, stream);
    Args a{};
    for (int i = 0; i < 24; ++i) a.in[i] = (const float*)d_in[i];
    a.out = (float*)d_out; a.ws = (unsigned char*)d_ws;
    void* args[] = {&a};
#ifdef PLAIN_LAUNCH
    hipLaunchKernelGGL(mk_fwd, dim3(grid), dim3(NWAVES * 64), LDS_BYTES, stream, a); hipError_t e = hipPeekAtLastError(); (void)args;
#else
    hipError_t e = hipLaunchCooperativeKernel((const void*)mk_fwd, dim3(grid), dim3(NWAVES * 64), args, LDS_BYTES, stream);
#endif
    if (e != hipSuccess) fprintf(stderr, "cooperative launch failed: %s (grid %d)\n", hipGetErrorString(e), grid);
}
```

```cpp
#define PLAIN_LAUNCH 1
#include <hip/hip_runtime.h>
#include <hip/hip_cooperative_groups.h>
#include <stdint.h>
#include <cstdio>
namespace cg = cooperative_groups;

typedef unsigned short bf16_t;
typedef short bf16x8 __attribute__((ext_vector_type(8)));
typedef float f32x4 __attribute__((ext_vector_type(4)));
typedef unsigned u32x4 __attribute__((ext_vector_type(4)));
typedef unsigned u32x2 __attribute__((ext_vector_type(2)));

constexpr int NB = 8, SEQ = 2048, NMETA = 16, LTOT = 2064, DM = 1024, DEPTH = 4, NH = 8, HD = 64;
constexpr int N_IN = 3880, DFF = 2816, DFF2 = 5632;
constexpr int MROWS = NB * SEQ;
constexpr int RROWS = MROWS + NMETA;
constexpr int N1 = 4096;
constexpr int PBW = 3584;
constexpr int PNW = 320;
constexpr float LOG2E = 1.4426950408889634f;

constexpr size_t MiB = 1u << 20;
constexpr size_t WS_CTL = 0, CTL_ZERO_BYTES = 1 * MiB;
constexpr size_t WS_W = 1 * MiB, WL_BYTES = 27 * MiB;
constexpr size_t WO_W1 = 0;
constexpr size_t WO_W2 = 8 * MiB;
constexpr size_t WO_W3 = 10 * MiB;
constexpr size_t WO_W4 = 21 * MiB;
constexpr size_t WO_LUP = 26 * MiB + 512 * 1024;
constexpr size_t WS_SMALL = WS_W + 2 * WL_BYTES;
constexpr size_t WS_HM = WS_SMALL;
constexpr size_t WS_C2 = WS_SMALL + 1 * MiB;
constexpr size_t WS_SSQ = WS_SMALL + 3 * MiB;
constexpr size_t WS_HB = WS_SMALL + 6 * MiB;
constexpr size_t WS_P = WS_HB + 33 * MiB;
constexpr size_t WS_PN = WS_P + 113 * MiB;
constexpr size_t WS_Y = WS_PN + 21 * MiB;
constexpr size_t WS_FREE = WS_Y + 33 * MiB;
constexpr int NCH = 129;
constexpr size_t RA_BYTES = 8192, RB_BYTES = 4096;
constexpr size_t WS_RA = WS_FREE;
#define SWZ4(r) (3 * (((r) >> 3) & 1))
constexpr size_t WS_ACT = WS_P;
constexpr size_t WS_FIX = WS_PN;
constexpr size_t WS_RAWM = WS_PN + 6 * MiB;
constexpr size_t WS_BV = WS_RA + 65 * MiB;
constexpr size_t WS_END = WS_BV + 17 * MiB;

__device__ __forceinline__ float bf2f(bf16_t v) { return __uint_as_float(((unsigned)v) << 16); }
typedef float f32x2_t_ __attribute__((ext_vector_type(2))); typedef __bf16 bf16x2_t_ __attribute__((ext_vector_type(2)));
__device__ __forceinline__ unsigned pk2bf(float lo, float hi) { const f32x2_t_ v = {lo, hi}; return __builtin_bit_cast(unsigned, __builtin_convertvector(v, bf16x2_t_)); }
__device__ __forceinline__ bf16_t f2bf(float f) { return __builtin_bit_cast(bf16_t, (__bf16)f); }
__device__ __forceinline__ float sigmoidf_(float x) { return 1.f / (1.f + __expf(-x)); }
__device__ __forceinline__ float wave_sum_dpp(float v) {
#define DPPF_(x, ctrl, rmask) __int_as_float(__builtin_amdgcn_update_dpp(0, __float_as_int(x), ctrl, rmask, 0xf, false))
    v += DPPF_(v, 0xB1, 0xf);
    v += DPPF_(v, 0x4E, 0xf);
    v += DPPF_(v, 0x141, 0xf);
    v += DPPF_(v, 0x140, 0xf);
    v += DPPF_(v, 0x142, 0xa);
    v += DPPF_(v, 0x143, 0xc);
#undef DPPF_
    return __int_as_float(__builtin_amdgcn_readlane(__float_as_int(v), 63));
}
__device__ __forceinline__ float wave_sum(float v) { return wave_sum_dpp(v); }
__device__ __forceinline__ void wave_sum_dpp8(float (&v)[8]) {
#define DPPF_(x, ctrl, rmask) __int_as_float(__builtin_amdgcn_update_dpp(0, __float_as_int(x), ctrl, rmask, 0xf, false))
#define DPPS_(ctrl, rmask) _Pragma("unroll") for (int j_ = 0; j_ < 8; ++j_) v[j_] += DPPF_(v[j_], ctrl, rmask);
    DPPS_(0xB1, 0xf) DPPS_(0x4E, 0xf) DPPS_(0x141, 0xf) DPPS_(0x140, 0xf) DPPS_(0x142, 0xa) DPPS_(0x143, 0xc)
#undef DPPS_
#undef DPPF_
#pragma unroll
    for (int j_ = 0; j_ < 8; ++j_) v[j_] = __int_as_float(__builtin_amdgcn_readlane(__float_as_int(v[j_]), 63));
}
__device__ __forceinline__ float wave_max(float v) {
#define DPPF_(x, ctrl, rmask) __int_as_float(__builtin_amdgcn_update_dpp(__float_as_int(x), __float_as_int(x), ctrl, rmask, 0xf, false))
    v = fmaxf(v, DPPF_(v, 0xB1, 0xf)); v = fmaxf(v, DPPF_(v, 0x4E, 0xf)); v = fmaxf(v, DPPF_(v, 0x141, 0xf)); v = fmaxf(v, DPPF_(v, 0x140, 0xf));
    v = fmaxf(v, DPPF_(v, 0x142, 0xa)); v = fmaxf(v, DPPF_(v, 0x143, 0xc));
#undef DPPF_
    return __int_as_float(__builtin_amdgcn_readlane(__float_as_int(v), 63));
}
__device__ __forceinline__ float add_xor16(float x) { const auto r = __builtin_amdgcn_permlane16_swap(__float_as_uint(x), __float_as_uint(x), false, false); return __uint_as_float(r[0]) + __uint_as_float(r[1]); }
__device__ __forceinline__ float add_xor32(float x) { const auto r = __builtin_amdgcn_permlane32_swap(__float_as_uint(x), __float_as_uint(x), false, false); return __uint_as_float(r[0]) + __uint_as_float(r[1]); }
__device__ __forceinline__ int lane_id() { int l; asm volatile("v_mbcnt_lo_u32_b32 %0, -1, 0\n\tv_mbcnt_hi_u32_b32 %0, -1, %0" : "=v"(l)); return l; }
#define WAVE_LDS_SYNC() do { __builtin_amdgcn_s_waitcnt(0xc07f); __builtin_amdgcn_wave_barrier(); } while (0)
__device__ __forceinline__ int rowof(int b, int t) { return t < NMETA ? MROWS + t : b * SEQ + (t - NMETA); }
__device__ __forceinline__ int prevrow(int row) {
    if (row >= MROWS) return row == MROWS ? -1 : row - 1;
    return (row & (SEQ - 1)) ? row - 1 : MROWS + NMETA - 1;
}

#define PERM32(j) (8 * (((j) >> 2) & 3) + 4 * ((j) >> 4) + ((j) & 3))
__device__ __forceinline__ int src_col(int mode, int n) {
    if (mode == 1) {
        const int g = n >> 9, c_ = n & 255, o = (n & 256) + (g < 7 ? ((c_ >> 5) & 3) * 64 + (c_ >> 7) * 32 + PERM32(c_ & 31) : c_);
        switch (g) {
            case 0: return o;
            case 1: return 512 + o;
            case 2: return 1024 + o;
            case 3: return 1824 + o;
            case 4: return 2336 + o;
            case 5: return 2848 + o;
            case 6: return 3360 + o;
            default:
                if (o < 64) return 1536 + o;
                if (o < 128) return 1600 + (o - 64);
                if (o < 288) return 1664 + (o - 128);
                if (o < 296) return 3872 + (o - 288);
                return -1;
        }
    }
    if (mode == 3) { const int t = n >> 8, c = n & 255; return c < 128 ? 128 * t + c : DFF + 128 * t + (c - 128); }
    return (n & ~31) + PERM32(n & 31);
}
__device__ __forceinline__ void wprep_item(const float* W, const float* gk, bf16_t* WT, int K, int Nsrc, int Ndst, int mode, int item, float* scr, int lane) {
    const int nblk = Ndst / 32, kb = item / nblk, nb = item % nblk, k0 = 64 * kb, n0 = 32 * nb;
    const int sc = src_col(mode, n0 + (lane & 31));
    const float* wp = W + (size_t)(k0 + (lane >> 5)) * Nsrc + (sc >= 0 ? sc : 0);
    float v[32];
#pragma unroll
    for (int i = 0; i < 32; ++i) { v[i] = *wp; wp += 2 * (size_t)Nsrc; }
#pragma unroll
    for (int i = 0; i < 32; ++i) scr[(2 * i + (lane >> 5)) * 33 + (lane & 31)] = sc >= 0 ? v[i] : 0.f;
    WAVE_LDS_SYNC();
    const int c = lane & 7;
    f32x4 g0 = (f32x4){1.f, 1.f, 1.f, 1.f}, g1 = g0;
    if (gk) { g0 = *(const f32x4*)(gk + k0 + 8 * c); g1 = *(const f32x4*)(gk + k0 + 8 * c + 4); }
#pragma unroll
    for (int j = 0; j < 4; ++j) {
        const int n = (lane >> 3) + 8 * j; const float* s = scr + (8 * c) * 33 + n;
        u32x4 o;
        o.x = pk2bf(s[0 * 33] * g0[0], s[1 * 33] * g0[1]); o.y = pk2bf(s[2 * 33] * g0[2], s[3 * 33] * g0[3]); o.z = pk2bf(s[4 * 33] * g1[0], s[5 * 33] * g1[1]); o.w = pk2bf(s[6 * 33] * g1[2], s[7 * 33] * g1[3]);
        *(u32x4*)(WT + (size_t)(n0 + n) * K + k0 + 8 * c) = o;
    }
    WAVE_LDS_SYNC();
}
namespace pg8 {
#define PG8_LAS __attribute__((address_space(3)))
typedef unsigned short bf16_t;
typedef short bf16x8 __attribute__((ext_vector_type(8)));
typedef float f32x4 __attribute__((ext_vector_type(4)));
typedef unsigned u32x4 __attribute__((ext_vector_type(4)));
constexpr int BM = 256, BK = 64, HALF = 128, HTB = HALF * BK * 2  , STAGE_BYTES = 8 * HTB, NXCD = 8, WGM = 8;

__host__ __device__ __forceinline__ int lds_byte(int r, int c) { const int st = (r >> 4) * 2 + (c >> 5), rr = r & 15, cc = c & 31, ob = rr * 64 + cc * 2; return st * 1024 + (ob ^ (((ob >> 9) & 1) << 5)); }
__host__ __device__ __forceinline__ void stage_rc(int b, int& R, int& C) { const int st = b / 1024, sb = b % 1024, swz = sb ^ (((sb >> 9) & 1) << 5); R = (st >> 1) * 16 + swz / 64; C = (st & 1) * 32 + (swz % 64) / 2; }
__host__ __device__ __forceinline__ int perm32(int rho) { const int n = rho >> 4, i = rho & 15; return 8 * (i >> 2) + 4 * n + (i & 3); }

struct Unit { int pm, pn, idx; };
struct Gemm { const bf16_t* A; const bf16_t* Bt; int M, N, K; };

struct StaticOrder {
    int nM, nN, nwg, G, c;
    __host__ __device__ void init(int M, int N, int G_, int c_) { nM = M / BM; nN = N / BM; nwg = nM * nN; G = G_; c = c_; }
    __host__ __device__ bool next(int i, Unit& u) const {
        const long L = (long)i * G + c; if (L >= nwg) return false;
        int wgid = (int)L; { const int q = nwg / NXCD, r = nwg % NXCD, xcd = wgid % NXCD, off = wgid / NXCD; wgid = (xcd < r ? xcd * (q + 1) : r * (q + 1) + (xcd - r) * q) + off; }
        const int nig = WGM * nN, gid = wgid / nig, fm = gid * WGM, gsz = (nM - fm) < WGM ? (nM - fm) : WGM;
        u.pm = fm + ((wgid % nig) % gsz); u.pn = (wgid % nig) / gsz; u.idx = i; return true;
    }
    __device__ __forceinline__ void a_ready(const Unit&) const {}
    __device__ __forceinline__ void done(const Unit&) const {}
};

__device__ __forceinline__ float row_rstd(const float* ssqp, int row) {
    const f32x4* sp = (const f32x4*)(ssqp + (size_t)row * 16);
    const f32x4 a = sp[0], b = sp[1], c = sp[2], d = sp[3];
    const float s = (((a.x + a.y) + (a.z + a.w)) + ((b.x + b.y) + (b.z + b.w))) + (((c.x + c.y) + (c.z + c.w)) + ((d.x + d.y) + (d.z + d.w)));
    return 1.0f / sqrtf(s * (1.f / 1024.f) + 1e-6f);
}
struct Epi1 {
    static constexpr bool PERM = false, AFTER_DRAIN = false;
    const PG8_LAS float* rstdl; bf16_t* p; float* pn; const float* q_g; const float* k_g;
    __device__ __forceinline__ void operator()(const f32x4 (&acc)[2][2][4][2], const Unit& u, int wr, int wc, int fr, int fq) const {
        const int row0 = u.pm * BM + wr * 64 + fr;
        const bool isq = (u.pn >> 1) == 3, isk = (u.pn >> 1) == 4;
        f32x4 gsc[2][2];
        if (isq || isk) {
#pragma unroll
            for (int bj = 0; bj < 2; ++bj)
#pragma unroll
                for (int n = 0; n < 2; ++n) gsc[bj][n] = *(const f32x4*)((isq ? q_g : k_g) + 32 * bj + 8 * fq + 4 * n) * (isq ? 0.125f * 1.4426950408889634f : 1.f);
        }
#pragma unroll
        for (int ai = 0; ai < 2; ++ai)
#pragma unroll
            for (int m = 0; m < 4; ++m) {
                const int row = row0 + ai * HALF + m * 16; const float rs = rstdl[u.idx * 256 + wr * 64 + fr + ai * HALF + m * 16];
                f32x4 v[2][2];
#pragma unroll
                for (int bj = 0; bj < 2; ++bj)
#pragma unroll
                    for (int n = 0; n < 2; ++n) v[bj][n] = acc[ai][bj][m][n] * rs;
                if (u.pn < 14) {
                    if (isq || isk) {
                        float ss = 0.f;
#pragma unroll
                        for (int bj = 0; bj < 2; ++bj)
#pragma unroll
                            for (int n = 0; n < 2; ++n) ss += (v[bj][n][0] * v[bj][n][0] + v[bj][n][1] * v[bj][n][1]) + (v[bj][n][2] * v[bj][n][2] + v[bj][n][3] * v[bj][n][3]);
                        ss = add_xor16(ss); ss = add_xor32(ss);
                        const float rn = 1.0f / sqrtf(ss * (1.f / 64.f) + 1e-6f);
#pragma unroll
                        for (int bj = 0; bj < 2; ++bj)
#pragma unroll
                            for (int n = 0; n < 2; ++n) v[bj][n] = v[bj][n] * gsc[bj][n] * rn;
                    }
#pragma unroll
                    for (int bj = 0; bj < 2; ++bj) { u32x4 w; w.x = pk2bf(v[bj][0][0], v[bj][0][1]); w.y = pk2bf(v[bj][0][2], v[bj][0][3]); w.z = pk2bf(v[bj][1][0], v[bj][1][1]); w.w = pk2bf(v[bj][1][2], v[bj][1][3]);
                        *(u32x4*)(p + (size_t)row * PBW + u.pn * BM + wc * 64 + bj * 32 + 8 * fq) = w; }
                } else {
#pragma unroll
                    for (int bj = 0; bj < 2; ++bj)
#pragma unroll
                        for (int n = 0; n < 2; ++n) { const int o = u.pn * BM + wc * 32 + 4 * fq + bj * HALF + n * 16 - PBW; if (o < 296) *(f32x4*)(pn + (size_t)row * PNW + o) = v[bj][n]; }
                }
            }
    }
};
struct EpiRes {
    static constexpr bool PERM = false, AFTER_DRAIN = false;
    float* outp; bf16_t* hb; float* ssqp;
    __device__ __forceinline__ void operator()(const f32x4 (&acc)[2][2][4][2], const Unit& u, int wr, int wc, int fr, int fq) const {
        const int row0 = u.pm * BM + wr * 64 + fr, col0 = u.pn * BM + wc * 32 + 8 * fq;
#pragma unroll
        for (int ai = 0; ai < 2; ++ai) {
            u32x4 hw[4][2];
#pragma unroll
            for (int m = 0; m < 4; ++m)
#pragma unroll
                for (int bj = 0; bj < 2; ++bj) hw[m][bj] = *(const u32x4*)(hb + (size_t)(row0 + ai * HALF + m * 16) * DM + col0 + bj * HALF);
            asm volatile("s_waitcnt vmcnt(0)" ::: "memory");
#pragma unroll
            for (int m = 0; m < 4; ++m) {
                const int row = row0 + ai * HALF + m * 16; float ss = 0.f;
#pragma unroll
                for (int bj = 0; bj < 2; ++bj) {
                    const int col = col0 + bj * HALF; bf16_t* hp = hb + (size_t)row * DM + col;
                    const u32x4 h4 = hw[m][bj];
                    const f32x4 v0 = (f32x4){__uint_as_float(h4.x << 16), __uint_as_float(h4.x & 0xffff0000u), __uint_as_float(h4.y << 16), __uint_as_float(h4.y & 0xffff0000u)} + acc[ai][bj][m][0];
                    const f32x4 v1 = (f32x4){__uint_as_float(h4.z << 16), __uint_as_float(h4.z & 0xffff0000u), __uint_as_float(h4.w << 16), __uint_as_float(h4.w & 0xffff0000u)} + acc[ai][bj][m][1];
                    u32x4 w; w.x = pk2bf(v0[0], v0[1]); w.y = pk2bf(v0[2], v0[3]); w.z = pk2bf(v1[0], v1[1]); w.w = pk2bf(v1[2], v1[3]);
                    *(u32x4*)hp = w;
                    if (outp) { *(f32x4*)(outp + (size_t)row * DM + col) = v0; *(f32x4*)(outp + (size_t)row * DM + col + 4) = v1; }
                    const f32x4 r0 = (f32x4){__uint_as_float(w.x << 16), __uint_as_float(w.x & 0xffff0000u), __uint_as_float(w.y << 16), __uint_as_float(w.y & 0xffff0000u)};
                    const f32x4 r1 = (f32x4){__uint_as_float(w.z << 16), __uint_as_float(w.z & 0xffff0000u), __uint_as_float(w.w << 16), __uint_as_float(w.w & 0xffff0000u)};
                    ss += ((r0[0] * r0[0] + r0[1] * r0[1]) + (r0[2] * r0[2] + r0[3] * r0[3])) + ((r1[0] * r1[0] + r1[1] * r1[1]) + (r1[2] * r1[2] + r1[3] * r1[3]));
                }
                ss = add_xor16(ss); ss = add_xor32(ss);
                if (fq == 0) ssqp[(size_t)row * 16 + u.pn * 4 + wc] = ss;
            }
        }
    }
};
__device__ __forceinline__ float dpp_ror1(float x) { return __int_as_float(__builtin_amdgcn_mov_dpp(__float_as_int(x), 0x121, 0xf, 0xf, true)); }
__device__ __forceinline__ float dpp_ror2(float x) { return __int_as_float(__builtin_amdgcn_mov_dpp(__float_as_int(x), 0x122, 0xf, 0xf, true)); }
__device__ __forceinline__ float vmul_s(float a, float b) { float r; asm volatile("v_mul_f32_e32 %0, %1, %2" : "=v"(r) : "v"(a), "v"(b)); return r; }
struct EpiConv {
    static constexpr bool PERM = false, AFTER_DRAIN = false;
    const PG8_LAS float* rstdl; const float* cw; const float* cb; bf16_t* act; float* fix; PG8_LAS unsigned char* halo; PG8_LAS float* ctab;
    __device__ __forceinline__ void operator()(const f32x4 (&acc)[2][2][4][2], const Unit& u, int wr, int wc, int fr_, int fq_) const {
        int fr = fr_, fq = fq_; asm volatile("" : "+v"(fr), "+v"(fq));
        const int row0 = u.pm * BM + wr * 64 + fr, cl = wc * 32 + 4 * fq;
        {
            const int q = 2 * ((wr * 4 + wc) * 64 + fq * 16 + fr), p = q >> 8, col = q & 255;
            const float* src = (p < 3 ? cw + (size_t)p * DFF2 : cb) + (col < 128 ? 128 * u.pn + col : DFF + 128 * u.pn + (col - 128));
            typedef float f32x2w __attribute__((ext_vector_type(2)));
            *(PG8_LAS f32x2w*)(ctab + q) = *(const f32x2w*)src;
        }
        float rs[2][4];
#pragma unroll
        for (int ai = 0; ai < 2; ++ai)
#pragma unroll
            for (int m = 0; m < 4; ++m) rs[ai][m] = rstdl[u.idx * 256 + wr * 64 + fr + ai * HALF + m * 16];
        if (fr >= 14) {
#pragma unroll
            for (int ai = 0; ai < 2; ++ai)
#pragma unroll
                for (int bj = 0; bj < 2; ++bj)
#pragma unroll
                    for (int n = 0; n < 2; ++n) { const f32x4 v = acc[ai][bj][3][n] * rs[ai][3];
                        *(PG8_LAS f32x4*)(halo + ((((ai * 2 + wr) * 2 + (fr - 14)) * 256) + bj * HALF + cl + n * 16) * 4) = v;
                        if (ai == 1 && wr == 1) *(f32x4*)(fix + (size_t)(u.pm * 4 + 2 + (fr - 14)) * DFF2 + bj * DFF + 128 * u.pn + cl + n * 16) = v; }
        }
        if (fr < 2 && wr == 0) {
#pragma unroll
            for (int bj = 0; bj < 2; ++bj)
#pragma unroll
                for (int n = 0; n < 2; ++n) *(f32x4*)(fix + (size_t)(u.pm * 4 + fr) * DFF2 + bj * DFF + 128 * u.pn + cl + n * 16) = acc[0][bj][0][n] * rs[0][0];
        }
        asm volatile("s_waitcnt lgkmcnt(0)\n\ts_barrier" ::: "memory");
        typedef float f32x2v __attribute__((ext_vector_type(2)));
#pragma unroll
        for (int n = 0; n < 2; ++n) {
            const unsigned la2 = (unsigned)(fr * DFF + cl) * 2u;
            unsigned wpk[2][2][4];
#pragma unroll
            for (int eh = 0; eh < 2; ++eh) {
                asm volatile("" ::: "memory"); __builtin_amdgcn_sched_barrier(0);
                const int e = 2 * eh;
#define CWL(p, g) (*(const PG8_LAS f32x2v*)(ctab + (p) * 256 + (g) * 128 + cl + n * 16 + e))
                const f32x2v wu0 = CWL(0, 0), wu1 = CWL(1, 0), wu2 = CWL(2, 0), bu = CWL(3, 0);
                const f32x2v wg0 = CWL(0, 1), wg1 = CWL(1, 1), wg2 = CWL(2, 1), bg = CWL(3, 1);
#undef CWL
#pragma unroll
                for (int ai = 0; ai < 2; ++ai) {
                    const int ps = (ai * 2 + wr) ? (ai * 2 + wr - 1) : 0;
                    const PG8_LAS float* hp = (const PG8_LAS float*)halo + (ps * 2) * 256 + cl + n * 16 + e;
                    const f32x2v hu62 = *(const PG8_LAS f32x2v*)hp, hu63 = *(const PG8_LAS f32x2v*)(hp + 256), hg62 = *(const PG8_LAS f32x2v*)(hp + 128), hg63 = *(const PG8_LAS f32x2v*)(hp + 256 + 128);
                    f32x2v p1u = hu63, p1g = hg63, p2u = fr == 0 ? hu62 : hu63, p2g = fr == 0 ? hg62 : hg63;
#pragma unroll
                    for (int m = 0; m < 4; ++m) {
                        __builtin_amdgcn_sched_barrier(0);
                        f32x2v xu, xg;
                        xu.x = vmul_s(acc[ai][0][m][n][e], rs[ai][m]); xu.y = vmul_s(acc[ai][0][m][n][e + 1], rs[ai][m]); xg.x = vmul_s(acc[ai][1][m][n][e], rs[ai][m]); xg.y = vmul_s(acc[ai][1][m][n][e + 1], rs[ai][m]);
                        f32x2v r1u, r2u, r1g, r2g;
                        r1u.x = dpp_ror1(xu.x); r1u.y = dpp_ror1(xu.y); r2u.x = dpp_ror2(xu.x); r2u.y = dpp_ror2(xu.y);
                        r1g.x = dpp_ror1(xg.x); r1g.y = dpp_ror1(xg.y); r2g.x = dpp_ror2(xg.x); r2g.y = dpp_ror2(xg.y);
                        const f32x2v x1u = fr >= 1 ? r1u : p1u, x2u = fr >= 2 ? r2u : p2u, x1g = fr >= 1 ? r1g : p1g, x2g = fr >= 2 ? r2g : p2g;
                        p1u = r1u; p2u = r2u; p1g = r1g; p2g = r2g;
                        const f32x2v cu = bu + wu0 * x2u + wu1 * x1u + wu2 * xu, cg = bg + wg0 * x2g + wg1 * x1g + wg2 * xg;
                        const float o0 = cg.x * __builtin_amdgcn_rcpf(1.f + __builtin_amdgcn_exp2f(-1.4426950408889634f * cg.x)) * cu.x;
                        const float o1 = cg.y * __builtin_amdgcn_rcpf(1.f + __builtin_amdgcn_exp2f(-1.4426950408889634f * cg.y)) * cu.y;
                        wpk[eh][ai][m] = pk2bf(o0, o1);
                    }
                }
            }
#pragma unroll
            for (int ai = 0; ai < 2; ++ai)
#pragma unroll
                for (int m = 0; m < 4; ++m)
                {
                    u32x2 w; w.x = wpk[0][ai][m]; w.y = wpk[1][ai][m];
                    *(u32x2*)((char*)(act + (size_t)(u.pm * BM + wr * 64 + ai * HALF + m * 16) * DFF + 128 * u.pn + n * 16) + la2) = w; }
        }
    }
};

#ifdef TPROBE
#ifndef TPROBE_PH
#define TPROBE_PH -1
#endif
#define PG8_TP(ph) do { if (TPROBE < 20) break; const unsigned t_ = (unsigned)__builtin_amdgcn_s_memrealtime(); if (wave_s == 0 && lane_id() == 0) { volatile PG8_LAS unsigned* q_ = (volatile PG8_LAS unsigned*)(lds + (163840 - 1024 + 512)); \
        if ((ph) == TPROBE && (TPROBE_PH < 0 || q_[2] == (unsigned)TPROBE_PH)) q_[1] += t_ - q_[0]; q_[0] = t_; } } while (0)
#else
#define PG8_TP(ph) do {} while (0)
#endif
template <class Epi, class Sched, bool ALIGN_EPI = false, bool SP2 = false>
__device__ __forceinline__ void gemm_phase(PG8_LAS unsigned char* lds, const Gemm g, const Sched& S, const Epi& E, const int wave_s) {
    int tid_ = wave_s * 64 + lane_id(); asm volatile("" : "+v"(tid_));
    const int tid = tid_, wid = wave_s, lane = tid & 63, wr = wid >> 2, wc = wid & 3, fr = lane & 15, fq = lane >> 4;
    const int K = g.K, nt = K / BK;
    unsigned voffA[2], voffB[2];
#pragma unroll
    for (int i = 0; i < 2; ++i) { int R, C; stage_rc(tid * 16 + i * 8192, R, C); const int Rb = Epi::PERM ? ((R & ~31) + perm32(R & 31)) : R;
        voffA[i] = (unsigned)(R * K + C) * 2u; voffB[i] = (unsigned)(Rb * K + C) * 2u; }
    const size_t kstep = (size_t)(BK * 2);
    const size_t hstep = (size_t)HALF * K * 2;
    const size_t tstep = 2 * hstep;
    const unsigned ldsw = (unsigned)wid * 1024u;
    const int aoff = lds_byte(wr * 64 + fr, fq * 8), boff = lds_byte(wc * 32 + fr, fq * 8);
#define PG8_SA(b, h) (((b) * 2 + (h)) * HTB)
#define PG8_SB(b, h) ((4 + (b) * 2 + (h)) * HTB)
#define PG8_STAGE(bufoff, gbase, voff) do { _Pragma("unroll") for (int _i = 0; _i < 2; ++_i) \
        __builtin_amdgcn_global_load_lds((const unsigned*)((const char*)(gbase) + (voff)[_i]), (PG8_LAS unsigned*)(lds + (bufoff) + ldsw + _i * 8192), 16, 0, 0); } while (0)
#define PG8_LDA(dst, b, h) do { _Pragma("unroll") for (int m = 0; m < 4; ++m) _Pragma("unroll") for (int k = 0; k < 2; ++k) dst[m][k] = *(const PG8_LAS bf16x8*)(lds + PG8_SA(b, h) + aoff + m * 2048 + k * 1024); } while (0)
#define PG8_LDB(dst, b, h) do { _Pragma("unroll") for (int n = 0; n < 2; ++n) _Pragma("unroll") for (int k = 0; k < 2; ++k) dst[n][k] = *(const PG8_LAS bf16x8*)(lds + PG8_SB(b, h) + boff + n * 2048 + k * 1024); } while (0)
#define PG8_MMA(ai, bj, At, Bt) do { __builtin_amdgcn_s_setprio(1); _Pragma("unroll") for (int m = 0; m < 4; ++m) _Pragma("unroll") for (int n = 0; n < 2; ++n) _Pragma("unroll") for (int k = 0; k < 2; ++k) \
        acc[ai][bj][m][n] = __builtin_amdgcn_mfma_f32_16x16x32_bf16(Bt[n][k], At[m][k], acc[ai][bj][m][n], 0, 0, 0); __builtin_amdgcn_s_setprio(0); } while (0)
#define PG8_WAIT_V(n) asm volatile("s_waitcnt vmcnt(" #n ")" ::: "memory")
#define PG8_WAIT_L(n) asm volatile("s_waitcnt lgkmcnt(" #n ")" ::: "memory")
#define PG8_BAR __builtin_amdgcn_s_barrier()
#define PG8_SCHED __builtin_amdgcn_sched_barrier(0)
    Unit cur, nxt; int ui = 0;
    if (!S.next(0, cur)) return;
    f32x4 acc[2][2][4][2];
#pragma unroll
    for (int a = 0; a < 2; ++a)
#pragma unroll
        for (int b = 0; b < 2; ++b)
#pragma unroll
            for (int m = 0; m < 4; ++m)
#pragma unroll
                for (int n = 0; n < 2; ++n) acc[a][b][m][n] = (f32x4){0.f, 0.f, 0.f, 0.f};
    bf16x8 At[4][2], B0[2][2], B1[2][2];
    const char* cA = (const char*)g.A + (size_t)cur.pm * tstep; const char* cB = (const char*)g.Bt + (size_t)cur.pn * tstep;
    S.a_ready(cur);
    if constexpr (SP2) {
        PG8_STAGE(PG8_SB(0, 0), cB, voffB); PG8_STAGE(PG8_SB(0, 1), cB + hstep, voffB); PG8_STAGE(PG8_SA(0, 0), cA, voffA); PG8_STAGE(PG8_SA(0, 1), cA + hstep, voffA);
        if (wr == 1) PG8_BAR;
        PG8_WAIT_V(2); PG8_BAR;
        PG8_STAGE(PG8_SB(1, 0), cB + kstep, voffB); PG8_STAGE(PG8_SA(1, 0), cA + kstep, voffA); PG8_STAGE(PG8_SB(1, 1), cB + hstep + kstep, voffB);
        PG8_WAIT_V(6); PG8_BAR;
    } else {
        PG8_STAGE(PG8_SB(0, 0), cB, voffB); PG8_STAGE(PG8_SA(0, 0), cA, voffA); PG8_STAGE(PG8_SB(0, 1), cB + hstep, voffB); PG8_STAGE(PG8_SA(0, 1), cA + hstep, voffA);
        if (wr == 1) PG8_BAR;
        PG8_WAIT_V(4); PG8_BAR;
        PG8_STAGE(PG8_SB(1, 0), cB + kstep, voffB); PG8_STAGE(PG8_SA(1, 0), cA + kstep, voffA); PG8_STAGE(PG8_SB(1, 1), cB + hstep + kstep, voffB);
        PG8_WAIT_V(6); PG8_BAR;
    }
    for (;;) {
        const bool has_next = S.next(ui + 1, nxt);
        const char* nA = has_next ? (const char*)g.A + (size_t)nxt.pm * tstep : cA; const char* nB = has_next ? (const char*)g.Bt + (size_t)nxt.pn * tstep : cB;
        for (int t = 0; t < nt; t += 2) {
            const bool last = (t == nt - 2);
            const char* a1 = cA + (size_t)(t + 1) * kstep;
            const char* a2 = last ? nA : cA + (size_t)(t + 2) * kstep; const char* b2 = last ? nB : cB + (size_t)(t + 2) * kstep;
            const char* a3 = a2 + kstep; const char* b3 = b2 + kstep;
            if (last && has_next) S.a_ready(nxt);
            if constexpr (SP2) {
            PG8_LDB(B0, 0, 0); PG8_LDB(B1, 0, 1); PG8_SCHED; PG8_LDA(At, 0, 0); PG8_STAGE(PG8_SA(1, 1), a1 + hstep, voffA);
            PG8_WAIT_V(8); PG8_WAIT_L(0); PG8_BAR; PG8_MMA(0, 0, At, B0); PG8_MMA(0, 1, At, B1); PG8_BAR; PG8_SCHED;
            PG8_LDA(At, 0, 1); PG8_STAGE(PG8_SB(0, 0), b2, voffB); PG8_STAGE(PG8_SB(0, 1), b2 + hstep, voffB); PG8_STAGE(PG8_SA(0, 0), a2, voffA);
            PG8_WAIT_V(8); PG8_WAIT_L(0); PG8_BAR; PG8_MMA(1, 0, At, B0); PG8_MMA(1, 1, At, B1); PG8_BAR; PG8_SCHED;
            PG8_LDB(B0, 1, 0); PG8_LDB(B1, 1, 1); PG8_SCHED; PG8_LDA(At, 1, 0); PG8_STAGE(PG8_SA(0, 1), a2 + hstep, voffA);
            PG8_WAIT_V(8); PG8_WAIT_L(0); PG8_BAR; PG8_MMA(0, 0, At, B0); PG8_MMA(0, 1, At, B1); PG8_BAR; PG8_SCHED;
            PG8_LDA(At, 1, 1); PG8_STAGE(PG8_SB(1, 0), b3, voffB); PG8_STAGE(PG8_SB(1, 1), b3 + hstep, voffB); PG8_STAGE(PG8_SA(1, 0), a3, voffA);
            PG8_WAIT_V(8); PG8_WAIT_L(0); PG8_BAR; PG8_MMA(1, 0, At, B0); PG8_MMA(1, 1, At, B1); PG8_BAR; PG8_SCHED;
            } else {
            PG8_LDB(B0, 0, 0); PG8_SCHED; PG8_LDA(At, 0, 0); PG8_STAGE(PG8_SA(1, 1), a1 + hstep, voffA);
            PG8_WAIT_L(8); PG8_BAR; PG8_WAIT_L(0); PG8_MMA(0, 0, At, B0); PG8_BAR; PG8_SCHED;
            PG8_LDB(B1, 0, 1); PG8_STAGE(PG8_SB(0, 0), b2, voffB);
            PG8_BAR; PG8_WAIT_L(0); PG8_MMA(0, 1, At, B1); PG8_BAR;
            PG8_LDA(At, 0, 1); PG8_STAGE(PG8_SA(0, 0), a2, voffA);
            PG8_BAR; PG8_WAIT_L(0); PG8_MMA(1, 0, At, B0); PG8_BAR; PG8_SCHED;
            PG8_STAGE(PG8_SB(0, 1), b2 + hstep, voffB);
            PG8_WAIT_V(6); PG8_BAR; PG8_MMA(1, 1, At, B1); PG8_BAR;
            PG8_LDB(B0, 1, 0); PG8_SCHED; PG8_LDA(At, 1, 0); PG8_STAGE(PG8_SA(0, 1), a2 + hstep, voffA);
            PG8_WAIT_L(8); PG8_BAR; PG8_WAIT_L(0); PG8_MMA(0, 0, At, B0); PG8_BAR; PG8_SCHED;
            PG8_LDB(B1, 1, 1); PG8_STAGE(PG8_SB(1, 0), b3, voffB);
            PG8_BAR; PG8_WAIT_L(0); PG8_MMA(0, 1, At, B1); PG8_BAR;
            PG8_LDA(At, 1, 1); PG8_STAGE(PG8_SA(1, 0), a3, voffA);
            PG8_BAR; PG8_WAIT_L(0); PG8_MMA(1, 0, At, B0); PG8_BAR; PG8_SCHED;
            PG8_STAGE(PG8_SB(1, 1), b3 + hstep, voffB);
            PG8_WAIT_V(6); PG8_BAR; PG8_MMA(1, 1, At, B1); PG8_BAR;
            }
        }
        PG8_TP(49);
        if constexpr (ALIGN_EPI) { if (wr == 0) PG8_BAR; }
        if constexpr (!Epi::AFTER_DRAIN) { E(acc, cur, wr, wc, fr, fq); S.done(cur); }
        PG8_TP(50);
        if (!has_next) break;
#pragma unroll
        for (int a = 0; a < 2; ++a)
#pragma unroll
            for (int b = 0; b < 2; ++b)
#pragma unroll
                for (int m = 0; m < 4; ++m)
#pragma unroll
                    for (int n = 0; n < 2; ++n) acc[a][b][m][n] = (f32x4){0.f, 0.f, 0.f, 0.f};
        cur = nxt; cA = nA; cB = nB; ++ui;
        if constexpr (ALIGN_EPI) { if (wr == 1) PG8_BAR; }
    }
    PG8_WAIT_V(0);
    if constexpr (!ALIGN_EPI) { if (wr == 0) PG8_BAR; }
    PG8_BAR;
    if constexpr (Epi::AFTER_DRAIN) { E.fused(acc, cur, wr, wc, fr, fq, lds, wid, lane); S.done(cur); }
#undef PG8_SA
#undef PG8_SB
#undef PG8_STAGE
#undef PG8_LDA
#undef PG8_LDB
#undef PG8_MMA
#undef PG8_WAIT_V
#undef PG8_WAIT_L
#undef PG8_BAR
#undef PG8_SCHED
}
}
#include <hip/hip_bf16.h>
#include <cmath>
namespace attn_body {
using bf16=__hip_bfloat16;
using bf16x8=__attribute__((ext_vector_type(8)))short;
using s16x4=__attribute__((ext_vector_type(4)))short;
using f32x16=__attribute__((ext_vector_type(16)))float;
using u32x4=__attribute__((ext_vector_type(4)))unsigned;
constexpr int BATCH=8,NHEAD=8,SEQ=2048,D=64,PITCH=3584,OPITCH=1024,LEADROW=16384,VK=2176;
constexpr int NW=8,QBLK=32,QB=QBLK*NW,KVBLK=64,NQB=SEQ/QB;
constexpr int ATTN_UNIT_ROWS=QB;
__device__ __forceinline__ int crow(int r,int hi){return (r&3)+8*(r>>2)+4*hi;}
#define SBAR() __builtin_amdgcn_sched_barrier(0)
__device__ __forceinline__ void cmask(f32x16&p0,f32x16&p1,int jb,int qrel,int hi){
  const float NEG=-INFINITY; int kb=64*jb+4*hi;
  #pragma unroll
  for(int r=0;r<16;++r){int kv=kb+(r&3)+8*(r>>2); if(kv>qrel)p0[r]=NEG; if(kv+32>qrel)p1[r]=NEG;}
}

constexpr int NSLOT=3, SLOTB=8192;
constexpr int LDS_K=0, LDS_V=NSLOT*SLOTB, LDS_WS=2*NSLOT*SLOTB, LDS_OST=LDS_WS+NW*64*4, LDS_C2=LDS_OST+NW*4096, LDS_BYTES=LDS_C2+VK*4;
constexpr float C2=0.125f*1.4426950408889634f;
__device__ __forceinline__ void glds16(const void*gsrc,unsigned lds_dst){unsigned keep;
  asm volatile("s_mov_b32 %0, m0\n\ts_mov_b32 m0, %2\n\ts_nop 0\n\tglobal_load_lds_dwordx4 %1, off\n\ts_mov_b32 m0, %0":"=&s"(keep):"v"(gsrc),"s"(lds_dst):"memory");}
__device__ __forceinline__ float max3f(float a,float b,float c){float r;asm("v_max3_f32 %0, %1, %2, %3":"=v"(r):"v"(a),"v"(b),"v"(c));return r;}
__device__ __forceinline__ float max2f(float a,float b){float r;asm("v_max_f32_e32 %0, %1, %2":"=v"(r):"v"(a),"v"(b));return r;}
__device__ __forceinline__ float fadd_s(float a,float b){float r;asm("v_add_f32_e32 %0, %1, %2":"=v"(r):"v"(a),"v"(b));return r;}
__device__ __forceinline__ float fsub_s(float a,float b){float r;asm("v_sub_f32_e32 %0, %1, %2":"=v"(r):"v"(a),"v"(b));return r;}
typedef float f32x2_t __attribute__((ext_vector_type(2))); typedef __bf16 bf16x2_t __attribute__((ext_vector_type(2)));
__device__ __forceinline__ unsigned cvtpk_s(float lo,float hi){f32x2_t v={lo,hi};bf16x2_t b=__builtin_convertvector(v,bf16x2_t);return __builtin_bit_cast(unsigned,b);}
#define WAIT_BAR(N) asm volatile("s_waitcnt vmcnt(" #N ") lgkmcnt(0)\n\ts_barrier":::"memory")

__device__ __forceinline__ void qkt(f32x16&p0,f32x16&p1,const char*Kslot,const bf16x8*qr,int r32,int hi){
  const char*kb=Kslot+hi*1024+r32*16;
  #pragma unroll
  for(int d0=0;d0<4;++d0){
    const bf16x8 b0=*reinterpret_cast<const bf16x8*>(kb+d0*2048);
    const bf16x8 b1=*reinterpret_cast<const bf16x8*>(kb+d0*2048+512);
    p0=__builtin_amdgcn_mfma_f32_32x32x16_bf16(b0,qr[d0],p0,0,0,0);p1=__builtin_amdgcn_mfma_f32_32x32x16_bf16(b1,qr[d0],p1,0,0,0);}
}
typedef __attribute__((address_space(3))) const char* lds_cptr;
typedef short v4i16_t __attribute__((ext_vector_type(4)));
__device__ __forceinline__ void kload8(bf16x8*kf,lds_cptr kp){
  kf[0]=*(const __attribute__((address_space(3))) bf16x8*)(kp);      kf[1]=*(const __attribute__((address_space(3))) bf16x8*)(kp+512);
  kf[2]=*(const __attribute__((address_space(3))) bf16x8*)(kp+2048); kf[3]=*(const __attribute__((address_space(3))) bf16x8*)(kp+2560);
  kf[4]=*(const __attribute__((address_space(3))) bf16x8*)(kp+4096); kf[5]=*(const __attribute__((address_space(3))) bf16x8*)(kp+4608);
  kf[6]=*(const __attribute__((address_space(3))) bf16x8*)(kp+6144); kf[7]=*(const __attribute__((address_space(3))) bf16x8*)(kp+6656);
}
__device__ __forceinline__ void kload2(bf16x8*kf,lds_cptr kp,int j){ kf[2*j]=*(const __attribute__((address_space(3))) bf16x8*)(kp+j*2048); kf[2*j+1]=*(const __attribute__((address_space(3))) bf16x8*)(kp+j*2048+512); }
__device__ __forceinline__ s16x4 vtr(lds_cptr p){ return __builtin_bit_cast(s16x4,__builtin_amdgcn_ds_read_tr16_b64_v4i16((__attribute__((address_space(3))) v4i16_t*)p)); }
__device__ __forceinline__ float rowmax(const f32x16&p0,const f32x16&p1){
  float a=max3f(p0[0],p0[1],p1[0]),b=max3f(p0[2],p0[3],p1[1]);a=max3f(a,p1[2],p1[3]);
  #pragma unroll
  for(int r=4;r<16;r+=4){a=max3f(a,p0[r],p0[r+1]);b=max3f(b,p0[r+2],p0[r+3]);a=max3f(a,p1[r],p1[r+1]);b=max3f(b,p1[r+2],p1[r+3]);}
  const float m=max2f(a,b);
  auto rr=__builtin_amdgcn_permlane32_swap(__float_as_uint(m),__float_as_uint(m),false,false);
  return max2f(__uint_as_float(rr[0]),__uint_as_float(rr[1]));
}
__device__ __forceinline__ void pv(f32x16*o,int vb,bf16x8 pa0,bf16x8 pa1,bf16x8 pa2,bf16x8 pa3){
  #pragma unroll
  for(int d0=0;d0<2;++d0){s16x4 lo[4],hi[4];
    #pragma unroll
    for(int ks=0;ks<4;++ks){
      asm volatile("ds_read_b64_tr_b16 %0,%1 offset:%c2":"=&v"(lo[ks]):"v"(vb),"i"(d0*4096+ks*1024):"memory");
      asm volatile("ds_read_b64_tr_b16 %0,%1 offset:%c2":"=&v"(hi[ks]):"v"(vb),"i"(d0*4096+ks*1024+512):"memory");}
    asm volatile("s_waitcnt lgkmcnt(0)":::"memory");SBAR();
    #define PK(k) (bf16x8){lo[k][0],lo[k][1],lo[k][2],lo[k][3],hi[k][0],hi[k][1],hi[k][2],hi[k][3]}
    o[d0]=__builtin_amdgcn_mfma_f32_32x32x16_bf16(pa0,PK(0),o[d0],0,0,0);
    o[d0]=__builtin_amdgcn_mfma_f32_32x32x16_bf16(pa1,PK(1),o[d0],0,0,0);
    o[d0]=__builtin_amdgcn_mfma_f32_32x32x16_bf16(pa2,PK(2),o[d0],0,0,0);
    o[d0]=__builtin_amdgcn_mfma_f32_32x32x16_bf16(pa3,PK(3),o[d0],0,0,0);
    #undef PK
  }
}

#ifndef ATTN_STORE16
#define ATTN_STORE16(p,v) (*(u32x4*)(p)=(v))
#endif
template<int THRL> __device__ __forceinline__ void attn_unit(int b,int h,int qb,const bf16*Q,const bf16*__restrict__ K,const bf16*__restrict__ V,const bf16*__restrict__ OG,const float*__restrict__ c2v,bf16*O,char*shm,const int wave_s,const bool stage_c2=true){
  int tid_=wave_s*64+lane_id(); asm volatile("":"+v"(tid_));
  const int tid=tid_,lane=tid&63,r32=lane&31,hi=lane>>5; const int wid=wave_s;
  const long rowbase=(long)b*SEQ; const int q0=qb*QB;
  const bf16*Qw=Q+(rowbase+q0+wid*QBLK)*PITCH+h*D;
  const bf16*Kh=K+(rowbase-2*KVBLK)*PITCH+h*D,*Vh=V+(rowbase-2*KVBLK)*PITCH+h*D;
  const bf16*KhL=K+(long)LEADROW*PITCH+h*D,*VhL=V+(long)LEADROW*PITCH+h*D;
  const unsigned lds0=(unsigned)(uintptr_t)shm;
  float*wsf=(float*)(shm+LDS_WS)+wid*64;
  const bf16*ksrc=Kh+(long)lane*PITCH+wid*8,*ksrcL=KhL+(long)lane*PITCH+wid*8;
  const bf16*vsrc=Vh+(long)(16*(wid&3)+(lane>>2))*PITCH+(wid>>2)*32+(lane&3)*8,*vsrcL=VhL+(long)(16*(wid&3)+(lane>>2))*PITCH+(wid>>2)*32+(lane&3)*8;
  const unsigned kdst=lds0+LDS_K+wid*1024, vdst=lds0+LDS_V+wid*1024;
  #define DMA_K(t,slot) glds16(((t)<2?ksrcL:ksrc)+(long)(t)*KVBLK*PITCH,(unsigned)__builtin_amdgcn_readfirstlane(kdst+(slot)))
  #define DMA_V(t,slot) glds16(((t)<2?vsrcL:vsrc)+(long)(t)*KVBLK*PITCH,(unsigned)__builtin_amdgcn_readfirstlane(vdst+(slot)))
  const int vb0=(int)(lds0+LDS_V)+((lane>>4)&1)*32+(lane&3)*8+(4*hi+((lane&15)>>2))*64;
  const char*Kbase=shm+LDS_K; bf16x8 kf[8];
  const lds_cptr shm3=(lds_cptr)shm; const lds_cptr kp0=shm3+LDS_K+hi*1024+r32*16; const lds_cptr vp0=shm3+LDS_V+((lane>>4)&1)*32+(lane&3)*8+(4*hi+((lane&15)>>2))*64;
  const int NT=(q0+QB)/KVBLK+2;
  if(stage_c2){ __attribute__((address_space(3))) float*negc_w=(__attribute__((address_space(3))) float*)((lds_cptr)shm+LDS_C2); const float*cs=c2v+(long)(b*NHEAD+h)*VK;
    float cv_[5];
    _Pragma("unroll") for(int i_=0;i_<5;++i_){const int i=tid+i_*NW*64; cv_[i_]=i<NT*KVBLK?cs[i]:0.f;}
    _Pragma("unroll") for(int i_=0;i_<5;++i_){const int i=tid+i_*NW*64; if(i<NT*KVBLK)negc_w[i]=-cv_[i_];} }
  const __attribute__((address_space(3))) float* negc3=(const __attribute__((address_space(3))) float*)((lds_cptr)shm+LDS_C2)+4*hi;
  typedef float f32x4_t __attribute__((ext_vector_type(4)));
  #define NEGC(t,i) (*(const __attribute__((address_space(3))) f32x4_t*)(negc3+64*(t)+(((i)>>2)*32)+8*((i)&3)))
  DMA_K(0,0);DMA_V(0,0);DMA_K(1,SLOTB);
  bf16x8 qr[4];
  #pragma unroll
  for(int d0=0;d0<4;++d0)qr[d0]=*reinterpret_cast<const bf16x8*>(&Qw[(long)r32*PITCH+d0*16+hi*8]);
  float mhat=0.f,l_reg=0.f;f32x16 o[2];o[0]=f32x16{};o[1]=f32x16{};
  const int qrel=wid*QBLK+r32;
  #define CMASK(P0,P1,t) do{int jb_=(t)-(NT-4); if(jb_>=0)cmask(P0,P1,jb_,qrel,hi);}while(0)
  bool resc=false;
  #define START(P0,P1) do{ const float rm=rowmax(P0,P1); resc=false; \
    { const float dl=rm; mhat=fadd_s(mhat,dl); \
      _Pragma("unroll") for(int r=0;r<16;++r){P0[r]=fsub_s(P0[r],dl);P1[r]=fsub_s(P1[r],dl);} } \
    _Pragma("unroll") for(int r=0;r<16;++r)P0[r]=__builtin_amdgcn_exp2f(P0[r]); }while(0)
  #define RESC() do{ if(resc){ asm volatile("s_waitcnt lgkmcnt(0)":::"memory"); \
      _Pragma("unroll") for(int d_=0;d_<2;++d_) _Pragma("unroll") for(int r=0;r<16;++r)o[d_][r]*=wsf[crow(r,hi)]; } }while(0)
  f32x16 pA0,pA1,pB0,pB1;
  int sl_prev=0,sl_cur=0,sl_next=SLOTB;
  #define ROT() do{sl_prev=sl_cur;sl_cur=sl_next;sl_next=(sl_next==(NSLOT-1)*SLOTB)?0:sl_next+SLOTB;}while(0)
  DMA_K(2,2*SLOTB);
  WAIT_BAR(3);
  #define FILLT(P0,P1,t) do{ _Pragma("unroll") for(int i_=0;i_<4;++i_){ const f32x4_t a_=NEGC(t,i_),b_=NEGC(t,4+i_); \
      P0[4*i_]=a_[0]-mhat;P0[4*i_+1]=a_[1]-mhat;P0[4*i_+2]=a_[2]-mhat;P0[4*i_+3]=a_[3]-mhat; P1[4*i_]=b_[0]-mhat;P1[4*i_+1]=b_[1]-mhat;P1[4*i_+2]=b_[2]-mhat;P1[4*i_+3]=b_[3]-mhat; } }while(0)
  FILLT(pA0,pA1,0);
  qkt(pA0,pA1,Kbase,qr,r32,hi);asm volatile("s_nop 15\n\ts_nop 7":"+v"(pA0),"+v"(pA1));CMASK(pA0,pA1,0);
  START(pA0,pA1);
  FILLT(pB0,pB1,1);
  _Pragma("unroll") for(int r=0;r<16;++r)pA1[r]=__builtin_amdgcn_exp2f(pA1[r]);
  WAIT_BAR(0);
  DMA_K(3,0);DMA_V(1,SLOTB);
  ROT();
  kload8(kf,kp0+sl_cur);
  WAIT_BAR(2);
  s16x4 vlo[8],vhi[8]; u32x4 pw0,pw1,pw2,pw3;
  #define PKW(P,B) cvtpk_s(P[B],P[B+1])
  #define PAF(k) __builtin_bit_cast(bf16x8,pw##k)
  #define VFR(i) (bf16x8){vlo[i][0],vlo[i][1],vlo[i][2],vlo[i][3],vhi[i][0],vhi[i][1],vhi[i][2],vhi[i][3]}
  #define PIN(x) asm volatile("":"+v"(x))
  #define MX3(a,b,c) __builtin_fmaxf(__builtin_fmaxf((a),(b)),(c))
  #define GAPA(MF,A0,A1,A2,A3,W0,W1,PW) do{ MF; sacc+=A0; sacc+=A1; sacc+=A2; sacc+=A3; PIN(sacc); W0; W1; PIN(PW); SBAR(); }while(0)
  #define EX(v) __builtin_amdgcn_exp2f(v)
  #define GAPB(MF,X,B,FP,FB,I,t,GF) do{ MF; X[B]=EX(X[B]); X[B+1]=EX(X[B+1]); X[B+2]=EX(X[B+2]); X[B+3]=EX(X[B+3]); \
      if(GF){ FP[FB]=fsub_s(cn_[0],mhat); FP[FB+1]=fsub_s(cn_[1],mhat); FP[FB+2]=fsub_s(cn_[2],mhat); FP[FB+3]=fsub_s(cn_[3],mhat); PIN(FP); if((I)<7){cn_=NEGC((t)+1,(I)+1);} } \
      PIN(X); SBAR(); }while(0)
  #define VRD(i) do{ vlo[i]=vtr(vp_+(((i)>>2)*4096+((i)&3)*1024)); vhi[i]=vtr(vp_+(((i)>>2)*4096+((i)&3)*1024+512)); }while(0)
  #define KRD(G,j) do{ if(G){ kload2(kf,kp0+sl_next,j); SBAR(); } }while(0)
  #define STEP(C0,C1,P0,P1,t,GK,GV,GL) do{ SBAR(); \
    const lds_cptr vp_=vp0+sl_prev; \
    VRD(0); SBAR(); float sacc=(P0[0]+P0[1]); \
    GAPA(C0=__builtin_amdgcn_mfma_f32_32x32x16_bf16(kf[0],qr[0],C0,0,0,0), P0[2],P0[3],P0[4],P0[5],     pw0[0]=PKW(P0,0), pw0[1]=PKW(P0,2), pw0); \
    VRD(4); SBAR(); GAPA(C1=__builtin_amdgcn_mfma_f32_32x32x16_bf16(kf[1],qr[0],C1,0,0,0), P0[6],P0[7],P0[8],P0[9],     pw0[2]=PKW(P0,4), pw0[3]=PKW(P0,6), pw0); \
    VRD(1); SBAR(); GAPA(C0=__builtin_amdgcn_mfma_f32_32x32x16_bf16(kf[2],qr[1],C0,0,0,0),   P0[10],P0[11],P0[12],P0[13], pw1[0]=PKW(P0,8), pw1[1]=PKW(P0,10), pw1); \
    VRD(5); SBAR(); GAPA(C1=__builtin_amdgcn_mfma_f32_32x32x16_bf16(kf[3],qr[1],C1,0,0,0),   P0[14],P0[15],P1[0],P1[1],   pw1[2]=PKW(P0,12),pw1[3]=PKW(P0,14), pw1); \
    VRD(2); SBAR(); GAPA(C0=__builtin_amdgcn_mfma_f32_32x32x16_bf16(kf[4],qr[2],C0,0,0,0),   P1[2],P1[3],P1[4],P1[5],     pw2[0]=PKW(P1,0), pw2[1]=PKW(P1,2), pw2); \
    VRD(6); SBAR(); GAPA(C1=__builtin_amdgcn_mfma_f32_32x32x16_bf16(kf[5],qr[2],C1,0,0,0),   P1[6],P1[7],P1[8],P1[9],     pw2[2]=PKW(P1,4), pw2[3]=PKW(P1,6), pw2); \
    VRD(3); SBAR(); GAPA(C0=__builtin_amdgcn_mfma_f32_32x32x16_bf16(kf[6],qr[3],C0,0,0,0),   P1[10],P1[11],P1[12],P1[13], pw3[0]=PKW(P1,8), pw3[1]=PKW(P1,10), pw3); \
    VRD(7); SBAR(); GAPA(C1=__builtin_amdgcn_mfma_f32_32x32x16_bf16(kf[7],qr[3],C1,0,0,0),   P1[14],P1[15],0.f,0.f,       pw3[2]=PKW(P1,12),pw3[3]=PKW(P1,14), pw3); \
    l_reg+=sacc; \
    if(GK){DMA_K((t)+3,sl_cur);} if(GV){DMA_V((t)+1,sl_next);} \
    CMASK(C0,C1,t); \
    { float a=MX3(C0[0],C0[1],C1[0]),b=MX3(C0[2],C0[3],C1[1]); a=MX3(a,C1[2],C1[3]); \
      _Pragma("unroll") for(int r=4;r<16;r+=4){a=MX3(a,C0[r],C0[r+1]);b=MX3(b,C0[r+2],C0[r+3]);a=MX3(a,C1[r],C1[r+1]);b=MX3(b,C1[r+2],C1[r+3]);} \
      float rm=__builtin_fmaxf(a,b); { auto rr=__builtin_amdgcn_permlane32_swap(__float_as_uint(rm),__float_as_uint(rm),false,false); rm=__builtin_fmaxf(__uint_as_float(rr[0]),__uint_as_float(rr[1])); } \
      resc=false; \
      if(__builtin_expect(__any(rm>(float)THRL),0)){ const float dl=__builtin_fmaxf(rm,0.f); mhat+=dl; \
        _Pragma("unroll") for(int r=0;r<16;++r){C0[r]-=dl;C1[r]-=dl;} \
        const float f=__builtin_amdgcn_exp2f(-dl); l_reg*=f; if(hi==0)wsf[r32]=f; resc=true; } } \
    f32x4_t cn_=(f32x4_t){0.f,0.f,0.f,0.f}; if(GL){cn_=NEGC((t)+1,0);} \
    SBAR(); \
    GAPB(o[0]=__builtin_amdgcn_mfma_f32_32x32x16_bf16(PAF(0),VFR(0),o[0],0,0,0), C0,0,P0,0,0,t,GL); \
    GAPB(o[1]=__builtin_amdgcn_mfma_f32_32x32x16_bf16(PAF(0),VFR(4),o[1],0,0,0), C0,4,P0,4,1,t,GL); \
    KRD(GL,0); GAPB(o[0]=__builtin_amdgcn_mfma_f32_32x32x16_bf16(PAF(1),VFR(1),o[0],0,0,0), C0,8,P0,8,2,t,GL); \
    KRD(GL,1); GAPB(o[1]=__builtin_amdgcn_mfma_f32_32x32x16_bf16(PAF(1),VFR(5),o[1],0,0,0), C0,12,P0,12,3,t,GL); \
    KRD(GL,2); GAPB(o[0]=__builtin_amdgcn_mfma_f32_32x32x16_bf16(PAF(2),VFR(2),o[0],0,0,0), C1,0,P1,0,4,t,GL); \
    KRD(GL,3); GAPB(o[1]=__builtin_amdgcn_mfma_f32_32x32x16_bf16(PAF(2),VFR(6),o[1],0,0,0), C1,4,P1,4,5,t,GL); \
    GAPB(o[0]=__builtin_amdgcn_mfma_f32_32x32x16_bf16(PAF(3),VFR(3),o[0],0,0,0), C1,8,P1,8,6,t,GL); \
    GAPB(o[1]=__builtin_amdgcn_mfma_f32_32x32x16_bf16(PAF(3),VFR(7),o[1],0,0,0), C1,12,P1,12,7,t,GL); \
    }while(0)
  int t=1;
  #undef CMASK
  #define CMASK(P0,P1,t) do{}while(0)
  for(;t+5<NT;t+=2){
    STEP(pB0,pB1,pA0,pA1,t,true,true,true);     WAIT_BAR(2); RESC(); ROT();
    STEP(pA0,pA1,pB0,pB1,t+1,true,true,true);   WAIT_BAR(2); RESC(); ROT();
  }
  #undef CMASK
  #define CMASK(P0,P1,t) do{int jb_=(t)-(NT-4); if(jb_>=0)cmask(P0,P1,jb_,qrel,hi);}while(0)
  #define ENDW(tt) do{ if((tt)+3<NT){WAIT_BAR(2);} else if((tt)+2<NT){WAIT_BAR(1);} else {WAIT_BAR(0);} }while(0)
  for(;t+1<NT;t+=2){
    STEP(pB0,pB1,pA0,pA1,t,(t+3<NT),(t+1<NT),(t+1<NT));       ENDW(t);   RESC(); ROT();
    STEP(pA0,pA1,pB0,pB1,t+1,(t+4<NT),(t+2<NT),(t+2<NT));     ENDW(t+1); RESC(); ROT();
  }
  STEP(pB0,pB1,pA0,pA1,NT-1,false,false,false); RESC();
  { float sacc=pB0[0]+pB0[1]; _Pragma("unroll") for(int r=2;r<16;++r)sacc+=pB0[r]; _Pragma("unroll") for(int r=0;r<16;++r)sacc+=pB1[r]; l_reg+=sacc;
    pw0=(u32x4){PKW(pB0,0),PKW(pB0,2),PKW(pB0,4),PKW(pB0,6)};pw1=(u32x4){PKW(pB0,8),PKW(pB0,10),PKW(pB0,12),PKW(pB0,14)};pw2=(u32x4){PKW(pB1,0),PKW(pB1,2),PKW(pB1,4),PKW(pB1,6)};pw3=(u32x4){PKW(pB1,8),PKW(pB1,10),PKW(pB1,12),PKW(pB1,14)};
    SBAR(); pv(o,vb0+sl_cur,PAF(0),PAF(1),PAF(2),PAF(3)); }
  #undef PKW
  #undef PAF
  #undef VFR
  #undef PIN
  #undef MX3
  #undef GAPA
  #undef GAPB
  #undef EX
  #undef VRD
  #undef KRD
  #undef STEP
  #undef ENDW
  {auto rr=__builtin_amdgcn_permlane32_swap(__float_as_uint(l_reg),__float_as_uint(l_reg),false,false);l_reg=__uint_as_float(rr[0])+__uint_as_float(rr[1]);}
  if(hi==0)wsf[32+r32]=l_reg;asm volatile("s_waitcnt lgkmcnt(0)":::"memory");
  float rli[16];
  #pragma unroll
  for(int r=0;r<16;++r)rli[r]=__builtin_amdgcn_rcpf(wsf[32+crow(r,hi)]);
  bf16*Ow=O+(rowbase+q0+wid*QBLK)*OPITCH+h*D; const bf16*Gw=OG+(rowbase+q0+wid*QBLK)*PITCH+h*D;
  u32x4 gg[4];
  #pragma unroll
  for(int i=0;i<4;++i){const int row=i*8+(lane>>3),ch=lane&7; gg[i]=*(const u32x4*)(Gw+(long)row*PITCH+ch*8);}
  { bf16*stg=(bf16*)(shm+LDS_OST)+wid*2048;
    #pragma unroll
    for(int r=0;r<16;++r){const int orow=crow(r,hi);
      #pragma unroll
      for(int d0=0;d0<2;++d0)stg[orow*64+d0*32+r32]=__float2bfloat16(o[d0][r]*rli[r]);}
    asm volatile("s_waitcnt lgkmcnt(0)":::"memory");
    #pragma unroll
    for(int i=0;i<4;++i){const int row=i*8+(lane>>3),ch=lane&7; u32x4 v=*(const u32x4*)(stg+row*64+ch*8);
      #pragma unroll
      for(int w=0;w<4;++w){ const float o0=__uint_as_float(v[w]<<16),o1=__uint_as_float(v[w]&0xffff0000u),g0=__uint_as_float(gg[i][w]<<16),g1=__uint_as_float(gg[i][w]&0xffff0000u);
        v[w]=cvtpk_s(o0*__builtin_amdgcn_rcpf(1.f+__builtin_amdgcn_exp2f(-1.4426950408889634f*g0)),o1*__builtin_amdgcn_rcpf(1.f+__builtin_amdgcn_exp2f(-1.4426950408889634f*g1))); }
      ATTN_STORE16(Ow+(long)row*OPITCH+ch*8,v);} }
  asm volatile("s_waitcnt lgkmcnt(0)\n\ts_barrier":::"memory");
  #undef DMA_K
  #undef NEGC
  #undef FILLT
  #undef DMA_V
  #undef CMASK
  #undef START
  #undef RESC
  #undef ROT
}
constexpr int ATTN_LDS_BYTES=LDS_BYTES;
struct AttnTensors { const bf16* Q; const bf16* K; const bf16* V; const bf16* OG; const float* c2v; bf16* O; };
struct AttnUnit { int bh; int qb; };
struct StaticOrder {
  int vcu, G, blk;
  __device__ __forceinline__ explicit StaticOrder(int grid,int block):vcu((grid%8==0)?(block%8)*(grid/8)+block/8:block),G(grid),blk(block){}
  __device__ __forceinline__ bool next(int i,AttnUnit&u)const{
    if(G==256){ if(blk<64){ if(i>=1)return false; u.bh=blk; u.qb=0; return true; } const int j=blk-64,g=j>>6; u.bh=j&63;
      if(g==0){ if(i>=2)return false; u.qb=i?3:7; } else if(g==1){ if(i>=2)return false; u.qb=i?4:6; } else { if(i>=3)return false; u.qb=i==0?5:3-i; }
      return true; }
    const int pair=vcu+(i>>1)*G; if(pair>=BATCH*NHEAD*4)return false; const int s=pair&3; u.bh=pair>>2; u.qb=(i&1)?s:7-s; return true; }
  __device__ __forceinline__ void a_ready(const AttnUnit&)const{}
  __device__ __forceinline__ void done(const AttnUnit&)const{}
};
template<class Sched,int THRL=8> __device__ __forceinline__ void attn_phase(char*lds,const AttnTensors&T,const Sched&S,const int wave_s){
  AttnUnit u;
  int pbh=-1,pqb=-1;
  for(int i=0;S.next(i,u);++i){ S.a_ready(u); attn_unit<THRL>(u.bh/NHEAD,u.bh%NHEAD,u.qb,T.Q,T.K,T.V,T.OG,T.c2v,T.O,lds,wave_s,!(u.bh==pbh&&u.qb<=pqb)); if(u.bh!=pbh||u.qb>pqb){pbh=u.bh;pqb=u.qb;} S.done(u); }
}
#undef SBAR
#undef WAIT_BAR
}
#define GAS __attribute__((address_space(1)))
#define LAS __attribute__((address_space(3)))
typedef unsigned short bf16;
typedef unsigned v4u __attribute__((ext_vector_type(4)));
typedef float f32x4 __attribute__((ext_vector_type(4)));
typedef short bf16x8 __attribute__((ext_vector_type(8)));
typedef GAS unsigned gu32;
typedef GAS unsigned long long gu64;
#define RLX_AGENT __ATOMIC_RELAXED, __HIP_MEMORY_SCOPE_AGENT
#define LDS_WAIT() asm volatile("s_waitcnt lgkmcnt(0)" ::: "memory")
#define VM_WAIT() asm volatile("s_waitcnt vmcnt(0)" ::: "memory")
#define XB_TMO      128
#define XB_XCNT(j)  (256  + 64 * (j))
#define XB_XSUB(j)  (1280 + 64 * (j))
#define XB_XGEN(j)  (2304 + 64 * (j))
#define XB_TOP      3328
#define XB_TOPGEN   3392
#define XCD_BAR_WORDS 3456
#define XB_SPIN_CAP (1u << 18)

__device__ __forceinline__ unsigned xb_ld(unsigned* p)              { return __hip_atomic_load(p, __ATOMIC_RELAXED, __HIP_MEMORY_SCOPE_AGENT); }
__device__ __forceinline__ unsigned xb_add(unsigned* p, unsigned v) { return __hip_atomic_fetch_add(p, v, __ATOMIC_RELAXED, __HIP_MEMORY_SCOPE_AGENT); }
__device__ __forceinline__ unsigned xb_xcc_id() { return (unsigned)__builtin_amdgcn_s_getreg((3 << 11) | 20) & 0xFu; }
#define XB_SPIN(cond, bar) do { unsigned _sp = 0; while (cond) { __builtin_amdgcn_s_sleep(1); \
    if ((++_sp & 255u) == 0u) { if (xb_ld(&(bar)[XB_TMO])) break; if (_sp > XB_SPIN_CAP) { atomicAdd(&(bar)[XB_TMO], 1u); break; } } } } while (0)

struct XcdBarrier {
    unsigned* bar; unsigned x;
    volatile LAS unsigned* st;
};

__device__ __forceinline__ XcdBarrier xcd_barrier_post(unsigned* bar, volatile LAS unsigned* st) {
    XcdBarrier b; b.bar = bar; b.x = xb_xcc_id(); b.st = st;
    if (threadIdx.x == 0) (void)xb_add(&bar[XB_XCNT(b.x)], 1u);
    return b;
}
__device__ __forceinline__ void xcd_barrier_complete(unsigned* bar, unsigned x, unsigned& nloc, unsigned& nx) {
    const unsigned G = gridDim.x * gridDim.y * gridDim.z;
    unsigned sum, cnt, mine, sp = 0u;
    for (;;) {
        sum = 0u; cnt = 0u; mine = 0u;
#pragma unroll
        for (unsigned j = 0; j < 16; ++j) { const unsigned c = xb_ld(&bar[XB_XCNT(j)]); sum += c; cnt += (c > 0u) ? 1u : 0u; mine = (j == x) ? c : mine; }
        if (sum == G) break;
        __builtin_amdgcn_s_sleep(1);
        if ((++sp & 255u) == 0u) { if (xb_ld(&bar[XB_TMO])) break; if (sp > XB_SPIN_CAP) { atomicAdd(&bar[XB_TMO], 1u); break; } }
    }
    nloc = mine > 0u ? mine : 1u; nx = cnt > 0u ? cnt : 1u;
}

__device__ __forceinline__ void xcd_barrier(const XcdBarrier& b, const int wave_s) {
    asm volatile("s_waitcnt vmcnt(0)" ::: "memory");
    __syncthreads();
    if (wave_s == 0 && lane_id() == 0) {
        int z0_ = 0; asm volatile("" : "+s"(z0_));
        unsigned* bar = b.bar + z0_;
        __builtin_amdgcn_s_waitcnt(0);
        unsigned nloc = b.st[0], nx = b.st[1];
        if (nloc == 0u) { xcd_barrier_complete(bar, b.x, nloc, nx); b.st[0] = nloc; b.st[1] = nx; }
        const unsigned old = xb_add(&bar[XB_XSUB(b.x)], 1u);
        const unsigned gen = old / nloc;
        if (old + 1u == (gen + 1u) * nloc) {
            __builtin_amdgcn_fence(__ATOMIC_RELEASE, "agent");
            asm volatile("s_waitcnt vmcnt(0)" ::: "memory");
            const unsigned og = xb_add(&bar[XB_TOP], 1u);
            const unsigned tg = og / nx;
            if (og + 1u == (tg + 1u) * nx) xb_add(&bar[XB_TOPGEN], 1u);
            else XB_SPIN(xb_ld(&bar[XB_TOPGEN]) == tg, bar);
            __builtin_amdgcn_fence(__ATOMIC_ACQUIRE, "agent");
            xb_add(&bar[XB_XGEN(b.x)], 1u);
            asm volatile("s_waitcnt vmcnt(0)" ::: "memory");
        } else {
            XB_SPIN(xb_ld(&bar[XB_XGEN(b.x)]) == gen, bar);
            __builtin_amdgcn_fence(__ATOMIC_ACQUIRE, "agent");
            asm volatile("s_waitcnt vmcnt(0)" ::: "memory");
        }
    }
    __syncthreads();
}

constexpr int NWAVES = 8;
constexpr int RING_BYTES = 131072;
constexpr int LDS_BYTES = 163840;
constexpr int LDSCTL_OFF = LDS_BYTES - 1024, MISC_OFF = LDSCTL_OFF + 320;
constexpr int HALO_OFF = RING_BYTES;
constexpr int RSTD_OFF = HALO_OFF + 8192;
static_assert(RSTD_OFF + 6 * 1024 + 4096 <= LDSCTL_OFF, "LDS map");
constexpr int CW_BAR = 4096;

struct Args { const float* in[24]; float* out; unsigned char* ws; };

template <bool AF32, class F>
__device__ __forceinline__ void meta_gemm(const void* A, int lda, const bf16_t* Wt, int N, int K, int bid, int G, int wave, int lane, float* red, const F& f) {
    const int fr = lane & 15, fq = lane >> 4, kw = K / NWAVES;
    for (int cb = bid; cb < N / 16; cb += G) {
        f32x4 acc = (f32x4){0.f, 0.f, 0.f, 0.f}; float ss = 0.f;
        const bf16_t* bp = Wt + (size_t)(cb * 16 + fr) * K + wave * kw + 8 * fq;
#pragma unroll
        for (int k = 0; k < kw; k += 32) {
            bf16x8 a;
            if (AF32) {
                const float* ap = (const float*)A + (size_t)fr * lda + wave * kw + k + 8 * fq;
                const f32x4 a0 = *(const f32x4*)ap, a1 = *(const f32x4*)(ap + 4);
                ss += ((a0.x * a0.x + a0.y * a0.y) + (a0.z * a0.z + a0.w * a0.w)) + ((a1.x * a1.x + a1.y * a1.y) + (a1.z * a1.z + a1.w * a1.w));
                u32x4 w; w.x = pk2bf(a0.x, a0.y); w.y = pk2bf(a0.z, a0.w); w.z = pk2bf(a1.x, a1.y); w.w = pk2bf(a1.z, a1.w);
                a = __builtin_bit_cast(bf16x8, w);
            } else a = *(const bf16x8*)((const bf16_t*)A + (size_t)fr * lda + wave * kw + k + 8 * fq);
            const bf16x8 b = *(const bf16x8*)(bp + k);
            acc = __builtin_amdgcn_mfma_f32_16x16x32_bf16(a, b, acc, 0, 0, 0);
        }
        float* rw = red + (wave * 64 + lane) * 5;
        rw[0] = acc[0]; rw[1] = acc[1]; rw[2] = acc[2]; rw[3] = acc[3]; rw[4] = ss;
        __syncthreads();
        if (wave == 0) {
            f32x4 t = (f32x4){0.f, 0.f, 0.f, 0.f}; float s2 = 0.f;
#pragma unroll
            for (int w = 0; w < NWAVES; ++w) { const float* r_ = red + (w * 64 + lane) * 5; t[0] += r_[0]; t[1] += r_[1]; t[2] += r_[2]; t[3] += r_[3]; s2 += r_[4]; }
            float rstd = 1.f;
            if (AF32) { s2 = add_xor16(s2); s2 = add_xor32(s2); rstd = 1.0f / sqrtf(s2 * (1.f / DM) + 1e-6f); }
#pragma unroll
            for (int r = 0; r < 4; ++r) { const int row = 4 * fq + r; const float rs = AF32 ? __int_as_float(__builtin_amdgcn_ds_bpermute(row << 2, __float_as_int(rstd))) : 1.f; f(row, cb * 16 + fr, t[r] * rs); }
        }
        __syncthreads();
    }
}
struct MEpi1 { bf16_t* p; float* pn;
    __device__ __forceinline__ void operator()(int r, int col, float v) const {
        const int row = MROWS + r; const int g = col >> 9, c_ = col & 255;
        if (g < 7) p[(size_t)row * PBW + (col & ~255) + ((c_ >> 5) & 3) * 64 + (c_ >> 7) * 32 + PERM32(c_ & 31)] = f2bf(v);
        else { const int o = col & 511; if (o < 296) pn[(size_t)row * PNW + o] = v; } } };
struct MEpiRes { float* hm; __device__ __forceinline__ void operator()(int r, int col, float v) const { float* h = hm + r * DM + (col & ~31) + PERM32(col & 31); *h = *h + v; } };
struct MEpi3 { float* rawm;
    __device__ __forceinline__ void operator()(int r, int col, float v) const { const int t = col >> 8, c = col & 255; rawm[(size_t)r * DFF2 + (c < 128 ? 128 * t + c : DFF + 128 * t + (c - 128))] = v; } };

__device__ __forceinline__ void meta_gemm3(const float* hm, const bf16_t* W3, int bid, int G, int wave, int lane, int tid, float* red, float* rug, const float* cw, const float* cb, float* rawm, bf16_t* am) {
    const int fr = lane & 15, fq = lane >> 4; constexpr int kw = DM / NWAVES;
    const int pb0 = G == 256 ? 128 : 0, pst = G == 256 ? 128 : G;
    for (int pr = bid - pb0; pr >= 0 && pr < DFF / 16; pr += pst) {
        const int t = pr >> 3, kk = pr & 7, cbu = 16 * t + kk;
        f32x4 au = (f32x4){0.f, 0.f, 0.f, 0.f}, ag = au; float ss = 0.f;
        const bf16_t* bpu = W3 + (size_t)(cbu * 16 + fr) * DM + wave * kw + 8 * fq; const bf16_t* bpg = bpu + (size_t)128 * DM;
#pragma unroll
        for (int k = 0; k < kw; k += 32) {
            const float* ap = hm + (size_t)fr * DM + wave * kw + k + 8 * fq;
            const f32x4 a0 = *(const f32x4*)ap, a1 = *(const f32x4*)(ap + 4);
            ss += ((a0.x * a0.x + a0.y * a0.y) + (a0.z * a0.z + a0.w * a0.w)) + ((a1.x * a1.x + a1.y * a1.y) + (a1.z * a1.z + a1.w * a1.w));
            u32x4 w; w.x = pk2bf(a0.x, a0.y); w.y = pk2bf(a0.z, a0.w); w.z = pk2bf(a1.x, a1.y); w.w = pk2bf(a1.z, a1.w);
            const bf16x8 a = __builtin_bit_cast(bf16x8, w);
            au = __builtin_amdgcn_mfma_f32_16x16x32_bf16(a, *(const bf16x8*)(bpu + k), au, 0, 0, 0);
            ag = __builtin_amdgcn_mfma_f32_16x16x32_bf16(a, *(const bf16x8*)(bpg + k), ag, 0, 0, 0);
        }
        float* rw = red + (wave * 64 + lane) * 9;
        rw[0] = au[0]; rw[1] = au[1]; rw[2] = au[2]; rw[3] = au[3]; rw[4] = ag[0]; rw[5] = ag[1]; rw[6] = ag[2]; rw[7] = ag[3]; rw[8] = ss;
        __syncthreads();
        if (wave == 0) {
            f32x4 tu = (f32x4){0.f, 0.f, 0.f, 0.f}, tg = tu; float s2 = 0.f;
#pragma unroll
            for (int w = 0; w < NWAVES; ++w) { const float* r_ = red + (w * 64 + lane) * 9; tu[0] += r_[0]; tu[1] += r_[1]; tu[2] += r_[2]; tu[3] += r_[3]; tg[0] += r_[4]; tg[1] += r_[5]; tg[2] += r_[6]; tg[3] += r_[7]; s2 += r_[8]; }
            s2 = add_xor16(s2); s2 = add_xor32(s2); const float rstd = 1.0f / sqrtf(s2 * (1.f / DM) + 1e-6f);
#pragma unroll
            for (int r = 0; r < 4; ++r) { const int row = 4 * fq + r; const float rs = __int_as_float(__builtin_amdgcn_ds_bpermute(row << 2, __float_as_int(rstd)));
                const float vu = tu[r] * rs, vg = tg[r] * rs; rug[row * 16 + fr] = vu; rug[256 + row * 16 + fr] = vg;
                if (row >= 14) { rawm[(size_t)row * DFF2 + 128 * t + 16 * kk + fr] = vu; rawm[(size_t)row * DFF2 + DFF + 128 * t + 16 * kk + fr] = vg; } }
        }
        __syncthreads();
        if (tid < 256) {
            const int row = tid >> 4, j = tid & 15, ch = 128 * t + 16 * kk + j;
            const float xu0 = rug[row * 16 + j], xu1 = row >= 1 ? rug[(row - 1) * 16 + j] : 0.f, xu2 = row >= 2 ? rug[(row - 2) * 16 + j] : 0.f;
            const float xg0 = rug[256 + row * 16 + j], xg1 = row >= 1 ? rug[256 + (row - 1) * 16 + j] : 0.f, xg2 = row >= 2 ? rug[256 + (row - 2) * 16 + j] : 0.f;
            const float cu = cb[ch] + cw[ch] * xu2 + cw[DFF2 + ch] * xu1 + cw[2 * DFF2 + ch] * xu0;
            const float cg = cb[DFF + ch] + cw[DFF + ch] * xg2 + cw[DFF2 + DFF + ch] * xg1 + cw[2 * DFF2 + DFF + ch] * xg0;
            am[(size_t)row * DFF + ch] = f2bf(cg * sigmoidf_(cg) * cu);
        }
        __syncthreads();
    }
}

__device__ __forceinline__ void wprep_layer(const float* const* in, int l, unsigned char* ws, int gw, int ngw, int lane, float* scr, int part) {
    unsigned char* wb = ws + WS_W + (size_t)(l & 1) * WL_BYTES;
    constexpr int I1 = (DM / 64) * (N1 / 32), I2 = (DM / 64) * (DM / 32), I3 = (DM / 64) * (DFF2 / 32), I4 = (DFF / 64) * (DM / 32);
    const int n1 = (part & 1) ? I1 : 0, n2 = (part & 2) ? I2 : 0, n3 = (part & 4) ? I3 : 0, n4 = (part & 8) ? I4 : 0;
    for (int it = gw; it < n1 + n2 + n3 + n4; it += ngw) {
        int r = it, mode = 1, K = DM, Nsrc = N_IN, Ndst = N1; const float* W = in[3] + (size_t)l * DM * N_IN; const float* gk = in[2] + l * DM; bf16_t* WT = (bf16_t*)(wb + WO_W1);
        if (r >= n1) { r -= n1; mode = 2; Nsrc = DM; Ndst = DM; W = in[18] + (size_t)l * DM * DM; gk = nullptr; WT = (bf16_t*)(wb + WO_W2);
            if (r >= n2) { r -= n2; mode = 3; Nsrc = DFF2; Ndst = DFF2; W = in[20] + (size_t)l * DM * DFF2; gk = in[19] + l * DM; WT = (bf16_t*)(wb + WO_W3);
                if (r >= n3) { r -= n3; mode = 4; K = DFF; Nsrc = DM; Ndst = DM; W = in[23] + (size_t)l * DFF * DM; gk = nullptr; WT = (bf16_t*)(wb + WO_W4); } } }
        wprep_item(W, gk, WT, K, Nsrc, Ndst, mode, r, scr, lane);
    }
    if (part & 1) {
        bf16_t* lup = (bf16_t*)(wb + WO_LUP);
        const float* wu = in[6] + (size_t)l * 64 * 512; const float* au = in[8] + (size_t)l * 64 * 512; const float* gu = in[9] + (size_t)l * 160 * 512;
        for (int n = gw; n < 512; n += ngw) {
#pragma unroll
            for (int kq = 0; kq < 5; ++kq) { const int k = lane + 64 * kq;
                if (k < 288) lup[n * 288 + k] = f2bf(k < 64 ? wu[k * 512 + n] : (k < 128 ? au[(k - 64) * 512 + n] : gu[(k - 128) * 512 + n])); }
        }
    }
}

struct RwP { const float* mu; const float* w0; const float* w_up; const float* a0; const float* a_up; const float* g_up; };
struct RwS { const float* mu; const float* k_k; const float* k_a; const float* r_k; const float* gn_w; const float* gn_b; };
constexpr int RCH = 8;

__global__ void __launch_bounds__(NWAVES * 64, 2) mk_fwd(Args a) {
    extern __shared__ __attribute__((aligned(16))) unsigned char lds[];
    const int tid0 = threadIdx.x, wave_s = __builtin_amdgcn_readfirstlane(tid0 >> 6);
    const int G0 = gridDim.x, bid0 = blockIdx.x;
    for (int u = tid0; u < (LDS_BYTES - LDSCTL_OFF) / 4; u += NWAVES * 64) ((LAS unsigned*)((LAS unsigned char*)lds + LDSCTL_OFF))[u] = 0u;
    __syncthreads();
    XcdBarrier bar = xcd_barrier_post((unsigned*)(a.ws + WS_CTL) + CW_BAR, (volatile LAS unsigned*)((LAS unsigned char*)lds + MISC_OFF) + 8);
#ifdef TPROBE
#define TP_MARK(ph) do { if ((ph) >= 20 && TPROBE < 20) break;     \
        const unsigned t_ = (unsigned)__builtin_amdgcn_s_memrealtime(); if (wave_s == 0 && lane_id() == 0) { volatile LAS unsigned* q_ = (volatile LAS unsigned*)((LAS unsigned char*)lds + LDSCTL_OFF + 512); \
        if ((ph) == TPROBE) q_[1] += t_ - q_[0]; q_[0] = t_; } } while (0)
#else
#define TP_MARK(ph) do {} while (0)
#endif
#define GRID_BAR() do { int wv_ = wave_s; asm volatile("" : "+s"(wv_)); xcd_barrier(bar, wv_); } while (0)
#define RSTD_TABLE(S) do { pg8::Unit u0_, u_; if (S.next(0, u0_)) { float rv_ = 0.f; if (tid < 256) rv_ = pg8::row_rstd(ssqp, u0_.pm * 256 + tid); \
        for (int i_ = 0; S.next(i_, u_); ++i_) if (tid < 256) ((LAS float*)(ldsl + RSTD_OFF))[i_ * 256 + tid] = u_.pm == u0_.pm ? rv_ : pg8::row_rstd(ssqp, u_.pm * 256 + tid); } \
        __syncthreads(); } while (0)
    TP_MARK(-1);
#define PHASE_IDS() int G_ = G0, bid_ = bid0, wv_ = wave_s; asm volatile("" : "+s"(G_), "+s"(bid_), "+s"(wv_)); int tid = wv_ * 64 + lane_id(); asm volatile("" : "+v"(tid)); \
    const int G = G_, bid = bid_, ngw = G * NWAVES, lane = tid & 63, wave = wv_, gw = bid * NWAVES + wave; (void)lane; (void)gw; (void)ngw
#define PHASE_PTRS(L) int z0_ = 0; asm volatile("" : "+s"(z0_)); const float* const* inq = a.in + z0_; unsigned char* ws = a.ws + z0_; float* out = a.out + z0_; const int lq = (L) + z0_; \
    float* hm = (float*)(ws + WS_HM); float* c2 = (float*)(ws + WS_C2); float* ssqp = (float*)(ws + WS_SSQ); \
    bf16_t* hb = (bf16_t*)(ws + WS_HB); bf16_t* p = (bf16_t*)(ws + WS_P); float* pn = (float*)(ws + WS_PN); bf16_t* y = (bf16_t*)(ws + WS_Y); \
    bf16_t* act = (bf16_t*)(ws + WS_ACT); float* fixb = (float*)(ws + WS_FIX); float* rawm = (float*)(ws + WS_RAWM); \
    const unsigned char* wbuf = ws + WS_W + (size_t)(lq & 1) * WL_BYTES; \
    const bf16_t* W1 = (const bf16_t*)(wbuf + WO_W1); const bf16_t* W2 = (const bf16_t*)(wbuf + WO_W2); const bf16_t* W3 = (const bf16_t*)(wbuf + WO_W3); const bf16_t* W4 = (const bf16_t*)(wbuf + WO_W4); \
    (void)hm; (void)c2; (void)ssqp; (void)hb; (void)p; (void)pn; (void)y; (void)act; (void)fixb; (void)rawm; (void)out; (void)W1; (void)W2; (void)W3; (void)W4
    LAS unsigned char* ldsl = (LAS unsigned char*)lds;

    {
        PHASE_IDS(); PHASE_PTRS(0);
        for (int row = gw; row < RROWS; row += ngw) {
            const f32x4* xr = (const f32x4*)(row < MROWS ? inq[0] + (size_t)row * DM : inq[1] + (size_t)(row - MROWS) * DM) + lane;
            f32x4* hr = (f32x4*)(hm + (size_t)(row < MROWS ? 0 : row - MROWS) * DM) + lane;
            f32x4 v[4]; float s = 0.f;
#pragma unroll
            for (int j = 0; j < 4; ++j) { v[j] = xr[64 * j]; if (row >= MROWS) hr[64 * j] = v[j]; s += (v[j].x * v[j].x + v[j].y * v[j].y) + (v[j].z * v[j].z + v[j].w * v[j].w); }
            s = wave_sum(s);
            if (lane < 16) ssqp[(size_t)row * 16 + lane] = lane == 0 ? s : 0.f;
            u32x2* o8 = (u32x2*)(hb + (size_t)row * DM) + lane;
#pragma unroll
            for (int j = 0; j < 4; ++j) { u32x2 w; w.x = pk2bf(v[j].x, v[j].y); w.y = pk2bf(v[j].z, v[j].w); o8[64 * j] = w; }
        }
    }
    {
        PHASE_IDS(); PHASE_PTRS(0);
        u32x4* z = (u32x4*)(p + (size_t)RROWS * PBW); const unsigned n16 = (unsigned)((16512 - RROWS) * PBW * 2 / 16);
        for (unsigned i = (unsigned)(bid * (NWAVES * 64) + tid); i < n16; i += (unsigned)(G * (NWAVES * 64))) z[i] = (u32x4){0u, 0u, 0u, 0u};
    }
#ifndef PLAIN_LAUNCH
    cg::this_grid().sync();
#endif
    TP_MARK(0);

#pragma unroll 1
    for (int l = -1; l < DEPTH; ++l) {
#pragma unroll 1
      for (int ph = l < 0 ? 1 : 0; ph < (l < 0 ? 2 : 6); ++ph) {
#ifdef TPROBE
        if (wave_s == 0 && lane_id() == 0) ((volatile LAS unsigned*)((LAS unsigned char*)lds + LDSCTL_OFF + 512))[2] = (unsigned)ph;
#endif
        if (ph == 1 || ph == 4)
        {
            PHASE_IDS(); PHASE_PTRS(l);
            if (lq + 1 < DEPTH) {
                const int first = (G == 256 && lq >= 0) ? (ph == 4 ? 128 : 8) : 0, part = lq < 0 ? 15 : (G == 256 ? (ph == 4 ? 6 : 9) : (ph == 4 ? 0 : 15));
                if (bid >= first && part) wprep_layer(inq, lq + 1, ws, gw - first * NWAVES, ngw - first * NWAVES, lane, (float*)(lds + wave * 16384), part);
            }
            __syncthreads();
        }
        if (ph == 0) {
        {
            PHASE_IDS(); PHASE_PTRS(l);
            pg8::Gemm g{hb, W1, MROWS, N1, DM}; pg8::StaticOrder S; S.init(MROWS, N1, G, bid);
            RSTD_TABLE(S);
            pg8::Epi1 E{(const LAS float*)(ldsl + RSTD_OFF), p, pn, inq[16] + lq * 64, inq[17] + lq * 64};
            pg8::gemm_phase<pg8::Epi1, pg8::StaticOrder, true, true>(ldsl, g, S, E, wave);
            meta_gemm<true>(hm, DM, W1, N1, DM, bid, G, wave, lane, (float*)lds, MEpi1{p, pn});
        }
        } else if (ph == 4) {
        {
            PHASE_IDS(); PHASE_PTRS(l);
            const float* cw = inq[21] + (size_t)lq * 3 * DFF2; const float* cb = inq[22] + (size_t)lq * DFF2;
            pg8::Gemm g{hb, W3, MROWS, DFF2, DM}; pg8::StaticOrder S; S.init(MROWS, DFF2, G, bid);
            RSTD_TABLE(S);
            pg8::EpiConv E{(const LAS float*)(ldsl + RSTD_OFF), cw, cb, act, fixb, ldsl + HALO_OFF, (LAS float*)(ldsl + RSTD_OFF + 6 * 1024)};
            pg8::gemm_phase<pg8::EpiConv, pg8::StaticOrder, true, true>(ldsl, g, S, E, wave);
            meta_gemm3(hm, W3, bid, G, wave, lane, tid, (float*)lds, (float*)(lds + 20480), cw, cb, rawm, act + (size_t)MROWS * DFF);
        }
        }
        if (ph == 1 && l >= 0) {
        {
            PHASE_IDS(); PHASE_PTRS(l);
            __syncthreads(); TP_MARK(20);
            {
                const float* mu = inq[4] + lq * 1824;
                const bf16_t* lup = (const bf16_t*)(wbuf + WO_LUP);
                const int h = wave, cg = h * 64 + lane, fr = lane & 15, fq = lane >> 4;
                const float mu_r = mu[cg], mu_k = mu[512 + cg], mu_v = mu[1024 + cg];
                const float w0c = (inq[5] + lq * 512)[cg], a0c = (inq[7] + lq * 512)[cg];
                const float kkc = (inq[10] + lq * 512)[cg], kac = (inq[11] + lq * 512)[cg], rkc = (inq[12] + lq * 512)[cg];
                LAS unsigned char* PNS = ldsl;
                LAS unsigned char* PSW = ldsl + 22528 + wave * 6528;
                LAS unsigned char* LW = ldsl + 74752 + wave * 9216;
                LAS unsigned char* LIN = ldsl + 148480;
                LAS float* MU = (LAS float*)(ldsl + 158720);
                LAS float* TR = (LAS float*)LW; LAS float* LT = (LAS float*)LW; LAS float* LAK = (LAS float*)(LW + 1280);
#define PN_DMA(uu) do { const int c_ = (uu) % NCH, r0_ = rowof((uu) / NCH, 16 * c_), p0_ = prevrow(r0_); \
                    for (int pc_ = wave; pc_ < (p0_ >= 0 ? 22 : 20); pc_ += NWAVES) { \
                        const char* src_ = (pc_ < 20 ? (const char*)(pn + (size_t)r0_ * PNW) + pc_ * 1024 : (const char*)(pn + (size_t)p0_ * PNW) + (pc_ - 20) * 1024) + lane * 16; \
                        __builtin_amdgcn_global_load_lds((const unsigned*)src_, (LAS unsigned*)(PNS + pc_ * 1024), 16, 0, 0); } } while (0)
#define PS_DMA(uu) do { const int c_ = (uu) % NCH, r0_ = rowof((uu) / NCH, 16 * c_), p0_ = prevrow(r0_); int ln_ = lane; asm volatile("" : "+v"(ln_));     \
                    _Pragma("unroll") for (int j_ = 0; j_ < 7; ++j_) { const int s_ = j_ * 8 + (ln_ >> 3); \
                        if (s_ < 51) { const int i_ = s_ / 3, sg_ = s_ - 3 * i_, rw_ = i_ ? r0_ + i_ - 1 : (p0_ >= 0 ? p0_ : r0_); \
                            const char* src_ = (const char*)(p + (size_t)rw_ * PBW) + sg_ * 1024 + wave * 128 + (ln_ & 7) * 16; \
                            __builtin_amdgcn_global_load_lds((const unsigned*)src_, (LAS unsigned*)(PSW + j_ * 1024), 16, 0, 0); } } } while (0)
#define PSV(i, sg) bf2f(((const LAS bf16_t*)PSW)[(3 * (i) + (sg)) * 64 + lane])
                if (tid < 288) MU[tid] = mu[1536 + tid];
                if (bid < NB * NCH) { PN_DMA(bid); PS_DMA(bid); }
                asm volatile("s_waitcnt vmcnt(0)" ::: "memory");
                bf16x8 bw_[2][4], ba_[2][4];
                {   const int fru = lane & 15, fqu = lane >> 4;
#pragma unroll
                    for (int nb = 0; nb < 4; ++nb) { const bf16_t* bp_ = lup + (size_t)(h * 64 + 16 * nb + fru) * 288 + 8 * fqu;
#pragma unroll
                        for (int ks = 0; ks < 2; ++ks) { bw_[ks][nb] = *(const bf16x8*)(bp_ + 32 * ks); ba_[ks][nb] = *(const bf16x8*)(bp_ + 64 + 32 * ks); }
                    } }
                for (int u = bid; u < NB * NCH; u += G) {
                    const int b = u / NCH, c = u % NCH, row0 = rowof(b, 16 * c), prow0 = prevrow(row0);
                    int tidu = tid; asm volatile("" : "+v"(tidu));
                    const int fr = tidu & 15, fq = (tidu >> 4) & 3;
                    bf16x8 bg_[5][4];
                    TP_MARK(27);
                    asm volatile("s_waitcnt lgkmcnt(0)\n\ts_barrier" ::: "memory");
                    {
                        float cur_[9], prv_[9], mu_[9];
#pragma unroll
                        for (int i = 0; i < 9; ++i) { const int e = tidu + 512 * i, ti = e / 288, j = e - 288 * ti;
                            cur_[i] = ((const LAS float*)PNS)[ti * 320 + j]; prv_[i] = ((const LAS float*)PNS)[(ti ? ti - 1 : 16) * 320 + j]; mu_[i] = MU[j]; }
#pragma unroll
                        for (int i = 0; i < 9; ++i) { const int e = tidu + 512 * i, ti = e / 288, j = e - 288 * ti;
                            const float prv = (ti || prow0 >= 0) ? prv_[i] : 0.f, s = cur_[i] + mu_[i] * (prv - cur_[i]);
                            const float ex = __builtin_amdgcn_exp2f((j < 64 ? 2.f * LOG2E : -LOG2E) * s), rc = __builtin_amdgcn_rcpf(1.f + ex);
                            ((LAS bf16_t*)LIN)[ti * 296 + j] = f2bf(j < 64 ? 1.f - 2.f * rc : (j < 128 ? s : rc)); }
                    }
                    {   const int fru = fr, fqu = fq;
#pragma unroll
                        for (int nb = 0; nb < 4; ++nb) { const bf16_t* bp_ = lup + (size_t)(h * 64 + 16 * nb + fru) * 288 + 8 * fqu;
#pragma unroll
                            for (int ks = 0; ks < 5; ++ks) bg_[ks][nb] = *(const bf16x8*)(bp_ + 128 + 32 * ks); } }
                    TP_MARK(28);
                    asm volatile("s_waitcnt lgkmcnt(0)\n\ts_barrier" ::: "memory");
                    if (u + G < NB * NCH) PN_DMA(u + G);
                    TP_MARK(22);
#define LORA_PRE(ZA, KB0, NKS, BF) do { f32x4 acc_[4]; _Pragma("unroll") for (int nb = 0; nb < 4; ++nb) acc_[nb] = (f32x4){0.f, 0.f, 0.f, 0.f}; \
                        _Pragma("unroll") for (int ks = 0; ks < (NKS); ++ks) { const bf16x8 af = *(const LAS bf16x8*)(LIN + fr * 592 + ((KB0) + 32 * ks + 8 * fq) * 2); \
                            _Pragma("unroll") for (int nb = 0; nb < 4; ++nb) acc_[nb] = __builtin_amdgcn_mfma_f32_16x16x32_bf16(af, BF[ks][nb], acc_[nb], 0, 0, 0); } \
                        WAVE_LDS_SYNC(); \
                        _Pragma("unroll") for (int nb = 0; nb < 4; ++nb) _Pragma("unroll") for (int r = 0; r < 4; ++r) TR[(4 * fq + r) * 65 + 16 * nb + fr] = acc_[nb][r]; \
                        WAVE_LDS_SYNC(); \
                        _Pragma("unroll") for (int i = 0; i < 16; ++i) ZA[i] = TR[i * 65 + lane]; } while (0)
                    float zw[16], za[16];
                    LORA_PRE(zw, 0, 2, bw_); LORA_PRE(za, 64, 2, ba_);
                    {
                        float zg[16]; LORA_PRE(zg, 128, 5, bg_); (void)zg;
                        asm volatile("s_waitcnt vmcnt(0)" ::: "memory");
                        {
                            const int ti_ = lane >> 2, pt_ = lane & 3; float gv_[16];
#pragma unroll
                            for (int k_ = 0; k_ < 16; ++k_) gv_[k_] = TR[ti_ * 65 + 16 * pt_ + k_];
                            u32x4 o0_, o1_;
                            o0_.x = pk2bf(gv_[0], gv_[1]); o0_.y = pk2bf(gv_[2], gv_[3]); o0_.z = pk2bf(gv_[4], gv_[5]); o0_.w = pk2bf(gv_[6], gv_[7]);
                            o1_.x = pk2bf(gv_[8], gv_[9]); o1_.y = pk2bf(gv_[10], gv_[11]); o1_.z = pk2bf(gv_[12], gv_[13]); o1_.w = pk2bf(gv_[14], gv_[15]);
                            bf16_t* yp_ = y + (size_t)(row0 + ti_) * DM + h * 64 + 16 * pt_;
                            *(u32x4*)yp_ = o0_; *(u32x4*)(yp_ + 8) = o1_; } }
#undef LORA_PRE
                    WAVE_LDS_SYNC();
                    const int ci = (b * 8 + h) * NCH + c;
                    unsigned char* ra = ws + WS_RA + (size_t)ci * RA_BYTES; unsigned char* rb = (unsigned char*)out + (size_t)ci * RB_BYTES;
                    bf16_t* BV = (bf16_t*)(ws + WS_BV);
                    LAS bf16_t* OA = (LAS bf16_t*)LW; LAS bf16_t* OB = OA + 16 * 72; LAS bf16_t* OK = OB + 16 * 72; LAS bf16_t* OR = OK + 16 * 72;
                    const int cxk = (lane >> 5) * 4 + ((lane >> 2) & 3), jk2 = (((lane >> 4) & 1) * 4 + (lane & 3)) * 2;
                    TP_MARK(23);
                    float atil[16]; unsigned bkB[8], bkK[8], vtp[8];
                    float cumC = 0.f;
#pragma unroll
                    for (int i = 0; i < 16; ++i) { zw[i] = 0.6065306597126334f * __builtin_amdgcn_rcpf(1.f + __builtin_amdgcn_exp2f(-LOG2E * (zw[i] + w0c))); cumC += zw[i]; }
                    float cum = 0.f, gprev = 1.f, rp = 0.f, kp_ = 0.f, vp = 0.f, be = 0.f, ke = 0.f, ve = 0.f, bve = 0.f; unsigned bvp[8];
                    unsigned short prr[17], pkk[17], pvv[17];
#pragma unroll
                    for (int i = 0; i < 17; ++i) { prr[i] = ((const LAS bf16_t*)PSW)[(3 * i) * 64 + lane]; pkk[i] = ((const LAS bf16_t*)PSW)[(3 * i + 1) * 64 + lane]; pvv[i] = ((const LAS bf16_t*)PSW)[(3 * i + 2) * 64 + lane]; }
                    WAVE_LDS_SYNC();
                    if (u + G < NB * NCH) PS_DMA(u + G);
                    rp = bf2f(prr[0]); kp_ = bf2f(pkk[0]); vp = bf2f(pvv[0]);
                    const float hp0 = prow0 >= 0 ? 1.f : 0.f;
#pragma unroll
                    for (int i0 = 0; i0 < 16; i0 += 4) {
                        float rs4[4], vs4[4], alr4[4], kkr4[4], kpr4[4], red[8];
#pragma unroll
                        for (int j = 0; j < 4; ++j) { const int i = i0 + j;
                            const float rc = bf2f(prr[i + 1]), kc = bf2f(pkk[i + 1]), vc = bf2f(pvv[i + 1]);
                            const float hp = i ? 1.f : hp0;
                            const float rs = rc + mu_r * (hp * rp - rc), ks_ = kc + mu_k * (hp * kp_ - kc), vs = vc + mu_v * (hp * vp - vc);
                            rp = rc; kp_ = kc; vp = vc;
                            const float alr = __builtin_amdgcn_rcpf(1.f + __builtin_amdgcn_exp2f(-LOG2E * (za[i] + a0c)));
                            const float kkr = ks_ * kkc, kpr = ks_ * (1.f + (alr - 1.f) * kac);
                            rs4[j] = rs; vs4[j] = vs; alr4[j] = alr; kkr4[j] = kkr; kpr4[j] = kpr; red[2 * j] = kkr * kkr; red[2 * j + 1] = rs * kpr * rkc; }
                        wave_sum_dpp8(red);
#pragma unroll
                        for (int j = 0; j < 4; ++j) { const int i = i0 + j;
                            cum += zw[i];
                            const float kk = kkr4[j] * __builtin_amdgcn_rsqf(fmaxf(red[2 * j], 1e-24f)), bon = red[2 * j + 1], kpr = kpr4[j], vs = vs4[j];
                            const float eg = __builtin_amdgcn_exp2f(LOG2E * cum), gi = __builtin_amdgcn_exp2f(-LOG2E * cum), tail = __builtin_amdgcn_exp2f(LOG2E * (cum - cumC));
                            atil[i] = -kk * gprev;
                            const float bb = kk * alr4[j], rtil = rs4[j] * gi; gprev = gi;
                            OA[i * 72 + lane] = f2bf(atil[i]); OB[i * 72 + lane] = f2bf(bb * eg); OK[i * 72 + lane] = f2bf(kpr * eg); OR[i * 72 + lane] = f2bf(rtil);
                            if (i & 1) { bkB[i >> 1] = pk2bf(be, bb * tail); bkK[i >> 1] = pk2bf(ke, kpr * tail); vtp[i >> 1] = pk2bf(ve, vs); } else { be = bb * tail; ke = kpr * tail; ve = vs; }
                            if (i & 1) bvp[i >> 1] = pk2bf(bve, bon * vs); else bve = bon * vs; }
                    }
                    {
                        ((float*)(rb + 3584))[lane] = gprev;
#pragma unroll
                        for (int q = 0; q < 4; ++q) *(u32x4*)(ra + 4096 + lane * 64 + ((q ^ SWZ4(lane)) << 4)) = (u32x4){bkB[2 * q], bkB[2 * q + 1], bkK[2 * q], bkK[2 * q + 1]};
                        *(u32x4*)(rb + lane * 32) = (u32x4){vtp[0], vtp[1], vtp[2], vtp[3]}; *(u32x4*)(rb + lane * 32 + 16) = (u32x4){vtp[4], vtp[5], vtp[6], vtp[7]};
                    }
                    WAVE_LDS_SYNC();
                    TP_MARK(24);
#define REC_STORE(TILE, DST) do { _Pragma("unroll") for (int hh_ = 0; hh_ < 2; ++hh_) { const int i_ = (lane >> 3) + 8 * hh_, pc_ = lane & 7, c_ = pc_ ^ ((i_ >> 1) & 7), base_ = (c_ >> 2) * 32 + (c_ & 3) * 4; \
                        const u32x2 lo_ = *(const LAS u32x2*)((TILE) + i_ * 72 + base_), hi_ = *(const LAS u32x2*)((TILE) + i_ * 72 + base_ + 16); \
                        *(u32x4*)((DST) + i_ * 128 + pc_ * 16) = (u32x4){lo_.x, lo_.y, hi_.x, hi_.y}; } } while (0)
                    REC_STORE(OR, ra + 2048);
                    {
                        f32x4 dab = (f32x4){0.f, 0.f, 0.f, 0.f}, dak = dab, drb = dab, drk = dab;
#pragma unroll
                        for (int ks = 0; ks < 2; ++ks) {
                            const int off = fr * 72 + 32 * ks + 8 * fq;
                            const bf16x8 fa = *(const LAS bf16x8*)(OA + off), fb = *(const LAS bf16x8*)(OB + off), fk = *(const LAS bf16x8*)(OK + off), frr = *(const LAS bf16x8*)(OR + off);
                            dab = __builtin_amdgcn_mfma_f32_16x16x32_bf16(fa, fb, dab, 0, 0, 0); dak = __builtin_amdgcn_mfma_f32_16x16x32_bf16(fa, fk, dak, 0, 0, 0);
                            drb = __builtin_amdgcn_mfma_f32_16x16x32_bf16(frr, fb, drb, 0, 0, 0); drk = __builtin_amdgcn_mfma_f32_16x16x32_bf16(frr, fk, drk, 0, 0, 0);
                        }
#pragma unroll
                        for (int r = 0; r < 4; ++r) { const int i = 4 * fq + r, j = fr;
                            LT[i * 20 + j] = j < i ? dab[r] : 0.f; LAK[i * 16 + j] = j < i ? dak[r] : 0.f;
                            bf16_t* mp = (bf16_t*)(rb + 2048 + i * 64 + (((j >> 2) ^ SWZ4(i)) << 4)) + (j & 3);
                            mp[0] = f2bf(j <= i ? drb[r] : 0.f); mp[4] = f2bf(j <= i ? drk[r] : 0.f); }
                    }
                    WAVE_LDS_SYNC();
                    {
#pragma unroll
                        for (int k_ = 0; k_ < 8; ++k_) { OB[(2 * k_) * 72 + lane] = (bf16_t)(bvp[k_] & 0xffffu); OB[(2 * k_ + 1) * 72 + lane] = (bf16_t)(bvp[k_] >> 16); }
                        WAVE_LDS_SYNC();
                        const int ti_ = lane >> 2, pt_ = lane & 3;
                        const u32x4 b0_ = *(const LAS u32x4*)(OB + ti_ * 72 + 16 * pt_), b1_ = *(const LAS u32x4*)(OB + ti_ * 72 + 16 * pt_ + 8);
                        bf16_t* bp_ = BV + (size_t)(row0 + ti_) * 512 + h * 64 + 16 * pt_;
                        *(u32x4*)bp_ = b0_; *(u32x4*)(bp_ + 8) = b1_;
                    }
                    float tt[16];
#pragma unroll
                    for (int mm = 0; mm < 16; ++mm) tt[mm] = mm == fr ? 1.f : 0.f;
#pragma unroll
                    for (int j = 14; j >= 0; --j) { float val = 0.f;
#pragma unroll
                        for (int mm = j + 1; mm < 16; ++mm) val += tt[mm] * LT[mm * 20 + j];
                        tt[j] += val; }
                    WAVE_LDS_SYNC();
                    if (fq == 0) {
#pragma unroll
                        for (int mm = 0; mm < 16; ++mm) LT[fr * 20 + mm] = tt[mm]; }
                    {
                        f32x4 g4 = (f32x4){0.f, 0.f, 0.f, 0.f};
#pragma unroll
                        for (int mm = 0; mm < 16; ++mm) g4 += *(const LAS f32x4*)(LAK + mm * 16 + 4 * fq) * tt[mm];
                        u32x2 w; w.x = pk2bf(g4[0], g4[1]); w.y = pk2bf(g4[2], g4[3]);
                        *(u32x2*)(rb + 3072 + (fr * 16 + 4 * fq) * 2) = w;
                    }
                    WAVE_LDS_SYNC();
                    TP_MARK(25);
                    {
#pragma unroll
                        for (int i = 0; i < 16; ++i) { float acc = 0.f;
                            const f32x4 t0 = *(const LAS f32x4*)(LT + i * 20), t1 = *(const LAS f32x4*)(LT + i * 20 + 4), t2 = *(const LAS f32x4*)(LT + i * 20 + 8), t3 = *(const LAS f32x4*)(LT + i * 20 + 12);
                            const float trow[16] = {t0[0], t0[1], t0[2], t0[3], t1[0], t1[1], t1[2], t1[3], t2[0], t2[1], t2[2], t2[3], t3[0], t3[1], t3[2], t3[3]};
#pragma unroll
                            for (int mm = 0; mm <= i; ++mm) acc += trow[mm] * atil[mm];
                            OK[i * 72 + lane] = f2bf(acc); }
                        WAVE_LDS_SYNC();
                        REC_STORE(OK, ra);
                    }
#undef REC_STORE
                    TP_MARK(26);
                }
            }
            __syncthreads();
#undef PN_DMA
#undef PS_DMA
#undef PSV
            TP_MARK(29);
            TP_MARK(21);
            const float* q_g = inq[16] + lq * 64; const float* k_g = inq[17] + lq * 64; const float* b_f = inq[15] + lq * 8;
            for (int it = gw - (G >= 96 ? 80 * NWAVES : 0); it >= 0 && it < NMETA * NH; it += ngw) {
                const int row = MROWS + (it >> 3), h = it & 7;
                bf16_t* qp = p + (size_t)row * PBW + 1536 + h * 64 + lane; bf16_t* kp = p + (size_t)row * PBW + 2048 + h * 64 + lane;
                const float q = bf2f(*qp), k = bf2f(*kp);
                const float mq = wave_sum(q * q) * (1.f / 64.f), mk = wave_sum(k * k) * (1.f / 64.f);
                *qp = f2bf(q * (1.0f / sqrtf(mq + 1e-6f)) * q_g[lane] * (0.125f * LOG2E));
                *kp = f2bf(k * (1.0f / sqrtf(mk + 1e-6f)) * k_g[lane]);
            }
            for (int it = bid - (G >= 80 ? 16 : 0); it >= 0 && it < NB * NH; it += G) {
                constexpr int PER = 5;
                const int b = it >> 3, h = it & 7;
                float zv[PER], loc[PER], s = 0.f;
#pragma unroll
                for (int i = 0; i < PER; ++i) { const int t = tid * PER + i; zv[i] = pn[(size_t)rowof(b, t < LTOT ? t : LTOT - 1) * PNW + 288 + h]; }
#pragma unroll
                for (int i = 0; i < PER; ++i) { const int t = tid * PER + i;
                    const float v = t < LTOT ? -__builtin_amdgcn_logf(1.f + __builtin_amdgcn_exp2f(-LOG2E * (zv[i] + b_f[h]))) : 0.f;
                    s += v; loc[i] = s; }
                float incl = s;
#pragma unroll
                for (int o = 1; o < 64; o <<= 1) { const float n = __int_as_float(__builtin_amdgcn_ds_bpermute((lane - o) << 2, __float_as_int(incl))); if (lane >= o) incl += n; }
                float base = incl - s;
                if (lane == 63) ((LAS float*)ldsl)[wave] = incl;
                __syncthreads();
#pragma unroll
                for (int w = 0; w < NWAVES - 1; ++w) base += w < wave ? ((const LAS float*)ldsl)[w] : 0.f;
                float* cv = c2 + (size_t)it * 2176;
#pragma unroll
                for (int i = 0; i < PER; ++i) { const int t = tid * PER + i; if (t < LTOT) cv[t < NMETA ? t : t + 112] = base + loc[i]; }
                if (tid < 112) cv[16 + tid] = 1e5f;
                __syncthreads();
            }
        }
        } else if (ph == 2) {
        {
            PHASE_IDS(); PHASE_PTRS(l);
            typedef short s16x4 __attribute__((ext_vector_type(4)));
            constexpr int SLOTB = 12288, NSLOT = 10  , YB_OFF = NSLOT * SLOTB, YB_BYTES = 32 * 68 * 4, NSC = (NCH + 1) / 2;
            static_assert(YB_OFF + 2 * YB_BYTES <= LDSCTL_OFF, "scan LDS map");
#define RAW_BAR() asm volatile("s_waitcnt lgkmcnt(0)\n\ts_barrier" ::: "memory")
#define QXOR1(x) __int_as_float(__builtin_amdgcn_update_dpp(0, __float_as_int(x), 0xB1, 0xf, 0xf, false))
#define QXOR2(x) __int_as_float(__builtin_amdgcn_update_dpp(0, __float_as_int(x), 0x4E, 0xf, 0xf, false))
            for (int unit = bid; unit < 64; unit += G) {
                const int b = unit >> 3, h = unit & 7, fr = lane & 15, fq = lane >> 4;
                const unsigned char* RA0 = ws + WS_RA + (size_t)unit * NCH * RA_BYTES; const unsigned char* RB0 = (const unsigned char*)out + (size_t)unit * NCH * RB_BYTES;
                if (wave < 4) {
                    const int v = 16 * wave + fr;
                    f32x4 Z[4];
#pragma unroll
                    for (int kb = 0; kb < 4; ++kb) Z[kb] = (f32x4){0.f, 0.f, 0.f, 0.f};
                    const int o_ah0 = fr * 128 + (((fq) ^ ((fr >> 1) & 7)) << 4), o_ah1 = fr * 128 + (((4 + fq) ^ ((fr >> 1) & 7)) << 4);
                    const int o_bk = 4096 + fr * 64 + ((fq ^ SWZ4(fr)) << 4), o_mrk = 10240 + fr * 64 + ((fq ^ SWZ4(fr)) << 4);
                    const int o_vt = 8192 + v * 32 + fq * 8, o_g = 11264 + fr * 32 + fq * 8, o_gam = 11776 + fq * 16;
                    RAW_BAR();
                    for (int s = 0; s < NSC; ++s) {
                        LAS float* YB = (LAS float*)(ldsl + YB_OFF + (s & 1) * YB_BYTES);
                        const int nc = (NCH - 2 * s) < 2 ? 1 : 2;
                        for (int cs = 0; cs < nc; ++cs) {
                            const LAS unsigned char* sl = ldsl + ((2 * s + cs) % NSLOT) * SLOTB;
                            const bf16x8 ah0 = *(const LAS bf16x8*)(sl + o_ah0), ah1 = *(const LAS bf16x8*)(sl + o_ah1);
                            const bf16x8 rh0 = *(const LAS bf16x8*)(sl + 2048 + o_ah0), rh1 = *(const LAS bf16x8*)(sl + 2048 + o_ah1);
                            bf16x8 bk[4]; f32x4 gam[4];
#pragma unroll
                            for (int kb = 0; kb < 4; ++kb) { bk[kb] = *(const LAS bf16x8*)(sl + o_bk + kb * 1024); gam[kb] = *(const LAS f32x4*)(sl + o_gam + kb * 64); }
                            const u32x2 vt = *(const LAS u32x2*)(sl + o_vt);
                            const bf16x8 mrk = *(const LAS bf16x8*)(sl + o_mrk);
                            const u32x2 g4 = *(const LAS u32x2*)(sl + o_g);
                            u32x4 zw01, zw23;
                            zw01.x = pk2bf(Z[0][0], Z[0][1]); zw01.y = pk2bf(Z[0][2], Z[0][3]); zw01.z = pk2bf(Z[1][0], Z[1][1]); zw01.w = pk2bf(Z[1][2], Z[1][3]);
                            zw23.x = pk2bf(Z[2][0], Z[2][1]); zw23.y = pk2bf(Z[2][2], Z[2][3]); zw23.z = pk2bf(Z[3][0], Z[3][1]); zw23.w = pk2bf(Z[3][2], Z[3][3]);
                            const bf16x8 zp01 = __builtin_bit_cast(bf16x8, zw01), zp23 = __builtin_bit_cast(bf16x8, zw23);
                            f32x4 U = (f32x4){0.f, 0.f, 0.f, 0.f}, Yv = U;
                            U = __builtin_amdgcn_mfma_f32_16x16x32_bf16(ah0, zp01, U, 0, 0, 0); U = __builtin_amdgcn_mfma_f32_16x16x32_bf16(ah1, zp23, U, 0, 0, 0);
                            U = __builtin_amdgcn_mfma_f32_16x16x16bf16_1k(__builtin_bit_cast(s16x4, g4), __builtin_bit_cast(s16x4, vt), U, 0, 0, 0);
                            Yv = __builtin_amdgcn_mfma_f32_16x16x32_bf16(rh0, zp01, Yv, 0, 0, 0); Yv = __builtin_amdgcn_mfma_f32_16x16x32_bf16(rh1, zp23, Yv, 0, 0, 0);
                            u32x4 uvw; uvw.x = pk2bf(U[0], U[1]); uvw.y = pk2bf(U[2], U[3]); uvw.z = vt.x; uvw.w = vt.y;
                            const bf16x8 uv = __builtin_bit_cast(bf16x8, uvw);
                            Yv = __builtin_amdgcn_mfma_f32_16x16x32_bf16(mrk, uv, Yv, 0, 0, 0);
#pragma unroll
                            for (int kb = 0; kb < 4; ++kb) { Z[kb] = Z[kb] * gam[kb]; Z[kb] = __builtin_amdgcn_mfma_f32_16x16x32_bf16(bk[kb], uv, Z[kb], 0, 0, 0); }
#pragma unroll
                            for (int r = 0; r < 4; ++r) YB[(cs * 16 + 4 * fq + r) * 68 + v] = Yv[r];
                        }
                        RAW_BAR();
                    }
                } else if (wave < 6) {
                    const unsigned lds0 = (unsigned)(uintptr_t)lds; const int lw = wave - 4;
#define DMA_SC(sc) do { const int nc_ = (NCH - 2 * (sc)) < 2 ? 1 : 2; for (int cs_ = 0; cs_ < nc_; ++cs_) { const int ch_ = 2 * (sc) + cs_; \
                        _Pragma("unroll") for (int pc_ = 0; pc_ < 6; ++pc_) { const int pc = lw * 6 + pc_; \
                            const unsigned char* src_ = (pc < 8 ? RA0 + (size_t)ch_ * RA_BYTES + pc * 1024 : RB0 + (size_t)ch_ * RB_BYTES + (pc - 8) * 1024) + lane * 16; \
                            attn_body::glds16(src_, (unsigned)__builtin_amdgcn_readfirstlane(lds0 + (ch_ % NSLOT) * SLOTB + pc * 1024)); } } } while (0)
                    DMA_SC(0); DMA_SC(1); DMA_SC(2); DMA_SC(3);
                    asm volatile("s_waitcnt vmcnt(36)\n\ts_barrier" ::: "memory");
                    for (int s = 0; s < NSC; ++s) {
                        if (s + 4 < NSC) DMA_SC(s + 4);
#define NPC_(sc) ((sc) < NSC ? ((NCH - 2 * (sc)) < 2 ? 6 : 12) : 0)
                        const int fl = NPC_(s + 2) + NPC_(s + 3) + NPC_(s + 4);
#undef NPC_
                        if (fl == 36) asm volatile("s_waitcnt vmcnt(36)\n\ts_barrier" ::: "memory");
                        else if (fl == 30) asm volatile("s_waitcnt vmcnt(30)\n\ts_barrier" ::: "memory");
                        else if (fl == 18) asm volatile("s_waitcnt vmcnt(18)\n\ts_barrier" ::: "memory");
                        else if (fl == 6) asm volatile("s_waitcnt vmcnt(6)\n\ts_barrier" ::: "memory");
                        else asm volatile("s_waitcnt vmcnt(0)\n\ts_barrier" ::: "memory");
                    }
#undef DMA_SC
                } else {
                    const int pw = wave - 6, tk = lane >> 2, part = lane & 3, cgv = h * 64 + part * 16;
                    const bf16_t* BV = (const bf16_t*)(ws + WS_BV);
                    float gnw[16], gnb[16];
#pragma unroll
                    for (int j = 0; j < 16; ++j) { gnw[j] = (inq[13] + lq * 512)[cgv + j]; gnb[j] = (inq[14] + lq * 512)[cgv + j]; }
#define PLOAD(G0, G1, B0, B1, sg) do { const int cn_ = 2 * (sg) + pw; if ((sg) < NSC && cn_ < NCH) { const size_t rown = (size_t)rowof(b, 16 * cn_ + tk); \
                        G0 = *(const u32x4*)(y + rown * DM + cgv); G1 = *(const u32x4*)(y + rown * DM + cgv + 8); B0 = *(const u32x4*)(BV + rown * 512 + cgv); B1 = *(const u32x4*)(BV + rown * 512 + cgv + 8); } } while (0)
                    u32x4 ga0 = (u32x4){0u, 0u, 0u, 0u}, ga1 = ga0, ba0 = ga0, ba1 = ga0, gb0 = ga0, gb1 = ga0, bb0 = ga0, bb1 = ga0, gc0 = ga0, gc1 = ga0, bc0 = ga0, bc1 = ga0;
                    PLOAD(gb0, gb1, bb0, bb1, 0); PLOAD(gc0, gc1, bc0, bc1, 1);
                    RAW_BAR();
                    for (int s = 0; s <= NSC; ++s) {
                        const int cp = 2 * (s - 1) + pw;
                        const bool do_now = s >= 1 && cp < NCH && (cp > 0 || b == 0);
                        const u32x4 g0 = ga0, g1 = ga1, b0 = ba0, b1 = ba1;
                        ga0 = gb0; ga1 = gb1; ba0 = bb0; ba1 = bb1; gb0 = gc0; gb1 = gc1; bb0 = bc0; bb1 = bc1;
                        PLOAD(gc0, gc1, bc0, bc1, s + 2);
                        if (do_now) {
                            const LAS float* yb = (const LAS float*)(ldsl + YB_OFF + ((s - 1) & 1) * YB_BYTES) + (pw * 16 + tk) * 68 + part * 16;
                            float yv[16];
#pragma unroll
                            for (int q4 = 0; q4 < 4; ++q4) { const f32x4 t4 = *(const LAS f32x4*)(yb + 4 * q4); yv[4 * q4] = t4[0]; yv[4 * q4 + 1] = t4[1]; yv[4 * q4 + 2] = t4[2]; yv[4 * q4 + 3] = t4[3]; }
                            float s1 = 0.f;
#pragma unroll
                            for (int j = 0; j < 16; ++j) s1 += yv[j];
                            s1 += QXOR1(s1); s1 += QXOR2(s1);
                            const float mean = s1 * (1.f / 64.f); float s2 = 0.f;
#pragma unroll
                            for (int j = 0; j < 16; ++j) { yv[j] -= mean; s2 += yv[j] * yv[j]; }
                            s2 += QXOR1(s2); s2 += QXOR2(s2);
                            const float rstd = 1.0f / sqrtf(s2 * (1.f / 64.f) + 64e-5f);
                            const unsigned gws[8] = {g0.x, g0.y, g0.z, g0.w, g1.x, g1.y, g1.z, g1.w}, bws[8] = {b0.x, b0.y, b0.z, b0.w, b1.x, b1.y, b1.z, b1.w};
                            unsigned ow[8];
#pragma unroll
                            for (int j2 = 0; j2 < 8; ++j2) {
                                const float oa = (yv[2 * j2] * rstd * gnw[2 * j2] + gnb[2 * j2] + __uint_as_float(bws[j2] << 16)) * __uint_as_float(gws[j2] << 16);
                                const float ob = (yv[2 * j2 + 1] * rstd * gnw[2 * j2 + 1] + gnb[2 * j2 + 1] + __uint_as_float(bws[j2] & 0xffff0000u)) * __uint_as_float(gws[j2] & 0xffff0000u);
                                ow[j2] = pk2bf(oa, ob); }
                            bf16_t* yo = y + (size_t)rowof(b, 16 * cp + tk) * DM + cgv;
                            *(u32x4*)yo = (u32x4){ow[0], ow[1], ow[2], ow[3]}; *(u32x4*)(yo + 8) = (u32x4){ow[4], ow[5], ow[6], ow[7]};
                        }
                        if (s < NSC) RAW_BAR();
                    }
#undef PLOAD
                }
                __syncthreads();
            }
#undef RAW_BAR
#undef QXOR1
#undef QXOR2
        }
        TP_MARK(30);
        {
            PHASE_IDS(); PHASE_PTRS(l);
            if (gw < NH * NMETA) {
                const int h = gw >> 4, t = gw & 15;
                const bf16_t* qrow = p + (size_t)(MROWS + t) * PBW + 1536 + h * 64;
                float s = -INFINITY;
                if (lane <= t) { const bf16_t* kr = p + (size_t)(MROWS + lane) * PBW + 2048 + h * 64; float d = 0.f;
                    for (int e = 0; e < 64; ++e) d += bf2f(qrow[e]) * bf2f(kr[e]);
                    s = d - c2[(size_t)h * 2176 + lane]; }
                const float mx = wave_max(s); const float e = lane <= t ? exp2f(s - mx) : 0.f; const float sum = wave_sum(e);
                float o = 0.f;
                for (int j = 0; j <= t; ++j) o += __int_as_float(__builtin_amdgcn_readlane(__float_as_int(e), j)) * bf2f(p[(size_t)(MROWS + j) * PBW + 2560 + h * 64 + lane]);
                const float og = bf2f(p[(size_t)(MROWS + t) * PBW + 3072 + h * 64 + lane]);
                y[(size_t)(MROWS + t) * DM + 512 + h * 64 + lane] = f2bf(o * __builtin_amdgcn_rcpf(sum) * __builtin_amdgcn_rcpf(1.f + __builtin_amdgcn_exp2f(-LOG2E * og)));
            }
        }
        __syncthreads();
        {
            PHASE_IDS(); PHASE_PTRS(l);
            typedef attn_body::bf16 abf;
            const attn_body::AttnTensors AT{(const abf*)(p + 1536), (const abf*)(p + 2048), (const abf*)(p + 2560), (const abf*)(p + 3072), c2, (abf*)(y + 512)};
            const attn_body::StaticOrder S(G, bid);
            TP_MARK(31);
            attn_body::attn_phase<attn_body::StaticOrder>((char*)lds, AT, S, wave);
            TP_MARK(32);
        }
        } else if (ph == 3) {
        {
            PHASE_IDS(); PHASE_PTRS(l);
            pg8::Gemm g{y, W2, MROWS, DM, DM}; pg8::StaticOrder S; S.init(MROWS, DM, G, bid);
            pg8::EpiRes E{nullptr, hb, ssqp};
            pg8::gemm_phase<pg8::EpiRes, pg8::StaticOrder, true, true>(ldsl, g, S, E, wave);
            meta_gemm<false>(y + (size_t)MROWS * DM, DM, W2, DM, DM, bid, G, wave, lane, (float*)lds, MEpiRes{hm});
        }
        } else if (ph == 5) {
        {
            PHASE_IDS(); PHASE_PTRS(l);
            const float* cw = inq[21] + (size_t)lq * 3 * DFF2; const float* cb = inq[22] + (size_t)lq * DFF2;
            pg8::Gemm g{act, W4, MROWS, DM, DFF}; pg8::StaticOrder S; S.init(MROWS, DM, G, bid);
            {
                pg8::Unit u;
                for (int i = 0; S.next(i, u); ++i) {
                    const int pm = u.pm;
                    const float* own0 = fixb + (size_t)(pm * 4) * DFF2; const float* own1 = own0 + DFF2;
                    const float* pv0 = (pm & 7) ? fixb + (size_t)((pm - 1) * 4 + 2) * DFF2 : rawm + (size_t)14 * DFF2; const float* pv1 = pv0 + DFF2;
                    for (int j = 4 * tid; j < DFF; j += 4 * NWAVES * 64) {
                        const f32x4 w0u = *(const f32x4*)(cw + j), w1u = *(const f32x4*)(cw + DFF2 + j), w2u = *(const f32x4*)(cw + 2 * DFF2 + j), bu = *(const f32x4*)(cb + j);
                        const f32x4 w0g = *(const f32x4*)(cw + DFF + j), w1g = *(const f32x4*)(cw + DFF2 + DFF + j), w2g = *(const f32x4*)(cw + 2 * DFF2 + DFF + j), bg = *(const f32x4*)(cb + DFF + j);
                        const f32x4 au = *(const f32x4*)(pv0 + j), bu_ = *(const f32x4*)(pv1 + j), cu_ = *(const f32x4*)(own0 + j), du = *(const f32x4*)(own1 + j);
                        const f32x4 ag = *(const f32x4*)(pv0 + DFF + j), bg_ = *(const f32x4*)(pv1 + DFF + j), cg_ = *(const f32x4*)(own0 + DFF + j), dg = *(const f32x4*)(own1 + DFF + j);
                        const f32x4 u0 = bu + w0u * au + w1u * bu_ + w2u * cu_, g0 = bg + w0g * ag + w1g * bg_ + w2g * cg_;
                        const f32x4 u1 = bu + w0u * bu_ + w1u * cu_ + w2u * du, g1 = bg + w0g * bg_ + w1g * cg_ + w2g * dg;
                        u32x2 o0, o1;
                        o0.x = pk2bf(g0[0] * sigmoidf_(g0[0]) * u0[0], g0[1] * sigmoidf_(g0[1]) * u0[1]); o0.y = pk2bf(g0[2] * sigmoidf_(g0[2]) * u0[2], g0[3] * sigmoidf_(g0[3]) * u0[3]);
                        o1.x = pk2bf(g1[0] * sigmoidf_(g1[0]) * u1[0], g1[1] * sigmoidf_(g1[1]) * u1[1]); o1.y = pk2bf(g1[2] * sigmoidf_(g1[2]) * u1[2], g1[3] * sigmoidf_(g1[3]) * u1[3]);
                        *(u32x2*)(act + (size_t)(256 * pm) * DFF + j) = o0; *(u32x2*)(act + (size_t)(256 * pm + 1) * DFF + j) = o1;
                    }
                }
                asm volatile("s_waitcnt vmcnt(0)" ::: "memory"); __syncthreads();
            }
            pg8::EpiRes E{lq + 1 == DEPTH ? out : nullptr, hb, ssqp};
            pg8::gemm_phase<pg8::EpiRes, pg8::StaticOrder, true, true>(ldsl, g, S, E, wave);
            meta_gemm<false>(act + (size_t)MROWS * DFF, DFF, W4, DM, DFF, bid, G, wave, lane, (float*)lds, MEpiRes{hm});
        }
        }
#ifdef TPROBE
#ifdef TPROBE_WAIT
        TP_MARK(19);
#endif
        GRID_BAR(); TP_MARK(ph == 0 ? 1 : ph == 1 ? 2 : ph == 2 ? 3 : ph == 3 ? 4 : ph == 4 ? 5 : 6);
#if TPROBE == 40
        GRID_BAR(); TP_MARK(40);
#endif
#else
        if (ph < 5 || l + 1 < DEPTH) GRID_BAR();
#endif
      }
    }
#ifdef TPROBE
#ifndef TPROBE_BLOCK
#define TPROBE_BLOCK 0
#endif
    if (bid0 == TPROBE_BLOCK && wave_s == 0 && lane_id() == 0) a.out[0] += (float)((volatile LAS unsigned*)((LAS unsigned char*)lds + LDSCTL_OFF + 512))[1] * 0.0001f;
#endif
}

extern "C" void kernel_launch(void* const* d_in, const int* in_sizes, int n_in, void* d_out, int out_size, void* d_ws, size_t ws_size, hipStream_t stream) {
    static int grid = 0;
    if (grid == 0) {
        if (n_in != 24 || out_size != MROWS * DM || ws_size < WS_END) { fprintf(stderr, "kernel_launch: unexpected shapes (n_in %d out %d ws %zu)\n", n_in, out_size, ws_size); grid = -1; return; }
        int dev = 0, cus = 0, per_cu = 0;
        hipGetDevice(&dev); hipDeviceGetAttribute(&cus, hipDeviceAttributeMultiprocessorCount, dev);
        if (hipFuncSetAttribute((const void*)mk_fwd, hipFuncAttributeMaxDynamicSharedMemorySize, LDS_BYTES) != hipSuccess) { fprintf(stderr, "kernel_launch: hipFuncSetAttribute failed\n"); grid = -1; return; }
        hipOccupancyMaxActiveBlocksPerMultiprocessor(&per_cu, (const void*)mk_fwd, NWAVES * 64, LDS_BYTES);
        (void)hipGetLastError();
        if (per_cu < 1) { fprintf(stderr, "kernel_launch: occupancy query says %d blocks per CU\n", per_cu); }
        grid = cus;
    }
    if (grid < 0) return;
    hipMemsetAsync((char*)d_ws + WS_CTL, 0, 32768, stream);
    Args a{};
    for (int i = 0; i < 24; ++i) a.in[i] = (const float*)d_in[i];
    a.out = (float*)d_out; a.ws = (unsigned char*)d_ws;
    void* args[] = {&a};
#ifdef PLAIN_LAUNCH
    hipLaunchKernelGGL(mk_fwd, dim3(grid), dim3(NWAVES * 64), LDS_BYTES, stream, a); hipError_t e = hipPeekAtLastError(); (void)args;
#else
    hipError_t e = hipLaunchCooperativeKernel((const void*)mk_fwd, dim3(grid), dim3(NWAVES * 64), args, LDS_BYTES, stream);
#endif
    if (e != hipSuccess) fprintf(stderr, "cooperative launch failed: %s (grid %d)\n", hipGetErrorString(e), grid);
}
```

```cpp
#define PLAIN_LAUNCH 1
#include <hip/hip_runtime.h>
#include <hip/hip_cooperative_groups.h>
#include <stdint.h>
#include <cstdio>
namespace cg = cooperative_groups;

typedef unsigned short bf16_t;
typedef short bf16x8 __attribute__((ext_vector_type(8)));
typedef float f32x4 __attribute__((ext_vector_type(4)));
typedef unsigned u32x4 __attribute__((ext_vector_type(4)));
typedef unsigned u32x2 __attribute__((ext_vector_type(2)));

constexpr int NB = 8, SEQ = 2048, NMETA = 16, LTOT = 2064, DM = 1024, DEPTH = 4, NH = 8, HD = 64;
constexpr int N_IN = 3880, DFF = 2816, DFF2 = 5632;
constexpr int MROWS = NB * SEQ;
constexpr int RROWS = MROWS + NMETA;
constexpr int N1 = 4096;
constexpr int PBW = 3584;
constexpr int PNW = 320;
constexpr float LOG2E = 1.4426950408889634f;

constexpr size_t MiB = 1u << 20;
constexpr size_t WS_CTL = 0, CTL_ZERO_BYTES = 1 * MiB;
constexpr size_t WS_W = 1 * MiB, WL_BYTES = 27 * MiB;
constexpr size_t WO_W1 = 0;
constexpr size_t WO_W2 = 8 * MiB;
constexpr size_t WO_W3 = 10 * MiB;
constexpr size_t WO_W4 = 21 * MiB;
constexpr size_t WO_LUP = 26 * MiB + 512 * 1024;
constexpr size_t WS_SMALL = WS_W + 2 * WL_BYTES;
constexpr size_t WS_HM = WS_SMALL;
constexpr size_t WS_C2 = WS_SMALL + 1 * MiB;
constexpr size_t WS_SSQ = WS_SMALL + 3 * MiB;
constexpr size_t WS_HB = WS_SMALL + 6 * MiB;
constexpr size_t WS_P = WS_HB + 33 * MiB;
constexpr size_t WS_PN = WS_P + 113 * MiB;
constexpr size_t WS_Y = WS_PN + 21 * MiB;
constexpr size_t WS_FREE = WS_Y + 33 * MiB;
constexpr int NCH = 129;
constexpr size_t RA_BYTES = 8192, RB_BYTES = 4096;
constexpr size_t WS_RA = WS_FREE;
#define SWZ4(r) (3 * (((r) >> 3) & 1))
constexpr size_t WS_ACT = WS_P;
constexpr size_t WS_FIX = WS_PN;
constexpr size_t WS_RAWM = WS_PN + 6 * MiB;
constexpr size_t WS_BV = WS_RA + 65 * MiB;
constexpr size_t WS_END = WS_BV + 17 * MiB;

__device__ __forceinline__ float bf2f(bf16_t v) { return __uint_as_float(((unsigned)v) << 16); }
typedef float f32x2_t_ __attribute__((ext_vector_type(2))); typedef __bf16 bf16x2_t_ __attribute__((ext_vector_type(2)));
__device__ __forceinline__ unsigned pk2bf(float lo, float hi) { const f32x2_t_ v = {lo, hi}; return __builtin_bit_cast(unsigned, __builtin_convertvector(v, bf16x2_t_)); }
__device__ __forceinline__ bf16_t f2bf(float f) { return __builtin_bit_cast(bf16_t, (__bf16)f); }
__device__ __forceinline__ float sigmoidf_(float x) { return 1.f / (1.f + __expf(-x)); }
__device__ __forceinline__ float wave_sum_dpp(float v) {
#define DPPF_(x, ctrl, rmask) __int_as_float(__builtin_amdgcn_update_dpp(0, __float_as_int(x), ctrl, rmask, 0xf, false))
    v += DPPF_(v, 0xB1, 0xf);
    v += DPPF_(v, 0x4E, 0xf);
    v += DPPF_(v, 0x141, 0xf);
    v += DPPF_(v, 0x140, 0xf);
    v += DPPF_(v, 0x142, 0xa);
    v += DPPF_(v, 0x143, 0xc);
#undef DPPF_
    return __int_as_float(__builtin_amdgcn_readlane(__float_as_int(v), 63));
}
__device__ __forceinline__ float wave_sum(float v) { return wave_sum_dpp(v); }
__device__ __forceinline__ void wave_sum_dpp8(float (&v)[8]) {
#define DPPF_(x, ctrl, rmask) __int_as_float(__builtin_amdgcn_update_dpp(0, __float_as_int(x), ctrl, rmask, 0xf, false))
#define DPPS_(ctrl, rmask) _Pragma("unroll") for (int j_ = 0; j_ < 8; ++j_) v[j_] += DPPF_(v[j_], ctrl, rmask);
    DPPS_(0xB1, 0xf) DPPS_(0x4E, 0xf) DPPS_(0x141, 0xf) DPPS_(0x140, 0xf) DPPS_(0x142, 0xa) DPPS_(0x143, 0xc)
#undef DPPS_
#undef DPPF_
#pragma unroll
    for (int j_ = 0; j_ < 8; ++j_) v[j_] = __int_as_float(__builtin_amdgcn_readlane(__float_as_int(v[j_]), 63));
}
__device__ __forceinline__ float wave_max(float v) {
#define DPPF_(x, ctrl, rmask) __int_as_float(__builtin_amdgcn_update_dpp(__float_as_int(x), __float_as_int(x), ctrl, rmask, 0xf, false))
    v = fmaxf(v, DPPF_(v, 0xB1, 0xf)); v = fmaxf(v, DPPF_(v, 0x4E, 0xf)); v = fmaxf(v, DPPF_(v, 0x141, 0xf)); v = fmaxf(v, DPPF_(v, 0x140, 0xf));
    v = fmaxf(v, DPPF_(v, 0x142, 0xa)); v = fmaxf(v, DPPF_(v, 0x143, 0xc));
#undef DPPF_
    return __int_as_float(__builtin_amdgcn_readlane(__float_as_int(v), 63));
}
__device__ __forceinline__ float add_xor16(float x) { const auto r = __builtin_amdgcn_permlane16_swap(__float_as_uint(x), __float_as_uint(x), false, false); return __uint_as_float(r[0]) + __uint_as_float(r[1]); }
__device__ __forceinline__ float add_xor32(float x) { const auto r = __builtin_amdgcn_permlane32_swap(__float_as_uint(x), __float_as_uint(x), false, false); return __uint_as_float(r[0]) + __uint_as_float(r[1]); }
__device__ __forceinline__ int lane_id() { int l; asm volatile("v_mbcnt_lo_u32_b32 %0, -1, 0\n\tv_mbcnt_hi_u32_b32 %0, -1, %0" : "=v"(l)); return l; }
#define WAVE_LDS_SYNC() do { __builtin_amdgcn_s_waitcnt(0xc07f); __builtin_amdgcn_wave_barrier(); } while (0)
__device__ __forceinline__ int rowof(int b, int t) { return t < NMETA ? MROWS + t : b * SEQ + (t - NMETA); }
__device__ __forceinline__ int prevrow(int row) {
    if (row >= MROWS) return row == MROWS ? -1 : row - 1;
    return (row & (SEQ - 1)) ? row - 1 : MROWS + NMETA - 1;
}

#define PERM32(j) (8 * (((j) >> 2) & 3) + 4 * ((j) >> 4) + ((j) & 3))
__device__ __forceinline__ int src_col(int mode, int n) {
    if (mode == 1) {
        const int g = n >> 9, c_ = n & 255, o = (n & 256) + (g < 7 ? ((c_ >> 5) & 3) * 64 + (c_ >> 7) * 32 + PERM32(c_ & 31) : c_);
        switch (g) {
            case 0: return o;
            case 1: return 512 + o;
            case 2: return 1024 + o;
            case 3: return 1824 + o;
            case 4: return 2336 + o;
            case 5: return 2848 + o;
            case 6: return 3360 + o;
            default:
                if (o < 64) return 1536 + o;
                if (o < 128) return 1600 + (o - 64);
                if (o < 288) return 1664 + (o - 128);
                if (o < 296) return 3872 + (o - 288);
                return -1;
        }
    }
    if (mode == 3) { const int t = n >> 8, c = n & 255; return c < 128 ? 128 * t + c : DFF + 128 * t + (c - 128); }
    return (n & ~31) + PERM32(n & 31);
}
__device__ __forceinline__ void wprep_item(const float* W, const float* gk, bf16_t* WT, int K, int Nsrc, int Ndst, int mode, int item, float* scr, int lane) {
    const int nblk = Ndst / 32, kb = item / nblk, nb = item % nblk, k0 = 64 * kb, n0 = 32 * nb;
    const int sc = src_col(mode, n0 + (lane & 31));
    const float* wp = W + (size_t)(k0 + (lane >> 5)) * Nsrc + (sc >= 0 ? sc : 0);
    float v[32];
#pragma unroll
    for (int i = 0; i < 32; ++i) { v[i] = *wp; wp += 2 * (size_t)Nsrc; }
#pragma unroll
    for (int i = 0; i < 32; ++i) scr[(2 * i + (lane >> 5)) * 33 + (lane & 31)] = sc >= 0 ? v[i] : 0.f;
    WAVE_LDS_SYNC();
    const int c = lane & 7;
    f32x4 g0 = (f32x4){1.f, 1.f, 1.f, 1.f}, g1 = g0;
    if (gk) { g0 = *(const f32x4*)(gk + k0 + 8 * c); g1 = *(const f32x4*)(gk + k0 + 8 * c + 4); }
#pragma unroll
    for (int j = 0; j < 4; ++j) {
        const int n = (lane >> 3) + 8 * j; const float* s = scr + (8 * c) * 33 + n;
        u32x4 o;
        o.x = pk2bf(s[0 * 33] * g0[0], s[1 * 33] * g0[1]); o.y = pk2bf(s[2 * 33] * g0[2], s[3 * 33] * g0[3]); o.z = pk2bf(s[4 * 33] * g1[0], s[5 * 33] * g1[1]); o.w = pk2bf(s[6 * 33] * g1[2], s[7 * 33] * g1[3]);
        *(u32x4*)(WT + (size_t)(n0 + n) * K + k0 + 8 * c) = o;
    }
    WAVE_LDS_SYNC();
}
namespace pg8 {
#define PG8_LAS __attribute__((address_space(3)))
typedef unsigned short bf16_t;
typedef short bf16x8 __attribute__((ext_vector_type(8)));
typedef float f32x4 __attribute__((ext_vector_type(4)));
typedef unsigned u32x4 __attribute__((ext_vector_type(4)));
constexpr int BM = 256, BK = 64, HALF = 128, HTB = HALF * BK * 2  , STAGE_BYTES = 8 * HTB, NXCD = 8, WGM = 8;

__host__ __device__ __forceinline__ int lds_byte(int r, int c) { const int st = (r >> 4) * 2 + (c >> 5), rr = r & 15, cc = c & 31, ob = rr * 64 + cc * 2; return st * 1024 + (ob ^ (((ob >> 9) & 1) << 5)); }
__host__ __device__ __forceinline__ void stage_rc(int b, int& R, int& C) { const int st = b / 1024, sb = b % 1024, swz = sb ^ (((sb >> 9) & 1) << 5); R = (st >> 1) * 16 + swz / 64; C = (st & 1) * 32 + (swz % 64) / 2; }
__host__ __device__ __forceinline__ int perm32(int rho) { const int n = rho >> 4, i = rho & 15; return 8 * (i >> 2) + 4 * n + (i & 3); }

struct Unit { int pm, pn, idx; };
struct Gemm { const bf16_t* A; const bf16_t* Bt; int M, N, K; };

struct StaticOrder {
    int nM, nN, nwg, G, c;
    __host__ __device__ void init(int M, int N, int G_, int c_) { nM = M / BM; nN = N / BM; nwg = nM * nN; G = G_; c = c_; }
    __host__ __device__ bool next(int i, Unit& u) const {
        const long L = (long)i * G + c; if (L >= nwg) return false;
        int wgid = (int)L; { const int q = nwg / NXCD, r = nwg % NXCD, xcd = wgid % NXCD, off = wgid / NXCD; wgid = (xcd < r ? xcd * (q + 1) : r * (q + 1) + (xcd - r) * q) + off; }
        const int nig = WGM * nN, gid = wgid / nig, fm = gid * WGM, gsz = (nM - fm) < WGM ? (nM - fm) : WGM;
        u.pm = fm + ((wgid % nig) % gsz); u.pn = (wgid % nig) / gsz; u.idx = i; return true;
    }
    __device__ __forceinline__ void a_ready(const Unit&) const {}
    __device__ __forceinline__ void done(const Unit&) const {}
};

__device__ __forceinline__ float row_rstd(const float* ssqp, int row) {
    const f32x4* sp = (const f32x4*)(ssqp + (size_t)row * 16);
    const f32x4 a = sp[0], b = sp[1], c = sp[2], d = sp[3];
    const float s = (((a.x + a.y) + (a.z + a.w)) + ((b.x + b.y) + (b.z + b.w))) + (((c.x + c.y) + (c.z + c.w)) + ((d.x + d.y) + (d.z + d.w)));
    return 1.0f / sqrtf(s * (1.f / 1024.f) + 1e-6f);
}
struct Epi1 {
    static constexpr bool PERM = false, AFTER_DRAIN = false;
    const PG8_LAS float* rstdl; bf16_t* p; float* pn; const float* q_g; const float* k_g;
    __device__ __forceinline__ void operator()(const f32x4 (&acc)[2][2][4][2], const Unit& u, int wr, int wc, int fr, int fq) const {
        const int row0 = u.pm * BM + wr * 64 + fr;
        const bool isq = (u.pn >> 1) == 3, isk = (u.pn >> 1) == 4;
        f32x4 gsc[2][2];
        if (isq || isk) {
#pragma unroll
            for (int bj = 0; bj < 2; ++bj)
#pragma unroll
                for (int n = 0; n < 2; ++n) gsc[bj][n] = *(const f32x4*)((isq ? q_g : k_g) + 32 * bj + 8 * fq + 4 * n) * (isq ? 0.125f * 1.4426950408889634f : 1.f);
        }
#pragma unroll
        for (int ai = 0; ai < 2; ++ai)
#pragma unroll
            for (int m = 0; m < 4; ++m) {
                const int row = row0 + ai * HALF + m * 16; const float rs = rstdl[u.idx * 256 + wr * 64 + fr + ai * HALF + m * 16];
                f32x4 v[2][2];
#pragma unroll
                for (int bj = 0; bj < 2; ++bj)
#pragma unroll
                    for (int n = 0; n < 2; ++n) v[bj][n] = acc[ai][bj][m][n] * rs;
                if (u.pn < 14) {
                    if (isq || isk) {
                        float ss = 0.f;
#pragma unroll
                        for (int bj = 0; bj < 2; ++bj)
#pragma unroll
                            for (int n = 0; n < 2; ++n) ss += (v[bj][n][0] * v[bj][n][0] + v[bj][n][1] * v[bj][n][1]) + (v[bj][n][2] * v[bj][n][2] + v[bj][n][3] * v[bj][n][3]);
                        ss = add_xor16(ss); ss = add_xor32(ss);
                        const float rn = 1.0f / sqrtf(ss * (1.f / 64.f) + 1e-6f);
#pragma unroll
                        for (int bj = 0; bj < 2; ++bj)
#pragma unroll
                            for (int n = 0; n < 2; ++n) v[bj][n] = v[bj][n] * gsc[bj][n] * rn;
                    }
#pragma unroll
                    for (int bj = 0; bj < 2; ++bj) { u32x4 w; w.x = pk2bf(v[bj][0][0], v[bj][0][1]); w.y = pk2bf(v[bj][0][2], v[bj][0][3]); w.z = pk2bf(v[bj][1][0], v[bj][1][1]); w.w = pk2bf(v[bj][1][2], v[bj][1][3]);
                        *(u32x4*)(p + (size_t)row * PBW + u.pn * BM + wc * 64 + bj * 32 + 8 * fq) = w; }
                } else {
#pragma unroll
                    for (int bj = 0; bj < 2; ++bj)
#pragma unroll
                        for (int n = 0; n < 2; ++n) { const int o = u.pn * BM + wc * 32 + 4 * fq + bj * HALF + n * 16 - PBW; if (o < 296) *(f32x4*)(pn + (size_t)row * PNW + o) = v[bj][n]; }
                }
            }
    }
};
struct EpiRes {
    static constexpr bool PERM = false, AFTER_DRAIN = false;
    float* outp; bf16_t* hb; float* ssqp;
    __device__ __forceinline__ void operator()(const f32x4 (&acc)[2][2][4][2], const Unit& u, int wr, int wc, int fr, int fq) const {
        const int row0 = u.pm * BM + wr * 64 + fr, col0 = u.pn * BM + wc * 32 + 8 * fq;
#pragma unroll
        for (int ai = 0; ai < 2; ++ai) {
            u32x4 hw[4][2];
#pragma unroll
            for (int m = 0; m < 4; ++m)
#pragma unroll
                for (int bj = 0; bj < 2; ++bj) hw[m][bj] = *(const u32x4*)(hb + (size_t)(row0 + ai * HALF + m * 16) * DM + col0 + bj * HALF);
            asm volatile("s_waitcnt vmcnt(0)" ::: "memory");
#pragma unroll
            for (int m = 0; m < 4; ++m) {
                const int row = row0 + ai * HALF + m * 16; float ss = 0.f;
#pragma unroll
                for (int bj = 0; bj < 2; ++bj) {
                    const int col = col0 + bj * HALF; bf16_t* hp = hb + (size_t)row * DM + col;
                    const u32x4 h4 = hw[m][bj];
                    const f32x4 v0 = (f32x4){__uint_as_float(h4.x << 16), __uint_as_float(h4.x & 0xffff0000u), __uint_as_float(h4.y << 16), __uint_as_float(h4.y & 0xffff0000u)} + acc[ai][bj][m][0];
                    const f32x4 v1 = (f32x4){__uint_as_float(h4.z << 16), __uint_as_float(h4.z & 0xffff0000u), __uint_as_float(h4.w << 16), __uint_as_float(h4.w & 0xffff0000u)} + acc[ai][bj][m][1];
                    u32x4 w; w.x = pk2bf(v0[0], v0[1]); w.y = pk2bf(v0[2], v0[3]); w.z = pk2bf(v1[0], v1[1]); w.w = pk2bf(v1[2], v1[3]);
                    *(u32x4*)hp = w;
                    if (outp) { *(f32x4*)(outp + (size_t)row * DM + col) = v0; *(f32x4*)(outp + (size_t)row * DM + col + 4) = v1; }
                    const f32x4 r0 = (f32x4){__uint_as_float(w.x << 16), __uint_as_float(w.x & 0xffff0000u), __uint_as_float(w.y << 16), __uint_as_float(w.y & 0xffff0000u)};
                    const f32x4 r1 = (f32x4){__uint_as_float(w.z << 16), __uint_as_float(w.z & 0xffff0000u), __uint_as_float(w.w << 16), __uint_as_float(w.w & 0xffff0000u)};
                    ss += ((r0[0] * r0[0] + r0[1] * r0[1]) + (r0[2] * r0[2] + r0[3] * r0[3])) + ((r1[0] * r1[0] + r1[1] * r1[1]) + (r1[2] * r1[2] + r1[3] * r1[3]));
                }
                ss = add_xor16(ss); ss = add_xor32(ss);
                if (fq == 0) ssqp[(size_t)row * 16 + u.pn * 4 + wc] = ss;
            }
        }
    }
};
__device__ __forceinline__ float dpp_ror1(float x) { return __int_as_float(__builtin_amdgcn_mov_dpp(__float_as_int(x), 0x121, 0xf, 0xf, true)); }
__device__ __forceinline__ float dpp_ror2(float x) { return __int_as_float(__builtin_amdgcn_mov_dpp(__float_as_int(x), 0x122, 0xf, 0xf, true)); }
__device__ __forceinline__ float vmul_s(float a, float b) { float r; asm volatile("v_mul_f32_e32 %0, %1, %2" : "=v"(r) : "v"(a), "v"(b)); return r; }
struct EpiConv {
    static constexpr bool PERM = false, AFTER_DRAIN = false;
    const PG8_LAS float* rstdl; const float* cw; const float* cb; bf16_t* act; float* fix; PG8_LAS unsigned char* halo; PG8_LAS float* ctab;
    __device__ __forceinline__ void operator()(const f32x4 (&acc)[2][2][4][2], const Unit& u, int wr, int wc, int fr_, int fq_) const {
        int fr = fr_, fq = fq_; asm volatile("" : "+v"(fr), "+v"(fq));
        const int row0 = u.pm * BM + wr * 64 + fr, cl = wc * 32 + 4 * fq;
        {
            const int q = 2 * ((wr * 4 + wc) * 64 + fq * 16 + fr), p = q >> 8, col = q & 255;
            const float* src = (p < 3 ? cw + (size_t)p * DFF2 : cb) + (col < 128 ? 128 * u.pn + col : DFF + 128 * u.pn + (col - 128));
            typedef float f32x2w __attribute__((ext_vector_type(2)));
            *(PG8_LAS f32x2w*)(ctab + q) = *(const f32x2w*)src;
        }
        float rs[2][4];
#pragma unroll
        for (int ai = 0; ai < 2; ++ai)
#pragma unroll
            for (int m = 0; m < 4; ++m) rs[ai][m] = rstdl[u.idx * 256 + wr * 64 + fr + ai * HALF + m * 16];
        if (fr >= 14) {
#pragma unroll
            for (int ai = 0; ai < 2; ++ai)
#pragma unroll
                for (int bj = 0; bj < 2; ++bj)
#pragma unroll
                    for (int n = 0; n < 2; ++n) { const f32x4 v = acc[ai][bj][3][n] * rs[ai][3];
                        *(PG8_LAS f32x4*)(halo + ((((ai * 2 + wr) * 2 + (fr - 14)) * 256) + bj * HALF + cl + n * 16) * 4) = v;
                        if (ai == 1 && wr == 1) *(f32x4*)(fix + (size_t)(u.pm * 4 + 2 + (fr - 14)) * DFF2 + bj * DFF + 128 * u.pn + cl + n * 16) = v; }
        }
        if (fr < 2 && wr == 0) {
#pragma unroll
            for (int bj = 0; bj < 2; ++bj)
#pragma unroll
                for (int n = 0; n < 2; ++n) *(f32x4*)(fix + (size_t)(u.pm * 4 + fr) * DFF2 + bj * DFF + 128 * u.pn + cl + n * 16) = acc[0][bj][0][n] * rs[0][0];
        }
        asm volatile("s_waitcnt lgkmcnt(0)\n\ts_barrier" ::: "memory");
        typedef float f32x2v __attribute__((ext_vector_type(2)));
#pragma unroll
        for (int n = 0; n < 2; ++n) {
            const unsigned la2 = (unsigned)(fr * DFF + cl) * 2u;
            unsigned wpk[2][2][4];
#pragma unroll
            for (int eh = 0; eh < 2; ++eh) {
                asm volatile("" ::: "memory"); __builtin_amdgcn_sched_barrier(0);
                const int e = 2 * eh;
#define CWL(p, g) (*(const PG8_LAS f32x2v*)(ctab + (p) * 256 + (g) * 128 + cl + n * 16 + e))
                const f32x2v wu0 = CWL(0, 0), wu1 = CWL(1, 0), wu2 = CWL(2, 0), bu = CWL(3, 0);
                const f32x2v wg0 = CWL(0, 1), wg1 = CWL(1, 1), wg2 = CWL(2, 1), bg = CWL(3, 1);
#undef CWL
#pragma unroll
                for (int ai = 0; ai < 2; ++ai) {
                    const int ps = (ai * 2 + wr) ? (ai * 2 + wr - 1) : 0;
                    const PG8_LAS float* hp = (const PG8_LAS float*)halo + (ps * 2) * 256 + cl + n * 16 + e;
                    const f32x2v hu62 = *(const PG8_LAS f32x2v*)hp, hu63 = *(const PG8_LAS f32x2v*)(hp + 256), hg62 = *(const PG8_LAS f32x2v*)(hp + 128), hg63 = *(const PG8_LAS f32x2v*)(hp + 256 + 128);
                    f32x2v p1u = hu63, p1g = hg63, p2u = fr == 0 ? hu62 : hu63, p2g = fr == 0 ? hg62 : hg63;
#pragma unroll
                    for (int m = 0; m < 4; ++m) {
                        __builtin_amdgcn_sched_barrier(0);
                        f32x2v xu, xg;
                        xu.x = vmul_s(acc[ai][0][m][n][e], rs[ai][m]); xu.y = vmul_s(acc[ai][0][m][n][e + 1], rs[ai][m]); xg.x = vmul_s(acc[ai][1][m][n][e], rs[ai][m]); xg.y = vmul_s(acc[ai][1][m][n][e + 1], rs[ai][m]);
                        f32x2v r1u, r2u, r1g, r2g;
                        r1u.x = dpp_ror1(xu.x); r1u.y = dpp_ror1(xu.y); r2u.x = dpp_ror2(xu.x); r2u.y = dpp_ror2(xu.y);
                        r1g.x = dpp_ror1(xg.x); r1g.y = dpp_ror1(xg.y); r2g.x = dpp_ror2(xg.x); r2g.y = dpp_ror2(xg.y);
                        const f32x2v x1u = fr >= 1 ? r1u : p1u, x2u = fr >= 2 ? r2u : p2u, x1g = fr >= 1 ? r1g : p1g, x2g = fr >= 2 ? r2g : p2g;
                        p1u = r1u; p2u = r2u; p1g = r1g; p2g = r2g;
                        const f32x2v cu = bu + wu0 * x2u + wu1 * x1u + wu2 * xu, cg = bg + wg0 * x2g + wg1 * x1g + wg2 * xg;
                        const float o0 = cg.x * __builtin_amdgcn_rcpf(1.f + __builtin_amdgcn_exp2f(-1.4426950408889634f * cg.x)) * cu.x;
                        const float o1 = cg.y * __builtin_amdgcn_rcpf(1.f + __builtin_amdgcn_exp2f(-1.4426950408889634f * cg.y)) * cu.y;
                        wpk[eh][ai][m] = pk2bf(o0, o1);
                    }
                }
            }
#pragma unroll
            for (int ai = 0; ai < 2; ++ai)
#pragma unroll
                for (int m = 0; m < 4; ++m)
                {
                    u32x2 w; w.x = wpk[0][ai][m]; w.y = wpk[1][ai][m];
                    *(u32x2*)((char*)(act + (size_t)(u.pm * BM + wr * 64 + ai * HALF + m * 16) * DFF + 128 * u.pn + n * 16) + la2) = w; }
        }
    }
};

#ifdef TPROBE
#ifndef TPROBE_PH
#define TPROBE_PH -1
#endif
#define PG8_TP(ph) do { if (TPROBE < 20) break; const unsigned t_ = (unsigned)__builtin_amdgcn_s_memrealtime(); if (wave_s == 0 && lane_id() == 0) { volatile PG8_LAS unsigned* q_ = (volatile PG8_LAS unsigned*)(lds + (163840 - 1024 + 512)); \
        if ((ph) == TPROBE && (TPROBE_PH < 0 || q_[2] == (unsigned)TPROBE_PH)) q_[1] += t_ - q_[0]; q_[0] = t_; } } while (0)
#else
#define PG8_TP(ph) do {} while (0)
#endif
template <class Epi, class Sched, bool ALIGN_EPI = false, bool SP2 = false>
__device__ __forceinline__ void gemm_phase(PG8_LAS unsigned char* lds, const Gemm g, const Sched& S, const Epi& E, const int wave_s) {
    int tid_ = wave_s * 64 + lane_id(); asm volatile("" : "+v"(tid_));
    const int tid = tid_, wid = wave_s, lane = tid & 63, wr = wid >> 2, wc = wid & 3, fr = lane & 15, fq = lane >> 4;
    const int K = g.K, nt = K / BK;
    unsigned voffA[2], voffB[2];
#pragma unroll
    for (int i = 0; i < 2; ++i) { int R, C; stage_rc(tid * 16 + i * 8192, R, C); const int Rb = Epi::PERM ? ((R & ~31) + perm32(R & 31)) : R;
        voffA[i] = (unsigned)(R * K + C) * 2u; voffB[i] = (unsigned)(Rb * K + C) * 2u; }
    const size_t kstep = (size_t)(BK * 2);
    const size_t hstep = (size_t)HALF * K * 2;
    const size_t tstep = 2 * hstep;
    const unsigned ldsw = (unsigned)wid * 1024u;
    const int aoff = lds_byte(wr * 64 + fr, fq * 8), boff = lds_byte(wc * 32 + fr, fq * 8);
#define PG8_SA(b, h) (((b) * 2 + (h)) * HTB)
#define PG8_SB(b, h) ((4 + (b) * 2 + (h)) * HTB)
#define PG8_STAGE(bufoff, gbase, voff) do { _Pragma("unroll") for (int _i = 0; _i < 2; ++_i) \
        __builtin_amdgcn_global_load_lds((const unsigned*)((const char*)(gbase) + (voff)[_i]), (PG8_LAS unsigned*)(lds + (bufoff) + ldsw + _i * 8192), 16, 0, 0); } while (0)
#define PG8_LDA(dst, b, h) do { _Pragma("unroll") for (int m = 0; m < 4; ++m) _Pragma("unroll") for (int k = 0; k < 2; ++k) dst[m][k] = *(const PG8_LAS bf16x8*)(lds + PG8_SA(b, h) + aoff + m * 2048 + k * 1024); } while (0)
#define PG8_LDB(dst, b, h) do { _Pragma("unroll") for (int n = 0; n < 2; ++n) _Pragma("unroll") for (int k = 0; k < 2; ++k) dst[n][k] = *(const PG8_LAS bf16x8*)(lds + PG8_SB(b, h) + boff + n * 2048 + k * 1024); } while (0)
#define PG8_MMA(ai, bj, At, Bt) do { __builtin_amdgcn_s_setprio(1); _Pragma("unroll") for (int m = 0; m < 4; ++m) _Pragma("unroll") for (int n = 0; n < 2; ++n) _Pragma("unroll") for (int k = 0; k < 2; ++k) \
        acc[ai][bj][m][n] = __builtin_amdgcn_mfma_f32_16x16x32_bf16(Bt[n][k], At[m][k], acc[ai][bj][m][n], 0, 0, 0); __builtin_amdgcn_s_setprio(0); } while (0)
#define PG8_WAIT_V(n) asm volatile("s_waitcnt vmcnt(" #n ")" ::: "memory")
#define PG8_WAIT_L(n) asm volatile("s_waitcnt lgkmcnt(" #n ")" ::: "memory")
#define PG8_BAR __builtin_amdgcn_s_barrier()
#define PG8_SCHED __builtin_amdgcn_sched_barrier(0)
    Unit cur, nxt; int ui = 0;
    if (!S.next(0, cur)) return;
    f32x4 acc[2][2][4][2];
#pragma unroll
    for (int a = 0; a < 2; ++a)
#pragma unroll
        for (int b = 0; b < 2; ++b)
#pragma unroll
            for (int m = 0; m < 4; ++m)
#pragma unroll
                for (int n = 0; n < 2; ++n) acc[a][b][m][n] = (f32x4){0.f, 0.f, 0.f, 0.f};
    bf16x8 At[4][2], B0[2][2], B1[2][2];
    const char* cA = (const char*)g.A + (size_t)cur.pm * tstep; const char* cB = (const char*)g.Bt + (size_t)cur.pn * tstep;
    S.a_ready(cur);
    if constexpr (SP2) {
        PG8_STAGE(PG8_SB(0, 0), cB, voffB); PG8_STAGE(PG8_SB(0, 1), cB + hstep, voffB); PG8_STAGE(PG8_SA(0, 0), cA, voffA); PG8_STAGE(PG8_SA(0, 1), cA + hstep, voffA);
        if (wr == 1) PG8_BAR;
        PG8_WAIT_V(2); PG8_BAR;
        PG8_STAGE(PG8_SB(1, 0), cB + kstep, voffB); PG8_STAGE(PG8_SA(1, 0), cA + kstep, voffA); PG8_STAGE(PG8_SB(1, 1), cB + hstep + kstep, voffB);
        PG8_WAIT_V(6); PG8_BAR;
    } else {
        PG8_STAGE(PG8_SB(0, 0), cB, voffB); PG8_STAGE(PG8_SA(0, 0), cA, voffA); PG8_STAGE(PG8_SB(0, 1), cB + hstep, voffB); PG8_STAGE(PG8_SA(0, 1), cA + hstep, voffA);
        if (wr == 1) PG8_BAR;
        PG8_WAIT_V(4); PG8_BAR;
        PG8_STAGE(PG8_SB(1, 0), cB + kstep, voffB); PG8_STAGE(PG8_SA(1, 0), cA + kstep, voffA); PG8_STAGE(PG8_SB(1, 1), cB + hstep + kstep, voffB);
        PG8_WAIT_V(6); PG8_BAR;
    }
    for (;;) {
        const bool has_next = S.next(ui + 1, nxt);
        const char* nA = has_next ? (const char*)g.A + (size_t)nxt.pm * tstep : cA; const char* nB = has_next ? (const char*)g.Bt + (size_t)nxt.pn * tstep : cB;
        for (int t = 0; t < nt; t += 2) {
            const bool last = (t == nt - 2);
            const char* a1 = cA + (size_t)(t + 1) * kstep;
            const char* a2 = last ? nA : cA + (size_t)(t + 2) * kstep; const char* b2 = last ? nB : cB + (size_t)(t + 2) * kstep;
            const char* a3 = a2 + kstep; const char* b3 = b2 + kstep;
            if (last && has_next) S.a_ready(nxt);
            if constexpr (SP2) {
            PG8_LDB(B0, 0, 0); PG8_LDB(B1, 0, 1); PG8_SCHED; PG8_LDA(At, 0, 0); PG8_STAGE(PG8_SA(1, 1), a1 + hstep, voffA);
            PG8_WAIT_V(8); PG8_WAIT_L(0); PG8_BAR; PG8_MMA(0, 0, At, B0); PG8_MMA(0, 1, At, B1); PG8_BAR; PG8_SCHED;
            PG8_LDA(At, 0, 1); PG8_STAGE(PG8_SB(0, 0), b2, voffB); PG8_STAGE(PG8_SB(0, 1), b2 + hstep, voffB); PG8_STAGE(PG8_SA(0, 0), a2, voffA);
            PG8_WAIT_V(8); PG8_WAIT_L(0); PG8_BAR; PG8_MMA(1, 0, At, B0); PG8_MMA(1, 1, At, B1); PG8_BAR; PG8_SCHED;
            PG8_LDB(B0, 1, 0); PG8_LDB(B1, 1, 1); PG8_SCHED; PG8_LDA(At, 1, 0); PG8_STAGE(PG8_SA(0, 1), a2 + hstep, voffA);
            PG8_WAIT_V(8); PG8_WAIT_L(0); PG8_BAR; PG8_MMA(0, 0, At, B0); PG8_MMA(0, 1, At, B1); PG8_BAR; PG8_SCHED;
            PG8_LDA(At, 1, 1); PG8_STAGE(PG8_SB(1, 0), b3, voffB); PG8_STAGE(PG8_SB(1, 1), b3 + hstep, voffB); PG8_STAGE(PG8_SA(1, 0), a3, voffA);
            PG8_WAIT_V(8); PG8_WAIT_L(0); PG8_BAR; PG8_MMA(1, 0, At, B0); PG8_MMA(1, 1, At, B1); PG8_BAR; PG8_SCHED;
            } else {
            PG8_LDB(B0, 0, 0); PG8_SCHED; PG8_LDA(At, 0, 0); PG8_STAGE(PG8_SA(1, 1), a1 + hstep, voffA);
            PG8_WAIT_L(8); PG8_BAR; PG8_WAIT_L(0); PG8_MMA(0, 0, At, B0); PG8_BAR; PG8_SCHED;
            PG8_LDB(B1, 0, 1); PG8_STAGE(PG8_SB(0, 0), b2, voffB);
            PG8_BAR; PG8_WAIT_L(0); PG8_MMA(0, 1, At, B1); PG8_BAR;
            PG8_LDA(At, 0, 1); PG8_STAGE(PG8_SA(0, 0), a2, voffA);
            PG8_BAR; PG8_WAIT_L(0); PG8_MMA(1, 0, At, B0); PG8_BAR; PG8_SCHED;
            PG8_STAGE(PG8_SB(0, 1), b2 + hstep, voffB);
            PG8_WAIT_V(6); PG8_BAR; PG8_MMA(1, 1, At, B1); PG8_BAR;
            PG8_LDB(B0, 1, 0); PG8_SCHED; PG8_LDA(At, 1, 0); PG8_STAGE(PG8_SA(0, 1), a2 + hstep, voffA);
            PG8_WAIT_L(8); PG8_BAR; PG8_WAIT_L(0); PG8_MMA(0, 0, At, B0); PG8_BAR; PG8_SCHED;
            PG8_LDB(B1, 1, 1); PG8_STAGE(PG8_SB(1, 0), b3, voffB);
            PG8_BAR; PG8_WAIT_L(0); PG8_MMA(0, 1, At, B1); PG8_BAR;
            PG8_LDA(At, 1, 1); PG8_STAGE(PG8_SA(1, 0), a3, voffA);
            PG8_BAR; PG8_WAIT_L(0); PG8_MMA(1, 0, At, B0); PG8_BAR; PG8_SCHED;
            PG8_STAGE(PG8_SB(1, 1), b3 + hstep, voffB);
            PG8_WAIT_V(6); PG8_BAR; PG8_MMA(1, 1, At, B1); PG8_BAR;
            }
        }
        PG8_TP(49);
        if constexpr (ALIGN_EPI) { if (wr == 0) PG8_BAR; }
        if constexpr (!Epi::AFTER_DRAIN) { E(acc, cur, wr, wc, fr, fq); S.done(cur); }
        PG8_TP(50);
        if (!has_next) break;
#pragma unroll
        for (int a = 0; a < 2; ++a)
#pragma unroll
            for (int b = 0; b < 2; ++b)
#pragma unroll
                for (int m = 0; m < 4; ++m)
#pragma unroll
                    for (int n = 0; n < 2; ++n) acc[a][b][m][n] = (f32x4){0.f, 0.f, 0.f, 0.f};
        cur = nxt; cA = nA; cB = nB; ++ui;
        if constexpr (ALIGN_EPI) { if (wr == 1) PG8_BAR; }
    }
    PG8_WAIT_V(0);
    if constexpr (!ALIGN_EPI) { if (wr == 0) PG8_BAR; }
    PG8_BAR;
    if constexpr (Epi::AFTER_DRAIN) { E.fused(acc, cur, wr, wc, fr, fq, lds, wid, lane); S.done(cur); }
#undef PG8_SA
#undef PG8_SB
#undef PG8_STAGE
#undef PG8_LDA
#undef PG8_LDB
#undef PG8_MMA
#undef PG8_WAIT_V
#undef PG8_WAIT_L
#undef PG8_BAR
#undef PG8_SCHED
}
}
#include <hip/hip_bf16.h>
#include <cmath>
namespace attn_body {
using bf16=__hip_bfloat16;
using bf16x8=__attribute__((ext_vector_type(8)))short;
using s16x4=__attribute__((ext_vector_type(4)))short;
using f32x16=__attribute__((ext_vector_type(16)))float;
using u32x4=__attribute__((ext_vector_type(4)))unsigned;
constexpr int BATCH=8,NHEAD=8,SEQ=2048,D=64,PITCH=3584,OPITCH=1024,LEADROW=16384,VK=2176;
constexpr int NW=8,QBLK=32,QB=QBLK*NW,KVBLK=64,NQB=SEQ/QB;
constexpr int ATTN_UNIT_ROWS=QB;
__device__ __forceinline__ int crow(int r,int hi){return (r&3)+8*(r>>2)+4*hi;}
#define SBAR() __builtin_amdgcn_sched_barrier(0)
__device__ __forceinline__ void cmask(f32x16&p0,f32x16&p1,int jb,int qrel,int hi){
  const float NEG=-INFINITY; int kb=64*jb+4*hi;
  #pragma unroll
  for(int r=0;r<16;++r){int kv=kb+(r&3)+8*(r>>2); if(kv>qrel)p0[r]=NEG; if(kv+32>qrel)p1[r]=NEG;}
}

constexpr int NSLOT=3, SLOTB=8192;
constexpr int LDS_K=0, LDS_V=NSLOT*SLOTB, LDS_WS=2*NSLOT*SLOTB, LDS_OST=LDS_WS+NW*64*4, LDS_C2=LDS_OST+NW*4096, LDS_BYTES=LDS_C2+VK*4;
constexpr float C2=0.125f*1.4426950408889634f;
__device__ __forceinline__ void glds16(const void*gsrc,unsigned lds_dst){unsigned keep;
  asm volatile("s_mov_b32 %0, m0\n\ts_mov_b32 m0, %2\n\ts_nop 0\n\tglobal_load_lds_dwordx4 %1, off\n\ts_mov_b32 m0, %0":"=&s"(keep):"v"(gsrc),"s"(lds_dst):"memory");}
__device__ __forceinline__ float max3f(float a,float b,float c){float r;asm("v_max3_f32 %0, %1, %2, %3":"=v"(r):"v"(a),"v"(b),"v"(c));return r;}
__device__ __forceinline__ float max2f(float a,float b){float r;asm("v_max_f32_e32 %0, %1, %2":"=v"(r):"v"(a),"v"(b));return r;}
__device__ __forceinline__ float fadd_s(float a,float b){float r;asm("v_add_f32_e32 %0, %1, %2":"=v"(r):"v"(a),"v"(b));return r;}
__device__ __forceinline__ float fsub_s(float a,float b){float r;asm("v_sub_f32_e32 %0, %1, %2":"=v"(r):"v"(a),"v"(b));return r;}
typedef float f32x2_t __attribute__((ext_vector_type(2))); typedef __bf16 bf16x2_t __attribute__((ext_vector_type(2)));
__device__ __forceinline__ unsigned cvtpk_s(float lo,float hi){f32x2_t v={lo,hi};bf16x2_t b=__builtin_convertvector(v,bf16x2_t);return __builtin_bit_cast(unsigned,b);}
#define WAIT_BAR(N) asm volatile("s_waitcnt vmcnt(" #N ") lgkmcnt(0)\n\ts_barrier":::"memory")

__device__ __forceinline__ void qkt(f32x16&p0,f32x16&p1,const char*Kslot,const bf16x8*qr,int r32,int hi){
  const char*kb=Kslot+hi*1024+r32*16;
  #pragma unroll
  for(int d0=0;d0<4;++d0){
    const bf16x8 b0=*reinterpret_cast<const bf16x8*>(kb+d0*2048);
    const bf16x8 b1=*reinterpret_cast<const bf16x8*>(kb+d0*2048+512);
    p0=__builtin_amdgcn_mfma_f32_32x32x16_bf16(b0,qr[d0],p0,0,0,0);p1=__builtin_amdgcn_mfma_f32_32x32x16_bf16(b1,qr[d0],p1,0,0,0);}
}
typedef __attribute__((address_space(3))) const char* lds_cptr;
typedef short v4i16_t __attribute__((ext_vector_type(4)));
__device__ __forceinline__ void kload8(bf16x8*kf,lds_cptr kp){
  kf[0]=*(const __attribute__((address_space(3))) bf16x8*)(kp);      kf[1]=*(const __attribute__((address_space(3))) bf16x8*)(kp+512);
  kf[2]=*(const __attribute__((address_space(3))) bf16x8*)(kp+2048); kf[3]=*(const __attribute__((address_space(3))) bf16x8*)(kp+2560);
  kf[4]=*(const __attribute__((address_space(3))) bf16x8*)(kp+4096); kf[5]=*(const __attribute__((address_space(3))) bf16x8*)(kp+4608);
  kf[6]=*(const __attribute__((address_space(3))) bf16x8*)(kp+6144); kf[7]=*(const __attribute__((address_space(3))) bf16x8*)(kp+6656);
}
__device__ __forceinline__ void kload2(bf16x8*kf,lds_cptr kp,int j){ kf[2*j]=*(const __attribute__((address_space(3))) bf16x8*)(kp+j*2048); kf[2*j+1]=*(const __attribute__((address_space(3))) bf16x8*)(kp+j*2048+512); }
__device__ __forceinline__ s16x4 vtr(lds_cptr p){ return __builtin_bit_cast(s16x4,__builtin_amdgcn_ds_read_tr16_b64_v4i16((__attribute__((address_space(3))) v4i16_t*)p)); }
__device__ __forceinline__ float rowmax(const f32x16&p0,const f32x16&p1){
  float a=max3f(p0[0],p0[1],p1[0]),b=max3f(p0[2],p0[3],p1[1]);a=max3f(a,p1[2],p1[3]);
  #pragma unroll
  for(int r=4;r<16;r+=4){a=max3f(a,p0[r],p0[r+1]);b=max3f(b,p0[r+2],p0[r+3]);a=max3f(a,p1[r],p1[r+1]);b=max3f(b,p1[r+2],p1[r+3]);}
  const float m=max2f(a,b);
  auto rr=__builtin_amdgcn_permlane32_swap(__float_as_uint(m),__float_as_uint(m),false,false);
  return max2f(__uint_as_float(rr[0]),__uint_as_float(rr[1]));
}
__device__ __forceinline__ void pv(f32x16*o,int vb,bf16x8 pa0,bf16x8 pa1,bf16x8 pa2,bf16x8 pa3){
  #pragma unroll
  for(int d0=0;d0<2;++d0){s16x4 lo[4],hi[4];
    #pragma unroll
    for(int ks=0;ks<4;++ks){
      asm volatile("ds_read_b64_tr_b16 %0,%1 offset:%c2":"=&v"(lo[ks]):"v"(vb),"i"(d0*4096+ks*1024):"memory");
      asm volatile("ds_read_b64_tr_b16 %0,%1 offset:%c2":"=&v"(hi[ks]):"v"(vb),"i"(d0*4096+ks*1024+512):"memory");}
    asm volatile("s_waitcnt lgkmcnt(0)":::"memory");SBAR();
    #define PK(k) (bf16x8){lo[k][0],lo[k][1],lo[k][2],lo[k][3],hi[k][0],hi[k][1],hi[k][2],hi[k][3]}
    o[d0]=__builtin_amdgcn_mfma_f32_32x32x16_bf16(pa0,PK(0),o[d0],0,0,0);
    o[d0]=__builtin_amdgcn_mfma_f32_32x32x16_bf16(pa1,PK(1),o[d0],0,0,0);
    o[d0]=__builtin_amdgcn_mfma_f32_32x32x16_bf16(pa2,PK(2),o[d0],0,0,0);
    o[d0]=__builtin_amdgcn_mfma_f32_32x32x16_bf16(pa3,PK(3),o[d0],0,0,0);
    #undef PK
  }
}

#ifndef ATTN_STORE16
#define ATTN_STORE16(p,v) (*(u32x4*)(p)=(v))
#endif
template<int THRL> __device__ __forceinline__ void attn_unit(int b,int h,int qb,const bf16*Q,const bf16*__restrict__ K,const bf16*__restrict__ V,const bf16*__restrict__ OG,const float*__restrict__ c2v,bf16*O,char*shm,const int wave_s,const bool stage_c2=true){
  int tid_=wave_s*64+lane_id(); asm volatile("":"+v"(tid_));
  const int tid=tid_,lane=tid&63,r32=lane&31,hi=lane>>5; const int wid=wave_s;
  const long rowbase=(long)b*SEQ; const int q0=qb*QB;
  const bf16*Qw=Q+(rowbase+q0+wid*QBLK)*PITCH+h*D;
  const bf16*Kh=K+(rowbase-2*KVBLK)*PITCH+h*D,*Vh=V+(rowbase-2*KVBLK)*PITCH+h*D;
  const bf16*KhL=K+(long)LEADROW*PITCH+h*D,*VhL=V+(long)LEADROW*PITCH+h*D;
  const unsigned lds0=(unsigned)(uintptr_t)shm;
  float*wsf=(float*)(shm+LDS_WS)+wid*64;
  const bf16*ksrc=Kh+(long)lane*PITCH+wid*8,*ksrcL=KhL+(long)lane*PITCH+wid*8;
  const bf16*vsrc=Vh+(long)(16*(wid&3)+(lane>>2))*PITCH+(wid>>2)*32+(lane&3)*8,*vsrcL=VhL+(long)(16*(wid&3)+(lane>>2))*PITCH+(wid>>2)*32+(lane&3)*8;
  const unsigned kdst=lds0+LDS_K+wid*1024, vdst=lds0+LDS_V+wid*1024;
  #define DMA_K(t,slot) glds16(((t)<2?ksrcL:ksrc)+(long)(t)*KVBLK*PITCH,(unsigned)__builtin_amdgcn_readfirstlane(kdst+(slot)))
  #define DMA_V(t,slot) glds16(((t)<2?vsrcL:vsrc)+(long)(t)*KVBLK*PITCH,(unsigned)__builtin_amdgcn_readfirstlane(vdst+(slot)))
  const int vb0=(int)(lds0+LDS_V)+((lane>>4)&1)*32+(lane&3)*8+(4*hi+((lane&15)>>2))*64;
  const char*Kbase=shm+LDS_K; bf16x8 kf[8];
  const lds_cptr shm3=(lds_cptr)shm; const lds_cptr kp0=shm3+LDS_K+hi*1024+r32*16; const lds_cptr vp0=shm3+LDS_V+((lane>>4)&1)*32+(lane&3)*8+(4*hi+((lane&15)>>2))*64;
  const int NT=(q0+QB)/KVBLK+2;
  if(stage_c2){ __attribute__((address_space(3))) float*negc_w=(__attribute__((address_space(3))) float*)((lds_cptr)shm+LDS_C2); const float*cs=c2v+(long)(b*NHEAD+h)*VK;
    float cv_[5];
    _Pragma("unroll") for(int i_=0;i_<5;++i_){const int i=tid+i_*NW*64; cv_[i_]=i<NT*KVBLK?cs[i]:0.f;}
    _Pragma("unroll") for(int i_=0;i_<5;++i_){const int i=tid+i_*NW*64; if(i<NT*KVBLK)negc_w[i]=-cv_[i_];} }
  const __attribute__((address_space(3))) float* negc3=(const __attribute__((address_space(3))) float*)((lds_cptr)shm+LDS_C2)+4*hi;
  typedef float f32x4_t __attribute__((ext_vector_type(4)));
  #define NEGC(t,i) (*(const __attribute__((address_space(3))) f32x4_t*)(negc3+64*(t)+(((i)>>2)*32)+8*((i)&3)))
  DMA_K(0,0);DMA_V(0,0);DMA_K(1,SLOTB);
  bf16x8 qr[4];
  #pragma unroll
  for(int d0=0;d0<4;++d0)qr[d0]=*reinterpret_cast<const bf16x8*>(&Qw[(long)r32*PITCH+d0*16+hi*8]);
  float mhat=0.f,l_reg=0.f;f32x16 o[2];o[0]=f32x16{};o[1]=f32x16{};
  const int qrel=wid*QBLK+r32;
  #define CMASK(P0,P1,t) do{int jb_=(t)-(NT-4); if(jb_>=0)cmask(P0,P1,jb_,qrel,hi);}while(0)
  bool resc=false;
  #define START(P0,P1) do{ const float rm=rowmax(P0,P1); resc=false; \
    { const float dl=rm; mhat=fadd_s(mhat,dl); \
      _Pragma("unroll") for(int r=0;r<16;++r){P0[r]=fsub_s(P0[r],dl);P1[r]=fsub_s(P1[r],dl);} } \
    _Pragma("unroll") for(int r=0;r<16;++r)P0[r]=__builtin_amdgcn_exp2f(P0[r]); }while(0)
  #define RESC() do{ if(resc){ asm volatile("s_waitcnt lgkmcnt(0)":::"memory"); \
      _Pragma("unroll") for(int d_=0;d_<2;++d_) _Pragma("unroll") for(int r=0;r<16;++r)o[d_][r]*=wsf[crow(r,hi)]; } }while(0)
  f32x16 pA0,pA1,pB0,pB1;
  int sl_prev=0,sl_cur=0,sl_next=SLOTB;
  #define ROT() do{sl_prev=sl_cur;sl_cur=sl_next;sl_next=(sl_next==(NSLOT-1)*SLOTB)?0:sl_next+SLOTB;}while(0)
  DMA_K(2,2*SLOTB);
  WAIT_BAR(3);
  #define FILLT(P0,P1,t) do{ _Pragma("unroll") for(int i_=0;i_<4;++i_){ const f32x4_t a_=NEGC(t,i_),b_=NEGC(t,4+i_); \
      P0[4*i_]=a_[0]-mhat;P0[4*i_+1]=a_[1]-mhat;P0[4*i_+2]=a_[2]-mhat;P0[4*i_+3]=a_[3]-mhat; P1[4*i_]=b_[0]-mhat;P1[4*i_+1]=b_[1]-mhat;P1[4*i_+2]=b_[2]-mhat;P1[4*i_+3]=b_[3]-mhat; } }while(0)
  FILLT(pA0,pA1,0);
  qkt(pA0,pA1,Kbase,qr,r32,hi);asm volatile("s_nop 15\n\ts_nop 7":"+v"(pA0),"+v"(pA1));CMASK(pA0,pA1,0);
  START(pA0,pA1);
  FILLT(pB0,pB1,1);
  _Pragma("unroll") for(int r=0;r<16;++r)pA1[r]=__builtin_amdgcn_exp2f(pA1[r]);
  WAIT_BAR(0);
  DMA_K(3,0);DMA_V(1,SLOTB);
  ROT();
  kload8(kf,kp0+sl_cur);
  WAIT_BAR(2);
  s16x4 vlo[8],vhi[8]; u32x4 pw0,pw1,pw2,pw3;
  #define PKW(P,B) cvtpk_s(P[B],P[B+1])
  #define PAF(k) __builtin_bit_cast(bf16x8,pw##k)
  #define VFR(i) (bf16x8){vlo[i][0],vlo[i][1],vlo[i][2],vlo[i][3],vhi[i][0],vhi[i][1],vhi[i][2],vhi[i][3]}
  #define PIN(x) asm volatile("":"+v"(x))
  #define MX3(a,b,c) __builtin_fmaxf(__builtin_fmaxf((a),(b)),(c))
  #define GAPA(MF,A0,A1,A2,A3,W0,W1,PW) do{ MF; sacc+=A0; sacc+=A1; sacc+=A2; sacc+=A3; PIN(sacc); W0; W1; PIN(PW); SBAR(); }while(0)
  #define EX(v) __builtin_amdgcn_exp2f(v)
  #define GAPB(MF,X,B,FP,FB,I,t,GF) do{ MF; X[B]=EX(X[B]); X[B+1]=EX(X[B+1]); X[B+2]=EX(X[B+2]); X[B+3]=EX(X[B+3]); \
      if(GF){ FP[FB]=fsub_s(cn_[0],mhat); FP[FB+1]=fsub_s(cn_[1],mhat); FP[FB+2]=fsub_s(cn_[2],mhat); FP[FB+3]=fsub_s(cn_[3],mhat); PIN(FP); if((I)<7){cn_=NEGC((t)+1,(I)+1);} } \
      PIN(X); SBAR(); }while(0)
  #define VRD(i) do{ vlo[i]=vtr(vp_+(((i)>>2)*4096+((i)&3)*1024)); vhi[i]=vtr(vp_+(((i)>>2)*4096+((i)&3)*1024+512)); }while(0)
  #define KRD(G,j) do{ if(G){ kload2(kf,kp0+sl_next,j); SBAR(); } }while(0)
  #define STEP(C0,C1,P0,P1,t,GK,GV,GL) do{ SBAR(); \
    const lds_cptr vp_=vp0+sl_prev; \
    VRD(0); SBAR(); float sacc=(P0[0]+P0[1]); \
    GAPA(C0=__builtin_amdgcn_mfma_f32_32x32x16_bf16(kf[0],qr[0],C0,0,0,0), P0[2],P0[3],P0[4],P0[5],     pw0[0]=PKW(P0,0), pw0[1]=PKW(P0,2), pw0); \
    VRD(4); SBAR(); GAPA(C1=__builtin_amdgcn_mfma_f32_32x32x16_bf16(kf[1],qr[0],C1,0,0,0), P0[6],P0[7],P0[8],P0[9],     pw0[2]=PKW(P0,4), pw0[3]=PKW(P0,6), pw0); \
    VRD(1); SBAR(); GAPA(C0=__builtin_amdgcn_mfma_f32_32x32x16_bf16(kf[2],qr[1],C0,0,0,0),   P0[10],P0[11],P0[12],P0[13], pw1[0]=PKW(P0,8), pw1[1]=PKW(P0,10), pw1); \
    VRD(5); SBAR(); GAPA(C1=__builtin_amdgcn_mfma_f32_32x32x16_bf16(kf[3],qr[1],C1,0,0,0),   P0[14],P0[15],P1[0],P1[1],   pw1[2]=PKW(P0,12),pw1[3]=PKW(P0,14), pw1); \
    VRD(2); SBAR(); GAPA(C0=__builtin_amdgcn_mfma_f32_32x32x16_bf16(kf[4],qr[2],C0,0,0,0),   P1[2],P1[3],P1[4],P1[5],     pw2[0]=PKW(P1,0), pw2[1]=PKW(P1,2), pw2); \
    VRD(6); SBAR(); GAPA(C1=__builtin_amdgcn_mfma_f32_32x32x16_bf16(kf[5],qr[2],C1,0,0,0),   P1[6],P1[7],P1[8],P1[9],     pw2[2]=PKW(P1,4), pw2[3]=PKW(P1,6), pw2); \
    VRD(3); SBAR(); GAPA(C0=__builtin_amdgcn_mfma_f32_32x32x16_bf16(kf[6],qr[3],C0,0,0,0),   P1[10],P1[11],P1[12],P1[13], pw3[0]=PKW(P1,8), pw3[1]=PKW(P1,10), pw3); \
    VRD(7); SBAR(); GAPA(C1=__builtin_amdgcn_mfma_f32_32x32x16_bf16(kf[7],qr[3],C1,0,0,0),   P1[14],P1[15],0.f,0.f,       pw3[2]=PKW(P1,12),pw3[3]=PKW(P1,14), pw3); \
    l_reg+=sacc; \
    if(GK){DMA_K((t)+3,sl_cur);} if(GV){DMA_V((t)+1,sl_next);} \
    CMASK(C0,C1,t); \
    { float a=MX3(C0[0],C0[1],C1[0]),b=MX3(C0[2],C0[3],C1[1]); a=MX3(a,C1[2],C1[3]); \
      _Pragma("unroll") for(int r=4;r<16;r+=4){a=MX3(a,C0[r],C0[r+1]);b=MX3(b,C0[r+2],C0[r+3]);a=MX3(a,C1[r],C1[r+1]);b=MX3(b,C1[r+2],C1[r+3]);} \
      float rm=__builtin_fmaxf(a,b); { auto rr=__builtin_amdgcn_permlane32_swap(__float_as_uint(rm),__float_as_uint(rm),false,false); rm=__builtin_fmaxf(__uint_as_float(rr[0]),__uint_as_float(rr[1])); } \
      resc=false; \
      if(__builtin_expect(__any(rm>(float)THRL),0)){ const float dl=__builtin_fmaxf(rm,0.f); mhat+=dl; \
        _Pragma("unroll") for(int r=0;r<16;++r){C0[r]-=dl;C1[r]-=dl;} \
        const float f=__builtin_amdgcn_exp2f(-dl); l_reg*=f; if(hi==0)wsf[r32]=f; resc=true; } } \
    f32x4_t cn_=(f32x4_t){0.f,0.f,0.f,0.f}; if(GL){cn_=NEGC((t)+1,0);} \
    SBAR(); \
    GAPB(o[0]=__builtin_amdgcn_mfma_f32_32x32x16_bf16(PAF(0),VFR(0),o[0],0,0,0), C0,0,P0,0,0,t,GL); \
    GAPB(o[1]=__builtin_amdgcn_mfma_f32_32x32x16_bf16(PAF(0),VFR(4),o[1],0,0,0), C0,4,P0,4,1,t,GL); \
    KRD(GL,0); GAPB(o[0]=__builtin_amdgcn_mfma_f32_32x32x16_bf16(PAF(1),VFR(1),o[0],0,0,0), C0,8,P0,8,2,t,GL); \
    KRD(GL,1); GAPB(o[1]=__builtin_amdgcn_mfma_f32_32x32x16_bf16(PAF(1),VFR(5),o[1],0,0,0), C0,12,P0,12,3,t,GL); \
    KRD(GL,2); GAPB(o[0]=__builtin_amdgcn_mfma_f32_32x32x16_bf16(PAF(2),VFR(2),o[0],0,0,0), C1,0,P1,0,4,t,GL); \
    KRD(GL,3); GAPB(o[1]=__builtin_amdgcn_mfma_f32_32x32x16_bf16(PAF(2),VFR(6),o[1],0,0,0), C1,4,P1,4,5,t,GL); \
    GAPB(o[0]=__builtin_amdgcn_mfma_f32_32x32x16_bf16(PAF(3),VFR(3),o[0],0,0,0), C1,8,P1,8,6,t,GL); \
    GAPB(o[1]=__builtin_amdgcn_mfma_f32_32x32x16_bf16(PAF(3),VFR(7),o[1],0,0,0), C1,12,P1,12,7,t,GL); \
    }while(0)
  int t=1;
  #undef CMASK
  #define CMASK(P0,P1,t) do{}while(0)
  for(;t+5<NT;t+=2){
    STEP(pB0,pB1,pA0,pA1,t,true,true,true);     WAIT_BAR(2); RESC(); ROT();
    STEP(pA0,pA1,pB0,pB1,t+1,true,true,true);   WAIT_BAR(2); RESC(); ROT();
  }
  #undef CMASK
  #define CMASK(P0,P1,t) do{int jb_=(t)-(NT-4); if(jb_>=0)cmask(P0,P1,jb_,qrel,hi);}while(0)
  #define ENDW(tt) do{ if((tt)+3<NT){WAIT_BAR(2);} else if((tt)+2<NT){WAIT_BAR(1);} else {WAIT_BAR(0);} }while(0)
  for(;t+1<NT;t+=2){
    STEP(pB0,pB1,pA0,pA1,t,(t+3<NT),(t+1<NT),(t+1<NT));       ENDW(t);   RESC(); ROT();
    STEP(pA0,pA1,pB0,pB1,t+1,(t+4<NT),(t+2<NT),(t+2<NT));     ENDW(t+1); RESC(); ROT();
  }
  STEP(pB0,pB1,pA0,pA1,NT-1,false,false,false); RESC();
  { float sacc=pB0[0]+pB0[1]; _Pragma("unroll") for(int r=2;r<16;++r)sacc+=pB0[r]; _Pragma("unroll") for(int r=0;r<16;++r)sacc+=pB1[r]; l_reg+=sacc;
    pw0=(u32x4){PKW(pB0,0),PKW(pB0,2),PKW(pB0,4),PKW(pB0,6)};pw1=(u32x4){PKW(pB0,8),PKW(pB0,10),PKW(pB0,12),PKW(pB0,14)};pw2=(u32x4){PKW(pB1,0),PKW(pB1,2),PKW(pB1,4),PKW(pB1,6)};pw3=(u32x4){PKW(pB1,8),PKW(pB1,10),PKW(pB1,12),PKW(pB1,14)};
    SBAR(); pv(o,vb0+sl_cur,PAF(0),PAF(1),PAF(2),PAF(3)); }
  #undef PKW
  #undef PAF
  #undef VFR
  #undef PIN
  #undef MX3
  #undef GAPA
  #undef GAPB
  #undef EX
  #undef VRD
  #undef KRD
  #undef STEP
  #undef ENDW
  {auto rr=__builtin_amdgcn_permlane32_swap(__float_as_uint(l_reg),__float_as_uint(l_reg),false,false);l_reg=__uint_as_float(rr[0])+__uint_as_float(rr[1]);}
  if(hi==0)wsf[32+r32]=l_reg;asm volatile("s_waitcnt lgkmcnt(0)":::"memory");
  float rli[16];
  #pragma unroll
  for(int r=0;r<16;++r)rli[r]=__builtin_amdgcn_rcpf(wsf[32+crow(r,hi)]);
  bf16*Ow=O+(rowbase+q0+wid*QBLK)*OPITCH+h*D; const bf16*Gw=OG+(rowbase+q0+wid*QBLK)*PITCH+h*D;
  u32x4 gg[4];
  #pragma unroll
  for(int i=0;i<4;++i){const int row=i*8+(lane>>3),ch=lane&7; gg[i]=*(const u32x4*)(Gw+(long)row*PITCH+ch*8);}
  { bf16*stg=(bf16*)(shm+LDS_OST)+wid*2048;
    #pragma unroll
    for(int r=0;r<16;++r){const int orow=crow(r,hi);
      #pragma unroll
      for(int d0=0;d0<2;++d0)stg[orow*64+d0*32+r32]=__float2bfloat16(o[d0][r]*rli[r]);}
    asm volatile("s_waitcnt lgkmcnt(0)":::"memory");
    #pragma unroll
    for(int i=0;i<4;++i){const int row=i*8+(lane>>3),ch=lane&7; u32x4 v=*(const u32x4*)(stg+row*64+ch*8);
      #pragma unroll
      for(int w=0;w<4;++w){ const float o0=__uint_as_float(v[w]<<16),o1=__uint_as_float(v[w]&0xffff0000u),g0=__uint_as_float(gg[i][w]<<16),g1=__uint_as_float(gg[i][w]&0xffff0000u);
        v[w]=cvtpk_s(o0*__builtin_amdgcn_rcpf(1.f+__builtin_amdgcn_exp2f(-1.4426950408889634f*g0)),o1*__builtin_amdgcn_rcpf(1.f+__builtin_amdgcn_exp2f(-1.4426950408889634f*g1))); }
      ATTN_STORE16(Ow+(long)row*OPITCH+ch*8,v);} }
  asm volatile("s_waitcnt lgkmcnt(0)\n\ts_barrier":::"memory");
  #undef DMA_K
  #undef NEGC
  #undef FILLT
  #undef DMA_V
  #undef CMASK
  #undef START
  #undef RESC
  #undef ROT
}
constexpr int ATTN_LDS_BYTES=LDS_BYTES;
struct AttnTensors { const bf16* Q; const bf16* K; const bf16* V; const bf16* OG; const float* c2v; bf16* O; };
struct AttnUnit { int bh; int qb; };
struct StaticOrder {
  int vcu, G, blk;
  __device__ __forceinline__ explicit StaticOrder(int grid,int block):vcu((grid%8==0)?(block%8)*(grid/8)+block/8:block),G(grid),blk(block){}
  __device__ __forceinline__ bool next(int i,AttnUnit&u)const{
    if(G==256){ if(blk<64){ if(i>=1)return false; u.bh=blk; u.qb=0; return true; } const int j=blk-64,g=j>>6; u.bh=j&63;
      if(g==0){ if(i>=2)return false; u.qb=i?3:7; } else if(g==1){ if(i>=2)return false; u.qb=i?4:6; } else { if(i>=3)return false; u.qb=i==0?5:3-i; }
      return true; }
    const int pair=vcu+(i>>1)*G; if(pair>=BATCH*NHEAD*4)return false; const int s=pair&3; u.bh=pair>>2; u.qb=(i&1)?s:7-s; return true; }
  __device__ __forceinline__ void a_ready(const AttnUnit&)const{}
  __device__ __forceinline__ void done(const AttnUnit&)const{}
};
template<class Sched,int THRL=8> __device__ __forceinline__ void attn_phase(char*lds,const AttnTensors&T,const Sched&S,const int wave_s){
  AttnUnit u;
  int pbh=-1,pqb=-1;
  for(int i=0;S.next(i,u);++i){ S.a_ready(u); attn_unit<THRL>(u.bh/NHEAD,u.bh%NHEAD,u.qb,T.Q,T.K,T.V,T.OG,T.c2v,T.O,lds,wave_s,!(u.bh==pbh&&u.qb<=pqb)); if(u.bh!=pbh||u.qb>pqb){pbh=u.bh;pqb=u.qb;} S.done(u); }
}
#undef SBAR
#undef WAIT_BAR
}
#define GAS __attribute__((address_space(1)))
#define LAS __attribute__((address_space(3)))
typedef unsigned short bf16;
typedef unsigned v4u __attribute__((ext_vector_type(4)));
typedef float f32x4 __attribute__((ext_vector_type(4)));
typedef short bf16x8 __attribute__((ext_vector_type(8)));
typedef GAS unsigned gu32;
typedef GAS unsigned long long gu64;
#define RLX_AGENT __ATOMIC_RELAXED, __HIP_MEMORY_SCOPE_AGENT
#define LDS_WAIT() asm volatile("s_waitcnt lgkmcnt(0)" ::: "memory")
#define VM_WAIT() asm volatile("s_waitcnt vmcnt(0)" ::: "memory")
#define XB_TMO      128
#define XB_XCNT(j)  (256  + 64 * (j))
#define XB_XSUB(j)  (1280 + 64 * (j))
#define XB_XGEN(j)  (2304 + 64 * (j))
#define XB_TOP      3328
#define XB_TOPGEN   3392
#define XCD_BAR_WORDS 3456
#define XB_SPIN_CAP (1u << 18)

__device__ __forceinline__ unsigned xb_ld(unsigned* p)              { return __hip_atomic_load(p, __ATOMIC_RELAXED, __HIP_MEMORY_SCOPE_AGENT); }
__device__ __forceinline__ unsigned xb_add(unsigned* p, unsigned v) { return __hip_atomic_fetch_add(p, v, __ATOMIC_RELAXED, __HIP_MEMORY_SCOPE_AGENT); }
__device__ __forceinline__ unsigned xb_xcc_id() { return (unsigned)__builtin_amdgcn_s_getreg((3 << 11) | 20) & 0xFu; }
#define XB_SPIN(cond, bar) do { unsigned _sp = 0; while (cond) { __builtin_amdgcn_s_sleep(1); \
    if ((++_sp & 255u) == 0u) { if (xb_ld(&(bar)[XB_TMO])) break; if (_sp > XB_SPIN_CAP) { atomicAdd(&(bar)[XB_TMO], 1u); break; } } } } while (0)

struct XcdBarrier {
    unsigned* bar; unsigned x;
    volatile LAS unsigned* st;
};

__device__ __forceinline__ XcdBarrier xcd_barrier_post(unsigned* bar, volatile LAS unsigned* st) {
    XcdBarrier b; b.bar = bar; b.x = xb_xcc_id(); b.st = st;
    if (threadIdx.x == 0) (void)xb_add(&bar[XB_XCNT(b.x)], 1u);
    return b;
}
__device__ __forceinline__ void xcd_barrier_complete(unsigned* bar, unsigned x, unsigned& nloc, unsigned& nx) {
    const unsigned G = gridDim.x * gridDim.y * gridDim.z;
    unsigned sum, cnt, mine, sp = 0u;
    for (;;) {
        sum = 0u; cnt = 0u; mine = 0u;
#pragma unroll
        for (unsigned j = 0; j < 16; ++j) { const unsigned c = xb_ld(&bar[XB_XCNT(j)]); sum += c; cnt += (c > 0u) ? 1u : 0u; mine = (j == x) ? c : mine; }
        if (sum == G) break;
        __builtin_amdgcn_s_sleep(1);
        if ((++sp & 255u) == 0u) { if (xb_ld(&bar[XB_TMO])) break; if (sp > XB_SPIN_CAP) { atomicAdd(&bar[XB_TMO], 1u); break; } }
    }
    nloc = mine > 0u ? mine : 1u; nx = cnt > 0u ? cnt : 1u;
}

__device__ __forceinline__ void xcd_barrier(const XcdBarrier& b, const int wave_s) {
    asm volatile("s_waitcnt vmcnt(0)" ::: "memory");
    __syncthreads();
    if (wave_s == 0 && lane_id() == 0) {
        int z0_ = 0; asm volatile("" : "+s"(z0_));
        unsigned* bar = b.bar + z0_;
        __builtin_amdgcn_s_waitcnt(0);
        unsigned nloc = b.st[0], nx = b.st[1];
        if (nloc == 0u) { xcd_barrier_complete(bar, b.x, nloc, nx); b.st[0] = nloc; b.st[1] = nx; }
        const unsigned old = xb_add(&bar[XB_XSUB(b.x)], 1u);
        const unsigned gen = old / nloc;
        if (old + 1u == (gen + 1u) * nloc) {
            __builtin_amdgcn_fence(__ATOMIC_RELEASE, "agent");
            asm volatile("s_waitcnt vmcnt(0)" ::: "memory");
            const unsigned og = xb_add(&bar[XB_TOP], 1u);
            const unsigned tg = og / nx;
            if (og + 1u == (tg + 1u) * nx) xb_add(&bar[XB_TOPGEN], 1u);
            else XB_SPIN(xb_ld(&bar[XB_TOPGEN]) == tg, bar);
            __builtin_amdgcn_fence(__ATOMIC_ACQUIRE, "agent");
            xb_add(&bar[XB_XGEN(b.x)], 1u);
            asm volatile("s_waitcnt vmcnt(0)" ::: "memory");
        } else {
            XB_SPIN(xb_ld(&bar[XB_XGEN(b.x)]) == gen, bar);
            __builtin_amdgcn_fence(__ATOMIC_ACQUIRE, "agent");
            asm volatile("s_waitcnt vmcnt(0)" ::: "memory");
        }
    }
    __syncthreads();
}

constexpr int NWAVES = 8;
constexpr int RING_BYTES = 131072;
constexpr int LDS_BYTES = 163840;
constexpr int LDSCTL_OFF = LDS_BYTES - 1024, MISC_OFF = LDSCTL_OFF + 320;
constexpr int HALO_OFF = RING_BYTES;
constexpr int RSTD_OFF = HALO_OFF + 8192;
static_assert(RSTD_OFF + 6 * 1024 + 4096 <= LDSCTL_OFF, "LDS map");
constexpr int CW_BAR = 4096;

struct Args { const float* in[24]; float* out; unsigned char* ws; };

template <bool AF32, class F>
__device__ __forceinline__ void meta_gemm(const void* A, int lda, const bf16_t* Wt, int N, int K, int bid, int G, int wave, int lane, float* red, const F& f) {
    const int fr = lane & 15, fq = lane >> 4, kw = K / NWAVES;
    for (int cb = bid; cb < N / 16; cb += G) {
        f32x4 acc = (f32x4){0.f, 0.f, 0.f, 0.f}; float ss = 0.f;
        const bf16_t* bp = Wt + (size_t)(cb * 16 + fr) * K + wave * kw + 8 * fq;
#pragma unroll
        for (int k = 0; k < kw; k += 32) {
            bf16x8 a;
            if (AF32) {
                const float* ap = (const float*)A + (size_t)fr * lda + wave * kw + k + 8 * fq;
                const f32x4 a0 = *(const f32x4*)ap, a1 = *(const f32x4*)(ap + 4);
                ss += ((a0.x * a0.x + a0.y * a0.y) + (a0.z * a0.z + a0.w * a0.w)) + ((a1.x * a1.x + a1.y * a1.y) + (a1.z * a1.z + a1.w * a1.w));
                u32x4 w; w.x = pk2bf(a0.x, a0.y); w.y = pk2bf(a0.z, a0.w); w.z = pk2bf(a1.x, a1.y); w.w = pk2bf(a1.z, a1.w);
                a = __builtin_bit_cast(bf16x8, w);
            } else a = *(const bf16x8*)((const bf16_t*)A + (size_t)fr * lda + wave * kw + k + 8 * fq);
            const bf16x8 b = *(const bf16x8*)(bp + k);
            acc = __builtin_amdgcn_mfma_f32_16x16x32_bf16(a, b, acc, 0, 0, 0);
        }
        float* rw = red + (wave * 64 + lane) * 5;
        rw[0] = acc[0]; rw[1] = acc[1]; rw[2] = acc[2]; rw[3] = acc[3]; rw[4] = ss;
        __syncthreads();
        if (wave == 0) {
            f32x4 t = (f32x4){0.f, 0.f, 0.f, 0.f}; float s2 = 0.f;
#pragma unroll
            for (int w = 0; w < NWAVES; ++w) { const float* r_ = red + (w * 64 + lane) * 5; t[0] += r_[0]; t[1] += r_[1]; t[2] += r_[2]; t[3] += r_[3]; s2 += r_[4]; }
            float rstd = 1.f;
            if (AF32) { s2 = add_xor16(s2); s2 = add_xor32(s2); rstd = 1.0f / sqrtf(s2 * (1.f / DM) + 1e-6f); }
#pragma unroll
            for (int r = 0; r < 4; ++r) { const int row = 4 * fq + r; const float rs = AF32 ? __int_as_float(__builtin_amdgcn_ds_bpermute(row << 2, __float_as_int(rstd))) : 1.f; f(row, cb * 16 + fr, t[r] * rs); }
        }
        __syncthreads();
    }
}
struct MEpi1 { bf16_t* p; float* pn;
    __device__ __forceinline__ void operator()(int r, int col, float v) const {
        const int row = MROWS + r; const int g = col >> 9, c_ = col & 255;
        if (g < 7) p[(size_t)row * PBW + (col & ~255) + ((c_ >> 5) & 3) * 64 + (c_ >> 7) * 32 + PERM32(c_ & 31)] = f2bf(v);
        else { const int o = col & 511; if (o < 296) pn[(size_t)row * PNW + o] = v; } } };
struct MEpiRes { float* hm; __device__ __forceinline__ void operator()(int r, int col, float v) const { float* h = hm + r * DM + (col & ~31) + PERM32(col & 31); *h = *h + v; } };
struct MEpi3 { float* rawm;
    __device__ __forceinline__ void operator()(int r, int col, float v) const { const int t = col >> 8, c = col & 255; rawm[(size_t)r * DFF2 + (c < 128 ? 128 * t + c : DFF + 128 * t + (c - 128))] = v; } };

__device__ __forceinline__ void meta_gemm3(const float* hm, const bf16_t* W3, int bid, int G, int wave, int lane, int tid, float* red, float* rug, const float* cw, const float* cb, float* rawm, bf16_t* am) {
    const int fr = lane & 15, fq = lane >> 4; constexpr int kw = DM / NWAVES;
    const int pb0 = G == 256 ? 128 : 0, pst = G == 256 ? 128 : G;
    for (int pr = bid - pb0; pr >= 0 && pr < DFF / 16; pr += pst) {
        const int t = pr >> 3, kk = pr & 7, cbu = 16 * t + kk;
        f32x4 au = (f32x4){0.f, 0.f, 0.f, 0.f}, ag = au; float ss = 0.f;
        const bf16_t* bpu = W3 + (size_t)(cbu * 16 + fr) * DM + wave * kw + 8 * fq; const bf16_t* bpg = bpu + (size_t)128 * DM;
#pragma unroll
        for (int k = 0; k < kw; k += 32) {
            const float* ap = hm + (size_t)fr * DM + wave * kw + k + 8 * fq;
            const f32x4 a0 = *(const f32x4*)ap, a1 = *(const f32x4*)(ap + 4);
            ss += ((a0.x * a0.x + a0.y * a0.y) + (a0.z * a0.z + a0.w * a0.w)) + ((a1.x * a1.x + a1.y * a1.y) + (a1.z * a1.z + a1.w * a1.w));
            u32x4 w; w.x = pk2bf(a0.x, a0.y); w.y = pk2bf(a0.z, a0.w); w.z = pk2bf(a1.x, a1.y); w.w = pk2bf(a1.z, a1.w);
            const bf16x8 a = __builtin_bit_cast(bf16x8, w);
            au = __builtin_amdgcn_mfma_f32_16x16x32_bf16(a, *(const bf16x8*)(bpu + k), au, 0, 0, 0);
            ag = __builtin_amdgcn_mfma_f32_16x16x32_bf16(a, *(const bf16x8*)(bpg + k), ag, 0, 0, 0);
        }
        float* rw = red + (wave * 64 + lane) * 9;
        rw[0] = au[0]; rw[1] = au[1]; rw[2] = au[2]; rw[3] = au[3]; rw[4] = ag[0]; rw[5] = ag[1]; rw[6] = ag[2]; rw[7] = ag[3]; rw[8] = ss;
        __syncthreads();
        if (wave == 0) {
            f32x4 tu = (f32x4){0.f, 0.f, 0.f, 0.f}, tg = tu; float s2 = 0.f;
#pragma unroll
            for (int w = 0; w < NWAVES; ++w) { const float* r_ = red + (w * 64 + lane) * 9; tu[0] += r_[0]; tu[1] += r_[1]; tu[2] += r_[2]; tu[3] += r_[3]; tg[0] += r_[4]; tg[1] += r_[5]; tg[2] += r_[6]; tg[3] += r_[7]; s2 += r_[8]; }
            s2 = add_xor16(s2); s2 = add_xor32(s2); const float rstd = 1.0f / sqrtf(s2 * (1.f / DM) + 1e-6f);
#pragma unroll
            for (int r = 0; r < 4; ++r) { const int row = 4 * fq + r; const float rs = __int_as_float(__builtin_amdgcn_ds_bpermute(row << 2, __float_as_int(rstd)));
                const float vu = tu[r] * rs, vg = tg[r] * rs; rug[row * 16 + fr] = vu; rug[256 + row * 16 + fr] = vg;
                if (row >= 14) { rawm[(size_t)row * DFF2 + 128 * t + 16 * kk + fr] = vu; rawm[(size_t)row * DFF2 + DFF + 128 * t + 16 * kk + fr] = vg; } }
        }
        __syncthreads();
        if (tid < 256) {
            const int row = tid >> 4, j = tid & 15, ch = 128 * t + 16 * kk + j;
            const float xu0 = rug[row * 16 + j], xu1 = row >= 1 ? rug[(row - 1) * 16 + j] : 0.f, xu2 = row >= 2 ? rug[(row - 2) * 16 + j] : 0.f;
            const float xg0 = rug[256 + row * 16 + j], xg1 = row >= 1 ? rug[256 + (row - 1) * 16 + j] : 0.f, xg2 = row >= 2 ? rug[256 + (row - 2) * 16 + j] : 0.f;
            const float cu = cb[ch] + cw[ch] * xu2 + cw[DFF2 + ch] * xu1 + cw[2 * DFF2 + ch] * xu0;
            const float cg = cb[DFF + ch] + cw[DFF + ch] * xg2 + cw[DFF2 + DFF + ch] * xg1 + cw[2 * DFF2 + DFF + ch] * xg0;
            am[(size_t)row * DFF + ch] = f2bf(cg * sigmoidf_(cg) * cu);
        }
        __syncthreads();
    }
}

__device__ __forceinline__ void wprep_layer(const float* const* in, int l, unsigned char* ws, int gw, int ngw, int lane, float* scr, int part) {
    unsigned char* wb = ws + WS_W + (size_t)(l & 1) * WL_BYTES;
    constexpr int I1 = (DM / 64) * (N1 / 32), I2 = (DM / 64) * (DM / 32), I3 = (DM / 64) * (DFF2 / 32), I4 = (DFF / 64) * (DM / 32);
    const int n1 = (part & 1) ? I1 : 0, n2 = (part & 2) ? I2 : 0, n3 = (part & 4) ? I3 : 0, n4 = (part & 8) ? I4 : 0;
    for (int it = gw; it < n1 + n2 + n3 + n4; it += ngw) {
        int r = it, mode = 1, K = DM, Nsrc = N_IN, Ndst = N1; const float* W = in[3] + (size_t)l * DM * N_IN; const float* gk = in[2] + l * DM; bf16_t* WT = (bf16_t*)(wb + WO_W1);
        if (r >= n1) { r -= n1; mode = 2; Nsrc = DM; Ndst = DM; W = in[18] + (size_t)l * DM * DM; gk = nullptr; WT = (bf16_t*)(wb + WO_W2);
            if (r >= n2) { r -= n2; mode = 3; Nsrc = DFF2; Ndst = DFF2; W = in[20] + (size_t)l * DM * DFF2; gk = in[19] + l * DM; WT = (bf16_t*)(wb + WO_W3);
                if (r >= n3) { r -= n3; mode = 4; K = DFF; Nsrc = DM; Ndst = DM; W = in[23] + (size_t)l * DFF * DM; gk = nullptr; WT = (bf16_t*)(wb + WO_W4); } } }
        wprep_item(W, gk, WT, K, Nsrc, Ndst, mode, r, scr, lane);
    }
    if (part & 1) {
        bf16_t* lup = (bf16_t*)(wb + WO_LUP);
        const float* wu = in[6] + (size_t)l * 64 * 512; const float* au = in[8] + (size_t)l * 64 * 512; const float* gu = in[9] + (size_t)l * 160 * 512;
        for (int n = gw; n < 512; n += ngw) {
#pragma unroll
            for (int kq = 0; kq < 5; ++kq) { const int k = lane + 64 * kq;
                if (k < 288) lup[n * 288 + k] = f2bf(k < 64 ? wu[k * 512 + n] : (k < 128 ? au[(k - 64) * 512 + n] : gu[(k - 128) * 512 + n])); }
        }
    }
}

struct RwP { const float* mu; const float* w0; const float* w_up; const float* a0; const float* a_up; const float* g_up; };
struct RwS { const float* mu; const float* k_k; const float* k_a; const float* r_k; const float* gn_w; const float* gn_b; };
constexpr int RCH = 8;

__global__ void __launch_bounds__(NWAVES * 64, 2) mk_fwd(Args a) {
    extern __shared__ __attribute__((aligned(16))) unsigned char lds[];
    const int tid0 = threadIdx.x, wave_s = __builtin_amdgcn_readfirstlane(tid0 >> 6);
    const int G0 = gridDim.x, bid0 = blockIdx.x;
    for (int u = tid0; u < (LDS_BYTES - LDSCTL_OFF) / 4; u += NWAVES * 64) ((LAS unsigned*)((LAS unsigned char*)lds + LDSCTL_OFF))[u] = 0u;
    __syncthreads();
    XcdBarrier bar = xcd_barrier_post((unsigned*)(a.ws + WS_CTL) + CW_BAR, (volatile LAS unsigned*)((LAS unsigned char*)lds + MISC_OFF) + 8);
#ifdef TPROBE
#define TP_MARK(ph) do { if ((ph) >= 20 && TPROBE < 20) break;     \
        const unsigned t_ = (unsigned)__builtin_amdgcn_s_memrealtime(); if (wave_s == 0 && lane_id() == 0) { volatile LAS unsigned* q_ = (volatile LAS unsigned*)((LAS unsigned char*)lds + LDSCTL_OFF + 512); \
        if ((ph) == TPROBE) q_[1] += t_ - q_[0]; q_[0] = t_; } } while (0)
#else
#define TP_MARK(ph) do {} while (0)
#endif
#define GRID_BAR() do { int wv_ = wave_s; asm volatile("" : "+s"(wv_)); xcd_barrier(bar, wv_); } while (0)
#define RSTD_TABLE(S) do { pg8::Unit u0_, u_; if (S.next(0, u0_)) { float rv_ = 0.f; if (tid < 256) rv_ = pg8::row_rstd(ssqp, u0_.pm * 256 + tid); \
        for (int i_ = 0; S.next(i_, u_); ++i_) if (tid < 256) ((LAS float*)(ldsl + RSTD_OFF))[i_ * 256 + tid] = u_.pm == u0_.pm ? rv_ : pg8::row_rstd(ssqp, u_.pm * 256 + tid); } \
        __syncthreads(); } while (0)
    TP_MARK(-1);
#define PHASE_IDS() int G_ = G0, bid_ = bid0, wv_ = wave_s; asm volatile("" : "+s"(G_), "+s"(bid_), "+s"(wv_)); int tid = wv_ * 64 + lane_id(); asm volatile("" : "+v"(tid)); \
    const int G = G_, bid = bid_, ngw = G * NWAVES, lane = tid & 63, wave = wv_, gw = bid * NWAVES + wave; (void)lane; (void)gw; (void)ngw
#define PHASE_PTRS(L) int z0_ = 0; asm volatile("" : "+s"(z0_)); const float* const* inq = a.in + z0_; unsigned char* ws = a.ws + z0_; float* out = a.out + z0_; const int lq = (L) + z0_; \
    float* hm = (float*)(ws + WS_HM); float* c2 = (float*)(ws + WS_C2); float* ssqp = (float*)(ws + WS_SSQ); \
    bf16_t* hb = (bf16_t*)(ws + WS_HB); bf16_t* p = (bf16_t*)(ws + WS_P); float* pn = (float*)(ws + WS_PN); bf16_t* y = (bf16_t*)(ws + WS_Y); \
    bf16_t* act = (bf16_t*)(ws + WS_ACT); float* fixb = (float*)(ws + WS_FIX); float* rawm = (float*)(ws + WS_RAWM); \
    const unsigned char* wbuf = ws + WS_W + (size_t)(lq & 1) * WL_BYTES; \
    const bf16_t* W1 = (const bf16_t*)(wbuf + WO_W1); const bf16_t* W2 = (const bf16_t*)(wbuf + WO_W2); const bf16_t* W3 = (const bf16_t*)(wbuf + WO_W3); const bf16_t* W4 = (const bf16_t*)(wbuf + WO_W4); \
    (void)hm; (void)c2; (void)ssqp; (void)hb; (void)p; (void)pn; (void)y; (void)act; (void)fixb; (void)rawm; (void)out; (void)W1; (void)W2; (void)W3; (void)W4
    LAS unsigned char* ldsl = (LAS unsigned char*)lds;

    {
        PHASE_IDS(); PHASE_PTRS(0);
        for (int row = gw; row < RROWS; row += ngw) {
            const f32x4* xr = (const f32x4*)(row < MROWS ? inq[0] + (size_t)row * DM : inq[1] + (size_t)(row - MROWS) * DM) + lane;
            f32x4* hr = (f32x4*)(hm + (size_t)(row < MROWS ? 0 : row - MROWS) * DM) + lane;
            f32x4 v[4]; float s = 0.f;
#pragma unroll
            for (int j = 0; j < 4; ++j) { v[j] = xr[64 * j]; if (row >= MROWS) hr[64 * j] = v[j]; s += (v[j].x * v[j].x + v[j].y * v[j].y) + (v[j].z * v[j].z + v[j].w * v[j].w); }
            s = wave_sum(s);
            if (lane < 16) ssqp[(size_t)row * 16 + lane] = lane == 0 ? s : 0.f;
            u32x2* o8 = (u32x2*)(hb + (size_t)row * DM) + lane;
#pragma unroll
            for (int j = 0; j < 4; ++j) { u32x2 w; w.x = pk2bf(v[j].x, v[j].y); w.y = pk2bf(v[j].z, v[j].w); o8[64 * j] = w; }
        }
    }
    {
        PHASE_IDS(); PHASE_PTRS(0);
        u32x4* z = (u32x4*)(p + (size_t)RROWS * PBW); const unsigned n16 = (unsigned)((16512 - RROWS) * PBW * 2 / 16);
        for (unsigned i = (unsigned)(bid * (NWAVES * 64) + tid); i < n16; i += (unsigned)(G * (NWAVES * 64))) z[i] = (u32x4){0u, 0u, 0u, 0u};
    }
#ifndef PLAIN_LAUNCH
    cg::this_grid().sync();
#endif
    TP_MARK(0);

#pragma unroll 1
    for (int l = -1; l < DEPTH; ++l) {
#pragma unroll 1
      for (int ph = l < 0 ? 1 : 0; ph < (l < 0 ? 2 : 6); ++ph) {
#ifdef TPROBE
        if (wave_s == 0 && lane_id() == 0) ((volatile LAS unsigned*)((LAS unsigned char*)lds + LDSCTL_OFF + 512))[2] = (unsigned)ph;
#endif
        if (ph == 1 || ph == 4)
        {
            PHASE_IDS(); PHASE_PTRS(l);
            if (lq + 1 < DEPTH) {
                const int first = (G == 256 && lq >= 0) ? (ph == 4 ? 128 : 8) : 0, part = lq < 0 ? 15 : (G == 256 ? (ph == 4 ? 6 : 9) : (ph == 4 ? 0 : 15));
                if (bid >= first && part) wprep_layer(inq, lq + 1, ws, gw - first * NWAVES, ngw - first * NWAVES, lane, (float*)(lds + wave * 16384), part);
            }
            __syncthreads();
        }
        if (ph == 0) {
        {
            PHASE_IDS(); PHASE_PTRS(l);
            pg8::Gemm g{hb, W1, MROWS, N1, DM}; pg8::StaticOrder S; S.init(MROWS, N1, G, bid);
            RSTD_TABLE(S);
            pg8::Epi1 E{(const LAS float*)(ldsl + RSTD_OFF), p, pn, inq[16] + lq * 64, inq[17] + lq * 64};
            pg8::gemm_phase<pg8::Epi1, pg8::StaticOrder, true, true>(ldsl, g, S, E, wave);
            meta_gemm<true>(hm, DM, W1, N1, DM, bid, G, wave, lane, (float*)lds, MEpi1{p, pn});
        }
        } else if (ph == 4) {
        {
            PHASE_IDS(); PHASE_PTRS(l);
            const float* cw = inq[21] + (size_t)lq * 3 * DFF2; const float* cb = inq[22] + (size_t)lq * DFF2;
            pg8::Gemm g{hb, W3, MROWS, DFF2, DM}; pg8::StaticOrder S; S.init(MROWS, DFF2, G, bid);
            RSTD_TABLE(S);
            pg8::EpiConv E{(const LAS float*)(ldsl + RSTD_OFF), cw, cb, act, fixb, ldsl + HALO_OFF, (LAS float*)(ldsl + RSTD_OFF + 6 * 1024)};
            pg8::gemm_phase<pg8::EpiConv, pg8::StaticOrder, true, true>(ldsl, g, S, E, wave);
            meta_gemm3(hm, W3, bid, G, wave, lane, tid, (float*)lds, (float*)(lds + 20480), cw, cb, rawm, act + (size_t)MROWS * DFF);
        }
        }
        if (ph == 1 && l >= 0) {
        {
            PHASE_IDS(); PHASE_PTRS(l);
            __syncthreads(); TP_MARK(20);
            {
                const float* mu = inq[4] + lq * 1824;
                const bf16_t* lup = (const bf16_t*)(wbuf + WO_LUP);
                const int h = wave, cg = h * 64 + lane, fr = lane & 15, fq = lane >> 4;
                const float mu_r = mu[cg], mu_k = mu[512 + cg], mu_v = mu[1024 + cg];
                const float w0c = (inq[5] + lq * 512)[cg], a0c = (inq[7] + lq * 512)[cg];
                const float kkc = (inq[10] + lq * 512)[cg], kac = (inq[11] + lq * 512)[cg], rkc = (inq[12] + lq * 512)[cg];
                LAS unsigned char* PNS = ldsl;
                LAS unsigned char* PSW = ldsl + 22528 + wave * 6528;
                LAS unsigned char* LW = ldsl + 74752 + wave * 9216;
                LAS unsigned char* LIN = ldsl + 148480;
                LAS float* MU = (LAS float*)(ldsl + 158720);
                LAS float* TR = (LAS float*)LW; LAS float* LT = (LAS float*)LW; LAS float* LAK = (LAS float*)(LW + 1280);
#define PN_DMA(uu) do { const int c_ = (uu) % NCH, r0_ = rowof((uu) / NCH, 16 * c_), p0_ = prevrow(r0_); \
                    for (int pc_ = wave; pc_ < (p0_ >= 0 ? 22 : 20); pc_ += NWAVES) { \
                        const char* src_ = (pc_ < 20 ? (const char*)(pn + (size_t)r0_ * PNW) + pc_ * 1024 : (const char*)(pn + (size_t)p0_ * PNW) + (pc_ - 20) * 1024) + lane * 16; \
                        __builtin_amdgcn_global_load_lds((const unsigned*)src_, (LAS unsigned*)(PNS + pc_ * 1024), 16, 0, 0); } } while (0)
#define PS_DMA(uu) do { const int c_ = (uu) % NCH, r0_ = rowof((uu) / NCH, 16 * c_), p0_ = prevrow(r0_); int ln_ = lane; asm volatile("" : "+v"(ln_));     \
                    _Pragma("unroll") for (int j_ = 0; j_ < 7; ++j_) { const int s_ = j_ * 8 + (ln_ >> 3); \
                        if (s_ < 51) { const int i_ = s_ / 3, sg_ = s_ - 3 * i_, rw_ = i_ ? r0_ + i_ - 1 : (p0_ >= 0 ? p0_ : r0_); \
                            const char* src_ = (const char*)(p + (size_t)rw_ * PBW) + sg_ * 1024 + wave * 128 + (ln_ & 7) * 16; \
                            __builtin_amdgcn_global_load_lds((const unsigned*)src_, (LAS unsigned*)(PSW + j_ * 1024), 16, 0, 0); } } } while (0)
#define PSV(i, sg) bf2f(((const LAS bf16_t*)PSW)[(3 * (i) + (sg)) * 64 + lane])
                if (tid < 288) MU[tid] = mu[1536 + tid];
                if (bid < NB * NCH) { PN_DMA(bid); PS_DMA(bid); }
                asm volatile("s_waitcnt vmcnt(0)" ::: "memory");
                bf16x8 bw_[2][4], ba_[2][4];
                {   const int fru = lane & 15, fqu = lane >> 4;
#pragma unroll
                    for (int nb = 0; nb < 4; ++nb) { const bf16_t* bp_ = lup + (size_t)(h * 64 + 16 * nb + fru) * 288 + 8 * fqu;
#pragma unroll
                        for (int ks = 0; ks < 2; ++ks) { bw_[ks][nb] = *(const bf16x8*)(bp_ + 32 * ks); ba_[ks][nb] = *(const bf16x8*)(bp_ + 64 + 32 * ks); }
                    } }
                for (int u = bid; u < NB * NCH; u += G) {
                    const int b = u / NCH, c = u % NCH, row0 = rowof(b, 16 * c), prow0 = prevrow(row0);
                    int tidu = tid; asm volatile("" : "+v"(tidu));
                    const int fr = tidu & 15, fq = (tidu >> 4) & 3;
                    bf16x8 bg_[5][4];
                    TP_MARK(27);
                    asm volatile("s_waitcnt lgkmcnt(0)\n\ts_barrier" ::: "memory");
                    {
                        float cur_[9], prv_[9], mu_[9];
#pragma unroll
                        for (int i = 0; i < 9; ++i) { const int e = tidu + 512 * i, ti = e / 288, j = e - 288 * ti;
                            cur_[i] = ((const LAS float*)PNS)[ti * 320 + j]; prv_[i] = ((const LAS float*)PNS)[(ti ? ti - 1 : 16) * 320 + j]; mu_[i] = MU[j]; }
#pragma unroll
                        for (int i = 0; i < 9; ++i) { const int e = tidu + 512 * i, ti = e / 288, j = e - 288 * ti;
                            const float prv = (ti || prow0 >= 0) ? prv_[i] : 0.f, s = cur_[i] + mu_[i] * (prv - cur_[i]);
                            const float ex = __builtin_amdgcn_exp2f((j < 64 ? 2.f * LOG2E : -LOG2E) * s), rc = __builtin_amdgcn_rcpf(1.f + ex);
                            ((LAS bf16_t*)LIN)[ti * 296 + j] = f2bf(j < 64 ? 1.f - 2.f * rc : (j < 128 ? s : rc)); }
                    }
                    {   const int fru = fr, fqu = fq;
#pragma unroll
                        for (int nb = 0; nb < 4; ++nb) { const bf16_t* bp_ = lup + (size_t)(h * 64 + 16 * nb + fru) * 288 + 8 * fqu;
#pragma unroll
                            for (int ks = 0; ks < 5; ++ks) bg_[ks][nb] = *(const bf16x8*)(bp_ + 128 + 32 * ks); } }
                    TP_MARK(28);
                    asm volatile("s_waitcnt lgkmcnt(0)\n\ts_barrier" ::: "memory");
                    if (u + G < NB * NCH) PN_DMA(u + G);
                    TP_MARK(22);
#define LORA_PRE(ZA, KB0, NKS, BF) do { f32x4 acc_[4]; _Pragma("unroll") for (int nb = 0; nb < 4; ++nb) acc_[nb] = (f32x4){0.f, 0.f, 0.f, 0.f}; \
                        _Pragma("unroll") for (int ks = 0; ks < (NKS); ++ks) { const bf16x8 af = *(const LAS bf16x8*)(LIN + fr * 592 + ((KB0) + 32 * ks + 8 * fq) * 2); \
                            _Pragma("unroll") for (int nb = 0; nb < 4; ++nb) acc_[nb] = __builtin_amdgcn_mfma_f32_16x16x32_bf16(af, BF[ks][nb], acc_[nb], 0, 0, 0); } \
                        WAVE_LDS_SYNC(); \
                        _Pragma("unroll") for (int nb = 0; nb < 4; ++nb) _Pragma("unroll") for (int r = 0; r < 4; ++r) TR[(4 * fq + r) * 65 + 16 * nb + fr] = acc_[nb][r]; \
                        WAVE_LDS_SYNC(); \
                        _Pragma("unroll") for (int i = 0; i < 16; ++i) ZA[i] = TR[i * 65 + lane]; } while (0)
                    float zw[16], za[16];
                    LORA_PRE(zw, 0, 2, bw_); LORA_PRE(za, 64, 2, ba_);
                    {
                        float zg[16]; LORA_PRE(zg, 128, 5, bg_); (void)zg;
                        asm volatile("s_waitcnt vmcnt(0)" ::: "memory");
                        {
                            const int ti_ = lane >> 2, pt_ = lane & 3; float gv_[16];
#pragma unroll
                            for (int k_ = 0; k_ < 16; ++k_) gv_[k_] = TR[ti_ * 65 + 16 * pt_ + k_];
                            u32x4 o0_, o1_;
                            o0_.x = pk2bf(gv_[0], gv_[1]); o0_.y = pk2bf(gv_[2], gv_[3]); o0_.z = pk2bf(gv_[4], gv_[5]); o0_.w = pk2bf(gv_[6], gv_[7]);
                            o1_.x = pk2bf(gv_[8], gv_[9]); o1_.y = pk2bf(gv_[10], gv_[11]); o1_.z = pk2bf(gv_[12], gv_[13]); o1_.w = pk2bf(gv_[14], gv_[15]);
                            bf16_t* yp_ = y + (size_t)(row0 + ti_) * DM + h * 64 + 16 * pt_;
                            *(u32x4*)yp_ = o0_; *(u32x4*)(yp_ + 8) = o1_; } }
#undef LORA_PRE
                    WAVE_LDS_SYNC();
                    const int ci = (b * 8 + h) * NCH + c;
                    unsigned char* ra = ws + WS_RA + (size_t)ci * RA_BYTES; unsigned char* rb = (unsigned char*)out + (size_t)ci * RB_BYTES;
                    bf16_t* BV = (bf16_t*)(ws + WS_BV);
                    LAS bf16_t* OA = (LAS bf16_t*)LW; LAS bf16_t* OB = OA + 16 * 72; LAS bf16_t* OK = OB + 16 * 72; LAS bf16_t* OR = OK + 16 * 72;
                    const int cxk = (lane >> 5) * 4 + ((lane >> 2) & 3), jk2 = (((lane >> 4) & 1) * 4 + (lane & 3)) * 2;
                    TP_MARK(23);
                    float atil[16]; unsigned bkB[8], bkK[8], vtp[8];
                    float cumC = 0.f;
#pragma unroll
                    for (int i = 0; i < 16; ++i) { zw[i] = 0.6065306597126334f * __builtin_amdgcn_rcpf(1.f + __builtin_amdgcn_exp2f(-LOG2E * (zw[i] + w0c))); cumC += zw[i]; }
                    float cum = 0.f, gprev = 1.f, rp = 0.f, kp_ = 0.f, vp = 0.f, be = 0.f, ke = 0.f, ve = 0.f, bve = 0.f; unsigned bvp[8];
                    unsigned short prr[17], pkk[17], pvv[17];
#pragma unroll
                    for (int i = 0; i < 17; ++i) { prr[i] = ((const LAS bf16_t*)PSW)[(3 * i) * 64 + lane]; pkk[i] = ((const LAS bf16_t*)PSW)[(3 * i + 1) * 64 + lane]; pvv[i] = ((const LAS bf16_t*)PSW)[(3 * i + 2) * 64 + lane]; }
                    WAVE_LDS_SYNC();
                    if (u + G < NB * NCH) PS_DMA(u + G);
                    rp = bf2f(prr[0]); kp_ = bf2f(pkk[0]); vp = bf2f(pvv[0]);
                    const float hp0 = prow0 >= 0 ? 1.f : 0.f;
#pragma unroll
                    for (int i0 = 0; i0 < 16; i0 += 4) {
                        float rs4[4], vs4[4], alr4[4], kkr4[4], kpr4[4], red[8];
#pragma unroll
                        for (int j = 0; j < 4; ++j) { const int i = i0 + j;
                            const float rc = bf2f(prr[i + 1]), kc = bf2f(pkk[i + 1]), vc = bf2f(pvv[i + 1]);
                            const float hp = i ? 1.f : hp0;
                            const float rs = rc + mu_r * (hp * rp - rc), ks_ = kc + mu_k * (hp * kp_ - kc), vs = vc + mu_v * (hp * vp - vc);
                            rp = rc; kp_ = kc; vp = vc;
                            const float alr = __builtin_amdgcn_rcpf(1.f + __builtin_amdgcn_exp2f(-LOG2E * (za[i] + a0c)));
                            const float kkr = ks_ * kkc, kpr = ks_ * (1.f + (alr - 1.f) * kac);
                            rs4[j] = rs; vs4[j] = vs; alr4[j] = alr; kkr4[j] = kkr; kpr4[j] = kpr; red[2 * j] = kkr * kkr; red[2 * j + 1] = rs * kpr * rkc; }
                        wave_sum_dpp8(red);
#pragma unroll
                        for (int j = 0; j < 4; ++j) { const int i = i0 + j;
                            cum += zw[i];
                            const float kk = kkr4[j] * __builtin_amdgcn_rsqf(fmaxf(red[2 * j], 1e-24f)), bon = red[2 * j + 1], kpr = kpr4[j], vs = vs4[j];
                            const float eg = __builtin_amdgcn_exp2f(LOG2E * cum), gi = __builtin_amdgcn_exp2f(-LOG2E * cum), tail = __builtin_amdgcn_exp2f(LOG2E * (cum - cumC));
                            atil[i] = -kk * gprev;
                            const float bb = kk * alr4[j], rtil = rs4[j] * gi; gprev = gi;
                            OA[i * 72 + lane] = f2bf(atil[i]); OB[i * 72 + lane] = f2bf(bb * eg); OK[i * 72 + lane] = f2bf(kpr * eg); OR[i * 72 + lane] = f2bf(rtil);
                            if (i & 1) { bkB[i >> 1] = pk2bf(be, bb * tail); bkK[i >> 1] = pk2bf(ke, kpr * tail); vtp[i >> 1] = pk2bf(ve, vs); } else { be = bb * tail; ke = kpr * tail; ve = vs; }
                            if (i & 1) bvp[i >> 1] = pk2bf(bve, bon * vs); else bve = bon * vs; }
                    }
                    {
                        ((float*)(rb + 3584))[lane] = gprev;
#pragma unroll
                        for (int q = 0; q < 4; ++q) *(u32x4*)(ra + 4096 + lane * 64 + ((q ^ SWZ4(lane)) << 4)) = (u32x4){bkB[2 * q], bkB[2 * q + 1], bkK[2 * q], bkK[2 * q + 1]};
                        *(u32x4*)(rb + lane * 32) = (u32x4){vtp[0], vtp[1], vtp[2], vtp[3]}; *(u32x4*)(rb + lane * 32 + 16) = (u32x4){vtp[4], vtp[5], vtp[6], vtp[7]};
                    }
                    WAVE_LDS_SYNC();
                    TP_MARK(24);
#define REC_STORE(TILE, DST) do { _Pragma("unroll") for (int hh_ = 0; hh_ < 2; ++hh_) { const int i_ = (lane >> 3) + 8 * hh_, pc_ = lane & 7, c_ = pc_ ^ ((i_ >> 1) & 7), base_ = (c_ >> 2) * 32 + (c_ & 3) * 4; \
                        const u32x2 lo_ = *(const LAS u32x2*)((TILE) + i_ * 72 + base_), hi_ = *(const LAS u32x2*)((TILE) + i_ * 72 + base_ + 16); \
                        *(u32x4*)((DST) + i_ * 128 + pc_ * 16) = (u32x4){lo_.x, lo_.y, hi_.x, hi_.y}; } } while (0)
                    REC_STORE(OR, ra + 2048);
                    {
                        f32x4 dab = (f32x4){0.f, 0.f, 0.f, 0.f}, dak = dab, drb = dab, drk = dab;
#pragma unroll
                        for (int ks = 0; ks < 2; ++ks) {
                            const int off = fr * 72 + 32 * ks + 8 * fq;
                            const bf16x8 fa = *(const LAS bf16x8*)(OA + off), fb = *(const LAS bf16x8*)(OB + off), fk = *(const LAS bf16x8*)(OK + off), frr = *(const LAS bf16x8*)(OR + off);
                            dab = __builtin_amdgcn_mfma_f32_16x16x32_bf16(fa, fb, dab, 0, 0, 0); dak = __builtin_amdgcn_mfma_f32_16x16x32_bf16(fa, fk, dak, 0, 0, 0);
                            drb = __builtin_amdgcn_mfma_f32_16x16x32_bf16(frr, fb, drb, 0, 0, 0); drk = __builtin_amdgcn_mfma_f32_16x16x32_bf16(frr, fk, drk, 0, 0, 0);
                        }
#pragma unroll
                        for (int r = 0; r < 4; ++r) { const int i = 4 * fq + r, j = fr;
                            LT[i * 20 + j] = j < i ? dab[r] : 0.f; LAK[i * 16 + j] = j < i ? dak[r] : 0.f;
                            bf16_t* mp = (bf16_t*)(rb + 2048 + i * 64 + (((j >> 2) ^ SWZ4(i)) << 4)) + (j & 3);
                            mp[0] = f2bf(j <= i ? drb[r] : 0.f); mp[4] = f2bf(j <= i ? drk[r] : 0.f); }
                    }
                    WAVE_LDS_SYNC();
                    {
#pragma unroll
                        for (int k_ = 0; k_ < 8; ++k_) { OB[(2 * k_) * 72 + lane] = (bf16_t)(bvp[k_] & 0xffffu); OB[(2 * k_ + 1) * 72 + lane] = (bf16_t)(bvp[k_] >> 16); }
                        WAVE_LDS_SYNC();
                        const int ti_ = lane >> 2, pt_ = lane & 3;
                        const u32x4 b0_ = *(const LAS u32x4*)(OB + ti_ * 72 + 16 * pt_), b1_ = *(const LAS u32x4*)(OB + ti_ * 72 + 16 * pt_ + 8);
                        bf16_t* bp_ = BV + (size_t)(row0 + ti_) * 512 + h * 64 + 16 * pt_;
                        *(u32x4*)bp_ = b0_; *(u32x4*)(bp_ + 8) = b1_;
                    }
                    float tt[16];
#pragma unroll
                    for (int mm = 0; mm < 16; ++mm) tt[mm] = mm == fr ? 1.f : 0.f;
#pragma unroll
                    for (int j = 14; j >= 0; --j) { float val = 0.f;
#pragma unroll
                        for (int mm = j + 1; mm < 16; ++mm) val += tt[mm] * LT[mm * 20 + j];
                        tt[j] += val; }
                    WAVE_LDS_SYNC();
                    if (fq == 0) {
#pragma unroll
                        for (int mm = 0; mm < 16; ++mm) LT[fr * 20 + mm] = tt[mm]; }
                    {
                        f32x4 g4 = (f32x4){0.f, 0.f, 0.f, 0.f};
#pragma unroll
                        for (int mm = 0; mm < 16; ++mm) g4 += *(const LAS f32x4*)(LAK + mm * 16 + 4 * fq) * tt[mm];
                        u32x2 w; w.x = pk2bf(g4[0], g4[1]); w.y = pk2bf(g4[2], g4[3]);
                        *(u32x2*)(rb + 3072 + (fr * 16 + 4 * fq) * 2) = w;
                    }
                    WAVE_LDS_SYNC();
                    TP_MARK(25);
                    {
#pragma unroll
                        for (int i = 0; i < 16; ++i) { float acc = 0.f;
                            const f32x4 t0 = *(const LAS f32x4*)(LT + i * 20), t1 = *(const LAS f32x4*)(LT + i * 20 + 4), t2 = *(const LAS f32x4*)(LT + i * 20 + 8), t3 = *(const LAS f32x4*)(LT + i * 20 + 12);
                            const float trow[16] = {t0[0], t0[1], t0[2], t0[3], t1[0], t1[1], t1[2], t1[3], t2[0], t2[1], t2[2], t2[3], t3[0], t3[1], t3[2], t3[3]};
#pragma unroll
                            for (int mm = 0; mm <= i; ++mm) acc += trow[mm] * atil[mm];
                            OK[i * 72 + lane] = f2bf(acc); }
                        WAVE_LDS_SYNC();
                        REC_STORE(OK, ra);
                    }
#undef REC_STORE
                    TP_MARK(26);
                }
            }
            __syncthreads();
#undef PN_DMA
#undef PS_DMA
#undef PSV
            TP_MARK(29);
            TP_MARK(21);
            const float* q_g = inq[16] + lq * 64; const float* k_g = inq[17] + lq * 64; const float* b_f = inq[15] + lq * 8;
            for (int it = gw - (G >= 96 ? 80 * NWAVES : 0); it >= 0 && it < NMETA * NH; it += ngw) {
                const int row = MROWS + (it >> 3), h = it & 7;
                bf16_t* qp = p + (size_t)row * PBW + 1536 + h * 64 + lane; bf16_t* kp = p + (size_t)row * PBW + 2048 + h * 64 + lane;
                const float q = bf2f(*qp), k = bf2f(*kp);
                const float mq = wave_sum(q * q) * (1.f / 64.f), mk = wave_sum(k * k) * (1.f / 64.f);
                *qp = f2bf(q * (1.0f / sqrtf(mq + 1e-6f)) * q_g[lane] * (0.125f * LOG2E));
                *kp = f2bf(k * (1.0f / sqrtf(mk + 1e-6f)) * k_g[lane]);
            }
            for (int it = bid - (G >= 80 ? 16 : 0); it >= 0 && it < NB * NH; it += G) {
                constexpr int PER = 5;
                const int b = it >> 3, h = it & 7;
                float zv[PER], loc[PER], s = 0.f;
#pragma unroll
                for (int i = 0; i < PER; ++i) { const int t = tid * PER + i; zv[i] = pn[(size_t)rowof(b, t < LTOT ? t : LTOT - 1) * PNW + 288 + h]; }
#pragma unroll
                for (int i = 0; i < PER; ++i) { const int t = tid * PER + i;
                    const float v = t < LTOT ? -__builtin_amdgcn_logf(1.f + __builtin_amdgcn_exp2f(-LOG2E * (zv[i] + b_f[h]))) : 0.f;
                    s += v; loc[i] = s; }
                float incl = s;
#pragma unroll
                for (int o = 1; o < 64; o <<= 1) { const float n = __int_as_float(__builtin_amdgcn_ds_bpermute((lane - o) << 2, __float_as_int(incl))); if (lane >= o) incl += n; }
                float base = incl - s;
                if (lane == 63) ((LAS float*)ldsl)[wave] = incl;
                __syncthreads();
#pragma unroll
                for (int w = 0; w < NWAVES - 1; ++w) base += w < wave ? ((const LAS float*)ldsl)[w] : 0.f;
                float* cv = c2 + (size_t)it * 2176;
#pragma unroll
                for (int i = 0; i < PER; ++i) { const int t = tid * PER + i; if (t < LTOT) cv[t < NMETA ? t : t + 112] = base + loc[i]; }
                if (tid < 112) cv[16 + tid] = 1e5f;
                __syncthreads();
            }
        }
        } else if (ph == 2) {
        {
            PHASE_IDS(); PHASE_PTRS(l);
            typedef short s16x4 __attribute__((ext_vector_type(4)));
            constexpr int SLOTB = 12288, NSLOT = 10  , YB_OFF = NSLOT * SLOTB, YB_BYTES = 32 * 68 * 4, NSC = (NCH + 1) / 2;
            static_assert(YB_OFF + 2 * YB_BYTES <= LDSCTL_OFF, "scan LDS map");
#define RAW_BAR() asm volatile("s_waitcnt lgkmcnt(0)\n\ts_barrier" ::: "memory")
#define QXOR1(x) __int_as_float(__builtin_amdgcn_update_dpp(0, __float_as_int(x), 0xB1, 0xf, 0xf, false))
#define QXOR2(x) __int_as_float(__builtin_amdgcn_update_dpp(0, __float_as_int(x), 0x4E, 0xf, 0xf, false))
            for (int unit = bid; unit < 64; unit += G) {
                const int b = unit >> 3, h = unit & 7, fr = lane & 15, fq = lane >> 4;
                const unsigned char* RA0 = ws + WS_RA + (size_t)unit * NCH * RA_BYTES; const unsigned char* RB0 = (const unsigned char*)out + (size_t)unit * NCH * RB_BYTES;
                if (wave < 4) {
                    const int v = 16 * wave + fr;
                    f32x4 Z[4];
#pragma unroll
                    for (int kb = 0; kb < 4; ++kb) Z[kb] = (f32x4){0.f, 0.f, 0.f, 0.f};
                    const int o_ah0 = fr * 128 + (((fq) ^ ((fr >> 1) & 7)) << 4), o_ah1 = fr * 128 + (((4 + fq) ^ ((fr >> 1) & 7)) << 4);
                    const int o_bk = 4096 + fr * 64 + ((fq ^ SWZ4(fr)) << 4), o_mrk = 10240 + fr * 64 + ((fq ^ SWZ4(fr)) << 4);
                    const int o_vt = 8192 + v * 32 + fq * 8, o_g = 11264 + fr * 32 + fq * 8, o_gam = 11776 + fq * 16;
                    RAW_BAR();
                    for (int s = 0; s < NSC; ++s) {
                        LAS float* YB = (LAS float*)(ldsl + YB_OFF + (s & 1) * YB_BYTES);
                        const int nc = (NCH - 2 * s) < 2 ? 1 : 2;
                        for (int cs = 0; cs < nc; ++cs) {
                            const LAS unsigned char* sl = ldsl + ((2 * s + cs) % NSLOT) * SLOTB;
                            const bf16x8 ah0 = *(const LAS bf16x8*)(sl + o_ah0), ah1 = *(const LAS bf16x8*)(sl + o_ah1);
                            const bf16x8 rh0 = *(const LAS bf16x8*)(sl + 2048 + o_ah0), rh1 = *(const LAS bf16x8*)(sl + 2048 + o_ah1);
                            bf16x8 bk[4]; f32x4 gam[4];
#pragma unroll
                            for (int kb = 0; kb < 4; ++kb) { bk[kb] = *(const LAS bf16x8*)(sl + o_bk + kb * 1024); gam[kb] = *(const LAS f32x4*)(sl + o_gam + kb * 64); }
                            const u32x2 vt = *(const LAS u32x2*)(sl + o_vt);
                            const bf16x8 mrk = *(const LAS bf16x8*)(sl + o_mrk);
                            const u32x2 g4 = *(const LAS u32x2*)(sl + o_g);
                            u32x4 zw01, zw23;
                            zw01.x = pk2bf(Z[0][0], Z[0][1]); zw01.y = pk2bf(Z[0][2], Z[0][3]); zw01.z = pk2bf(Z[1][0], Z[1][1]); zw01.w = pk2bf(Z[1][2], Z[1][3]);
                            zw23.x = pk2bf(Z[2][0], Z[2][1]); zw23.y = pk2bf(Z[2][2], Z[2][3]); zw23.z = pk2bf(Z[3][0], Z[3][1]); zw23.w = pk2bf(Z[3][2], Z[3][3]);
                            const bf16x8 zp01 = __builtin_bit_cast(bf16x8, zw01), zp23 = __builtin_bit_cast(bf16x8, zw23);
                            f32x4 U = (f32x4){0.f, 0.f, 0.f, 0.f}, Yv = U;
                            U = __builtin_amdgcn_mfma_f32_16x16x32_bf16(ah0, zp01, U, 0, 0, 0); U = __builtin_amdgcn_mfma_f32_16x16x32_bf16(ah1, zp23, U, 0, 0, 0);
                            U = __builtin_amdgcn_mfma_f32_16x16x16bf16_1k(__builtin_bit_cast(s16x4, g4), __builtin_bit_cast(s16x4, vt), U, 0, 0, 0);
                            Yv = __builtin_amdgcn_mfma_f32_16x16x32_bf16(rh0, zp01, Yv, 0, 0, 0); Yv = __builtin_amdgcn_mfma_f32_16x16x32_bf16(rh1, zp23, Yv, 0, 0, 0);
                            u32x4 uvw; uvw.x = pk2bf(U[0], U[1]); uvw.y = pk2bf(U[2], U[3]); uvw.z = vt.x; uvw.w = vt.y;
                            const bf16x8 uv = __builtin_bit_cast(bf16x8, uvw);
                            Yv = __builtin_amdgcn_mfma_f32_16x16x32_bf16(mrk, uv, Yv, 0, 0, 0);
#pragma unroll
                            for (int kb = 0; kb < 4; ++kb) { Z[kb] = Z[kb] * gam[kb]; Z[kb] = __builtin_amdgcn_mfma_f32_16x16x32_bf16(bk[kb], uv, Z[kb], 0, 0, 0); }
#pragma unroll
                            for (int r = 0; r < 4; ++r) YB[(cs * 16 + 4 * fq + r) * 68 + v] = Yv[r];
                        }
                        RAW_BAR();
                    }
                } else if (wave < 6) {
                    const unsigned lds0 = (unsigned)(uintptr_t)lds; const int lw = wave - 4;
#define DMA_SC(sc) do { const int nc_ = (NCH - 2 * (sc)) < 2 ? 1 : 2; for (int cs_ = 0; cs_ < nc_; ++cs_) { const int ch_ = 2 * (sc) + cs_; \
                        _Pragma("unroll") for (int pc_ = 0; pc_ < 6; ++pc_) { const int pc = lw * 6 + pc_; \
                            const unsigned char* src_ = (pc < 8 ? RA0 + (size_t)ch_ * RA_BYTES + pc * 1024 : RB0 + (size_t)ch_ * RB_BYTES + (pc - 8) * 1024) + lane * 16; \
                            attn_body::glds16(src_, (unsigned)__builtin_amdgcn_readfirstlane(lds0 + (ch_ % NSLOT) * SLOTB + pc * 1024)); } } } while (0)
                    DMA_SC(0); DMA_SC(1); DMA_SC(2); DMA_SC(3);
                    asm volatile("s_waitcnt vmcnt(36)\n\ts_barrier" ::: "memory");
                    for (int s = 0; s < NSC; ++s) {
                        if (s + 4 < NSC) DMA_SC(s + 4);
#define NPC_(sc) ((sc) < NSC ? ((NCH - 2 * (sc)) < 2 ? 6 : 12) : 0)
                        const int fl = NPC_(s + 2) + NPC_(s + 3) + NPC_(s + 4);
#undef NPC_
                        if (fl == 36) asm volatile("s_waitcnt vmcnt(36)\n\ts_barrier" ::: "memory");
                        else if (fl == 30) asm volatile("s_waitcnt vmcnt(30)\n\ts_barrier" ::: "memory");
                        else if (fl == 18) asm volatile("s_waitcnt vmcnt(18)\n\ts_barrier" ::: "memory");
                        else if (fl == 6) asm volatile("s_waitcnt vmcnt(6)\n\ts_barrier" ::: "memory");
                        else asm volatile("s_waitcnt vmcnt(0)\n\ts_barrier" ::: "memory");
                    }
#undef DMA_SC
                } else {
                    const int pw = wave - 6, tk = lane >> 2, part = lane & 3, cgv = h * 64 + part * 16;
                    const bf16_t* BV = (const bf16_t*)(ws + WS_BV);
                    float gnw[16], gnb[16];
#pragma unroll
                    for (int j = 0; j < 16; ++j) { gnw[j] = (inq[13] + lq * 512)[cgv + j]; gnb[j] = (inq[14] + lq * 512)[cgv + j]; }
#define PLOAD(G0, G1, B0, B1, sg) do { const int cn_ = 2 * (sg) + pw; if ((sg) < NSC && cn_ < NCH) { const size_t rown = (size_t)rowof(b, 16 * cn_ + tk); \
                        G0 = *(const u32x4*)(y + rown * DM + cgv); G1 = *(const u32x4*)(y + rown * DM + cgv + 8); B0 = *(const u32x4*)(BV + rown * 512 + cgv); B1 = *(const u32x4*)(BV + rown * 512 + cgv + 8); } } while (0)
                    u32x4 ga0 = (u32x4){0u, 0u, 0u, 0u}, ga1 = ga0, ba0 = ga0, ba1 = ga0, gb0 = ga0, gb1 = ga0, bb0 = ga0, bb1 = ga0, gc0 = ga0, gc1 = ga0, bc0 = ga0, bc1 = ga0;
                    PLOAD(gb0, gb1, bb0, bb1, 0); PLOAD(gc0, gc1, bc0, bc1, 1);
                    RAW_BAR();
                    for (int s = 0; s <= NSC; ++s) {
                        const int cp = 2 * (s - 1) + pw;
                        const bool do_now = s >= 1 && cp < NCH && (cp > 0 || b == 0);
                        const u32x4 g0 = ga0, g1 = ga1, b0 = ba0, b1 = ba1;
                        ga0 = gb0; ga1 = gb1; ba0 = bb0; ba1 = bb1; gb0 = gc0; gb1 = gc1; bb0 = bc0; bb1 = bc1;
                        PLOAD(gc0, gc1, bc0, bc1, s + 2);
                        if (do_now) {
                            const LAS float* yb = (const LAS float*)(ldsl + YB_OFF + ((s - 1) & 1) * YB_BYTES) + (pw * 16 + tk) * 68 + part * 16;
                            float yv[16];
#pragma unroll
                            for (int q4 = 0; q4 < 4; ++q4) { const f32x4 t4 = *(const LAS f32x4*)(yb + 4 * q4); yv[4 * q4] = t4[0]; yv[4 * q4 + 1] = t4[1]; yv[4 * q4 + 2] = t4[2]; yv[4 * q4 + 3] = t4[3]; }
                            float s1 = 0.f;
#pragma unroll
                            for (int j = 0; j < 16; ++j) s1 += yv[j];
                            s1 += QXOR1(s1); s1 += QXOR2(s1);
                            const float mean = s1 * (1.f / 64.f); float s2 = 0.f;
#pragma unroll
                            for (int j = 0; j < 16; ++j) { yv[j] -= mean; s2 += yv[j] * yv[j]; }
                            s2 += QXOR1(s2); s2 += QXOR2(s2);
                            const float rstd = 1.0f / sqrtf(s2 * (1.f / 64.f) + 64e-5f);
                            const unsigned gws[8] = {g0.x, g0.y, g0.z, g0.w, g1.x, g1.y, g1.z, g1.w}, bws[8] = {b0.x, b0.y, b0.z, b0.w, b1.x, b1.y, b1.z, b1.w};
                            unsigned ow[8];
#pragma unroll
                            for (int j2 = 0; j2 < 8; ++j2) {
                                const float oa = (yv[2 * j2] * rstd * gnw[2 * j2] + gnb[2 * j2] + __uint_as_float(bws[j2] << 16)) * __uint_as_float(gws[j2] << 16);
                                const float ob = (yv[2 * j2 + 1] * rstd * gnw[2 * j2 + 1] + gnb[2 * j2 + 1] + __uint_as_float(bws[j2] & 0xffff0000u)) * __uint_as_float(gws[j2] & 0xffff0000u);
                                ow[j2] = pk2bf(oa, ob); }
                            bf16_t* yo = y + (size_t)rowof(b, 16 * cp + tk) * DM + cgv;
                            *(u32x4*)yo = (u32x4){ow[0], ow[1], ow[2], ow[3]}; *(u32x4*)(yo + 8) = (u32x4){ow[4], ow[5], ow[6], ow[7]};
                        }
                        if (s < NSC) RAW_BAR();
                    }
#undef PLOAD
                }
                __syncthreads();
            }
#undef RAW_BAR
#undef QXOR1
#undef QXOR2
        }
        TP_MARK(30);
        {
            PHASE_IDS(); PHASE_PTRS(l);
            if (gw < NH * NMETA) {
                const int h = gw >> 4, t = gw & 15;
                const bf16_t* qrow = p + (size_t)(MROWS + t) * PBW + 1536 + h * 64;
                float s = -INFINITY;
                if (lane <= t) { const bf16_t* kr = p + (size_t)(MROWS + lane) * PBW + 2048 + h * 64; float d = 0.f;
                    for (int e = 0; e < 64; ++e) d += bf2f(qrow[e]) * bf2f(kr[e]);
                    s = d - c2[(size_t)h * 2176 + lane]; }
                const float mx = wave_max(s); const float e = lane <= t ? exp2f(s - mx) : 0.f; const float sum = wave_sum(e);
                float o = 0.f;
                for (int j = 0; j <= t; ++j) o += __int_as_float(__builtin_amdgcn_readlane(__float_as_int(e), j)) * bf2f(p[(size_t)(MROWS + j) * PBW + 2560 + h * 64 + lane]);
                const float og = bf2f(p[(size_t)(MROWS + t) * PBW + 3072 + h * 64 + lane]);
                y[(size_t)(MROWS + t) * DM + 512 + h * 64 + lane] = f2bf(o * __builtin_amdgcn_rcpf(sum) * __builtin_amdgcn_rcpf(1.f + __builtin_amdgcn_exp2f(-LOG2E * og)));
            }
        }
        __syncthreads();
        {
            PHASE_IDS(); PHASE_PTRS(l);
            typedef attn_body::bf16 abf;
            const attn_body::AttnTensors AT{(const abf*)(p + 1536), (const abf*)(p + 2048), (const abf*)(p + 2560), (const abf*)(p + 3072), c2, (abf*)(y + 512)};
            const attn_body::StaticOrder S(G, bid);
            TP_MARK(31);
            attn_body::attn_phase<attn_body::StaticOrder>((char*)lds, AT, S, wave);
            TP_MARK(32);
        }
        } else if (ph == 3) {
        {
            PHASE_IDS(); PHASE_PTRS(l);
            pg8::Gemm g{y, W2, MROWS, DM, DM}; pg8::StaticOrder S; S.init(MROWS, DM, G, bid);
            pg8::EpiRes E{nullptr, hb, ssqp};
            pg8::gemm_phase<pg8::EpiRes, pg8::StaticOrder, true, true>(ldsl, g, S, E, wave);
            meta_gemm<false>(y + (size_t)MROWS * DM, DM, W2, DM, DM, bid, G, wave, lane, (float*)lds, MEpiRes{hm});
        }
        } else if (ph == 5) {
        {
            PHASE_IDS(); PHASE_PTRS(l);
            const float* cw = inq[21] + (size_t)lq * 3 * DFF2; const float* cb = inq[22] + (size_t)lq * DFF2;
            pg8::Gemm g{act, W4, MROWS, DM, DFF}; pg8::StaticOrder S; S.init(MROWS, DM, G, bid);
            {
                pg8::Unit u;
                for (int i = 0; S.next(i, u); ++i) {
                    const int pm = u.pm;
                    const float* own0 = fixb + (size_t)(pm * 4) * DFF2; const float* own1 = own0 + DFF2;
                    const float* pv0 = (pm & 7) ? fixb + (size_t)((pm - 1) * 4 + 2) * DFF2 : rawm + (size_t)14 * DFF2; const float* pv1 = pv0 + DFF2;
#define FIX_LOAD(J) const f32x4 w0u = *(const f32x4*)(cw + (J)), w1u = *(const f32x4*)(cw + DFF2 + (J)), w2u = *(const f32x4*)(cw + 2 * DFF2 + (J)), bu = *(const f32x4*)(cb + (J)), \
                        w0g = *(const f32x4*)(cw + DFF + (J)), w1g = *(const f32x4*)(cw + DFF2 + DFF + (J)), w2g = *(const f32x4*)(cw + 2 * DFF2 + DFF + (J)), bg = *(const f32x4*)(cb + DFF + (J)), \
                        au = *(const f32x4*)(pv0 + (J)), bu_ = *(const f32x4*)(pv1 + (J)), cu_ = *(const f32x4*)(own0 + (J)), du = *(const f32x4*)(own1 + (J)), \
                        ag = *(const f32x4*)(pv0 + DFF + (J)), bg_ = *(const f32x4*)(pv1 + DFF + (J)), cg_ = *(const f32x4*)(own0 + DFF + (J)), dg = *(const f32x4*)(own1 + DFF + (J))
#define FIX_COMP(O0, O1) do { const f32x4 u0 = bu + w0u * au + w1u * bu_ + w2u * cu_, g0 = bg + w0g * ag + w1g * bg_ + w2g * cg_; \
                        const f32x4 u1 = bu + w0u * bu_ + w1u * cu_ + w2u * du, g1 = bg + w0g * bg_ + w1g * cg_ + w2g * dg; \
                        O0.x = pk2bf(g0[0] * sigmoidf_(g0[0]) * u0[0], g0[1] * sigmoidf_(g0[1]) * u0[1]); O0.y = pk2bf(g0[2] * sigmoidf_(g0[2]) * u0[2], g0[3] * sigmoidf_(g0[3]) * u0[3]); \
                        O1.x = pk2bf(g1[0] * sigmoidf_(g1[0]) * u1[0], g1[1] * sigmoidf_(g1[1]) * u1[1]); O1.y = pk2bf(g1[2] * sigmoidf_(g1[2]) * u1[2], g1[3] * sigmoidf_(g1[3]) * u1[3]); } while (0)
                    const int j0 = 4 * tid, j1 = 4 * tid + 4 * NWAVES * 64; const bool two = j1 < DFF; const int j1c = two ? j1 : j0;
                    u32x2 a0, a1, b0, b1;
                    { FIX_LOAD(j0); FIX_COMP(a0, a1); }
                    { FIX_LOAD(j1c);
                      *(u32x2*)(act + (size_t)(256 * pm) * DFF + j0) = a0; *(u32x2*)(act + (size_t)(256 * pm + 1) * DFF + j0) = a1;
                      FIX_COMP(b0, b1); }
                    if (two) { *(u32x2*)(act + (size_t)(256 * pm) * DFF + j1) = b0; *(u32x2*)(act + (size_t)(256 * pm + 1) * DFF + j1) = b1; }
#undef FIX_LOAD
#undef FIX_COMP
                }
                asm volatile("s_waitcnt vmcnt(0)" ::: "memory"); __syncthreads();
            }
            pg8::EpiRes E{lq + 1 == DEPTH ? out : nullptr, hb, ssqp};
            pg8::gemm_phase<pg8::EpiRes, pg8::StaticOrder, true, true>(ldsl, g, S, E, wave);
            meta_gemm<false>(act + (size_t)MROWS * DFF, DFF, W4, DM, DFF, bid, G, wave, lane, (float*)lds, MEpiRes{hm});
        }
        }
#ifdef TPROBE
#ifdef TPROBE_WAIT
        TP_MARK(19);
#endif
        GRID_BAR(); TP_MARK(ph == 0 ? 1 : ph == 1 ? 2 : ph == 2 ? 3 : ph == 3 ? 4 : ph == 4 ? 5 : 6);
#if TPROBE == 40
        GRID_BAR(); TP_MARK(40);
#endif
#else
        if (ph < 5 || l + 1 < DEPTH) GRID_BAR();
#endif
      }
    }
#ifdef TPROBE
#ifndef TPROBE_BLOCK
#define TPROBE_BLOCK 0
#endif
    if (bid0 == TPROBE_BLOCK && wave_s == 0 && lane_id() == 0) a.out[0] += (float)((volatile LAS unsigned*)((LAS unsigned char*)lds + LDSCTL_OFF + 512))[1] * 0.0001f;
#endif
}

extern "C" void kernel_launch(void* const* d_in, const int* in_sizes, int n_in, void* d_out, int out_size, void* d_ws, size_t ws_size, hipStream_t stream) {
    static int grid = 0;
    if (grid == 0) {
        if (n_in != 24 || out_size != MROWS * DM || ws_size < WS_END) { fprintf(stderr, "kernel_launch: unexpected shapes (n_in %d out %d ws %zu)\n", n_in, out_size, ws_size); grid = -1; return; }
        int dev = 0, cus = 0, per_cu = 0;
        hipGetDevice(&dev); hipDeviceGetAttribute(&cus, hipDeviceAttributeMultiprocessorCount, dev);
        if (hipFuncSetAttribute((const void*)mk_fwd, hipFuncAttributeMaxDynamicSharedMemorySize, LDS_BYTES) != hipSuccess) { fprintf(stderr, "kernel_launch: hipFuncSetAttribute failed\n"); grid = -1; return; }
        hipOccupancyMaxActiveBlocksPerMultiprocessor(&per_cu, (const void*)mk_fwd, NWAVES * 64, LDS_BYTES);
        (void)hipGetLastError();
        if (per_cu < 1) { fprintf(stderr, "kernel_launch: occupancy query says %d blocks per CU\n", per_cu); }
        grid = cus;
    }
    if (grid < 0) return;
    hipMemsetAsync((char*)d_ws + WS_CTL, 0, 32768, stream);
    Args a{};
    for (int i = 0; i < 24; ++i) a.in[i] = (const float*)d_in[i];
    a.out = (float*)d_out; a.ws = (unsigned char*)d_ws;
    void* args[] = {&a};
#ifdef PLAIN_LAUNCH
    hipLaunchKernelGGL(mk_fwd, dim3(grid), dim3(NWAVES * 64), LDS_BYTES, stream, a); hipError_t e = hipPeekAtLastError(); (void)args;
#else
    hipError_t e = hipLaunchCooperativeKernel((const void*)mk_fwd, dim3(grid), dim3(NWAVES * 64), args, LDS_BYTES, stream);
#endif
    if (e != hipSuccess) fprintf(stderr, "cooperative launch failed: %s (grid %d)\n", hipGetErrorString(e), grid);
}
```

```cpp
#define PLAIN_LAUNCH 1
#include <hip/hip_runtime.h>
#include <hip/hip_cooperative_groups.h>
#include <stdint.h>
#include <cstdio>
namespace cg = cooperative_groups;

typedef unsigned short bf16_t;
typedef short bf16x8 __attribute__((ext_vector_type(8)));
typedef float f32x4 __attribute__((ext_vector_type(4)));
typedef unsigned u32x4 __attribute__((ext_vector_type(4)));
typedef unsigned u32x2 __attribute__((ext_vector_type(2)));

constexpr int NB = 8, SEQ = 2048, NMETA = 16, LTOT = 2064, DM = 1024, DEPTH = 4, NH = 8, HD = 64;
constexpr int N_IN = 3880, DFF = 2816, DFF2 = 5632;
constexpr int MROWS = NB * SEQ;
constexpr int RROWS = MROWS + NMETA;
constexpr int N1 = 4096;
constexpr int PBW = 3584;
constexpr int PNW = 320;
constexpr float LOG2E = 1.4426950408889634f;

constexpr size_t MiB = 1u << 20;
constexpr size_t WS_CTL = 0, CTL_ZERO_BYTES = 1 * MiB;
constexpr size_t WS_W = 1 * MiB, WL_BYTES = 27 * MiB;
constexpr size_t WO_W1 = 0;
constexpr size_t WO_W2 = 8 * MiB;
constexpr size_t WO_W3 = 10 * MiB;
constexpr size_t WO_W4 = 21 * MiB;
constexpr size_t WO_LUP = 26 * MiB + 512 * 1024;
constexpr size_t WS_SMALL = WS_W + 2 * WL_BYTES;
constexpr size_t WS_HM = WS_SMALL;
constexpr size_t WS_C2 = WS_SMALL + 1 * MiB;
constexpr size_t WS_SSQ = WS_SMALL + 3 * MiB;
constexpr size_t WS_HB = WS_SMALL + 6 * MiB;
constexpr size_t WS_P = WS_HB + 33 * MiB;
constexpr size_t WS_PN = WS_P + 113 * MiB;
constexpr size_t WS_Y = WS_PN + 21 * MiB;
constexpr size_t WS_FREE = WS_Y + 33 * MiB;
constexpr int NCH = 129;
constexpr size_t RA_BYTES = 8192, RB_BYTES = 4096;
constexpr size_t WS_RA = WS_FREE;
#define SWZ4(r) (3 * (((r) >> 3) & 1))
constexpr size_t WS_ACT = WS_P;
constexpr size_t WS_FIX = WS_PN;
constexpr size_t WS_RAWM = WS_PN + 6 * MiB;
constexpr size_t WS_BV = WS_RA + 65 * MiB;
constexpr size_t WS_END = WS_BV + 17 * MiB;

__device__ __forceinline__ float bf2f(bf16_t v) { return __uint_as_float(((unsigned)v) << 16); }
typedef float f32x2_t_ __attribute__((ext_vector_type(2))); typedef __bf16 bf16x2_t_ __attribute__((ext_vector_type(2)));
__device__ __forceinline__ unsigned pk2bf(float lo, float hi) { const f32x2_t_ v = {lo, hi}; return __builtin_bit_cast(unsigned, __builtin_convertvector(v, bf16x2_t_)); }
__device__ __forceinline__ bf16_t f2bf(float f) { return __builtin_bit_cast(bf16_t, (__bf16)f); }
__device__ __forceinline__ float sigmoidf_(float x) { return 1.f / (1.f + __expf(-x)); }
__device__ __forceinline__ float wave_sum_dpp(float v) {
#define DPPF_(x, ctrl, rmask) __int_as_float(__builtin_amdgcn_update_dpp(0, __float_as_int(x), ctrl, rmask, 0xf, false))
    v += DPPF_(v, 0xB1, 0xf);
    v += DPPF_(v, 0x4E, 0xf);
    v += DPPF_(v, 0x141, 0xf);
    v += DPPF_(v, 0x140, 0xf);
    v += DPPF_(v, 0x142, 0xa);
    v += DPPF_(v, 0x143, 0xc);
#undef DPPF_
    return __int_as_float(__builtin_amdgcn_readlane(__float_as_int(v), 63));
}
__device__ __forceinline__ float wave_sum(float v) { return wave_sum_dpp(v); }
__device__ __forceinline__ void wave_sum_dpp8(float (&v)[8]) {
#define DPPF_(x, ctrl, rmask) __int_as_float(__builtin_amdgcn_update_dpp(0, __float_as_int(x), ctrl, rmask, 0xf, false))
#define DPPS_(ctrl, rmask) _Pragma("unroll") for (int j_ = 0; j_ < 8; ++j_) v[j_] += DPPF_(v[j_], ctrl, rmask);
    DPPS_(0xB1, 0xf) DPPS_(0x4E, 0xf) DPPS_(0x141, 0xf) DPPS_(0x140, 0xf) DPPS_(0x142, 0xa) DPPS_(0x143, 0xc)
#undef DPPS_
#undef DPPF_
#pragma unroll
    for (int j_ = 0; j_ < 8; ++j_) v[j_] = __int_as_float(__builtin_amdgcn_readlane(__float_as_int(v[j_]), 63));
}
__device__ __forceinline__ float wave_max(float v) {
#define DPPF_(x, ctrl, rmask) __int_as_float(__builtin_amdgcn_update_dpp(__float_as_int(x), __float_as_int(x), ctrl, rmask, 0xf, false))
    v = fmaxf(v, DPPF_(v, 0xB1, 0xf)); v = fmaxf(v, DPPF_(v, 0x4E, 0xf)); v = fmaxf(v, DPPF_(v, 0x141, 0xf)); v = fmaxf(v, DPPF_(v, 0x140, 0xf));
    v = fmaxf(v, DPPF_(v, 0x142, 0xa)); v = fmaxf(v, DPPF_(v, 0x143, 0xc));
#undef DPPF_
    return __int_as_float(__builtin_amdgcn_readlane(__float_as_int(v), 63));
}
__device__ __forceinline__ float add_xor16(float x) { const auto r = __builtin_amdgcn_permlane16_swap(__float_as_uint(x), __float_as_uint(x), false, false); return __uint_as_float(r[0]) + __uint_as_float(r[1]); }
__device__ __forceinline__ float add_xor32(float x) { const auto r = __builtin_amdgcn_permlane32_swap(__float_as_uint(x), __float_as_uint(x), false, false); return __uint_as_float(r[0]) + __uint_as_float(r[1]); }
__device__ __forceinline__ int lane_id() { int l; asm volatile("v_mbcnt_lo_u32_b32 %0, -1, 0\n\tv_mbcnt_hi_u32_b32 %0, -1, %0" : "=v"(l)); return l; }
#define WAVE_LDS_SYNC() do { __builtin_amdgcn_s_waitcnt(0xc07f); __builtin_amdgcn_wave_barrier(); } while (0)
__device__ __forceinline__ int rowof(int b, int t) { return t < NMETA ? MROWS + t : b * SEQ + (t - NMETA); }
__device__ __forceinline__ int prevrow(int row) {
    if (row >= MROWS) return row == MROWS ? -1 : row - 1;
    return (row & (SEQ - 1)) ? row - 1 : MROWS + NMETA - 1;
}

#define PERM32(j) (8 * (((j) >> 2) & 3) + 4 * ((j) >> 4) + ((j) & 3))
__device__ __forceinline__ int src_col(int mode, int n) {
    if (mode == 1) {
        const int g = n >> 9, c_ = n & 255, o = (n & 256) + (g < 7 ? ((c_ >> 5) & 3) * 64 + (c_ >> 7) * 32 + PERM32(c_ & 31) : c_);
        switch (g) {
            case 0: return o;
            case 1: return 512 + o;
            case 2: return 1024 + o;
            case 3: return 1824 + o;
            case 4: return 2336 + o;
            case 5: return 2848 + o;
            case 6: return 3360 + o;
            default:
                if (o < 64) return 1536 + o;
                if (o < 128) return 1600 + (o - 64);
                if (o < 288) return 1664 + (o - 128);
                if (o < 296) return 3872 + (o - 288);
                return -1;
        }
    }
    if (mode == 3) { const int t = n >> 8, c = n & 255; return c < 128 ? 128 * t + c : DFF + 128 * t + (c - 128); }
    return (n & ~31) + PERM32(n & 31);
}
__device__ __forceinline__ void wprep_item(const float* W, const float* gk, bf16_t* WT, int K, int Nsrc, int Ndst, int mode, int item, float* scr, int lane) {
    const int nblk = Ndst / 32, kb = item / nblk, nb = item % nblk, k0 = 64 * kb, n0 = 32 * nb;
    const int sc = src_col(mode, n0 + (lane & 31));
    const float* wp = W + (size_t)(k0 + (lane >> 5)) * Nsrc + (sc >= 0 ? sc : 0);
    float v[32];
#pragma unroll
    for (int i = 0; i < 32; ++i) { v[i] = *wp; wp += 2 * (size_t)Nsrc; }
#pragma unroll
    for (int i = 0; i < 32; ++i) scr[(2 * i + (lane >> 5)) * 33 + (lane & 31)] = sc >= 0 ? v[i] : 0.f;
    WAVE_LDS_SYNC();
    const int c = lane & 7;
    f32x4 g0 = (f32x4){1.f, 1.f, 1.f, 1.f}, g1 = g0;
    if (gk) { g0 = *(const f32x4*)(gk + k0 + 8 * c); g1 = *(const f32x4*)(gk + k0 + 8 * c + 4); }
#pragma unroll
    for (int j = 0; j < 4; ++j) {
        const int n = (lane >> 3) + 8 * j; const float* s = scr + (8 * c) * 33 + n;
        u32x4 o;
        o.x = pk2bf(s[0 * 33] * g0[0], s[1 * 33] * g0[1]); o.y = pk2bf(s[2 * 33] * g0[2], s[3 * 33] * g0[3]); o.z = pk2bf(s[4 * 33] * g1[0], s[5 * 33] * g1[1]); o.w = pk2bf(s[6 * 33] * g1[2], s[7 * 33] * g1[3]);
        *(u32x4*)(WT + (size_t)(n0 + n) * K + k0 + 8 * c) = o;
    }
    WAVE_LDS_SYNC();
}
namespace pg8 {
#define PG8_LAS __attribute__((address_space(3)))
typedef unsigned short bf16_t;
typedef short bf16x8 __attribute__((ext_vector_type(8)));
typedef float f32x4 __attribute__((ext_vector_type(4)));
typedef unsigned u32x4 __attribute__((ext_vector_type(4)));
constexpr int BM = 256, BK = 64, HALF = 128, HTB = HALF * BK * 2  , STAGE_BYTES = 8 * HTB, NXCD = 8, WGM = 8;

__host__ __device__ __forceinline__ int lds_byte(int r, int c) { const int st = (r >> 4) * 2 + (c >> 5), rr = r & 15, cc = c & 31, ob = rr * 64 + cc * 2; return st * 1024 + (ob ^ (((ob >> 9) & 1) << 5)); }
__host__ __device__ __forceinline__ void stage_rc(int b, int& R, int& C) { const int st = b / 1024, sb = b % 1024, swz = sb ^ (((sb >> 9) & 1) << 5); R = (st >> 1) * 16 + swz / 64; C = (st & 1) * 32 + (swz % 64) / 2; }
__host__ __device__ __forceinline__ int perm32(int rho) { const int n = rho >> 4, i = rho & 15; return 8 * (i >> 2) + 4 * n + (i & 3); }

struct Unit { int pm, pn, idx; };
struct Gemm { const bf16_t* A; const bf16_t* Bt; int M, N, K; };

struct StaticOrder {
    int nM, nN, nwg, G, c;
    __host__ __device__ void init(int M, int N, int G_, int c_) { nM = M / BM; nN = N / BM; nwg = nM * nN; G = G_; c = c_; }
    __host__ __device__ bool next(int i, Unit& u) const {
        const long L = (long)i * G + c; if (L >= nwg) return false;
        int wgid = (int)L; { const int q = nwg / NXCD, r = nwg % NXCD, xcd = wgid % NXCD, off = wgid / NXCD; wgid = (xcd < r ? xcd * (q + 1) : r * (q + 1) + (xcd - r) * q) + off; }
        const int nig = WGM * nN, gid = wgid / nig, fm = gid * WGM, gsz = (nM - fm) < WGM ? (nM - fm) : WGM;
        u.pm = fm + ((wgid % nig) % gsz); u.pn = (wgid % nig) / gsz; u.idx = i; return true;
    }
    __device__ __forceinline__ void a_ready(const Unit&) const {}
    __device__ __forceinline__ void done(const Unit&) const {}
};

__device__ __forceinline__ float row_rstd(const float* ssqp, int row) {
    const f32x4* sp = (const f32x4*)(ssqp + (size_t)row * 16);
    const f32x4 a = sp[0], b = sp[1], c = sp[2], d = sp[3];
    const float s = (((a.x + a.y) + (a.z + a.w)) + ((b.x + b.y) + (b.z + b.w))) + (((c.x + c.y) + (c.z + c.w)) + ((d.x + d.y) + (d.z + d.w)));
    return 1.0f / sqrtf(s * (1.f / 1024.f) + 1e-6f);
}
struct Epi1 {
    static constexpr bool PERM = false, AFTER_DRAIN = false;
    const PG8_LAS float* rstdl; bf16_t* p; float* pn; const float* q_g; const float* k_g;
    __device__ __forceinline__ void operator()(const f32x4 (&acc)[2][2][4][2], const Unit& u, int wr, int wc, int fr, int fq) const {
        const int row0 = u.pm * BM + wr * 64 + fr;
        const bool isq = (u.pn >> 1) == 3, isk = (u.pn >> 1) == 4;
        f32x4 gsc[2][2];
        if (isq || isk) {
#pragma unroll
            for (int bj = 0; bj < 2; ++bj)
#pragma unroll
                for (int n = 0; n < 2; ++n) gsc[bj][n] = *(const f32x4*)((isq ? q_g : k_g) + 32 * bj + 8 * fq + 4 * n) * (isq ? 0.125f * 1.4426950408889634f : 1.f);
        }
#pragma unroll
        for (int ai = 0; ai < 2; ++ai)
#pragma unroll
            for (int m = 0; m < 4; ++m) {
                const int row = row0 + ai * HALF + m * 16; const float rs = rstdl[u.idx * 256 + wr * 64 + fr + ai * HALF + m * 16];
                f32x4 v[2][2];
#pragma unroll
                for (int bj = 0; bj < 2; ++bj)
#pragma unroll
                    for (int n = 0; n < 2; ++n) v[bj][n] = acc[ai][bj][m][n] * rs;
                if (u.pn < 14) {
                    if (isq || isk) {
                        float ss = 0.f;
#pragma unroll
                        for (int bj = 0; bj < 2; ++bj)
#pragma unroll
                            for (int n = 0; n < 2; ++n) ss += (v[bj][n][0] * v[bj][n][0] + v[bj][n][1] * v[bj][n][1]) + (v[bj][n][2] * v[bj][n][2] + v[bj][n][3] * v[bj][n][3]);
                        ss = add_xor16(ss); ss = add_xor32(ss);
                        const float rn = 1.0f / sqrtf(ss * (1.f / 64.f) + 1e-6f);
#pragma unroll
                        for (int bj = 0; bj < 2; ++bj)
#pragma unroll
                            for (int n = 0; n < 2; ++n) v[bj][n] = v[bj][n] * gsc[bj][n] * rn;
                    }
#pragma unroll
                    for (int bj = 0; bj < 2; ++bj) { u32x4 w; w.x = pk2bf(v[bj][0][0], v[bj][0][1]); w.y = pk2bf(v[bj][0][2], v[bj][0][3]); w.z = pk2bf(v[bj][1][0], v[bj][1][1]); w.w = pk2bf(v[bj][1][2], v[bj][1][3]);
                        *(u32x4*)(p + (size_t)row * PBW + u.pn * BM + wc * 64 + bj * 32 + 8 * fq) = w; }
                } else {
#pragma unroll
                    for (int bj = 0; bj < 2; ++bj)
#pragma unroll
                        for (int n = 0; n < 2; ++n) { const int o = u.pn * BM + wc * 32 + 4 * fq + bj * HALF + n * 16 - PBW; if (o < 296) *(f32x4*)(pn + (size_t)row * PNW + o) = v[bj][n]; }
                }
            }
    }
};
struct EpiRes {
    static constexpr bool PERM = false, AFTER_DRAIN = false;
    float* outp; bf16_t* hb; float* ssqp;
    __device__ __forceinline__ void operator()(const f32x4 (&acc)[2][2][4][2], const Unit& u, int wr, int wc, int fr, int fq) const {
        const int row0 = u.pm * BM + wr * 64 + fr, col0 = u.pn * BM + wc * 32 + 8 * fq;
#pragma unroll
        for (int ai = 0; ai < 2; ++ai) {
            u32x4 hw[4][2];
#pragma unroll
            for (int m = 0; m < 4; ++m)
#pragma unroll
                for (int bj = 0; bj < 2; ++bj) hw[m][bj] = *(const u32x4*)(hb + (size_t)(row0 + ai * HALF + m * 16) * DM + col0 + bj * HALF);
            asm volatile("s_waitcnt vmcnt(0)" ::: "memory");
#pragma unroll
            for (int m = 0; m < 4; ++m) {
                const int row = row0 + ai * HALF + m * 16; float ss = 0.f;
#pragma unroll
                for (int bj = 0; bj < 2; ++bj) {
                    const int col = col0 + bj * HALF; bf16_t* hp = hb + (size_t)row * DM + col;
                    const u32x4 h4 = hw[m][bj];
                    const f32x4 v0 = (f32x4){__uint_as_float(h4.x << 16), __uint_as_float(h4.x & 0xffff0000u), __uint_as_float(h4.y << 16), __uint_as_float(h4.y & 0xffff0000u)} + acc[ai][bj][m][0];
                    const f32x4 v1 = (f32x4){__uint_as_float(h4.z << 16), __uint_as_float(h4.z & 0xffff0000u), __uint_as_float(h4.w << 16), __uint_as_float(h4.w & 0xffff0000u)} + acc[ai][bj][m][1];
                    u32x4 w; w.x = pk2bf(v0[0], v0[1]); w.y = pk2bf(v0[2], v0[3]); w.z = pk2bf(v1[0], v1[1]); w.w = pk2bf(v1[2], v1[3]);
                    *(u32x4*)hp = w;
                    if (outp) { *(f32x4*)(outp + (size_t)row * DM + col) = v0; *(f32x4*)(outp + (size_t)row * DM + col + 4) = v1; }
                    const f32x4 r0 = (f32x4){__uint_as_float(w.x << 16), __uint_as_float(w.x & 0xffff0000u), __uint_as_float(w.y << 16), __uint_as_float(w.y & 0xffff0000u)};
                    const f32x4 r1 = (f32x4){__uint_as_float(w.z << 16), __uint_as_float(w.z & 0xffff0000u), __uint_as_float(w.w << 16), __uint_as_float(w.w & 0xffff0000u)};
                    ss += ((r0[0] * r0[0] + r0[1] * r0[1]) + (r0[2] * r0[2] + r0[3] * r0[3])) + ((r1[0] * r1[0] + r1[1] * r1[1]) + (r1[2] * r1[2] + r1[3] * r1[3]));
                }
                ss = add_xor16(ss); ss = add_xor32(ss);
                if (fq == 0) ssqp[(size_t)row * 16 + u.pn * 4 + wc] = ss;
            }
        }
    }
};
__device__ __forceinline__ float dpp_ror1(float x) { return __int_as_float(__builtin_amdgcn_mov_dpp(__float_as_int(x), 0x121, 0xf, 0xf, true)); }
__device__ __forceinline__ float dpp_ror2(float x) { return __int_as_float(__builtin_amdgcn_mov_dpp(__float_as_int(x), 0x122, 0xf, 0xf, true)); }
__device__ __forceinline__ float vmul_s(float a, float b) { float r; asm volatile("v_mul_f32_e32 %0, %1, %2" : "=v"(r) : "v"(a), "v"(b)); return r; }
struct EpiConv {
    static constexpr bool PERM = false, AFTER_DRAIN = false;
    const PG8_LAS float* rstdl; const float* cw; const float* cb; bf16_t* act; float* fix; PG8_LAS unsigned char* halo; PG8_LAS float* ctab;
    __device__ __forceinline__ void operator()(const f32x4 (&acc)[2][2][4][2], const Unit& u, int wr, int wc, int fr_, int fq_) const {
        int fr = fr_, fq = fq_; asm volatile("" : "+v"(fr), "+v"(fq));
        const int row0 = u.pm * BM + wr * 64 + fr, cl = wc * 32 + 4 * fq;
        {
            const int q = 2 * ((wr * 4 + wc) * 64 + fq * 16 + fr), p = q >> 8, col = q & 255;
            const float* src = (p < 3 ? cw + (size_t)p * DFF2 : cb) + (col < 128 ? 128 * u.pn + col : DFF + 128 * u.pn + (col - 128));
            typedef float f32x2w __attribute__((ext_vector_type(2)));
            *(PG8_LAS f32x2w*)(ctab + q) = *(const f32x2w*)src;
        }
        float rs[2][4];
#pragma unroll
        for (int ai = 0; ai < 2; ++ai)
#pragma unroll
            for (int m = 0; m < 4; ++m) rs[ai][m] = rstdl[u.idx * 256 + wr * 64 + fr + ai * HALF + m * 16];
        if (fr >= 14) {
#pragma unroll
            for (int ai = 0; ai < 2; ++ai)
#pragma unroll
                for (int bj = 0; bj < 2; ++bj)
#pragma unroll
                    for (int n = 0; n < 2; ++n) { const f32x4 v = acc[ai][bj][3][n] * rs[ai][3];
                        *(PG8_LAS f32x4*)(halo + ((((ai * 2 + wr) * 2 + (fr - 14)) * 256) + bj * HALF + cl + n * 16) * 4) = v;
                        if (ai == 1 && wr == 1) *(f32x4*)(fix + (size_t)(u.pm * 4 + 2 + (fr - 14)) * DFF2 + bj * DFF + 128 * u.pn + cl + n * 16) = v; }
        }
        if (fr < 2 && wr == 0) {
#pragma unroll
            for (int bj = 0; bj < 2; ++bj)
#pragma unroll
                for (int n = 0; n < 2; ++n) *(f32x4*)(fix + (size_t)(u.pm * 4 + fr) * DFF2 + bj * DFF + 128 * u.pn + cl + n * 16) = acc[0][bj][0][n] * rs[0][0];
        }
        asm volatile("s_waitcnt lgkmcnt(0)\n\ts_barrier" ::: "memory");
        typedef float f32x2v __attribute__((ext_vector_type(2)));
#pragma unroll
        for (int n = 0; n < 2; ++n) {
            const unsigned la2 = (unsigned)(fr * DFF + cl) * 2u;
            unsigned wpk[2][2][4];
#pragma unroll
            for (int eh = 0; eh < 2; ++eh) {
                asm volatile("" ::: "memory"); __builtin_amdgcn_sched_barrier(0);
                const int e = 2 * eh;
#define CWL(p, g) (*(const PG8_LAS f32x2v*)(ctab + (p) * 256 + (g) * 128 + cl + n * 16 + e))
                const f32x2v wu0 = CWL(0, 0), wu1 = CWL(1, 0), wu2 = CWL(2, 0), bu = CWL(3, 0);
                const f32x2v wg0 = CWL(0, 1), wg1 = CWL(1, 1), wg2 = CWL(2, 1), bg = CWL(3, 1);
#undef CWL
#pragma unroll
                for (int ai = 0; ai < 2; ++ai) {
                    const int ps = (ai * 2 + wr) ? (ai * 2 + wr - 1) : 0;
                    const PG8_LAS float* hp = (const PG8_LAS float*)halo + (ps * 2) * 256 + cl + n * 16 + e;
                    const f32x2v hu62 = *(const PG8_LAS f32x2v*)hp, hu63 = *(const PG8_LAS f32x2v*)(hp + 256), hg62 = *(const PG8_LAS f32x2v*)(hp + 128), hg63 = *(const PG8_LAS f32x2v*)(hp + 256 + 128);
                    f32x2v p1u = hu63, p1g = hg63, p2u = fr == 0 ? hu62 : hu63, p2g = fr == 0 ? hg62 : hg63;
#pragma unroll
                    for (int m = 0; m < 4; ++m) {
                        __builtin_amdgcn_sched_barrier(0);
                        f32x2v xu, xg;
                        xu.x = vmul_s(acc[ai][0][m][n][e], rs[ai][m]); xu.y = vmul_s(acc[ai][0][m][n][e + 1], rs[ai][m]); xg.x = vmul_s(acc[ai][1][m][n][e], rs[ai][m]); xg.y = vmul_s(acc[ai][1][m][n][e + 1], rs[ai][m]);
                        f32x2v r1u, r2u, r1g, r2g;
                        r1u.x = dpp_ror1(xu.x); r1u.y = dpp_ror1(xu.y); r2u.x = dpp_ror2(xu.x); r2u.y = dpp_ror2(xu.y);
                        r1g.x = dpp_ror1(xg.x); r1g.y = dpp_ror1(xg.y); r2g.x = dpp_ror2(xg.x); r2g.y = dpp_ror2(xg.y);
                        const f32x2v x1u = fr >= 1 ? r1u : p1u, x2u = fr >= 2 ? r2u : p2u, x1g = fr >= 1 ? r1g : p1g, x2g = fr >= 2 ? r2g : p2g;
                        p1u = r1u; p2u = r2u; p1g = r1g; p2g = r2g;
                        const f32x2v cu = bu + wu0 * x2u + wu1 * x1u + wu2 * xu, cg = bg + wg0 * x2g + wg1 * x1g + wg2 * xg;
                        const float o0 = cg.x * __builtin_amdgcn_rcpf(1.f + __builtin_amdgcn_exp2f(-1.4426950408889634f * cg.x)) * cu.x;
                        const float o1 = cg.y * __builtin_amdgcn_rcpf(1.f + __builtin_amdgcn_exp2f(-1.4426950408889634f * cg.y)) * cu.y;
                        wpk[eh][ai][m] = pk2bf(o0, o1);
                    }
                }
            }
#pragma unroll
            for (int ai = 0; ai < 2; ++ai)
#pragma unroll
                for (int m = 0; m < 4; ++m)
                {
                    u32x2 w; w.x = wpk[0][ai][m]; w.y = wpk[1][ai][m];
                    *(u32x2*)((char*)(act + (size_t)(u.pm * BM + wr * 64 + ai * HALF + m * 16) * DFF + 128 * u.pn + n * 16) + la2) = w; }
        }
    }
};

#ifdef TPROBE
#ifndef TPROBE_PH
#define TPROBE_PH -1
#endif
#define PG8_TP(ph) do { if (TPROBE < 20) break; const unsigned t_ = (unsigned)__builtin_amdgcn_s_memrealtime(); if (wave_s == 0 && lane_id() == 0) { volatile PG8_LAS unsigned* q_ = (volatile PG8_LAS unsigned*)(lds + (163840 - 1024 + 512)); \
        if ((ph) == TPROBE && (TPROBE_PH < 0 || q_[2] == (unsigned)TPROBE_PH)) q_[1] += t_ - q_[0]; q_[0] = t_; } } while (0)
#else
#define PG8_TP(ph) do {} while (0)
#endif
template <class Epi, class Sched, bool ALIGN_EPI = false, bool SP2 = false>
__device__ __forceinline__ void gemm_phase(PG8_LAS unsigned char* lds, const Gemm g, const Sched& S, const Epi& E, const int wave_s) {
    int tid_ = wave_s * 64 + lane_id(); asm volatile("" : "+v"(tid_));
    const int tid = tid_, wid = wave_s, lane = tid & 63, wr = wid >> 2, wc = wid & 3, fr = lane & 15, fq = lane >> 4;
    const int K = g.K, nt = K / BK;
    unsigned voffA[2], voffB[2];
#pragma unroll
    for (int i = 0; i < 2; ++i) { int R, C; stage_rc(tid * 16 + i * 8192, R, C); const int Rb = Epi::PERM ? ((R & ~31) + perm32(R & 31)) : R;
        voffA[i] = (unsigned)(R * K + C) * 2u; voffB[i] = (unsigned)(Rb * K + C) * 2u; }
    const size_t kstep = (size_t)(BK * 2);
    const size_t hstep = (size_t)HALF * K * 2;
    const size_t tstep = 2 * hstep;
    const unsigned ldsw = (unsigned)wid * 1024u;
    const int aoff = lds_byte(wr * 64 + fr, fq * 8), boff = lds_byte(wc * 32 + fr, fq * 8);
#define PG8_SA(b, h) (((b) * 2 + (h)) * HTB)
#define PG8_SB(b, h) ((4 + (b) * 2 + (h)) * HTB)
#define PG8_STAGE(bufoff, gbase, voff) do { _Pragma("unroll") for (int _i = 0; _i < 2; ++_i) \
        __builtin_amdgcn_global_load_lds((const unsigned*)((const char*)(gbase) + (voff)[_i]), (PG8_LAS unsigned*)(lds + (bufoff) + ldsw + _i * 8192), 16, 0, 0); } while (0)
#define PG8_LDA(dst, b, h) do { _Pragma("unroll") for (int m = 0; m < 4; ++m) _Pragma("unroll") for (int k = 0; k < 2; ++k) dst[m][k] = *(const PG8_LAS bf16x8*)(lds + PG8_SA(b, h) + aoff + m * 2048 + k * 1024); } while (0)
#define PG8_LDB(dst, b, h) do { _Pragma("unroll") for (int n = 0; n < 2; ++n) _Pragma("unroll") for (int k = 0; k < 2; ++k) dst[n][k] = *(const PG8_LAS bf16x8*)(lds + PG8_SB(b, h) + boff + n * 2048 + k * 1024); } while (0)
#define PG8_MMA(ai, bj, At, Bt) do { __builtin_amdgcn_s_setprio(1); _Pragma("unroll") for (int m = 0; m < 4; ++m) _Pragma("unroll") for (int n = 0; n < 2; ++n) _Pragma("unroll") for (int k = 0; k < 2; ++k) \
        acc[ai][bj][m][n] = __builtin_amdgcn_mfma_f32_16x16x32_bf16(Bt[n][k], At[m][k], acc[ai][bj][m][n], 0, 0, 0); __builtin_amdgcn_s_setprio(0); } while (0)
#define PG8_WAIT_V(n) asm volatile("s_waitcnt vmcnt(" #n ")" ::: "memory")
#define PG8_WAIT_L(n) asm volatile("s_waitcnt lgkmcnt(" #n ")" ::: "memory")
#define PG8_BAR __builtin_amdgcn_s_barrier()
#define PG8_SCHED __builtin_amdgcn_sched_barrier(0)
    Unit cur, nxt; int ui = 0;
    if (!S.next(0, cur)) return;
    f32x4 acc[2][2][4][2];
#pragma unroll
    for (int a = 0; a < 2; ++a)
#pragma unroll
        for (int b = 0; b < 2; ++b)
#pragma unroll
            for (int m = 0; m < 4; ++m)
#pragma unroll
                for (int n = 0; n < 2; ++n) acc[a][b][m][n] = (f32x4){0.f, 0.f, 0.f, 0.f};
    bf16x8 At[4][2], B0[2][2], B1[2][2];
    const char* cA = (const char*)g.A + (size_t)cur.pm * tstep; const char* cB = (const char*)g.Bt + (size_t)cur.pn * tstep;
    S.a_ready(cur);
    if constexpr (SP2) {
        PG8_STAGE(PG8_SB(0, 0), cB, voffB); PG8_STAGE(PG8_SB(0, 1), cB + hstep, voffB); PG8_STAGE(PG8_SA(0, 0), cA, voffA); PG8_STAGE(PG8_SA(0, 1), cA + hstep, voffA);
        if (wr == 1) PG8_BAR;
        PG8_WAIT_V(2); PG8_BAR;
        PG8_STAGE(PG8_SB(1, 0), cB + kstep, voffB); PG8_STAGE(PG8_SA(1, 0), cA + kstep, voffA); PG8_STAGE(PG8_SB(1, 1), cB + hstep + kstep, voffB);
        PG8_WAIT_V(6); PG8_BAR;
    } else {
        PG8_STAGE(PG8_SB(0, 0), cB, voffB); PG8_STAGE(PG8_SA(0, 0), cA, voffA); PG8_STAGE(PG8_SB(0, 1), cB + hstep, voffB); PG8_STAGE(PG8_SA(0, 1), cA + hstep, voffA);
        if (wr == 1) PG8_BAR;
        PG8_WAIT_V(4); PG8_BAR;
        PG8_STAGE(PG8_SB(1, 0), cB + kstep, voffB); PG8_STAGE(PG8_SA(1, 0), cA + kstep, voffA); PG8_STAGE(PG8_SB(1, 1), cB + hstep + kstep, voffB);
        PG8_WAIT_V(6); PG8_BAR;
    }
    for (;;) {
        const bool has_next = S.next(ui + 1, nxt);
        const char* nA = has_next ? (const char*)g.A + (size_t)nxt.pm * tstep : cA; const char* nB = has_next ? (const char*)g.Bt + (size_t)nxt.pn * tstep : cB;
        for (int t = 0; t < nt; t += 2) {
            const bool last = (t == nt - 2);
            const char* a1 = cA + (size_t)(t + 1) * kstep;
            const char* a2 = last ? nA : cA + (size_t)(t + 2) * kstep; const char* b2 = last ? nB : cB + (size_t)(t + 2) * kstep;
            const char* a3 = a2 + kstep; const char* b3 = b2 + kstep;
            if (last && has_next) S.a_ready(nxt);
            if constexpr (SP2) {
            PG8_LDB(B0, 0, 0); PG8_LDB(B1, 0, 1); PG8_SCHED; PG8_LDA(At, 0, 0); PG8_STAGE(PG8_SA(1, 1), a1 + hstep, voffA);
            PG8_WAIT_V(8); PG8_WAIT_L(0); PG8_BAR; PG8_MMA(0, 0, At, B0); PG8_MMA(0, 1, At, B1); PG8_BAR; PG8_SCHED;
            PG8_LDA(At, 0, 1); PG8_STAGE(PG8_SB(0, 0), b2, voffB); PG8_STAGE(PG8_SB(0, 1), b2 + hstep, voffB); PG8_STAGE(PG8_SA(0, 0), a2, voffA);
            PG8_WAIT_V(8); PG8_WAIT_L(0); PG8_BAR; PG8_MMA(1, 0, At, B0); PG8_MMA(1, 1, At, B1); PG8_BAR; PG8_SCHED;
            PG8_LDB(B0, 1, 0); PG8_LDB(B1, 1, 1); PG8_SCHED; PG8_LDA(At, 1, 0); PG8_STAGE(PG8_SA(0, 1), a2 + hstep, voffA);
            PG8_WAIT_V(8); PG8_WAIT_L(0); PG8_BAR; PG8_MMA(0, 0, At, B0); PG8_MMA(0, 1, At, B1); PG8_BAR; PG8_SCHED;
            PG8_LDA(At, 1, 1); PG8_STAGE(PG8_SB(1, 0), b3, voffB); PG8_STAGE(PG8_SB(1, 1), b3 + hstep, voffB); PG8_STAGE(PG8_SA(1, 0), a3, voffA);
            PG8_WAIT_V(8); PG8_WAIT_L(0); PG8_BAR; PG8_MMA(1, 0, At, B0); PG8_MMA(1, 1, At, B1); PG8_BAR; PG8_SCHED;
            } else {
            PG8_LDB(B0, 0, 0); PG8_SCHED; PG8_LDA(At, 0, 0); PG8_STAGE(PG8_SA(1, 1), a1 + hstep, voffA);
            PG8_WAIT_L(8); PG8_BAR; PG8_WAIT_L(0); PG8_MMA(0, 0, At, B0); PG8_BAR; PG8_SCHED;
            PG8_LDB(B1, 0, 1); PG8_STAGE(PG8_SB(0, 0), b2, voffB);
            PG8_BAR; PG8_WAIT_L(0); PG8_MMA(0, 1, At, B1); PG8_BAR;
            PG8_LDA(At, 0, 1); PG8_STAGE(PG8_SA(0, 0), a2, voffA);
            PG8_BAR; PG8_WAIT_L(0); PG8_MMA(1, 0, At, B0); PG8_BAR; PG8_SCHED;
            PG8_STAGE(PG8_SB(0, 1), b2 + hstep, voffB);
            PG8_WAIT_V(6); PG8_BAR; PG8_MMA(1, 1, At, B1); PG8_BAR;
            PG8_LDB(B0, 1, 0); PG8_SCHED; PG8_LDA(At, 1, 0); PG8_STAGE(PG8_SA(0, 1), a2 + hstep, voffA);
            PG8_WAIT_L(8); PG8_BAR; PG8_WAIT_L(0); PG8_MMA(0, 0, At, B0); PG8_BAR; PG8_SCHED;
            PG8_LDB(B1, 1, 1); PG8_STAGE(PG8_SB(1, 0), b3, voffB);
            PG8_BAR; PG8_WAIT_L(0); PG8_MMA(0, 1, At, B1); PG8_BAR;
            PG8_LDA(At, 1, 1); PG8_STAGE(PG8_SA(1, 0), a3, voffA);
            PG8_BAR; PG8_WAIT_L(0); PG8_MMA(1, 0, At, B0); PG8_BAR; PG8_SCHED;
            PG8_STAGE(PG8_SB(1, 1), b3 + hstep, voffB);
            PG8_WAIT_V(6); PG8_BAR; PG8_MMA(1, 1, At, B1); PG8_BAR;
            }
        }
        PG8_TP(49);
        if constexpr (ALIGN_EPI) { if (wr == 0) PG8_BAR; }
        if constexpr (!Epi::AFTER_DRAIN) { E(acc, cur, wr, wc, fr, fq); S.done(cur); }
        PG8_TP(50);
        if (!has_next) break;
#pragma unroll
        for (int a = 0; a < 2; ++a)
#pragma unroll
            for (int b = 0; b < 2; ++b)
#pragma unroll
                for (int m = 0; m < 4; ++m)
#pragma unroll
                    for (int n = 0; n < 2; ++n) acc[a][b][m][n] = (f32x4){0.f, 0.f, 0.f, 0.f};
        cur = nxt; cA = nA; cB = nB; ++ui;
        if constexpr (ALIGN_EPI) { if (wr == 1) PG8_BAR; }
    }
    PG8_WAIT_V(0);
    if constexpr (!ALIGN_EPI) { if (wr == 0) PG8_BAR; }
    PG8_BAR;
    if constexpr (Epi::AFTER_DRAIN) { E.fused(acc, cur, wr, wc, fr, fq, lds, wid, lane); S.done(cur); }
#undef PG8_SA
#undef PG8_SB
#undef PG8_STAGE
#undef PG8_LDA
#undef PG8_LDB
#undef PG8_MMA
#undef PG8_WAIT_V
#undef PG8_WAIT_L
#undef PG8_BAR
#undef PG8_SCHED
}
}
#include <hip/hip_bf16.h>
#include <cmath>
namespace attn_body {
using bf16=__hip_bfloat16;
using bf16x8=__attribute__((ext_vector_type(8)))short;
using s16x4=__attribute__((ext_vector_type(4)))short;
using f32x16=__attribute__((ext_vector_type(16)))float;
using u32x4=__attribute__((ext_vector_type(4)))unsigned;
constexpr int BATCH=8,NHEAD=8,SEQ=2048,D=64,PITCH=3584,OPITCH=1024,LEADROW=16384,VK=2176;
constexpr int NW=8,QBLK=32,QB=QBLK*NW,KVBLK=64,NQB=SEQ/QB;
constexpr int ATTN_UNIT_ROWS=QB;
__device__ __forceinline__ int crow(int r,int hi){return (r&3)+8*(r>>2)+4*hi;}
#define SBAR() __builtin_amdgcn_sched_barrier(0)
__device__ __forceinline__ void cmask(f32x16&p0,f32x16&p1,int jb,int qrel,int hi){
  const float NEG=-INFINITY; int kb=64*jb+4*hi;
  #pragma unroll
  for(int r=0;r<16;++r){int kv=kb+(r&3)+8*(r>>2); if(kv>qrel)p0[r]=NEG; if(kv+32>qrel)p1[r]=NEG;}
}

constexpr int NSLOT=3, SLOTB=8192;
constexpr int LDS_K=0, LDS_V=NSLOT*SLOTB, LDS_WS=2*NSLOT*SLOTB, LDS_OST=LDS_WS+NW*64*4, LDS_C2=LDS_OST+NW*4096, LDS_BYTES=LDS_C2+VK*4;
constexpr float C2=0.125f*1.4426950408889634f;
__device__ __forceinline__ void glds16(const void*gsrc,unsigned lds_dst){unsigned keep;
  asm volatile("s_mov_b32 %0, m0\n\ts_mov_b32 m0, %2\n\ts_nop 0\n\tglobal_load_lds_dwordx4 %1, off\n\ts_mov_b32 m0, %0":"=&s"(keep):"v"(gsrc),"s"(lds_dst):"memory");}
__device__ __forceinline__ float max3f(float a,float b,float c){float r;asm("v_max3_f32 %0, %1, %2, %3":"=v"(r):"v"(a),"v"(b),"v"(c));return r;}
__device__ __forceinline__ float max2f(float a,float b){float r;asm("v_max_f32_e32 %0, %1, %2":"=v"(r):"v"(a),"v"(b));return r;}
__device__ __forceinline__ float fadd_s(float a,float b){float r;asm("v_add_f32_e32 %0, %1, %2":"=v"(r):"v"(a),"v"(b));return r;}
__device__ __forceinline__ float fsub_s(float a,float b){float r;asm("v_sub_f32_e32 %0, %1, %2":"=v"(r):"v"(a),"v"(b));return r;}
typedef float f32x2_t __attribute__((ext_vector_type(2))); typedef __bf16 bf16x2_t __attribute__((ext_vector_type(2)));
__device__ __forceinline__ unsigned cvtpk_s(float lo,float hi){f32x2_t v={lo,hi};bf16x2_t b=__builtin_convertvector(v,bf16x2_t);return __builtin_bit_cast(unsigned,b);}
#define WAIT_BAR(N) asm volatile("s_waitcnt vmcnt(" #N ") lgkmcnt(0)\n\ts_barrier":::"memory")

__device__ __forceinline__ void qkt(f32x16&p0,f32x16&p1,const char*Kslot,const bf16x8*qr,int r32,int hi){
  const char*kb=Kslot+hi*1024+r32*16;
  #pragma unroll
  for(int d0=0;d0<4;++d0){
    const bf16x8 b0=*reinterpret_cast<const bf16x8*>(kb+d0*2048);
    const bf16x8 b1=*reinterpret_cast<const bf16x8*>(kb+d0*2048+512);
    p0=__builtin_amdgcn_mfma_f32_32x32x16_bf16(b0,qr[d0],p0,0,0,0);p1=__builtin_amdgcn_mfma_f32_32x32x16_bf16(b1,qr[d0],p1,0,0,0);}
}
typedef __attribute__((address_space(3))) const char* lds_cptr;
typedef short v4i16_t __attribute__((ext_vector_type(4)));
__device__ __forceinline__ void kload8(bf16x8*kf,lds_cptr kp){
  kf[0]=*(const __attribute__((address_space(3))) bf16x8*)(kp);      kf[1]=*(const __attribute__((address_space(3))) bf16x8*)(kp+512);
  kf[2]=*(const __attribute__((address_space(3))) bf16x8*)(kp+2048); kf[3]=*(const __attribute__((address_space(3))) bf16x8*)(kp+2560);
  kf[4]=*(const __attribute__((address_space(3))) bf16x8*)(kp+4096); kf[5]=*(const __attribute__((address_space(3))) bf16x8*)(kp+4608);
  kf[6]=*(const __attribute__((address_space(3))) bf16x8*)(kp+6144); kf[7]=*(const __attribute__((address_space(3))) bf16x8*)(kp+6656);
}
__device__ __forceinline__ void kload2(bf16x8*kf,lds_cptr kp,int j){ kf[2*j]=*(const __attribute__((address_space(3))) bf16x8*)(kp+j*2048); kf[2*j+1]=*(const __attribute__((address_space(3))) bf16x8*)(kp+j*2048+512); }
__device__ __forceinline__ s16x4 vtr(lds_cptr p){ return __builtin_bit_cast(s16x4,__builtin_amdgcn_ds_read_tr16_b64_v4i16((__attribute__((address_space(3))) v4i16_t*)p)); }
__device__ __forceinline__ float rowmax(const f32x16&p0,const f32x16&p1){
  float a=max3f(p0[0],p0[1],p1[0]),b=max3f(p0[2],p0[3],p1[1]);a=max3f(a,p1[2],p1[3]);
  #pragma unroll
  for(int r=4;r<16;r+=4){a=max3f(a,p0[r],p0[r+1]);b=max3f(b,p0[r+2],p0[r+3]);a=max3f(a,p1[r],p1[r+1]);b=max3f(b,p1[r+2],p1[r+3]);}
  const float m=max2f(a,b);
  auto rr=__builtin_amdgcn_permlane32_swap(__float_as_uint(m),__float_as_uint(m),false,false);
  return max2f(__uint_as_float(rr[0]),__uint_as_float(rr[1]));
}
__device__ __forceinline__ void pv(f32x16*o,int vb,bf16x8 pa0,bf16x8 pa1,bf16x8 pa2,bf16x8 pa3){
  #pragma unroll
  for(int d0=0;d0<2;++d0){s16x4 lo[4],hi[4];
    #pragma unroll
    for(int ks=0;ks<4;++ks){
      asm volatile("ds_read_b64_tr_b16 %0,%1 offset:%c2":"=&v"(lo[ks]):"v"(vb),"i"(d0*4096+ks*1024):"memory");
      asm volatile("ds_read_b64_tr_b16 %0,%1 offset:%c2":"=&v"(hi[ks]):"v"(vb),"i"(d0*4096+ks*1024+512):"memory");}
    asm volatile("s_waitcnt lgkmcnt(0)":::"memory");SBAR();
    #define PK(k) (bf16x8){lo[k][0],lo[k][1],lo[k][2],lo[k][3],hi[k][0],hi[k][1],hi[k][2],hi[k][3]}
    o[d0]=__builtin_amdgcn_mfma_f32_32x32x16_bf16(pa0,PK(0),o[d0],0,0,0);
    o[d0]=__builtin_amdgcn_mfma_f32_32x32x16_bf16(pa1,PK(1),o[d0],0,0,0);
    o[d0]=__builtin_amdgcn_mfma_f32_32x32x16_bf16(pa2,PK(2),o[d0],0,0,0);
    o[d0]=__builtin_amdgcn_mfma_f32_32x32x16_bf16(pa3,PK(3),o[d0],0,0,0);
    #undef PK
  }
}

#ifndef ATTN_STORE16
#define ATTN_STORE16(p,v) (*(u32x4*)(p)=(v))
#endif
template<int THRL> __device__ __forceinline__ void attn_unit(int b,int h,int qb,const bf16*Q,const bf16*__restrict__ K,const bf16*__restrict__ V,const bf16*__restrict__ OG,const float*__restrict__ c2v,bf16*O,char*shm,const int wave_s,const bool stage_c2=true){
  int tid_=wave_s*64+lane_id(); asm volatile("":"+v"(tid_));
  const int tid=tid_,lane=tid&63,r32=lane&31,hi=lane>>5; const int wid=wave_s;
  const long rowbase=(long)b*SEQ; const int q0=qb*QB;
  const bf16*Qw=Q+(rowbase+q0+wid*QBLK)*PITCH+h*D;
  const bf16*Kh=K+(rowbase-2*KVBLK)*PITCH+h*D,*Vh=V+(rowbase-2*KVBLK)*PITCH+h*D;
  const bf16*KhL=K+(long)LEADROW*PITCH+h*D,*VhL=V+(long)LEADROW*PITCH+h*D;
  const unsigned lds0=(unsigned)(uintptr_t)shm;
  float*wsf=(float*)(shm+LDS_WS)+wid*64;
  const bf16*ksrc=Kh+(long)lane*PITCH+wid*8,*ksrcL=KhL+(long)lane*PITCH+wid*8;
  const bf16*vsrc=Vh+(long)(16*(wid&3)+(lane>>2))*PITCH+(wid>>2)*32+(lane&3)*8,*vsrcL=VhL+(long)(16*(wid&3)+(lane>>2))*PITCH+(wid>>2)*32+(lane&3)*8;
  const unsigned kdst=lds0+LDS_K+wid*1024, vdst=lds0+LDS_V+wid*1024;
  #define DMA_K(t,slot) glds16(((t)<2?ksrcL:ksrc)+(long)(t)*KVBLK*PITCH,(unsigned)__builtin_amdgcn_readfirstlane(kdst+(slot)))
  #define DMA_V(t,slot) glds16(((t)<2?vsrcL:vsrc)+(long)(t)*KVBLK*PITCH,(unsigned)__builtin_amdgcn_readfirstlane(vdst+(slot)))
  const int vb0=(int)(lds0+LDS_V)+((lane>>4)&1)*32+(lane&3)*8+(4*hi+((lane&15)>>2))*64;
  const char*Kbase=shm+LDS_K; bf16x8 kf[8];
  const lds_cptr shm3=(lds_cptr)shm; const lds_cptr kp0=shm3+LDS_K+hi*1024+r32*16; const lds_cptr vp0=shm3+LDS_V+((lane>>4)&1)*32+(lane&3)*8+(4*hi+((lane&15)>>2))*64;
  const int NT=(q0+QB)/KVBLK+2;
  if(stage_c2){ __attribute__((address_space(3))) float*negc_w=(__attribute__((address_space(3))) float*)((lds_cptr)shm+LDS_C2); const float*cs=c2v+(long)(b*NHEAD+h)*VK;
    float cv_[5];
    _Pragma("unroll") for(int i_=0;i_<5;++i_){const int i=tid+i_*NW*64; cv_[i_]=i<NT*KVBLK?cs[i]:0.f;}
    _Pragma("unroll") for(int i_=0;i_<5;++i_){const int i=tid+i_*NW*64; if(i<NT*KVBLK)negc_w[i]=-cv_[i_];} }
  const __attribute__((address_space(3))) float* negc3=(const __attribute__((address_space(3))) float*)((lds_cptr)shm+LDS_C2)+4*hi;
  typedef float f32x4_t __attribute__((ext_vector_type(4)));
  #define NEGC(t,i) (*(const __attribute__((address_space(3))) f32x4_t*)(negc3+64*(t)+(((i)>>2)*32)+8*((i)&3)))
  DMA_K(0,0);DMA_V(0,0);DMA_K(1,SLOTB);
  bf16x8 qr[4];
  #pragma unroll
  for(int d0=0;d0<4;++d0)qr[d0]=*reinterpret_cast<const bf16x8*>(&Qw[(long)r32*PITCH+d0*16+hi*8]);
  float mhat=0.f,l_reg=0.f;f32x16 o[2];o[0]=f32x16{};o[1]=f32x16{};
  const int qrel=wid*QBLK+r32;
  #define CMASK(P0,P1,t) do{int jb_=(t)-(NT-4); if(jb_>=0)cmask(P0,P1,jb_,qrel,hi);}while(0)
  bool resc=false;
  #define START(P0,P1) do{ const float rm=rowmax(P0,P1); resc=false; \
    { const float dl=rm; mhat=fadd_s(mhat,dl); \
      _Pragma("unroll") for(int r=0;r<16;++r){P0[r]=fsub_s(P0[r],dl);P1[r]=fsub_s(P1[r],dl);} } \
    _Pragma("unroll") for(int r=0;r<16;++r)P0[r]=__builtin_amdgcn_exp2f(P0[r]); }while(0)
  #define RESC() do{ if(resc){ asm volatile("s_waitcnt lgkmcnt(0)":::"memory"); \
      _Pragma("unroll") for(int d_=0;d_<2;++d_) _Pragma("unroll") for(int r=0;r<16;++r)o[d_][r]*=wsf[crow(r,hi)]; } }while(0)
  f32x16 pA0,pA1,pB0,pB1;
  int sl_prev=0,sl_cur=0,sl_next=SLOTB;
  #define ROT() do{sl_prev=sl_cur;sl_cur=sl_next;sl_next=(sl_next==(NSLOT-1)*SLOTB)?0:sl_next+SLOTB;}while(0)
  DMA_K(2,2*SLOTB);
  WAIT_BAR(3);
  #define FILLT(P0,P1,t) do{ _Pragma("unroll") for(int i_=0;i_<4;++i_){ const f32x4_t a_=NEGC(t,i_),b_=NEGC(t,4+i_); \
      P0[4*i_]=a_[0]-mhat;P0[4*i_+1]=a_[1]-mhat;P0[4*i_+2]=a_[2]-mhat;P0[4*i_+3]=a_[3]-mhat; P1[4*i_]=b_[0]-mhat;P1[4*i_+1]=b_[1]-mhat;P1[4*i_+2]=b_[2]-mhat;P1[4*i_+3]=b_[3]-mhat; } }while(0)
  FILLT(pA0,pA1,0);
  qkt(pA0,pA1,Kbase,qr,r32,hi);asm volatile("s_nop 15\n\ts_nop 7":"+v"(pA0),"+v"(pA1));CMASK(pA0,pA1,0);
  START(pA0,pA1);
  FILLT(pB0,pB1,1);
  _Pragma("unroll") for(int r=0;r<16;++r)pA1[r]=__builtin_amdgcn_exp2f(pA1[r]);
  WAIT_BAR(0);
  DMA_K(3,0);DMA_V(1,SLOTB);
  ROT();
  kload8(kf,kp0+sl_cur);
  WAIT_BAR(2);
  s16x4 vlo[8],vhi[8]; u32x4 pw0,pw1,pw2,pw3;
  #define PKW(P,B) cvtpk_s(P[B],P[B+1])
  #define PAF(k) __builtin_bit_cast(bf16x8,pw##k)
  #define VFR(i) (bf16x8){vlo[i][0],vlo[i][1],vlo[i][2],vlo[i][3],vhi[i][0],vhi[i][1],vhi[i][2],vhi[i][3]}
  #define PIN(x) asm volatile("":"+v"(x))
  #define MX3(a,b,c) __builtin_fmaxf(__builtin_fmaxf((a),(b)),(c))
  #define GAPA(MF,A0,A1,A2,A3,W0,W1,PW) do{ MF; sacc+=A0; sacc+=A1; sacc+=A2; sacc+=A3; PIN(sacc); W0; W1; PIN(PW); SBAR(); }while(0)
  #define EX(v) __builtin_amdgcn_exp2f(v)
  #define GAPB(MF,X,B,FP,FB,I,t,GF) do{ MF; X[B]=EX(X[B]); X[B+1]=EX(X[B+1]); X[B+2]=EX(X[B+2]); X[B+3]=EX(X[B+3]); \
      if(GF){ FP[FB]=fsub_s(cn_[0],mhat); FP[FB+1]=fsub_s(cn_[1],mhat); FP[FB+2]=fsub_s(cn_[2],mhat); FP[FB+3]=fsub_s(cn_[3],mhat); PIN(FP); if((I)<7){cn_=NEGC((t)+1,(I)+1);} } \
      PIN(X); SBAR(); }while(0)
  #define VRD(i) do{ vlo[i]=vtr(vp_+(((i)>>2)*4096+((i)&3)*1024)); vhi[i]=vtr(vp_+(((i)>>2)*4096+((i)&3)*1024+512)); }while(0)
  #define KRD(G,j) do{ if(G){ kload2(kf,kp0+sl_next,j); SBAR(); } }while(0)
  #define STEP(C0,C1,P0,P1,t,GK,GV,GL) do{ SBAR(); \
    const lds_cptr vp_=vp0+sl_prev; \
    VRD(0); SBAR(); float sacc=(P0[0]+P0[1]); \
    GAPA(C0=__builtin_amdgcn_mfma_f32_32x32x16_bf16(kf[0],qr[0],C0,0,0,0), P0[2],P0[3],P0[4],P0[5],     pw0[0]=PKW(P0,0), pw0[1]=PKW(P0,2), pw0); \
    VRD(4); SBAR(); GAPA(C1=__builtin_amdgcn_mfma_f32_32x32x16_bf16(kf[1],qr[0],C1,0,0,0), P0[6],P0[7],P0[8],P0[9],     pw0[2]=PKW(P0,4), pw0[3]=PKW(P0,6), pw0); \
    VRD(1); SBAR(); GAPA(C0=__builtin_amdgcn_mfma_f32_32x32x16_bf16(kf[2],qr[1],C0,0,0,0),   P0[10],P0[11],P0[12],P0[13], pw1[0]=PKW(P0,8), pw1[1]=PKW(P0,10), pw1); \
    VRD(5); SBAR(); GAPA(C1=__builtin_amdgcn_mfma_f32_32x32x16_bf16(kf[3],qr[1],C1,0,0,0),   P0[14],P0[15],P1[0],P1[1],   pw1[2]=PKW(P0,12),pw1[3]=PKW(P0,14), pw1); \
    VRD(2); SBAR(); GAPA(C0=__builtin_amdgcn_mfma_f32_32x32x16_bf16(kf[4],qr[2],C0,0,0,0),   P1[2],P1[3],P1[4],P1[5],     pw2[0]=PKW(P1,0), pw2[1]=PKW(P1,2), pw2); \
    VRD(6); SBAR(); GAPA(C1=__builtin_amdgcn_mfma_f32_32x32x16_bf16(kf[5],qr[2],C1,0,0,0),   P1[6],P1[7],P1[8],P1[9],     pw2[2]=PKW(P1,4), pw2[3]=PKW(P1,6), pw2); \
    VRD(3); SBAR(); GAPA(C0=__builtin_amdgcn_mfma_f32_32x32x16_bf16(kf[6],qr[3],C0,0,0,0),   P1[10],P1[11],P1[12],P1[13], pw3[0]=PKW(P1,8), pw3[1]=PKW(P1,10), pw3); \
    VRD(7); SBAR(); GAPA(C1=__builtin_amdgcn_mfma_f32_32x32x16_bf16(kf[7],qr[3],C1,0,0,0),   P1[14],P1[15],0.f,0.f,       pw3[2]=PKW(P1,12),pw3[3]=PKW(P1,14), pw3); \
    l_reg+=sacc; \
    if(GK){DMA_K((t)+3,sl_cur);} if(GV){DMA_V((t)+1,sl_next);} \
    CMASK(C0,C1,t); \
    { float a=MX3(C0[0],C0[1],C1[0]),b=MX3(C0[2],C0[3],C1[1]); a=MX3(a,C1[2],C1[3]); \
      _Pragma("unroll") for(int r=4;r<16;r+=4){a=MX3(a,C0[r],C0[r+1]);b=MX3(b,C0[r+2],C0[r+3]);a=MX3(a,C1[r],C1[r+1]);b=MX3(b,C1[r+2],C1[r+3]);} \
      float rm=__builtin_fmaxf(a,b); { auto rr=__builtin_amdgcn_permlane32_swap(__float_as_uint(rm),__float_as_uint(rm),false,false); rm=__builtin_fmaxf(__uint_as_float(rr[0]),__uint_as_float(rr[1])); } \
      resc=false; \
      if(__builtin_expect(__any(rm>(float)THRL),0)){ const float dl=__builtin_fmaxf(rm,0.f); mhat+=dl; \
        _Pragma("unroll") for(int r=0;r<16;++r){C0[r]-=dl;C1[r]-=dl;} \
        const float f=__builtin_amdgcn_exp2f(-dl); l_reg*=f; if(hi==0)wsf[r32]=f; resc=true; } } \
    f32x4_t cn_=(f32x4_t){0.f,0.f,0.f,0.f}; if(GL){cn_=NEGC((t)+1,0);} \
    SBAR(); \
    GAPB(o[0]=__builtin_amdgcn_mfma_f32_32x32x16_bf16(PAF(0),VFR(0),o[0],0,0,0), C0,0,P0,0,0,t,GL); \
    GAPB(o[1]=__builtin_amdgcn_mfma_f32_32x32x16_bf16(PAF(0),VFR(4),o[1],0,0,0), C0,4,P0,4,1,t,GL); \
    KRD(GL,0); GAPB(o[0]=__builtin_amdgcn_mfma_f32_32x32x16_bf16(PAF(1),VFR(1),o[0],0,0,0), C0,8,P0,8,2,t,GL); \
    KRD(GL,1); GAPB(o[1]=__builtin_amdgcn_mfma_f32_32x32x16_bf16(PAF(1),VFR(5),o[1],0,0,0), C0,12,P0,12,3,t,GL); \
    KRD(GL,2); GAPB(o[0]=__builtin_amdgcn_mfma_f32_32x32x16_bf16(PAF(2),VFR(2),o[0],0,0,0), C1,0,P1,0,4,t,GL); \
    KRD(GL,3); GAPB(o[1]=__builtin_amdgcn_mfma_f32_32x32x16_bf16(PAF(2),VFR(6),o[1],0,0,0), C1,4,P1,4,5,t,GL); \
    GAPB(o[0]=__builtin_amdgcn_mfma_f32_32x32x16_bf16(PAF(3),VFR(3),o[0],0,0,0), C1,8,P1,8,6,t,GL); \
    GAPB(o[1]=__builtin_amdgcn_mfma_f32_32x32x16_bf16(PAF(3),VFR(7),o[1],0,0,0), C1,12,P1,12,7,t,GL); \
    }while(0)
  int t=1;
  #undef CMASK
  #define CMASK(P0,P1,t) do{}while(0)
  for(;t+5<NT;t+=2){
    STEP(pB0,pB1,pA0,pA1,t,true,true,true);     WAIT_BAR(2); RESC(); ROT();
    STEP(pA0,pA1,pB0,pB1,t+1,true,true,true);   WAIT_BAR(2); RESC(); ROT();
  }
  #undef CMASK
  #define CMASK(P0,P1,t) do{int jb_=(t)-(NT-4); if(jb_>=0)cmask(P0,P1,jb_,qrel,hi);}while(0)
  #define ENDW(tt) do{ if((tt)+3<NT){WAIT_BAR(2);} else if((tt)+2<NT){WAIT_BAR(1);} else {WAIT_BAR(0);} }while(0)
  for(;t+1<NT;t+=2){
    STEP(pB0,pB1,pA0,pA1,t,(t+3<NT),(t+1<NT),(t+1<NT));       ENDW(t);   RESC(); ROT();
    STEP(pA0,pA1,pB0,pB1,t+1,(t+4<NT),(t+2<NT),(t+2<NT));     ENDW(t+1); RESC(); ROT();
  }
  STEP(pB0,pB1,pA0,pA1,NT-1,false,false,false); RESC();
  { float sacc=pB0[0]+pB0[1]; _Pragma("unroll") for(int r=2;r<16;++r)sacc+=pB0[r]; _Pragma("unroll") for(int r=0;r<16;++r)sacc+=pB1[r]; l_reg+=sacc;
    pw0=(u32x4){PKW(pB0,0),PKW(pB0,2),PKW(pB0,4),PKW(pB0,6)};pw1=(u32x4){PKW(pB0,8),PKW(pB0,10),PKW(pB0,12),PKW(pB0,14)};pw2=(u32x4){PKW(pB1,0),PKW(pB1,2),PKW(pB1,4),PKW(pB1,6)};pw3=(u32x4){PKW(pB1,8),PKW(pB1,10),PKW(pB1,12),PKW(pB1,14)};
    SBAR(); pv(o,vb0+sl_cur,PAF(0),PAF(1),PAF(2),PAF(3)); }
  #undef PKW
  #undef PAF
  #undef VFR
  #undef PIN
  #undef MX3
  #undef GAPA
  #undef GAPB
  #undef EX
  #undef VRD
  #undef KRD
  #undef STEP
  #undef ENDW
  {auto rr=__builtin_amdgcn_permlane32_swap(__float_as_uint(l_reg),__float_as_uint(l_reg),false,false);l_reg=__uint_as_float(rr[0])+__uint_as_float(rr[1]);}
  if(hi==0)wsf[32+r32]=l_reg;asm volatile("s_waitcnt lgkmcnt(0)":::"memory");
  float rli[16];
  #pragma unroll
  for(int r=0;r<16;++r)rli[r]=__builtin_amdgcn_rcpf(wsf[32+crow(r,hi)]);
  bf16*Ow=O+(rowbase+q0+wid*QBLK)*OPITCH+h*D; const bf16*Gw=OG+(rowbase+q0+wid*QBLK)*PITCH+h*D;
  u32x4 gg[4];
  #pragma unroll
  for(int i=0;i<4;++i){const int row=i*8+(lane>>3),ch=lane&7; gg[i]=*(const u32x4*)(Gw+(long)row*PITCH+ch*8);}
  { bf16*stg=(bf16*)(shm+LDS_OST)+wid*2048;
    #pragma unroll
    for(int r=0;r<16;++r){const int orow=crow(r,hi);
      #pragma unroll
      for(int d0=0;d0<2;++d0)stg[orow*64+d0*32+r32]=__float2bfloat16(o[d0][r]*rli[r]);}
    asm volatile("s_waitcnt lgkmcnt(0)":::"memory");
    #pragma unroll
    for(int i=0;i<4;++i){const int row=i*8+(lane>>3),ch=lane&7; u32x4 v=*(const u32x4*)(stg+row*64+ch*8);
      #pragma unroll
      for(int w=0;w<4;++w){ const float o0=__uint_as_float(v[w]<<16),o1=__uint_as_float(v[w]&0xffff0000u),g0=__uint_as_float(gg[i][w]<<16),g1=__uint_as_float(gg[i][w]&0xffff0000u);
        v[w]=cvtpk_s(o0*__builtin_amdgcn_rcpf(1.f+__builtin_amdgcn_exp2f(-1.4426950408889634f*g0)),o1*__builtin_amdgcn_rcpf(1.f+__builtin_amdgcn_exp2f(-1.4426950408889634f*g1))); }
      ATTN_STORE16(Ow+(long)row*OPITCH+ch*8,v);} }
  asm volatile("s_waitcnt lgkmcnt(0)\n\ts_barrier":::"memory");
  #undef DMA_K
  #undef NEGC
  #undef FILLT
  #undef DMA_V
  #undef CMASK
  #undef START
  #undef RESC
  #undef ROT
}
constexpr int ATTN_LDS_BYTES=LDS_BYTES;
struct AttnTensors { const bf16* Q; const bf16* K; const bf16* V; const bf16* OG; const float* c2v; bf16* O; };
struct AttnUnit { int bh; int qb; };
struct StaticOrder {
  int vcu, G, blk;
  __device__ __forceinline__ explicit StaticOrder(int grid,int block):vcu((grid%8==0)?(block%8)*(grid/8)+block/8:block),G(grid),blk(block){}
  __device__ __forceinline__ bool next(int i,AttnUnit&u)const{
    if(G==256){ if(blk<64){ if(i>=1)return false; u.bh=blk; u.qb=0; return true; } const int j=blk-64,g=j>>6; u.bh=j&63;
      if(g==0){ if(i>=2)return false; u.qb=i?3:7; } else if(g==1){ if(i>=2)return false; u.qb=i?4:6; } else { if(i>=3)return false; u.qb=i==0?5:3-i; }
      return true; }
    const int pair=vcu+(i>>1)*G; if(pair>=BATCH*NHEAD*4)return false; const int s=pair&3; u.bh=pair>>2; u.qb=(i&1)?s:7-s; return true; }
  __device__ __forceinline__ void a_ready(const AttnUnit&)const{}
  __device__ __forceinline__ void done(const AttnUnit&)const{}
};
template<class Sched,int THRL=8> __device__ __forceinline__ void attn_phase(char*lds,const AttnTensors&T,const Sched&S,const int wave_s){
  AttnUnit u;
  int pbh=-1,pqb=-1;
  for(int i=0;S.next(i,u);++i){ S.a_ready(u); attn_unit<THRL>(u.bh/NHEAD,u.bh%NHEAD,u.qb,T.Q,T.K,T.V,T.OG,T.c2v,T.O,lds,wave_s,!(u.bh==pbh&&u.qb<=pqb)); if(u.bh!=pbh||u.qb>pqb){pbh=u.bh;pqb=u.qb;} S.done(u); }
}
#undef SBAR
#undef WAIT_BAR
}
#define GAS __attribute__((address_space(1)))
#define LAS __attribute__((address_space(3)))
typedef unsigned short bf16;
typedef unsigned v4u __attribute__((ext_vector_type(4)));
typedef float f32x4 __attribute__((ext_vector_type(4)));
typedef short bf16x8 __attribute__((ext_vector_type(8)));
typedef GAS unsigned gu32;
typedef GAS unsigned long long gu64;
#define RLX_AGENT __ATOMIC_RELAXED, __HIP_MEMORY_SCOPE_AGENT
#define LDS_WAIT() asm volatile("s_waitcnt lgkmcnt(0)" ::: "memory")
#define VM_WAIT() asm volatile("s_waitcnt vmcnt(0)" ::: "memory")
#define XB_TMO      128
#define XB_XCNT(j)  (256  + 64 * (j))
#define XB_XSUB(j)  (1280 + 64 * (j))
#define XB_XGEN(j)  (2304 + 64 * (j))
#define XB_TOP      3328
#define XB_TOPGEN   3392
#define XCD_BAR_WORDS 3456
#define XB_SPIN_CAP (1u << 18)

__device__ __forceinline__ unsigned xb_ld(unsigned* p)              { return __hip_atomic_load(p, __ATOMIC_RELAXED, __HIP_MEMORY_SCOPE_AGENT); }
__device__ __forceinline__ unsigned xb_add(unsigned* p, unsigned v) { return __hip_atomic_fetch_add(p, v, __ATOMIC_RELAXED, __HIP_MEMORY_SCOPE_AGENT); }
__device__ __forceinline__ unsigned xb_xcc_id() { return (unsigned)__builtin_amdgcn_s_getreg((3 << 11) | 20) & 0xFu; }
#define XB_SPIN(cond, bar) do { unsigned _sp = 0; while (cond) { __builtin_amdgcn_s_sleep(1); \
    if ((++_sp & 255u) == 0u) { if (xb_ld(&(bar)[XB_TMO])) break; if (_sp > XB_SPIN_CAP) { atomicAdd(&(bar)[XB_TMO], 1u); break; } } } } while (0)

struct XcdBarrier {
    unsigned* bar; unsigned x;
    volatile LAS unsigned* st;
};

__device__ __forceinline__ XcdBarrier xcd_barrier_post(unsigned* bar, volatile LAS unsigned* st) {
    XcdBarrier b; b.bar = bar; b.x = xb_xcc_id(); b.st = st;
    if (threadIdx.x == 0) (void)xb_add(&bar[XB_XCNT(b.x)], 1u);
    return b;
}
__device__ __forceinline__ void xcd_barrier_complete(unsigned* bar, unsigned x, unsigned& nloc, unsigned& nx) {
    const unsigned G = gridDim.x * gridDim.y * gridDim.z;
    unsigned sum, cnt, mine, sp = 0u;
    for (;;) {
        sum = 0u; cnt = 0u; mine = 0u;
#pragma unroll
        for (unsigned j = 0; j < 16; ++j) { const unsigned c = xb_ld(&bar[XB_XCNT(j)]); sum += c; cnt += (c > 0u) ? 1u : 0u; mine = (j == x) ? c : mine; }
        if (sum == G) break;
        __builtin_amdgcn_s_sleep(1);
        if ((++sp & 255u) == 0u) { if (xb_ld(&bar[XB_TMO])) break; if (sp > XB_SPIN_CAP) { atomicAdd(&bar[XB_TMO], 1u); break; } }
    }
    nloc = mine > 0u ? mine : 1u; nx = cnt > 0u ? cnt : 1u;
}

__device__ __forceinline__ void xcd_barrier(const XcdBarrier& b, const int wave_s) {
    asm volatile("s_waitcnt vmcnt(0)" ::: "memory");
    __syncthreads();
    if (wave_s == 0 && lane_id() == 0) {
        int z0_ = 0; asm volatile("" : "+s"(z0_));
        unsigned* bar = b.bar + z0_;
        __builtin_amdgcn_s_waitcnt(0);
        unsigned nloc = b.st[0], nx = b.st[1];
        if (nloc == 0u) { xcd_barrier_complete(bar, b.x, nloc, nx); b.st[0] = nloc; b.st[1] = nx; }
        const unsigned old = xb_add(&bar[XB_XSUB(b.x)], 1u);
        const unsigned gen = old / nloc;
        if (old + 1u == (gen + 1u) * nloc) {
            __builtin_amdgcn_fence(__ATOMIC_RELEASE, "agent");
            asm volatile("s_waitcnt vmcnt(0)" ::: "memory");
            const unsigned og = xb_add(&bar[XB_TOP], 1u);
            const unsigned tg = og / nx;
            if (og + 1u == (tg + 1u) * nx) xb_add(&bar[XB_TOPGEN], 1u);
            else XB_SPIN(xb_ld(&bar[XB_TOPGEN]) == tg, bar);
            __builtin_amdgcn_fence(__ATOMIC_ACQUIRE, "agent");
            xb_add(&bar[XB_XGEN(b.x)], 1u);
            asm volatile("s_waitcnt vmcnt(0)" ::: "memory");
        } else {
            XB_SPIN(xb_ld(&bar[XB_XGEN(b.x)]) == gen, bar);
            __builtin_amdgcn_fence(__ATOMIC_ACQUIRE, "agent");
            asm volatile("s_waitcnt vmcnt(0)" ::: "memory");
        }
    }
    __syncthreads();
}

constexpr int NWAVES = 8;
constexpr int RING_BYTES = 131072;
constexpr int LDS_BYTES = 163840;
constexpr int LDSCTL_OFF = LDS_BYTES - 1024, MISC_OFF = LDSCTL_OFF + 320;
constexpr int HALO_OFF = RING_BYTES;
constexpr int RSTD_OFF = HALO_OFF + 8192;
static_assert(RSTD_OFF + 6 * 1024 + 4096 <= LDSCTL_OFF, "LDS map");
constexpr int CW_BAR = 4096;

struct Args { const float* in[24]; float* out; unsigned char* ws; };

template <bool AF32, class F>
__device__ __forceinline__ void meta_gemm(const void* A, int lda, const bf16_t* Wt, int N, int K, int bid, int G, int wave, int lane, float* red, const F& f) {
    const int fr = lane & 15, fq = lane >> 4, kw = K / NWAVES;
    for (int cb = bid; cb < N / 16; cb += G) {
        f32x4 acc = (f32x4){0.f, 0.f, 0.f, 0.f}; float ss = 0.f;
        const bf16_t* bp = Wt + (size_t)(cb * 16 + fr) * K + wave * kw + 8 * fq;
#pragma unroll
        for (int k = 0; k < kw; k += 32) {
            bf16x8 a;
            if (AF32) {
                const float* ap = (const float*)A + (size_t)fr * lda + wave * kw + k + 8 * fq;
                const f32x4 a0 = *(const f32x4*)ap, a1 = *(const f32x4*)(ap + 4);
                ss += ((a0.x * a0.x + a0.y * a0.y) + (a0.z * a0.z + a0.w * a0.w)) + ((a1.x * a1.x + a1.y * a1.y) + (a1.z * a1.z + a1.w * a1.w));
                u32x4 w; w.x = pk2bf(a0.x, a0.y); w.y = pk2bf(a0.z, a0.w); w.z = pk2bf(a1.x, a1.y); w.w = pk2bf(a1.z, a1.w);
                a = __builtin_bit_cast(bf16x8, w);
            } else a = *(const bf16x8*)((const bf16_t*)A + (size_t)fr * lda + wave * kw + k + 8 * fq);
            const bf16x8 b = *(const bf16x8*)(bp + k);
            acc = __builtin_amdgcn_mfma_f32_16x16x32_bf16(a, b, acc, 0, 0, 0);
        }
        float* rw = red + (wave * 64 + lane) * 5;
        rw[0] = acc[0]; rw[1] = acc[1]; rw[2] = acc[2]; rw[3] = acc[3]; rw[4] = ss;
        __syncthreads();
        if (wave == 0) {
            f32x4 t = (f32x4){0.f, 0.f, 0.f, 0.f}; float s2 = 0.f;
#pragma unroll
            for (int w = 0; w < NWAVES; ++w) { const float* r_ = red + (w * 64 + lane) * 5; t[0] += r_[0]; t[1] += r_[1]; t[2] += r_[2]; t[3] += r_[3]; s2 += r_[4]; }
            float rstd = 1.f;
            if (AF32) { s2 = add_xor16(s2); s2 = add_xor32(s2); rstd = 1.0f / sqrtf(s2 * (1.f / DM) + 1e-6f); }
            float oldv[4];
#pragma unroll
            for (int r = 0; r < 4; ++r) oldv[r] = f.pre(4 * fq + r, cb * 16 + fr);
#pragma unroll
            for (int r = 0; r < 4; ++r) { const int row = 4 * fq + r; const float rs = AF32 ? __int_as_float(__builtin_amdgcn_ds_bpermute(row << 2, __float_as_int(rstd))) : 1.f; f(row, cb * 16 + fr, t[r] * rs, oldv[r]); }
        }
        __syncthreads();
    }
}
struct MEpi1 { bf16_t* p; float* pn;
    __device__ __forceinline__ float pre(int, int) const { return 0.f; }
    __device__ __forceinline__ void operator()(int r, int col, float v, float) const {
        const int row = MROWS + r; const int g = col >> 9, c_ = col & 255;
        if (g < 7) p[(size_t)row * PBW + (col & ~255) + ((c_ >> 5) & 3) * 64 + (c_ >> 7) * 32 + PERM32(c_ & 31)] = f2bf(v);
        else { const int o = col & 511; if (o < 296) pn[(size_t)row * PNW + o] = v; } } };
struct MEpiRes { float* hm;
    __device__ __forceinline__ float pre(int r, int col) const { return hm[r * DM + (col & ~31) + PERM32(col & 31)]; }
    __device__ __forceinline__ void operator()(int r, int col, float v, float old) const { hm[r * DM + (col & ~31) + PERM32(col & 31)] = old + v; } };
struct MEpi3 { float* rawm;
    __device__ __forceinline__ float pre(int, int) const { return 0.f; }
    __device__ __forceinline__ void operator()(int r, int col, float v, float) const { const int t = col >> 8, c = col & 255; rawm[(size_t)r * DFF2 + (c < 128 ? 128 * t + c : DFF + 128 * t + (c - 128))] = v; } };

__device__ __forceinline__ void meta_gemm3(const float* hm, const bf16_t* W3, int bid, int G, int wave, int lane, int tid, float* red, float* rug, const float* cw, const float* cb, float* rawm, bf16_t* am) {
    const int fr = lane & 15, fq = lane >> 4; constexpr int kw = DM / NWAVES;
    const int pb0 = G == 256 ? 128 : 0, pst = G == 256 ? 128 : G;
    for (int pr = bid - pb0; pr >= 0 && pr < DFF / 16; pr += pst) {
        const int t = pr >> 3, kk = pr & 7, cbu = 16 * t + kk;
        f32x4 au = (f32x4){0.f, 0.f, 0.f, 0.f}, ag = au; float ss = 0.f;
        const bf16_t* bpu = W3 + (size_t)(cbu * 16 + fr) * DM + wave * kw + 8 * fq; const bf16_t* bpg = bpu + (size_t)128 * DM;
#pragma unroll
        for (int k = 0; k < kw; k += 32) {
            const float* ap = hm + (size_t)fr * DM + wave * kw + k + 8 * fq;
            const f32x4 a0 = *(const f32x4*)ap, a1 = *(const f32x4*)(ap + 4);
            ss += ((a0.x * a0.x + a0.y * a0.y) + (a0.z * a0.z + a0.w * a0.w)) + ((a1.x * a1.x + a1.y * a1.y) + (a1.z * a1.z + a1.w * a1.w));
            u32x4 w; w.x = pk2bf(a0.x, a0.y); w.y = pk2bf(a0.z, a0.w); w.z = pk2bf(a1.x, a1.y); w.w = pk2bf(a1.z, a1.w);
            const bf16x8 a = __builtin_bit_cast(bf16x8, w);
            au = __builtin_amdgcn_mfma_f32_16x16x32_bf16(a, *(const bf16x8*)(bpu + k), au, 0, 0, 0);
            ag = __builtin_amdgcn_mfma_f32_16x16x32_bf16(a, *(const bf16x8*)(bpg + k), ag, 0, 0, 0);
        }
        float* rw = red + (wave * 64 + lane) * 9;
        rw[0] = au[0]; rw[1] = au[1]; rw[2] = au[2]; rw[3] = au[3]; rw[4] = ag[0]; rw[5] = ag[1]; rw[6] = ag[2]; rw[7] = ag[3]; rw[8] = ss;
        __syncthreads();
        if (wave == 0) {
            f32x4 tu = (f32x4){0.f, 0.f, 0.f, 0.f}, tg = tu; float s2 = 0.f;
#pragma unroll
            for (int w = 0; w < NWAVES; ++w) { const float* r_ = red + (w * 64 + lane) * 9; tu[0] += r_[0]; tu[1] += r_[1]; tu[2] += r_[2]; tu[3] += r_[3]; tg[0] += r_[4]; tg[1] += r_[5]; tg[2] += r_[6]; tg[3] += r_[7]; s2 += r_[8]; }
            s2 = add_xor16(s2); s2 = add_xor32(s2); const float rstd = 1.0f / sqrtf(s2 * (1.f / DM) + 1e-6f);
#pragma unroll
            for (int r = 0; r < 4; ++r) { const int row = 4 * fq + r; const float rs = __int_as_float(__builtin_amdgcn_ds_bpermute(row << 2, __float_as_int(rstd)));
                const float vu = tu[r] * rs, vg = tg[r] * rs; rug[row * 16 + fr] = vu; rug[256 + row * 16 + fr] = vg;
                if (row >= 14) { rawm[(size_t)row * DFF2 + 128 * t + 16 * kk + fr] = vu; rawm[(size_t)row * DFF2 + DFF + 128 * t + 16 * kk + fr] = vg; } }
        }
        __syncthreads();
        if (tid < 256) {
            const int row = tid >> 4, j = tid & 15, ch = 128 * t + 16 * kk + j;
            const float xu0 = rug[row * 16 + j], xu1 = row >= 1 ? rug[(row - 1) * 16 + j] : 0.f, xu2 = row >= 2 ? rug[(row - 2) * 16 + j] : 0.f;
            const float xg0 = rug[256 + row * 16 + j], xg1 = row >= 1 ? rug[256 + (row - 1) * 16 + j] : 0.f, xg2 = row >= 2 ? rug[256 + (row - 2) * 16 + j] : 0.f;
            const float cu = cb[ch] + cw[ch] * xu2 + cw[DFF2 + ch] * xu1 + cw[2 * DFF2 + ch] * xu0;
            const float cg = cb[DFF + ch] + cw[DFF + ch] * xg2 + cw[DFF2 + DFF + ch] * xg1 + cw[2 * DFF2 + DFF + ch] * xg0;
            am[(size_t)row * DFF + ch] = f2bf(cg * sigmoidf_(cg) * cu);
        }
        __syncthreads();
    }
}

__device__ __forceinline__ void wprep_layer(const float* const* in, int l, unsigned char* ws, int gw, int ngw, int lane, float* scr, int part) {
    unsigned char* wb = ws + WS_W + (size_t)(l & 1) * WL_BYTES;
    constexpr int I1 = (DM / 64) * (N1 / 32), I2 = (DM / 64) * (DM / 32), I3 = (DM / 64) * (DFF2 / 32), I4 = (DFF / 64) * (DM / 32);
    const int n1 = (part & 1) ? I1 : 0, n2 = (part & 2) ? I2 : 0, n3 = (part & 4) ? I3 : 0, n4 = (part & 8) ? I4 : 0;
    for (int it = gw; it < n1 + n2 + n3 + n4; it += ngw) {
        int r = it, mode = 1, K = DM, Nsrc = N_IN, Ndst = N1; const float* W = in[3] + (size_t)l * DM * N_IN; const float* gk = in[2] + l * DM; bf16_t* WT = (bf16_t*)(wb + WO_W1);
        if (r >= n1) { r -= n1; mode = 2; Nsrc = DM; Ndst = DM; W = in[18] + (size_t)l * DM * DM; gk = nullptr; WT = (bf16_t*)(wb + WO_W2);
            if (r >= n2) { r -= n2; mode = 3; Nsrc = DFF2; Ndst = DFF2; W = in[20] + (size_t)l * DM * DFF2; gk = in[19] + l * DM; WT = (bf16_t*)(wb + WO_W3);
                if (r >= n3) { r -= n3; mode = 4; K = DFF; Nsrc = DM; Ndst = DM; W = in[23] + (size_t)l * DFF * DM; gk = nullptr; WT = (bf16_t*)(wb + WO_W4); } } }
        wprep_item(W, gk, WT, K, Nsrc, Ndst, mode, r, scr, lane);
    }
    if (part & 1) {
        bf16_t* lup = (bf16_t*)(wb + WO_LUP);
        const float* wu = in[6] + (size_t)l * 64 * 512; const float* au = in[8] + (size_t)l * 64 * 512; const float* gu = in[9] + (size_t)l * 160 * 512;
        for (int n = gw; n < 512; n += ngw) {
#pragma unroll
            for (int kq = 0; kq < 5; ++kq) { const int k = lane + 64 * kq;
                if (k < 288) lup[n * 288 + k] = f2bf(k < 64 ? wu[k * 512 + n] : (k < 128 ? au[(k - 64) * 512 + n] : gu[(k - 128) * 512 + n])); }
        }
    }
}

struct RwP { const float* mu; const float* w0; const float* w_up; const float* a0; const float* a_up; const float* g_up; };
struct RwS { const float* mu; const float* k_k; const float* k_a; const float* r_k; const float* gn_w; const float* gn_b; };
constexpr int RCH = 8;

__global__ void __launch_bounds__(NWAVES * 64, 2) mk_fwd(Args a) {
    extern __shared__ __attribute__((aligned(16))) unsigned char lds[];
    const int tid0 = threadIdx.x, wave_s = __builtin_amdgcn_readfirstlane(tid0 >> 6);
    const int G0 = gridDim.x, bid0 = blockIdx.x;
    for (int u = tid0; u < (LDS_BYTES - LDSCTL_OFF) / 4; u += NWAVES * 64) ((LAS unsigned*)((LAS unsigned char*)lds + LDSCTL_OFF))[u] = 0u;
    __syncthreads();
    XcdBarrier bar = xcd_barrier_post((unsigned*)(a.ws + WS_CTL) + CW_BAR, (volatile LAS unsigned*)((LAS unsigned char*)lds + MISC_OFF) + 8);
#ifdef TPROBE
#define TP_MARK(ph) do { if ((ph) >= 20 && TPROBE < 20) break;     \
        const unsigned t_ = (unsigned)__builtin_amdgcn_s_memrealtime(); if (wave_s == 0 && lane_id() == 0) { volatile LAS unsigned* q_ = (volatile LAS unsigned*)((LAS unsigned char*)lds + LDSCTL_OFF + 512); \
        if ((ph) == TPROBE) q_[1] += t_ - q_[0]; q_[0] = t_; } } while (0)
#else
#define TP_MARK(ph) do {} while (0)
#endif
#define GRID_BAR() do { int wv_ = wave_s; asm volatile("" : "+s"(wv_)); xcd_barrier(bar, wv_); } while (0)
#define RSTD_TABLE(S) do { pg8::Unit u0_, u_; if (S.next(0, u0_)) { float rv_ = 0.f; if (tid < 256) rv_ = pg8::row_rstd(ssqp, u0_.pm * 256 + tid); \
        for (int i_ = 0; S.next(i_, u_); ++i_) if (tid < 256) ((LAS float*)(ldsl + RSTD_OFF))[i_ * 256 + tid] = u_.pm == u0_.pm ? rv_ : pg8::row_rstd(ssqp, u_.pm * 256 + tid); } \
        __syncthreads(); } while (0)
    TP_MARK(-1);
#define PHASE_IDS() int G_ = G0, bid_ = bid0, wv_ = wave_s; asm volatile("" : "+s"(G_), "+s"(bid_), "+s"(wv_)); int tid = wv_ * 64 + lane_id(); asm volatile("" : "+v"(tid)); \
    const int G = G_, bid = bid_, ngw = G * NWAVES, lane = tid & 63, wave = wv_, gw = bid * NWAVES + wave; (void)lane; (void)gw; (void)ngw
#define PHASE_PTRS(L) int z0_ = 0; asm volatile("" : "+s"(z0_)); const float* const* inq = a.in + z0_; unsigned char* ws = a.ws + z0_; float* out = a.out + z0_; const int lq = (L) + z0_; \
    float* hm = (float*)(ws + WS_HM); float* c2 = (float*)(ws + WS_C2); float* ssqp = (float*)(ws + WS_SSQ); \
    bf16_t* hb = (bf16_t*)(ws + WS_HB); bf16_t* p = (bf16_t*)(ws + WS_P); float* pn = (float*)(ws + WS_PN); bf16_t* y = (bf16_t*)(ws + WS_Y); \
    bf16_t* act = (bf16_t*)(ws + WS_ACT); float* fixb = (float*)(ws + WS_FIX); float* rawm = (float*)(ws + WS_RAWM); \
    const unsigned char* wbuf = ws + WS_W + (size_t)(lq & 1) * WL_BYTES; \
    const bf16_t* W1 = (const bf16_t*)(wbuf + WO_W1); const bf16_t* W2 = (const bf16_t*)(wbuf + WO_W2); const bf16_t* W3 = (const bf16_t*)(wbuf + WO_W3); const bf16_t* W4 = (const bf16_t*)(wbuf + WO_W4); \
    (void)hm; (void)c2; (void)ssqp; (void)hb; (void)p; (void)pn; (void)y; (void)act; (void)fixb; (void)rawm; (void)out; (void)W1; (void)W2; (void)W3; (void)W4
    LAS unsigned char* ldsl = (LAS unsigned char*)lds;

    {
        PHASE_IDS(); PHASE_PTRS(0);
        for (int row = gw; row < RROWS; row += ngw) {
            const f32x4* xr = (const f32x4*)(row < MROWS ? inq[0] + (size_t)row * DM : inq[1] + (size_t)(row - MROWS) * DM) + lane;
            f32x4* hr = (f32x4*)(hm + (size_t)(row < MROWS ? 0 : row - MROWS) * DM) + lane;
            f32x4 v[4]; float s = 0.f;
#pragma unroll
            for (int j = 0; j < 4; ++j) { v[j] = xr[64 * j]; if (row >= MROWS) hr[64 * j] = v[j]; s += (v[j].x * v[j].x + v[j].y * v[j].y) + (v[j].z * v[j].z + v[j].w * v[j].w); }
            s = wave_sum(s);
            if (lane < 16) ssqp[(size_t)row * 16 + lane] = lane == 0 ? s : 0.f;
            u32x2* o8 = (u32x2*)(hb + (size_t)row * DM) + lane;
#pragma unroll
            for (int j = 0; j < 4; ++j) { u32x2 w; w.x = pk2bf(v[j].x, v[j].y); w.y = pk2bf(v[j].z, v[j].w); o8[64 * j] = w; }
        }
    }
    {
        PHASE_IDS(); PHASE_PTRS(0);
        u32x4* z = (u32x4*)(p + (size_t)RROWS * PBW); const unsigned n16 = (unsigned)((16512 - RROWS) * PBW * 2 / 16);
        for (unsigned i = (unsigned)(bid * (NWAVES * 64) + tid); i < n16; i += (unsigned)(G * (NWAVES * 64))) z[i] = (u32x4){0u, 0u, 0u, 0u};
    }
#ifndef PLAIN_LAUNCH
    cg::this_grid().sync();
#endif
    TP_MARK(0);

#pragma unroll 1
    for (int l = -1; l < DEPTH; ++l) {
#pragma unroll 1
      for (int ph = l < 0 ? 1 : 0; ph < (l < 0 ? 2 : 6); ++ph) {
#ifdef TPROBE
        if (wave_s == 0 && lane_id() == 0) ((volatile LAS unsigned*)((LAS unsigned char*)lds + LDSCTL_OFF + 512))[2] = (unsigned)ph;
#endif
        if (ph == 1 || ph == 4)
        {
            PHASE_IDS(); PHASE_PTRS(l);
            if (lq + 1 < DEPTH) {
                const int first = (G == 256 && lq >= 0) ? (ph == 4 ? 128 : 8) : 0, part = lq < 0 ? 15 : (G == 256 ? (ph == 4 ? 6 : 9) : (ph == 4 ? 0 : 15));
                if (bid >= first && part) wprep_layer(inq, lq + 1, ws, gw - first * NWAVES, ngw - first * NWAVES, lane, (float*)(lds + wave * 16384), part);
            }
            __syncthreads();
        }
        if (ph == 0) {
        {
            PHASE_IDS(); PHASE_PTRS(l);
            pg8::Gemm g{hb, W1, MROWS, N1, DM}; pg8::StaticOrder S; S.init(MROWS, N1, G, bid);
            RSTD_TABLE(S);
            pg8::Epi1 E{(const LAS float*)(ldsl + RSTD_OFF), p, pn, inq[16] + lq * 64, inq[17] + lq * 64};
            pg8::gemm_phase<pg8::Epi1, pg8::StaticOrder, true, true>(ldsl, g, S, E, wave);
            meta_gemm<true>(hm, DM, W1, N1, DM, bid, G, wave, lane, (float*)lds, MEpi1{p, pn});
        }
        } else if (ph == 4) {
        {
            PHASE_IDS(); PHASE_PTRS(l);
            const float* cw = inq[21] + (size_t)lq * 3 * DFF2; const float* cb = inq[22] + (size_t)lq * DFF2;
            pg8::Gemm g{hb, W3, MROWS, DFF2, DM}; pg8::StaticOrder S; S.init(MROWS, DFF2, G, bid);
            RSTD_TABLE(S);
            pg8::EpiConv E{(const LAS float*)(ldsl + RSTD_OFF), cw, cb, act, fixb, ldsl + HALO_OFF, (LAS float*)(ldsl + RSTD_OFF + 6 * 1024)};
            pg8::gemm_phase<pg8::EpiConv, pg8::StaticOrder, true, true>(ldsl, g, S, E, wave);
            meta_gemm3(hm, W3, bid, G, wave, lane, tid, (float*)lds, (float*)(lds + 20480), cw, cb, rawm, act + (size_t)MROWS * DFF);
        }
        }
        if (ph == 1 && l >= 0) {
        {
            PHASE_IDS(); PHASE_PTRS(l);
            __syncthreads(); TP_MARK(20);
            {
                const float* mu = inq[4] + lq * 1824;
                const bf16_t* lup = (const bf16_t*)(wbuf + WO_LUP);
                const int h = wave, cg = h * 64 + lane, fr = lane & 15, fq = lane >> 4;
                const float mu_r = mu[cg], mu_k = mu[512 + cg], mu_v = mu[1024 + cg];
                const float w0c = (inq[5] + lq * 512)[cg], a0c = (inq[7] + lq * 512)[cg];
                const float kkc = (inq[10] + lq * 512)[cg], kac = (inq[11] + lq * 512)[cg], rkc = (inq[12] + lq * 512)[cg];
                LAS unsigned char* PNS = ldsl;
                LAS unsigned char* PSW = ldsl + 22528 + wave * 6528;
                LAS unsigned char* LW = ldsl + 74752 + wave * 9216;
                LAS unsigned char* LIN = ldsl + 148480;
                LAS float* MU = (LAS float*)(ldsl + 158720);
                LAS float* TR = (LAS float*)LW; LAS float* LT = (LAS float*)LW; LAS float* LAK = (LAS float*)(LW + 1280);
#define PN_DMA(uu) do { const int c_ = (uu) % NCH, r0_ = rowof((uu) / NCH, 16 * c_), p0_ = prevrow(r0_); \
                    for (int pc_ = wave; pc_ < (p0_ >= 0 ? 22 : 20); pc_ += NWAVES) { \
                        const char* src_ = (pc_ < 20 ? (const char*)(pn + (size_t)r0_ * PNW) + pc_ * 1024 : (const char*)(pn + (size_t)p0_ * PNW) + (pc_ - 20) * 1024) + lane * 16; \
                        __builtin_amdgcn_global_load_lds((const unsigned*)src_, (LAS unsigned*)(PNS + pc_ * 1024), 16, 0, 0); } } while (0)
#define PS_DMA(uu) do { const int c_ = (uu) % NCH, r0_ = rowof((uu) / NCH, 16 * c_), p0_ = prevrow(r0_); int ln_ = lane; asm volatile("" : "+v"(ln_));     \
                    _Pragma("unroll") for (int j_ = 0; j_ < 7; ++j_) { const int s_ = j_ * 8 + (ln_ >> 3); \
                        if (s_ < 51) { const int i_ = s_ / 3, sg_ = s_ - 3 * i_, rw_ = i_ ? r0_ + i_ - 1 : (p0_ >= 0 ? p0_ : r0_); \
                            const char* src_ = (const char*)(p + (size_t)rw_ * PBW) + sg_ * 1024 + wave * 128 + (ln_ & 7) * 16; \
                            __builtin_amdgcn_global_load_lds((const unsigned*)src_, (LAS unsigned*)(PSW + j_ * 1024), 16, 0, 0); } } } while (0)
#define PSV(i, sg) bf2f(((const LAS bf16_t*)PSW)[(3 * (i) + (sg)) * 64 + lane])
                if (tid < 288) MU[tid] = mu[1536 + tid];
                if (bid < NB * NCH) { PN_DMA(bid); PS_DMA(bid); }
                asm volatile("s_waitcnt vmcnt(0)" ::: "memory");
                bf16x8 bw_[2][4], ba_[2][4];
                {   const int fru = lane & 15, fqu = lane >> 4;
#pragma unroll
                    for (int nb = 0; nb < 4; ++nb) { const bf16_t* bp_ = lup + (size_t)(h * 64 + 16 * nb + fru) * 288 + 8 * fqu;
#pragma unroll
                        for (int ks = 0; ks < 2; ++ks) { bw_[ks][nb] = *(const bf16x8*)(bp_ + 32 * ks); ba_[ks][nb] = *(const bf16x8*)(bp_ + 64 + 32 * ks); }
                    } }
                for (int u = bid; u < NB * NCH; u += G) {
                    const int b = u / NCH, c = u % NCH, row0 = rowof(b, 16 * c), prow0 = prevrow(row0);
                    int tidu = tid; asm volatile("" : "+v"(tidu));
                    const int fr = tidu & 15, fq = (tidu >> 4) & 3;
                    bf16x8 bg_[5][4];
                    TP_MARK(27);
                    asm volatile("s_waitcnt lgkmcnt(0)\n\ts_barrier" ::: "memory");
                    {
                        float cur_[9], prv_[9], mu_[9];
#pragma unroll
                        for (int i = 0; i < 9; ++i) { const int e = tidu + 512 * i, ti = e / 288, j = e - 288 * ti;
                            cur_[i] = ((const LAS float*)PNS)[ti * 320 + j]; prv_[i] = ((const LAS float*)PNS)[(ti ? ti - 1 : 16) * 320 + j]; mu_[i] = MU[j]; }
#pragma unroll
                        for (int i = 0; i < 9; ++i) { const int e = tidu + 512 * i, ti = e / 288, j = e - 288 * ti;
                            const float prv = (ti || prow0 >= 0) ? prv_[i] : 0.f, s = cur_[i] + mu_[i] * (prv - cur_[i]);
                            const float ex = __builtin_amdgcn_exp2f((j < 64 ? 2.f * LOG2E : -LOG2E) * s), rc = __builtin_amdgcn_rcpf(1.f + ex);
                            ((LAS bf16_t*)LIN)[ti * 296 + j] = f2bf(j < 64 ? 1.f - 2.f * rc : (j < 128 ? s : rc)); }
                    }
                    {   const int fru = fr, fqu = fq;
#pragma unroll
                        for (int nb = 0; nb < 4; ++nb) { const bf16_t* bp_ = lup + (size_t)(h * 64 + 16 * nb + fru) * 288 + 8 * fqu;
#pragma unroll
                            for (int ks = 0; ks < 5; ++ks) bg_[ks][nb] = *(const bf16x8*)(bp_ + 128 + 32 * ks); } }
                    TP_MARK(28);
                    asm volatile("s_waitcnt lgkmcnt(0)\n\ts_barrier" ::: "memory");
                    if (u + G < NB * NCH) PN_DMA(u + G);
                    TP_MARK(22);
#define LORA_PRE(ZA, KB0, NKS, BF) do { f32x4 acc_[4]; _Pragma("unroll") for (int nb = 0; nb < 4; ++nb) acc_[nb] = (f32x4){0.f, 0.f, 0.f, 0.f}; \
                        _Pragma("unroll") for (int ks = 0; ks < (NKS); ++ks) { const bf16x8 af = *(const LAS bf16x8*)(LIN + fr * 592 + ((KB0) + 32 * ks + 8 * fq) * 2); \
                            _Pragma("unroll") for (int nb = 0; nb < 4; ++nb) acc_[nb] = __builtin_amdgcn_mfma_f32_16x16x32_bf16(af, BF[ks][nb], acc_[nb], 0, 0, 0); } \
                        WAVE_LDS_SYNC(); \
                        _Pragma("unroll") for (int nb = 0; nb < 4; ++nb) _Pragma("unroll") for (int r = 0; r < 4; ++r) TR[(4 * fq + r) * 65 + 16 * nb + fr] = acc_[nb][r]; \
                        WAVE_LDS_SYNC(); \
                        _Pragma("unroll") for (int i = 0; i < 16; ++i) ZA[i] = TR[i * 65 + lane]; } while (0)
                    float zw[16], za[16];
                    LORA_PRE(zw, 0, 2, bw_); LORA_PRE(za, 64, 2, ba_);
                    {
                        float zg[16]; LORA_PRE(zg, 128, 5, bg_); (void)zg;
                        asm volatile("s_waitcnt vmcnt(0)" ::: "memory");
                        {
                            const int ti_ = lane >> 2, pt_ = lane & 3; float gv_[16];
#pragma unroll
                            for (int k_ = 0; k_ < 16; ++k_) gv_[k_] = TR[ti_ * 65 + 16 * pt_ + k_];
                            u32x4 o0_, o1_;
                            o0_.x = pk2bf(gv_[0], gv_[1]); o0_.y = pk2bf(gv_[2], gv_[3]); o0_.z = pk2bf(gv_[4], gv_[5]); o0_.w = pk2bf(gv_[6], gv_[7]);
                            o1_.x = pk2bf(gv_[8], gv_[9]); o1_.y = pk2bf(gv_[10], gv_[11]); o1_.z = pk2bf(gv_[12], gv_[13]); o1_.w = pk2bf(gv_[14], gv_[15]);
                            bf16_t* yp_ = y + (size_t)(row0 + ti_) * DM + h * 64 + 16 * pt_;
                            *(u32x4*)yp_ = o0_; *(u32x4*)(yp_ + 8) = o1_; } }
#undef LORA_PRE
                    WAVE_LDS_SYNC();
                    const int ci = (b * 8 + h) * NCH + c;
                    unsigned char* ra = ws + WS_RA + (size_t)ci * RA_BYTES; unsigned char* rb = (unsigned char*)out + (size_t)ci * RB_BYTES;
                    bf16_t* BV = (bf16_t*)(ws + WS_BV);
                    LAS bf16_t* OA = (LAS bf16_t*)LW; LAS bf16_t* OB = OA + 16 * 72; LAS bf16_t* OK = OB + 16 * 72; LAS bf16_t* OR = OK + 16 * 72;
                    const int cxk = (lane >> 5) * 4 + ((lane >> 2) & 3), jk2 = (((lane >> 4) & 1) * 4 + (lane & 3)) * 2;
                    TP_MARK(23);
                    float atil[16]; unsigned bkB[8], bkK[8], vtp[8];
                    float cumC = 0.f;
#pragma unroll
                    for (int i = 0; i < 16; ++i) { zw[i] = 0.6065306597126334f * __builtin_amdgcn_rcpf(1.f + __builtin_amdgcn_exp2f(-LOG2E * (zw[i] + w0c))); cumC += zw[i]; }
                    float cum = 0.f, gprev = 1.f, rp = 0.f, kp_ = 0.f, vp = 0.f, be = 0.f, ke = 0.f, ve = 0.f, bve = 0.f; unsigned bvp[8];
                    unsigned short prr[17], pkk[17], pvv[17];
#pragma unroll
                    for (int i = 0; i < 17; ++i) { prr[i] = ((const LAS bf16_t*)PSW)[(3 * i) * 64 + lane]; pkk[i] = ((const LAS bf16_t*)PSW)[(3 * i + 1) * 64 + lane]; pvv[i] = ((const LAS bf16_t*)PSW)[(3 * i + 2) * 64 + lane]; }
                    WAVE_LDS_SYNC();
                    if (u + G < NB * NCH) PS_DMA(u + G);
                    rp = bf2f(prr[0]); kp_ = bf2f(pkk[0]); vp = bf2f(pvv[0]);
                    const float hp0 = prow0 >= 0 ? 1.f : 0.f;
#pragma unroll
                    for (int i0 = 0; i0 < 16; i0 += 4) {
                        float rs4[4], vs4[4], alr4[4], kkr4[4], kpr4[4], red[8];
#pragma unroll
                        for (int j = 0; j < 4; ++j) { const int i = i0 + j;
                            const float rc = bf2f(prr[i + 1]), kc = bf2f(pkk[i + 1]), vc = bf2f(pvv[i + 1]);
                            const float hp = i ? 1.f : hp0;
                            const float rs = rc + mu_r * (hp * rp - rc), ks_ = kc + mu_k * (hp * kp_ - kc), vs = vc + mu_v * (hp * vp - vc);
                            rp = rc; kp_ = kc; vp = vc;
                            const float alr = __builtin_amdgcn_rcpf(1.f + __builtin_amdgcn_exp2f(-LOG2E * (za[i] + a0c)));
                            const float kkr = ks_ * kkc, kpr = ks_ * (1.f + (alr - 1.f) * kac);
                            rs4[j] = rs; vs4[j] = vs; alr4[j] = alr; kkr4[j] = kkr; kpr4[j] = kpr; red[2 * j] = kkr * kkr; red[2 * j + 1] = rs * kpr * rkc; }
                        wave_sum_dpp8(red);
#pragma unroll
                        for (int j = 0; j < 4; ++j) { const int i = i0 + j;
                            cum += zw[i];
                            const float kk = kkr4[j] * __builtin_amdgcn_rsqf(fmaxf(red[2 * j], 1e-24f)), bon = red[2 * j + 1], kpr = kpr4[j], vs = vs4[j];
                            const float eg = __builtin_amdgcn_exp2f(LOG2E * cum), gi = __builtin_amdgcn_exp2f(-LOG2E * cum), tail = __builtin_amdgcn_exp2f(LOG2E * (cum - cumC));
                            atil[i] = -kk * gprev;
                            const float bb = kk * alr4[j], rtil = rs4[j] * gi; gprev = gi;
                            OA[i * 72 + lane] = f2bf(atil[i]); OB[i * 72 + lane] = f2bf(bb * eg); OK[i * 72 + lane] = f2bf(kpr * eg); OR[i * 72 + lane] = f2bf(rtil);
                            if (i & 1) { bkB[i >> 1] = pk2bf(be, bb * tail); bkK[i >> 1] = pk2bf(ke, kpr * tail); vtp[i >> 1] = pk2bf(ve, vs); } else { be = bb * tail; ke = kpr * tail; ve = vs; }
                            if (i & 1) bvp[i >> 1] = pk2bf(bve, bon * vs); else bve = bon * vs; }
                    }
                    {
                        ((float*)(rb + 3584))[lane] = gprev;
#pragma unroll
                        for (int q = 0; q < 4; ++q) *(u32x4*)(ra + 4096 + lane * 64 + ((q ^ SWZ4(lane)) << 4)) = (u32x4){bkB[2 * q], bkB[2 * q + 1], bkK[2 * q], bkK[2 * q + 1]};
                        *(u32x4*)(rb + lane * 32) = (u32x4){vtp[0], vtp[1], vtp[2], vtp[3]}; *(u32x4*)(rb + lane * 32 + 16) = (u32x4){vtp[4], vtp[5], vtp[6], vtp[7]};
                    }
                    WAVE_LDS_SYNC();
                    TP_MARK(24);
#define REC_STORE(TILE, DST) do { _Pragma("unroll") for (int hh_ = 0; hh_ < 2; ++hh_) { const int i_ = (lane >> 3) + 8 * hh_, pc_ = lane & 7, c_ = pc_ ^ ((i_ >> 1) & 7), base_ = (c_ >> 2) * 32 + (c_ & 3) * 4; \
                        const u32x2 lo_ = *(const LAS u32x2*)((TILE) + i_ * 72 + base_), hi_ = *(const LAS u32x2*)((TILE) + i_ * 72 + base_ + 16); \
                        *(u32x4*)((DST) + i_ * 128 + pc_ * 16) = (u32x4){lo_.x, lo_.y, hi_.x, hi_.y}; } } while (0)
                    REC_STORE(OR, ra + 2048);
                    {
                        f32x4 dab = (f32x4){0.f, 0.f, 0.f, 0.f}, dak = dab, drb = dab, drk = dab;
#pragma unroll
                        for (int ks = 0; ks < 2; ++ks) {
                            const int off = fr * 72 + 32 * ks + 8 * fq;
                            const bf16x8 fa = *(const LAS bf16x8*)(OA + off), fb = *(const LAS bf16x8*)(OB + off), fk = *(const LAS bf16x8*)(OK + off), frr = *(const LAS bf16x8*)(OR + off);
                            dab = __builtin_amdgcn_mfma_f32_16x16x32_bf16(fa, fb, dab, 0, 0, 0); dak = __builtin_amdgcn_mfma_f32_16x16x32_bf16(fa, fk, dak, 0, 0, 0);
                            drb = __builtin_amdgcn_mfma_f32_16x16x32_bf16(frr, fb, drb, 0, 0, 0); drk = __builtin_amdgcn_mfma_f32_16x16x32_bf16(frr, fk, drk, 0, 0, 0);
                        }
#pragma unroll
                        for (int r = 0; r < 4; ++r) { const int i = 4 * fq + r, j = fr;
                            LT[i * 20 + j] = j < i ? dab[r] : 0.f; LAK[i * 16 + j] = j < i ? dak[r] : 0.f;
                            bf16_t* mp = (bf16_t*)(rb + 2048 + i * 64 + (((j >> 2) ^ SWZ4(i)) << 4)) + (j & 3);
                            mp[0] = f2bf(j <= i ? drb[r] : 0.f); mp[4] = f2bf(j <= i ? drk[r] : 0.f); }
                    }
                    WAVE_LDS_SYNC();
                    {
#pragma unroll
                        for (int k_ = 0; k_ < 8; ++k_) { OB[(2 * k_) * 72 + lane] = (bf16_t)(bvp[k_] & 0xffffu); OB[(2 * k_ + 1) * 72 + lane] = (bf16_t)(bvp[k_] >> 16); }
                        WAVE_LDS_SYNC();
                        const int ti_ = lane >> 2, pt_ = lane & 3;
                        const u32x4 b0_ = *(const LAS u32x4*)(OB + ti_ * 72 + 16 * pt_), b1_ = *(const LAS u32x4*)(OB + ti_ * 72 + 16 * pt_ + 8);
                        bf16_t* bp_ = BV + (size_t)(row0 + ti_) * 512 + h * 64 + 16 * pt_;
                        *(u32x4*)bp_ = b0_; *(u32x4*)(bp_ + 8) = b1_;
                    }
                    float tt[16];
#pragma unroll
                    for (int mm = 0; mm < 16; ++mm) tt[mm] = mm == fr ? 1.f : 0.f;
#pragma unroll
                    for (int j = 14; j >= 0; --j) { float val = 0.f;
#pragma unroll
                        for (int mm = j + 1; mm < 16; ++mm) val += tt[mm] * LT[mm * 20 + j];
                        tt[j] += val; }
                    WAVE_LDS_SYNC();
                    if (fq == 0) {
#pragma unroll
                        for (int mm = 0; mm < 16; ++mm) LT[fr * 20 + mm] = tt[mm]; }
                    {
                        f32x4 g4 = (f32x4){0.f, 0.f, 0.f, 0.f};
#pragma unroll
                        for (int mm = 0; mm < 16; ++mm) g4 += *(const LAS f32x4*)(LAK + mm * 16 + 4 * fq) * tt[mm];
                        u32x2 w; w.x = pk2bf(g4[0], g4[1]); w.y = pk2bf(g4[2], g4[3]);
                        *(u32x2*)(rb + 3072 + (fr * 16 + 4 * fq) * 2) = w;
                    }
                    WAVE_LDS_SYNC();
                    TP_MARK(25);
                    {
#pragma unroll
                        for (int i = 0; i < 16; ++i) { float acc = 0.f;
                            const f32x4 t0 = *(const LAS f32x4*)(LT + i * 20), t1 = *(const LAS f32x4*)(LT + i * 20 + 4), t2 = *(const LAS f32x4*)(LT + i * 20 + 8), t3 = *(const LAS f32x4*)(LT + i * 20 + 12);
                            const float trow[16] = {t0[0], t0[1], t0[2], t0[3], t1[0], t1[1], t1[2], t1[3], t2[0], t2[1], t2[2], t2[3], t3[0], t3[1], t3[2], t3[3]};
#pragma unroll
                            for (int mm = 0; mm <= i; ++mm) acc += trow[mm] * atil[mm];
                            OK[i * 72 + lane] = f2bf(acc); }
                        WAVE_LDS_SYNC();
                        REC_STORE(OK, ra);
                    }
#undef REC_STORE
                    TP_MARK(26);
                }
            }
            __syncthreads();
#undef PN_DMA
#undef PS_DMA
#undef PSV
            TP_MARK(29);
            TP_MARK(21);
            const float* q_g = inq[16] + lq * 64; const float* k_g = inq[17] + lq * 64; const float* b_f = inq[15] + lq * 8;
            for (int it = gw - (G >= 96 ? 80 * NWAVES : 0); it >= 0 && it < NMETA * NH; it += ngw) {
                const int row = MROWS + (it >> 3), h = it & 7;
                bf16_t* qp = p + (size_t)row * PBW + 1536 + h * 64 + lane; bf16_t* kp = p + (size_t)row * PBW + 2048 + h * 64 + lane;
                const float q = bf2f(*qp), k = bf2f(*kp);
                const float mq = wave_sum(q * q) * (1.f / 64.f), mk = wave_sum(k * k) * (1.f / 64.f);
                *qp = f2bf(q * (1.0f / sqrtf(mq + 1e-6f)) * q_g[lane] * (0.125f * LOG2E));
                *kp = f2bf(k * (1.0f / sqrtf(mk + 1e-6f)) * k_g[lane]);
            }
            for (int it = bid - (G >= 80 ? 16 : 0); it >= 0 && it < NB * NH; it += G) {
                constexpr int PER = 5;
                const int b = it >> 3, h = it & 7;
                float zv[PER], loc[PER], s = 0.f;
#pragma unroll
                for (int i = 0; i < PER; ++i) { const int t = tid * PER + i; zv[i] = pn[(size_t)rowof(b, t < LTOT ? t : LTOT - 1) * PNW + 288 + h]; }
#pragma unroll
                for (int i = 0; i < PER; ++i) { const int t = tid * PER + i;
                    const float v = t < LTOT ? -__builtin_amdgcn_logf(1.f + __builtin_amdgcn_exp2f(-LOG2E * (zv[i] + b_f[h]))) : 0.f;
                    s += v; loc[i] = s; }
                float incl = s;
#pragma unroll
                for (int o = 1; o < 64; o <<= 1) { const float n = __int_as_float(__builtin_amdgcn_ds_bpermute((lane - o) << 2, __float_as_int(incl))); if (lane >= o) incl += n; }
                float base = incl - s;
                if (lane == 63) ((LAS float*)ldsl)[wave] = incl;
                __syncthreads();
#pragma unroll
                for (int w = 0; w < NWAVES - 1; ++w) base += w < wave ? ((const LAS float*)ldsl)[w] : 0.f;
                float* cv = c2 + (size_t)it * 2176;
#pragma unroll
                for (int i = 0; i < PER; ++i) { const int t = tid * PER + i; if (t < LTOT) cv[t < NMETA ? t : t + 112] = base + loc[i]; }
                if (tid < 112) cv[16 + tid] = 1e5f;
                __syncthreads();
            }
        }
        } else if (ph == 2) {
        {
            PHASE_IDS(); PHASE_PTRS(l);
            typedef short s16x4 __attribute__((ext_vector_type(4)));
            constexpr int SLOTB = 12288, NSLOT = 10  , YB_OFF = NSLOT * SLOTB, YB_BYTES = 32 * 68 * 4, NSC = (NCH + 1) / 2;
            static_assert(YB_OFF + 2 * YB_BYTES <= LDSCTL_OFF, "scan LDS map");
#define RAW_BAR() asm volatile("s_waitcnt lgkmcnt(0)\n\ts_barrier" ::: "memory")
#define QXOR1(x) __int_as_float(__builtin_amdgcn_update_dpp(0, __float_as_int(x), 0xB1, 0xf, 0xf, false))
#define QXOR2(x) __int_as_float(__builtin_amdgcn_update_dpp(0, __float_as_int(x), 0x4E, 0xf, 0xf, false))
            for (int unit = bid; unit < 64; unit += G) {
                const int b = unit >> 3, h = unit & 7, fr = lane & 15, fq = lane >> 4;
                const unsigned char* RA0 = ws + WS_RA + (size_t)unit * NCH * RA_BYTES; const unsigned char* RB0 = (const unsigned char*)out + (size_t)unit * NCH * RB_BYTES;
                if (wave < 4) {
                    const int v = 16 * wave + fr;
                    f32x4 Z[4];
#pragma unroll
                    for (int kb = 0; kb < 4; ++kb) Z[kb] = (f32x4){0.f, 0.f, 0.f, 0.f};
                    const int o_ah0 = fr * 128 + (((fq) ^ ((fr >> 1) & 7)) << 4), o_ah1 = fr * 128 + (((4 + fq) ^ ((fr >> 1) & 7)) << 4);
                    const int o_bk = 4096 + fr * 64 + ((fq ^ SWZ4(fr)) << 4), o_mrk = 10240 + fr * 64 + ((fq ^ SWZ4(fr)) << 4);
                    const int o_vt = 8192 + v * 32 + fq * 8, o_g = 11264 + fr * 32 + fq * 8, o_gam = 11776 + fq * 16;
                    RAW_BAR();
                    for (int s = 0; s < NSC; ++s) {
                        LAS float* YB = (LAS float*)(ldsl + YB_OFF + (s & 1) * YB_BYTES);
                        const int nc = (NCH - 2 * s) < 2 ? 1 : 2;
                        for (int cs = 0; cs < nc; ++cs) {
                            const LAS unsigned char* sl = ldsl + ((2 * s + cs) % NSLOT) * SLOTB;
                            const bf16x8 ah0 = *(const LAS bf16x8*)(sl + o_ah0), ah1 = *(const LAS bf16x8*)(sl + o_ah1);
                            const bf16x8 rh0 = *(const LAS bf16x8*)(sl + 2048 + o_ah0), rh1 = *(const LAS bf16x8*)(sl + 2048 + o_ah1);
                            bf16x8 bk[4]; f32x4 gam[4];
#pragma unroll
                            for (int kb = 0; kb < 4; ++kb) { bk[kb] = *(const LAS bf16x8*)(sl + o_bk + kb * 1024); gam[kb] = *(const LAS f32x4*)(sl + o_gam + kb * 64); }
                            const u32x2 vt = *(const LAS u32x2*)(sl + o_vt);
                            const bf16x8 mrk = *(const LAS bf16x8*)(sl + o_mrk);
                            const u32x2 g4 = *(const LAS u32x2*)(sl + o_g);
                            u32x4 zw01, zw23;
                            zw01.x = pk2bf(Z[0][0], Z[0][1]); zw01.y = pk2bf(Z[0][2], Z[0][3]); zw01.z = pk2bf(Z[1][0], Z[1][1]); zw01.w = pk2bf(Z[1][2], Z[1][3]);
                            zw23.x = pk2bf(Z[2][0], Z[2][1]); zw23.y = pk2bf(Z[2][2], Z[2][3]); zw23.z = pk2bf(Z[3][0], Z[3][1]); zw23.w = pk2bf(Z[3][2], Z[3][3]);
                            const bf16x8 zp01 = __builtin_bit_cast(bf16x8, zw01), zp23 = __builtin_bit_cast(bf16x8, zw23);
                            f32x4 U = (f32x4){0.f, 0.f, 0.f, 0.f}, Yv = U;
                            U = __builtin_amdgcn_mfma_f32_16x16x32_bf16(ah0, zp01, U, 0, 0, 0); U = __builtin_amdgcn_mfma_f32_16x16x32_bf16(ah1, zp23, U, 0, 0, 0);
                            U = __builtin_amdgcn_mfma_f32_16x16x16bf16_1k(__builtin_bit_cast(s16x4, g4), __builtin_bit_cast(s16x4, vt), U, 0, 0, 0);
                            Yv = __builtin_amdgcn_mfma_f32_16x16x32_bf16(rh0, zp01, Yv, 0, 0, 0); Yv = __builtin_amdgcn_mfma_f32_16x16x32_bf16(rh1, zp23, Yv, 0, 0, 0);
                            u32x4 uvw; uvw.x = pk2bf(U[0], U[1]); uvw.y = pk2bf(U[2], U[3]); uvw.z = vt.x; uvw.w = vt.y;
                            const bf16x8 uv = __builtin_bit_cast(bf16x8, uvw);
                            Yv = __builtin_amdgcn_mfma_f32_16x16x32_bf16(mrk, uv, Yv, 0, 0, 0);
#pragma unroll
                            for (int kb = 0; kb < 4; ++kb) { Z[kb] = Z[kb] * gam[kb]; Z[kb] = __builtin_amdgcn_mfma_f32_16x16x32_bf16(bk[kb], uv, Z[kb], 0, 0, 0); }
#pragma unroll
                            for (int r = 0; r < 4; ++r) YB[(cs * 16 + 4 * fq + r) * 68 + v] = Yv[r];
                        }
                        RAW_BAR();
                    }
                } else if (wave < 6) {
                    const unsigned lds0 = (unsigned)(uintptr_t)lds; const int lw = wave - 4;
#define DMA_SC(sc) do { const int nc_ = (NCH - 2 * (sc)) < 2 ? 1 : 2; for (int cs_ = 0; cs_ < nc_; ++cs_) { const int ch_ = 2 * (sc) + cs_; \
                        _Pragma("unroll") for (int pc_ = 0; pc_ < 6; ++pc_) { const int pc = lw * 6 + pc_; \
                            const unsigned char* src_ = (pc < 8 ? RA0 + (size_t)ch_ * RA_BYTES + pc * 1024 : RB0 + (size_t)ch_ * RB_BYTES + (pc - 8) * 1024) + lane * 16; \
                            attn_body::glds16(src_, (unsigned)__builtin_amdgcn_readfirstlane(lds0 + (ch_ % NSLOT) * SLOTB + pc * 1024)); } } } while (0)
                    DMA_SC(0); DMA_SC(1); DMA_SC(2); DMA_SC(3);
                    asm volatile("s_waitcnt vmcnt(36)\n\ts_barrier" ::: "memory");
                    for (int s = 0; s < NSC; ++s) {
                        if (s + 4 < NSC) DMA_SC(s + 4);
#define NPC_(sc) ((sc) < NSC ? ((NCH - 2 * (sc)) < 2 ? 6 : 12) : 0)
                        const int fl = NPC_(s + 2) + NPC_(s + 3) + NPC_(s + 4);
#undef NPC_
                        if (fl == 36) asm volatile("s_waitcnt vmcnt(36)\n\ts_barrier" ::: "memory");
                        else if (fl == 30) asm volatile("s_waitcnt vmcnt(30)\n\ts_barrier" ::: "memory");
                        else if (fl == 18) asm volatile("s_waitcnt vmcnt(18)\n\ts_barrier" ::: "memory");
                        else if (fl == 6) asm volatile("s_waitcnt vmcnt(6)\n\ts_barrier" ::: "memory");
                        else asm volatile("s_waitcnt vmcnt(0)\n\ts_barrier" ::: "memory");
                    }
#undef DMA_SC
                } else {
                    const int pw = wave - 6, tk = lane >> 2, part = lane & 3, cgv = h * 64 + part * 16;
                    const bf16_t* BV = (const bf16_t*)(ws + WS_BV);
                    float gnw[16], gnb[16];
#pragma unroll
                    for (int j = 0; j < 16; ++j) { gnw[j] = (inq[13] + lq * 512)[cgv + j]; gnb[j] = (inq[14] + lq * 512)[cgv + j]; }
#define PLOAD(G0, G1, B0, B1, sg) do { const int cn_ = 2 * (sg) + pw; if ((sg) < NSC && cn_ < NCH) { const size_t rown = (size_t)rowof(b, 16 * cn_ + tk); \
                        G0 = *(const u32x4*)(y + rown * DM + cgv); G1 = *(const u32x4*)(y + rown * DM + cgv + 8); B0 = *(const u32x4*)(BV + rown * 512 + cgv); B1 = *(const u32x4*)(BV + rown * 512 + cgv + 8); } } while (0)
                    u32x4 ga0 = (u32x4){0u, 0u, 0u, 0u}, ga1 = ga0, ba0 = ga0, ba1 = ga0, gb0 = ga0, gb1 = ga0, bb0 = ga0, bb1 = ga0, gc0 = ga0, gc1 = ga0, bc0 = ga0, bc1 = ga0;
                    PLOAD(gb0, gb1, bb0, bb1, 0); PLOAD(gc0, gc1, bc0, bc1, 1);
                    RAW_BAR();
                    for (int s = 0; s <= NSC; ++s) {
                        const int cp = 2 * (s - 1) + pw;
                        const bool do_now = s >= 1 && cp < NCH && (cp > 0 || b == 0);
                        const u32x4 g0 = ga0, g1 = ga1, b0 = ba0, b1 = ba1;
                        ga0 = gb0; ga1 = gb1; ba0 = bb0; ba1 = bb1; gb0 = gc0; gb1 = gc1; bb0 = bc0; bb1 = bc1;
                        PLOAD(gc0, gc1, bc0, bc1, s + 2);
                        if (do_now) {
                            const LAS float* yb = (const LAS float*)(ldsl + YB_OFF + ((s - 1) & 1) * YB_BYTES) + (pw * 16 + tk) * 68 + part * 16;
                            float yv[16];
#pragma unroll
                            for (int q4 = 0; q4 < 4; ++q4) { const f32x4 t4 = *(const LAS f32x4*)(yb + 4 * q4); yv[4 * q4] = t4[0]; yv[4 * q4 + 1] = t4[1]; yv[4 * q4 + 2] = t4[2]; yv[4 * q4 + 3] = t4[3]; }
                            float s1 = 0.f;
#pragma unroll
                            for (int j = 0; j < 16; ++j) s1 += yv[j];
                            s1 += QXOR1(s1); s1 += QXOR2(s1);
                            const float mean = s1 * (1.f / 64.f); float s2 = 0.f;
#pragma unroll
                            for (int j = 0; j < 16; ++j) { yv[j] -= mean; s2 += yv[j] * yv[j]; }
                            s2 += QXOR1(s2); s2 += QXOR2(s2);
                            const float rstd = 1.0f / sqrtf(s2 * (1.f / 64.f) + 64e-5f);
                            const unsigned gws[8] = {g0.x, g0.y, g0.z, g0.w, g1.x, g1.y, g1.z, g1.w}, bws[8] = {b0.x, b0.y, b0.z, b0.w, b1.x, b1.y, b1.z, b1.w};
                            unsigned ow[8];
#pragma unroll
                            for (int j2 = 0; j2 < 8; ++j2) {
                                const float oa = (yv[2 * j2] * rstd * gnw[2 * j2] + gnb[2 * j2] + __uint_as_float(bws[j2] << 16)) * __uint_as_float(gws[j2] << 16);
                                const float ob = (yv[2 * j2 + 1] * rstd * gnw[2 * j2 + 1] + gnb[2 * j2 + 1] + __uint_as_float(bws[j2] & 0xffff0000u)) * __uint_as_float(gws[j2] & 0xffff0000u);
                                ow[j2] = pk2bf(oa, ob); }
                            bf16_t* yo = y + (size_t)rowof(b, 16 * cp + tk) * DM + cgv;
                            *(u32x4*)yo = (u32x4){ow[0], ow[1], ow[2], ow[3]}; *(u32x4*)(yo + 8) = (u32x4){ow[4], ow[5], ow[6], ow[7]};
                        }
                        if (s < NSC) RAW_BAR();
                    }
#undef PLOAD
                }
                __syncthreads();
            }
#undef RAW_BAR
#undef QXOR1
#undef QXOR2
        }
        TP_MARK(30);
        {
            PHASE_IDS(); PHASE_PTRS(l);
            if (gw < NH * NMETA) {
                const int h = gw >> 4, t = gw & 15;
                const bf16_t* qrow = p + (size_t)(MROWS + t) * PBW + 1536 + h * 64;
                float s = -INFINITY;
                if (lane <= t) { const bf16_t* kr = p + (size_t)(MROWS + lane) * PBW + 2048 + h * 64; float d = 0.f;
                    for (int e = 0; e < 64; ++e) d += bf2f(qrow[e]) * bf2f(kr[e]);
                    s = d - c2[(size_t)h * 2176 + lane]; }
                const float mx = wave_max(s); const float e = lane <= t ? exp2f(s - mx) : 0.f; const float sum = wave_sum(e);
                float o = 0.f;
                for (int j = 0; j <= t; ++j) o += __int_as_float(__builtin_amdgcn_readlane(__float_as_int(e), j)) * bf2f(p[(size_t)(MROWS + j) * PBW + 2560 + h * 64 + lane]);
                const float og = bf2f(p[(size_t)(MROWS + t) * PBW + 3072 + h * 64 + lane]);
                y[(size_t)(MROWS + t) * DM + 512 + h * 64 + lane] = f2bf(o * __builtin_amdgcn_rcpf(sum) * __builtin_amdgcn_rcpf(1.f + __builtin_amdgcn_exp2f(-LOG2E * og)));
            }
        }
        __syncthreads();
        {
            PHASE_IDS(); PHASE_PTRS(l);
            typedef attn_body::bf16 abf;
            const attn_body::AttnTensors AT{(const abf*)(p + 1536), (const abf*)(p + 2048), (const abf*)(p + 2560), (const abf*)(p + 3072), c2, (abf*)(y + 512)};
            const attn_body::StaticOrder S(G, bid);
            TP_MARK(31);
            attn_body::attn_phase<attn_body::StaticOrder>((char*)lds, AT, S, wave);
            TP_MARK(32);
        }
        } else if (ph == 3) {
        {
            PHASE_IDS(); PHASE_PTRS(l);
            pg8::Gemm g{y, W2, MROWS, DM, DM}; pg8::StaticOrder S; S.init(MROWS, DM, G, bid);
            pg8::EpiRes E{nullptr, hb, ssqp};
            pg8::gemm_phase<pg8::EpiRes, pg8::StaticOrder, true, true>(ldsl, g, S, E, wave);
            meta_gemm<false>(y + (size_t)MROWS * DM, DM, W2, DM, DM, bid, G, wave, lane, (float*)lds, MEpiRes{hm});
        }
        } else if (ph == 5) {
        {
            PHASE_IDS(); PHASE_PTRS(l);
            const float* cw = inq[21] + (size_t)lq * 3 * DFF2; const float* cb = inq[22] + (size_t)lq * DFF2;
            pg8::Gemm g{act, W4, MROWS, DM, DFF}; pg8::StaticOrder S; S.init(MROWS, DM, G, bid);
            {
                pg8::Unit u;
                for (int i = 0; S.next(i, u); ++i) {
                    const int pm = u.pm;
                    const float* own0 = fixb + (size_t)(pm * 4) * DFF2; const float* own1 = own0 + DFF2;
                    const float* pv0 = (pm & 7) ? fixb + (size_t)((pm - 1) * 4 + 2) * DFF2 : rawm + (size_t)14 * DFF2; const float* pv1 = pv0 + DFF2;
#define FIX_LOAD(J) const f32x4 w0u = *(const f32x4*)(cw + (J)), w1u = *(const f32x4*)(cw + DFF2 + (J)), w2u = *(const f32x4*)(cw + 2 * DFF2 + (J)), bu = *(const f32x4*)(cb + (J)), \
                        w0g = *(const f32x4*)(cw + DFF + (J)), w1g = *(const f32x4*)(cw + DFF2 + DFF + (J)), w2g = *(const f32x4*)(cw + 2 * DFF2 + DFF + (J)), bg = *(const f32x4*)(cb + DFF + (J)), \
                        au = *(const f32x4*)(pv0 + (J)), bu_ = *(const f32x4*)(pv1 + (J)), cu_ = *(const f32x4*)(own0 + (J)), du = *(const f32x4*)(own1 + (J)), \
                        ag = *(const f32x4*)(pv0 + DFF + (J)), bg_ = *(const f32x4*)(pv1 + DFF + (J)), cg_ = *(const f32x4*)(own0 + DFF + (J)), dg = *(const f32x4*)(own1 + DFF + (J))
#define FIX_COMP(O0, O1) do { const f32x4 u0 = bu + w0u * au + w1u * bu_ + w2u * cu_, g0 = bg + w0g * ag + w1g * bg_ + w2g * cg_; \
                        const f32x4 u1 = bu + w0u * bu_ + w1u * cu_ + w2u * du, g1 = bg + w0g * bg_ + w1g * cg_ + w2g * dg; \
                        O0.x = pk2bf(g0[0] * sigmoidf_(g0[0]) * u0[0], g0[1] * sigmoidf_(g0[1]) * u0[1]); O0.y = pk2bf(g0[2] * sigmoidf_(g0[2]) * u0[2], g0[3] * sigmoidf_(g0[3]) * u0[3]); \
                        O1.x = pk2bf(g1[0] * sigmoidf_(g1[0]) * u1[0], g1[1] * sigmoidf_(g1[1]) * u1[1]); O1.y = pk2bf(g1[2] * sigmoidf_(g1[2]) * u1[2], g1[3] * sigmoidf_(g1[3]) * u1[3]); } while (0)
                    const int j0 = 4 * tid, j1 = 4 * tid + 4 * NWAVES * 64; const bool two = j1 < DFF; const int j1c = two ? j1 : j0;
                    u32x2 a0, a1, b0, b1;
                    { FIX_LOAD(j0); FIX_COMP(a0, a1); }
                    { FIX_LOAD(j1c);
                      *(u32x2*)(act + (size_t)(256 * pm) * DFF + j0) = a0; *(u32x2*)(act + (size_t)(256 * pm + 1) * DFF + j0) = a1;
                      FIX_COMP(b0, b1); }
                    if (two) { *(u32x2*)(act + (size_t)(256 * pm) * DFF + j1) = b0; *(u32x2*)(act + (size_t)(256 * pm + 1) * DFF + j1) = b1; }
#undef FIX_LOAD
#undef FIX_COMP
                }
                asm volatile("s_waitcnt vmcnt(0)" ::: "memory"); __syncthreads();
            }
            pg8::EpiRes E{lq + 1 == DEPTH ? out : nullptr, hb, ssqp};
            pg8::gemm_phase<pg8::EpiRes, pg8::StaticOrder, true, true>(ldsl, g, S, E, wave);
            meta_gemm<false>(act + (size_t)MROWS * DFF, DFF, W4, DM, DFF, bid, G, wave, lane, (float*)lds, MEpiRes{hm});
        }
        }
#ifdef TPROBE
#ifdef TPROBE_WAIT
        TP_MARK(19);
#endif
        GRID_BAR(); TP_MARK(ph == 0 ? 1 : ph == 1 ? 2 : ph == 2 ? 3 : ph == 3 ? 4 : ph == 4 ? 5 : 6);
#if TPROBE == 40
        GRID_BAR(); TP_MARK(40);
#endif
#else
        if (ph < 5 || l + 1 < DEPTH) GRID_BAR();
#endif
      }
    }
#ifdef TPROBE
#ifndef TPROBE_BLOCK
#define TPROBE_BLOCK 0
#endif
    if (bid0 == TPROBE_BLOCK && wave_s == 0 && lane_id() == 0) a.out[0] += (float)((volatile LAS unsigned*)((LAS unsigned char*)lds + LDSCTL_OFF + 512))[1] * 0.0001f;
#endif
}

extern "C" void kernel_launch(void* const* d_in, const int* in_sizes, int n_in, void* d_out, int out_size, void* d_ws, size_t ws_size, hipStream_t stream) {
    static int grid = 0;
    if (grid == 0) {
        if (n_in != 24 || out_size != MROWS * DM || ws_size < WS_END) { fprintf(stderr, "kernel_launch: unexpected shapes (n_in %d out %d ws %zu)\n", n_in, out_size, ws_size); grid = -1; return; }
        int dev = 0, cus = 0, per_cu = 0;
        hipGetDevice(&dev); hipDeviceGetAttribute(&cus, hipDeviceAttributeMultiprocessorCount, dev);
        if (hipFuncSetAttribute((const void*)mk_fwd, hipFuncAttributeMaxDynamicSharedMemorySize, LDS_BYTES) != hipSuccess) { fprintf(stderr, "kernel_launch: hipFuncSetAttribute failed\n"); grid = -1; return; }
        hipOccupancyMaxActiveBlocksPerMultiprocessor(&per_cu, (const void*)mk_fwd, NWAVES * 64, LDS_BYTES);
        (void)hipGetLastError();
        if (per_cu < 1) { fprintf(stderr, "kernel_launch: occupancy query says %d blocks per CU\n", per_cu); }
        grid = cus;
    }
    if (grid < 0) return;
    hipMemsetAsync((char*)d_ws + WS_CTL, 0, 32768, stream);
    Args a{};
    for (int i = 0; i < 24; ++i) a.in[i] = (const float*)d_in[i];
    a.out = (float*)d_out; a.ws = (unsigned char*)d_ws;
    void* args[] = {&a};
#ifdef PLAIN_LAUNCH
    hipLaunchKernelGGL(mk_fwd, dim3(grid), dim3(NWAVES * 64), LDS_BYTES, stream, a); hipError_t e = hipPeekAtLastError(); (void)args;
#else
    hipError_t e = hipLaunchCooperativeKernel((const void*)mk_fwd, dim3(grid), dim3(NWAVES * 64), args, LDS_BYTES, stream);
#endif
    if (e != hipSuccess) fprintf(stderr, "cooperative launch failed: %s (grid %d)\n", hipGetErrorString(e), grid);
}
```
